# Optimizing an MI355X kernel written in HIP

```python
import math
import jax, jax.numpy as jnp
from jax import lax
import numpy as np

D_MODEL = 1024
BATCH = 8
SEQ = 4096
DEPTH = 2

CTX_LEN = 256
GRID_W = 64
D_MIX = D_MODEL
D_A = 512
D_B = D_MIX - D_A
A_HEADS = 4
A_HEAD_DIM = D_A // A_HEADS
CHUNK = 64
SHORT_K = 3
HY_EMB = 33
HY_BANDS = (HY_EMB - 1) // 2
HY_WIDTH = 64
HY_MIN_DECAY = math.log(1e-2) / 1.5
HY_MAX_DECAY = math.log(1e-2) / 0.3
N_IN = 5 * D_A + 4 * D_B
EPS = 1e-6

kernel_name = "hymba_hgrn2_hyena_prefix_dit"

F32 = jnp.float32


def rmsnorm(x, w):
    xf = x.astype(F32)
    y = xf * lax.rsqrt(jnp.mean(xf * xf, axis=-1, keepdims=True) + EPS)
    return y.astype(x.dtype) * w


def _chunk_scan(q, k, v, g, S0):
    Bn, H, L, DK = q.shape
    DV = v.shape[-1]
    N = L // CHUNK

    def to_chunks(a):
        return jnp.moveaxis(a.reshape(Bn, H, N, CHUNK, a.shape[-1]), 2, 0)

    mask = jnp.tril(jnp.ones((CHUNK, CHUNK), dtype=bool))[:, :, None]

    def step(S, inp):
        qc, kc, vc, gc = inp
        bcum = jnp.cumsum(gc, axis=2)
        o_inter = jnp.einsum('bhck,bhkv->bhcv', qc * jnp.exp(bcum), S)
        diff = bcum[:, :, :, None, :] - bcum[:, :, None, :, :]
        decay = jnp.exp(jnp.where(mask, diff, -jnp.inf))
        scores = jnp.einsum('bhik,bhijk,bhjk->bhij', qc, decay, kc)
        o = o_inter + jnp.einsum('bhij,bhjv->bhiv', scores, vc)
        b_last = bcum[:, :, -1:, :]
        S_new = jnp.exp(b_last[:, :, 0, :])[..., None] * S + jnp.einsum(
            'bhck,bhcv->bhkv', kc * jnp.exp(b_last - bcum), vc)
        return S_new, o

    S_fin, o = lax.scan(step, S0, (to_chunks(q), to_chunks(k), to_chunks(v), to_chunks(g)))
    o = jnp.moveaxis(o, 0, 2).reshape(Bn, H, L, DV)
    return o, S_fin


def hgrn2_mixer(q_raw, ff_raw, fb_raw, i_raw, lb, S0_f, S0_b):
    Bn, L, _ = q_raw.shape

    def heads(a):
        return a.astype(F32).reshape(Bn, L, A_HEADS, A_HEAD_DIM).transpose(0, 2, 1, 3)

    q = jax.nn.silu(heads(q_raw))
    v = heads(i_raw)

    def gates(f_raw, lb_dir):
        f = heads(f_raw)
        lbh = lb_dir.reshape(A_HEADS, 1, A_HEAD_DIM)
        g = jnp.logaddexp(jnp.log(lbh), jnp.log1p(-lbh) + jax.nn.log_sigmoid(f))
        k = (1.0 - lbh) * jax.nn.sigmoid(-f)
        return k, g

    k_f, g_f = gates(ff_raw, lb[0])
    k_b, g_b = gates(fb_raw, lb[1])
    o_f, S_f = _chunk_scan(q, k_f, v, g_f, S0_f)

    def flip(a):
        return jnp.flip(a, axis=2)

    o_b, S_b = _chunk_scan(flip(q), flip(k_b), flip(v), flip(g_b), S0_b)
    return o_f + flip(o_b), S_f, S_b


def head_rmsnorm(o, w):
    Bn, H, L, DV = o.shape
    o = o * lax.rsqrt(jnp.mean(o * o, axis=-1, keepdims=True) + EPS)
    return o.transpose(0, 2, 1, 3).reshape(Bn, L, H * DV) * w.astype(F32)


def pos_features(L):
    t = jnp.linspace(0.0, 1.0, L, dtype=F32)[:, None]
    w = 2.0 * math.pi * jnp.arange(L, dtype=F32)[:, None] / L
    f = jnp.linspace(1e-4, HY_BANDS - 1, HY_BANDS, dtype=F32)[None, :]
    return jnp.concatenate([t, jnp.cos(f * w), -jnp.sin(f * w)], axis=-1)


def hyena_filter(L, w1, b1, freq, w2, b2, w3, b3, w4):
    z = pos_features(L)
    fr = freq.astype(F32)
    h = jnp.sin(fr * (z @ w1.astype(F32) + b1.astype(F32)))
    h = jnp.sin(fr * (h @ w2.astype(F32) + b2.astype(F32)))
    h = jnp.sin(fr * (h @ w3.astype(F32) + b3.astype(F32)))
    h = h @ w4.astype(F32)
    deltas = jnp.abs(jnp.linspace(HY_MIN_DECAY, HY_MAX_DECAY, D_B, dtype=F32))
    decay = jnp.exp(-z[:, :1] * deltas)
    h_f = h[:, :D_B] * decay
    h_b = h[:, D_B:] * decay
    k = jnp.concatenate([h_f, jnp.zeros((1, D_B), F32), jnp.flip(h_b[1:], axis=0)], axis=0)
    return k / jnp.sum(jnp.abs(k), axis=0, keepdims=True)


def long_conv(v, k):
    L = v.shape[1]
    vf = jnp.fft.rfft(v.astype(F32), n=2 * L, axis=1)
    kf = jnp.fft.rfft(k, n=2 * L, axis=0)
    return jnp.fft.irfft(vf * kf[None], n=2 * L, axis=1)[:, :L].astype(v.dtype)


def short_conv(u, w, b):
    L = u.shape[1]
    pad = SHORT_K // 2
    up = jnp.pad(u, ((0, 0), (pad, SHORT_K - 1 - pad), (0, 0)))
    out = b
    for j in range(SHORT_K):
        out = out + up[:, j:j + L] * w[j]
    return out


def hyena_mixer(u, conv_w, conv_b, filt, hy_bias):
    uc = short_conv(u, conv_w, conv_b)
    x0, x1, v = jnp.split(uc, 3, axis=-1)
    v = v * x1
    y = long_conv(v, filt) + v * hy_bias
    return y * x0


def mixer_outputs(p, lb, g_norm_w, conv_w, conv_b, filt, hy_bias, S0_f, S0_b):
    q, ff, fb, iv, gA = [p[..., j * D_A:(j + 1) * D_A] for j in range(5)]
    uB = p[..., 5 * D_A:5 * D_A + 3 * D_B]
    gB = p[..., 5 * D_A + 3 * D_B:]
    oA, S_f, S_b = hgrn2_mixer(q, ff, fb, iv, lb, S0_f, S0_b)
    oA = head_rmsnorm(oA, g_norm_w).astype(p.dtype) * jax.nn.silu(gA)
    oB = hyena_mixer(uB, conv_w, conv_b, filt, hy_bias) * jax.nn.silu(gB)
    return jnp.concatenate([oA, oB], axis=-1), S_f, S_b


def setup_inputs(seed: int = 0) -> dict:
    key = jax.random.key(seed)
    ks = jax.random.split(key, 24)
    nrm = jax.random.normal
    D = D_MODEL
    return {
        "x": nrm(ks[0], (BATCH, SEQ, D), F32),
        "c": nrm(ks[1], (BATCH, D), F32),
        "ctx": nrm(ks[2], (BATCH, CTX_LEN, D), F32),
        "c_ctx": nrm(ks[3], (D,), F32),
        "norm_w": 1.0 + 0.05 * nrm(ks[4], (DEPTH, D), F32),
        "w_ada": 0.5 * D ** -0.5 * nrm(ks[5], (DEPTH, D, 3 * D), F32),
        "b_ada": 0.02 * nrm(ks[6], (DEPTH, 3 * D), F32),
        "w_in": D ** -0.5 * nrm(ks[7], (DEPTH, D, N_IN), F32),
        "w_out": D_MIX ** -0.5 * nrm(ks[8], (DEPTH, D_MIX, D), F32),
        "lb_logits": 0.5 * nrm(ks[9], (DEPTH, 2, D_A), F32),
        "g_norm_w": 1.0 + 0.05 * nrm(ks[10], (DEPTH, D_A), F32),
        "conv_w": 0.5 * nrm(ks[11], (DEPTH, SHORT_K, 3 * D_B), F32),
        "conv_b": 0.02 * nrm(ks[12], (DEPTH, 3 * D_B), F32),
        "hy_w1": HY_EMB ** -0.5 * nrm(ks[13], (DEPTH, HY_EMB, HY_WIDTH), F32),
        "hy_b1": 0.1 * nrm(ks[14], (DEPTH, HY_WIDTH), F32),
        "hy_freq": 1.0 + 0.05 * nrm(ks[15], (DEPTH, HY_WIDTH), F32),
        "hy_w2": HY_WIDTH ** -0.5 * nrm(ks[16], (DEPTH, HY_WIDTH, HY_WIDTH), F32),
        "hy_b2": 0.1 * nrm(ks[17], (DEPTH, HY_WIDTH), F32),
        "hy_w3": HY_WIDTH ** -0.5 * nrm(ks[18], (DEPTH, HY_WIDTH, HY_WIDTH), F32),
        "hy_b3": 0.1 * nrm(ks[19], (DEPTH, HY_WIDTH), F32),
        "hy_w4": HY_WIDTH ** -0.5 * nrm(ks[20], (DEPTH, HY_WIDTH, 2 * D_B), F32),
        "hy_bias": nrm(ks[21], (DEPTH, D_B), F32),
        "final_norm_w": 1.0 + 0.05 * nrm(ks[22], (D,), F32),
    }


def reference(x, c, ctx, c_ctx, norm_w, w_ada, b_ada, w_in, w_out, lb_logits, g_norm_w,
              conv_w, conv_b, hy_w1, hy_b1, hy_freq, hy_w2, hy_b2, hy_w3, hy_b3, hy_w4,
              hy_bias, final_norm_w):
    Bn, L_lat, _ = x.shape
    L_ctx = ctx.shape[1]
    p_lb = jax.nn.softmax(lb_logits.astype(F32), axis=0)
    lbs = jnp.cumsum(p_lb, axis=0)
    lbs = lbs - lbs[0:1]
    zero_state = jnp.zeros((Bn, A_HEADS, A_HEAD_DIM, A_HEAD_DIM), F32)

    for l in range(DEPTH):
        last = l == DEPTH - 1
        filt_args = (hy_w1[l], hy_b1[l], hy_freq[l], hy_w2[l], hy_b2[l], hy_w3[l], hy_b3[l], hy_w4[l])
        mod_x = jax.nn.silu(c) @ w_ada[l] + b_ada[l]
        sh_x, sc_x, gt_x = jnp.split(mod_x[:, None, :], 3, axis=-1)
        mod_c = jax.nn.silu(c_ctx) @ w_ada[l] + b_ada[l]
        sh_c, sc_c, gt_c = jnp.split(mod_c, 3, axis=-1)

        hc = rmsnorm(ctx, norm_w[l]) * (1.0 + sc_c) + sh_c
        if last:
            pA = hc @ w_in[l, :, :4 * D_A]
            q, ff, fb, iv = [pA[..., j * D_A:(j + 1) * D_A] for j in range(4)]
            _, S_f, S_b = hgrn2_mixer(q, ff, fb, iv, lbs[l], zero_state, zero_state)
        else:
            pc = hc @ w_in[l]
            filt_c = hyena_filter(L_ctx, *filt_args)
            oc, S_f, S_b = mixer_outputs(pc, lbs[l], g_norm_w[l], conv_w[l], conv_b[l],
                                         filt_c, hy_bias[l], zero_state, zero_state)
            ctx = ctx + gt_c * (oc @ w_out[l])

        hx = rmsnorm(x, norm_w[l]) * (1.0 + sc_x) + sh_x
        px = hx @ w_in[l]
        filt_x = hyena_filter(L_lat, *filt_args)
        ox, _, _ = mixer_outputs(px, lbs[l], g_norm_w[l], conv_w[l], conv_b[l],
                                 filt_x, hy_bias[l], S_f, S_b)
        x = x + gt_x * (ox @ w_out[l])

    return rmsnorm(x, final_norm_w)
```

```cpp
#include <hip/hip_runtime.h>
#include <math.h>
#include <stdint.h>

namespace {
constexpr int D = 1024, NB = 8, LX = 4096, LCX = 256, NIN = 4608, DA = 512, DB = 512, HD = 128;
constexpr float EPS = 1e-6f;
constexpr float HY_MIN_DECAY = -3.0701134573253944f;
constexpr float HY_MAX_DECAY = -15.350567286626972f;

__device__ __forceinline__ float silu_f(float x) { return x / (1.0f + expf(-x)); }
__device__ __forceinline__ float sigmoid_f(float x) { return 1.0f / (1.0f + expf(-x)); }

__global__ void k_lbs(const float* __restrict__ lb_logits, float* __restrict__ lbs) {
    int i = blockIdx.x * blockDim.x + threadIdx.x;
    if (i >= 1024) return;
    float a0 = lb_logits[i], a1 = lb_logits[1024 + i];
    float m = fmaxf(a0, a1);
    float e0 = expf(a0 - m), e1 = expf(a1 - m);
    float p0 = e0 / (e0 + e1), p1 = e1 / (e0 + e1);
    float c0 = p0, c1 = p0 + p1;
    lbs[i] = c0 - c0;
    lbs[1024 + i] = c1 - c0;
}

__global__ void k_mod(const float* __restrict__ c, const float* __restrict__ c_ctx, const float* __restrict__ w_ada,
                      const float* __restrict__ b_ada, float* __restrict__ mod) {
    __shared__ float sv[D];
    const int l = blockIdx.z, r = blockIdx.y, n = blockIdx.x * 256 + threadIdx.x;
    const float* cv = r < 8 ? c + r * D : c_ctx;
    for (int k = threadIdx.x; k < D; k += 256) sv[k] = silu_f(cv[k]);
    __syncthreads();
    const float* w = w_ada + (size_t)l * D * 3 * D + n;
    float s = 0.f;
    for (int k = 0; k < D; ++k) s += sv[k] * w[(size_t)k * 3 * D];
    mod[((size_t)l * 9 + r) * 3 * D + n] = s + b_ada[l * 3 * D + n];
}

__global__ void k_filt_mlp(int L, const float* __restrict__ w1, const float* __restrict__ b1, const float* __restrict__ fr,
                           const float* __restrict__ w2, const float* __restrict__ b2, const float* __restrict__ w3,
                           const float* __restrict__ b3, float* __restrict__ h3) {
    __shared__ float z[33];
    __shared__ float ha[64];
    __shared__ float hb[64];
    const int n = blockIdx.x, j = threadIdx.x;
    if (j == 0) z[0] = (float)n / (float)(L - 1);
    if (j >= 1 && j < 33) {
        const int i = (j - 1) & 15;
        const double f = 1e-4 + (double)i * ((15.0 - 1e-4) / 15.0);
        double rev = f * (double)n / (double)L;
        rev -= floor(rev);
        const float ang = (float)(rev * 6.283185307179586476925);
        z[j] = (j <= 16) ? cosf(ang) : -sinf(ang);
    }
    __syncthreads();
    float s = b1[j];
    for (int e = 0; e < 33; ++e) s += z[e] * w1[e * 64 + j];
    const float f = fr[j];
    ha[j] = sinf(f * s);
    __syncthreads();
    s = b2[j];
    for (int e = 0; e < 64; ++e) s += ha[e] * w2[e * 64 + j];
    hb[j] = sinf(f * s);
    __syncthreads();
    s = b3[j];
    for (int e = 0; e < 64; ++e) s += hb[e] * w3[e * 64 + j];
    h3[n * 64 + j] = sinf(f * s);
}
__global__ void k_filt_out(int L, const float* __restrict__ h3, const float* __restrict__ w4, float* __restrict__ hk) {
    const int n = blockIdx.x, c2 = blockIdx.y * 256 + threadIdx.x;
    float s = 0.f;
    for (int j = 0; j < 64; ++j) s += h3[n * 64 + j] * w4[j * 1024 + c2];
    const int c = c2 & 511;
    const float delta = fabsf(HY_MIN_DECAY + (float)c * ((HY_MAX_DECAY - HY_MIN_DECAY) / 511.0f));
    const float t = (float)n / (float)(L - 1);
    hk[(size_t)n * 1024 + c2] = s * expf(-t * delta);
}
__global__ void k_filt_norm(int L, const float* __restrict__ hk, float* __restrict__ inv_norm) {
    __shared__ float red[256];
    const int c = blockIdx.x;
    float s = 0.f;
    for (int n = threadIdx.x; n < L; n += 256) {
        s += fabsf(hk[(size_t)n * 1024 + c]);
        if (n >= 1) s += fabsf(hk[(size_t)n * 1024 + 512 + c]);
    }
    red[threadIdx.x] = s;
    __syncthreads();
    for (int o = 128; o > 0; o >>= 1) { if (threadIdx.x < o) red[threadIdx.x] += red[threadIdx.x + o]; __syncthreads(); }
    if (threadIdx.x == 0) inv_norm[c] = 1.0f / red[0];
}

__global__ void k_rowstat(const float* __restrict__ x, float* __restrict__ rstd) {
    __shared__ float red[256];
    const size_t row = blockIdx.x;
    float s = 0.f;
    for (int k = threadIdx.x; k < D; k += 256) { float v = x[row * D + k]; s += v * v; }
    red[threadIdx.x] = s;
    __syncthreads();
    for (int o = 128; o > 0; o >>= 1) { if (threadIdx.x < o) red[threadIdx.x] += red[threadIdx.x + o]; __syncthreads(); }
    if (threadIdx.x == 0) rstd[row] = 1.0f / sqrtf(red[0] * (1.0f / D) + EPS);
}

struct GemmArgs {
    const float* x; const float* rstd; const float* nw; const float* mod;
    const float* o; const float* hr; const float* gnw; const float* p; const float* oB; const float* xin;
    const float* W; float* C;
    int M, N, ldw, ldc, rows_per_mod, mod_base;
};
template <int MODE>
__global__ void __launch_bounds__(256) k_gemm(GemmArgs g) {
    __shared__ float As[8][128 + 4];
    __shared__ float Bs[8][128 + 4];
    const int tid = threadIdx.x, tx = tid & 15, ty = tid >> 4;
    const int m0 = blockIdx.y * 128, n0 = blockIdx.x * 128;
    float acc[8][8];
#pragma unroll
    for (int i = 0; i < 8; ++i)
#pragma unroll
        for (int j = 0; j < 8; ++j) acc[i][j] = 0.f;
    const int ar = tid >> 1, ak = (tid & 1) * 4;
    const int arow = m0 + ar;
    const int mrow = g.mod_base + arow / g.rows_per_mod;
    const float* sh = g.mod + (size_t)mrow * 3 * D;
    const float* sc = sh + D;
    float rs = 0.f, hr4[4] = {0.f, 0.f, 0.f, 0.f};
    if (MODE == 0) rs = g.rstd[arow];
    else { for (int h = 0; h < 4; ++h) hr4[h] = g.hr[(size_t)arow * 4 + h]; }
    const int bk = tid >> 5, bn = (tid & 31) * 4;
    for (int k0 = 0; k0 < D; k0 += 8) {
        float av[4];
#pragma unroll
        for (int j = 0; j < 4; ++j) {
            const int k = k0 + ak + j;
            if (MODE == 0) av[j] = g.x[(size_t)arow * D + k] * rs * g.nw[k] * (1.0f + sc[k]) + sh[k];
            else {
                if (k < DA) av[j] = g.o[(size_t)arow * DA + k] * hr4[k >> 7] * g.gnw[k] * silu_f(g.p[(size_t)arow * NIN + 2048 + k]);
                else av[j] = g.oB[(size_t)arow * DB + (k - DA)];
            }
        }
        const float4 bv = *(const float4*)(g.W + (size_t)(k0 + bk) * g.ldw + n0 + bn);
        __syncthreads();
#pragma unroll
        for (int j = 0; j < 4; ++j) As[ak + j][ar] = av[j];
        Bs[bk][bn + 0] = bv.x; Bs[bk][bn + 1] = bv.y; Bs[bk][bn + 2] = bv.z; Bs[bk][bn + 3] = bv.w;
        __syncthreads();
#pragma unroll
        for (int kk = 0; kk < 8; ++kk) {
            float a[8], b[8];
#pragma unroll
            for (int i = 0; i < 8; ++i) a[i] = As[kk][ty * 8 + i];
#pragma unroll
            for (int j = 0; j < 8; ++j) b[j] = Bs[kk][tx * 8 + j];
#pragma unroll
            for (int i = 0; i < 8; ++i)
#pragma unroll
                for (int j = 0; j < 8; ++j) acc[i][j] += a[i] * b[j];
        }
    }
#pragma unroll
    for (int i = 0; i < 8; ++i) {
        const int row = m0 + ty * 8 + i;
        const int mr = g.mod_base + row / g.rows_per_mod;
        const float* gt = g.mod + (size_t)mr * 3 * D + 2 * D;
#pragma unroll
        for (int j = 0; j < 8; ++j) {
            const int n = n0 + tx * 8 + j;
            if (MODE == 0) g.C[(size_t)row * g.ldc + n] = acc[i][j];
            else g.C[(size_t)row * g.ldc + n] = g.xin[(size_t)row * g.ldc + n] + gt[n] * acc[i][j];
        }
    }
}

__global__ void __launch_bounds__(256) k_hgrn2(const float* __restrict__ p, int L, const float* __restrict__ lbs_l  ,
                                               const float* __restrict__ S_in, float* __restrict__ S_out, int b_glob0,
                                               float* __restrict__ o) {
    __shared__ float qs[16][128], fgs[16][128], kks[16][128], vs[16][128];
    __shared__ float red[16][256];
    const int tid = threadIdx.x, v = tid & 127, kh = tid >> 7;
    const int dir = blockIdx.x & 1, h = (blockIdx.x >> 1) & 3, bl = blockIdx.x >> 3;
    const size_t sidx = ((size_t)((b_glob0 + bl) * 4 + h) * 2 + dir) * HD * HD;
    float S[64];
#pragma unroll
    for (int kk = 0; kk < 64; ++kk) S[kk] = S_in ? S_in[sidx + (size_t)(kh * 64 + kk) * HD + v] : 0.f;
    for (int c = 0; c < L / 16; ++c) {
        for (int e = tid; e < 16 * 128; e += 256) {
            const int j = e >> 7, d = e & 127;
            const int t = dir == 0 ? (16 * c + j) : (L - 1 - (16 * c + j));
            const float* pr = p + (size_t)(bl * L + t) * NIN + h * HD + d;
            const float qr = pr[0], fr = pr[(dir == 0) ? 512 : 1024], ir = pr[1536];
            const float lb = lbs_l[dir * 512 + h * HD + d];
            const float fg = lb + (1.0f - lb) * sigmoid_f(fr);
            qs[j][d] = silu_f(qr); fgs[j][d] = fg; kks[j][d] = (1.0f - lb) * sigmoid_f(-fr); vs[j][d] = ir;
        }
        __syncthreads();
        float op[16];
#pragma unroll
        for (int j = 0; j < 16; ++j) {
            const float vv = vs[j][v];
            float oo = 0.f;
#pragma unroll
            for (int kk = 0; kk < 64; ++kk) {
                const int k = kh * 64 + kk;
                S[kk] = fgs[j][k] * S[kk] + kks[j][k] * vv;
                oo += S[kk] * qs[j][k];
            }
            op[j] = oo;
        }
#pragma unroll
        for (int j = 0; j < 16; ++j) red[j][tid] = op[j];
        __syncthreads();
        for (int e = tid; e < 16 * 128; e += 256) {
            const int j = e >> 7, d = e & 127;
            const int t = dir == 0 ? (16 * c + j) : (L - 1 - (16 * c + j));
            atomicAdd(&o[(size_t)(bl * L + t) * DA + h * HD + d], red[j][d] + red[j][128 + d]);
        }
        __syncthreads();
    }
    if (S_out) {
#pragma unroll
        for (int kk = 0; kk < 64; ++kk) S_out[sidx + (size_t)(kh * 64 + kk) * HD + v] = S[kk];
    }
}

__global__ void k_headstat(const float* __restrict__ o, float* __restrict__ hr, int nrows) {
    const int w = (blockIdx.x * blockDim.x + threadIdx.x) >> 6, lane = threadIdx.x & 63;
    if (w >= nrows * 4) return;
    const float a = o[(size_t)w * HD + lane], b = o[(size_t)w * HD + 64 + lane];
    float s = a * a + b * b;
    for (int off = 32; off > 0; off >>= 1) s += __shfl_xor(s, off);
    if (lane == 0) hr[w] = 1.0f / sqrtf(s * (1.0f / HD) + EPS);
}

__device__ __forceinline__ float sconv(const float* __restrict__ p, int b, int t, int L, int col  , const float* __restrict__ cw,
                                       const float* __restrict__ cb) {
    const float* base = p + (size_t)b * L * NIN + 2560 + col;
    float s = cb[col] + cw[1536 + col] * base[(size_t)t * NIN];
    if (t > 0) s += cw[col] * base[(size_t)(t - 1) * NIN];
    if (t < L - 1) s += cw[2 * 1536 + col] * base[(size_t)(t + 1) * NIN];
    return s;
}
__global__ void __launch_bounds__(256) k_hyena(const float* __restrict__ p, int L, const float* __restrict__ hk, const float* __restrict__ inv_norm,
                                               const float* __restrict__ cw, const float* __restrict__ cb, const float* __restrict__ hy_bias,
                                               float* __restrict__ oB) {
    __shared__ float vvs[64][64];
    __shared__ float kw[191][64];
    const int tid = threadIdx.x, cl = tid & 63, tg = tid >> 6;
    const int t0 = blockIdx.x * 128, c0 = blockIdx.y * 64, b = blockIdx.z;
    float acc[32];
#pragma unroll
    for (int i = 0; i < 32; ++i) acc[i] = 0.f;
    for (int s0 = 0; s0 < L; s0 += 64) {
        __syncthreads();
        for (int e = tid; e < 64 * 64; e += 256) {
            const int s = e >> 6, c = e & 63;
            vvs[s][c] = sconv(p, b, s0 + s, L, 1024 + c0 + c, cw, cb) * sconv(p, b, s0 + s, L, 512 + c0 + c, cw, cb);
        }
        for (int e = tid; e < 191 * 64; e += 256) {
            const int r = e >> 6, c = e & 63;
            const int lag = t0 - s0 - 63 + r;
            float kv = 0.f;
            if (lag >= 0 && lag < L) kv = hk[(size_t)lag * 1024 + c0 + c];
            else if (lag < 0 && -lag < L) kv = hk[(size_t)(-lag) * 1024 + 512 + c0 + c];
            kw[r][c] = kv;
        }
        __syncthreads();
        for (int s = 0; s < 64; ++s) {
            const float v = vvs[s][cl];
#pragma unroll
            for (int i = 0; i < 32; ++i) acc[i] += kw[tg * 32 + i - s + 63][cl] * v;
        }
    }
    const int c = c0 + cl;
    const float inn = inv_norm[c], hb = hy_bias[c];
    for (int i = 0; i < 32; ++i) {
        const int t = t0 + tg * 32 + i;
        const float vv = sconv(p, b, t, L, 1024 + c, cw, cb) * sconv(p, b, t, L, 512 + c, cw, cb);
        const float y = acc[i] * inn + vv * hb;
        const float x0 = sconv(p, b, t, L, c, cw, cb);
        const float gB = p[(size_t)(b * L + t) * NIN + 4096 + c];
        oB[(size_t)(b * L + t) * DB + c] = y * x0 * silu_f(gB);
    }
}

__global__ void k_final_norm(float* __restrict__ x, const float* __restrict__ w) {
    __shared__ float red[256];
    const size_t row = blockIdx.x;
    float v[4]; float s = 0.f;
#pragma unroll
    for (int j = 0; j < 4; ++j) { v[j] = x[row * D + threadIdx.x + 256 * j]; s += v[j] * v[j]; }
    red[threadIdx.x] = s;
    __syncthreads();
    for (int o = 128; o > 0; o >>= 1) { if (threadIdx.x < o) red[threadIdx.x] += red[threadIdx.x + o]; __syncthreads(); }
    const float r = 1.0f / sqrtf(red[0] * (1.0f / D) + EPS);
#pragma unroll
    for (int j = 0; j < 4; ++j) x[row * D + threadIdx.x + 256 * j] = v[j] * r * w[threadIdx.x + 256 * j];
}
}

extern "C" void kernel_launch(void* const* d_in, const int* in_sizes, int n_in, void* d_out, int out_size, void* d_ws, size_t ws_size,
                              hipStream_t stream) {
    const float* x = (const float*)d_in[0];
    const float* c = (const float*)d_in[1];
    const float* ctx = (const float*)d_in[2];
    const float* c_ctx = (const float*)d_in[3];
    const float* norm_w = (const float*)d_in[4];
    const float* w_ada = (const float*)d_in[5];
    const float* b_ada = (const float*)d_in[6];
    const float* w_in = (const float*)d_in[7];
    const float* w_out = (const float*)d_in[8];
    const float* lb_logits = (const float*)d_in[9];
    const float* g_norm_w = (const float*)d_in[10];
    const float* conv_w = (const float*)d_in[11];
    const float* conv_b = (const float*)d_in[12];
    const float* hy_w1 = (const float*)d_in[13];
    const float* hy_b1 = (const float*)d_in[14];
    const float* hy_freq = (const float*)d_in[15];
    const float* hy_w2 = (const float*)d_in[16];
    const float* hy_b2 = (const float*)d_in[17];
    const float* hy_w3 = (const float*)d_in[18];
    const float* hy_b3 = (const float*)d_in[19];
    const float* hy_w4 = (const float*)d_in[20];
    const float* hy_bias = (const float*)d_in[21];
    const float* final_norm_w = (const float*)d_in[22];
    float* out = (float*)d_out;

    float* ws = (float*)d_ws;
    size_t off = 0;
    auto carve = [&](size_t n) { float* p = ws + off; off += (n + 63) & ~(size_t)63; return p; };
    float* mod = carve(2 * 9 * 3 * D);
    float* lbs = carve(2 * 2 * 512);
    float* h3 = carve(4096 * 64);
    float* hk4096 = carve((size_t)2 * 4096 * 1024);
    float* hk256 = carve(256 * 1024);
    float* inorm4096 = carve(2 * 512);
    float* inorm256 = carve(512);
    float* rstd_x = carve(NB * LX);
    float* rstd_c = carve(NB * LCX);
    float* ctx_work = carve((size_t)NB * LCX * D);
    float* p_c = carve((size_t)NB * LCX * NIN);
    float* o_c = carve((size_t)NB * LCX * DA);
    float* oB_c = carve((size_t)NB * LCX * DB);
    float* hr_c = carve(NB * LCX * 4);
    float* S_ctx = carve((size_t)NB * 4 * 2 * HD * HD);
    float* p_h = carve((size_t)4 * LX * NIN);
    float* o_h = carve((size_t)4 * LX * DA);
    float* oB_h = carve((size_t)4 * LX * DB);
    float* hr_h = carve((size_t)4 * LX * 4);
    if (off * 4 > ws_size) return;

    k_lbs<<<4, 256, 0, stream>>>(lb_logits, lbs);
    k_mod<<<dim3(12, 9, 2), 256, 0, stream>>>(c, c_ctx, w_ada, b_ada, mod);
    for (int l = 0; l < 2; ++l) {
        k_filt_mlp<<<4096, 64, 0, stream>>>(4096, hy_w1 + l * 33 * 64, hy_b1 + l * 64, hy_freq + l * 64, hy_w2 + l * 4096, hy_b2 + l * 64,
                                            hy_w3 + l * 4096, hy_b3 + l * 64, h3);
        k_filt_out<<<dim3(4096, 4), 256, 0, stream>>>(4096, h3, hy_w4 + (size_t)l * 64 * 1024, hk4096 + (size_t)l * 4096 * 1024);
        k_filt_norm<<<512, 256, 0, stream>>>(4096, hk4096 + (size_t)l * 4096 * 1024, inorm4096 + l * 512);
    }
    k_filt_mlp<<<256, 64, 0, stream>>>(256, hy_w1, hy_b1, hy_freq, hy_w2, hy_b2, hy_w3, hy_b3, h3);
    k_filt_out<<<dim3(256, 4), 256, 0, stream>>>(256, h3, hy_w4, hk256);
    k_filt_norm<<<512, 256, 0, stream>>>(256, hk256, inorm256);

    for (int l = 0; l < 2; ++l) {
        const float* modl = mod + (size_t)l * 9 * 3 * D;
        const float* lbsl = lbs + l * 1024;
        const float* cwl = conv_w + (size_t)l * 3 * 1536;
        const float* cbl = conv_b + (size_t)l * 1536;
        const float* ctx_cur = (l == 0) ? ctx : ctx_work;
        k_rowstat<<<NB * LCX, 256, 0, stream>>>(ctx_cur, rstd_c);
        {
            GemmArgs g{};
            g.x = ctx_cur; g.rstd = rstd_c; g.nw = norm_w + l * D; g.mod = modl; g.W = w_in + (size_t)l * D * NIN; g.C = p_c;
            g.M = NB * LCX; g.N = NIN; g.ldw = NIN; g.ldc = NIN; g.rows_per_mod = 1 << 30; g.mod_base = 8;
            k_gemm<0><<<dim3(NIN / 128, NB * LCX / 128), 256, 0, stream>>>(g);
        }
        hipMemsetAsync(o_c, 0, (size_t)NB * LCX * DA * 4, stream);
        k_hgrn2<<<NB * 8, 256, 0, stream>>>(p_c, LCX, lbsl, nullptr, S_ctx, 0, o_c);
        if (l == 0) {
            k_headstat<<<NB * LCX * 4 / 4, 256, 0, stream>>>(o_c, hr_c, NB * LCX);
            k_hyena<<<dim3(LCX / 128, 8, NB), 256, 0, stream>>>(p_c, LCX, hk256, inorm256, cwl, cbl, hy_bias + l * 512, oB_c);
            GemmArgs g{};
            g.o = o_c; g.hr = hr_c; g.gnw = g_norm_w + l * 512; g.p = p_c; g.oB = oB_c; g.xin = ctx_cur; g.mod = modl;
            g.W = w_out + (size_t)l * D * D; g.C = ctx_work; g.M = NB * LCX; g.N = D; g.ldw = D; g.ldc = D; g.rows_per_mod = 1 << 30; g.mod_base = 8;
            k_gemm<1><<<dim3(D / 128, NB * LCX / 128), 256, 0, stream>>>(g);
        }
        const float* x_cur = (l == 0) ? x : out;
        k_rowstat<<<NB * LX, 256, 0, stream>>>(x_cur, rstd_x);
        for (int hf = 0; hf < 2; ++hf) {
            const size_t r0 = (size_t)hf * 4 * LX;
            {
                GemmArgs g{};
                g.x = x_cur + r0 * D; g.rstd = rstd_x + r0; g.nw = norm_w + l * D; g.mod = modl; g.W = w_in + (size_t)l * D * NIN; g.C = p_h;
                g.M = 4 * LX; g.N = NIN; g.ldw = NIN; g.ldc = NIN; g.rows_per_mod = LX; g.mod_base = 4 * hf;
                k_gemm<0><<<dim3(NIN / 128, 4 * LX / 128), 256, 0, stream>>>(g);
            }
            hipMemsetAsync(o_h, 0, (size_t)4 * LX * DA * 4, stream);
            k_hgrn2<<<4 * 8, 256, 0, stream>>>(p_h, LX, lbsl, S_ctx, nullptr, 4 * hf, o_h);
            k_headstat<<<4 * LX * 4 / 4, 256, 0, stream>>>(o_h, hr_h, 4 * LX);
            k_hyena<<<dim3(LX / 128, 8, 4), 256, 0, stream>>>(p_h, LX, hk4096 + (size_t)l * 4096 * 1024, inorm4096 + l * 512, cwl, cbl,
                                                              hy_bias + l * 512, oB_h);
            GemmArgs g{};
            g.o = o_h; g.hr = hr_h; g.gnw = g_norm_w + l * 512; g.p = p_h; g.oB = oB_h; g.xin = x_cur + r0 * D; g.mod = modl;
            g.W = w_out + (size_t)l * D * D; g.C = out + r0 * D; g.M = 4 * LX; g.N = D; g.ldw = D; g.ldc = D; g.rows_per_mod = LX; g.mod_base = 4 * hf;
            k_gemm<1><<<dim3(D / 128, 4 * LX / 128), 256, 0, stream>>>(g);
        }
    }
    k_final_norm<<<NB * LX, 256, 0, stream>>>(out, final_norm_w);
}
```

```cpp
#include <hip/hip_runtime.h>
#include <cstdio>
#include <cstdint>
#include <math.h>

namespace pg8 {
#define PG8_LAS __attribute__((address_space(3)))
typedef unsigned short bf16_t;
typedef short bf16x8 __attribute__((ext_vector_type(8)));
typedef float f32x4 __attribute__((ext_vector_type(4)));
typedef unsigned u32x4 __attribute__((ext_vector_type(4)));
typedef unsigned u32x2 __attribute__((ext_vector_type(2)));
constexpr int BM = 256, BK = 64, HALF = 128, HTB = HALF * BK * 2, STAGE_BYTES = 8 * HTB, NXCD = 8, WGM = 8;

__host__ __device__ __forceinline__ int lds_byte(int r, int c) { const int st = (r >> 4) * 2 + (c >> 5), rr = r & 15, cc = c & 31, ob = rr * 64 + cc * 2; return st * 1024 + (ob ^ (((ob >> 9) & 1) << 5)); }
__host__ __device__ __forceinline__ void stage_rc(int b, int& R, int& C) { const int st = b / 1024, sb = b % 1024, swz = sb ^ (((sb >> 9) & 1) << 5); R = (st >> 1) * 16 + swz / 64; C = (st & 1) * 32 + (swz % 64) / 2; }
__host__ __device__ __forceinline__ int perm32(int rho) { const int n = rho >> 4, i = rho & 15; return 8 * (i >> 2) + 4 * n + (i & 3); }

struct Unit { int pm, pn; };
struct Gemm { const bf16_t* A; const bf16_t* Bt; int K; };

struct Sched {
    int nM, nN, nwg, G, c, nctx, nctxN;
    __device__ void init(int nM_, int nN_, int G_, int c_, int nctxM, int nctxN_) { nM = nM_; nN = nN_; nwg = nM * nN; G = G_; c = c_; nctx = nctxM * nctxN_; nctxN = nctxN_ > 0 ? nctxN_ : 1; }
    __device__ bool next(int i, Unit& u) const {
        const long L = (long)i * G + c;
        if (L >= nwg) { const long L2 = L - nwg; if (L2 >= nctx) return false; u.pm = nM + (int)(L2 / nctxN); u.pn = (int)(L2 % nctxN); return true; }
        int wgid = (int)L; { const int q = nwg / NXCD, r = nwg % NXCD, xcd = wgid % NXCD, off = wgid / NXCD; wgid = (xcd < r ? xcd * (q + 1) : r * (q + 1) + (xcd - r) * q) + off; }
        const int nig = WGM * nN, gid = wgid / nig, fm = gid * WGM, gsz = (nM - fm) < WGM ? (nM - fm) : WGM;
        u.pm = fm + ((wgid % nig) % gsz); u.pn = (wgid % nig) / gsz; return true;
    }
};

template <class Epi, bool ALIGN_EPI, bool SP2>
__device__ __forceinline__ void gemm_phase(PG8_LAS unsigned char* lds, const Gemm g, const Sched& S, const Epi& E) {
    const int tid = threadIdx.x, wid = __builtin_amdgcn_readfirstlane(tid >> 6), lane = tid & 63, wr = wid >> 2, wc = wid & 3, fr = lane & 15, fq = lane >> 4;
    const int K = g.K, nt = K / BK;
    unsigned voffA[2], voffB[2];
#pragma unroll
    for (int i = 0; i < 2; ++i) { int R, C; stage_rc(tid * 16 + i * 8192, R, C); const int Rb = Epi::PERM ? ((R & ~31) + perm32(R & 31)) : R;
        voffA[i] = (unsigned)(R * K + C) * 2u; voffB[i] = (unsigned)(Rb * K + C) * 2u; }
    const size_t kstep = (size_t)(BK * 2);
    const size_t hstep = (size_t)HALF * K * 2;
    const size_t tstep = 2 * hstep;
    const unsigned ldsw = (unsigned)wid * 1024u;
    const int aoff = lds_byte(wr * 64 + fr, fq * 8), boff = lds_byte(wc * 32 + fr, fq * 8);
#define PG8_SA(b, h) (((b) * 2 + (h)) * HTB)
#define PG8_SB(b, h) ((4 + (b) * 2 + (h)) * HTB)
#define PG8_STAGE(bufoff, gbase, voff) do { _Pragma("unroll") for (int _i = 0; _i < 2; ++_i) \
        __builtin_amdgcn_global_load_lds((const unsigned*)((const char*)(gbase) + (voff)[_i]), (PG8_LAS unsigned*)(lds + (bufoff) + ldsw + _i * 8192), 16, 0, 0); } while (0)
#define PG8_LDA(dst, b, h) do { _Pragma("unroll") for (int m = 0; m < 4; ++m) _Pragma("unroll") for (int k = 0; k < 2; ++k) dst[m][k] = *(const PG8_LAS bf16x8*)(lds + PG8_SA(b, h) + aoff + m * 2048 + k * 1024); } while (0)
#define PG8_LDB(dst, b, h) do { _Pragma("unroll") for (int n = 0; n < 2; ++n) _Pragma("unroll") for (int k = 0; k < 2; ++k) dst[n][k] = *(const PG8_LAS bf16x8*)(lds + PG8_SB(b, h) + boff + n * 2048 + k * 1024); } while (0)
#define PG8_MMA(ai, bj, At, Bt) do { __builtin_amdgcn_s_setprio(1); _Pragma("unroll") for (int m = 0; m < 4; ++m) _Pragma("unroll") for (int n = 0; n < 2; ++n) _Pragma("unroll") for (int k = 0; k < 2; ++k) \
        acc[ai][bj][m][n] = __builtin_amdgcn_mfma_f32_16x16x32_bf16(Bt[n][k], At[m][k], acc[ai][bj][m][n], 0, 0, 0); __builtin_amdgcn_s_setprio(0); } while (0)
#define PG8_WAIT_V(n) asm volatile("s_waitcnt vmcnt(" #n ")" ::: "memory")
#define PG8_WAIT_L(n) asm volatile("s_waitcnt lgkmcnt(" #n ")" ::: "memory")
#define PG8_BAR __builtin_amdgcn_s_barrier()
#define PG8_SCHED __builtin_amdgcn_sched_barrier(0)
    Unit cur, nxt; int ui = 0;
    if (!S.next(0, cur)) return;
    f32x4 acc[2][2][4][2];
#pragma unroll
    for (int a = 0; a < 2; ++a)
#pragma unroll
        for (int b = 0; b < 2; ++b)
#pragma unroll
            for (int m = 0; m < 4; ++m)
#pragma unroll
                for (int n = 0; n < 2; ++n) acc[a][b][m][n] = (f32x4){0.f, 0.f, 0.f, 0.f};
    bf16x8 At[4][2], B0[2][2], B1[2][2];
    const char* cA = E.swap(cur) ? (const char*)g.Bt + (size_t)cur.pn * tstep : (const char*)g.A + (size_t)cur.pm * tstep;
    const char* cB = E.swap(cur) ? (const char*)g.A + (size_t)cur.pm * tstep : (const char*)g.Bt + (size_t)cur.pn * tstep;
    if constexpr (SP2) {
        PG8_STAGE(PG8_SB(0, 0), cB, voffB); PG8_STAGE(PG8_SB(0, 1), cB + hstep, voffB); PG8_STAGE(PG8_SA(0, 0), cA, voffA); PG8_STAGE(PG8_SA(0, 1), cA + hstep, voffA);
        if (wr == 1) PG8_BAR;
        PG8_WAIT_V(2); PG8_BAR;
        PG8_STAGE(PG8_SB(1, 0), cB + kstep, voffB); PG8_STAGE(PG8_SA(1, 0), cA + kstep, voffA); PG8_STAGE(PG8_SB(1, 1), cB + hstep + kstep, voffB);
        PG8_WAIT_V(6); PG8_BAR;
    } else {
        PG8_STAGE(PG8_SB(0, 0), cB, voffB); PG8_STAGE(PG8_SA(0, 0), cA, voffA); PG8_STAGE(PG8_SB(0, 1), cB + hstep, voffB); PG8_STAGE(PG8_SA(0, 1), cA + hstep, voffA);
        if (wr == 1) PG8_BAR;
        PG8_WAIT_V(4); PG8_BAR;
        PG8_STAGE(PG8_SB(1, 0), cB + kstep, voffB); PG8_STAGE(PG8_SA(1, 0), cA + kstep, voffA); PG8_STAGE(PG8_SB(1, 1), cB + hstep + kstep, voffB);
        PG8_WAIT_V(6); PG8_BAR;
    }
    for (;;) {
        const bool has_next = S.next(ui + 1, nxt);
        const bool nsw = has_next && E.swap(nxt);
        const char* nA = has_next ? (nsw ? (const char*)g.Bt + (size_t)nxt.pn * tstep : (const char*)g.A + (size_t)nxt.pm * tstep) : cA;
        const char* nB = has_next ? (nsw ? (const char*)g.A + (size_t)nxt.pm * tstep : (const char*)g.Bt + (size_t)nxt.pn * tstep) : cB;
        for (int t = 0; t < nt; t += 2) {
            const bool last = (t == nt - 2);
            const char* a1 = cA + (size_t)(t + 1) * kstep;
            const char* a2 = last ? nA : cA + (size_t)(t + 2) * kstep; const char* b2 = last ? nB : cB + (size_t)(t + 2) * kstep;
            const char* a3 = a2 + kstep; const char* b3 = b2 + kstep;
            if constexpr (SP2) {
            PG8_LDB(B0, 0, 0); PG8_LDB(B1, 0, 1); PG8_SCHED; PG8_LDA(At, 0, 0); PG8_STAGE(PG8_SA(1, 1), a1 + hstep, voffA);
            PG8_WAIT_V(8); PG8_WAIT_L(0); PG8_BAR; PG8_MMA(0, 0, At, B0); PG8_MMA(0, 1, At, B1); PG8_BAR; PG8_SCHED;
            PG8_LDA(At, 0, 1); PG8_STAGE(PG8_SB(0, 0), b2, voffB); PG8_STAGE(PG8_SB(0, 1), b2 + hstep, voffB); PG8_STAGE(PG8_SA(0, 0), a2, voffA);
            PG8_WAIT_V(8); PG8_WAIT_L(0); PG8_BAR; PG8_MMA(1, 0, At, B0); PG8_MMA(1, 1, At, B1); PG8_BAR; PG8_SCHED;
            PG8_LDB(B0, 1, 0); PG8_LDB(B1, 1, 1); PG8_SCHED; PG8_LDA(At, 1, 0); PG8_STAGE(PG8_SA(0, 1), a2 + hstep, voffA);
            PG8_WAIT_V(8); PG8_WAIT_L(0); PG8_BAR; PG8_MMA(0, 0, At, B0); PG8_MMA(0, 1, At, B1); PG8_BAR; PG8_SCHED;
            PG8_LDA(At, 1, 1); PG8_STAGE(PG8_SB(1, 0), b3, voffB); PG8_STAGE(PG8_SB(1, 1), b3 + hstep, voffB); PG8_STAGE(PG8_SA(1, 0), a3, voffA);
            PG8_WAIT_V(8); PG8_WAIT_L(0); PG8_BAR; PG8_MMA(1, 0, At, B0); PG8_MMA(1, 1, At, B1); PG8_BAR; PG8_SCHED;
            } else {
            PG8_LDB(B0, 0, 0); PG8_SCHED; PG8_LDA(At, 0, 0); PG8_STAGE(PG8_SA(1, 1), a1 + hstep, voffA);
            PG8_WAIT_L(8); PG8_BAR; PG8_WAIT_L(0); PG8_MMA(0, 0, At, B0); PG8_BAR; PG8_SCHED;
            PG8_LDB(B1, 0, 1); PG8_STAGE(PG8_SB(0, 0), b2, voffB);
            PG8_BAR; PG8_WAIT_L(0); PG8_MMA(0, 1, At, B1); PG8_BAR;
            PG8_LDA(At, 0, 1); PG8_STAGE(PG8_SA(0, 0), a2, voffA);
            PG8_BAR; PG8_WAIT_L(0); PG8_MMA(1, 0, At, B0); PG8_BAR; PG8_SCHED;
            PG8_STAGE(PG8_SB(0, 1), b2 + hstep, voffB);
            PG8_WAIT_V(6); PG8_BAR; PG8_MMA(1, 1, At, B1); PG8_BAR;
            PG8_LDB(B0, 1, 0); PG8_SCHED; PG8_LDA(At, 1, 0); PG8_STAGE(PG8_SA(0, 1), a2 + hstep, voffA);
            PG8_WAIT_L(8); PG8_BAR; PG8_WAIT_L(0); PG8_MMA(0, 0, At, B0); PG8_BAR; PG8_SCHED;
            PG8_LDB(B1, 1, 1); PG8_STAGE(PG8_SB(1, 0), b3, voffB);
            PG8_BAR; PG8_WAIT_L(0); PG8_MMA(0, 1, At, B1); PG8_BAR;
            PG8_LDA(At, 1, 1); PG8_STAGE(PG8_SA(1, 0), a3, voffA);
            PG8_BAR; PG8_WAIT_L(0); PG8_MMA(1, 0, At, B0); PG8_BAR; PG8_SCHED;
            PG8_STAGE(PG8_SB(1, 1), b3 + hstep, voffB);
            PG8_WAIT_V(6); PG8_BAR; PG8_MMA(1, 1, At, B1); PG8_BAR;
            }
        }
        if constexpr (ALIGN_EPI) { if (wr == 0) PG8_BAR; }
        E(acc, cur, wr, wc, fr, fq);
        if (!has_next) break;
#pragma unroll
        for (int a = 0; a < 2; ++a)
#pragma unroll
            for (int b = 0; b < 2; ++b)
#pragma unroll
                for (int m = 0; m < 4; ++m)
#pragma unroll
                    for (int n = 0; n < 2; ++n) acc[a][b][m][n] = (f32x4){0.f, 0.f, 0.f, 0.f};
        cur = nxt; cA = nA; cB = nB; ++ui;
        if constexpr (ALIGN_EPI) { if (wr == 1) PG8_BAR; }
    }
    PG8_WAIT_V(0);
    if constexpr (!ALIGN_EPI) { if (wr == 0) PG8_BAR; }
    PG8_BAR;
#undef PG8_SA
#undef PG8_SB
#undef PG8_STAGE
#undef PG8_LDA
#undef PG8_LDB
#undef PG8_MMA
#undef PG8_WAIT_V
#undef PG8_WAIT_L
#undef PG8_BAR
#undef PG8_SCHED
}
}

constexpr int D = 1024, NB = 8, LX = 4096, LCX = 256, NIN = 4608, DA = 512, DB = 512, HD = 128;
constexpr int MLAT = NB * LX, MCTX = NB * LCX, MTOK = MLAT + MCTX;
constexpr int PA_LD = 2560;
constexpr int FZ = 8448, FZC = 640;
constexpr float EPS = 1e-6f;
constexpr float HY_MIN_DECAY = -3.0701134573253944f, HY_MAX_DECAY = -15.350567286626972f;
constexpr int NWAVES = 8, NTHR = 512;

constexpr size_t MiB = 1u << 20;
constexpr size_t WS_CTL = 0, CTL_ZERO_BYTES = 1 * MiB;
constexpr size_t WS_MOD = 1 * MiB;
constexpr size_t WS_LBS = WS_MOD + 256 * 1024;
constexpr size_t WS_WIN = 6 * MiB;
constexpr size_t WS_WOUT = 24 * MiB;
constexpr size_t WS_FG = 28 * MiB;
constexpr size_t WS_FGC = 45 * MiB;
constexpr size_t WS_CTX1 = 46 * MiB;
constexpr size_t WS_OC = 2 * MiB;
constexpr size_t WS_XA = 54 * MiB;
constexpr size_t WS_PA = 122 * MiB;
constexpr size_t WS_PB = 292 * MiB;
constexpr size_t WS_OBT = 428 * MiB;
constexpr size_t WS_HK = 292 * MiB;
constexpr size_t WS_END = 462 * MiB;
constexpr int CW_NORM = 1024;

constexpr int LDS_BYTES = 156 * 1024;
#define LAS __attribute__((address_space(3)))
#define GAS __attribute__((address_space(1)))
typedef unsigned short bf16;
typedef unsigned v4u __attribute__((ext_vector_type(4)));
typedef unsigned v2u __attribute__((ext_vector_type(2)));
typedef float f32x4 __attribute__((ext_vector_type(4)));

__device__ __forceinline__ unsigned f2bf(float f) { unsigned u = __builtin_bit_cast(unsigned, f); return (u + 0x7fffu + ((u >> 16) & 1u)) >> 16; }
__device__ __forceinline__ unsigned pk2(float lo, float hi) { return f2bf(lo) | (f2bf(hi) << 16); }
__device__ __forceinline__ float bf2f(unsigned short h) { return __builtin_bit_cast(float, (unsigned)h << 16); }
__device__ __forceinline__ unsigned f2h(float f) { _Float16 h = (_Float16)f; return (unsigned)__builtin_bit_cast(unsigned short, h); }
__device__ __forceinline__ unsigned pk2h(float lo, float hi) { return f2h(lo) | (f2h(hi) << 16); }
__device__ __forceinline__ float h2f(unsigned short u) { return (float)__builtin_bit_cast(_Float16, u); }
__device__ __forceinline__ float silu_f(float x) { return x / (1.0f + __expf(-x)); }
__device__ __forceinline__ float sigmoid_f(float x) { return 1.0f / (1.0f + __expf(-x)); }
__device__ __forceinline__ float wave_sum(float v) {
#pragma unroll
    for (int o = 1; o < 64; o <<= 1) v += __shfl_xor(v, o);
    return v;
}

struct EpiIn {
    static constexpr bool PERM = true;
    bf16* PA; bf16* PB; const float* lb;
    __device__ __forceinline__ bool swap(const pg8::Unit& u) const { return u.pn >= 10; }
    __device__ __forceinline__ void operator()(const f32x4 (&acc)[2][2][4][2], const pg8::Unit& u, int wr, int wc, int fr, int fq) const {
        if (u.pn < 10) {
            const int type = u.pn >> 1;
            const int row0 = u.pm * 256 + wr * 64 + fr, col0 = u.pn * 256 + wc * 32 + 8 * fq;
#pragma unroll
            for (int bj = 0; bj < 2; ++bj) {
                float lbv[8];
#pragma unroll
                for (int e = 0; e < 8; ++e) lbv[e] = (type == 1 || type == 2) ? lb[col0 + bj * 128 + e - 512] : 0.f;
#pragma unroll
                for (int ai = 0; ai < 2; ++ai)
#pragma unroll
                    for (int m = 0; m < 4; ++m) {
                        bf16* rowp = PA + (size_t)(row0 + ai * 128 + m * 16) * PA_LD + col0 + bj * 128;
                        float x[8];
#pragma unroll
                        for (int e = 0; e < 4; ++e) { x[e] = acc[ai][bj][m][0][e]; x[4 + e] = acc[ai][bj][m][1][e]; }
                        v4u w;
                        if (type == 0) {
#pragma unroll
                            for (int e = 0; e < 8; ++e) x[e] = silu_f(x[e]);
                            w.x = pk2(x[0], x[1]); w.y = pk2(x[2], x[3]); w.z = pk2(x[4], x[5]); w.w = pk2(x[6], x[7]);
                        } else if (type == 1 || type == 2) {
#pragma unroll
                            for (int e = 0; e < 8; ++e) x[e] = lbv[e] + (1.0f - lbv[e]) * sigmoid_f(x[e]);
                            w.x = pk2h(x[0], x[1]); w.y = pk2h(x[2], x[3]); w.z = pk2h(x[4], x[5]); w.w = pk2h(x[6], x[7]);
                        } else {
                            w.x = pk2(x[0], x[1]); w.y = pk2(x[2], x[3]); w.z = pk2(x[4], x[5]); w.w = pk2(x[6], x[7]);
                        }
                        *(v4u*)rowp = w;
                        asm volatile("" ::: "memory");
                    }
            }
        } else {
#pragma unroll
            for (int ai = 0; ai < 2; ++ai)
#pragma unroll
                for (int m = 0; m < 4; ++m) {
                    const int cw = u.pn * 256 + ai * 128 + wr * 64 + m * 16 + fr;
                    bf16* colp = PB + (size_t)(cw - 2560) * MTOK + u.pm * 256 + wc * 32 + 8 * fq;
#pragma unroll
                    for (int bj = 0; bj < 2; ++bj) {
                        const f32x4 v0 = acc[ai][bj][m][0], v1 = acc[ai][bj][m][1];
                        v4u w; w.x = pk2(v0[0], v0[1]); w.y = pk2(v0[2], v0[3]); w.z = pk2(v1[0], v1[1]); w.w = pk2(v1[2], v1[3]);
                        *(v4u*)(colp + bj * 128) = w;
                    }
                }
        }
    }
};
struct EpiOut {
    static constexpr bool PERM = false;
    const float* xin_lat; float* out_lat; const float* xin_ctx; float* out_ctx; const float* mod;
    __device__ __forceinline__ bool swap(const pg8::Unit&) const { return false; }
    __device__ __forceinline__ void operator()(const f32x4 (&acc)[2][2][4][2], const pg8::Unit& u, int wr, int wc, int fr, int fq) const {
        const bool isctx = u.pm >= 128;
        const int col0 = u.pn * 256 + wc * 32 + 4 * fq;
#pragma unroll
        for (int ai = 0; ai < 2; ++ai)
#pragma unroll
            for (int m = 0; m < 4; ++m) {
                const int row = u.pm * 256 + ai * 128 + wr * 64 + m * 16 + fr;
                const int rl = isctx ? row - MLAT : row;
                const int mr = isctx ? 8 : (row >> 12);
                const float* xi = (isctx ? xin_ctx : xin_lat) + (size_t)rl * D + col0;
                float* xo = (isctx ? out_ctx : out_lat) + (size_t)rl * D + col0;
                const float* gt = mod + (size_t)mr * 3 * D + 2 * D + col0;
#pragma unroll
                for (int bj = 0; bj < 2; ++bj)
#pragma unroll
                    for (int n = 0; n < 2; ++n) {
                        const int o = bj * 128 + n * 16;
                        const f32x4 xv = *(const f32x4*)(xi + o), gv = *(const f32x4*)(gt + o);
                        *(f32x4*)(xo + o) = xv + gv * acc[ai][bj][m][n];
                    }
            }
    }
};

struct Args {
    const float* in[23]; float* out; unsigned char* ws; int ph_lo, ph_hi;
};

struct Frame {
    LAS unsigned char* lds; int tid, lane, wave, vcu, G;
};

__device__ __forceinline__ void p0_transpose_item(const float* W, int K, int N, bf16* WT, LAS float* scr, int item, int lane) {
    const int nblk = N / 32, kb = item / nblk, nb = item % nblk, k0 = 64 * kb, n0 = 32 * nb;
#pragma unroll 8
    for (int i = 0; i < 32; ++i) { const int kk = 2 * i + (lane >> 5); scr[kk * 33 + (lane & 31)] = W[(size_t)(k0 + kk) * N + n0 + (lane & 31)]; }
    asm volatile("s_waitcnt lgkmcnt(0)" ::: "memory");
    const int c = lane & 7;
#pragma unroll
    for (int j = 0; j < 4; ++j) { const int n = (lane >> 3) + 8 * j; const LAS float* s = scr + (8 * c) * 33 + n;
        v4u o; o.x = pk2(s[0 * 33], s[1 * 33]); o.y = pk2(s[2 * 33], s[3 * 33]); o.z = pk2(s[4 * 33], s[5 * 33]); o.w = pk2(s[6 * 33], s[7 * 33]);
        *(v4u*)(WT + (size_t)(n0 + n) * K + k0 + 8 * c) = o; }
    asm volatile("s_waitcnt lgkmcnt(0)" ::: "memory");
}

__device__ __forceinline__ void phase_prologue(const Args& a, Frame& F) {
    unsigned char* ws = a.ws;
    {
        LAS float* scr = (LAS float*)(F.lds + F.wave * 16384);
        const int gw = F.vcu * NWAVES + F.wave, NGW = F.G * NWAVES;
        constexpr int I_IN = (D / 64) * (NIN / 32), I_OUT = (D / 64) * (D / 32);
        for (int it = gw; it < 2 * (I_IN + I_OUT); it += NGW) {
            int r = it; const int l = r / (I_IN + I_OUT); r -= l * (I_IN + I_OUT);
            if (r < I_IN) p0_transpose_item(a.in[7] + (size_t)l * D * NIN, D, NIN, (bf16*)(ws + WS_WIN) + (size_t)l * NIN * D, scr, r, F.lane);
            else p0_transpose_item(a.in[8] + (size_t)l * D * D, D, D, (bf16*)(ws + WS_WOUT) + (size_t)l * D * D, scr, r - I_IN, F.lane);
        }
    }
    __syncthreads();
    if (F.vcu == 0) {
        float* lbs = (float*)(ws + WS_LBS);
        for (int i = F.tid; i < 1024; i += NTHR) {
            const float a0 = a.in[9][i], a1 = a.in[9][1024 + i];
            const float m = fmaxf(a0, a1), e0 = expf(a0 - m), e1 = expf(a1 - m);
            const float p0 = e0 / (e0 + e1), p1 = e1 / (e0 + e1);
            const float c0 = p0, c1 = p0 + p1;
            lbs[i] = c0 - c0; lbs[1024 + i] = c1 - c0;
        }
    }
    {
        LAS float* sv = (LAS float*)F.lds;
        LAS float* part = sv + 9 * 1024;
        for (int task = F.vcu; task < 96; task += F.G) {
            const int l = task / 48, n0 = (task % 48) * 64;
            for (int e = F.tid; e < 9 * 1024; e += NTHR) { const int r = e >> 10, k = e & 1023; const float cv = r < 8 ? a.in[1][r * D + k] : a.in[3][k]; sv[e] = cv / (1.0f + expf(-cv)); }
            __syncthreads();
            float acc9[9];
#pragma unroll
            for (int r = 0; r < 9; ++r) acc9[r] = 0.f;
            const float* w = a.in[5] + (size_t)l * D * 3 * D + n0 + F.lane;
            for (int k = F.wave * 128; k < F.wave * 128 + 128; ++k) {
                const float wv = w[(size_t)k * 3 * D];
#pragma unroll
                for (int r = 0; r < 9; ++r) acc9[r] += sv[r * 1024 + k] * wv;
            }
#pragma unroll
            for (int r = 0; r < 9; ++r) part[(F.wave * 9 + r) * 64 + F.lane] = acc9[r];
            __syncthreads();
            for (int e = F.tid; e < 9 * 64; e += NTHR) {
                const int r = e >> 6, c = e & 63; float s = 0.f;
#pragma unroll
                for (int w8 = 0; w8 < 8; ++w8) s += part[(w8 * 9 + r) * 64 + c];
                ((float*)(ws + WS_MOD))[((size_t)l * 9 + r) * 3 * D + n0 + c] = s + a.in[6][l * 3 * D + n0 + c];
            }
            __syncthreads();
        }
    }
    {
        LAS float* zs = (LAS float*)F.lds;
        LAS float* h3s = zs + 8 * 64;
        float* nrm = (float*)(ws + WS_CTL) + CW_NORM;
        for (int task = F.vcu; task < 1056; task += F.G) {
            const int set = task < 512 ? 0 : (task < 1024 ? 1 : 2);
            const int L = set == 2 ? 256 : 4096, l = set == 1 ? 1 : 0;
            const int n0 = (set == 0 ? task : set == 1 ? task - 512 : task - 1024) * 8;
            const int n = n0 + F.wave, j = F.lane;
            LAS float* zw = zs + F.wave * 64;
            if (j == 0) zw[0] = (float)n / (float)(L - 1);
            if (j >= 1 && j < 33) {
                const int i = (j - 1) & 15;
                const double f = 1e-4 + (double)i * ((15.0 - 1e-4) / 15.0);
                double rev = f * (double)n / (double)L; rev -= floor(rev);
                const float ang = (float)(rev * 6.283185307179586476925);
                zw[j] = (j <= 16) ? cosf(ang) : -sinf(ang);
            }
            asm volatile("s_waitcnt lgkmcnt(0)" ::: "memory");
            const float* w1 = a.in[13] + l * 33 * 64; const float* b1 = a.in[14] + l * 64; const float fr = a.in[15][l * 64 + j];
            const float* w2 = a.in[16] + l * 4096; const float* b2 = a.in[17] + l * 64; const float* w3 = a.in[18] + l * 4096; const float* b3 = a.in[19] + l * 64;
            float s = b1[j];
            for (int e = 0; e < 33; ++e) s += zw[e] * w1[e * 64 + j];
            const float h1 = sinf(fr * s);
            asm volatile("s_waitcnt lgkmcnt(0)" ::: "memory");
            zw[j] = h1;
            asm volatile("s_waitcnt lgkmcnt(0)" ::: "memory");
            s = b2[j];
            for (int e = 0; e < 64; ++e) s += zw[e] * w2[e * 64 + j];
            const float h2 = sinf(fr * s);
            asm volatile("s_waitcnt lgkmcnt(0)" ::: "memory");
            zw[j] = h2;
            asm volatile("s_waitcnt lgkmcnt(0)" ::: "memory");
            s = b3[j];
            for (int e = 0; e < 64; ++e) s += zw[e] * w3[e * 64 + j];
            h3s[F.wave * 64 + j] = sinf(fr * s);
            __syncthreads();
            const int c2 = 2 * F.tid;
            const float* w4 = a.in[20] + (size_t)l * 64 * 1024 + c2;
            float acc[8][2];
#pragma unroll
            for (int p = 0; p < 8; ++p) { acc[p][0] = 0.f; acc[p][1] = 0.f; }
            for (int jj = 0; jj < 64; ++jj) {
                const float2 wv = *(const float2*)(w4 + (size_t)jj * 1024);
#pragma unroll
                for (int p = 0; p < 8; ++p) { const float hv = h3s[p * 64 + jj]; acc[p][0] += hv * wv.x; acc[p][1] += hv * wv.y; }
            }
            float* hk = (float*)(ws + WS_HK) + (size_t)set * 4096 * 1024;
            float ns[2] = {0.f, 0.f};
#pragma unroll
            for (int e = 0; e < 2; ++e) {
                const int cc = c2 + e, c = cc & 511;
                const float delta = fabsf(HY_MIN_DECAY + (float)c * ((HY_MAX_DECAY - HY_MIN_DECAY) / 511.0f));
#pragma unroll
                for (int p = 0; p < 8; ++p) {
                    const int nn = n0 + p; const float t = (float)nn / (float)(L - 1);
                    const float v = acc[p][e] * expf(-t * delta);
                    hk[(size_t)nn * 1024 + cc] = v;
                    if (cc < 512 || nn >= 1) ns[e] += fabsf(v);
                }
            }
            atomicAdd(&nrm[set * 512 + (c2 & 511)], ns[0]);
            atomicAdd(&nrm[set * 512 + ((c2 + 1) & 511)], ns[1]);
            __syncthreads();
        }
    }
}

__device__ __forceinline__ void phase_normrows(const Args& a, Frame& F, int l, const float* xlat, const float* xctx) {
    unsigned char* ws = a.ws;
    const float* nw = a.in[4] + l * D;
    const float* mod = (const float*)(ws + WS_MOD) + (size_t)l * 9 * 3 * D;
    bf16* XA = (bf16*)(ws + WS_XA);
    const int gw = F.vcu * NWAVES + F.wave, NGW = F.G * NWAVES;
    for (int tok = gw; tok < MTOK; tok += NGW) {
        const bool isctx = tok >= MLAT;
        const float* xr = isctx ? xctx + (size_t)(tok - MLAT) * D : xlat + (size_t)tok * D;
        const int mr = isctx ? 8 : (tok >> 12);
        const float* sh = mod + (size_t)mr * 3 * D; const float* sc = sh + D;
        f32x4 v[4]; float s = 0.f;
#pragma unroll
        for (int j = 0; j < 4; ++j) { v[j] = *(const f32x4*)(xr + 256 * j + 4 * F.lane); s += (v[j].x * v[j].x + v[j].y * v[j].y) + (v[j].z * v[j].z + v[j].w * v[j].w); }
        const float rstd = 1.0f / sqrtf(wave_sum(s) * (1.0f / D) + EPS);
#pragma unroll
        for (int j = 0; j < 4; ++j) {
            const int k = 256 * j + 4 * F.lane;
            const f32x4 w4 = *(const f32x4*)(nw + k), s4 = *(const f32x4*)(sc + k), h4 = *(const f32x4*)(sh + k);
            const f32x4 y = v[j] * rstd * w4 * (s4 + 1.0f) + h4;
            v2u o; o.x = pk2(y.x, y.y); o.y = pk2(y.z, y.w);
            *(v2u*)(XA + (size_t)tok * D + k) = o;
        }
    }
}
__device__ __forceinline__ void phase_filter_finalize(const Args& a, Frame& F) {
    unsigned char* ws = a.ws;
    LAS float* scr = (LAS float*)(F.lds + F.wave * 16640);
    const int gw = F.vcu * NWAVES + F.wave, NGW = F.G * NWAVES;
    constexpr int T01 = 8 * (FZ / 64), T2 = 8 * (FZC / 64);
    for (int it = gw; it < 2 * T01 + T2; it += NGW) {
        const int set = it < T01 ? 0 : (it < 2 * T01 ? 1 : 2);
        const int r = it - (set == 0 ? 0 : set == 1 ? T01 : 2 * T01);
        const int L = set == 2 ? 256 : 4096, nzt = (set == 2 ? FZC : FZ) / 64;
        const int ct = r / nzt, zt = r % nzt, c0 = ct * 64, z0 = zt * 64;
        const float* hk = (const float*)(ws + WS_HK) + (size_t)set * 4096 * 1024;
        for (int zz = 0; zz < 64; ++zz) {
            const int lag = L - (z0 + zz); float v = 0.f;
            if (lag >= 0 && lag <= L - 1) v = hk[(size_t)lag * 1024 + c0 + F.lane];
            else if (lag < 0 && -lag <= L - 1) v = hk[(size_t)(-lag) * 1024 + 512 + c0 + F.lane];
            scr[zz * 65 + F.lane] = v;
        }
        asm volatile("s_waitcnt lgkmcnt(0)" ::: "memory");
        bf16* dst = set == 2 ? (bf16*)(ws + WS_FGC) : (bf16*)(ws + WS_FG) + (size_t)set * 512 * FZ;
        const int ld = set == 2 ? FZC : FZ;
        for (int cc = 0; cc < 64; ++cc) dst[(size_t)(c0 + cc) * ld + z0 + F.lane] = (bf16)f2bf(scr[F.lane * 65 + cc]);
        asm volatile("s_waitcnt lgkmcnt(0)" ::: "memory");
    }
}

__device__ __forceinline__ void phase_finalize_ox(const Args& a, Frame& F, int l) {
    unsigned char* ws = a.ws;
    const bf16* PA = (const bf16*)(ws + WS_PA);
    const bf16* OC = (const bf16*)(ws + WS_OC);
    bf16* XA = (bf16*)(ws + WS_XA);
    const float* gnw = a.in[10] + l * 512;
    const int gw = F.vcu * NWAVES + F.wave, NGW = F.G * NWAVES;
    const int ntok = (l == 0) ? MTOK : MLAT;
    for (int tok = gw; tok < ntok; tok += NGW) {
        const bool isctx = tok >= MLAT;
        const int c8 = 8 * F.lane;
        const bf16* pf = isctx ? OC + (size_t)(tok - MLAT) * 512 + c8 : PA + (size_t)tok * PA_LD + 512 + c8;
        const bf16* pb = isctx ? OC + (size_t)MCTX * 512 + (size_t)(tok - MLAT) * 512 + c8 : PA + (size_t)tok * PA_LD + 1024 + c8;
        const v4u wf = *(const v4u*)pf, wb = *(const v4u*)pb, wg = *(const v4u*)(PA + (size_t)tok * PA_LD + 2048 + c8);
        float o[8], g[8];
#pragma unroll
        for (int e = 0; e < 4; ++e) {
            o[2 * e] = bf2f((unsigned short)(wf[e] & 0xffff)) + bf2f((unsigned short)(wb[e] & 0xffff));
            o[2 * e + 1] = bf2f((unsigned short)(wf[e] >> 16)) + bf2f((unsigned short)(wb[e] >> 16));
            g[2 * e] = bf2f((unsigned short)(wg[e] & 0xffff)); g[2 * e + 1] = bf2f((unsigned short)(wg[e] >> 16));
        }
        float s = 0.f;
#pragma unroll
        for (int e = 0; e < 8; ++e) s += o[e] * o[e];
        s += __shfl_xor(s, 1); s += __shfl_xor(s, 2); s += __shfl_xor(s, 4); s += __shfl_xor(s, 8);
        const float rstd = 1.0f / sqrtf(s * (1.0f / HD) + EPS);
        float y[8];
#pragma unroll
        for (int e = 0; e < 8; ++e) y[e] = o[e] * rstd * gnw[c8 + e] * silu_f(g[e]);
        v4u w; w.x = pk2(y[0], y[1]); w.y = pk2(y[2], y[3]); w.z = pk2(y[4], y[5]); w.w = pk2(y[6], y[7]);
        *(v4u*)(XA + (size_t)tok * D + c8) = w;
    }
    LAS unsigned short* t = (LAS unsigned short*)(F.lds + F.wave * 16384);
    const int ntt = ntok / 64;
    for (int it = gw; it < 8 * ntt; it += NGW) {
        const int ct = it / ntt, tt = it % ntt, c0 = ct * 64, t0 = tt * 64;
        const bf16* OBT = (const bf16*)(ws + WS_OBT);
#pragma unroll
        for (int i = 0; i < 8; ++i) {
            const int e = F.lane + 64 * i, c = e >> 3, ch = e & 7;
            const v4u w = *(const v4u*)(OBT + (size_t)(c0 + c) * MTOK + t0 + 8 * ch);
#pragma unroll
            for (int q = 0; q < 4; ++q) { t[c * 66 + 8 * ch + 2 * q] = (unsigned short)(w[q] & 0xffff); t[c * 66 + 8 * ch + 2 * q + 1] = (unsigned short)(w[q] >> 16); }
        }
        asm volatile("s_waitcnt lgkmcnt(0)" ::: "memory");
#pragma unroll
        for (int i = 0; i < 8; ++i) {
            const int e = F.lane + 64 * i, tk = e >> 3, cg = e & 7;
            unsigned short h[8];
#pragma unroll
            for (int q = 0; q < 8; ++q) h[q] = t[(8 * cg + q) * 66 + tk];
            v4u w; w.x = h[0] | ((unsigned)h[1] << 16); w.y = h[2] | ((unsigned)h[3] << 16); w.z = h[4] | ((unsigned)h[5] << 16); w.w = h[6] | ((unsigned)h[7] << 16);
            *(v4u*)(XA + (size_t)(t0 + tk) * D + 512 + c0 + 8 * cg) = w;
        }
        asm volatile("s_waitcnt lgkmcnt(0)" ::: "memory");
    }
}

__device__ __forceinline__ void phase_final_norm(const Args& a, Frame& F) {
    const float* w = a.in[22];
    const int gw = F.vcu * NWAVES + F.wave, NGW = F.G * NWAVES;
    for (int tok = gw; tok < MLAT; tok += NGW) {
        float* xr = a.out + (size_t)tok * D;
        f32x4 v[4]; float s = 0.f;
#pragma unroll
        for (int j = 0; j < 4; ++j) { v[j] = *(const f32x4*)(xr + 256 * j + 4 * F.lane); s += (v[j].x * v[j].x + v[j].y * v[j].y) + (v[j].z * v[j].z + v[j].w * v[j].w); }
        const float rstd = 1.0f / sqrtf(wave_sum(s) * (1.0f / D) + EPS);
#pragma unroll
        for (int j = 0; j < 4; ++j) { const f32x4 w4 = *(const f32x4*)(w + 256 * j + 4 * F.lane); *(f32x4*)(xr + 256 * j + 4 * F.lane) = v[j] * rstd * w4; }
    }
}

enum { PH_PRO = 0, PH_NORM0 = 1, PH_IN0 = 2, PH_FIN0 = 3, PH_OUT0 = 4, PH_NORM1 = 5, PH_IN1 = 6, PH_FIN1 = 7, PH_OUT1 = 8, PH_FINAL = 9 };

__device__ __forceinline__ Frame mkframe(unsigned char* lds) {
    Frame F;
    F.lds = (LAS unsigned char*)lds;
    F.tid = threadIdx.x; F.lane = F.tid & 63; F.wave = __builtin_amdgcn_readfirstlane(F.tid >> 6);
    F.G = gridDim.x; { const int bx = blockIdx.x; F.vcu = (F.G % 8 == 0) ? (bx % 8) * (F.G / 8) + bx / 8 : bx; }
    return F;
}
template <int l> __device__ __forceinline__ void run_inproj(const Args& args, unsigned char* lds) {
    unsigned char* ws = args.ws; Frame F = mkframe(lds);
    pg8::Gemm g{(const bf16*)(ws + WS_XA), (const bf16*)(ws + WS_WIN) + (size_t)l * NIN * D, D};
    pg8::Sched S; S.init(128, 18, F.G, (int)blockIdx.x, 8, l == 0 ? 18 : 8);
    EpiIn E{(bf16*)(ws + WS_PA), (bf16*)(ws + WS_PB), (const float*)(ws + WS_LBS) + l * 1024};
    pg8::gemm_phase<EpiIn, true, true>(F.lds, g, S, E);
}
template <int l> __device__ __forceinline__ void run_outproj(const Args& args, unsigned char* lds) {
    unsigned char* ws = args.ws; Frame F = mkframe(lds);
    pg8::Gemm g{(const bf16*)(ws + WS_XA), (const bf16*)(ws + WS_WOUT) + (size_t)l * D * D, D};
    pg8::Sched S; S.init(128, 4, F.G, (int)blockIdx.x, l == 0 ? 8 : 0, 4);
    EpiOut E{l == 0 ? args.in[0] : args.out, args.out, args.in[2], (float*)(ws + WS_CTX1), (const float*)(ws + WS_MOD) + (size_t)l * 9 * 3 * D};
    pg8::gemm_phase<EpiOut, true, true>(F.lds, g, S, E);
}
__global__ void __launch_bounds__(NTHR, 2) mega(Args args) {
    extern __shared__ __attribute__((aligned(16))) unsigned char lds[];
    const int lo = args.ph_lo, hi = args.ph_hi;
#define IN(k) (lo <= (k) && (k) < hi)
#define SEAM(k) do { __syncthreads(); } while (0)
    if (IN(PH_PRO)) { Frame F = mkframe(lds); phase_prologue(args, F); SEAM(PH_PRO); }
    if (IN(PH_NORM0)) { Frame F = mkframe(lds); phase_normrows(args, F, 0, args.in[0], args.in[2]); phase_filter_finalize(args, F); SEAM(PH_NORM0); }
    if (IN(PH_IN0)) { run_inproj<0>(args, lds); SEAM(PH_IN0); }
    if (IN(PH_FIN0)) { Frame F = mkframe(lds); phase_finalize_ox(args, F, 0); SEAM(PH_FIN0); }
    if (IN(PH_OUT0)) { run_outproj<0>(args, lds); SEAM(PH_OUT0); }
    if (IN(PH_NORM1)) { Frame F = mkframe(lds); phase_normrows(args, F, 1, args.out, (const float*)(args.ws + WS_CTX1)); SEAM(PH_NORM1); }
    if (IN(PH_IN1)) { run_inproj<1>(args, lds); SEAM(PH_IN1); }
    if (IN(PH_FIN1)) { Frame F = mkframe(lds); phase_finalize_ox(args, F, 1); SEAM(PH_FIN1); }
    if (IN(PH_OUT1)) { run_outproj<1>(args, lds); SEAM(PH_OUT1); }
    if (IN(PH_FINAL)) { Frame F = mkframe(lds); phase_final_norm(args, F); }
#undef IN
#undef SEAM
}

__global__ void __launch_bounds__(256) k_hgrn2_v2(unsigned char* ws) {
    __shared__ float qs[16][128], fgs[16][128], vs[16][128];
    __shared__ float red[16][256];
    bf16* PA = (bf16*)(ws + WS_PA);
    bf16* OC = (bf16*)(ws + WS_OC);
    const int tid = threadIdx.x, v = tid & 127, kh = tid >> 7;
    const bool ctxunit = blockIdx.x >= 64;
    const int u = blockIdx.x & 63, dir = u & 1, h = (u >> 1) & 3, b = u >> 3;
    float S[64];
#pragma unroll
    for (int kk = 0; kk < 64; ++kk) S[kk] = 0.f;
    const int nseg = ctxunit ? 1 : 2;
    for (int seg = 0; seg < nseg; ++seg) {
        const bool isctx = (seg == 0);
        const int L = isctx ? LCX : LX;
        const int base = isctx ? MLAT + b * LCX : b * LX;
        const bool wr_o = ctxunit || !isctx;
        for (int c = 0; c < L / 16; ++c) {
            for (int e = tid; e < 16 * 128; e += 256) {
                const int j = e >> 7, d = e & 127;
                const int t = dir == 0 ? (16 * c + j) : (L - 1 - (16 * c + j));
                const bf16* pr = PA + (size_t)(base + t) * PA_LD + h * HD + d;
                qs[j][d] = bf2f(pr[0]); fgs[j][d] = h2f(pr[512 + dir * 512]); vs[j][d] = bf2f(pr[1536]);
            }
            __syncthreads();
            float op[16];
#pragma unroll
            for (int j = 0; j < 16; ++j) {
                const float vv = vs[j][v]; float oo = 0.f;
#pragma unroll
                for (int kk = 0; kk < 64; ++kk) { const int k = kh * 64 + kk; const float fg = fgs[j][k]; S[kk] = fg * S[kk] + (1.0f - fg) * vv; oo += S[kk] * qs[j][k]; }
                op[j] = oo;
            }
#pragma unroll
            for (int j = 0; j < 16; ++j) red[j][tid] = op[j];
            __syncthreads();
            if (wr_o) {
                for (int e = tid; e < 16 * 128; e += 256) {
                    const int j = e >> 7, d = e & 127;
                    const int t = dir == 0 ? (16 * c + j) : (L - 1 - (16 * c + j));
                    const float o = red[j][d] + red[j][128 + d];
                    if (isctx) OC[(size_t)dir * MCTX * 512 + (size_t)(b * LCX + t) * 512 + h * HD + d] = (bf16)f2bf(o);
                    else PA[(size_t)(base + t) * PA_LD + 512 + dir * 512 + h * HD + d] = (bf16)f2bf(o);
                }
            }
            __syncthreads();
        }
    }
}
__global__ void __launch_bounds__(256) k_hyena_v2(unsigned char* ws, const float* conv_w, const float* conv_b, const float* hy_bias, int l) {
    __shared__ float vv[4096];
    __shared__ float Fw[8192];
    const int c = blockIdx.x, b = blockIdx.y, isctx = blockIdx.z;
    const int L = isctx ? LCX : LX, base = isctx ? MLAT + b * LCX : b * LX, set = isctx ? 2 : l;
    const bf16* PB = (const bf16*)(ws + WS_PB);
    const bf16* x0 = PB + (size_t)c * MTOK + base; const bf16* x1 = PB + (size_t)(512 + c) * MTOK + base;
    const bf16* vr = PB + (size_t)(1024 + c) * MTOK + base; const bf16* gb = PB + (size_t)(1536 + c) * MTOK + base;
    const bf16* Fg = isctx ? (const bf16*)(ws + WS_FGC) + (size_t)c * FZC : (const bf16*)(ws + WS_FG) + ((size_t)l * 512 + c) * FZ;
    const float* cw = conv_w + (size_t)l * 3 * 1536; const float* cb = conv_b + (size_t)l * 1536;
    const int tid = threadIdx.x;
    auto sconv = [&](const bf16* u, int col, int t) { float s = cb[col] + cw[1536 + col] * bf2f(u[t]); if (t > 0) s += cw[col] * bf2f(u[t - 1]); if (t < L - 1) s += cw[3072 + col] * bf2f(u[t + 1]); return s; };
    for (int t = tid; t < L; t += 256) vv[t] = sconv(vr, 1024 + c, t) * sconv(x1, 512 + c, t);
    for (int z = tid; z < 2 * L; z += 256) Fw[z] = bf2f(Fg[z]);
    __syncthreads();
    const float inn = 1.0f / ((const float*)(ws + WS_CTL))[CW_NORM + set * 512 + c], hb = hy_bias[l * 512 + c];
    bf16* OBT = (bf16*)(ws + WS_OBT) + (size_t)c * MTOK + base;
    for (int t = tid; t < L; t += 256) {
        float acc = 0.f;
        for (int s = 0; s < L; ++s) acc += Fw[L - t + s] * vv[s];
        const float y = acc * inn + vv[t] * hb;
        OBT[t] = (bf16)f2bf(y * sconv(x0, c, t) * silu_f(bf2f(gb[t])));
    }
}

extern "C" void kernel_launch(void* const* d_in, const int* in_sizes, int n_in, void* d_out, int out_size, void* d_ws, size_t ws_size, hipStream_t stream) {
    static int grid = 0;
    if (grid == 0) {
        if (n_in != 23 || ws_size < WS_END) { fprintf(stderr, "kernel_launch: unexpected n_in %d / ws_size %zu\n", n_in, ws_size); grid = -1; return; }
        int dev = 0, cus = 0;
        if (hipGetDevice(&dev) != hipSuccess || hipDeviceGetAttribute(&cus, hipDeviceAttributeMultiprocessorCount, dev) != hipSuccess) { grid = -1; return; }
        if (hipFuncSetAttribute((const void*)mega, hipFuncAttributeMaxDynamicSharedMemorySize, LDS_BYTES) != hipSuccess) { fprintf(stderr, "kernel_launch: hipFuncSetAttribute failed\n"); grid = -1; return; }
        grid = cus;
    }
    if (grid < 0) return;
    (void)hipMemsetAsync((char*)d_ws + WS_CTL, 0, CTL_ZERO_BYTES, stream);
    Args a{};
    for (int i = 0; i < 23; ++i) a.in[i] = (const float*)d_in[i];
    a.out = (float*)d_out; a.ws = (unsigned char*)d_ws;
    auto run = [&](int ph) { a.ph_lo = ph; a.ph_hi = ph + 1; hipLaunchKernelGGL(mega, dim3(grid), dim3(NTHR), LDS_BYTES, stream, a); };
    run(PH_PRO); run(PH_NORM0); run(PH_IN0);
    hipLaunchKernelGGL(k_hgrn2_v2, dim3(128), dim3(256), 0, stream, (unsigned char*)d_ws);
    hipLaunchKernelGGL(k_hyena_v2, dim3(512, 8, 2), dim3(256), 0, stream, (unsigned char*)d_ws, (const float*)d_in[11], (const float*)d_in[12], (const float*)d_in[21], 0);
    run(PH_FIN0); run(PH_OUT0); run(PH_NORM1); run(PH_IN1);
    hipLaunchKernelGGL(k_hgrn2_v2, dim3(64), dim3(256), 0, stream, (unsigned char*)d_ws);
    hipLaunchKernelGGL(k_hyena_v2, dim3(512, 8, 1), dim3(256), 0, stream, (unsigned char*)d_ws, (const float*)d_in[11], (const float*)d_in[12], (const float*)d_in[21], 1);
    run(PH_FIN1); run(PH_OUT1); run(PH_FINAL);
}
```

```cpp
#include <hip/hip_runtime.h>
#include <cstdio>
#include <cstdint>
#include <math.h>

namespace pg8 {
#define PG8_LAS __attribute__((address_space(3)))
typedef unsigned short bf16_t;
typedef short bf16x8 __attribute__((ext_vector_type(8)));
typedef float f32x4 __attribute__((ext_vector_type(4)));
typedef unsigned u32x4 __attribute__((ext_vector_type(4)));
typedef unsigned u32x2 __attribute__((ext_vector_type(2)));
constexpr int BM = 256, BK = 64, HALF = 128, HTB = HALF * BK * 2, STAGE_BYTES = 8 * HTB, NXCD = 8, WGM = 8;

__host__ __device__ __forceinline__ int lds_byte(int r, int c) { const int st = (r >> 4) * 2 + (c >> 5), rr = r & 15, cc = c & 31, ob = rr * 64 + cc * 2; return st * 1024 + (ob ^ (((ob >> 9) & 1) << 5)); }
__host__ __device__ __forceinline__ void stage_rc(int b, int& R, int& C) { const int st = b / 1024, sb = b % 1024, swz = sb ^ (((sb >> 9) & 1) << 5); R = (st >> 1) * 16 + swz / 64; C = (st & 1) * 32 + (swz % 64) / 2; }
__host__ __device__ __forceinline__ int perm32(int rho) { const int n = rho >> 4, i = rho & 15; return 8 * (i >> 2) + 4 * n + (i & 3); }

struct Unit { int pm, pn; };
struct Gemm { const bf16_t* A; const bf16_t* Bt; int K; };

struct Sched {
    int nM, nN, nwg, G, c, nctx, nctxN;
    __device__ void init(int nM_, int nN_, int G_, int c_, int nctxM, int nctxN_) { nM = nM_; nN = nN_; nwg = nM * nN; G = G_; c = c_; nctx = nctxM * nctxN_; nctxN = nctxN_ > 0 ? nctxN_ : 1; }
    __device__ bool next(int i, Unit& u) const {
        const long L = (long)i * G + c;
        if (L >= nwg) { const long L2 = L - nwg; if (L2 >= nctx) return false; u.pm = nM + (int)(L2 / nctxN); u.pn = (int)(L2 % nctxN); return true; }
        int wgid = (int)L; { const int q = nwg / NXCD, r = nwg % NXCD, xcd = wgid % NXCD, off = wgid / NXCD; wgid = (xcd < r ? xcd * (q + 1) : r * (q + 1) + (xcd - r) * q) + off; }
        const int nig = WGM * nN, gid = wgid / nig, fm = gid * WGM, gsz = (nM - fm) < WGM ? (nM - fm) : WGM;
        u.pm = fm + ((wgid % nig) % gsz); u.pn = (wgid % nig) / gsz; return true;
    }
};

template <class Epi, bool ALIGN_EPI, bool SP2>
__device__ __forceinline__ void gemm_phase(PG8_LAS unsigned char* lds, const Gemm g, const Sched& S, const Epi& E) {
    const int tid = threadIdx.x, wid = __builtin_amdgcn_readfirstlane(tid >> 6), lane = tid & 63, wr = wid >> 2, wc = wid & 3, fr = lane & 15, fq = lane >> 4;
    const int K = g.K, nt = K / BK;
    unsigned voffA[2], voffB[2];
#pragma unroll
    for (int i = 0; i < 2; ++i) { int R, C; stage_rc(tid * 16 + i * 8192, R, C); const int Rb = Epi::PERM ? ((R & ~31) + perm32(R & 31)) : R;
        voffA[i] = (unsigned)(R * K + C) * 2u; voffB[i] = (unsigned)(Rb * K + C) * 2u; }
    const size_t kstep = (size_t)(BK * 2);
    const size_t hstep = (size_t)HALF * K * 2;
    const size_t tstep = 2 * hstep;
    const unsigned ldsw = (unsigned)wid * 1024u;
    const int aoff = lds_byte(wr * 64 + fr, fq * 8), boff = lds_byte(wc * 32 + fr, fq * 8);
#define PG8_SA(b, h) (((b) * 2 + (h)) * HTB)
#define PG8_SB(b, h) ((4 + (b) * 2 + (h)) * HTB)
#define PG8_STAGE(bufoff, gbase, voff) do { _Pragma("unroll") for (int _i = 0; _i < 2; ++_i) \
        __builtin_amdgcn_global_load_lds((const unsigned*)((const char*)(gbase) + (voff)[_i]), (PG8_LAS unsigned*)(lds + (bufoff) + ldsw + _i * 8192), 16, 0, 0); } while (0)
#define PG8_LDA(dst, b, h) do { _Pragma("unroll") for (int m = 0; m < 4; ++m) _Pragma("unroll") for (int k = 0; k < 2; ++k) dst[m][k] = *(const PG8_LAS bf16x8*)(lds + PG8_SA(b, h) + aoff + m * 2048 + k * 1024); } while (0)
#define PG8_LDB(dst, b, h) do { _Pragma("unroll") for (int n = 0; n < 2; ++n) _Pragma("unroll") for (int k = 0; k < 2; ++k) dst[n][k] = *(const PG8_LAS bf16x8*)(lds + PG8_SB(b, h) + boff + n * 2048 + k * 1024); } while (0)
#define PG8_MMA(ai, bj, At, Bt) do { __builtin_amdgcn_s_setprio(1); _Pragma("unroll") for (int m = 0; m < 4; ++m) _Pragma("unroll") for (int n = 0; n < 2; ++n) _Pragma("unroll") for (int k = 0; k < 2; ++k) \
        acc[ai][bj][m][n] = __builtin_amdgcn_mfma_f32_16x16x32_bf16(Bt[n][k], At[m][k], acc[ai][bj][m][n], 0, 0, 0); __builtin_amdgcn_s_setprio(0); } while (0)
#define PG8_WAIT_V(n) asm volatile("s_waitcnt vmcnt(" #n ")" ::: "memory")
#define PG8_WAIT_L(n) asm volatile("s_waitcnt lgkmcnt(" #n ")" ::: "memory")
#define PG8_BAR __builtin_amdgcn_s_barrier()
#define PG8_SCHED __builtin_amdgcn_sched_barrier(0)
    Unit cur, nxt; int ui = 0;
    if (!S.next(0, cur)) return;
    f32x4 acc[2][2][4][2];
#pragma unroll
    for (int a = 0; a < 2; ++a)
#pragma unroll
        for (int b = 0; b < 2; ++b)
#pragma unroll
            for (int m = 0; m < 4; ++m)
#pragma unroll
                for (int n = 0; n < 2; ++n) acc[a][b][m][n] = (f32x4){0.f, 0.f, 0.f, 0.f};
    bf16x8 At[4][2], B0[2][2], B1[2][2];
    const char* cA = E.swap(cur) ? (const char*)g.Bt + (size_t)cur.pn * tstep : (const char*)g.A + (size_t)cur.pm * tstep;
    const char* cB = E.swap(cur) ? (const char*)g.A + (size_t)cur.pm * tstep : (const char*)g.Bt + (size_t)cur.pn * tstep;
    if constexpr (SP2) {
        PG8_STAGE(PG8_SB(0, 0), cB, voffB); PG8_STAGE(PG8_SB(0, 1), cB + hstep, voffB); PG8_STAGE(PG8_SA(0, 0), cA, voffA); PG8_STAGE(PG8_SA(0, 1), cA + hstep, voffA);
        if (wr == 1) PG8_BAR;
        PG8_WAIT_V(2); PG8_BAR;
        PG8_STAGE(PG8_SB(1, 0), cB + kstep, voffB); PG8_STAGE(PG8_SA(1, 0), cA + kstep, voffA); PG8_STAGE(PG8_SB(1, 1), cB + hstep + kstep, voffB);
        PG8_WAIT_V(6); PG8_BAR;
    } else {
        PG8_STAGE(PG8_SB(0, 0), cB, voffB); PG8_STAGE(PG8_SA(0, 0), cA, voffA); PG8_STAGE(PG8_SB(0, 1), cB + hstep, voffB); PG8_STAGE(PG8_SA(0, 1), cA + hstep, voffA);
        if (wr == 1) PG8_BAR;
        PG8_WAIT_V(4); PG8_BAR;
        PG8_STAGE(PG8_SB(1, 0), cB + kstep, voffB); PG8_STAGE(PG8_SA(1, 0), cA + kstep, voffA); PG8_STAGE(PG8_SB(1, 1), cB + hstep + kstep, voffB);
        PG8_WAIT_V(6); PG8_BAR;
    }
    for (;;) {
        const bool has_next = S.next(ui + 1, nxt);
        const bool nsw = has_next && E.swap(nxt);
        const char* nA = has_next ? (nsw ? (const char*)g.Bt + (size_t)nxt.pn * tstep : (const char*)g.A + (size_t)nxt.pm * tstep) : cA;
        const char* nB = has_next ? (nsw ? (const char*)g.A + (size_t)nxt.pm * tstep : (const char*)g.Bt + (size_t)nxt.pn * tstep) : cB;
        for (int t = 0; t < nt; t += 2) {
            const bool last = (t == nt - 2);
            const char* a1 = cA + (size_t)(t + 1) * kstep;
            const char* a2 = last ? nA : cA + (size_t)(t + 2) * kstep; const char* b2 = last ? nB : cB + (size_t)(t + 2) * kstep;
            const char* a3 = a2 + kstep; const char* b3 = b2 + kstep;
            if constexpr (SP2) {
            PG8_LDB(B0, 0, 0); PG8_LDB(B1, 0, 1); PG8_SCHED; PG8_LDA(At, 0, 0); PG8_STAGE(PG8_SA(1, 1), a1 + hstep, voffA);
            PG8_WAIT_V(8); PG8_WAIT_L(0); PG8_BAR; PG8_MMA(0, 0, At, B0); PG8_MMA(0, 1, At, B1); PG8_BAR; PG8_SCHED;
            PG8_LDA(At, 0, 1); PG8_STAGE(PG8_SB(0, 0), b2, voffB); PG8_STAGE(PG8_SB(0, 1), b2 + hstep, voffB); PG8_STAGE(PG8_SA(0, 0), a2, voffA);
            PG8_WAIT_V(8); PG8_WAIT_L(0); PG8_BAR; PG8_MMA(1, 0, At, B0); PG8_MMA(1, 1, At, B1); PG8_BAR; PG8_SCHED;
            PG8_LDB(B0, 1, 0); PG8_LDB(B1, 1, 1); PG8_SCHED; PG8_LDA(At, 1, 0); PG8_STAGE(PG8_SA(0, 1), a2 + hstep, voffA);
            PG8_WAIT_V(8); PG8_WAIT_L(0); PG8_BAR; PG8_MMA(0, 0, At, B0); PG8_MMA(0, 1, At, B1); PG8_BAR; PG8_SCHED;
            PG8_LDA(At, 1, 1); PG8_STAGE(PG8_SB(1, 0), b3, voffB); PG8_STAGE(PG8_SB(1, 1), b3 + hstep, voffB); PG8_STAGE(PG8_SA(1, 0), a3, voffA);
            PG8_WAIT_V(8); PG8_WAIT_L(0); PG8_BAR; PG8_MMA(1, 0, At, B0); PG8_MMA(1, 1, At, B1); PG8_BAR; PG8_SCHED;
            } else {
            PG8_LDB(B0, 0, 0); PG8_SCHED; PG8_LDA(At, 0, 0); PG8_STAGE(PG8_SA(1, 1), a1 + hstep, voffA);
            PG8_WAIT_L(8); PG8_BAR; PG8_WAIT_L(0); PG8_MMA(0, 0, At, B0); PG8_BAR; PG8_SCHED;
            PG8_LDB(B1, 0, 1); PG8_STAGE(PG8_SB(0, 0), b2, voffB);
            PG8_BAR; PG8_WAIT_L(0); PG8_MMA(0, 1, At, B1); PG8_BAR;
            PG8_LDA(At, 0, 1); PG8_STAGE(PG8_SA(0, 0), a2, voffA);
            PG8_BAR; PG8_WAIT_L(0); PG8_MMA(1, 0, At, B0); PG8_BAR; PG8_SCHED;
            PG8_STAGE(PG8_SB(0, 1), b2 + hstep, voffB);
            PG8_WAIT_V(6); PG8_BAR; PG8_MMA(1, 1, At, B1); PG8_BAR;
            PG8_LDB(B0, 1, 0); PG8_SCHED; PG8_LDA(At, 1, 0); PG8_STAGE(PG8_SA(0, 1), a2 + hstep, voffA);
            PG8_WAIT_L(8); PG8_BAR; PG8_WAIT_L(0); PG8_MMA(0, 0, At, B0); PG8_BAR; PG8_SCHED;
            PG8_LDB(B1, 1, 1); PG8_STAGE(PG8_SB(1, 0), b3, voffB);
            PG8_BAR; PG8_WAIT_L(0); PG8_MMA(0, 1, At, B1); PG8_BAR;
            PG8_LDA(At, 1, 1); PG8_STAGE(PG8_SA(1, 0), a3, voffA);
            PG8_BAR; PG8_WAIT_L(0); PG8_MMA(1, 0, At, B0); PG8_BAR; PG8_SCHED;
            PG8_STAGE(PG8_SB(1, 1), b3 + hstep, voffB);
            PG8_WAIT_V(6); PG8_BAR; PG8_MMA(1, 1, At, B1); PG8_BAR;
            }
        }
        if constexpr (ALIGN_EPI) { if (wr == 0) PG8_BAR; }
        E(acc, cur, wr, wc, fr, fq);
        if (!has_next) break;
#pragma unroll
        for (int a = 0; a < 2; ++a)
#pragma unroll
            for (int b = 0; b < 2; ++b)
#pragma unroll
                for (int m = 0; m < 4; ++m)
#pragma unroll
                    for (int n = 0; n < 2; ++n) acc[a][b][m][n] = (f32x4){0.f, 0.f, 0.f, 0.f};
        cur = nxt; cA = nA; cB = nB; ++ui;
        if constexpr (ALIGN_EPI) { if (wr == 1) PG8_BAR; }
    }
    PG8_WAIT_V(0);
    if constexpr (!ALIGN_EPI) { if (wr == 0) PG8_BAR; }
    PG8_BAR;
#undef PG8_SA
#undef PG8_SB
#undef PG8_STAGE
#undef PG8_LDA
#undef PG8_LDB
#undef PG8_MMA
#undef PG8_WAIT_V
#undef PG8_WAIT_L
#undef PG8_BAR
#undef PG8_SCHED
}
}

constexpr int D = 1024, NB = 8, LX = 4096, LCX = 256, NIN = 4608, DA = 512, DB = 512, HD = 128;
constexpr int MLAT = NB * LX, MCTX = NB * LCX, MTOK = MLAT + MCTX;
constexpr int PA_LD = 2560;
constexpr int FZ = 8448, FZC = 640;
constexpr float EPS = 1e-6f;
constexpr float HY_MIN_DECAY = -3.0701134573253944f, HY_MAX_DECAY = -15.350567286626972f;
constexpr int NWAVES = 8, NTHR = 512;

constexpr size_t MiB = 1u << 20;
constexpr size_t WS_CTL = 0, CTL_ZERO_BYTES = 1 * MiB;
constexpr size_t WS_MOD = 1 * MiB;
constexpr size_t WS_LBS = WS_MOD + 256 * 1024;
constexpr size_t WS_WIN = 6 * MiB;
constexpr size_t WS_WOUT = 24 * MiB;
constexpr size_t WS_FG = 28 * MiB;
constexpr size_t WS_FGC = 45 * MiB;
constexpr size_t WS_CTX1 = 46 * MiB;
constexpr size_t WS_OC = 2 * MiB;
constexpr size_t WS_XA = 54 * MiB;
constexpr size_t WS_PA = 122 * MiB;
constexpr size_t WS_PB = 292 * MiB;
constexpr size_t WS_OBT = 428 * MiB;
constexpr size_t WS_HK = 292 * MiB;
constexpr size_t WS_END = 462 * MiB;
constexpr int CW_NORM = 1024;
constexpr int CW_BAR = 8192;
constexpr int CW_QUEUE = 4096;

constexpr int LDS_BYTES = 156 * 1024;
#define LAS __attribute__((address_space(3)))
#define GAS __attribute__((address_space(1)))
typedef unsigned short bf16;
typedef unsigned v4u __attribute__((ext_vector_type(4)));
typedef unsigned v2u __attribute__((ext_vector_type(2)));
typedef float f32x4 __attribute__((ext_vector_type(4)));

__device__ __forceinline__ unsigned f2bf(float f) { unsigned u = __builtin_bit_cast(unsigned, f); return (u + 0x7fffu + ((u >> 16) & 1u)) >> 16; }
__device__ __forceinline__ unsigned pk2(float lo, float hi) { return f2bf(lo) | (f2bf(hi) << 16); }
__device__ __forceinline__ float bf2f(unsigned short h) { return __builtin_bit_cast(float, (unsigned)h << 16); }
__device__ __forceinline__ unsigned f2h(float f) { _Float16 h = (_Float16)f; return (unsigned)__builtin_bit_cast(unsigned short, h); }
__device__ __forceinline__ unsigned pk2h(float lo, float hi) { return f2h(lo) | (f2h(hi) << 16); }
__device__ __forceinline__ float h2f(unsigned short u) { return (float)__builtin_bit_cast(_Float16, u); }
__device__ __forceinline__ float silu_f(float x) { return x / (1.0f + __expf(-x)); }
__device__ __forceinline__ float sigmoid_f(float x) { return 1.0f / (1.0f + __expf(-x)); }
__device__ __forceinline__ float wave_sum(float v) {
#pragma unroll
    for (int o = 1; o < 64; o <<= 1) v += __shfl_xor(v, o);
    return v;
}


typedef GAS unsigned gu32;
#define XB_TMO      128
#define XB_XCNT(j)  (256  + 64 * (j))
#define XB_XSUB(j)  (1280 + 64 * (j))
#define XB_XGEN(j)  (2304 + 64 * (j))
#define XB_TOP      3328
#define XB_TOPGEN   3392
#define XCD_BAR_WORDS 3456
#define XB_SPIN_CAP (1u << 18)
__device__ __forceinline__ unsigned xb_ld(unsigned* p)              { return __hip_atomic_load(p, __ATOMIC_RELAXED, __HIP_MEMORY_SCOPE_AGENT); }
__device__ __forceinline__ unsigned xb_add(unsigned* p, unsigned v) { return __hip_atomic_fetch_add(p, v, __ATOMIC_RELAXED, __HIP_MEMORY_SCOPE_AGENT); }
__device__ __forceinline__ unsigned xb_xcc_id() { return (unsigned)__builtin_amdgcn_s_getreg((3 << 11) | 20) & 0xFu; }
#define XB_SPIN(cond, bar) do { unsigned _sp = 0; while (cond) { __builtin_amdgcn_s_sleep(1); \
    if ((++_sp & 255u) == 0u) { if (xb_ld(&(bar)[XB_TMO])) break; if (_sp > XB_SPIN_CAP) { atomicAdd(&(bar)[XB_TMO], 1u); break; } } } } while (0)
struct XcdBarrier { unsigned* bar; unsigned x; volatile LAS unsigned* st; };
__device__ __forceinline__ XcdBarrier xcd_barrier_post(unsigned* bar, volatile LAS unsigned* st) {
    XcdBarrier b; b.bar = bar; b.x = xb_xcc_id(); b.st = st;
    if (threadIdx.x == 0) (void)xb_add(&bar[XB_XCNT(b.x)], 1u);
    return b;
}
__device__ __forceinline__ void xcd_barrier_complete(unsigned* bar, unsigned x, unsigned& nloc, unsigned& nx) {
    const unsigned G = gridDim.x * gridDim.y * gridDim.z;
    unsigned sum, cnt, mine, sp = 0u;
    for (;;) {
        sum = 0u; cnt = 0u; mine = 0u;
#pragma unroll
        for (unsigned j = 0; j < 16; ++j) { const unsigned c = xb_ld(&bar[XB_XCNT(j)]); sum += c; cnt += (c > 0u) ? 1u : 0u; mine = (j == x) ? c : mine; }
        if (sum == G) break;
        __builtin_amdgcn_s_sleep(1);
        if ((++sp & 255u) == 0u) { if (xb_ld(&bar[XB_TMO])) break; if (sp > XB_SPIN_CAP) { atomicAdd(&bar[XB_TMO], 1u); break; } }
    }
    nloc = mine > 0u ? mine : 1u; nx = cnt > 0u ? cnt : 1u;
}
__device__ __forceinline__ void xcd_barrier(const XcdBarrier& b) {
    asm volatile("s_waitcnt vmcnt(0)" ::: "memory");
    __syncthreads();
    if (threadIdx.x == 0) {
        unsigned* bar = b.bar;
        __builtin_amdgcn_s_waitcnt(0);
        unsigned nloc = b.st[0], nx = b.st[1];
        if (nloc == 0u) { xcd_barrier_complete(bar, b.x, nloc, nx); b.st[0] = nloc; b.st[1] = nx; }
        const unsigned old = xb_add(&bar[XB_XSUB(b.x)], 1u);
        const unsigned gen = old / nloc;
        if (old + 1u == (gen + 1u) * nloc) {
            __builtin_amdgcn_fence(__ATOMIC_RELEASE, "agent");
            asm volatile("s_waitcnt vmcnt(0)" ::: "memory");
            const unsigned og = xb_add(&bar[XB_TOP], 1u);
            const unsigned tg = og / nx;
            if (og + 1u == (tg + 1u) * nx) xb_add(&bar[XB_TOPGEN], 1u);
            else XB_SPIN(xb_ld(&bar[XB_TOPGEN]) == tg, bar);
            __builtin_amdgcn_fence(__ATOMIC_ACQUIRE, "agent");
            xb_add(&bar[XB_XGEN(b.x)], 1u);
            asm volatile("s_waitcnt vmcnt(0)" ::: "memory");
        } else {
            XB_SPIN(xb_ld(&bar[XB_XGEN(b.x)]) == gen, bar);
            __builtin_amdgcn_fence(__ATOMIC_ACQUIRE, "agent");
            asm volatile("s_waitcnt vmcnt(0)" ::: "memory");
        }
    }
    __syncthreads();
}

struct EpiIn {
    static constexpr bool PERM = true;
    bf16* PA; bf16* PB; const float* lb;
    __device__ __forceinline__ bool swap(const pg8::Unit& u) const { return u.pn >= 10; }
    __device__ __forceinline__ void operator()(const f32x4 (&acc)[2][2][4][2], const pg8::Unit& u, int wr, int wc, int fr, int fq) const {
        if (u.pn < 10) {
            const int type = u.pn >> 1;
            const int row0 = u.pm * 256 + wr * 64 + fr, col0 = u.pn * 256 + wc * 32 + 8 * fq;
#pragma unroll
            for (int bj = 0; bj < 2; ++bj) {
                float lbv[8];
#pragma unroll
                for (int e = 0; e < 8; ++e) lbv[e] = (type == 1 || type == 2) ? lb[col0 + bj * 128 + e - 512] : 0.f;
#pragma unroll
                for (int ai = 0; ai < 2; ++ai)
#pragma unroll
                    for (int m = 0; m < 4; ++m) {
                        bf16* rowp = PA + (size_t)(row0 + ai * 128 + m * 16) * PA_LD + col0 + bj * 128;
                        float x[8];
#pragma unroll
                        for (int e = 0; e < 4; ++e) { x[e] = acc[ai][bj][m][0][e]; x[4 + e] = acc[ai][bj][m][1][e]; }
                        v4u w;
                        if (type == 0) {
#pragma unroll
                            for (int e = 0; e < 8; ++e) x[e] = silu_f(x[e]);
                            w.x = pk2(x[0], x[1]); w.y = pk2(x[2], x[3]); w.z = pk2(x[4], x[5]); w.w = pk2(x[6], x[7]);
                        } else if (type == 1 || type == 2) {
#pragma unroll
                            for (int e = 0; e < 8; ++e) x[e] = lbv[e] + (1.0f - lbv[e]) * sigmoid_f(x[e]);
                            w.x = pk2h(x[0], x[1]); w.y = pk2h(x[2], x[3]); w.z = pk2h(x[4], x[5]); w.w = pk2h(x[6], x[7]);
                        } else {
                            w.x = pk2(x[0], x[1]); w.y = pk2(x[2], x[3]); w.z = pk2(x[4], x[5]); w.w = pk2(x[6], x[7]);
                        }
                        *(v4u*)rowp = w;
                        asm volatile("" ::: "memory");
                    }
            }
        } else {
#pragma unroll
            for (int ai = 0; ai < 2; ++ai)
#pragma unroll
                for (int m = 0; m < 4; ++m) {
                    const int cw = u.pn * 256 + ai * 128 + wr * 64 + m * 16 + fr;
                    bf16* colp = PB + (size_t)(cw - 2560) * MTOK + u.pm * 256 + wc * 32 + 8 * fq;
#pragma unroll
                    for (int bj = 0; bj < 2; ++bj) {
                        const f32x4 v0 = acc[ai][bj][m][0], v1 = acc[ai][bj][m][1];
                        v4u w; w.x = pk2(v0[0], v0[1]); w.y = pk2(v0[2], v0[3]); w.z = pk2(v1[0], v1[1]); w.w = pk2(v1[2], v1[3]);
                        *(v4u*)(colp + bj * 128) = w;
                    }
                }
        }
    }
};
struct EpiOut {
    static constexpr bool PERM = false;
    const float* xin_lat; float* out_lat; const float* xin_ctx; float* out_ctx; const float* mod;
    __device__ __forceinline__ bool swap(const pg8::Unit&) const { return false; }
    __device__ __forceinline__ void operator()(const f32x4 (&acc)[2][2][4][2], const pg8::Unit& u, int wr, int wc, int fr, int fq) const {
        const bool isctx = u.pm >= 128;
        const int col0 = u.pn * 256 + wc * 32 + 4 * fq;
#pragma unroll
        for (int ai = 0; ai < 2; ++ai)
#pragma unroll
            for (int m = 0; m < 4; ++m) {
                const int row = u.pm * 256 + ai * 128 + wr * 64 + m * 16 + fr;
                const int rl = isctx ? row - MLAT : row;
                const int mr = isctx ? 8 : (row >> 12);
                const float* xi = (isctx ? xin_ctx : xin_lat) + (size_t)rl * D + col0;
                float* xo = (isctx ? out_ctx : out_lat) + (size_t)rl * D + col0;
                const float* gt = mod + (size_t)mr * 3 * D + 2 * D + col0;
#pragma unroll
                for (int bj = 0; bj < 2; ++bj)
#pragma unroll
                    for (int n = 0; n < 2; ++n) {
                        const int o = bj * 128 + n * 16;
                        const f32x4 xv = *(const f32x4*)(xi + o), gv = *(const f32x4*)(gt + o);
                        *(f32x4*)(xo + o) = xv + gv * acc[ai][bj][m][n];
                    }
            }
    }
};

struct Args {
    const float* in[23]; float* out; unsigned char* ws; int ph_lo, ph_hi;
};

struct Frame {
    LAS unsigned char* lds; int tid, lane, wave, vcu, G;
};

__device__ __forceinline__ void p0_transpose_item(const float* W, int K, int N, bf16* WT, LAS float* scr, int item, int lane) {
    const int nblk = N / 32, kb = item / nblk, nb = item % nblk, k0 = 64 * kb, n0 = 32 * nb;
#pragma unroll 8
    for (int i = 0; i < 32; ++i) { const int kk = 2 * i + (lane >> 5); scr[kk * 33 + (lane & 31)] = W[(size_t)(k0 + kk) * N + n0 + (lane & 31)]; }
    asm volatile("s_waitcnt lgkmcnt(0)" ::: "memory");
    const int c = lane & 7;
#pragma unroll
    for (int j = 0; j < 4; ++j) { const int n = (lane >> 3) + 8 * j; const LAS float* s = scr + (8 * c) * 33 + n;
        v4u o; o.x = pk2(s[0 * 33], s[1 * 33]); o.y = pk2(s[2 * 33], s[3 * 33]); o.z = pk2(s[4 * 33], s[5 * 33]); o.w = pk2(s[6 * 33], s[7 * 33]);
        *(v4u*)(WT + (size_t)(n0 + n) * K + k0 + 8 * c) = o; }
    asm volatile("s_waitcnt lgkmcnt(0)" ::: "memory");
}

__device__ __forceinline__ void phase_prologue(const Args& a, Frame& F) {
    unsigned char* ws = a.ws;
    {
        LAS float* scr = (LAS float*)(F.lds + F.wave * 16384);
        const int gw = F.vcu * NWAVES + F.wave, NGW = F.G * NWAVES;
        constexpr int I_IN = (D / 64) * (NIN / 32), I_OUT = (D / 64) * (D / 32);
        for (int it = gw; it < 2 * (I_IN + I_OUT); it += NGW) {
            int r = it; const int l = r / (I_IN + I_OUT); r -= l * (I_IN + I_OUT);
            if (r < I_IN) p0_transpose_item(a.in[7] + (size_t)l * D * NIN, D, NIN, (bf16*)(ws + WS_WIN) + (size_t)l * NIN * D, scr, r, F.lane);
            else p0_transpose_item(a.in[8] + (size_t)l * D * D, D, D, (bf16*)(ws + WS_WOUT) + (size_t)l * D * D, scr, r - I_IN, F.lane);
        }
    }
    __syncthreads();
    if (F.vcu == 0) {
        float* lbs = (float*)(ws + WS_LBS);
        for (int i = F.tid; i < 1024; i += NTHR) {
            const float a0 = a.in[9][i], a1 = a.in[9][1024 + i];
            const float m = fmaxf(a0, a1), e0 = expf(a0 - m), e1 = expf(a1 - m);
            const float p0 = e0 / (e0 + e1), p1 = e1 / (e0 + e1);
            const float c0 = p0, c1 = p0 + p1;
            lbs[i] = c0 - c0; lbs[1024 + i] = c1 - c0;
        }
    }
    {
        LAS float* sv = (LAS float*)F.lds;
        LAS float* part = sv + 9 * 1024;
        for (int task = F.vcu; task < 96; task += F.G) {
            const int l = task / 48, n0 = (task % 48) * 64;
            for (int e = F.tid; e < 9 * 1024; e += NTHR) { const int r = e >> 10, k = e & 1023; const float cv = r < 8 ? a.in[1][r * D + k] : a.in[3][k]; sv[e] = cv / (1.0f + expf(-cv)); }
            __syncthreads();
            float acc9[9];
#pragma unroll
            for (int r = 0; r < 9; ++r) acc9[r] = 0.f;
            const float* w = a.in[5] + (size_t)l * D * 3 * D + n0 + F.lane;
            for (int k = F.wave * 128; k < F.wave * 128 + 128; ++k) {
                const float wv = w[(size_t)k * 3 * D];
#pragma unroll
                for (int r = 0; r < 9; ++r) acc9[r] += sv[r * 1024 + k] * wv;
            }
#pragma unroll
            for (int r = 0; r < 9; ++r) part[(F.wave * 9 + r) * 64 + F.lane] = acc9[r];
            __syncthreads();
            for (int e = F.tid; e < 9 * 64; e += NTHR) {
                const int r = e >> 6, c = e & 63; float s = 0.f;
#pragma unroll
                for (int w8 = 0; w8 < 8; ++w8) s += part[(w8 * 9 + r) * 64 + c];
                ((float*)(ws + WS_MOD))[((size_t)l * 9 + r) * 3 * D + n0 + c] = s + a.in[6][l * 3 * D + n0 + c];
            }
            __syncthreads();
        }
    }
    {
        LAS float* zs = (LAS float*)F.lds;
        LAS float* h3s = zs + 8 * 64;
        float* nrm = (float*)(ws + WS_CTL) + CW_NORM;
        for (int task = F.vcu; task < 1056; task += F.G) {
            const int set = task < 512 ? 0 : (task < 1024 ? 1 : 2);
            const int L = set == 2 ? 256 : 4096, l = set == 1 ? 1 : 0;
            const int n0 = (set == 0 ? task : set == 1 ? task - 512 : task - 1024) * 8;
            const int n = n0 + F.wave, j = F.lane;
            LAS float* zw = zs + F.wave * 64;
            if (j == 0) zw[0] = (float)n / (float)(L - 1);
            if (j >= 1 && j < 33) {
                const int i = (j - 1) & 15;
                const double f = 1e-4 + (double)i * ((15.0 - 1e-4) / 15.0);
                double rev = f * (double)n / (double)L; rev -= floor(rev);
                const float ang = (float)(rev * 6.283185307179586476925);
                zw[j] = (j <= 16) ? cosf(ang) : -sinf(ang);
            }
            asm volatile("s_waitcnt lgkmcnt(0)" ::: "memory");
            const float* w1 = a.in[13] + l * 33 * 64; const float* b1 = a.in[14] + l * 64; const float fr = a.in[15][l * 64 + j];
            const float* w2 = a.in[16] + l * 4096; const float* b2 = a.in[17] + l * 64; const float* w3 = a.in[18] + l * 4096; const float* b3 = a.in[19] + l * 64;
            float s = b1[j];
            for (int e = 0; e < 33; ++e) s += zw[e] * w1[e * 64 + j];
            const float h1 = sinf(fr * s);
            asm volatile("s_waitcnt lgkmcnt(0)" ::: "memory");
            zw[j] = h1;
            asm volatile("s_waitcnt lgkmcnt(0)" ::: "memory");
            s = b2[j];
            for (int e = 0; e < 64; ++e) s += zw[e] * w2[e * 64 + j];
            const float h2 = sinf(fr * s);
            asm volatile("s_waitcnt lgkmcnt(0)" ::: "memory");
            zw[j] = h2;
            asm volatile("s_waitcnt lgkmcnt(0)" ::: "memory");
            s = b3[j];
            for (int e = 0; e < 64; ++e) s += zw[e] * w3[e * 64 + j];
            h3s[F.wave * 64 + j] = sinf(fr * s);
            __syncthreads();
            const int c2 = 2 * F.tid;
            const float* w4 = a.in[20] + (size_t)l * 64 * 1024 + c2;
            float acc[8][2];
#pragma unroll
            for (int p = 0; p < 8; ++p) { acc[p][0] = 0.f; acc[p][1] = 0.f; }
            for (int jj = 0; jj < 64; ++jj) {
                const float2 wv = *(const float2*)(w4 + (size_t)jj * 1024);
#pragma unroll
                for (int p = 0; p < 8; ++p) { const float hv = h3s[p * 64 + jj]; acc[p][0] += hv * wv.x; acc[p][1] += hv * wv.y; }
            }
            float* hk = (float*)(ws + WS_HK) + (size_t)set * 4096 * 1024;
            float ns[2] = {0.f, 0.f};
#pragma unroll
            for (int e = 0; e < 2; ++e) {
                const int cc = c2 + e, c = cc & 511;
                const float delta = fabsf(HY_MIN_DECAY + (float)c * ((HY_MAX_DECAY - HY_MIN_DECAY) / 511.0f));
#pragma unroll
                for (int p = 0; p < 8; ++p) {
                    const int nn = n0 + p; const float t = (float)nn / (float)(L - 1);
                    const float v = acc[p][e] * expf(-t * delta);
                    hk[(size_t)nn * 1024 + cc] = v;
                    if (cc < 512 || nn >= 1) ns[e] += fabsf(v);
                }
            }
            atomicAdd(&nrm[set * 512 + (c2 & 511)], ns[0]);
            atomicAdd(&nrm[set * 512 + ((c2 + 1) & 511)], ns[1]);
            __syncthreads();
        }
    }
}

__device__ __forceinline__ void phase_normrows(const Args& a, Frame& F, int l, const float* xlat, const float* xctx) {
    unsigned char* ws = a.ws;
    const float* nw = a.in[4] + l * D;
    const float* mod = (const float*)(ws + WS_MOD) + (size_t)l * 9 * 3 * D;
    bf16* XA = (bf16*)(ws + WS_XA);
    const int gw = F.vcu * NWAVES + F.wave, NGW = F.G * NWAVES;
    for (int tok = gw; tok < MTOK; tok += NGW) {
        const bool isctx = tok >= MLAT;
        const float* xr = isctx ? xctx + (size_t)(tok - MLAT) * D : xlat + (size_t)tok * D;
        const int mr = isctx ? 8 : (tok >> 12);
        const float* sh = mod + (size_t)mr * 3 * D; const float* sc = sh + D;
        f32x4 v[4]; float s = 0.f;
#pragma unroll
        for (int j = 0; j < 4; ++j) { v[j] = *(const f32x4*)(xr + 256 * j + 4 * F.lane); s += (v[j].x * v[j].x + v[j].y * v[j].y) + (v[j].z * v[j].z + v[j].w * v[j].w); }
        const float rstd = 1.0f / sqrtf(wave_sum(s) * (1.0f / D) + EPS);
#pragma unroll
        for (int j = 0; j < 4; ++j) {
            const int k = 256 * j + 4 * F.lane;
            const f32x4 w4 = *(const f32x4*)(nw + k), s4 = *(const f32x4*)(sc + k), h4 = *(const f32x4*)(sh + k);
            const f32x4 y = v[j] * rstd * w4 * (s4 + 1.0f) + h4;
            v2u o; o.x = pk2(y.x, y.y); o.y = pk2(y.z, y.w);
            *(v2u*)(XA + (size_t)tok * D + k) = o;
        }
    }
}
__device__ __forceinline__ void phase_filter_finalize(const Args& a, Frame& F) {
    unsigned char* ws = a.ws;
    LAS float* scr = (LAS float*)(F.lds + F.wave * 16640);
    const int gw = F.vcu * NWAVES + F.wave, NGW = F.G * NWAVES;
    constexpr int T01 = 8 * (FZ / 64), T2 = 8 * (FZC / 64);
    for (int it = gw; it < 2 * T01 + T2; it += NGW) {
        const int set = it < T01 ? 0 : (it < 2 * T01 ? 1 : 2);
        const int r = it - (set == 0 ? 0 : set == 1 ? T01 : 2 * T01);
        const int L = set == 2 ? 256 : 4096, nzt = (set == 2 ? FZC : FZ) / 64;
        const int ct = r / nzt, zt = r % nzt, c0 = ct * 64, z0 = zt * 64;
        const float* hk = (const float*)(ws + WS_HK) + (size_t)set * 4096 * 1024;
        for (int zz = 0; zz < 64; ++zz) {
            const int lag = L - (z0 + zz); float v = 0.f;
            if (lag >= 0 && lag <= L - 1) v = hk[(size_t)lag * 1024 + c0 + F.lane];
            else if (lag < 0 && -lag <= L - 1) v = hk[(size_t)(-lag) * 1024 + 512 + c0 + F.lane];
            scr[zz * 65 + F.lane] = v;
        }
        asm volatile("s_waitcnt lgkmcnt(0)" ::: "memory");
        bf16* dst = set == 2 ? (bf16*)(ws + WS_FGC) : (bf16*)(ws + WS_FG) + (size_t)set * 512 * FZ;
        const int ld = set == 2 ? FZC : FZ;
        for (int cc = 0; cc < 64; ++cc) dst[(size_t)(c0 + cc) * ld + z0 + F.lane] = (bf16)f2bf(scr[F.lane * 65 + cc]);
        asm volatile("s_waitcnt lgkmcnt(0)" ::: "memory");
    }
}


namespace scan {
typedef short bf16x8 __attribute__((ext_vector_type(8)));
typedef short bf16x4 __attribute__((ext_vector_type(4)));
constexpr int QI_RS = 272, KT_RS = 160, AI_RS = 160;
constexpr int OFF_QI = 0, OFF_KI = 17408, OFF_KT = 34816, OFF_VT = 55296, OFF_AI = 75776, OFF_SEG = 86016, OFF_SCL = 90112, LDS_END = 91648;
#define MFMA16(a, b, c) __builtin_amdgcn_mfma_f32_16x16x32_bf16((a), (b), (c), 0, 0, 0)
__device__ __forceinline__ bf16x8 ld_perm(const LAS unsigned char* p) {
    const bf16x4 lo = *(const LAS bf16x4*)p, hi = *(const LAS bf16x4*)(p + 32);
    return __builtin_shufflevector(lo, hi, 0, 1, 2, 3, 4, 5, 6, 7);
}
__device__ __forceinline__ int tok_row(int g, int i, int b, int dir) {
    if (g < 4) { const int t = 64 * g + i; return MLAT + b * LCX + (dir ? (LCX - 1 - t) : t); }
    const int t = 64 * (g - 4) + i; return b * LX + (dir ? (LX - 1 - t) : t);
}
__device__ __forceinline__ void scan_unit(LAS unsigned char* lds, bf16* PA, bf16* OC, const int b, const int h, const int dir, const bool ctxunit) {
    const int tid = threadIdx.x, lane = tid & 63, w = __builtin_amdgcn_readfirstlane(tid >> 6);
    const int l15 = lane & 15, q = lane >> 4;
    for (int e = tid; e < (64 * AI_RS) / 4; e += NTHR) ((LAS unsigned*)(lds + OFF_AI))[e] = 0u;
    f32x4 S[8];
#pragma unroll
    for (int kt = 0; kt < 8; ++kt) S[kt] = (f32x4){0.f, 0.f, 0.f, 0.f};
    const int nchunk = ctxunit ? 4 : 68;
    const int colq = h * HD + 2 * lane;
    unsigned rq[8], rf[8], rv[8];
#define SCAN_LOAD(g) do { _Pragma("unroll") for (int e = 0; e < 8; ++e) { const bf16* p_ = PA + (size_t)tok_row((g), 8 * w + e, b, dir) * PA_LD + colq; \
        rq[e] = *(const unsigned*)p_; rf[e] = *(const unsigned*)(p_ + 512 + dir * 512); rv[e] = *(const unsigned*)(p_ + 1536); } } while (0)
    SCAN_LOAD(0);
    __syncthreads();
    for (int g = 0; g < nchunk; ++g) {
        const bool do_o = ctxunit || g >= 4;
        float fa[8], fb[8], pa[8], pb[8];
#pragma unroll
        for (int e = 0; e < 8; ++e) { fa[e] = h2f((unsigned short)(rf[e] & 0xffffu)); fb[e] = h2f((unsigned short)(rf[e] >> 16)); }
        pa[0] = fa[0]; pb[0] = fb[0];
#pragma unroll
        for (int e = 1; e < 8; ++e) { pa[e] = pa[e - 1] * fa[e]; pb[e] = pb[e - 1] * fb[e]; }
        { LAS float* sg = (LAS float*)(lds + OFF_SEG) + w * 128 + 2 * lane; sg[0] = pa[7]; sg[1] = pb[7]; }
        __syncthreads();
        {
            const LAS float* seg = (const LAS float*)(lds + OFF_SEG) + 2 * lane;
            float ma = 1.f, mb = 1.f;
            if (w >= 4) {
#pragma unroll
                for (int s2 = 4; s2 < 7; ++s2) if (s2 < w) { ma *= seg[s2 * 128]; mb *= seg[s2 * 128 + 1]; }
            } else {
#pragma unroll
                for (int s2 = 1; s2 < 4; ++s2) if (s2 > w) { ma *= seg[s2 * 128]; mb *= seg[s2 * 128 + 1]; }
            }
            float xa[8], xb[8];
            if (w >= 4) {
#pragma unroll
                for (int e = 0; e < 8; ++e) { xa[e] = ma * pa[e]; xb[e] = mb * pb[e]; }
            } else {
                float sa = ma, sb = mb;
#pragma unroll
                for (int e = 7; e >= 0; --e) { xa[e] = sa; xb[e] = sb; sa *= fa[e]; sb *= fb[e]; }
            }
            unsigned kta[8], ktb[8];
#pragma unroll
            for (int e = 0; e < 8; ++e) {
                const float qa = bf2f((unsigned short)(rq[e] & 0xffffu)), qb = bf2f((unsigned short)(rq[e] >> 16));
                const float ka = 1.0f - fa[e], kb = 1.0f - fb[e];
                const float ra = __builtin_amdgcn_rcpf(fmaxf(xa[e], 1e-30f)), rb = __builtin_amdgcn_rcpf(fmaxf(xb[e], 1e-30f));
                float Qa, Qb, Ka, Kb;
                if (w >= 4) { Qa = qa * xa[e]; Qb = qb * xb[e]; Ka = ka * ra; Kb = kb * rb; }
                else { Qa = qa * ra; Qb = qb * rb; Ka = ka * xa[e]; Kb = kb * xb[e]; }
                const int i = 8 * w + e;
                kta[e] = f2bf(Ka); ktb[e] = f2bf(Kb);
                *(LAS unsigned*)(lds + OFF_QI + i * QI_RS + 4 * lane) = pk2(Qa, Qb);
                *(LAS unsigned*)(lds + OFF_KI + i * QI_RS + 4 * lane) = kta[e] | (ktb[e] << 16);
            }
            v4u t0, t1, u0, u1;
#pragma unroll
            for (int e = 0; e < 4; ++e) {
                t0[e] = kta[2 * e] | (kta[2 * e + 1] << 16); t1[e] = ktb[2 * e] | (ktb[2 * e + 1] << 16);
                u0[e] = (rv[2 * e] & 0xffffu) | (rv[2 * e + 1] << 16); u1[e] = (rv[2 * e] >> 16) | (rv[2 * e + 1] & 0xffff0000u);
            }
            *(LAS v4u*)(lds + OFF_KT + (2 * lane) * KT_RS + 16 * w) = t0;
            *(LAS v4u*)(lds + OFF_KT + (2 * lane + 1) * KT_RS + 16 * w) = t1;
            *(LAS v4u*)(lds + OFF_VT + (2 * lane) * KT_RS + 16 * w) = u0;
            *(LAS v4u*)(lds + OFF_VT + (2 * lane + 1) * KT_RS + 16 * w) = u1;
            if (w == 0) {
                float gma = 1.f, gmb = 1.f, gea = 1.f, geb = 1.f;
#pragma unroll
                for (int s2 = 0; s2 < 4; ++s2) { gma *= seg[s2 * 128]; gmb *= seg[s2 * 128 + 1]; }
#pragma unroll
                for (int s2 = 4; s2 < 8; ++s2) { gea *= seg[s2 * 128]; geb *= seg[s2 * 128 + 1]; }
                LAS float* scl = (LAS float*)(lds + OFF_SCL) + 2 * lane;
                scl[0] = gma; scl[1] = gmb; scl[128] = gea; scl[129] = geb; scl[256] = gma * gea; scl[257] = gmb * geb;
            }
        }
        if (g + 1 < nchunk) SCAN_LOAD(g + 1);
        __syncthreads();
        if (do_o) {
            for (int tt = w; tt < 10; tt += 8) {
                const int jt = tt < 4 ? 0 : (tt < 7 ? 1 : (tt < 9 ? 2 : 3)), it = tt < 4 ? tt : (tt < 7 ? tt - 3 : (tt < 9 ? tt - 5 : 3));
                f32x4 a4 = (f32x4){0.f, 0.f, 0.f, 0.f};
#pragma unroll
                for (int ks = 0; ks < 4; ++ks)
                    a4 = MFMA16(ld_perm(lds + OFF_KI + (16 * jt + l15) * QI_RS + (32 * ks + 4 * q) * 2), ld_perm(lds + OFF_QI + (16 * it + l15) * QI_RS + (32 * ks + 4 * q) * 2), a4);
#pragma unroll
                for (int r = 0; r < 4; ++r) a4[r] = (16 * jt + 4 * q + r <= 16 * it + l15) ? a4[r] : 0.f;
                v2u wv; wv.x = pk2(a4[0], a4[1]); wv.y = pk2(a4[2], a4[3]);
                *(LAS v2u*)(lds + OFF_AI + (16 * it + l15) * AI_RS + (16 * jt + 4 * q) * 2) = wv;
            }
            __syncthreads();
        }
        const bf16x8 vt0 = *(const LAS bf16x8*)(lds + OFF_VT + (16 * w + l15) * KT_RS + 16 * q);
        const bf16x8 vt1 = *(const LAS bf16x8*)(lds + OFF_VT + (16 * w + l15) * KT_RS + 64 + 16 * q);
        if (do_o) {
            f32x4 O[4];
#pragma unroll
            for (int it = 0; it < 4; ++it) O[it] = (f32x4){0.f, 0.f, 0.f, 0.f};
#pragma unroll
            for (int ks = 0; ks < 4; ++ks) {
                const f32x4 m0 = *(const LAS f32x4*)(lds + OFF_SCL + (32 * ks + 4 * q) * 4), m1 = *(const LAS f32x4*)(lds + OFF_SCL + (32 * ks + 16 + 4 * q) * 4);
                const f32x4 s0 = S[2 * ks] * m0, s1 = S[2 * ks + 1] * m1;
                v4u pk; pk.x = pk2(s0[0], s0[1]); pk.y = pk2(s0[2], s0[3]); pk.z = pk2(s1[0], s1[1]); pk.w = pk2(s1[2], s1[3]);
                const bf16x8 sf = __builtin_bit_cast(bf16x8, pk);
#pragma unroll
                for (int it = 0; it < 4; ++it) O[it] = MFMA16(sf, ld_perm(lds + OFF_QI + (16 * it + l15) * QI_RS + (32 * ks + 4 * q) * 2), O[it]);
            }
#pragma unroll
            for (int it = 0; it < 4; ++it) {
                O[it] = MFMA16(vt0, *(const LAS bf16x8*)(lds + OFF_AI + (16 * it + l15) * AI_RS + 16 * q), O[it]);
                if (it >= 2) O[it] = MFMA16(vt1, *(const LAS bf16x8*)(lds + OFF_AI + (16 * it + l15) * AI_RS + 64 + 16 * q), O[it]);
            }
#pragma unroll
            for (int it = 0; it < 4; ++it) {
                const int row = tok_row(g, 16 * it + l15, b, dir);
                v2u wv; wv.x = pk2(O[it][0], O[it][1]); wv.y = pk2(O[it][2], O[it][3]);
                bf16* dst = (g < 4) ? OC + (size_t)dir * MCTX * 512 + (size_t)(row - MLAT) * 512 + h * HD + 16 * w + 4 * q
                                    : PA + (size_t)row * PA_LD + 512 + dir * 512 + h * HD + 16 * w + 4 * q;
                *(v2u*)dst = wv;
            }
        }
#pragma unroll
        for (int kt = 0; kt < 8; ++kt) {
            f32x4 d4 = (f32x4){0.f, 0.f, 0.f, 0.f};
            d4 = MFMA16(*(const LAS bf16x8*)(lds + OFF_KT + (16 * kt + l15) * KT_RS + 16 * q), vt0, d4);
            d4 = MFMA16(*(const LAS bf16x8*)(lds + OFF_KT + (16 * kt + l15) * KT_RS + 64 + 16 * q), vt1, d4);
            const f32x4 gem = *(const LAS f32x4*)(lds + OFF_SCL + 512 + (16 * kt + 4 * q) * 4), ge = *(const LAS f32x4*)(lds + OFF_SCL + 1024 + (16 * kt + 4 * q) * 4);
            S[kt] = ge * S[kt] + gem * d4;
        }
    }
#undef SCAN_LOAD
}
}

__device__ __forceinline__ void phase_scan(const Args& a, Frame& F, int l) {
    const int nunits = l == 0 ? 128 : 64;
    for (int u = F.vcu; u < nunits; u += F.G) {
        const int uu = u & 63;
        scan::scan_unit(F.lds, (bf16*)(a.ws + WS_PA), (bf16*)(a.ws + WS_OC), uu >> 3, (uu >> 1) & 3, uu & 1, u >= 64);
        __syncthreads();
    }
}


namespace hy {
typedef short bf16x8 __attribute__((ext_vector_type(8)));
typedef short bf16x4 __attribute__((ext_vector_type(4)));
constexpr int CS = 16448;
constexpr int OFF_F = 0, OFF_V = 4 * CS, V_ROWS = 528, LDS_END = OFF_V + V_ROWS * 128;
static_assert(LDS_END <= LDS_BYTES - 256, "hyena LDS");
struct ConvW { float x0[4], x1[4], v[4]; };
__device__ __forceinline__ ConvW load_convw(const Args& a, int l, int c) {
    const float* cw = a.in[11] + (size_t)l * 3 * 1536; const float* cb = a.in[12] + (size_t)l * 1536; ConvW r;
#pragma unroll
    for (int j = 0; j < 3; ++j) { r.x0[j] = cw[j * 1536 + c]; r.x1[j] = cw[j * 1536 + 512 + c]; r.v[j] = cw[j * 1536 + 1024 + c]; }
    r.x0[3] = cb[c]; r.x1[3] = cb[512 + c]; r.v[3] = cb[1024 + c];
    return r;
}
__device__ __forceinline__ void hyena_channel(LAS unsigned char* lds, const Args& a, const int l, const int c) {
    const int tid = threadIdx.x, lane = tid & 63, w = __builtin_amdgcn_readfirstlane(tid >> 6), l15 = lane & 15, q = lane >> 4;
    unsigned char* ws = a.ws;
    const bf16* PB = (const bf16*)(ws + WS_PB);
    const bf16* x0r = PB + (size_t)c * MTOK; const bf16* x1r = PB + (size_t)(512 + c) * MTOK; const bf16* vr = PB + (size_t)(1024 + c) * MTOK; const bf16* gbr = PB + (size_t)(1536 + c) * MTOK;
    const ConvW cw = load_convw(a, l, c);
    {
        const bf16* F = (const bf16*)(ws + WS_FG) + ((size_t)l * 512 + c) * FZ;
        for (int ch = tid; ch < 1024; ch += NTHR) {
            const v4u cur = *(const v4u*)(F + 8 * ch); v4u prev = (v4u){0u, 0u, 0u, 0u};
            if (ch > 0) prev = *(const v4u*)(F + 8 * ch - 8);
            const unsigned W[8] = {prev.x, prev.y, prev.z, prev.w, cur.x, cur.y, cur.z, cur.w};
            v4u c1, c2, c3;
#pragma unroll
            for (int d = 0; d < 4; ++d) { c1[d] = (W[3 + d] >> 16) | (W[4 + d] << 16); c2[d] = W[3 + d]; c3[d] = (W[2 + d] >> 16) | (W[3 + d] << 16); }
            *(LAS v4u*)(lds + OFF_F + 0 * CS + 16 * ch) = cur;
            *(LAS v4u*)(lds + OFF_F + 1 * CS + 16 * ch) = c1;
            *(LAS v4u*)(lds + OFF_F + 2 * CS + 16 * ch) = c2;
            *(LAS v4u*)(lds + OFF_F + 3 * CS + 16 * ch) = c3;
        }
    }
    {
        if (tid < 256) { const int r = tid >> 5, d = tid & 31; ((LAS unsigned*)(lds + OFF_V + r * 128))[d] = 0u; ((LAS unsigned*)(lds + OFF_V + (520 + r) * 128))[d] = 0u; }
        for (int e = tid; e < 4096; e += NTHR) {
            const int b = e >> 9, t0 = (e & 511) * 8, ab = t0 >> 6, ch = (t0 & 63) >> 3;
            const size_t base = (size_t)b * LX + t0;
            const v4u vw = *(const v4u*)(vr + base), xw = *(const v4u*)(x1r + base);
            float vv[10], xx[10];
            vv[0] = t0 > 0 ? bf2f(vr[base - 1]) : 0.f; xx[0] = t0 > 0 ? bf2f(x1r[base - 1]) : 0.f;
            vv[9] = t0 + 8 < LX ? bf2f(vr[base + 8]) : 0.f; xx[9] = t0 + 8 < LX ? bf2f(x1r[base + 8]) : 0.f;
#pragma unroll
            for (int d = 0; d < 4; ++d) { vv[1 + 2 * d] = bf2f((unsigned short)(vw[d] & 0xffffu)); vv[2 + 2 * d] = bf2f((unsigned short)(vw[d] >> 16));
                                          xx[1 + 2 * d] = bf2f((unsigned short)(xw[d] & 0xffffu)); xx[2 + 2 * d] = bf2f((unsigned short)(xw[d] >> 16)); }
            float p[8];
#pragma unroll
            for (int d = 0; d < 8; ++d) p[d] = (cw.v[3] + cw.v[0] * vv[d] + cw.v[1] * vv[d + 1] + cw.v[2] * vv[d + 2]) * (cw.x1[3] + cw.x1[0] * xx[d] + cw.x1[1] * xx[d + 1] + cw.x1[2] * xx[d + 2]);
            v4u o; o.x = pk2(p[0], p[1]); o.y = pk2(p[2], p[3]); o.z = pk2(p[4], p[5]); o.w = pk2(p[6], p[7]);
            const int R = (ab + 1) * 8 + b;
            *(LAS v4u*)(lds + OFF_V + R * 128 + 16 * (ch ^ ((R >> 1) & 7))) = o;
        }
    }
    __syncthreads();
    f32x4 acc[4][4];
#pragma unroll
    for (int mt = 0; mt < 4; ++mt)
#pragma unroll
        for (int nt = 0; nt < 4; ++nt) acc[mt][nt] = (f32x4){0.f, 0.f, 0.f, 0.f};
    {
        const LAS unsigned char* fb = lds + OFF_F + (l15 & 3) * CS + (4096 - 4 * (l15 >> 2) + 8 * q) * 2;
        const int rowl = (l15 >> 3) * 8 + (l15 & 7);
        for (int m = 8 * w - 63; m <= 8 * w + 7; ++m) {
#pragma unroll
            for (int ks = 0; ks < 2; ++ks) {
                bf16x8 A[4];
#pragma unroll
                for (int mt = 0; mt < 4; ++mt) {
                    const LAS unsigned char* p = fb + (-64 * m - 16 * mt + 32 * ks) * 2;
                    const bf16x4 lo = *(const LAS bf16x4*)p, hi = *(const LAS bf16x4*)(p + 8);
                    A[mt] = __builtin_shufflevector(lo, hi, 0, 1, 2, 3, 4, 5, 6, 7);
                }
#pragma unroll
                for (int nt = 0; nt < 4; ++nt) {
                    const int a0 = 8 * w + 2 * nt - m;
                    if (a0 + 1 >= 0 && a0 <= 63) {
                        const int R = (a0 + 1) * 8 + rowl;
                        const bf16x8 B = *(const LAS bf16x8*)(lds + OFF_V + R * 128 + 16 * ((4 * ks + q) ^ ((R >> 1) & 7)));
#pragma unroll
                        for (int mt = 0; mt < 4; ++mt) acc[mt][nt] = __builtin_amdgcn_mfma_f32_16x16x32_bf16(A[mt], B, acc[mt][nt], 0, 0, 0);
                    }
                }
            }
        }
    }
    {
        const float inn = 1.0f / ((const float*)(ws + WS_CTL))[CW_NORM + l * 512 + c], hb = a.in[21][l * 512 + c];
        bf16* OBT = (bf16*)(ws + WS_OBT) + (size_t)c * MTOK;
        const int b = l15 & 7;
#pragma unroll
        for (int nt = 0; nt < 4; ++nt) {
            const int ab = 8 * w + 2 * nt + (l15 >> 3), R = (ab + 1) * 8 + b;
#pragma unroll
            for (int mt = 0; mt < 4; ++mt) {
                const int t = 64 * ab + 16 * mt + 4 * q; const size_t base = (size_t)b * LX + t;
                const v2u vw = *(const LAS v2u*)(lds + OFF_V + R * 128 + 16 * ((2 * mt + (q >> 1)) ^ ((R >> 1) & 7)) + 8 * (q & 1));
                const v2u xw = *(const v2u*)(x0r + base), gw = *(const v2u*)(gbr + base);
                float xs[6];
                xs[0] = t > 0 ? bf2f(x0r[base - 1]) : 0.f; xs[5] = t + 4 < LX ? bf2f(x0r[base + 4]) : 0.f;
                xs[1] = bf2f((unsigned short)(xw.x & 0xffffu)); xs[2] = bf2f((unsigned short)(xw.x >> 16)); xs[3] = bf2f((unsigned short)(xw.y & 0xffffu)); xs[4] = bf2f((unsigned short)(xw.y >> 16));
                const float vv4[4] = {bf2f((unsigned short)(vw.x & 0xffffu)), bf2f((unsigned short)(vw.x >> 16)), bf2f((unsigned short)(vw.y & 0xffffu)), bf2f((unsigned short)(vw.y >> 16))};
                const float g4[4] = {bf2f((unsigned short)(gw.x & 0xffffu)), bf2f((unsigned short)(gw.x >> 16)), bf2f((unsigned short)(gw.y & 0xffffu)), bf2f((unsigned short)(gw.y >> 16))};
                float o[4];
#pragma unroll
                for (int r = 0; r < 4; ++r) {
                    const float x0c = cw.x0[3] + cw.x0[0] * xs[r] + cw.x0[1] * xs[r + 1] + cw.x0[2] * xs[r + 2];
                    o[r] = (acc[mt][nt][r] * inn + vv4[r] * hb) * x0c * silu_f(g4[r]);
                }
                v2u ow; ow.x = pk2(o[0], o[1]); ow.y = pk2(o[2], o[3]);
                *(v2u*)(OBT + base) = ow;
            }
        }
    }
    __syncthreads();
}
__device__ __forceinline__ void hyena_ctx_channel(LAS unsigned char* lds, const Args& a, const int c) {
    const int tid = threadIdx.x;
    unsigned char* ws = a.ws;
    const bf16* PB = (const bf16*)(ws + WS_PB);
    const bf16* x0r = PB + (size_t)c * MTOK + MLAT; const bf16* x1r = PB + (size_t)(512 + c) * MTOK + MLAT; const bf16* vr = PB + (size_t)(1024 + c) * MTOK + MLAT; const bf16* gbr = PB + (size_t)(1536 + c) * MTOK + MLAT;
    const ConvW cw = load_convw(a, 0, c);
    LAS float* vvc = (LAS float*)lds;
    LAS float* Fc = vvc + 2048;
    for (int e = tid; e < 2048; e += NTHR) {
        const int t = e & 255;
        const float vm = t > 0 ? bf2f(vr[e - 1]) : 0.f, v0 = bf2f(vr[e]), vp = t < 255 ? bf2f(vr[e + 1]) : 0.f;
        const float xm = t > 0 ? bf2f(x1r[e - 1]) : 0.f, x0 = bf2f(x1r[e]), xp = t < 255 ? bf2f(x1r[e + 1]) : 0.f;
        vvc[e] = (cw.v[3] + cw.v[0] * vm + cw.v[1] * v0 + cw.v[2] * vp) * (cw.x1[3] + cw.x1[0] * xm + cw.x1[1] * x0 + cw.x1[2] * xp);
    }
    if (tid < 512) Fc[tid] = bf2f(((const bf16*)(ws + WS_FGC))[(size_t)c * FZC + tid]);
    __syncthreads();
    const float inn = 1.0f / ((const float*)(ws + WS_CTL))[CW_NORM + 2 * 512 + c], hb = a.in[21][c];
    bf16* OBT = (bf16*)(ws + WS_OBT) + (size_t)c * MTOK + MLAT;
    const int b = tid >> 6;
#pragma unroll
    for (int i = 0; i < 4; ++i) {
        const int t = (tid & 63) + 64 * i, e = b * 256 + t;
        float s = 0.f;
        for (int s2 = 0; s2 < 256; ++s2) s += Fc[256 - t + s2] * vvc[b * 256 + s2];
        const float xm = t > 0 ? bf2f(x0r[e - 1]) : 0.f, x0 = bf2f(x0r[e]), xp = t < 255 ? bf2f(x0r[e + 1]) : 0.f;
        const float x0c = cw.x0[3] + cw.x0[0] * xm + cw.x0[1] * x0 + cw.x0[2] * xp;
        OBT[e] = (bf16)f2bf((s * inn + vvc[e] * hb) * x0c * silu_f(bf2f(gbr[e])));
    }
    __syncthreads();
}
}

__device__ __forceinline__ void phase_mix(const Args& a, Frame& F, const int l) {
    unsigned* qctr = (unsigned*)(a.ws + WS_CTL) + CW_QUEUE + 64 * l;
    volatile LAS int* slot = (volatile LAS int*)(F.lds + LDS_BYTES - 64);
    const int ntasks = l == 0 ? 64 + 512 + 64 + 512 : 64 + 512;
    for (;;) {
        if (F.tid == 0) slot[0] = (int)atomicAdd(qctr, 1u);
        __syncthreads();
        const int t = slot[0];
        __syncthreads();
        if (t >= ntasks) break;
        if (t < 64) scan::scan_unit(F.lds, (bf16*)(a.ws + WS_PA), (bf16*)(a.ws + WS_OC), t >> 3, (t >> 1) & 3, t & 1, false);
        else if (t < 576) hy::hyena_channel(F.lds, a, l, t - 64);
        else if (t < 640) { const int u = t - 576; scan::scan_unit(F.lds, (bf16*)(a.ws + WS_PA), (bf16*)(a.ws + WS_OC), u >> 3, (u >> 1) & 3, u & 1, true); }
        else hy::hyena_ctx_channel(F.lds, a, t - 640);
        __syncthreads();
    }
}

__device__ __forceinline__ void phase_finalize_ox(const Args& a, Frame& F, int l) {
    unsigned char* ws = a.ws;
    const bf16* PA = (const bf16*)(ws + WS_PA);
    const bf16* OC = (const bf16*)(ws + WS_OC);
    bf16* XA = (bf16*)(ws + WS_XA);
    const float* gnw = a.in[10] + l * 512;
    const int gw = F.vcu * NWAVES + F.wave, NGW = F.G * NWAVES;
    const int ntok = (l == 0) ? MTOK : MLAT;
    for (int tok = gw; tok < ntok; tok += NGW) {
        const bool isctx = tok >= MLAT;
        const int c8 = 8 * F.lane;
        const bf16* pf = isctx ? OC + (size_t)(tok - MLAT) * 512 + c8 : PA + (size_t)tok * PA_LD + 512 + c8;
        const bf16* pb = isctx ? OC + (size_t)MCTX * 512 + (size_t)(tok - MLAT) * 512 + c8 : PA + (size_t)tok * PA_LD + 1024 + c8;
        const v4u wf = *(const v4u*)pf, wb = *(const v4u*)pb, wg = *(const v4u*)(PA + (size_t)tok * PA_LD + 2048 + c8);
        float o[8], g[8];
#pragma unroll
        for (int e = 0; e < 4; ++e) {
            o[2 * e] = bf2f((unsigned short)(wf[e] & 0xffff)) + bf2f((unsigned short)(wb[e] & 0xffff));
            o[2 * e + 1] = bf2f((unsigned short)(wf[e] >> 16)) + bf2f((unsigned short)(wb[e] >> 16));
            g[2 * e] = bf2f((unsigned short)(wg[e] & 0xffff)); g[2 * e + 1] = bf2f((unsigned short)(wg[e] >> 16));
        }
        float s = 0.f;
#pragma unroll
        for (int e = 0; e < 8; ++e) s += o[e] * o[e];
        s += __shfl_xor(s, 1); s += __shfl_xor(s, 2); s += __shfl_xor(s, 4); s += __shfl_xor(s, 8);
        const float rstd = 1.0f / sqrtf(s * (1.0f / HD) + EPS);
        float y[8];
#pragma unroll
        for (int e = 0; e < 8; ++e) y[e] = o[e] * rstd * gnw[c8 + e] * silu_f(g[e]);
        v4u w; w.x = pk2(y[0], y[1]); w.y = pk2(y[2], y[3]); w.z = pk2(y[4], y[5]); w.w = pk2(y[6], y[7]);
        *(v4u*)(XA + (size_t)tok * D + c8) = w;
    }
    LAS unsigned short* t = (LAS unsigned short*)(F.lds + F.wave * 16384);
    const int ntt = ntok / 64;
    for (int it = gw; it < 8 * ntt; it += NGW) {
        const int ct = it / ntt, tt = it % ntt, c0 = ct * 64, t0 = tt * 64;
        const bf16* OBT = (const bf16*)(ws + WS_OBT);
#pragma unroll
        for (int i = 0; i < 8; ++i) {
            const int e = F.lane + 64 * i, c = e >> 3, ch = e & 7;
            const v4u w = *(const v4u*)(OBT + (size_t)(c0 + c) * MTOK + t0 + 8 * ch);
#pragma unroll
            for (int q = 0; q < 4; ++q) { t[c * 66 + 8 * ch + 2 * q] = (unsigned short)(w[q] & 0xffff); t[c * 66 + 8 * ch + 2 * q + 1] = (unsigned short)(w[q] >> 16); }
        }
        asm volatile("s_waitcnt lgkmcnt(0)" ::: "memory");
#pragma unroll
        for (int i = 0; i < 8; ++i) {
            const int e = F.lane + 64 * i, tk = e >> 3, cg = e & 7;
            unsigned short h[8];
#pragma unroll
            for (int q = 0; q < 8; ++q) h[q] = t[(8 * cg + q) * 66 + tk];
            v4u w; w.x = h[0] | ((unsigned)h[1] << 16); w.y = h[2] | ((unsigned)h[3] << 16); w.z = h[4] | ((unsigned)h[5] << 16); w.w = h[6] | ((unsigned)h[7] << 16);
            *(v4u*)(XA + (size_t)(t0 + tk) * D + 512 + c0 + 8 * cg) = w;
        }
        asm volatile("s_waitcnt lgkmcnt(0)" ::: "memory");
    }
}

__device__ __forceinline__ void phase_final_norm(const Args& a, Frame& F) {
    const float* w = a.in[22];
    const int gw = F.vcu * NWAVES + F.wave, NGW = F.G * NWAVES;
    for (int tok = gw; tok < MLAT; tok += NGW) {
        float* xr = a.out + (size_t)tok * D;
        f32x4 v[4]; float s = 0.f;
#pragma unroll
        for (int j = 0; j < 4; ++j) { v[j] = *(const f32x4*)(xr + 256 * j + 4 * F.lane); s += (v[j].x * v[j].x + v[j].y * v[j].y) + (v[j].z * v[j].z + v[j].w * v[j].w); }
        const float rstd = 1.0f / sqrtf(wave_sum(s) * (1.0f / D) + EPS);
#pragma unroll
        for (int j = 0; j < 4; ++j) { const f32x4 w4 = *(const f32x4*)(w + 256 * j + 4 * F.lane); *(f32x4*)(xr + 256 * j + 4 * F.lane) = v[j] * rstd * w4; }
    }
}

enum { PH_PRO = 0, PH_NORM0 = 1, PH_IN0 = 2, PH_MIX0 = 3, PH_FIN0 = 4, PH_OUT0 = 5, PH_NORM1 = 6, PH_IN1 = 7, PH_MIX1 = 8, PH_FIN1 = 9, PH_OUT1 = 10, PH_FINAL = 11 };

__device__ __forceinline__ Frame mkframe(unsigned char* lds) {
    Frame F;
    F.lds = (LAS unsigned char*)lds;
    F.tid = threadIdx.x; F.lane = F.tid & 63; F.wave = __builtin_amdgcn_readfirstlane(F.tid >> 6);
    F.G = gridDim.x; { const int bx = blockIdx.x; F.vcu = (F.G % 8 == 0) ? (bx % 8) * (F.G / 8) + bx / 8 : bx; }
    return F;
}
template <int l> __device__ __forceinline__ void run_inproj(const Args& args, unsigned char* lds) {
    unsigned char* ws = args.ws; Frame F = mkframe(lds);
    pg8::Gemm g{(const bf16*)(ws + WS_XA), (const bf16*)(ws + WS_WIN) + (size_t)l * NIN * D, D};
    pg8::Sched S; S.init(128, 18, F.G, (int)blockIdx.x, 8, l == 0 ? 18 : 8);
    EpiIn E{(bf16*)(ws + WS_PA), (bf16*)(ws + WS_PB), (const float*)(ws + WS_LBS) + l * 1024};
    pg8::gemm_phase<EpiIn, true, true>(F.lds, g, S, E);
}
template <int l> __device__ __forceinline__ void run_outproj(const Args& args, unsigned char* lds) {
    unsigned char* ws = args.ws; Frame F = mkframe(lds);
    pg8::Gemm g{(const bf16*)(ws + WS_XA), (const bf16*)(ws + WS_WOUT) + (size_t)l * D * D, D};
    pg8::Sched S; S.init(128, 4, F.G, (int)blockIdx.x, l == 0 ? 8 : 0, 4);
    EpiOut E{l == 0 ? args.in[0] : args.out, args.out, args.in[2], (float*)(ws + WS_CTX1), (const float*)(ws + WS_MOD) + (size_t)l * 9 * 3 * D};
    pg8::gemm_phase<EpiOut, true, true>(F.lds, g, S, E);
}
__global__ void __launch_bounds__(NTHR, 2) mega(Args args) {
    extern __shared__ __attribute__((aligned(16))) unsigned char lds[];
    const int lo = args.ph_lo, hi = args.ph_hi;
#define IN(k) (lo <= (k) && (k) < hi)
    volatile LAS unsigned* bst = (volatile LAS unsigned*)((LAS unsigned char*)lds + LDS_BYTES - 32);
    if (threadIdx.x < 8) ((volatile LAS unsigned*)((LAS unsigned char*)lds + LDS_BYTES - 32))[threadIdx.x] = 0u;
    __syncthreads();
    XcdBarrier bar; bar.bar = (unsigned*)(args.ws + WS_CTL) + CW_BAR; bar.x = 0; bar.st = bst;
    if (hi - lo > 1) bar = xcd_barrier_post((unsigned*)(args.ws + WS_CTL) + CW_BAR, bst);
#define SEAM(k) do { if (IN((k) + 1)) xcd_barrier(bar); else __syncthreads(); } while (0)
    if (IN(PH_PRO)) { Frame F = mkframe(lds); phase_prologue(args, F); SEAM(PH_PRO); }
    if (IN(PH_NORM0)) { Frame F = mkframe(lds); phase_normrows(args, F, 0, args.in[0], args.in[2]); phase_filter_finalize(args, F); SEAM(PH_NORM0); }
    if (IN(PH_IN0)) { run_inproj<0>(args, lds); SEAM(PH_IN0); }
    if (IN(PH_MIX0)) { Frame F = mkframe(lds); phase_mix(args, F, 0); SEAM(PH_MIX0); }
    if (IN(PH_FIN0)) { Frame F = mkframe(lds); phase_finalize_ox(args, F, 0); SEAM(PH_FIN0); }
    if (IN(PH_OUT0)) { run_outproj<0>(args, lds); SEAM(PH_OUT0); }
    if (IN(PH_NORM1)) { Frame F = mkframe(lds); phase_normrows(args, F, 1, args.out, (const float*)(args.ws + WS_CTX1)); SEAM(PH_NORM1); }
    if (IN(PH_IN1)) { run_inproj<1>(args, lds); SEAM(PH_IN1); }
    if (IN(PH_MIX1)) { Frame F = mkframe(lds); phase_mix(args, F, 1); SEAM(PH_MIX1); }
    if (IN(PH_FIN1)) { Frame F = mkframe(lds); phase_finalize_ox(args, F, 1); SEAM(PH_FIN1); }
    if (IN(PH_OUT1)) { run_outproj<1>(args, lds); SEAM(PH_OUT1); }
    if (IN(PH_FINAL)) { Frame F = mkframe(lds); phase_final_norm(args, F); }
#undef IN
#undef SEAM
}

extern "C" void kernel_launch(void* const* d_in, const int* in_sizes, int n_in, void* d_out, int out_size, void* d_ws, size_t ws_size, hipStream_t stream) {
    static int grid = 0;
    if (grid == 0) {
        if (n_in != 23 || ws_size < WS_END) { fprintf(stderr, "kernel_launch: unexpected n_in %d / ws_size %zu\n", n_in, ws_size); grid = -1; return; }
        int dev = 0, cus = 0;
        if (hipGetDevice(&dev) != hipSuccess || hipDeviceGetAttribute(&cus, hipDeviceAttributeMultiprocessorCount, dev) != hipSuccess) { grid = -1; return; }
        if (hipFuncSetAttribute((const void*)mega, hipFuncAttributeMaxDynamicSharedMemorySize, LDS_BYTES) != hipSuccess) { fprintf(stderr, "kernel_launch: hipFuncSetAttribute failed\n"); grid = -1; return; }
        grid = cus;
    }
    if (grid < 0) return;
    (void)hipMemsetAsync((char*)d_ws + WS_CTL, 0, CTL_ZERO_BYTES, stream);
    Args a{};
    for (int i = 0; i < 23; ++i) a.in[i] = (const float*)d_in[i];
    a.out = (float*)d_out; a.ws = (unsigned char*)d_ws;
    a.ph_lo = 0; a.ph_hi = PH_FINAL + 1;
    hipLaunchKernelGGL(mega, dim3(grid), dim3(NTHR), LDS_BYTES, stream, a);
}
```

```cpp
#include <hip/hip_runtime.h>
#include <cstdio>
#include <cstdint>
#include <math.h>

namespace pg8 {
#define PG8_LAS __attribute__((address_space(3)))
typedef unsigned short bf16_t;
typedef short bf16x8 __attribute__((ext_vector_type(8)));
typedef float f32x4 __attribute__((ext_vector_type(4)));
typedef unsigned u32x4 __attribute__((ext_vector_type(4)));
typedef unsigned u32x2 __attribute__((ext_vector_type(2)));
constexpr int BM = 256, BK = 64, HALF = 128, HTB = HALF * BK * 2, STAGE_BYTES = 8 * HTB, NXCD = 8, WGM = 8;

__host__ __device__ __forceinline__ int lds_byte(int r, int c) { const int st = (r >> 4) * 2 + (c >> 5), rr = r & 15, cc = c & 31, ob = rr * 64 + cc * 2; return st * 1024 + (ob ^ (((ob >> 9) & 1) << 5)); }
__host__ __device__ __forceinline__ void stage_rc(int b, int& R, int& C) { const int st = b / 1024, sb = b % 1024, swz = sb ^ (((sb >> 9) & 1) << 5); R = (st >> 1) * 16 + swz / 64; C = (st & 1) * 32 + (swz % 64) / 2; }
__host__ __device__ __forceinline__ int perm32(int rho) { const int n = rho >> 4, i = rho & 15; return 8 * (i >> 2) + 4 * n + (i & 3); }

struct Unit { int pm, pn; };
struct Gemm { const bf16_t* A; const bf16_t* Bt; int K; };

struct Sched {
    int nM, nN, nwg, G, c, nctx, nctxN;
    __device__ void init(int nM_, int nN_, int G_, int c_, int nctxM, int nctxN_) { nM = nM_; nN = nN_; nwg = nM * nN; G = G_; c = c_; nctx = nctxM * nctxN_; nctxN = nctxN_ > 0 ? nctxN_ : 1; }
    __device__ bool next(int i, Unit& u) const {
        const long L = (long)i * G + c;
        if (L >= nwg) { const long L2 = L - nwg; if (L2 >= nctx) return false; u.pm = nM + (int)(L2 / nctxN); u.pn = (int)(L2 % nctxN); return true; }
        int wgid = (int)L; { const int q = nwg / NXCD, r = nwg % NXCD, xcd = wgid % NXCD, off = wgid / NXCD; wgid = (xcd < r ? xcd * (q + 1) : r * (q + 1) + (xcd - r) * q) + off; }
        const int nig = WGM * nN, gid = wgid / nig, fm = gid * WGM, gsz = (nM - fm) < WGM ? (nM - fm) : WGM;
        u.pm = fm + ((wgid % nig) % gsz); u.pn = (wgid % nig) / gsz; return true;
    }
};

template <class Epi, bool ALIGN_EPI, bool SP2>
__device__ __forceinline__ void gemm_phase(PG8_LAS unsigned char* lds, const Gemm g, const Sched& S, const Epi& E) {
    const int tid = threadIdx.x, wid = __builtin_amdgcn_readfirstlane(tid >> 6), lane = tid & 63, wr = wid >> 2, wc = wid & 3, fr = lane & 15, fq = lane >> 4;
    const int K = g.K, nt = K / BK;
    unsigned voffA[2], voffB[2];
#pragma unroll
    for (int i = 0; i < 2; ++i) { int R, C; stage_rc(tid * 16 + i * 8192, R, C); const int Rb = Epi::PERM ? ((R & ~31) + perm32(R & 31)) : R;
        voffA[i] = (unsigned)(R * K + C) * 2u; voffB[i] = (unsigned)(Rb * K + C) * 2u; }
    const size_t kstep = (size_t)(BK * 2);
    const size_t hstep = (size_t)HALF * K * 2;
    const size_t tstep = 2 * hstep;
    const unsigned ldsw = (unsigned)wid * 1024u;
    const int aoff = lds_byte(wr * 64 + fr, fq * 8), boff = lds_byte(wc * 32 + fr, fq * 8);
#define PG8_SA(b, h) (((b) * 2 + (h)) * HTB)
#define PG8_SB(b, h) ((4 + (b) * 2 + (h)) * HTB)
#define PG8_STAGE(bufoff, gbase, voff) do { _Pragma("unroll") for (int _i = 0; _i < 2; ++_i) \
        __builtin_amdgcn_global_load_lds((const unsigned*)((const char*)(gbase) + (voff)[_i]), (PG8_LAS unsigned*)(lds + (bufoff) + ldsw + _i * 8192), 16, 0, 0); } while (0)
#define PG8_LDA(dst, b, h) do { _Pragma("unroll") for (int m = 0; m < 4; ++m) _Pragma("unroll") for (int k = 0; k < 2; ++k) dst[m][k] = *(const PG8_LAS bf16x8*)(lds + PG8_SA(b, h) + aoff + m * 2048 + k * 1024); } while (0)
#define PG8_LDB(dst, b, h) do { _Pragma("unroll") for (int n = 0; n < 2; ++n) _Pragma("unroll") for (int k = 0; k < 2; ++k) dst[n][k] = *(const PG8_LAS bf16x8*)(lds + PG8_SB(b, h) + boff + n * 2048 + k * 1024); } while (0)
#define PG8_MMA(ai, bj, At, Bt) do { __builtin_amdgcn_s_setprio(1); _Pragma("unroll") for (int m = 0; m < 4; ++m) _Pragma("unroll") for (int n = 0; n < 2; ++n) _Pragma("unroll") for (int k = 0; k < 2; ++k) \
        acc[ai][bj][m][n] = __builtin_amdgcn_mfma_f32_16x16x32_bf16(Bt[n][k], At[m][k], acc[ai][bj][m][n], 0, 0, 0); __builtin_amdgcn_s_setprio(0); } while (0)
#define PG8_WAIT_V(n) asm volatile("s_waitcnt vmcnt(" #n ")" ::: "memory")
#define PG8_WAIT_L(n) asm volatile("s_waitcnt lgkmcnt(" #n ")" ::: "memory")
#define PG8_BAR __builtin_amdgcn_s_barrier()
#define PG8_SCHED __builtin_amdgcn_sched_barrier(0)
    Unit cur, nxt; int ui = 0;
    if (!S.next(0, cur)) return;
    f32x4 acc[2][2][4][2];
#pragma unroll
    for (int a = 0; a < 2; ++a)
#pragma unroll
        for (int b = 0; b < 2; ++b)
#pragma unroll
            for (int m = 0; m < 4; ++m)
#pragma unroll
                for (int n = 0; n < 2; ++n) acc[a][b][m][n] = (f32x4){0.f, 0.f, 0.f, 0.f};
    bf16x8 At[4][2], B0[2][2], B1[2][2];
    const char* cA = E.swap(cur) ? (const char*)g.Bt + (size_t)cur.pn * tstep : (const char*)g.A + (size_t)cur.pm * tstep;
    const char* cB = E.swap(cur) ? (const char*)g.A + (size_t)cur.pm * tstep : (const char*)g.Bt + (size_t)cur.pn * tstep;
    if constexpr (SP2) {
        PG8_STAGE(PG8_SB(0, 0), cB, voffB); PG8_STAGE(PG8_SB(0, 1), cB + hstep, voffB); PG8_STAGE(PG8_SA(0, 0), cA, voffA); PG8_STAGE(PG8_SA(0, 1), cA + hstep, voffA);
        if (wr == 1) PG8_BAR;
        PG8_WAIT_V(2); PG8_BAR;
        PG8_STAGE(PG8_SB(1, 0), cB + kstep, voffB); PG8_STAGE(PG8_SA(1, 0), cA + kstep, voffA); PG8_STAGE(PG8_SB(1, 1), cB + hstep + kstep, voffB);
        PG8_WAIT_V(6); PG8_BAR;
    } else {
        PG8_STAGE(PG8_SB(0, 0), cB, voffB); PG8_STAGE(PG8_SA(0, 0), cA, voffA); PG8_STAGE(PG8_SB(0, 1), cB + hstep, voffB); PG8_STAGE(PG8_SA(0, 1), cA + hstep, voffA);
        if (wr == 1) PG8_BAR;
        PG8_WAIT_V(4); PG8_BAR;
        PG8_STAGE(PG8_SB(1, 0), cB + kstep, voffB); PG8_STAGE(PG8_SA(1, 0), cA + kstep, voffA); PG8_STAGE(PG8_SB(1, 1), cB + hstep + kstep, voffB);
        PG8_WAIT_V(6); PG8_BAR;
    }
    for (;;) {
        const bool has_next = S.next(ui + 1, nxt);
        const bool nsw = has_next && E.swap(nxt);
        const char* nA = has_next ? (nsw ? (const char*)g.Bt + (size_t)nxt.pn * tstep : (const char*)g.A + (size_t)nxt.pm * tstep) : cA;
        const char* nB = has_next ? (nsw ? (const char*)g.A + (size_t)nxt.pm * tstep : (const char*)g.Bt + (size_t)nxt.pn * tstep) : cB;
        for (int t = 0; t < nt; t += 2) {
            const bool last = (t == nt - 2);
            const char* a1 = cA + (size_t)(t + 1) * kstep;
            const char* a2 = last ? nA : cA + (size_t)(t + 2) * kstep; const char* b2 = last ? nB : cB + (size_t)(t + 2) * kstep;
            const char* a3 = a2 + kstep; const char* b3 = b2 + kstep;
            if constexpr (SP2) {
            PG8_LDB(B0, 0, 0); PG8_LDB(B1, 0, 1); PG8_SCHED; PG8_LDA(At, 0, 0); PG8_STAGE(PG8_SA(1, 1), a1 + hstep, voffA);
            PG8_WAIT_V(8); PG8_WAIT_L(0); PG8_BAR; PG8_MMA(0, 0, At, B0); PG8_MMA(0, 1, At, B1); PG8_BAR; PG8_SCHED;
            PG8_LDA(At, 0, 1); PG8_STAGE(PG8_SB(0, 0), b2, voffB); PG8_STAGE(PG8_SB(0, 1), b2 + hstep, voffB); PG8_STAGE(PG8_SA(0, 0), a2, voffA);
            PG8_WAIT_V(8); PG8_WAIT_L(0); PG8_BAR; PG8_MMA(1, 0, At, B0); PG8_MMA(1, 1, At, B1); PG8_BAR; PG8_SCHED;
            PG8_LDB(B0, 1, 0); PG8_LDB(B1, 1, 1); PG8_SCHED; PG8_LDA(At, 1, 0); PG8_STAGE(PG8_SA(0, 1), a2 + hstep, voffA);
            PG8_WAIT_V(8); PG8_WAIT_L(0); PG8_BAR; PG8_MMA(0, 0, At, B0); PG8_MMA(0, 1, At, B1); PG8_BAR; PG8_SCHED;
            PG8_LDA(At, 1, 1); PG8_STAGE(PG8_SB(1, 0), b3, voffB); PG8_STAGE(PG8_SB(1, 1), b3 + hstep, voffB); PG8_STAGE(PG8_SA(1, 0), a3, voffA);
            PG8_WAIT_V(8); PG8_WAIT_L(0); PG8_BAR; PG8_MMA(1, 0, At, B0); PG8_MMA(1, 1, At, B1); PG8_BAR; PG8_SCHED;
            } else {
            PG8_LDB(B0, 0, 0); PG8_SCHED; PG8_LDA(At, 0, 0); PG8_STAGE(PG8_SA(1, 1), a1 + hstep, voffA);
            PG8_WAIT_L(8); PG8_BAR; PG8_WAIT_L(0); PG8_MMA(0, 0, At, B0); PG8_BAR; PG8_SCHED;
            PG8_LDB(B1, 0, 1); PG8_STAGE(PG8_SB(0, 0), b2, voffB);
            PG8_BAR; PG8_WAIT_L(0); PG8_MMA(0, 1, At, B1); PG8_BAR;
            PG8_LDA(At, 0, 1); PG8_STAGE(PG8_SA(0, 0), a2, voffA);
            PG8_BAR; PG8_WAIT_L(0); PG8_MMA(1, 0, At, B0); PG8_BAR; PG8_SCHED;
            PG8_STAGE(PG8_SB(0, 1), b2 + hstep, voffB);
            PG8_WAIT_V(6); PG8_BAR; PG8_MMA(1, 1, At, B1); PG8_BAR;
            PG8_LDB(B0, 1, 0); PG8_SCHED; PG8_LDA(At, 1, 0); PG8_STAGE(PG8_SA(0, 1), a2 + hstep, voffA);
            PG8_WAIT_L(8); PG8_BAR; PG8_WAIT_L(0); PG8_MMA(0, 0, At, B0); PG8_BAR; PG8_SCHED;
            PG8_LDB(B1, 1, 1); PG8_STAGE(PG8_SB(1, 0), b3, voffB);
            PG8_BAR; PG8_WAIT_L(0); PG8_MMA(0, 1, At, B1); PG8_BAR;
            PG8_LDA(At, 1, 1); PG8_STAGE(PG8_SA(1, 0), a3, voffA);
            PG8_BAR; PG8_WAIT_L(0); PG8_MMA(1, 0, At, B0); PG8_BAR; PG8_SCHED;
            PG8_STAGE(PG8_SB(1, 1), b3 + hstep, voffB);
            PG8_WAIT_V(6); PG8_BAR; PG8_MMA(1, 1, At, B1); PG8_BAR;
            }
        }
        if constexpr (ALIGN_EPI) { if (wr == 0) PG8_BAR; }
        E(acc, cur, wr, wc, fr, fq);
        if (!has_next) break;
#pragma unroll
        for (int a = 0; a < 2; ++a)
#pragma unroll
            for (int b = 0; b < 2; ++b)
#pragma unroll
                for (int m = 0; m < 4; ++m)
#pragma unroll
                    for (int n = 0; n < 2; ++n) acc[a][b][m][n] = (f32x4){0.f, 0.f, 0.f, 0.f};
        cur = nxt; cA = nA; cB = nB; ++ui;
        if constexpr (ALIGN_EPI) { if (wr == 1) PG8_BAR; }
    }
    PG8_WAIT_V(0);
    if constexpr (!ALIGN_EPI) { if (wr == 0) PG8_BAR; }
    PG8_BAR;
#undef PG8_SA
#undef PG8_SB
#undef PG8_STAGE
#undef PG8_LDA
#undef PG8_LDB
#undef PG8_MMA
#undef PG8_WAIT_V
#undef PG8_WAIT_L
#undef PG8_BAR
#undef PG8_SCHED
}
}

constexpr int D = 1024, NB = 8, LX = 4096, LCX = 256, NIN = 4608, DA = 512, DB = 512, HD = 128;
constexpr int MLAT = NB * LX, MCTX = NB * LCX, MTOK = MLAT + MCTX;
constexpr int PA_LD = 3072;
constexpr int FZ = 8448, FZC = 640;
constexpr float EPS = 1e-6f;
constexpr float HY_MIN_DECAY = -3.0701134573253944f, HY_MAX_DECAY = -15.350567286626972f;
constexpr int NWAVES = 8, NTHR = 512;

constexpr size_t MiB = 1u << 20;
constexpr size_t WS_CTL = 0, CTL_ZERO_BYTES = 1 * MiB;
constexpr size_t WS_MOD = 1 * MiB;
constexpr size_t WS_LBS = WS_MOD + 256 * 1024;
constexpr size_t WS_WIN = 6 * MiB;
constexpr size_t WS_WOUT = 24 * MiB;
constexpr size_t WS_FG = 28 * MiB;
constexpr size_t WS_FGC = 45 * MiB;
constexpr size_t WS_CTX1 = 46 * MiB;
constexpr size_t WS_OC = 2 * MiB;
constexpr size_t WS_XA = 54 * MiB;
constexpr size_t WS_PA = 122 * MiB;
constexpr size_t WS_PB = 326 * MiB;
constexpr size_t WS_OBT = 462 * MiB;
constexpr size_t WS_HK = 326 * MiB;
constexpr size_t WS_SCL = 496 * MiB;
constexpr size_t WS_END = 504 * MiB;
constexpr int CW_NORM = 1024;
constexpr int CW_BAR = 8192;
constexpr int CW_QUEUE = 4096;

constexpr int LDS_BYTES = 156 * 1024;
#define LAS __attribute__((address_space(3)))
#define GAS __attribute__((address_space(1)))
typedef unsigned short bf16;
typedef unsigned v4u __attribute__((ext_vector_type(4)));
typedef unsigned v2u __attribute__((ext_vector_type(2)));
typedef float f32x4 __attribute__((ext_vector_type(4)));

typedef __bf16 bf2_t __attribute__((ext_vector_type(2)));
typedef float f2_t __attribute__((ext_vector_type(2)));
__device__ __forceinline__ unsigned pk2(float lo, float hi) { const f2_t v = {lo, hi}; return __builtin_bit_cast(unsigned, __builtin_convertvector(v, bf2_t)); }
__device__ __forceinline__ unsigned f2bf(float f) { return pk2(f, 0.f) & 0xffffu; }
__device__ __forceinline__ float bf2f(unsigned short h) { return __builtin_bit_cast(float, (unsigned)h << 16); }
__device__ __forceinline__ unsigned f2h(float f) { _Float16 h = (_Float16)f; return (unsigned)__builtin_bit_cast(unsigned short, h); }
__device__ __forceinline__ unsigned pk2h(float lo, float hi) { return f2h(lo) | (f2h(hi) << 16); }
__device__ __forceinline__ float h2f(unsigned short u) { return (float)__builtin_bit_cast(_Float16, u); }
__device__ __forceinline__ float silu_f(float x) { return x / (1.0f + __expf(-x)); }
__device__ __forceinline__ float sigmoid_f(float x) { return 1.0f / (1.0f + __expf(-x)); }
__device__ __forceinline__ float wave_sum(float v) {
#pragma unroll
    for (int o = 1; o < 64; o <<= 1) v += __shfl_xor(v, o);
    return v;
}


typedef GAS unsigned gu32;
#define XB_TMO      128
#define XB_XCNT(j)  (256  + 64 * (j))
#define XB_XSUB(j)  (1280 + 64 * (j))
#define XB_XGEN(j)  (2304 + 64 * (j))
#define XB_TOP      3328
#define XB_TOPGEN   3392
#define XCD_BAR_WORDS 3456
#define XB_SPIN_CAP (1u << 18)
__device__ __forceinline__ unsigned xb_ld(unsigned* p)              { return __hip_atomic_load(p, __ATOMIC_RELAXED, __HIP_MEMORY_SCOPE_AGENT); }
__device__ __forceinline__ unsigned xb_add(unsigned* p, unsigned v) { return __hip_atomic_fetch_add(p, v, __ATOMIC_RELAXED, __HIP_MEMORY_SCOPE_AGENT); }
__device__ __forceinline__ unsigned xb_xcc_id() { return (unsigned)__builtin_amdgcn_s_getreg((3 << 11) | 20) & 0xFu; }
#define XB_SPIN(cond, bar) do { unsigned _sp = 0; while (cond) { __builtin_amdgcn_s_sleep(1); \
    if ((++_sp & 255u) == 0u) { if (xb_ld(&(bar)[XB_TMO])) break; if (_sp > XB_SPIN_CAP) { atomicAdd(&(bar)[XB_TMO], 1u); break; } } } } while (0)
struct XcdBarrier { unsigned* bar; unsigned x; volatile LAS unsigned* st; };
__device__ __forceinline__ XcdBarrier xcd_barrier_post(unsigned* bar, volatile LAS unsigned* st) {
    XcdBarrier b; b.bar = bar; b.x = xb_xcc_id(); b.st = st;
    if (threadIdx.x == 0) (void)xb_add(&bar[XB_XCNT(b.x)], 1u);
    return b;
}
__device__ __forceinline__ void xcd_barrier_complete(unsigned* bar, unsigned x, unsigned& nloc, unsigned& nx) {
    const unsigned G = gridDim.x * gridDim.y * gridDim.z;
    unsigned sum, cnt, mine, sp = 0u;
    for (;;) {
        sum = 0u; cnt = 0u; mine = 0u;
#pragma unroll
        for (unsigned j = 0; j < 16; ++j) { const unsigned c = xb_ld(&bar[XB_XCNT(j)]); sum += c; cnt += (c > 0u) ? 1u : 0u; mine = (j == x) ? c : mine; }
        if (sum == G) break;
        __builtin_amdgcn_s_sleep(1);
        if ((++sp & 255u) == 0u) { if (xb_ld(&bar[XB_TMO])) break; if (sp > XB_SPIN_CAP) { atomicAdd(&bar[XB_TMO], 1u); break; } }
    }
    nloc = mine > 0u ? mine : 1u; nx = cnt > 0u ? cnt : 1u;
}
__device__ __forceinline__ void xcd_barrier(const XcdBarrier& b) {
    asm volatile("s_waitcnt vmcnt(0)" ::: "memory");
    __syncthreads();
    if (threadIdx.x == 0) {
        unsigned* bar = b.bar;
        __builtin_amdgcn_s_waitcnt(0);
        unsigned nloc = b.st[0], nx = b.st[1];
        if (nloc == 0u) { xcd_barrier_complete(bar, b.x, nloc, nx); b.st[0] = nloc; b.st[1] = nx; }
        const unsigned old = xb_add(&bar[XB_XSUB(b.x)], 1u);
        const unsigned gen = old / nloc;
        if (old + 1u == (gen + 1u) * nloc) {
            __builtin_amdgcn_fence(__ATOMIC_RELEASE, "agent");
            asm volatile("s_waitcnt vmcnt(0)" ::: "memory");
            const unsigned og = xb_add(&bar[XB_TOP], 1u);
            const unsigned tg = og / nx;
            if (og + 1u == (tg + 1u) * nx) xb_add(&bar[XB_TOPGEN], 1u);
            else XB_SPIN(xb_ld(&bar[XB_TOPGEN]) == tg, bar);
            __builtin_amdgcn_fence(__ATOMIC_ACQUIRE, "agent");
            xb_add(&bar[XB_XGEN(b.x)], 1u);
            asm volatile("s_waitcnt vmcnt(0)" ::: "memory");
        } else {
            XB_SPIN(xb_ld(&bar[XB_XGEN(b.x)]) == gen, bar);
            __builtin_amdgcn_fence(__ATOMIC_ACQUIRE, "agent");
            asm volatile("s_waitcnt vmcnt(0)" ::: "memory");
        }
    }
    __syncthreads();
}

struct EpiIn {
    static constexpr bool PERM = true;
    bf16* PA; bf16* PB; const float* lb;
    __device__ __forceinline__ bool swap(const pg8::Unit& u) const { return u.pn >= 10; }
    __device__ __forceinline__ void operator()(const f32x4 (&acc)[2][2][4][2], const pg8::Unit& u, int wr, int wc, int fr, int fq) const {
        if (u.pn < 10) {
            const int type = u.pn >> 1;
            const int row0 = u.pm * 256 + wr * 64 + fr, col0 = u.pn * 256 + wc * 32 + 8 * fq;
#pragma unroll
            for (int bj = 0; bj < 2; ++bj) {
                float lbv[8];
#pragma unroll
                for (int e = 0; e < 8; ++e) lbv[e] = (type == 1 || type == 2) ? lb[col0 + bj * 128 + e - 512] : 0.f;
#pragma unroll
                for (int ai = 0; ai < 2; ++ai)
#pragma unroll
                    for (int m = 0; m < 4; ++m) {
                        bf16* rowp = PA + (size_t)(row0 + ai * 128 + m * 16) * PA_LD + col0 + bj * 128;
                        float x[8];
#pragma unroll
                        for (int e = 0; e < 4; ++e) { x[e] = acc[ai][bj][m][0][e]; x[4 + e] = acc[ai][bj][m][1][e]; }
                        v4u w;
                        if (type == 0) {
#pragma unroll
                            for (int e = 0; e < 8; ++e) x[e] = silu_f(x[e]);
                            w.x = pk2(x[0], x[1]); w.y = pk2(x[2], x[3]); w.z = pk2(x[4], x[5]); w.w = pk2(x[6], x[7]);
                        } else if (type == 1 || type == 2) {
#pragma unroll
                            for (int e = 0; e < 8; ++e) x[e] = lbv[e] + (1.0f - lbv[e]) * sigmoid_f(x[e]);
                            w.x = pk2h(x[0], x[1]); w.y = pk2h(x[2], x[3]); w.z = pk2h(x[4], x[5]); w.w = pk2h(x[6], x[7]);
                        } else {
                            w.x = pk2(x[0], x[1]); w.y = pk2(x[2], x[3]); w.z = pk2(x[4], x[5]); w.w = pk2(x[6], x[7]);
                        }
                        *(v4u*)rowp = w;
                        asm volatile("" ::: "memory");
                    }
            }
        } else {
#pragma unroll
            for (int ai = 0; ai < 2; ++ai)
#pragma unroll
                for (int m = 0; m < 4; ++m) {
                    const int cw = u.pn * 256 + ai * 128 + wr * 64 + m * 16 + fr;
                    bf16* colp = PB + (size_t)(cw - 2560) * MTOK + u.pm * 256 + wc * 32 + 8 * fq;
#pragma unroll
                    for (int bj = 0; bj < 2; ++bj) {
                        const f32x4 v0 = acc[ai][bj][m][0], v1 = acc[ai][bj][m][1];
                        v4u w; w.x = pk2(v0[0], v0[1]); w.y = pk2(v0[2], v0[3]); w.z = pk2(v1[0], v1[1]); w.w = pk2(v1[2], v1[3]);
                        *(v4u*)(colp + bj * 128) = w;
                    }
                }
        }
    }
};
struct EpiOut {
    static constexpr bool PERM = false;
    const float* xin_lat; float* out_lat; const float* xin_ctx; float* out_ctx; const float* mod;
    __device__ __forceinline__ bool swap(const pg8::Unit&) const { return false; }
    __device__ __forceinline__ void operator()(const f32x4 (&acc)[2][2][4][2], const pg8::Unit& u, int wr, int wc, int fr, int fq) const {
        const bool isctx = u.pm >= 128;
        const int col0 = u.pn * 256 + wc * 32 + 4 * fq;
#pragma unroll
        for (int ai = 0; ai < 2; ++ai)
#pragma unroll
            for (int m = 0; m < 4; ++m) {
                const int row = u.pm * 256 + ai * 128 + wr * 64 + m * 16 + fr;
                const int rl = isctx ? row - MLAT : row;
                const int mr = isctx ? 8 : (row >> 12);
                const float* xi = (isctx ? xin_ctx : xin_lat) + (size_t)rl * D + col0;
                float* xo = (isctx ? out_ctx : out_lat) + (size_t)rl * D + col0;
                const float* gt = mod + (size_t)mr * 3 * D + 2 * D + col0;
#pragma unroll
                for (int bj = 0; bj < 2; ++bj)
#pragma unroll
                    for (int n = 0; n < 2; ++n) {
                        const int o = bj * 128 + n * 16;
                        const f32x4 xv = *(const f32x4*)(xi + o), gv = *(const f32x4*)(gt + o);
                        *(f32x4*)(xo + o) = xv + gv * acc[ai][bj][m][n];
                    }
            }
    }
};

struct Args {
    const float* in[23]; float* out; unsigned char* ws; int ph_lo, ph_hi;
};

struct Frame {
    LAS unsigned char* lds; int tid, lane, wave, vcu, G;
};

__device__ __forceinline__ void p0_transpose_item(const float* W, int K, int N, bf16* WT, LAS float* scr, int item, int lane) {
    const int nblk = N / 32, kb = item / nblk, nb = item % nblk, k0 = 64 * kb, n0 = 32 * nb;
#pragma unroll 8
    for (int i = 0; i < 32; ++i) { const int kk = 2 * i + (lane >> 5); scr[kk * 33 + (lane & 31)] = W[(size_t)(k0 + kk) * N + n0 + (lane & 31)]; }
    asm volatile("s_waitcnt lgkmcnt(0)" ::: "memory");
    const int c = lane & 7;
#pragma unroll
    for (int j = 0; j < 4; ++j) { const int n = (lane >> 3) + 8 * j; const LAS float* s = scr + (8 * c) * 33 + n;
        v4u o; o.x = pk2(s[0 * 33], s[1 * 33]); o.y = pk2(s[2 * 33], s[3 * 33]); o.z = pk2(s[4 * 33], s[5 * 33]); o.w = pk2(s[6 * 33], s[7 * 33]);
        *(v4u*)(WT + (size_t)(n0 + n) * K + k0 + 8 * c) = o; }
    asm volatile("s_waitcnt lgkmcnt(0)" ::: "memory");
}

__device__ __forceinline__ void phase_prologue(const Args& a, Frame& F) {
    unsigned char* ws = a.ws;
    {
        LAS float* scr = (LAS float*)(F.lds + F.wave * 16384);
        const int gw = F.vcu * NWAVES + F.wave, NGW = F.G * NWAVES;
        constexpr int I_IN = (D / 64) * (NIN / 32), I_OUT = (D / 64) * (D / 32);
        for (int it = gw; it < 2 * (I_IN + I_OUT); it += NGW) {
            int r = it; const int l = r / (I_IN + I_OUT); r -= l * (I_IN + I_OUT);
            if (r < I_IN) p0_transpose_item(a.in[7] + (size_t)l * D * NIN, D, NIN, (bf16*)(ws + WS_WIN) + (size_t)l * NIN * D, scr, r, F.lane);
            else p0_transpose_item(a.in[8] + (size_t)l * D * D, D, D, (bf16*)(ws + WS_WOUT) + (size_t)l * D * D, scr, r - I_IN, F.lane);
        }
    }
    __syncthreads();
    if (F.vcu == 0) {
        float* lbs = (float*)(ws + WS_LBS);
        for (int i = F.tid; i < 1024; i += NTHR) {
            const float a0 = a.in[9][i], a1 = a.in[9][1024 + i];
            const float m = fmaxf(a0, a1), e0 = expf(a0 - m), e1 = expf(a1 - m);
            const float p0 = e0 / (e0 + e1), p1 = e1 / (e0 + e1);
            const float c0 = p0, c1 = p0 + p1;
            lbs[i] = c0 - c0; lbs[1024 + i] = c1 - c0;
        }
    }
    {
        LAS float* sv = (LAS float*)F.lds;
        LAS float* part = sv + 9 * 1024;
        for (int task = F.vcu; task < 96; task += F.G) {
            const int l = task / 48, n0 = (task % 48) * 64;
            for (int e = F.tid; e < 9 * 1024; e += NTHR) { const int r = e >> 10, k = e & 1023; const float cv = r < 8 ? a.in[1][r * D + k] : a.in[3][k]; sv[e] = cv / (1.0f + expf(-cv)); }
            __syncthreads();
            float acc9[9];
#pragma unroll
            for (int r = 0; r < 9; ++r) acc9[r] = 0.f;
            const float* w = a.in[5] + (size_t)l * D * 3 * D + n0 + F.lane;
            for (int k = F.wave * 128; k < F.wave * 128 + 128; ++k) {
                const float wv = w[(size_t)k * 3 * D];
#pragma unroll
                for (int r = 0; r < 9; ++r) acc9[r] += sv[r * 1024 + k] * wv;
            }
#pragma unroll
            for (int r = 0; r < 9; ++r) part[(F.wave * 9 + r) * 64 + F.lane] = acc9[r];
            __syncthreads();
            for (int e = F.tid; e < 9 * 64; e += NTHR) {
                const int r = e >> 6, c = e & 63; float s = 0.f;
#pragma unroll
                for (int w8 = 0; w8 < 8; ++w8) s += part[(w8 * 9 + r) * 64 + c];
                ((float*)(ws + WS_MOD))[((size_t)l * 9 + r) * 3 * D + n0 + c] = s + a.in[6][l * 3 * D + n0 + c];
            }
            __syncthreads();
        }
    }
    {
        LAS float* zs = (LAS float*)F.lds;
        LAS float* h3s = zs + 8 * 64;
        float* nrm = (float*)(ws + WS_CTL) + CW_NORM;
        for (int task = F.vcu; task < 1056; task += F.G) {
            const int set = task < 512 ? 0 : (task < 1024 ? 1 : 2);
            const int L = set == 2 ? 256 : 4096, l = set == 1 ? 1 : 0;
            const int n0 = (set == 0 ? task : set == 1 ? task - 512 : task - 1024) * 8;
            const int n = n0 + F.wave, j = F.lane;
            LAS float* zw = zs + F.wave * 64;
            if (j == 0) zw[0] = (float)n / (float)(L - 1);
            if (j >= 1 && j < 33) {
                const int i = (j - 1) & 15;
                const double f = 1e-4 + (double)i * ((15.0 - 1e-4) / 15.0);
                double rev = f * (double)n / (double)L; rev -= floor(rev);
                const float ang = (float)(rev * 6.283185307179586476925);
                zw[j] = (j <= 16) ? cosf(ang) : -sinf(ang);
            }
            asm volatile("s_waitcnt lgkmcnt(0)" ::: "memory");
            const float* w1 = a.in[13] + l * 33 * 64; const float* b1 = a.in[14] + l * 64; const float fr = a.in[15][l * 64 + j];
            const float* w2 = a.in[16] + l * 4096; const float* b2 = a.in[17] + l * 64; const float* w3 = a.in[18] + l * 4096; const float* b3 = a.in[19] + l * 64;
            float s = b1[j];
            for (int e = 0; e < 33; ++e) s += zw[e] * w1[e * 64 + j];
            const float h1 = sinf(fr * s);
            asm volatile("s_waitcnt lgkmcnt(0)" ::: "memory");
            zw[j] = h1;
            asm volatile("s_waitcnt lgkmcnt(0)" ::: "memory");
            s = b2[j];
            for (int e = 0; e < 64; ++e) s += zw[e] * w2[e * 64 + j];
            const float h2 = sinf(fr * s);
            asm volatile("s_waitcnt lgkmcnt(0)" ::: "memory");
            zw[j] = h2;
            asm volatile("s_waitcnt lgkmcnt(0)" ::: "memory");
            s = b3[j];
            for (int e = 0; e < 64; ++e) s += zw[e] * w3[e * 64 + j];
            h3s[F.wave * 64 + j] = sinf(fr * s);
            __syncthreads();
            const int c2 = 2 * F.tid;
            const float* w4 = a.in[20] + (size_t)l * 64 * 1024 + c2;
            float acc[8][2];
#pragma unroll
            for (int p = 0; p < 8; ++p) { acc[p][0] = 0.f; acc[p][1] = 0.f; }
            for (int jj = 0; jj < 64; ++jj) {
                const float2 wv = *(const float2*)(w4 + (size_t)jj * 1024);
#pragma unroll
                for (int p = 0; p < 8; ++p) { const float hv = h3s[p * 64 + jj]; acc[p][0] += hv * wv.x; acc[p][1] += hv * wv.y; }
            }
            float* hk = (float*)(ws + WS_HK) + (size_t)set * 4096 * 1024;
            float ns[2] = {0.f, 0.f};
#pragma unroll
            for (int e = 0; e < 2; ++e) {
                const int cc = c2 + e, c = cc & 511;
                const float delta = fabsf(HY_MIN_DECAY + (float)c * ((HY_MAX_DECAY - HY_MIN_DECAY) / 511.0f));
#pragma unroll
                for (int p = 0; p < 8; ++p) {
                    const int nn = n0 + p; const float t = (float)nn / (float)(L - 1);
                    const float v = acc[p][e] * expf(-t * delta);
                    hk[(size_t)nn * 1024 + cc] = v;
                    if (cc < 512 || nn >= 1) ns[e] += fabsf(v);
                }
            }
            atomicAdd(&nrm[set * 512 + (c2 & 511)], ns[0]);
            atomicAdd(&nrm[set * 512 + ((c2 + 1) & 511)], ns[1]);
            __syncthreads();
        }
    }
}

__device__ __forceinline__ void phase_normrows(const Args& a, Frame& F, int l, const float* xlat, const float* xctx) {
    unsigned char* ws = a.ws;
    const float* nw = a.in[4] + l * D;
    const float* mod = (const float*)(ws + WS_MOD) + (size_t)l * 9 * 3 * D;
    bf16* XA = (bf16*)(ws + WS_XA);
    const int gw = F.vcu * NWAVES + F.wave, NGW = F.G * NWAVES;
    for (int tok = gw; tok < MTOK; tok += NGW) {
        const bool isctx = tok >= MLAT;
        const float* xr = isctx ? xctx + (size_t)(tok - MLAT) * D : xlat + (size_t)tok * D;
        const int mr = isctx ? 8 : (tok >> 12);
        const float* sh = mod + (size_t)mr * 3 * D; const float* sc = sh + D;
        f32x4 v[4]; float s = 0.f;
#pragma unroll
        for (int j = 0; j < 4; ++j) { v[j] = *(const f32x4*)(xr + 256 * j + 4 * F.lane); s += (v[j].x * v[j].x + v[j].y * v[j].y) + (v[j].z * v[j].z + v[j].w * v[j].w); }
        const float rstd = 1.0f / sqrtf(wave_sum(s) * (1.0f / D) + EPS);
#pragma unroll
        for (int j = 0; j < 4; ++j) {
            const int k = 256 * j + 4 * F.lane;
            const f32x4 w4 = *(const f32x4*)(nw + k), s4 = *(const f32x4*)(sc + k), h4 = *(const f32x4*)(sh + k);
            const f32x4 y = v[j] * rstd * w4 * (s4 + 1.0f) + h4;
            v2u o; o.x = pk2(y.x, y.y); o.y = pk2(y.z, y.w);
            *(v2u*)(XA + (size_t)tok * D + k) = o;
        }
    }
}
__device__ __forceinline__ void phase_filter_finalize(const Args& a, Frame& F) {
    unsigned char* ws = a.ws;
    LAS float* scr = (LAS float*)(F.lds + F.wave * 16640);
    const int gw = F.vcu * NWAVES + F.wave, NGW = F.G * NWAVES;
    constexpr int T01 = 8 * (FZ / 64), T2 = 8 * (FZC / 64);
    for (int it = gw; it < 2 * T01 + T2; it += NGW) {
        const int set = it < T01 ? 0 : (it < 2 * T01 ? 1 : 2);
        const int r = it - (set == 0 ? 0 : set == 1 ? T01 : 2 * T01);
        const int L = set == 2 ? 256 : 4096, nzt = (set == 2 ? FZC : FZ) / 64;
        const int ct = r / nzt, zt = r % nzt, c0 = ct * 64, z0 = zt * 64;
        const float* hk = (const float*)(ws + WS_HK) + (size_t)set * 4096 * 1024;
        for (int zz = 0; zz < 64; ++zz) {
            const int lag = L - (z0 + zz); float v = 0.f;
            if (lag >= 0 && lag <= L - 1) v = hk[(size_t)lag * 1024 + c0 + F.lane];
            else if (lag < 0 && -lag <= L - 1) v = hk[(size_t)(-lag) * 1024 + 512 + c0 + F.lane];
            scr[zz * 65 + F.lane] = v;
        }
        asm volatile("s_waitcnt lgkmcnt(0)" ::: "memory");
        bf16* dst = set == 2 ? (bf16*)(ws + WS_FGC) : (bf16*)(ws + WS_FG) + (size_t)set * 512 * FZ;
        const int ld = set == 2 ? FZC : FZ;
        for (int cc = 0; cc < 64; ++cc) dst[(size_t)(c0 + cc) * ld + z0 + F.lane] = (bf16)f2bf(scr[F.lane * 65 + cc]);
        asm volatile("s_waitcnt lgkmcnt(0)" ::: "memory");
    }
}


#define PSTAMP_(lds_, k_) do { if (threadIdx.x == 0) ((volatile LAS unsigned long long*)((lds_) + LDS_BYTES - 512))[(k_)] = __builtin_amdgcn_s_memrealtime(); } while (0)
#if defined(PROBE_ID) && PROBE_ID >= 216 && PROBE_ID < 220
#define PSTAMP_H(lds_, k_) PSTAMP_(lds_, k_)
#else
#define PSTAMP_H(lds_, k_) do { } while (0)
#endif
#if defined(PROBE_ID) && PROBE_ID >= 220 && PROBE_ID < 230
#define PSTAMP_S(lds_, k_) PSTAMP_(lds_, k_)
#else
#define PSTAMP_S(lds_, k_) do { } while (0)
#endif
namespace scan {
typedef short bf16x8 __attribute__((ext_vector_type(8)));
typedef short bf16x4 __attribute__((ext_vector_type(4)));
constexpr int QI_RS = 272, KT_RS = 160, AI_RS = 160;
constexpr int OFF_QI = 0, OFF_KT = 17408, OFF_VT = 37888, OFF_AI = 58368, OFF_SCL = 68608, SET_BYTES = 70144;
constexpr int PRE_SEG = 0, PRE_QI = 8192, PRE_KI = 8192 + 17408;
#define MFMA16(a, b, c) __builtin_amdgcn_mfma_f32_16x16x32_bf16((a), (b), (c), 0, 0, 0)
__device__ __forceinline__ bf16x8 ld_perm(const LAS unsigned char* p) {
    const bf16x4 lo = *(const LAS bf16x4*)p, hi = *(const LAS bf16x4*)(p + 32);
    return __builtin_shufflevector(lo, hi, 0, 1, 2, 3, 4, 5, 6, 7);
}
__device__ __forceinline__ int tok_row(int g, int i, int b, int dir) {
    if (g < 4) { const int t = 64 * g + i; return MLAT + b * LCX + (dir ? (LCX - 1 - t) : t); }
    const int t = 64 * (g - 4) + i; return b * LX + (dir ? (LX - 1 - t) : t);
}
__device__ __forceinline__ int tok_block(int g, int b, int dir) {
    if (g < 4) return (MLAT / 64) + b * 4 + (dir ? 3 - g : g);
    return b * 64 + (dir ? 63 - (g - 4) : (g - 4));
}
__device__ __forceinline__ void prepass_task(LAS unsigned char* lds, bf16* PA, float* SCL, bf16* AT, const int tb, const int h) {
    int tid_ = threadIdx.x; asm volatile("" : "+v"(tid_));
    const int tid = tid_, lane = tid & 63, w = __builtin_amdgcn_readfirstlane(tid >> 6);
    const int r0 = 64 * tb, colq = h * HD + 2 * lane;
    float qa[2][8], qb[2][8], fa[2][8], fb[2][8];
#pragma unroll
    for (int dir = 0; dir < 2; ++dir)
#pragma unroll
        for (int e = 0; e < 8; ++e) {
            const int i = 8 * w + e, row = r0 + (dir ? 63 - i : i);
            const bf16* p = PA + (size_t)row * PA_LD + colq;
            const unsigned rq = *(const unsigned*)p, rf = *(const unsigned*)(p + 512 + dir * 512);
            qa[dir][e] = bf2f((unsigned short)(rq & 0xffffu)); qb[dir][e] = bf2f((unsigned short)(rq >> 16));
            fa[dir][e] = h2f((unsigned short)(rf & 0xffffu)); fb[dir][e] = h2f((unsigned short)(rf >> 16));
        }
    float pa[2][8], pb[2][8];
#pragma unroll
    for (int dir = 0; dir < 2; ++dir) {
        pa[dir][0] = fa[dir][0]; pb[dir][0] = fb[dir][0];
#pragma unroll
        for (int e = 1; e < 8; ++e) { pa[dir][e] = pa[dir][e - 1] * fa[dir][e]; pb[dir][e] = pb[dir][e - 1] * fb[dir][e]; }
        LAS float* sg = (LAS float*)(lds + PRE_SEG) + dir * 1024 + w * 128 + 2 * lane; sg[0] = pa[dir][7]; sg[1] = pb[dir][7];
    }
    __syncthreads();
#pragma unroll
    for (int dir = 0; dir < 2; ++dir) {
        const LAS float* seg = (const LAS float*)(lds + PRE_SEG) + dir * 1024 + 2 * lane;
        float ma = 1.f, mb = 1.f;
        if (w >= 4) {
#pragma unroll
            for (int s2 = 4; s2 < 7; ++s2) if (s2 < w) { ma *= seg[s2 * 128]; mb *= seg[s2 * 128 + 1]; }
        } else {
#pragma unroll
            for (int s2 = 1; s2 < 4; ++s2) if (s2 > w) { ma *= seg[s2 * 128]; mb *= seg[s2 * 128 + 1]; }
        }
        float xa[8], xb[8];
        if (w >= 4) {
#pragma unroll
            for (int e = 0; e < 8; ++e) { xa[e] = ma * pa[dir][e]; xb[e] = mb * pb[dir][e]; }
        } else {
            float sa = ma, sb = mb;
#pragma unroll
            for (int e = 7; e >= 0; --e) { xa[e] = sa; xb[e] = sb; sa *= fa[dir][e]; sb *= fb[dir][e]; }
        }
        float gma = 1.f, gmb = 1.f, gea = 1.f, geb = 1.f;
#pragma unroll
        for (int s2 = 0; s2 < 4; ++s2) { gma *= seg[s2 * 128]; gmb *= seg[s2 * 128 + 1]; }
#pragma unroll
        for (int s2 = 4; s2 < 8; ++s2) { gea *= seg[s2 * 128]; geb *= seg[s2 * 128 + 1]; }
#pragma unroll
        for (int e = 0; e < 8; ++e) {
            const float ka = 1.0f - fa[dir][e], kb = 1.0f - fb[dir][e];
            const float ra = __builtin_amdgcn_rcpf(fmaxf(xa[e], 1e-30f)), rb = __builtin_amdgcn_rcpf(fmaxf(xb[e], 1e-30f));
            float Qa, Qb, Ka, Kb;
            if (w >= 4) { Qa = qa[dir][e] * xa[e]; Qb = qb[dir][e] * xb[e]; Ka = ka * ra; Kb = kb * rb; }
            else { Qa = qa[dir][e] * ra; Qb = qb[dir][e] * rb; Ka = ka * xa[e]; Kb = kb * xb[e]; }
            const int i = 8 * w + e, row = r0 + (dir ? 63 - i : i);
            bf16* p = PA + (size_t)row * PA_LD + colq;
            const unsigned qw = pk2(Qa, Qb), kw = pk2(Ka, Kb);
            *(unsigned*)(p + (dir ? 2560 : 0)) = pk2(Qa * gma, Qb * gmb);
            *(unsigned*)(p + 512 + dir * 512) = pk2(Ka * gea, Kb * geb);
            *(LAS unsigned*)(lds + PRE_QI + dir * 34816 + i * QI_RS + 4 * lane) = qw;
            *(LAS unsigned*)(lds + PRE_KI + dir * 34816 + i * QI_RS + 4 * lane) = kw;
        }
        if (w == 0) *(f2_t*)(SCL + (size_t)(dir * 544 + tb) * 512 + colq) = (f2_t){gma * gea, gmb * geb};
    }
    __syncthreads();
    {
        const int l15 = lane & 15, q = lane >> 4;
        for (int tt = w; tt < 32; tt += 8) {
            const int dir = tt >> 4, it = (tt & 15) >> 2, jt = tt & 3;
            f32x4 a4 = (f32x4){0.f, 0.f, 0.f, 0.f};
            if (jt <= it) {
#pragma unroll
                for (int ks = 0; ks < 4; ++ks)
                    a4 = MFMA16(ld_perm(lds + PRE_KI + dir * 34816 + (16 * jt + l15) * QI_RS + (32 * ks + 4 * q) * 2), ld_perm(lds + PRE_QI + dir * 34816 + (16 * it + l15) * QI_RS + (32 * ks + 4 * q) * 2), a4);
#pragma unroll
                for (int r = 0; r < 4; ++r) a4[r] = (16 * jt + 4 * q + r <= 16 * it + l15) ? a4[r] : 0.f;
            }
            v2u wv; wv.x = pk2(a4[0], a4[1]); wv.y = pk2(a4[2], a4[3]);
            *(v2u*)(AT + ((size_t)((dir * 544 + tb) * 4 + h)) * 4096 + (16 * it + l15) * 64 + 16 * jt + 4 * q) = wv;
        }
    }
    __syncthreads();
}
__device__ __forceinline__ void scan_unit(LAS unsigned char* lds, bf16* PA, bf16* OC, const float* SCL, const bf16* AT, const int b, const int h, const int dir, const bool ctxunit) {
    int tid_ = threadIdx.x; asm volatile("" : "+v"(tid_));
    const int tid = tid_, lane = tid & 63, w = __builtin_amdgcn_readfirstlane(tid >> 6);
    const int l15 = lane & 15, q = lane >> 4;
    f32x4 S[8];
#pragma unroll
    for (int kt = 0; kt < 8; ++kt) S[kt] = (f32x4){0.f, 0.f, 0.f, 0.f};
    const int nchunk = ctxunit ? 4 : 68;
    const int colq = h * HD + 2 * lane;
    unsigned rq[8], rk[8], rv[8]; v4u ra; f32x4 rs = (f32x4){0.f, 0.f, 0.f, 0.f};
#define SCAN_LOAD(g) do { _Pragma("unroll") for (int e = 0; e < 8; ++e) { const bf16* p_ = PA + (size_t)tok_row((g), 8 * w + e, b, dir) * PA_LD + colq; \
        rq[e] = *(const unsigned*)(p_ + (dir ? 2560 : 0)); rk[e] = *(const unsigned*)(p_ + 512 + dir * 512); rv[e] = *(const unsigned*)(p_ + 1536); } \
        const int tb_ = tok_block((g), b, dir); ra = *(const v4u*)(AT + ((size_t)((dir * 544 + tb_) * 4 + h)) * 4096 + tid * 8); \
        if (tid < 32) rs = *(const f32x4*)(SCL + (size_t)(dir * 544 + tb_) * 512 + h * HD + 4 * tid); } while (0)
#define SCAN_IMG(set_) do { LAS unsigned char* s_ = lds + (set_) * SET_BYTES; v4u t0, t1, u0, u1; \
        _Pragma("unroll") for (int e = 0; e < 8; ++e) *(LAS unsigned*)(s_ + OFF_QI + (8 * w + e) * QI_RS + 4 * lane) = rq[e]; \
        _Pragma("unroll") for (int e = 0; e < 4; ++e) { t0[e] = (rk[2 * e] & 0xffffu) | (rk[2 * e + 1] << 16); t1[e] = (rk[2 * e] >> 16) | (rk[2 * e + 1] & 0xffff0000u); \
            u0[e] = (rv[2 * e] & 0xffffu) | (rv[2 * e + 1] << 16); u1[e] = (rv[2 * e] >> 16) | (rv[2 * e + 1] & 0xffff0000u); } \
        *(LAS v4u*)(s_ + OFF_KT + (2 * lane) * KT_RS + 16 * w) = t0; *(LAS v4u*)(s_ + OFF_KT + (2 * lane + 1) * KT_RS + 16 * w) = t1; \
        *(LAS v4u*)(s_ + OFF_VT + (2 * lane) * KT_RS + 16 * w) = u0; *(LAS v4u*)(s_ + OFF_VT + (2 * lane + 1) * KT_RS + 16 * w) = u1; \
        *(LAS v4u*)(s_ + OFF_AI + (tid >> 3) * AI_RS + 16 * (tid & 7)) = ra; \
        if (tid < 32) *(LAS f32x4*)(s_ + OFF_SCL + 16 * tid) = rs; } while (0)
    PSTAMP_S(lds, 20);
    SCAN_LOAD(0);
    SCAN_IMG(0);
    if (nchunk > 1) SCAN_LOAD(1);
    __syncthreads();
    for (int g = 0; g < nchunk; ++g) {
        const bool do_o = ctxunit || g >= 4;
        if (g + 1 < nchunk) { SCAN_IMG((g + 1) & 1); if (g + 2 < nchunk) SCAN_LOAD(g + 2); }
        const LAS unsigned char* cs = lds + (g & 1) * SET_BYTES;
        const bf16x8 vt0 = *(const LAS bf16x8*)(cs + OFF_VT + (16 * w + l15) * KT_RS + 16 * q);
        const bf16x8 vt1 = *(const LAS bf16x8*)(cs + OFF_VT + (16 * w + l15) * KT_RS + 64 + 16 * q);
        if (do_o) {
            f32x4 O[4];
#pragma unroll
            for (int it = 0; it < 4; ++it) O[it] = (f32x4){0.f, 0.f, 0.f, 0.f};
#pragma unroll
            for (int ks = 0; ks < 4; ++ks) {
                const f32x4 s0 = S[2 * ks], s1 = S[2 * ks + 1];
                v4u pk; pk.x = pk2(s0[0], s0[1]); pk.y = pk2(s0[2], s0[3]); pk.z = pk2(s1[0], s1[1]); pk.w = pk2(s1[2], s1[3]);
                const bf16x8 sf = __builtin_bit_cast(bf16x8, pk);
#pragma unroll
                for (int it = 0; it < 4; ++it) O[it] = MFMA16(sf, ld_perm(cs + OFF_QI + (16 * it + l15) * QI_RS + (32 * ks + 4 * q) * 2), O[it]);
            }
#pragma unroll
            for (int it = 0; it < 4; ++it) {
                O[it] = MFMA16(vt0, *(const LAS bf16x8*)(cs + OFF_AI + (16 * it + l15) * AI_RS + 16 * q), O[it]);
                if (it >= 2) O[it] = MFMA16(vt1, *(const LAS bf16x8*)(cs + OFF_AI + (16 * it + l15) * AI_RS + 64 + 16 * q), O[it]);
            }
#pragma unroll
            for (int it = 0; it < 4; ++it) {
                const int row = tok_row(g, 16 * it + l15, b, dir);
                v2u wv; wv.x = pk2(O[it][0], O[it][1]); wv.y = pk2(O[it][2], O[it][3]);
                bf16* dst = (g < 4) ? OC + (size_t)dir * MCTX * 512 + (size_t)(row - MLAT) * 512 + h * HD + 16 * w + 4 * q
                                    : PA + (size_t)row * PA_LD + 512 + dir * 512 + h * HD + 16 * w + 4 * q;
                *(v2u*)dst = wv;
            }
        }
#pragma unroll
        for (int kt = 0; kt < 8; ++kt) {
            const f32x4 ge = *(const LAS f32x4*)(cs + OFF_SCL + (16 * kt + 4 * q) * 4);
            f32x4 d4 = ge * S[kt];
            d4 = MFMA16(*(const LAS bf16x8*)(cs + OFF_KT + (16 * kt + l15) * KT_RS + 16 * q), vt0, d4);
            S[kt] = MFMA16(*(const LAS bf16x8*)(cs + OFF_KT + (16 * kt + l15) * KT_RS + 64 + 16 * q), vt1, d4);
        }
        __syncthreads();
    }
    PSTAMP_S(lds, 21);
#undef SCAN_LOAD
#undef SCAN_IMG
}
}


namespace hy {
typedef short bf16x8 __attribute__((ext_vector_type(8)));
typedef short bf16x4 __attribute__((ext_vector_type(4)));
constexpr int CS = 16416;
constexpr int VPAD = 7;
constexpr int OFF_F = 0, OFF_V = 4 * CS, V_ROWS = (64 + VPAD + 7) * 8, LDS_END = OFF_V + V_ROWS * 128;
static_assert(LDS_END <= LDS_BYTES - 256, "hyena LDS");
struct ConvW { float x0[4], x1[4], v[4]; };
__device__ __forceinline__ ConvW load_convw(const Args& a, int l, int c) {
    const float* cw = a.in[11] + (size_t)l * 3 * 1536; const float* cb = a.in[12] + (size_t)l * 1536; ConvW r;
#pragma unroll
    for (int j = 0; j < 3; ++j) { r.x0[j] = cw[j * 1536 + c]; r.x1[j] = cw[j * 1536 + 512 + c]; r.v[j] = cw[j * 1536 + 1024 + c]; }
    r.x0[3] = cb[c]; r.x1[3] = cb[512 + c]; r.v[3] = cb[1024 + c];
    return r;
}
__device__ __forceinline__ void hyena_channel(LAS unsigned char* lds, const Args& a, const int l, const int c) {
    int tid_ = threadIdx.x; asm volatile("" : "+v"(tid_));
    const int tid = tid_, lane = tid & 63, w = __builtin_amdgcn_readfirstlane(tid >> 6), l15 = lane & 15, q = lane >> 4;
    unsigned char* ws = a.ws;
    const bf16* PB = (const bf16*)(ws + WS_PB);
    const bf16* x0r = PB + (size_t)c * MTOK; const bf16* x1r = PB + (size_t)(512 + c) * MTOK; const bf16* vr = PB + (size_t)(1024 + c) * MTOK; const bf16* gbr = PB + (size_t)(1536 + c) * MTOK;
    const ConvW cw = load_convw(a, l, c);
    PSTAMP_H(lds, 16);
    {
        const bf16* F = (const bf16*)(ws + WS_FG) + ((size_t)l * 512 + c) * FZ;
        for (int ch = tid; ch < 1024; ch += NTHR) {
            const v4u cur = *(const v4u*)(F + 8 * ch); v4u prev = *(const v4u*)(F + (ch > 0 ? 8 * ch - 8 : 0));
            if (ch == 0) prev = (v4u){0u, 0u, 0u, 0u};
            const unsigned W[8] = {prev.x, prev.y, prev.z, prev.w, cur.x, cur.y, cur.z, cur.w};
            v4u c1, c2, c3;
#pragma unroll
            for (int d = 0; d < 4; ++d) { c1[d] = (W[3 + d] >> 16) | (W[4 + d] << 16); c2[d] = W[3 + d]; c3[d] = (W[2 + d] >> 16) | (W[3 + d] << 16); }
            *(LAS v4u*)(lds + OFF_F + 0 * CS + 16 * ch) = cur;
            *(LAS v4u*)(lds + OFF_F + 1 * CS + 16 * ch) = c1;
            *(LAS v4u*)(lds + OFF_F + 2 * CS + 16 * ch) = c2;
            *(LAS v4u*)(lds + OFF_F + 3 * CS + 16 * ch) = c3;
        }
    }
    {
        for (int e = tid; e < VPAD * 8 * 32; e += NTHR) ((LAS unsigned*)(lds + OFF_V))[e] = 0u;
        for (int e = tid; e < 7 * 8 * 32; e += NTHR) ((LAS unsigned*)(lds + OFF_V + (64 + VPAD) * 8 * 128))[e] = 0u;
        for (int bt = 0; bt < 2; ++bt) {
            v4u vw[4], xw[4]; unsigned short hv[4][2], hx[4][2];
#pragma unroll
            for (int j = 0; j < 4; ++j) {
                const int e = tid + NTHR * (4 * bt + j), b = e >> 9, t0 = (e & 511) * 8;
                const size_t base = (size_t)b * LX + t0;
                const size_t bm = t0 > 0 ? base - 1 : base, bp = t0 + 8 < LX ? base + 8 : base;
                vw[j] = *(const v4u*)(vr + base); xw[j] = *(const v4u*)(x1r + base);
                hv[j][0] = vr[bm]; hv[j][1] = vr[bp]; hx[j][0] = x1r[bm]; hx[j][1] = x1r[bp];
            }
#pragma unroll
            for (int j = 0; j < 4; ++j) {
                const int e = tid + NTHR * (4 * bt + j), b = e >> 9, t0 = (e & 511) * 8, ab = t0 >> 6, ch = (t0 & 63) >> 3;
                float vv[10], xx[10];
                vv[0] = t0 > 0 ? bf2f(hv[j][0]) : 0.f; xx[0] = t0 > 0 ? bf2f(hx[j][0]) : 0.f;
                vv[9] = t0 + 8 < LX ? bf2f(hv[j][1]) : 0.f; xx[9] = t0 + 8 < LX ? bf2f(hx[j][1]) : 0.f;
#pragma unroll
                for (int d = 0; d < 4; ++d) { vv[1 + 2 * d] = bf2f((unsigned short)(vw[j][d] & 0xffffu)); vv[2 + 2 * d] = bf2f((unsigned short)(vw[j][d] >> 16));
                                              xx[1 + 2 * d] = bf2f((unsigned short)(xw[j][d] & 0xffffu)); xx[2 + 2 * d] = bf2f((unsigned short)(xw[j][d] >> 16)); }
                float p[8];
#pragma unroll
                for (int d = 0; d < 8; ++d) p[d] = (cw.v[3] + cw.v[0] * vv[d] + cw.v[1] * vv[d + 1] + cw.v[2] * vv[d + 2]) * (cw.x1[3] + cw.x1[0] * xx[d] + cw.x1[1] * xx[d + 1] + cw.x1[2] * xx[d + 2]);
                v4u o; o.x = pk2(p[0], p[1]); o.y = pk2(p[2], p[3]); o.z = pk2(p[4], p[5]); o.w = pk2(p[6], p[7]);
                const int R = (ab + VPAD) * 8 + b;
                *(LAS v4u*)(lds + OFF_V + R * 128 + 16 * (ch ^ ((R >> 1) & 7))) = o;
            }
        }
    }
    __syncthreads();
    PSTAMP_H(lds, 17);
    f32x4 acc[4][4];
#pragma unroll
    for (int mt = 0; mt < 4; ++mt)
#pragma unroll
        for (int nt = 0; nt < 4; ++nt) acc[mt][nt] = (f32x4){0.f, 0.f, 0.f, 0.f};
    {
        const LAS unsigned char* pa = lds + OFF_F + (l15 & 3) * CS + (4096 - 4 * (l15 >> 2) + 8 * q) * 2 - 96;
        const int rowl = (l15 >> 3) * 8 + (l15 & 7);
        const int cq = (q ^ (rowl >> 1)) & 7;
        const LAS unsigned char* vb0 = lds + OFF_V + rowl * 128 + (8 * w + VPAD) * 1024 + 16 * cq;
        const LAS unsigned char* vb1 = lds + OFF_V + rowl * 128 + (8 * w + VPAD) * 1024 + 16 * (cq ^ 4);
#define HY_LDA(An_, m_) do { const LAS unsigned char* p_ = pa - 128 * (m_); _Pragma("unroll") for (int mt = 0; mt < 4; ++mt) { \
            const bf16x4 lo_ = *(const LAS bf16x4*)(p_ + 32 * (3 - mt)), hi_ = *(const LAS bf16x4*)(p_ + 32 * (3 - mt) + 8); An_[mt] = __builtin_shufflevector(lo_, hi_, 0, 1, 2, 3, 4, 5, 6, 7); } } while (0)
#define HY_LDB(B_, m_, PAR_) do { const LAS unsigned char* p0_ = ((PAR_) ? vb1 : vb0) - 1024 * (m_); const LAS unsigned char* p1_ = ((PAR_) ? vb0 : vb1) - 1024 * (m_); \
            _Pragma("unroll") for (int nt = 0; nt < 4; ++nt) { B_[0][nt] = *(const LAS bf16x8*)(p0_ + 2048 * nt); B_[1][nt] = *(const LAS bf16x8*)(p1_ + 2048 * nt); } } while (0)
#define HY_MMA(An_, Ao0_, Ao1_, B_, m_) do { _Pragma("unroll") for (int nt = 0; nt < 4; ++nt) { const int a0_ = 8 * w + 2 * nt - (m_); if (a0_ + 1 >= 0 && a0_ <= 63) { \
            _Pragma("unroll") for (int mt = 0; mt < 4; ++mt) acc[mt][nt] = __builtin_amdgcn_mfma_f32_16x16x32_bf16(An_[mt], B_[0][nt], acc[mt][nt], 0, 0, 0); \
            acc[0][nt] = __builtin_amdgcn_mfma_f32_16x16x32_bf16(Ao0_, B_[1][nt], acc[0][nt], 0, 0, 0); acc[1][nt] = __builtin_amdgcn_mfma_f32_16x16x32_bf16(Ao1_, B_[1][nt], acc[1][nt], 0, 0, 0); \
            acc[2][nt] = __builtin_amdgcn_mfma_f32_16x16x32_bf16(An_[0], B_[1][nt], acc[2][nt], 0, 0, 0); acc[3][nt] = __builtin_amdgcn_mfma_f32_16x16x32_bf16(An_[1], B_[1][nt], acc[3][nt], 0, 0, 0); } } } while (0)
        bf16x8 Aa[4], Ab[4], Ba[2][4], Bb[2][4], o0, o1;
        const int m0 = 8 * w - 63, mlast = 8 * w + 7;
        { bf16x8 t_[4]; HY_LDA(t_, m0 - 1); o0 = t_[2]; o1 = t_[3]; }
        HY_LDA(Aa, m0); HY_LDB(Ba, m0, 0);
        for (int m = m0; m < mlast; m += 2) {
            HY_LDA(Ab, m + 1); HY_LDB(Bb, m + 1, 1);
            HY_MMA(Aa, o0, o1, Ba, m);
            o0 = Aa[2]; o1 = Aa[3];
            HY_LDA(Aa, m + 2); HY_LDB(Ba, m + 2, 0);
            HY_MMA(Ab, o0, o1, Bb, m + 1);
            o0 = Ab[2]; o1 = Ab[3];
        }
        HY_MMA(Aa, o0, o1, Ba, mlast);
#undef HY_LDA
#undef HY_LDB
#undef HY_MMA
    }
    PSTAMP_H(lds, 18);
    {
        const float inn = 1.0f / ((const float*)(ws + WS_CTL))[CW_NORM + l * 512 + c], hb = a.in[21][l * 512 + c];
        bf16* OBT = (bf16*)(ws + WS_OBT) + (size_t)c * MTOK;
        const int b = l15 & 7;
#pragma unroll
        for (int nt = 0; nt < 4; ++nt) {
            const int ab = 8 * w + 2 * nt + (l15 >> 3), R = (ab + VPAD) * 8 + b;
            v2u xw[4], gw[4]; unsigned short hx[4][2];
#pragma unroll
            for (int mt = 0; mt < 4; ++mt) {
                const int t = 64 * ab + 16 * mt + 4 * q; const size_t base = (size_t)b * LX + t;
                xw[mt] = *(const v2u*)(x0r + base); gw[mt] = *(const v2u*)(gbr + base);
                hx[mt][0] = x0r[t > 0 ? base - 1 : base]; hx[mt][1] = x0r[t + 4 < LX ? base + 4 : base];
            }
#pragma unroll
            for (int mt = 0; mt < 4; ++mt) {
                const int t = 64 * ab + 16 * mt + 4 * q; const size_t base = (size_t)b * LX + t;
                const v2u vw = *(const LAS v2u*)(lds + OFF_V + R * 128 + 16 * ((2 * mt + (q >> 1)) ^ ((R >> 1) & 7)) + 8 * (q & 1));
                float xs[6];
                xs[0] = t > 0 ? bf2f(hx[mt][0]) : 0.f; xs[5] = t + 4 < LX ? bf2f(hx[mt][1]) : 0.f;
                xs[1] = bf2f((unsigned short)(xw[mt].x & 0xffffu)); xs[2] = bf2f((unsigned short)(xw[mt].x >> 16)); xs[3] = bf2f((unsigned short)(xw[mt].y & 0xffffu)); xs[4] = bf2f((unsigned short)(xw[mt].y >> 16));
                const float vv4[4] = {bf2f((unsigned short)(vw.x & 0xffffu)), bf2f((unsigned short)(vw.x >> 16)), bf2f((unsigned short)(vw.y & 0xffffu)), bf2f((unsigned short)(vw.y >> 16))};
                const float g4[4] = {bf2f((unsigned short)(gw[mt].x & 0xffffu)), bf2f((unsigned short)(gw[mt].x >> 16)), bf2f((unsigned short)(gw[mt].y & 0xffffu)), bf2f((unsigned short)(gw[mt].y >> 16))};
                float o[4];
#pragma unroll
                for (int r = 0; r < 4; ++r) {
                    const float x0c = cw.x0[3] + cw.x0[0] * xs[r] + cw.x0[1] * xs[r + 1] + cw.x0[2] * xs[r + 2];
                    o[r] = (acc[mt][nt][r] * inn + vv4[r] * hb) * x0c * silu_f(g4[r]);
                }
                v2u ow; ow.x = pk2(o[0], o[1]); ow.y = pk2(o[2], o[3]);
                *(v2u*)(OBT + base) = ow;
            }
        }
    }
    PSTAMP_H(lds, 19);
    __syncthreads();
}
__device__ __forceinline__ void hyena_ctx_channel(LAS unsigned char* lds, const Args& a, const int c) {
    int tid_ = threadIdx.x; asm volatile("" : "+v"(tid_));
    const int tid = tid_;
    unsigned char* ws = a.ws;
    const bf16* PB = (const bf16*)(ws + WS_PB);
    const bf16* x0r = PB + (size_t)c * MTOK + MLAT; const bf16* x1r = PB + (size_t)(512 + c) * MTOK + MLAT; const bf16* vr = PB + (size_t)(1024 + c) * MTOK + MLAT; const bf16* gbr = PB + (size_t)(1536 + c) * MTOK + MLAT;
    const ConvW cw = load_convw(a, 0, c);
    LAS float* vvc = (LAS float*)lds;
    LAS float* Fc = vvc + 2048;
    for (int e = tid; e < 2048; e += NTHR) {
        const int t = e & 255;
        const float vm_ = bf2f(vr[t > 0 ? e - 1 : e]), v0 = bf2f(vr[e]), vp_ = bf2f(vr[t < 255 ? e + 1 : e]);
        const float xm_ = bf2f(x1r[t > 0 ? e - 1 : e]), x0 = bf2f(x1r[e]), xp_ = bf2f(x1r[t < 255 ? e + 1 : e]);
        const float vm = t > 0 ? vm_ : 0.f, vp = t < 255 ? vp_ : 0.f, xm = t > 0 ? xm_ : 0.f, xp = t < 255 ? xp_ : 0.f;
        vvc[e] = (cw.v[3] + cw.v[0] * vm + cw.v[1] * v0 + cw.v[2] * vp) * (cw.x1[3] + cw.x1[0] * xm + cw.x1[1] * x0 + cw.x1[2] * xp);
    }
    if (tid < 512) Fc[tid] = bf2f(((const bf16*)(ws + WS_FGC))[(size_t)c * FZC + tid]);
    __syncthreads();
    const float inn = 1.0f / ((const float*)(ws + WS_CTL))[CW_NORM + 2 * 512 + c], hb = a.in[21][c];
    bf16* OBT = (bf16*)(ws + WS_OBT) + (size_t)c * MTOK + MLAT;
    const int b = tid >> 6;
#pragma unroll
    for (int i = 0; i < 4; ++i) {
        const int t = (tid & 63) + 64 * i, e = b * 256 + t;
        float s = 0.f;
        for (int s2 = 0; s2 < 256; ++s2) s += Fc[256 - t + s2] * vvc[b * 256 + s2];
        const float xm_ = bf2f(x0r[t > 0 ? e - 1 : e]), x0 = bf2f(x0r[e]), xp_ = bf2f(x0r[t < 255 ? e + 1 : e]);
        const float xm = t > 0 ? xm_ : 0.f, xp = t < 255 ? xp_ : 0.f;
        const float x0c = cw.x0[3] + cw.x0[0] * xm + cw.x0[1] * x0 + cw.x0[2] * xp;
        OBT[e] = (bf16)f2bf((s * inn + vvc[e] * hb) * x0c * silu_f(bf2f(gbr[e])));
    }
    __syncthreads();
}
}


__device__ __forceinline__ void phase_prepass(const Args& a, Frame& F) {
    for (int t = F.vcu; t < 544 * 4; t += F.G) scan::prepass_task(F.lds, (bf16*)(a.ws + WS_PA), (float*)(a.ws + WS_SCL), (bf16*)(a.ws + WS_XA), t >> 2, t & 3);
}

__device__ __forceinline__ void phase_mix(const Args& a, Frame& F, const int l, const int part = -1) {
    unsigned* qctr = (unsigned*)(a.ws + WS_CTL) + CW_QUEUE + 64 * l + (part == 1 ? 128 : 0);
    volatile LAS int* slot = (volatile LAS int*)(F.lds + LDS_BYTES - 64);
    const int ntasks = l == 0 ? 64 + 512 + 64 + 512 : 64 + 512;
    for (;;) {
        if (F.tid == 0) slot[0] = (int)atomicAdd(qctr, 1u);
        __syncthreads();
        const int t = __builtin_amdgcn_readfirstlane(slot[0]);
        __syncthreads();
        if (t >= ntasks) break;
        if (part == 0 && !(t < 64 || (t >= 576 && t < 640))) continue;
        if (part == 1 && (t < 64 || (t >= 576 && t < 640))) continue;
        if (t < 64) scan::scan_unit(F.lds, (bf16*)(a.ws + WS_PA), (bf16*)(a.ws + WS_OC), (const float*)(a.ws + WS_SCL), (const bf16*)(a.ws + WS_XA), t >> 3, (t >> 1) & 3, t & 1, false);
        else if (t < 576) hy::hyena_channel(F.lds, a, l, t - 64);
        else if (t < 640) { const int u = t - 576; scan::scan_unit(F.lds, (bf16*)(a.ws + WS_PA), (bf16*)(a.ws + WS_OC), (const float*)(a.ws + WS_SCL), (const bf16*)(a.ws + WS_XA), u >> 3, (u >> 1) & 3, u & 1, true); }
        else hy::hyena_ctx_channel(F.lds, a, t - 640);
        __syncthreads();
    }
}

__device__ __forceinline__ void phase_finalize_ox(const Args& a, Frame& F, int l) {
    unsigned char* ws = a.ws;
    const bf16* PA = (const bf16*)(ws + WS_PA);
    const bf16* OC = (const bf16*)(ws + WS_OC);
    bf16* XA = (bf16*)(ws + WS_XA);
    const float* gnw = a.in[10] + l * 512;
    const int gw = F.vcu * NWAVES + F.wave, NGW = F.G * NWAVES;
    const int ntok = (l == 0) ? MTOK : MLAT;
    for (int tok = gw; tok < ntok; tok += NGW) {
        const bool isctx = tok >= MLAT;
        const int c8 = 8 * F.lane;
        const bf16* pf = isctx ? OC + (size_t)(tok - MLAT) * 512 + c8 : PA + (size_t)tok * PA_LD + 512 + c8;
        const bf16* pb = isctx ? OC + (size_t)MCTX * 512 + (size_t)(tok - MLAT) * 512 + c8 : PA + (size_t)tok * PA_LD + 1024 + c8;
        const v4u wf = *(const v4u*)pf, wb = *(const v4u*)pb, wg = *(const v4u*)(PA + (size_t)tok * PA_LD + 2048 + c8);
        float o[8], g[8];
#pragma unroll
        for (int e = 0; e < 4; ++e) {
            o[2 * e] = bf2f((unsigned short)(wf[e] & 0xffff)) + bf2f((unsigned short)(wb[e] & 0xffff));
            o[2 * e + 1] = bf2f((unsigned short)(wf[e] >> 16)) + bf2f((unsigned short)(wb[e] >> 16));
            g[2 * e] = bf2f((unsigned short)(wg[e] & 0xffff)); g[2 * e + 1] = bf2f((unsigned short)(wg[e] >> 16));
        }
        float s = 0.f;
#pragma unroll
        for (int e = 0; e < 8; ++e) s += o[e] * o[e];
        s += __shfl_xor(s, 1); s += __shfl_xor(s, 2); s += __shfl_xor(s, 4); s += __shfl_xor(s, 8);
        const float rstd = 1.0f / sqrtf(s * (1.0f / HD) + EPS);
        float y[8];
#pragma unroll
        for (int e = 0; e < 8; ++e) y[e] = o[e] * rstd * gnw[c8 + e] * silu_f(g[e]);
        v4u w; w.x = pk2(y[0], y[1]); w.y = pk2(y[2], y[3]); w.z = pk2(y[4], y[5]); w.w = pk2(y[6], y[7]);
        *(v4u*)(XA + (size_t)tok * D + c8) = w;
    }
    LAS unsigned short* t = (LAS unsigned short*)(F.lds + F.wave * 16384);
    const int ntt = ntok / 64;
    for (int it = gw; it < 8 * ntt; it += NGW) {
        const int ct = it / ntt, tt = it % ntt, c0 = ct * 64, t0 = tt * 64;
        const bf16* OBT = (const bf16*)(ws + WS_OBT);
#pragma unroll
        for (int i = 0; i < 8; ++i) {
            const int e = F.lane + 64 * i, c = e >> 3, ch = e & 7;
            const v4u w = *(const v4u*)(OBT + (size_t)(c0 + c) * MTOK + t0 + 8 * ch);
#pragma unroll
            for (int q = 0; q < 4; ++q) { t[c * 66 + 8 * ch + 2 * q] = (unsigned short)(w[q] & 0xffff); t[c * 66 + 8 * ch + 2 * q + 1] = (unsigned short)(w[q] >> 16); }
        }
        asm volatile("s_waitcnt lgkmcnt(0)" ::: "memory");
#pragma unroll
        for (int i = 0; i < 8; ++i) {
            const int e = F.lane + 64 * i, tk = e >> 3, cg = e & 7;
            unsigned short h[8];
#pragma unroll
            for (int q = 0; q < 8; ++q) h[q] = t[(8 * cg + q) * 66 + tk];
            v4u w; w.x = h[0] | ((unsigned)h[1] << 16); w.y = h[2] | ((unsigned)h[3] << 16); w.z = h[4] | ((unsigned)h[5] << 16); w.w = h[6] | ((unsigned)h[7] << 16);
            *(v4u*)(XA + (size_t)(t0 + tk) * D + 512 + c0 + 8 * cg) = w;
        }
        asm volatile("s_waitcnt lgkmcnt(0)" ::: "memory");
    }
}

__device__ __forceinline__ void phase_final_norm(const Args& a, Frame& F) {
    const float* w = a.in[22];
    const int gw = F.vcu * NWAVES + F.wave, NGW = F.G * NWAVES;
    for (int tok = gw; tok < MLAT; tok += NGW) {
        float* xr = a.out + (size_t)tok * D;
        f32x4 v[4]; float s = 0.f;
#pragma unroll
        for (int j = 0; j < 4; ++j) { v[j] = *(const f32x4*)(xr + 256 * j + 4 * F.lane); s += (v[j].x * v[j].x + v[j].y * v[j].y) + (v[j].z * v[j].z + v[j].w * v[j].w); }
        const float rstd = 1.0f / sqrtf(wave_sum(s) * (1.0f / D) + EPS);
#pragma unroll
        for (int j = 0; j < 4; ++j) { const f32x4 w4 = *(const f32x4*)(w + 256 * j + 4 * F.lane); *(f32x4*)(xr + 256 * j + 4 * F.lane) = v[j] * rstd * w4; }
    }
}

enum { PH_PRO = 0, PH_NORM0 = 1, PH_IN0 = 2, PH_PRE0 = 3, PH_MIX0 = 4, PH_FIN0 = 5, PH_OUT0 = 6, PH_NORM1 = 7, PH_IN1 = 8, PH_PRE1 = 9, PH_MIX1 = 10, PH_FIN1 = 11, PH_OUT1 = 12, PH_FINAL = 13 };

__device__ __forceinline__ Frame mkframe(unsigned char* lds) {
    Frame F;
    F.lds = (LAS unsigned char*)lds;
    F.tid = threadIdx.x; F.lane = F.tid & 63; F.wave = __builtin_amdgcn_readfirstlane(F.tid >> 6);
    F.G = gridDim.x; { const int bx = blockIdx.x; F.vcu = (F.G % 8 == 0) ? (bx % 8) * (F.G / 8) + bx / 8 : bx; }
    return F;
}
template <int l> __device__ __forceinline__ void run_inproj(const Args& args, unsigned char* lds) {
    unsigned char* ws = args.ws; Frame F = mkframe(lds);
    pg8::Gemm g{(const bf16*)(ws + WS_XA), (const bf16*)(ws + WS_WIN) + (size_t)l * NIN * D, D};
    pg8::Sched S; S.init(128, 18, F.G, (int)blockIdx.x, 8, l == 0 ? 18 : 8);
    EpiIn E{(bf16*)(ws + WS_PA), (bf16*)(ws + WS_PB), (const float*)(ws + WS_LBS) + l * 1024};
    pg8::gemm_phase<EpiIn, true, true>(F.lds, g, S, E);
}
template <int l> __device__ __forceinline__ void run_outproj(const Args& args, unsigned char* lds) {
    unsigned char* ws = args.ws; Frame F = mkframe(lds);
    pg8::Gemm g{(const bf16*)(ws + WS_XA), (const bf16*)(ws + WS_WOUT) + (size_t)l * D * D, D};
    pg8::Sched S; S.init(128, 4, F.G, (int)blockIdx.x, l == 0 ? 8 : 0, 4);
    EpiOut E{l == 0 ? args.in[0] : args.out, args.out, args.in[2], (float*)(ws + WS_CTX1), (const float*)(ws + WS_MOD) + (size_t)l * 9 * 3 * D};
    pg8::gemm_phase<EpiOut, true, true>(F.lds, g, S, E);
}
__global__ void __launch_bounds__(NTHR, 2) mega(Args args) {
    extern __shared__ __attribute__((aligned(16))) unsigned char lds[];
    const int lo = args.ph_lo, hi = args.ph_hi;
#define IN(k) (lo <= (k) && (k) < hi)
    volatile LAS unsigned* bst = (volatile LAS unsigned*)((LAS unsigned char*)lds + LDS_BYTES - 32);
    if (threadIdx.x < 8) ((volatile LAS unsigned*)((LAS unsigned char*)lds + LDS_BYTES - 32))[threadIdx.x] = 0u;
    __syncthreads();
    XcdBarrier bar; bar.bar = (unsigned*)(args.ws + WS_CTL) + CW_BAR; bar.x = 0; bar.st = bst;
    if (hi - lo > 1) bar = xcd_barrier_post((unsigned*)(args.ws + WS_CTL) + CW_BAR, bst);
#ifdef PROBE_ID
    volatile LAS unsigned long long* pts = (volatile LAS unsigned long long*)((LAS unsigned char*)lds + LDS_BYTES - 512);
    if (threadIdx.x == 0) pts[0] = __builtin_amdgcn_s_memrealtime();
#define SEAM(k) do { if (IN((k) + 1)) xcd_barrier(bar); else __syncthreads(); if (threadIdx.x == 0) pts[(k) + 1] = __builtin_amdgcn_s_memrealtime(); } while (0)
#else
#define SEAM(k) do { if (IN((k) + 1)) xcd_barrier(bar); else __syncthreads(); } while (0)
#endif
    if (IN(PH_PRO)) { Frame F = mkframe(lds); phase_prologue(args, F); SEAM(PH_PRO); }
    if (IN(PH_NORM0)) { Frame F = mkframe(lds); phase_normrows(args, F, 0, args.in[0], args.in[2]); phase_filter_finalize(args, F); SEAM(PH_NORM0); }
    if (IN(PH_IN0)) { run_inproj<0>(args, lds); SEAM(PH_IN0); }
    if (IN(PH_PRE0)) { Frame F = mkframe(lds); phase_prepass(args, F); SEAM(PH_PRE0); }
#ifdef SPLIT_MIX
    if (IN(PH_MIX0)) { Frame F = mkframe(lds); phase_mix(args, F, 0, 0); xcd_barrier(bar); if (threadIdx.x == 0) pts[15] = __builtin_amdgcn_s_memrealtime(); phase_mix(args, F, 0, 1); SEAM(PH_MIX0); }
#else
    if (IN(PH_MIX0)) { Frame F = mkframe(lds); phase_mix(args, F, 0); SEAM(PH_MIX0); }
#endif
    if (IN(PH_FIN0)) { Frame F = mkframe(lds); phase_finalize_ox(args, F, 0); SEAM(PH_FIN0); }
    if (IN(PH_OUT0)) { run_outproj<0>(args, lds); SEAM(PH_OUT0); }
    if (IN(PH_NORM1)) { Frame F = mkframe(lds); phase_normrows(args, F, 1, args.out, (const float*)(args.ws + WS_CTX1)); SEAM(PH_NORM1); }
    if (IN(PH_IN1)) { run_inproj<1>(args, lds); SEAM(PH_IN1); }
    if (IN(PH_PRE1)) { Frame F = mkframe(lds); phase_prepass(args, F); SEAM(PH_PRE1); }
    if (IN(PH_MIX1)) { Frame F = mkframe(lds); phase_mix(args, F, 1); SEAM(PH_MIX1); }
    if (IN(PH_FIN1)) { Frame F = mkframe(lds); phase_finalize_ox(args, F, 1); SEAM(PH_FIN1); }
    if (IN(PH_OUT1)) { run_outproj<1>(args, lds); SEAM(PH_OUT1); }
    if (IN(PH_FINAL)) { Frame F = mkframe(lds); phase_final_norm(args, F); SEAM(PH_FINAL); }
#ifdef PROBE_ID
    if (blockIdx.x == 0 && threadIdx.x == 0) {
#ifdef SPLIT_MIX
        const unsigned long long dt = (PROBE_ID == 100) ? pts[15] - pts[PH_MIX0] : pts[PH_MIX0 + 1] - pts[15];
#else
        const unsigned long long dt = (PROBE_ID >= 200) ? (PROBE_ID == 220 ? 1ull : 16ull) * (pts[PROBE_ID - 200 + 1] - pts[PROBE_ID - 200]) : pts[PROBE_ID + 1] - pts[PROBE_ID];
#endif
        const unsigned long long t0 = __builtin_amdgcn_s_memrealtime();
        unsigned long long wt = 4ull * dt; if (wt > 300000ull) wt = 300000ull;
        while (__builtin_amdgcn_s_memrealtime() - t0 < wt) __builtin_amdgcn_s_sleep(8);
    }
#endif
#undef IN
#undef SEAM
}

extern "C" void kernel_launch(void* const* d_in, const int* in_sizes, int n_in, void* d_out, int out_size, void* d_ws, size_t ws_size, hipStream_t stream) {
    static int grid = 0;
    if (grid == 0) {
        if (n_in != 23 || ws_size < WS_END) { fprintf(stderr, "kernel_launch: unexpected n_in %d / ws_size %zu\n", n_in, ws_size); grid = -1; return; }
        int dev = 0, cus = 0;
        if (hipGetDevice(&dev) != hipSuccess || hipDeviceGetAttribute(&cus, hipDeviceAttributeMultiprocessorCount, dev) != hipSuccess) { grid = -1; return; }
        if (hipFuncSetAttribute((const void*)mega, hipFuncAttributeMaxDynamicSharedMemorySize, LDS_BYTES) != hipSuccess) { fprintf(stderr, "kernel_launch: hipFuncSetAttribute failed\n"); grid = -1; return; }
        grid = cus;
    }
    if (grid < 0) return;
    (void)hipMemsetAsync((char*)d_ws + WS_CTL, 0, CTL_ZERO_BYTES, stream);
    Args a{};
    for (int i = 0; i < 23; ++i) a.in[i] = (const float*)d_in[i];
    a.out = (float*)d_out; a.ws = (unsigned char*)d_ws;
    a.ph_lo = 0; a.ph_hi = PH_FINAL + 1;
    hipLaunchKernelGGL(mega, dim3(grid), dim3(NTHR), LDS_BYTES, stream, a);
}
```

```cpp
#include <hip/hip_runtime.h>
#include <cstdio>
#include <cstdint>
#include <math.h>

namespace pg8 {
#define PG8_LAS __attribute__((address_space(3)))
typedef unsigned short bf16_t;
typedef short bf16x8 __attribute__((ext_vector_type(8)));
typedef float f32x4 __attribute__((ext_vector_type(4)));
typedef unsigned u32x4 __attribute__((ext_vector_type(4)));
typedef unsigned u32x2 __attribute__((ext_vector_type(2)));
constexpr int BM = 256, BK = 64, HALF = 128, HTB = HALF * BK * 2, STAGE_BYTES = 8 * HTB, NXCD = 8, WGM = 8;

__host__ __device__ __forceinline__ int lds_byte(int r, int c) { const int st = (r >> 4) * 2 + (c >> 5), rr = r & 15, cc = c & 31, ob = rr * 64 + cc * 2; return st * 1024 + (ob ^ (((ob >> 9) & 1) << 5)); }
__host__ __device__ __forceinline__ void stage_rc(int b, int& R, int& C) { const int st = b / 1024, sb = b % 1024, swz = sb ^ (((sb >> 9) & 1) << 5); R = (st >> 1) * 16 + swz / 64; C = (st & 1) * 32 + (swz % 64) / 2; }
__host__ __device__ __forceinline__ int perm32(int rho) { const int n = rho >> 4, i = rho & 15; return 8 * (i >> 2) + 4 * n + (i & 3); }

struct Unit { int pm, pn; };
struct Gemm { const bf16_t* A; const bf16_t* Bt; int K; };

struct Sched {
    int nM, nN, nwg, G, c, nctx, nctxN;
    __device__ void init(int nM_, int nN_, int G_, int c_, int nctxM, int nctxN_) { nM = nM_; nN = nN_; nwg = nM * nN; G = G_; c = c_; nctx = nctxM * nctxN_; nctxN = nctxN_ > 0 ? nctxN_ : 1; }
    __device__ bool next(int i, Unit& u) const {
        const long L = (long)i * G + c;
        if (L >= nwg) { const long L2 = L - nwg; if (L2 >= nctx) return false; u.pm = nM + (int)(L2 / nctxN); u.pn = (int)(L2 % nctxN); return true; }
        int wgid = (int)L; { const int q = nwg / NXCD, r = nwg % NXCD, xcd = wgid % NXCD, off = wgid / NXCD; wgid = (xcd < r ? xcd * (q + 1) : r * (q + 1) + (xcd - r) * q) + off; }
        const int nig = WGM * nN, gid = wgid / nig, fm = gid * WGM, gsz = (nM - fm) < WGM ? (nM - fm) : WGM;
        u.pm = fm + ((wgid % nig) % gsz); u.pn = (wgid % nig) / gsz; return true;
    }
};

template <class Epi, bool ALIGN_EPI, bool SP2>
__device__ __forceinline__ void gemm_phase(PG8_LAS unsigned char* lds, const Gemm g, const Sched& S, const Epi& E) {
    const int tid = threadIdx.x, wid = __builtin_amdgcn_readfirstlane(tid >> 6), lane = tid & 63, wr = wid >> 2, wc = wid & 3, fr = lane & 15, fq = lane >> 4;
    const int K = g.K, nt = K / BK;
    unsigned voffA[2], voffB[2];
#pragma unroll
    for (int i = 0; i < 2; ++i) { int R, C; stage_rc(tid * 16 + i * 8192, R, C); const int Rb = Epi::PERM ? ((R & ~31) + perm32(R & 31)) : R;
        voffA[i] = (unsigned)(R * K + C) * 2u; voffB[i] = (unsigned)(Rb * K + C) * 2u; }
    const size_t kstep = (size_t)(BK * 2);
    const size_t hstep = (size_t)HALF * K * 2;
    const size_t tstep = 2 * hstep;
    const unsigned ldsw = (unsigned)wid * 1024u;
    const int aoff = lds_byte(wr * 64 + fr, fq * 8), boff = lds_byte(wc * 32 + fr, fq * 8);
#define PG8_SA(b, h) (((b) * 2 + (h)) * HTB)
#define PG8_SB(b, h) ((4 + (b) * 2 + (h)) * HTB)
#define PG8_STAGE(bufoff, gbase, voff) do { _Pragma("unroll") for (int _i = 0; _i < 2; ++_i) \
        __builtin_amdgcn_global_load_lds((const unsigned*)((const char*)(gbase) + (voff)[_i]), (PG8_LAS unsigned*)(lds + (bufoff) + ldsw + _i * 8192), 16, 0, 0); } while (0)
#define PG8_LDA(dst, b, h) do { _Pragma("unroll") for (int m = 0; m < 4; ++m) _Pragma("unroll") for (int k = 0; k < 2; ++k) dst[m][k] = *(const PG8_LAS bf16x8*)(lds + PG8_SA(b, h) + aoff + m * 2048 + k * 1024); } while (0)
#define PG8_LDB(dst, b, h) do { _Pragma("unroll") for (int n = 0; n < 2; ++n) _Pragma("unroll") for (int k = 0; k < 2; ++k) dst[n][k] = *(const PG8_LAS bf16x8*)(lds + PG8_SB(b, h) + boff + n * 2048 + k * 1024); } while (0)
#define PG8_MMA(ai, bj, At, Bt) do { __builtin_amdgcn_s_setprio(1); _Pragma("unroll") for (int m = 0; m < 4; ++m) _Pragma("unroll") for (int n = 0; n < 2; ++n) _Pragma("unroll") for (int k = 0; k < 2; ++k) \
        acc[ai][bj][m][n] = __builtin_amdgcn_mfma_f32_16x16x32_bf16(Bt[n][k], At[m][k], acc[ai][bj][m][n], 0, 0, 0); __builtin_amdgcn_s_setprio(0); } while (0)
#define PG8_WAIT_V(n) asm volatile("s_waitcnt vmcnt(" #n ")" ::: "memory")
#define PG8_WAIT_L(n) asm volatile("s_waitcnt lgkmcnt(" #n ")" ::: "memory")
#define PG8_BAR __builtin_amdgcn_s_barrier()
#define PG8_SCHED __builtin_amdgcn_sched_barrier(0)
    Unit cur, nxt; int ui = 0;
    if (!S.next(0, cur)) return;
    f32x4 acc[2][2][4][2];
#pragma unroll
    for (int a = 0; a < 2; ++a)
#pragma unroll
        for (int b = 0; b < 2; ++b)
#pragma unroll
            for (int m = 0; m < 4; ++m)
#pragma unroll
                for (int n = 0; n < 2; ++n) acc[a][b][m][n] = (f32x4){0.f, 0.f, 0.f, 0.f};
    bf16x8 At[4][2], B0[2][2], B1[2][2];
    const char* cA = E.swap(cur) ? (const char*)g.Bt + (size_t)cur.pn * tstep : (const char*)g.A + (size_t)cur.pm * tstep;
    const char* cB = E.swap(cur) ? (const char*)g.A + (size_t)cur.pm * tstep : (const char*)g.Bt + (size_t)cur.pn * tstep;
    if constexpr (SP2) {
        PG8_STAGE(PG8_SB(0, 0), cB, voffB); PG8_STAGE(PG8_SB(0, 1), cB + hstep, voffB); PG8_STAGE(PG8_SA(0, 0), cA, voffA); PG8_STAGE(PG8_SA(0, 1), cA + hstep, voffA);
        if (wr == 1) PG8_BAR;
        PG8_WAIT_V(2); PG8_BAR;
        PG8_STAGE(PG8_SB(1, 0), cB + kstep, voffB); PG8_STAGE(PG8_SA(1, 0), cA + kstep, voffA); PG8_STAGE(PG8_SB(1, 1), cB + hstep + kstep, voffB);
        PG8_WAIT_V(6); PG8_BAR;
    } else {
        PG8_STAGE(PG8_SB(0, 0), cB, voffB); PG8_STAGE(PG8_SA(0, 0), cA, voffA); PG8_STAGE(PG8_SB(0, 1), cB + hstep, voffB); PG8_STAGE(PG8_SA(0, 1), cA + hstep, voffA);
        if (wr == 1) PG8_BAR;
        PG8_WAIT_V(4); PG8_BAR;
        PG8_STAGE(PG8_SB(1, 0), cB + kstep, voffB); PG8_STAGE(PG8_SA(1, 0), cA + kstep, voffA); PG8_STAGE(PG8_SB(1, 1), cB + hstep + kstep, voffB);
        PG8_WAIT_V(6); PG8_BAR;
    }
    for (;;) {
        const bool has_next = S.next(ui + 1, nxt);
        const bool nsw = has_next && E.swap(nxt);
        const char* nA = has_next ? (nsw ? (const char*)g.Bt + (size_t)nxt.pn * tstep : (const char*)g.A + (size_t)nxt.pm * tstep) : cA;
        const char* nB = has_next ? (nsw ? (const char*)g.A + (size_t)nxt.pm * tstep : (const char*)g.Bt + (size_t)nxt.pn * tstep) : cB;
        for (int t = 0; t < nt; t += 2) {
            const bool last = (t == nt - 2);
            const char* a1 = cA + (size_t)(t + 1) * kstep;
            const char* a2 = last ? nA : cA + (size_t)(t + 2) * kstep; const char* b2 = last ? nB : cB + (size_t)(t + 2) * kstep;
            const char* a3 = a2 + kstep; const char* b3 = b2 + kstep;
            if constexpr (SP2) {
            PG8_LDB(B0, 0, 0); PG8_LDB(B1, 0, 1); PG8_SCHED; PG8_LDA(At, 0, 0); PG8_STAGE(PG8_SA(1, 1), a1 + hstep, voffA);
            PG8_WAIT_V(8); PG8_WAIT_L(0); PG8_BAR; PG8_MMA(0, 0, At, B0); PG8_MMA(0, 1, At, B1); PG8_BAR; PG8_SCHED;
            PG8_LDA(At, 0, 1); PG8_STAGE(PG8_SB(0, 0), b2, voffB); PG8_STAGE(PG8_SB(0, 1), b2 + hstep, voffB); PG8_STAGE(PG8_SA(0, 0), a2, voffA);
            PG8_WAIT_V(8); PG8_WAIT_L(0); PG8_BAR; PG8_MMA(1, 0, At, B0); PG8_MMA(1, 1, At, B1); PG8_BAR; PG8_SCHED;
            PG8_LDB(B0, 1, 0); PG8_LDB(B1, 1, 1); PG8_SCHED; PG8_LDA(At, 1, 0); PG8_STAGE(PG8_SA(0, 1), a2 + hstep, voffA);
            PG8_WAIT_V(8); PG8_WAIT_L(0); PG8_BAR; PG8_MMA(0, 0, At, B0); PG8_MMA(0, 1, At, B1); PG8_BAR; PG8_SCHED;
            PG8_LDA(At, 1, 1); PG8_STAGE(PG8_SB(1, 0), b3, voffB); PG8_STAGE(PG8_SB(1, 1), b3 + hstep, voffB); PG8_STAGE(PG8_SA(1, 0), a3, voffA);
            PG8_WAIT_V(8); PG8_WAIT_L(0); PG8_BAR; PG8_MMA(1, 0, At, B0); PG8_MMA(1, 1, At, B1); PG8_BAR; PG8_SCHED;
            } else {
            PG8_LDB(B0, 0, 0); PG8_SCHED; PG8_LDA(At, 0, 0); PG8_STAGE(PG8_SA(1, 1), a1 + hstep, voffA);
            PG8_WAIT_L(8); PG8_BAR; PG8_WAIT_L(0); PG8_MMA(0, 0, At, B0); PG8_BAR; PG8_SCHED;
            PG8_LDB(B1, 0, 1); PG8_STAGE(PG8_SB(0, 0), b2, voffB);
            PG8_BAR; PG8_WAIT_L(0); PG8_MMA(0, 1, At, B1); PG8_BAR;
            PG8_LDA(At, 0, 1); PG8_STAGE(PG8_SA(0, 0), a2, voffA);
            PG8_BAR; PG8_WAIT_L(0); PG8_MMA(1, 0, At, B0); PG8_BAR; PG8_SCHED;
            PG8_STAGE(PG8_SB(0, 1), b2 + hstep, voffB);
            PG8_WAIT_V(6); PG8_BAR; PG8_MMA(1, 1, At, B1); PG8_BAR;
            PG8_LDB(B0, 1, 0); PG8_SCHED; PG8_LDA(At, 1, 0); PG8_STAGE(PG8_SA(0, 1), a2 + hstep, voffA);
            PG8_WAIT_L(8); PG8_BAR; PG8_WAIT_L(0); PG8_MMA(0, 0, At, B0); PG8_BAR; PG8_SCHED;
            PG8_LDB(B1, 1, 1); PG8_STAGE(PG8_SB(1, 0), b3, voffB);
            PG8_BAR; PG8_WAIT_L(0); PG8_MMA(0, 1, At, B1); PG8_BAR;
            PG8_LDA(At, 1, 1); PG8_STAGE(PG8_SA(1, 0), a3, voffA);
            PG8_BAR; PG8_WAIT_L(0); PG8_MMA(1, 0, At, B0); PG8_BAR; PG8_SCHED;
            PG8_STAGE(PG8_SB(1, 1), b3 + hstep, voffB);
            PG8_WAIT_V(6); PG8_BAR; PG8_MMA(1, 1, At, B1); PG8_BAR;
            }
        }
        if constexpr (ALIGN_EPI) { if (wr == 0) PG8_BAR; }
        E(acc, cur, wr, wc, fr, fq);
        if (!has_next) break;
#pragma unroll
        for (int a = 0; a < 2; ++a)
#pragma unroll
            for (int b = 0; b < 2; ++b)
#pragma unroll
                for (int m = 0; m < 4; ++m)
#pragma unroll
                    for (int n = 0; n < 2; ++n) acc[a][b][m][n] = (f32x4){0.f, 0.f, 0.f, 0.f};
        cur = nxt; cA = nA; cB = nB; ++ui;
        if constexpr (ALIGN_EPI) { if (wr == 1) PG8_BAR; }
    }
    PG8_WAIT_V(0);
    if constexpr (!ALIGN_EPI) { if (wr == 0) PG8_BAR; }
    PG8_BAR;
#undef PG8_SA
#undef PG8_SB
#undef PG8_STAGE
#undef PG8_LDA
#undef PG8_LDB
#undef PG8_MMA
#undef PG8_WAIT_V
#undef PG8_WAIT_L
#undef PG8_BAR
#undef PG8_SCHED
}
}

constexpr int D = 1024, NB = 8, LX = 4096, LCX = 256, NIN = 4608, DA = 512, DB = 512, HD = 128;
constexpr int MLAT = NB * LX, MCTX = NB * LCX, MTOK = MLAT + MCTX;
constexpr int PA_LD = 3072;
constexpr int FZ = 8448, FZC = 640;
constexpr float EPS = 1e-6f;
constexpr float HY_MIN_DECAY = -3.0701134573253944f, HY_MAX_DECAY = -15.350567286626972f;
constexpr int NWAVES = 8, NTHR = 512;

constexpr size_t MiB = 1u << 20;
constexpr size_t WS_CTL = 0, CTL_ZERO_BYTES = 1 * MiB;
constexpr size_t WS_MOD = 1 * MiB;
constexpr size_t WS_LBS = WS_MOD + 256 * 1024;
constexpr size_t WS_WIN = 6 * MiB;
constexpr size_t WS_WOUT = 24 * MiB;
constexpr size_t WS_FG = 28 * MiB;
constexpr size_t WS_FGC = 45 * MiB;
constexpr size_t WS_CTX1 = 46 * MiB;
constexpr size_t WS_OC = 2 * MiB;
constexpr size_t WS_XA = 54 * MiB;
constexpr size_t WS_PA = 122 * MiB;
constexpr size_t WS_PB = 326 * MiB;
constexpr size_t WS_OBT = 462 * MiB;
constexpr size_t WS_HK = 326 * MiB;
constexpr size_t WS_SCL = 496 * MiB;
constexpr size_t WS_END = 504 * MiB;
constexpr int CW_NORM = 1024;
constexpr int CW_BAR = 8192;
constexpr int CW_QUEUE = 4096;

constexpr int LDS_BYTES = 156 * 1024;
#define LAS __attribute__((address_space(3)))
#define GAS __attribute__((address_space(1)))
typedef unsigned short bf16;
typedef unsigned v4u __attribute__((ext_vector_type(4)));
typedef unsigned v2u __attribute__((ext_vector_type(2)));
typedef float f32x4 __attribute__((ext_vector_type(4)));

typedef __bf16 bf2_t __attribute__((ext_vector_type(2)));
typedef float f2_t __attribute__((ext_vector_type(2)));
__device__ __forceinline__ unsigned pk2(float lo, float hi) { const f2_t v = {lo, hi}; return __builtin_bit_cast(unsigned, __builtin_convertvector(v, bf2_t)); }
__device__ __forceinline__ unsigned f2bf(float f) { return pk2(f, 0.f) & 0xffffu; }
__device__ __forceinline__ float bf2f(unsigned short h) { return __builtin_bit_cast(float, (unsigned)h << 16); }
__device__ __forceinline__ unsigned f2h(float f) { _Float16 h = (_Float16)f; return (unsigned)__builtin_bit_cast(unsigned short, h); }
__device__ __forceinline__ unsigned pk2h(float lo, float hi) { return f2h(lo) | (f2h(hi) << 16); }
__device__ __forceinline__ float h2f(unsigned short u) { return (float)__builtin_bit_cast(_Float16, u); }
__device__ __forceinline__ float silu_f(float x) { return x / (1.0f + __expf(-x)); }
__device__ __forceinline__ float sigmoid_f(float x) { return 1.0f / (1.0f + __expf(-x)); }
__device__ __forceinline__ float wave_sum(float v) {
#pragma unroll
    for (int o = 1; o < 64; o <<= 1) v += __shfl_xor(v, o);
    return v;
}


#define PSTAMP_(lds_, k_) do { if (threadIdx.x == 0) ((volatile LAS unsigned long long*)((lds_) + LDS_BYTES - 512))[(k_)] = __builtin_amdgcn_s_memrealtime(); } while (0)
#if defined(PROBE_ID) && PROBE_ID >= 216 && PROBE_ID < 220
#define PSTAMP_H(lds_, k_) PSTAMP_(lds_, k_)
#else
#define PSTAMP_H(lds_, k_) do { } while (0)
#endif
#if defined(PROBE_ID) && PROBE_ID >= 226 && PROBE_ID < 230
#define PSTAMP_P(lds_, k_) PSTAMP_(lds_, k_)
#else
#define PSTAMP_P(lds_, k_) do { } while (0)
#endif
#if defined(PROBE_ID) && PROBE_ID >= 220 && PROBE_ID < 226
#define PSTAMP_S(lds_, k_) PSTAMP_(lds_, k_)
#else
#define PSTAMP_S(lds_, k_) do { } while (0)
#endif
typedef GAS unsigned gu32;
#define XB_TMO      128
#define XB_XCNT(j)  (256  + 64 * (j))
#define XB_XSUB(j)  (1280 + 64 * (j))
#define XB_XGEN(j)  (2304 + 64 * (j))
#define XB_TOP      3328
#define XB_TOPGEN   3392
#define XCD_BAR_WORDS 3456
#define XB_SPIN_CAP (1u << 18)
__device__ __forceinline__ unsigned xb_ld(unsigned* p)              { return __hip_atomic_load(p, __ATOMIC_RELAXED, __HIP_MEMORY_SCOPE_AGENT); }
__device__ __forceinline__ unsigned xb_add(unsigned* p, unsigned v) { return __hip_atomic_fetch_add(p, v, __ATOMIC_RELAXED, __HIP_MEMORY_SCOPE_AGENT); }
__device__ __forceinline__ unsigned xb_xcc_id() { return (unsigned)__builtin_amdgcn_s_getreg((3 << 11) | 20) & 0xFu; }
#define XB_SPIN(cond, bar) do { unsigned _sp = 0; while (cond) { __builtin_amdgcn_s_sleep(1); \
    if ((++_sp & 255u) == 0u) { if (xb_ld(&(bar)[XB_TMO])) break; if (_sp > XB_SPIN_CAP) { atomicAdd(&(bar)[XB_TMO], 1u); break; } } } } while (0)
struct XcdBarrier { unsigned* bar; unsigned x; volatile LAS unsigned* st; };
__device__ __forceinline__ XcdBarrier xcd_barrier_post(unsigned* bar, volatile LAS unsigned* st) {
    XcdBarrier b; b.bar = bar; b.x = xb_xcc_id(); b.st = st;
    if (threadIdx.x == 0) (void)xb_add(&bar[XB_XCNT(b.x)], 1u);
    return b;
}
__device__ __forceinline__ void xcd_barrier_complete(unsigned* bar, unsigned x, unsigned& nloc, unsigned& nx) {
    const unsigned G = gridDim.x * gridDim.y * gridDim.z;
    unsigned sum, cnt, mine, sp = 0u;
    for (;;) {
        sum = 0u; cnt = 0u; mine = 0u;
#pragma unroll
        for (unsigned j = 0; j < 16; ++j) { const unsigned c = xb_ld(&bar[XB_XCNT(j)]); sum += c; cnt += (c > 0u) ? 1u : 0u; mine = (j == x) ? c : mine; }
        if (sum == G) break;
        __builtin_amdgcn_s_sleep(1);
        if ((++sp & 255u) == 0u) { if (xb_ld(&bar[XB_TMO])) break; if (sp > XB_SPIN_CAP) { atomicAdd(&bar[XB_TMO], 1u); break; } }
    }
    nloc = mine > 0u ? mine : 1u; nx = cnt > 0u ? cnt : 1u;
}
__device__ __forceinline__ void xcd_barrier(const XcdBarrier& b) {
    asm volatile("s_waitcnt vmcnt(0)" ::: "memory");
    __syncthreads();
    if (threadIdx.x == 0) {
        unsigned* bar = b.bar;
        __builtin_amdgcn_s_waitcnt(0);
        unsigned nloc = b.st[0], nx = b.st[1];
        if (nloc == 0u) { xcd_barrier_complete(bar, b.x, nloc, nx); b.st[0] = nloc; b.st[1] = nx; }
        const unsigned old = xb_add(&bar[XB_XSUB(b.x)], 1u);
        const unsigned gen = old / nloc;
        if (old + 1u == (gen + 1u) * nloc) {
            __builtin_amdgcn_fence(__ATOMIC_RELEASE, "agent");
            asm volatile("s_waitcnt vmcnt(0)" ::: "memory");
            const unsigned og = xb_add(&bar[XB_TOP], 1u);
            const unsigned tg = og / nx;
            if (og + 1u == (tg + 1u) * nx) xb_add(&bar[XB_TOPGEN], 1u);
            else XB_SPIN(xb_ld(&bar[XB_TOPGEN]) == tg, bar);
            __builtin_amdgcn_fence(__ATOMIC_ACQUIRE, "agent");
            xb_add(&bar[XB_XGEN(b.x)], 1u);
            asm volatile("s_waitcnt vmcnt(0)" ::: "memory");
        } else {
            XB_SPIN(xb_ld(&bar[XB_XGEN(b.x)]) == gen, bar);
            __builtin_amdgcn_fence(__ATOMIC_ACQUIRE, "agent");
            asm volatile("s_waitcnt vmcnt(0)" ::: "memory");
        }
    }
    __syncthreads();
}

struct EpiIn {
    static constexpr bool PERM = true;
    bf16* PA; bf16* PB; const float* lb;
    __device__ __forceinline__ bool swap(const pg8::Unit& u) const { return u.pn >= 10; }
    __device__ __forceinline__ void operator()(const f32x4 (&acc)[2][2][4][2], const pg8::Unit& u, int wr, int wc, int fr, int fq) const {
        if (u.pn < 10) {
            const int type = u.pn >> 1;
            const int row0 = u.pm * 256 + wr * 64 + fr, col0 = u.pn * 256 + wc * 32 + 8 * fq;
#pragma unroll
            for (int bj = 0; bj < 2; ++bj) {
                float lbv[8];
#pragma unroll
                for (int e = 0; e < 8; ++e) lbv[e] = (type == 1 || type == 2) ? lb[col0 + bj * 128 + e - 512] : 0.f;
#pragma unroll
                for (int ai = 0; ai < 2; ++ai)
#pragma unroll
                    for (int m = 0; m < 4; ++m) {
                        bf16* rowp = PA + (size_t)(row0 + ai * 128 + m * 16) * PA_LD + col0 + bj * 128;
                        float x[8];
#pragma unroll
                        for (int e = 0; e < 4; ++e) { x[e] = acc[ai][bj][m][0][e]; x[4 + e] = acc[ai][bj][m][1][e]; }
                        v4u w;
                        if (type == 0) {
#pragma unroll
                            for (int e = 0; e < 8; ++e) x[e] = silu_f(x[e]);
                            w.x = pk2(x[0], x[1]); w.y = pk2(x[2], x[3]); w.z = pk2(x[4], x[5]); w.w = pk2(x[6], x[7]);
                        } else if (type == 1 || type == 2) {
#pragma unroll
                            for (int e = 0; e < 8; ++e) x[e] = lbv[e] + (1.0f - lbv[e]) * sigmoid_f(x[e]);
                            w.x = pk2h(x[0], x[1]); w.y = pk2h(x[2], x[3]); w.z = pk2h(x[4], x[5]); w.w = pk2h(x[6], x[7]);
                        } else {
                            w.x = pk2(x[0], x[1]); w.y = pk2(x[2], x[3]); w.z = pk2(x[4], x[5]); w.w = pk2(x[6], x[7]);
                        }
                        *(v4u*)rowp = w;
                        asm volatile("" ::: "memory");
                    }
            }
        } else {
#pragma unroll
            for (int ai = 0; ai < 2; ++ai)
#pragma unroll
                for (int m = 0; m < 4; ++m) {
                    const int cw = u.pn * 256 + ai * 128 + wr * 64 + m * 16 + fr;
                    bf16* colp = PB + (size_t)(cw - 2560) * MTOK + u.pm * 256 + wc * 32 + 8 * fq;
#pragma unroll
                    for (int bj = 0; bj < 2; ++bj) {
                        const f32x4 v0 = acc[ai][bj][m][0], v1 = acc[ai][bj][m][1];
                        v4u w; w.x = pk2(v0[0], v0[1]); w.y = pk2(v0[2], v0[3]); w.z = pk2(v1[0], v1[1]); w.w = pk2(v1[2], v1[3]);
                        *(v4u*)(colp + bj * 128) = w;
                    }
                }
        }
    }
};
struct EpiOut {
    static constexpr bool PERM = false;
    const float* xin_lat; float* out_lat; const float* xin_ctx; float* out_ctx; const float* mod;
    __device__ __forceinline__ bool swap(const pg8::Unit&) const { return false; }
    __device__ __forceinline__ void operator()(const f32x4 (&acc)[2][2][4][2], const pg8::Unit& u, int wr, int wc, int fr, int fq) const {
        const bool isctx = u.pm >= 128;
        const int col0 = u.pn * 256 + wc * 32 + 4 * fq;
#pragma unroll
        for (int ai = 0; ai < 2; ++ai)
#pragma unroll
            for (int m = 0; m < 4; ++m) {
                const int row = u.pm * 256 + ai * 128 + wr * 64 + m * 16 + fr;
                const int rl = isctx ? row - MLAT : row;
                const int mr = isctx ? 8 : (row >> 12);
                const float* xi = (isctx ? xin_ctx : xin_lat) + (size_t)rl * D + col0;
                float* xo = (isctx ? out_ctx : out_lat) + (size_t)rl * D + col0;
                const float* gt = mod + (size_t)mr * 3 * D + 2 * D + col0;
#pragma unroll
                for (int bj = 0; bj < 2; ++bj)
#pragma unroll
                    for (int n = 0; n < 2; ++n) {
                        const int o = bj * 128 + n * 16;
                        const f32x4 xv = *(const f32x4*)(xi + o), gv = *(const f32x4*)(gt + o);
                        *(f32x4*)(xo + o) = xv + gv * acc[ai][bj][m][n];
                    }
            }
    }
};

struct Args {
    const float* in[23]; float* out; unsigned char* ws; int ph_lo, ph_hi;
};

struct Frame {
    LAS unsigned char* lds; int tid, lane, wave, vcu, G;
};

__device__ __forceinline__ void p0_transpose_item(const float* W, int K, int N, bf16* WT, LAS float* scr, int item, int lane) {
    const int nblk = N / 32, kb = item / nblk, nb = item % nblk, k0 = 64 * kb, n0 = 32 * nb;
#pragma unroll 8
    for (int i = 0; i < 32; ++i) { const int kk = 2 * i + (lane >> 5); scr[kk * 33 + (lane & 31)] = W[(size_t)(k0 + kk) * N + n0 + (lane & 31)]; }
    asm volatile("s_waitcnt lgkmcnt(0)" ::: "memory");
    const int c = lane & 7;
#pragma unroll
    for (int j = 0; j < 4; ++j) { const int n = (lane >> 3) + 8 * j; const LAS float* s = scr + (8 * c) * 33 + n;
        v4u o; o.x = pk2(s[0 * 33], s[1 * 33]); o.y = pk2(s[2 * 33], s[3 * 33]); o.z = pk2(s[4 * 33], s[5 * 33]); o.w = pk2(s[6 * 33], s[7 * 33]);
        *(v4u*)(WT + (size_t)(n0 + n) * K + k0 + 8 * c) = o; }
    asm volatile("s_waitcnt lgkmcnt(0)" ::: "memory");
}

__device__ __forceinline__ void filter_task(const Args& a, Frame& F, const int set, const int n0, int& cached_layer) {
    unsigned char* ws = a.ws;
    const int l = set == 1 ? 1 : 0, L = set == 2 ? 256 : 4096;
    LAS float* w1s = (LAS float*)F.lds;
    LAS float* w2s = w1s + 33 * 64;
    LAS float* w3s = w2s + 64 * 64;
    LAS float* bs = w3s + 64 * 64;
    LAS float* zs = bs + 256;
    LAS float* h3s = zs + 8 * 4 * 64;
    LAS unsigned short* tile = (LAS unsigned short*)(h3s + 32 * 64);
    if (cached_layer != l) {
        __syncthreads();
        for (int e = F.tid; e < 33 * 64; e += NTHR) w1s[e] = a.in[13][l * 33 * 64 + e];
        for (int e = F.tid; e < 4096; e += NTHR) { w2s[e] = a.in[16][l * 4096 + e]; w3s[e] = a.in[18][l * 4096 + e]; }
        if (F.tid < 64) { bs[F.tid] = a.in[14][l * 64 + F.tid]; bs[64 + F.tid] = a.in[17][l * 64 + F.tid]; bs[128 + F.tid] = a.in[19][l * 64 + F.tid]; bs[192 + F.tid] = a.in[15][l * 64 + F.tid]; }
        cached_layer = l;
        __syncthreads();
    }
    {
        const int j = F.lane; LAS float* zw = zs + F.wave * 256; const float fr = bs[192 + j];
#pragma unroll
        for (int p = 0; p < 4; ++p) {
            const int n = n0 + 4 * F.wave + p;
            float zv = 0.f;
            if (j == 0) zv = (float)n / (float)(L - 1);
            else if (j < 33) { const int i = (j - 1) & 15; const double f = 1e-4 + (double)i * ((15.0 - 1e-4) / 15.0); double rev = f * (double)n / (double)L; rev -= floor(rev);
                const float ang = (float)(rev * 6.283185307179586476925); zv = (j <= 16) ? __cosf(ang) : -__sinf(ang); }
            zw[p * 64 + j] = zv;
        }
        asm volatile("s_waitcnt lgkmcnt(0)" ::: "memory");
        float s4[4];
#pragma unroll
        for (int p = 0; p < 4; ++p) s4[p] = bs[j];
        for (int e = 0; e < 33; ++e) { const float wv = w1s[e * 64 + j];
#pragma unroll
            for (int p = 0; p < 4; ++p) s4[p] += zw[p * 64 + e] * wv; }
        asm volatile("s_waitcnt lgkmcnt(0)" ::: "memory");
#pragma unroll
        for (int p = 0; p < 4; ++p) zw[p * 64 + j] = __sinf(fr * s4[p]);
        asm volatile("s_waitcnt lgkmcnt(0)" ::: "memory");
#pragma unroll
        for (int p = 0; p < 4; ++p) s4[p] = bs[64 + j];
        for (int e = 0; e < 64; ++e) { const float wv = w2s[e * 64 + j];
#pragma unroll
            for (int p = 0; p < 4; ++p) s4[p] += zw[p * 64 + e] * wv; }
        asm volatile("s_waitcnt lgkmcnt(0)" ::: "memory");
#pragma unroll
        for (int p = 0; p < 4; ++p) zw[p * 64 + j] = __sinf(fr * s4[p]);
        asm volatile("s_waitcnt lgkmcnt(0)" ::: "memory");
#pragma unroll
        for (int p = 0; p < 4; ++p) s4[p] = bs[128 + j];
        for (int e = 0; e < 64; ++e) { const float wv = w3s[e * 64 + j];
#pragma unroll
            for (int p = 0; p < 4; ++p) s4[p] += zw[p * 64 + e] * wv; }
#pragma unroll
        for (int p = 0; p < 4; ++p) h3s[(4 * F.wave + p) * 64 + j] = __sinf(fr * s4[p]);
    }
    __syncthreads();
    {
        const int c2 = 2 * F.tid;
        const float* w4 = a.in[20] + (size_t)l * 64 * 1024 + c2;
        f2_t acc[32];
#pragma unroll
        for (int p = 0; p < 32; ++p) acc[p] = (f2_t){0.f, 0.f};
        for (int jb = 0; jb < 8; ++jb) {
            f2_t wv[8];
#pragma unroll
            for (int jj = 0; jj < 8; ++jj) wv[jj] = *(const f2_t*)(w4 + (size_t)(8 * jb + jj) * 1024);
#pragma unroll
            for (int p = 0; p < 32; ++p) {
                const f32x4 ha = *(const LAS f32x4*)(h3s + p * 64 + 8 * jb), hb = *(const LAS f32x4*)(h3s + p * 64 + 8 * jb + 4);
                acc[p] += wv[0] * ha[0]; acc[p] += wv[1] * ha[1]; acc[p] += wv[2] * ha[2]; acc[p] += wv[3] * ha[3];
                acc[p] += wv[4] * hb[0]; acc[p] += wv[5] * hb[1]; acc[p] += wv[6] * hb[2]; acc[p] += wv[7] * hb[3];
            }
        }
        float ns[2] = {0.f, 0.f};
        const int c = c2 & 511;
        const float d0 = fabsf(HY_MIN_DECAY + (float)c * ((HY_MAX_DECAY - HY_MIN_DECAY) / 511.0f)), d1 = fabsf(HY_MIN_DECAY + (float)(c + 1) * ((HY_MAX_DECAY - HY_MIN_DECAY) / 511.0f));
#pragma unroll
        for (int p = 0; p < 32; ++p) {
            const int nn = n0 + p; const float t = (float)nn / (float)(L - 1);
            const float v0 = acc[p][0] * __expf(-t * d0), v1 = acc[p][1] * __expf(-t * d1);
            if (c2 < 512 || nn >= 1) { ns[0] += fabsf(v0); ns[1] += fabsf(v1); }
            tile[c2 * 34 + p] = (unsigned short)f2bf(v0); tile[(c2 + 1) * 34 + p] = (unsigned short)f2bf(v1);
        }
        float* nrm = (float*)(ws + WS_CTL) + CW_NORM;
        atomicAdd(&nrm[set * 512 + c], ns[0]);
        atomicAdd(&nrm[set * 512 + c + 1], ns[1]);
    }
    __syncthreads();
    {
        bf16* dst = set == 2 ? (bf16*)(ws + WS_FGC) : (bf16*)(ws + WS_FG) + (size_t)set * 512 * FZ;
        const int ld = set == 2 ? FZC : FZ;
        for (int e = F.tid; e < 1024 * 32; e += NTHR) {
            const int col = e >> 5, p = e & 31, c = col & 511, n = n0 + p;
            const unsigned short v = tile[col * 34 + p];
            if (col < 512) dst[(size_t)c * ld + (L - n)] = v;
            else if (n >= 1) dst[(size_t)c * ld + (L + n)] = v;
        }
        if (n0 == 0) {
            const int npad = ld - 2 * L;
            for (int e = F.tid; e < 512 * (npad + 1); e += NTHR) { const int c = e / (npad + 1), k = e % (npad + 1); dst[(size_t)c * ld + (k == 0 ? 0 : 2 * L + k - 1)] = 0; }
        }
    }
    __syncthreads();
}

__device__ __forceinline__ void phase_prologue(const Args& a, Frame& F) {
    unsigned char* ws = a.ws;
    if (F.vcu == 0) {
        float* lbs = (float*)(ws + WS_LBS);
        for (int i = F.tid; i < 1024; i += NTHR) {
            const float a0 = a.in[9][i], a1 = a.in[9][1024 + i];
            const float m = fmaxf(a0, a1), e0 = expf(a0 - m), e1 = expf(a1 - m);
            const float p0 = e0 / (e0 + e1), p1 = e1 / (e0 + e1);
            const float c0 = p0, c1 = p0 + p1;
            lbs[i] = c0 - c0; lbs[1024 + i] = c1 - c0;
        }
    }
    unsigned* qctr = (unsigned*)(ws + WS_CTL) + CW_QUEUE + 256;
    volatile LAS int* slot = (volatile LAS int*)(F.lds + LDS_BYTES - 64);
    int cached_layer = -1; bool first_big = true;
    PSTAMP_P(F.lds, 26);
    constexpr int I_IN = (D / 64) * (NIN / 32), I_OUT = (D / 64) * (D / 32), NTR = 2 * (I_IN + I_OUT) / 8;
    for (;;) {
        if (F.tid == 0) slot[0] = (int)atomicAdd(qctr, 1u);
        __syncthreads();
        const int t = __builtin_amdgcn_readfirstlane(slot[0]);
        __syncthreads();
        if (t >= 8 + 96 + NTR + 256) break;
        if (t < 8) filter_task(a, F, 2, 32 * t, cached_layer);
        else if (t < 104) {
            const int task = t - 8;
            LAS float* sv = (LAS float*)(F.lds + 65536);
            LAS float* part = sv + 9 * 1024;
            const int l = task / 48, n0 = (task % 48) * 64;
            for (int e = F.tid; e < 9 * 1024; e += NTHR) { const int r = e >> 10, k = e & 1023; const float cv = r < 8 ? a.in[1][r * D + k] : a.in[3][k]; sv[e] = cv / (1.0f + expf(-cv)); }
            __syncthreads();
            float acc9[9];
#pragma unroll
            for (int r = 0; r < 9; ++r) acc9[r] = 0.f;
            const float* w = a.in[5] + (size_t)l * D * 3 * D + n0 + F.lane;
#pragma unroll 8
            for (int k = F.wave * 128; k < F.wave * 128 + 128; ++k) {
                const float wv = w[(size_t)k * 3 * D];
#pragma unroll
                for (int r = 0; r < 9; ++r) acc9[r] += sv[r * 1024 + k] * wv;
            }
#pragma unroll
            for (int r = 0; r < 9; ++r) part[(F.wave * 9 + r) * 64 + F.lane] = acc9[r];
            __syncthreads();
            for (int e = F.tid; e < 9 * 64; e += NTHR) {
                const int r = e >> 6, c = e & 63; float sum = 0.f;
#pragma unroll
                for (int w8 = 0; w8 < 8; ++w8) sum += part[(w8 * 9 + r) * 64 + c];
                ((float*)(ws + WS_MOD))[((size_t)l * 9 + r) * 3 * D + n0 + c] = sum + a.in[6][l * 3 * D + n0 + c];
            }
            __syncthreads();
        } else if (t < 104 + NTR) {
            LAS float* scr = (LAS float*)(F.lds + 65536 + F.wave * 8704);
            int r = (t - 104) * 8 + F.wave; const int l = r / (I_IN + I_OUT); r -= l * (I_IN + I_OUT);
            if (r < I_IN) p0_transpose_item(a.in[7] + (size_t)l * D * NIN, D, NIN, (bf16*)(ws + WS_WIN) + (size_t)l * NIN * D, scr, r, F.lane);
            else p0_transpose_item(a.in[8] + (size_t)l * D * D, D, D, (bf16*)(ws + WS_WOUT) + (size_t)l * D * D, scr, r - I_IN, F.lane);
            __syncthreads();
        } else { if (first_big) { PSTAMP_P(F.lds, 27); first_big = false; } const int ft = t - 104 - NTR; filter_task(a, F, ft >> 7, 32 * (ft & 127), cached_layer); PSTAMP_P(F.lds, 28); }
    }
    PSTAMP_P(F.lds, 29);
}

__device__ __forceinline__ void phase_normrows(const Args& a, Frame& F, int l, const float* xlat, const float* xctx) {
    unsigned char* ws = a.ws;
    const float* nw = a.in[4] + l * D;
    const float* mod = (const float*)(ws + WS_MOD) + (size_t)l * 9 * 3 * D;
    bf16* XA = (bf16*)(ws + WS_XA);
    const int gw = F.vcu * NWAVES + F.wave, NGW = F.G * NWAVES;
    for (int tok = gw; tok < MTOK; tok += NGW) {
        const bool isctx = tok >= MLAT;
        const float* xr = isctx ? xctx + (size_t)(tok - MLAT) * D : xlat + (size_t)tok * D;
        const int mr = isctx ? 8 : (tok >> 12);
        const float* sh = mod + (size_t)mr * 3 * D; const float* sc = sh + D;
        f32x4 v[4]; float s = 0.f;
#pragma unroll
        for (int j = 0; j < 4; ++j) { v[j] = *(const f32x4*)(xr + 256 * j + 4 * F.lane); s += (v[j].x * v[j].x + v[j].y * v[j].y) + (v[j].z * v[j].z + v[j].w * v[j].w); }
        const float rstd = 1.0f / sqrtf(wave_sum(s) * (1.0f / D) + EPS);
#pragma unroll
        for (int j = 0; j < 4; ++j) {
            const int k = 256 * j + 4 * F.lane;
            const f32x4 w4 = *(const f32x4*)(nw + k), s4 = *(const f32x4*)(sc + k), h4 = *(const f32x4*)(sh + k);
            const f32x4 y = v[j] * rstd * w4 * (s4 + 1.0f) + h4;
            v2u o; o.x = pk2(y.x, y.y); o.y = pk2(y.z, y.w);
            *(v2u*)(XA + (size_t)tok * D + k) = o;
        }
    }
}


namespace scan {
typedef short bf16x8 __attribute__((ext_vector_type(8)));
typedef short bf16x4 __attribute__((ext_vector_type(4)));
constexpr int QI_RS = 264, KT_RS = 160, AI_RS = 160;
constexpr int OFF_QI = 0, OFF_KT = 17408, OFF_VT = 37888, OFF_AI = 58368, OFF_SCL = 68608, SET_BYTES = 70144;
constexpr int PRE_SEG = 0, PRE_QI = 8192, PRE_KI = 8192 + 17408;
#define MFMA16(a, b, c) __builtin_amdgcn_mfma_f32_16x16x32_bf16((a), (b), (c), 0, 0, 0)
__device__ __forceinline__ bf16x8 ld_perm(const LAS unsigned char* p) {
    const bf16x4 lo = *(const LAS bf16x4*)p, hi = *(const LAS bf16x4*)(p + 32);
    return __builtin_shufflevector(lo, hi, 0, 1, 2, 3, 4, 5, 6, 7);
}
__device__ __forceinline__ int tok_row(int g, int i, int b, int dir) {
    if (g < 4) { const int t = 64 * g + i; return MLAT + b * LCX + (dir ? (LCX - 1 - t) : t); }
    const int t = 64 * (g - 4) + i; return b * LX + (dir ? (LX - 1 - t) : t);
}
__device__ __forceinline__ int tok_block(int g, int b, int dir) {
    if (g < 4) return (MLAT / 64) + b * 4 + (dir ? 3 - g : g);
    return b * 64 + (dir ? 63 - (g - 4) : (g - 4));
}
__device__ __forceinline__ void prepass_task(LAS unsigned char* lds, bf16* PA, float* SCL, bf16* AT, const int tb, const int h) {
    int tid_ = threadIdx.x; asm volatile("" : "+v"(tid_));
    const int tid = tid_, lane = tid & 63, w = __builtin_amdgcn_readfirstlane(tid >> 6);
    const int r0 = 64 * tb, colq = h * HD + 2 * lane;
    float qa[2][8], qb[2][8], fa[2][8], fb[2][8];
#pragma unroll
    for (int dir = 0; dir < 2; ++dir)
#pragma unroll
        for (int e = 0; e < 8; ++e) {
            const int i = 8 * w + e, row = r0 + (dir ? 63 - i : i);
            const bf16* p = PA + (size_t)row * PA_LD + colq;
            const unsigned rq = *(const unsigned*)p, rf = *(const unsigned*)(p + 512 + dir * 512);
            qa[dir][e] = bf2f((unsigned short)(rq & 0xffffu)); qb[dir][e] = bf2f((unsigned short)(rq >> 16));
            fa[dir][e] = h2f((unsigned short)(rf & 0xffffu)); fb[dir][e] = h2f((unsigned short)(rf >> 16));
        }
    float pa[2][8], pb[2][8];
#pragma unroll
    for (int dir = 0; dir < 2; ++dir) {
        pa[dir][0] = fa[dir][0]; pb[dir][0] = fb[dir][0];
#pragma unroll
        for (int e = 1; e < 8; ++e) { pa[dir][e] = pa[dir][e - 1] * fa[dir][e]; pb[dir][e] = pb[dir][e - 1] * fb[dir][e]; }
        LAS float* sg = (LAS float*)(lds + PRE_SEG) + dir * 1024 + w * 128 + 2 * lane; sg[0] = pa[dir][7]; sg[1] = pb[dir][7];
    }
    __syncthreads();
#pragma unroll
    for (int dir = 0; dir < 2; ++dir) {
        const LAS float* seg = (const LAS float*)(lds + PRE_SEG) + dir * 1024 + 2 * lane;
        float ma = 1.f, mb = 1.f;
        if (w >= 4) {
#pragma unroll
            for (int s2 = 4; s2 < 7; ++s2) if (s2 < w) { ma *= seg[s2 * 128]; mb *= seg[s2 * 128 + 1]; }
        } else {
#pragma unroll
            for (int s2 = 1; s2 < 4; ++s2) if (s2 > w) { ma *= seg[s2 * 128]; mb *= seg[s2 * 128 + 1]; }
        }
        float xa[8], xb[8];
        if (w >= 4) {
#pragma unroll
            for (int e = 0; e < 8; ++e) { xa[e] = ma * pa[dir][e]; xb[e] = mb * pb[dir][e]; }
        } else {
            float sa = ma, sb = mb;
#pragma unroll
            for (int e = 7; e >= 0; --e) { xa[e] = sa; xb[e] = sb; sa *= fa[dir][e]; sb *= fb[dir][e]; }
        }
        float gma = 1.f, gmb = 1.f, gea = 1.f, geb = 1.f;
#pragma unroll
        for (int s2 = 0; s2 < 4; ++s2) { gma *= seg[s2 * 128]; gmb *= seg[s2 * 128 + 1]; }
#pragma unroll
        for (int s2 = 4; s2 < 8; ++s2) { gea *= seg[s2 * 128]; geb *= seg[s2 * 128 + 1]; }
#pragma unroll
        for (int e = 0; e < 8; ++e) {
            const float ka = 1.0f - fa[dir][e], kb = 1.0f - fb[dir][e];
            const float ra = __builtin_amdgcn_rcpf(fmaxf(xa[e], 1e-30f)), rb = __builtin_amdgcn_rcpf(fmaxf(xb[e], 1e-30f));
            float Qa, Qb, Ka, Kb;
            if (w >= 4) { Qa = qa[dir][e] * xa[e]; Qb = qb[dir][e] * xb[e]; Ka = ka * ra; Kb = kb * rb; }
            else { Qa = qa[dir][e] * ra; Qb = qb[dir][e] * rb; Ka = ka * xa[e]; Kb = kb * xb[e]; }
            const int i = 8 * w + e, row = r0 + (dir ? 63 - i : i);
            bf16* p = PA + (size_t)row * PA_LD + colq;
            const unsigned qw = pk2(Qa, Qb), kw = pk2(Ka, Kb);
            *(unsigned*)(p + (dir ? 2560 : 0)) = pk2(Qa * gma, Qb * gmb);
            *(unsigned*)(p + 512 + dir * 512) = pk2(Ka * gea, Kb * geb);
            *(LAS unsigned*)(lds + PRE_QI + dir * 34816 + i * QI_RS + 4 * lane) = qw;
            *(LAS unsigned*)(lds + PRE_KI + dir * 34816 + i * QI_RS + 4 * lane) = kw;
        }
        if (w == 0) *(f2_t*)(SCL + (size_t)(dir * 544 + tb) * 512 + colq) = (f2_t){gma * gea, gmb * geb};
    }
    __syncthreads();
    {
        const int l15 = lane & 15, q = lane >> 4;
        for (int tt = w; tt < 32; tt += 8) {
            const int dir = tt >> 4, it = (tt & 15) >> 2, jt = tt & 3;
            f32x4 a4 = (f32x4){0.f, 0.f, 0.f, 0.f};
            if (jt <= it) {
#pragma unroll
                for (int ks = 0; ks < 4; ++ks)
                    a4 = MFMA16(ld_perm(lds + PRE_KI + dir * 34816 + (16 * jt + l15) * QI_RS + (32 * ks + 4 * q) * 2), ld_perm(lds + PRE_QI + dir * 34816 + (16 * it + l15) * QI_RS + (32 * ks + 4 * q) * 2), a4);
#pragma unroll
                for (int r = 0; r < 4; ++r) a4[r] = (16 * jt + 4 * q + r <= 16 * it + l15) ? a4[r] : 0.f;
            }
            v2u wv; wv.x = pk2(a4[0], a4[1]); wv.y = pk2(a4[2], a4[3]);
            *(v2u*)(AT + ((size_t)((dir * 544 + tb) * 4 + h)) * 4096 + (16 * it + l15) * 64 + 16 * jt + 4 * q) = wv;
        }
    }
    __syncthreads();
}
__device__ __forceinline__ void scan_unit(LAS unsigned char* lds, bf16* PA, bf16* OC, const float* SCL, const bf16* AT, const int b, const int h, const int dir, const bool ctxunit) {
    int tid_ = threadIdx.x; asm volatile("" : "+v"(tid_));
    const int tid = tid_, lane = tid & 63, w = __builtin_amdgcn_readfirstlane(tid >> 6);
    const int l15 = lane & 15, q = lane >> 4;
    const int nchunk = ctxunit ? 4 : 68;
    if (w >= 4) {
        const int pw = w - 4, ptid = tid - 256, th = lane >> 5, kq = lane & 31, colq = h * HD + 4 * kq;
        v2u qA[8], kA[8], vA[8], qB[8], kB[8], vB[8]; v4u a0A, a1A, a0B, a1B; f32x4 sA = (f32x4){0.f, 0.f, 0.f, 0.f}, sB = sA;
#define SCAN_LOAD(g, Q_, K_, V_, A0_, A1_, S_) do { _Pragma("unroll") for (int e = 0; e < 8; ++e) { const bf16* p_ = PA + (size_t)tok_row((g), 16 * pw + 8 * th + e, b, dir) * PA_LD + colq; \
            Q_[e] = *(const v2u*)(p_ + (dir ? 2560 : 0)); K_[e] = *(const v2u*)(p_ + 512 + dir * 512); V_[e] = *(const v2u*)(p_ + 1536); } \
            const int tb_ = tok_block((g), b, dir); const bf16* at_ = AT + ((size_t)((dir * 544 + tb_) * 4 + h)) * 4096 + ptid * 16; A0_ = *(const v4u*)at_; A1_ = *(const v4u*)(at_ + 8); \
            S_ = *(const f32x4*)(SCL + (size_t)(dir * 544 + tb_) * 512 + h * HD + 4 * (ptid & 31)); } while (0)
#define SCAN_IMG(set_, Q_, K_, V_, A0_, A1_, S_) do { LAS unsigned char* s_ = lds + (set_) * SET_BYTES; \
            _Pragma("unroll") for (int e = 0; e < 8; ++e) *(LAS v2u*)(s_ + OFF_QI + (16 * pw + 8 * th + e) * QI_RS + 8 * kq) = Q_[e]; \
            _Pragma("unroll") for (int d = 0; d < 4; ++d) { v4u t_, u_; \
                _Pragma("unroll") for (int e = 0; e < 4; ++e) { const unsigned ka_ = (d & 2) ? K_[2 * e].y : K_[2 * e].x, kb_ = (d & 2) ? K_[2 * e + 1].y : K_[2 * e + 1].x, va_ = (d & 2) ? V_[2 * e].y : V_[2 * e].x, vb_ = (d & 2) ? V_[2 * e + 1].y : V_[2 * e + 1].x; \
                    t_[e] = (d & 1) ? ((ka_ >> 16) | (kb_ & 0xffff0000u)) : ((ka_ & 0xffffu) | (kb_ << 16)); u_[e] = (d & 1) ? ((va_ >> 16) | (vb_ & 0xffff0000u)) : ((va_ & 0xffffu) | (vb_ << 16)); } \
                *(LAS v4u*)(s_ + OFF_KT + (4 * kq + d) * KT_RS + 16 * ((2 * pw + th) ^ (kq & 7))) = t_; *(LAS v4u*)(s_ + OFF_VT + (4 * kq + d) * KT_RS + 16 * ((2 * pw + th) ^ (kq & 7))) = u_; } \
            *(LAS v4u*)(s_ + OFF_AI + (ptid >> 2) * AI_RS + 32 * (ptid & 3)) = A0_; *(LAS v4u*)(s_ + OFF_AI + (ptid >> 2) * AI_RS + 32 * (ptid & 3) + 16) = A1_; \
            if (ptid < 32) *(LAS f32x4*)(s_ + OFF_SCL + 16 * ptid) = S_; } while (0)
        const int last = nchunk - 1;
        SCAN_LOAD(0, qA, kA, vA, a0A, a1A, sA);
        SCAN_LOAD(1, qB, kB, vB, a0B, a1B, sB);
        SCAN_IMG(0, qA, kA, vA, a0A, a1A, sA);
        SCAN_LOAD(2, qA, kA, vA, a0A, a1A, sA);
        __syncthreads();
        for (int g = 0; g < nchunk; g += 2) {
            SCAN_IMG(1, qB, kB, vB, a0B, a1B, sB);
            { const int gn = g + 3 < last ? g + 3 : last; SCAN_LOAD(gn, qB, kB, vB, a0B, a1B, sB); }
            __syncthreads();
            SCAN_IMG(0, qA, kA, vA, a0A, a1A, sA);
            { const int gn = g + 4 < last ? g + 4 : last; SCAN_LOAD(gn, qA, kA, vA, a0A, a1A, sA); }
            __syncthreads();
        }
#undef SCAN_LOAD
#undef SCAN_IMG
    } else {
        f32x4 S[2][8];
#pragma unroll
        for (int c = 0; c < 2; ++c)
#pragma unroll
            for (int kt = 0; kt < 8; ++kt) S[c][kt] = (f32x4){0.f, 0.f, 0.f, 0.f};
        const int vc0 = 32 * w;
        if (!ctxunit) PSTAMP_S(lds, 20);
        __syncthreads();
        for (int g = 0; g < nchunk; ++g) {
            const bool do_o = ctxunit || g >= 4;
            if (g == 30) PSTAMP_S(lds, 22);
            const LAS unsigned char* cs = lds + (g & 1) * SET_BYTES;
            bf16x8 vt[2][2];
#pragma unroll
            for (int c = 0; c < 2; ++c) { const int r_ = vc0 + 8 * (l15 >> 2) + 4 * c + (l15 & 3), x_ = (r_ >> 2) & 7;
                vt[c][0] = *(const LAS bf16x8*)(cs + OFF_VT + r_ * KT_RS + 16 * (q ^ x_)); vt[c][1] = *(const LAS bf16x8*)(cs + OFF_VT + r_ * KT_RS + 16 * ((4 + q) ^ x_)); }
            if (do_o) {
                f32x4 O[2][4];
#pragma unroll
                for (int c = 0; c < 2; ++c)
#pragma unroll
                    for (int it = 0; it < 4; ++it) O[c][it] = (f32x4){0.f, 0.f, 0.f, 0.f};
#pragma unroll
                for (int ks = 0; ks < 4; ++ks) {
                    bf16x8 sf[2];
#pragma unroll
                    for (int c = 0; c < 2; ++c) { const f32x4 s0 = S[c][2 * ks], s1 = S[c][2 * ks + 1];
                        v4u pk; pk.x = pk2(s0[0], s0[1]); pk.y = pk2(s0[2], s0[3]); pk.z = pk2(s1[0], s1[1]); pk.w = pk2(s1[2], s1[3]); sf[c] = __builtin_bit_cast(bf16x8, pk); }
#pragma unroll
                    for (int it = 0; it < 4; ++it) { const bf16x8 qf = ld_perm(cs + OFF_QI + (16 * it + l15) * QI_RS + (32 * ks + 4 * q) * 2);
                        O[0][it] = MFMA16(sf[0], qf, O[0][it]); O[1][it] = MFMA16(sf[1], qf, O[1][it]); }
                }
#pragma unroll
                for (int it = 0; it < 4; ++it) {
                    const bf16x8 a0 = *(const LAS bf16x8*)(cs + OFF_AI + (16 * it + l15) * AI_RS + 16 * q);
                    O[0][it] = MFMA16(vt[0][0], a0, O[0][it]); O[1][it] = MFMA16(vt[1][0], a0, O[1][it]);
                    if (it >= 2) { const bf16x8 a1 = *(const LAS bf16x8*)(cs + OFF_AI + (16 * it + l15) * AI_RS + 64 + 16 * q);
                        O[0][it] = MFMA16(vt[0][1], a1, O[0][it]); O[1][it] = MFMA16(vt[1][1], a1, O[1][it]); }
                }
#pragma unroll
                for (int it = 0; it < 4; ++it) {
                    const int row = tok_row(g, 16 * it + l15, b, dir);
                    bf16* dst = (g < 4) ? OC + (size_t)dir * MCTX * 512 + (size_t)(row - MLAT) * 512 + h * HD + vc0 + 8 * q
                                        : PA + (size_t)row * PA_LD + 512 + dir * 512 + h * HD + vc0 + 8 * q;
                    v4u wv; wv.x = pk2(O[0][it][0], O[0][it][1]); wv.y = pk2(O[0][it][2], O[0][it][3]); wv.z = pk2(O[1][it][0], O[1][it][1]); wv.w = pk2(O[1][it][2], O[1][it][3]);
                    *(v4u*)dst = wv;
                }
            }
#pragma unroll
            for (int kt = 0; kt < 8; ++kt) {
                const f32x4 ge = *(const LAS f32x4*)(cs + OFF_SCL + (16 * kt + 4 * q) * 4);
                const int xk_ = (4 * kt + (l15 >> 2)) & 7;
                const bf16x8 k0 = *(const LAS bf16x8*)(cs + OFF_KT + (16 * kt + l15) * KT_RS + 16 * (q ^ xk_)), k1 = *(const LAS bf16x8*)(cs + OFF_KT + (16 * kt + l15) * KT_RS + 16 * ((4 + q) ^ xk_));
#pragma unroll
                for (int c = 0; c < 2; ++c) { f32x4 d4 = ge * S[c][kt]; d4 = MFMA16(k0, vt[c][0], d4); S[c][kt] = MFMA16(k1, vt[c][1], d4); }
            }
            if (g == 30) PSTAMP_S(lds, 23);
            __syncthreads();
            if (g == 30) PSTAMP_S(lds, 24);
        }
        if (!ctxunit) PSTAMP_S(lds, 21);
    }
}
}


namespace hy {
typedef short bf16x8 __attribute__((ext_vector_type(8)));
typedef short bf16x4 __attribute__((ext_vector_type(4)));
constexpr int CS = 16416;
constexpr int VPAD = 7;
constexpr int OFF_F = 0, OFF_V = 4 * CS, V_ROWS = (64 + VPAD + 7) * 8, LDS_END = OFF_V + V_ROWS * 128;
static_assert(LDS_END <= LDS_BYTES - 256, "hyena LDS");
struct ConvW { float x0[4], x1[4], v[4]; };
__device__ __forceinline__ ConvW load_convw(const Args& a, int l, int c) {
    const float* cw = a.in[11] + (size_t)l * 3 * 1536; const float* cb = a.in[12] + (size_t)l * 1536; ConvW r;
#pragma unroll
    for (int j = 0; j < 3; ++j) { r.x0[j] = cw[j * 1536 + c]; r.x1[j] = cw[j * 1536 + 512 + c]; r.v[j] = cw[j * 1536 + 1024 + c]; }
    r.x0[3] = cb[c]; r.x1[3] = cb[512 + c]; r.v[3] = cb[1024 + c];
    return r;
}
__device__ __forceinline__ void hyena_channel(LAS unsigned char* lds, const Args& a, const int l, const int c) {
    int tid_ = threadIdx.x; asm volatile("" : "+v"(tid_));
    const int tid = tid_, lane = tid & 63, w = __builtin_amdgcn_readfirstlane(tid >> 6), l15 = lane & 15, q = lane >> 4;
    unsigned char* ws = a.ws;
    const bf16* PB = (const bf16*)(ws + WS_PB);
    const bf16* x0r = PB + (size_t)c * MTOK; const bf16* x1r = PB + (size_t)(512 + c) * MTOK; const bf16* vr = PB + (size_t)(1024 + c) * MTOK; const bf16* gbr = PB + (size_t)(1536 + c) * MTOK;
    const ConvW cw = load_convw(a, l, c);
    PSTAMP_H(lds, 16);
    {
        const bf16* F = (const bf16*)(ws + WS_FG) + ((size_t)l * 512 + c) * FZ;
        for (int ch = tid; ch < 1024; ch += NTHR) {
            const v4u cur = *(const v4u*)(F + 8 * ch); v4u prev = *(const v4u*)(F + (ch > 0 ? 8 * ch - 8 : 0));
            if (ch == 0) prev = (v4u){0u, 0u, 0u, 0u};
            const unsigned W[8] = {prev.x, prev.y, prev.z, prev.w, cur.x, cur.y, cur.z, cur.w};
            v4u c1, c2, c3;
#pragma unroll
            for (int d = 0; d < 4; ++d) { c1[d] = (W[3 + d] >> 16) | (W[4 + d] << 16); c2[d] = W[3 + d]; c3[d] = (W[2 + d] >> 16) | (W[3 + d] << 16); }
            *(LAS v4u*)(lds + OFF_F + 0 * CS + 16 * ch) = cur;
            *(LAS v4u*)(lds + OFF_F + 1 * CS + 16 * ch) = c1;
            *(LAS v4u*)(lds + OFF_F + 2 * CS + 16 * ch) = c2;
            *(LAS v4u*)(lds + OFF_F + 3 * CS + 16 * ch) = c3;
        }
    }
    {
        for (int e = tid; e < VPAD * 8 * 32; e += NTHR) ((LAS unsigned*)(lds + OFF_V))[e] = 0u;
        for (int e = tid; e < 7 * 8 * 32; e += NTHR) ((LAS unsigned*)(lds + OFF_V + (64 + VPAD) * 8 * 128))[e] = 0u;
        for (int bt = 0; bt < 2; ++bt) {
            v4u vw[4], xw[4]; unsigned short hv[4][2], hx[4][2];
#pragma unroll
            for (int j = 0; j < 4; ++j) {
                const int e = tid + NTHR * (4 * bt + j), b = e >> 9, t0 = (e & 511) * 8;
                const size_t base = (size_t)b * LX + t0;
                const size_t bm = t0 > 0 ? base - 1 : base, bp = t0 + 8 < LX ? base + 8 : base;
                vw[j] = *(const v4u*)(vr + base); xw[j] = *(const v4u*)(x1r + base);
                hv[j][0] = vr[bm]; hv[j][1] = vr[bp]; hx[j][0] = x1r[bm]; hx[j][1] = x1r[bp];
            }
#pragma unroll
            for (int j = 0; j < 4; ++j) {
                const int e = tid + NTHR * (4 * bt + j), b = e >> 9, t0 = (e & 511) * 8, ab = t0 >> 6, ch = (t0 & 63) >> 3;
                float vv[10], xx[10];
                vv[0] = t0 > 0 ? bf2f(hv[j][0]) : 0.f; xx[0] = t0 > 0 ? bf2f(hx[j][0]) : 0.f;
                vv[9] = t0 + 8 < LX ? bf2f(hv[j][1]) : 0.f; xx[9] = t0 + 8 < LX ? bf2f(hx[j][1]) : 0.f;
#pragma unroll
                for (int d = 0; d < 4; ++d) { vv[1 + 2 * d] = bf2f((unsigned short)(vw[j][d] & 0xffffu)); vv[2 + 2 * d] = bf2f((unsigned short)(vw[j][d] >> 16));
                                              xx[1 + 2 * d] = bf2f((unsigned short)(xw[j][d] & 0xffffu)); xx[2 + 2 * d] = bf2f((unsigned short)(xw[j][d] >> 16)); }
                float p[8];
#pragma unroll
                for (int d = 0; d < 8; ++d) p[d] = (cw.v[3] + cw.v[0] * vv[d] + cw.v[1] * vv[d + 1] + cw.v[2] * vv[d + 2]) * (cw.x1[3] + cw.x1[0] * xx[d] + cw.x1[1] * xx[d + 1] + cw.x1[2] * xx[d + 2]);
                v4u o; o.x = pk2(p[0], p[1]); o.y = pk2(p[2], p[3]); o.z = pk2(p[4], p[5]); o.w = pk2(p[6], p[7]);
                const int R = (ab + VPAD) * 8 + b;
                *(LAS v4u*)(lds + OFF_V + R * 128 + 16 * (ch ^ ((R >> 1) & 7))) = o;
            }
        }
    }
    __syncthreads();
    PSTAMP_H(lds, 17);
    f32x4 acc[4][4];
#pragma unroll
    for (int mt = 0; mt < 4; ++mt)
#pragma unroll
        for (int nt = 0; nt < 4; ++nt) acc[mt][nt] = (f32x4){0.f, 0.f, 0.f, 0.f};
    {
        const LAS unsigned char* pa = lds + OFF_F + (l15 & 3) * CS + (4096 - 4 * (l15 >> 2) + 8 * q) * 2 - 96;
        const int rowl = (l15 >> 3) * 8 + (l15 & 7);
        const int cq = (q ^ (rowl >> 1)) & 7;
        const LAS unsigned char* vb0 = lds + OFF_V + rowl * 128 + (8 * w + VPAD) * 1024 + 16 * cq;
        const LAS unsigned char* vb1 = lds + OFF_V + rowl * 128 + (8 * w + VPAD) * 1024 + 16 * (cq ^ 4);
#define HY_LDA(An_, m_) do { const LAS unsigned char* p_ = pa - 128 * (m_); _Pragma("unroll") for (int mt = 0; mt < 4; ++mt) { \
            const bf16x4 lo_ = *(const LAS bf16x4*)(p_ + 32 * (3 - mt)), hi_ = *(const LAS bf16x4*)(p_ + 32 * (3 - mt) + 8); An_[mt] = __builtin_shufflevector(lo_, hi_, 0, 1, 2, 3, 4, 5, 6, 7); } } while (0)
#define HY_LDB(B_, m_, PAR_) do { const LAS unsigned char* p0_ = ((PAR_) ? vb1 : vb0) - 1024 * (m_); const LAS unsigned char* p1_ = ((PAR_) ? vb0 : vb1) - 1024 * (m_); \
            _Pragma("unroll") for (int nt = 0; nt < 4; ++nt) { B_[0][nt] = *(const LAS bf16x8*)(p0_ + 2048 * nt); B_[1][nt] = *(const LAS bf16x8*)(p1_ + 2048 * nt); } } while (0)
#define HY_MMA(An_, Ao0_, Ao1_, B_, m_) do { _Pragma("unroll") for (int nt = 0; nt < 4; ++nt) { const int a0_ = 8 * w + 2 * nt - (m_); if (a0_ + 1 >= 0 && a0_ <= 63) { \
            _Pragma("unroll") for (int mt = 0; mt < 4; ++mt) acc[mt][nt] = __builtin_amdgcn_mfma_f32_16x16x32_bf16(An_[mt], B_[0][nt], acc[mt][nt], 0, 0, 0); \
            acc[0][nt] = __builtin_amdgcn_mfma_f32_16x16x32_bf16(Ao0_, B_[1][nt], acc[0][nt], 0, 0, 0); acc[1][nt] = __builtin_amdgcn_mfma_f32_16x16x32_bf16(Ao1_, B_[1][nt], acc[1][nt], 0, 0, 0); \
            acc[2][nt] = __builtin_amdgcn_mfma_f32_16x16x32_bf16(An_[0], B_[1][nt], acc[2][nt], 0, 0, 0); acc[3][nt] = __builtin_amdgcn_mfma_f32_16x16x32_bf16(An_[1], B_[1][nt], acc[3][nt], 0, 0, 0); } } } while (0)
        bf16x8 Aa[4], Ab[4], Ba[2][4], Bb[2][4], o0, o1;
        const int m0 = 8 * w - 63, mlast = 8 * w + 7;
        { bf16x8 t_[4]; HY_LDA(t_, m0 - 1); o0 = t_[2]; o1 = t_[3]; }
        HY_LDA(Aa, m0); HY_LDB(Ba, m0, 0);
        for (int m = m0; m < mlast; m += 2) {
            HY_LDA(Ab, m + 1); HY_LDB(Bb, m + 1, 1);
            HY_MMA(Aa, o0, o1, Ba, m);
            o0 = Aa[2]; o1 = Aa[3];
            HY_LDA(Aa, m + 2); HY_LDB(Ba, m + 2, 0);
            HY_MMA(Ab, o0, o1, Bb, m + 1);
            o0 = Ab[2]; o1 = Ab[3];
        }
        HY_MMA(Aa, o0, o1, Ba, mlast);
#undef HY_LDA
#undef HY_LDB
#undef HY_MMA
    }
    PSTAMP_H(lds, 18);
    __syncthreads();
    {
        constexpr int YRS = 8208;
        const float inn = 1.0f / ((const float*)(ws + WS_CTL))[CW_NORM + l * 512 + c], hb = a.in[21][l * 512 + c];
        const int b = l15 & 7;
#pragma unroll
        for (int nt = 0; nt < 4; ++nt) {
            const int ab = 8 * w + 2 * nt + (l15 >> 3), R = (ab + VPAD) * 8 + b;
#pragma unroll
            for (int mt = 0; mt < 4; ++mt) {
                const int t = 64 * ab + 16 * mt + 4 * q;
                const v2u vw = *(const LAS v2u*)(lds + OFF_V + R * 128 + 16 * ((2 * mt + (q >> 1)) ^ ((R >> 1) & 7)) + 8 * (q & 1));
                const float y0 = acc[mt][nt][0] * inn + bf2f((unsigned short)(vw.x & 0xffffu)) * hb, y1 = acc[mt][nt][1] * inn + bf2f((unsigned short)(vw.x >> 16)) * hb;
                const float y2 = acc[mt][nt][2] * inn + bf2f((unsigned short)(vw.y & 0xffffu)) * hb, y3 = acc[mt][nt][3] * inn + bf2f((unsigned short)(vw.y >> 16)) * hb;
                v2u yw; yw.x = pk2(y0, y1); yw.y = pk2(y2, y3);
                *(LAS v2u*)(lds + OFF_F + b * YRS + 2 * t) = yw;
            }
        }
        __syncthreads();
        bf16* OBT = (bf16*)(ws + WS_OBT) + (size_t)c * MTOK;
        int tid2 = tid; asm volatile("" : "+v"(tid2));
        for (int bt = 0; bt < 4; ++bt) {
            v4u xw[2], gw[2]; unsigned short hx[2][2];
#pragma unroll
            for (int j = 0; j < 2; ++j) {
                const int e = tid2 + NTHR * (2 * bt + j), bb = e >> 9, t0 = (e & 511) * 8;
                const size_t base = (size_t)bb * LX + t0;
                xw[j] = *(const v4u*)(x0r + base); gw[j] = *(const v4u*)(gbr + base);
                hx[j][0] = x0r[t0 > 0 ? base - 1 : base]; hx[j][1] = x0r[t0 + 8 < LX ? base + 8 : base];
            }
#pragma unroll
            for (int j = 0; j < 2; ++j) {
                const int e = tid2 + NTHR * (2 * bt + j), bb = e >> 9, t0 = (e & 511) * 8;
                const size_t base = (size_t)bb * LX + t0;
                const v4u yw = *(const LAS v4u*)(lds + OFF_F + bb * YRS + 2 * t0);
                float xs[10], o[8];
                xs[0] = t0 > 0 ? bf2f(hx[j][0]) : 0.f; xs[9] = t0 + 8 < LX ? bf2f(hx[j][1]) : 0.f;
#pragma unroll
                for (int d = 0; d < 4; ++d) { xs[1 + 2 * d] = bf2f((unsigned short)(xw[j][d] & 0xffffu)); xs[2 + 2 * d] = bf2f((unsigned short)(xw[j][d] >> 16)); }
#pragma unroll
                for (int d = 0; d < 8; ++d) {
                    const float yv = bf2f((unsigned short)((d & 1) ? (yw[d >> 1] >> 16) : (yw[d >> 1] & 0xffffu)));
                    const float gv = bf2f((unsigned short)((d & 1) ? (gw[j][d >> 1] >> 16) : (gw[j][d >> 1] & 0xffffu)));
                    o[d] = yv * (cw.x0[3] + cw.x0[0] * xs[d] + cw.x0[1] * xs[d + 1] + cw.x0[2] * xs[d + 2]) * silu_f(gv);
                }
                v4u ow; ow.x = pk2(o[0], o[1]); ow.y = pk2(o[2], o[3]); ow.z = pk2(o[4], o[5]); ow.w = pk2(o[6], o[7]);
                *(v4u*)(OBT + base) = ow;
            }
        }
    }
    PSTAMP_H(lds, 19);
    __syncthreads();
}
__device__ __forceinline__ void hyena_ctx_channel(LAS unsigned char* lds, const Args& a, const int c) {
    int tid_ = threadIdx.x; asm volatile("" : "+v"(tid_));
    const int tid = tid_;
    unsigned char* ws = a.ws;
    const bf16* PB = (const bf16*)(ws + WS_PB);
    const bf16* x0r = PB + (size_t)c * MTOK + MLAT; const bf16* x1r = PB + (size_t)(512 + c) * MTOK + MLAT; const bf16* vr = PB + (size_t)(1024 + c) * MTOK + MLAT; const bf16* gbr = PB + (size_t)(1536 + c) * MTOK + MLAT;
    const ConvW cw = load_convw(a, 0, c);
    LAS float* vvc = (LAS float*)lds;
    LAS float* Fc = vvc + 2048;
    for (int e = tid; e < 2048; e += NTHR) {
        const int t = e & 255;
        const float vm_ = bf2f(vr[t > 0 ? e - 1 : e]), v0 = bf2f(vr[e]), vp_ = bf2f(vr[t < 255 ? e + 1 : e]);
        const float xm_ = bf2f(x1r[t > 0 ? e - 1 : e]), x0 = bf2f(x1r[e]), xp_ = bf2f(x1r[t < 255 ? e + 1 : e]);
        const float vm = t > 0 ? vm_ : 0.f, vp = t < 255 ? vp_ : 0.f, xm = t > 0 ? xm_ : 0.f, xp = t < 255 ? xp_ : 0.f;
        vvc[e] = (cw.v[3] + cw.v[0] * vm + cw.v[1] * v0 + cw.v[2] * vp) * (cw.x1[3] + cw.x1[0] * xm + cw.x1[1] * x0 + cw.x1[2] * xp);
    }
    if (tid < 512) Fc[tid] = bf2f(((const bf16*)(ws + WS_FGC))[(size_t)c * FZC + tid]);
    __syncthreads();
    const float inn = 1.0f / ((const float*)(ws + WS_CTL))[CW_NORM + 2 * 512 + c], hb = a.in[21][c];
    bf16* OBT = (bf16*)(ws + WS_OBT) + (size_t)c * MTOK + MLAT;
    const int b = tid >> 6;
#pragma unroll
    for (int i = 0; i < 4; ++i) {
        const int t = (tid & 63) + 64 * i, e = b * 256 + t;
        float s = 0.f;
        for (int s2 = 0; s2 < 256; ++s2) s += Fc[256 - t + s2] * vvc[b * 256 + s2];
        const float xm_ = bf2f(x0r[t > 0 ? e - 1 : e]), x0 = bf2f(x0r[e]), xp_ = bf2f(x0r[t < 255 ? e + 1 : e]);
        const float xm = t > 0 ? xm_ : 0.f, xp = t < 255 ? xp_ : 0.f;
        const float x0c = cw.x0[3] + cw.x0[0] * xm + cw.x0[1] * x0 + cw.x0[2] * xp;
        OBT[e] = (bf16)f2bf((s * inn + vvc[e] * hb) * x0c * silu_f(bf2f(gbr[e])));
    }
    __syncthreads();
}
}


__device__ __forceinline__ void phase_prepass(const Args& a, Frame& F) {
    for (int t = F.vcu; t < 544 * 4; t += F.G) scan::prepass_task(F.lds, (bf16*)(a.ws + WS_PA), (float*)(a.ws + WS_SCL), (bf16*)(a.ws + WS_XA), t >> 2, t & 3);
}

__device__ __forceinline__ void phase_mix(const Args& a, Frame& F, const int l, const int part = -1) {
    unsigned* qctr = (unsigned*)(a.ws + WS_CTL) + CW_QUEUE + 64 * l + (part == 1 ? 128 : 0);
    volatile LAS int* slot = (volatile LAS int*)(F.lds + LDS_BYTES - 64);
    const int ntasks = l == 0 ? 64 + 512 + 64 + 512 : 64 + 512;
    for (;;) {
        if (F.tid == 0) slot[0] = (int)atomicAdd(qctr, 1u);
        __syncthreads();
        const int t = __builtin_amdgcn_readfirstlane(slot[0]);
        __syncthreads();
        if (t >= ntasks) break;
        if (part == 0 && !(t < 64 || (t >= 576 && t < 640))) continue;
        if (part == 1 && (t < 64 || (t >= 576 && t < 640))) continue;
        if (t < 64) scan::scan_unit(F.lds, (bf16*)(a.ws + WS_PA), (bf16*)(a.ws + WS_OC), (const float*)(a.ws + WS_SCL), (const bf16*)(a.ws + WS_XA), t >> 3, (t >> 1) & 3, t & 1, false);
        else if (t < 576) hy::hyena_channel(F.lds, a, l, t - 64);
        else if (t < 640) { const int u = t - 576; scan::scan_unit(F.lds, (bf16*)(a.ws + WS_PA), (bf16*)(a.ws + WS_OC), (const float*)(a.ws + WS_SCL), (const bf16*)(a.ws + WS_XA), u >> 3, (u >> 1) & 3, u & 1, true); }
        else hy::hyena_ctx_channel(F.lds, a, t - 640);
        __syncthreads();
    }
}

__device__ __forceinline__ void phase_finalize_ox(const Args& a, Frame& F, int l) {
    unsigned char* ws = a.ws;
    const bf16* PA = (const bf16*)(ws + WS_PA);
    const bf16* OC = (const bf16*)(ws + WS_OC);
    bf16* XA = (bf16*)(ws + WS_XA);
    const float* gnw = a.in[10] + l * 512;
    const int gw = F.vcu * NWAVES + F.wave, NGW = F.G * NWAVES;
    const int ntok = (l == 0) ? MTOK : MLAT;
    for (int tok = gw; tok < ntok; tok += NGW) {
        const bool isctx = tok >= MLAT;
        const int c8 = 8 * F.lane;
        const bf16* pf = isctx ? OC + (size_t)(tok - MLAT) * 512 + c8 : PA + (size_t)tok * PA_LD + 512 + c8;
        const bf16* pb = isctx ? OC + (size_t)MCTX * 512 + (size_t)(tok - MLAT) * 512 + c8 : PA + (size_t)tok * PA_LD + 1024 + c8;
        const v4u wf = *(const v4u*)pf, wb = *(const v4u*)pb, wg = *(const v4u*)(PA + (size_t)tok * PA_LD + 2048 + c8);
        float o[8], g[8];
#pragma unroll
        for (int e = 0; e < 4; ++e) {
            o[2 * e] = bf2f((unsigned short)(wf[e] & 0xffff)) + bf2f((unsigned short)(wb[e] & 0xffff));
            o[2 * e + 1] = bf2f((unsigned short)(wf[e] >> 16)) + bf2f((unsigned short)(wb[e] >> 16));
            g[2 * e] = bf2f((unsigned short)(wg[e] & 0xffff)); g[2 * e + 1] = bf2f((unsigned short)(wg[e] >> 16));
        }
        float s = 0.f;
#pragma unroll
        for (int e = 0; e < 8; ++e) s += o[e] * o[e];
        s += __shfl_xor(s, 1); s += __shfl_xor(s, 2); s += __shfl_xor(s, 4); s += __shfl_xor(s, 8);
        const float rstd = 1.0f / sqrtf(s * (1.0f / HD) + EPS);
        float y[8];
#pragma unroll
        for (int e = 0; e < 8; ++e) y[e] = o[e] * rstd * gnw[c8 + e] * silu_f(g[e]);
        v4u w; w.x = pk2(y[0], y[1]); w.y = pk2(y[2], y[3]); w.z = pk2(y[4], y[5]); w.w = pk2(y[6], y[7]);
        *(v4u*)(XA + (size_t)tok * D + c8) = w;
    }
    LAS unsigned short* t = (LAS unsigned short*)(F.lds + F.wave * 16384);
    const int ntt = ntok / 64;
    for (int it = gw; it < 8 * ntt; it += NGW) {
        const int ct = it / ntt, tt = it % ntt, c0 = ct * 64, t0 = tt * 64;
        const bf16* OBT = (const bf16*)(ws + WS_OBT);
#pragma unroll
        for (int i = 0; i < 8; ++i) {
            const int e = F.lane + 64 * i, c = e >> 3, ch = e & 7;
            const v4u w = *(const v4u*)(OBT + (size_t)(c0 + c) * MTOK + t0 + 8 * ch);
#pragma unroll
            for (int q = 0; q < 4; ++q) { t[c * 66 + 8 * ch + 2 * q] = (unsigned short)(w[q] & 0xffff); t[c * 66 + 8 * ch + 2 * q + 1] = (unsigned short)(w[q] >> 16); }
        }
        asm volatile("s_waitcnt lgkmcnt(0)" ::: "memory");
#pragma unroll
        for (int i = 0; i < 8; ++i) {
            const int e = F.lane + 64 * i, tk = e >> 3, cg = e & 7;
            unsigned short h[8];
#pragma unroll
            for (int q = 0; q < 8; ++q) h[q] = t[(8 * cg + q) * 66 + tk];
            v4u w; w.x = h[0] | ((unsigned)h[1] << 16); w.y = h[2] | ((unsigned)h[3] << 16); w.z = h[4] | ((unsigned)h[5] << 16); w.w = h[6] | ((unsigned)h[7] << 16);
            *(v4u*)(XA + (size_t)(t0 + tk) * D + 512 + c0 + 8 * cg) = w;
        }
        asm volatile("s_waitcnt lgkmcnt(0)" ::: "memory");
    }
}

__device__ __forceinline__ void phase_final_norm(const Args& a, Frame& F) {
    const float* w = a.in[22];
    const int gw = F.vcu * NWAVES + F.wave, NGW = F.G * NWAVES;
    for (int tok = gw; tok < MLAT; tok += NGW) {
        float* xr = a.out + (size_t)tok * D;
        f32x4 v[4]; float s = 0.f;
#pragma unroll
        for (int j = 0; j < 4; ++j) { v[j] = *(const f32x4*)(xr + 256 * j + 4 * F.lane); s += (v[j].x * v[j].x + v[j].y * v[j].y) + (v[j].z * v[j].z + v[j].w * v[j].w); }
        const float rstd = 1.0f / sqrtf(wave_sum(s) * (1.0f / D) + EPS);
#pragma unroll
        for (int j = 0; j < 4; ++j) { const f32x4 w4 = *(const f32x4*)(w + 256 * j + 4 * F.lane); *(f32x4*)(xr + 256 * j + 4 * F.lane) = v[j] * rstd * w4; }
    }
}

enum { PH_PRO = 0, PH_NORM0 = 1, PH_IN0 = 2, PH_PRE0 = 3, PH_MIX0 = 4, PH_FIN0 = 5, PH_OUT0 = 6, PH_NORM1 = 7, PH_IN1 = 8, PH_PRE1 = 9, PH_MIX1 = 10, PH_FIN1 = 11, PH_OUT1 = 12, PH_FINAL = 13 };

__device__ __forceinline__ Frame mkframe(unsigned char* lds) {
    Frame F;
    F.lds = (LAS unsigned char*)lds;
    F.tid = threadIdx.x; F.lane = F.tid & 63; F.wave = __builtin_amdgcn_readfirstlane(F.tid >> 6);
    F.G = gridDim.x; { const int bx = blockIdx.x; F.vcu = (F.G % 8 == 0) ? (bx % 8) * (F.G / 8) + bx / 8 : bx; }
    return F;
}
template <int l> __device__ __forceinline__ void run_inproj(const Args& args, unsigned char* lds) {
    unsigned char* ws = args.ws; Frame F = mkframe(lds);
    pg8::Gemm g{(const bf16*)(ws + WS_XA), (const bf16*)(ws + WS_WIN) + (size_t)l * NIN * D, D};
    pg8::Sched S; S.init(128, 18, F.G, (int)blockIdx.x, 8, l == 0 ? 18 : 8);
    EpiIn E{(bf16*)(ws + WS_PA), (bf16*)(ws + WS_PB), (const float*)(ws + WS_LBS) + l * 1024};
    pg8::gemm_phase<EpiIn, true, true>(F.lds, g, S, E);
}
template <int l> __device__ __forceinline__ void run_outproj(const Args& args, unsigned char* lds) {
    unsigned char* ws = args.ws; Frame F = mkframe(lds);
    pg8::Gemm g{(const bf16*)(ws + WS_XA), (const bf16*)(ws + WS_WOUT) + (size_t)l * D * D, D};
    pg8::Sched S; S.init(128, 4, F.G, (int)blockIdx.x, l == 0 ? 8 : 0, 4);
    EpiOut E{l == 0 ? args.in[0] : args.out, args.out, args.in[2], (float*)(ws + WS_CTX1), (const float*)(ws + WS_MOD) + (size_t)l * 9 * 3 * D};
    pg8::gemm_phase<EpiOut, true, true>(F.lds, g, S, E);
}
__global__ void __launch_bounds__(NTHR, 2) mega(Args args) {
    extern __shared__ __attribute__((aligned(16))) unsigned char lds[];
    const int lo = args.ph_lo, hi = args.ph_hi;
#define IN(k) (lo <= (k) && (k) < hi)
    volatile LAS unsigned* bst = (volatile LAS unsigned*)((LAS unsigned char*)lds + LDS_BYTES - 32);
    if (threadIdx.x < 8) ((volatile LAS unsigned*)((LAS unsigned char*)lds + LDS_BYTES - 32))[threadIdx.x] = 0u;
    __syncthreads();
    XcdBarrier bar; bar.bar = (unsigned*)(args.ws + WS_CTL) + CW_BAR; bar.x = 0; bar.st = bst;
    if (hi - lo > 1) bar = xcd_barrier_post((unsigned*)(args.ws + WS_CTL) + CW_BAR, bst);
#ifdef PROBE_ID
    volatile LAS unsigned long long* pts = (volatile LAS unsigned long long*)((LAS unsigned char*)lds + LDS_BYTES - 512);
    if (threadIdx.x == 0) pts[0] = __builtin_amdgcn_s_memrealtime();
#define SEAM(k) do { if (IN((k) + 1)) xcd_barrier(bar); else __syncthreads(); if (threadIdx.x == 0) pts[(k) + 1] = __builtin_amdgcn_s_memrealtime(); } while (0)
#else
#define SEAM(k) do { if (IN((k) + 1)) xcd_barrier(bar); else __syncthreads(); } while (0)
#endif
    if (IN(PH_PRO)) { Frame F = mkframe(lds); phase_prologue(args, F); SEAM(PH_PRO); }
    if (IN(PH_NORM0)) { Frame F = mkframe(lds); phase_normrows(args, F, 0, args.in[0], args.in[2]); SEAM(PH_NORM0); }
    if (IN(PH_IN0)) { run_inproj<0>(args, lds); SEAM(PH_IN0); }
    if (IN(PH_PRE0)) { Frame F = mkframe(lds); phase_prepass(args, F); SEAM(PH_PRE0); }
#ifdef SPLIT_MIX
    if (IN(PH_MIX0)) { Frame F = mkframe(lds); phase_mix(args, F, 0, 0); xcd_barrier(bar); if (threadIdx.x == 0) pts[15] = __builtin_amdgcn_s_memrealtime(); phase_mix(args, F, 0, 1); SEAM(PH_MIX0); }
#else
    if (IN(PH_MIX0)) { Frame F = mkframe(lds); phase_mix(args, F, 0); SEAM(PH_MIX0); }
#endif
    if (IN(PH_FIN0)) { Frame F = mkframe(lds); phase_finalize_ox(args, F, 0); SEAM(PH_FIN0); }
    if (IN(PH_OUT0)) { run_outproj<0>(args, lds); SEAM(PH_OUT0); }
    if (IN(PH_NORM1)) { Frame F = mkframe(lds); phase_normrows(args, F, 1, args.out, (const float*)(args.ws + WS_CTX1)); SEAM(PH_NORM1); }
    if (IN(PH_IN1)) { run_inproj<1>(args, lds); SEAM(PH_IN1); }
    if (IN(PH_PRE1)) { Frame F = mkframe(lds); phase_prepass(args, F); SEAM(PH_PRE1); }
    if (IN(PH_MIX1)) { Frame F = mkframe(lds); phase_mix(args, F, 1); SEAM(PH_MIX1); }
    if (IN(PH_FIN1)) { Frame F = mkframe(lds); phase_finalize_ox(args, F, 1); SEAM(PH_FIN1); }
    if (IN(PH_OUT1)) { run_outproj<1>(args, lds); SEAM(PH_OUT1); }
    if (IN(PH_FINAL)) { Frame F = mkframe(lds); phase_final_norm(args, F); SEAM(PH_FINAL); }
#ifdef PROBE_ID
    if (blockIdx.x == 0 && threadIdx.x == 0) {
#ifdef SPLIT_MIX
        const unsigned long long dt = (PROBE_ID == 100) ? pts[15] - pts[PH_MIX0] : pts[PH_MIX0 + 1] - pts[15];
#else
        const unsigned long long dt = (PROBE_ID >= 200) ? ((PROBE_ID == 220 || PROBE_ID >= 226) ? 1ull : 16ull) * (pts[PROBE_ID - 200 + 1] - pts[PROBE_ID - 200]) : pts[PROBE_ID + 1] - pts[PROBE_ID];
#endif
        const unsigned long long t0 = __builtin_amdgcn_s_memrealtime();
        unsigned long long wt = 4ull * dt; if (wt > 300000ull) wt = 300000ull;
        while (__builtin_amdgcn_s_memrealtime() - t0 < wt) __builtin_amdgcn_s_sleep(8);
    }
#endif
#undef IN
#undef SEAM
}

extern "C" void kernel_launch(void* const* d_in, const int* in_sizes, int n_in, void* d_out, int out_size, void* d_ws, size_t ws_size, hipStream_t stream) {
    static int grid = 0;
    if (grid == 0) {
        if (n_in != 23 || ws_size < WS_END) { fprintf(stderr, "kernel_launch: unexpected n_in %d / ws_size %zu\n", n_in, ws_size); grid = -1; return; }
        int dev = 0, cus = 0;
        if (hipGetDevice(&dev) != hipSuccess || hipDeviceGetAttribute(&cus, hipDeviceAttributeMultiprocessorCount, dev) != hipSuccess) { grid = -1; return; }
        if (hipFuncSetAttribute((const void*)mega, hipFuncAttributeMaxDynamicSharedMemorySize, LDS_BYTES) != hipSuccess) { fprintf(stderr, "kernel_launch: hipFuncSetAttribute failed\n"); grid = -1; return; }
        grid = cus;
    }
    if (grid < 0) return;
    (void)hipMemsetAsync((char*)d_ws + WS_CTL, 0, CTL_ZERO_BYTES, stream);
    Args a{};
    for (int i = 0; i < 23; ++i) a.in[i] = (const float*)d_in[i];
    a.out = (float*)d_out; a.ws = (unsigned char*)d_ws;
    a.ph_lo = 0; a.ph_hi = PH_FINAL + 1;
    hipLaunchKernelGGL(mega, dim3(grid), dim3(NTHR), LDS_BYTES, stream, a);
}
```

```cpp
#include <hip/hip_runtime.h>
#include <cstdio>
#include <cstdint>
#include <math.h>

namespace pg8 {
#define PG8_LAS __attribute__((address_space(3)))
typedef unsigned short bf16_t;
typedef short bf16x8 __attribute__((ext_vector_type(8)));
typedef float f32x4 __attribute__((ext_vector_type(4)));
typedef unsigned u32x4 __attribute__((ext_vector_type(4)));
typedef unsigned u32x2 __attribute__((ext_vector_type(2)));
constexpr int BM = 256, BK = 64, HALF = 128, HTB = HALF * BK * 2, STAGE_BYTES = 8 * HTB, NXCD = 8, WGM = 8;

__host__ __device__ __forceinline__ int lds_byte(int r, int c) { const int st = (r >> 4) * 2 + (c >> 5), rr = r & 15, cc = c & 31, ob = rr * 64 + cc * 2; return st * 1024 + (ob ^ (((ob >> 9) & 1) << 5)); }
__host__ __device__ __forceinline__ void stage_rc(int b, int& R, int& C) { const int st = b / 1024, sb = b % 1024, swz = sb ^ (((sb >> 9) & 1) << 5); R = (st >> 1) * 16 + swz / 64; C = (st & 1) * 32 + (swz % 64) / 2; }
__host__ __device__ __forceinline__ int perm32(int rho) { const int n = rho >> 4, i = rho & 15; return 8 * (i >> 2) + 4 * n + (i & 3); }

struct Unit { int pm, pn; };
struct Gemm { const bf16_t* A; const bf16_t* Bt; int K; };

struct Sched {
    int nM, nN, nwg, G, c, nctx, nctxN;
    __device__ void init(int nM_, int nN_, int G_, int c_, int nctxM, int nctxN_) { nM = nM_; nN = nN_; nwg = nM * nN; G = G_; c = c_; nctx = nctxM * nctxN_; nctxN = nctxN_ > 0 ? nctxN_ : 1; }
    __device__ bool next(int i, Unit& u) const {
        const long L = (long)i * G + c;
        if (L >= nwg) { const long L2 = L - nwg; if (L2 >= nctx) return false; u.pm = nM + (int)(L2 / nctxN); u.pn = (int)(L2 % nctxN); return true; }
        int wgid = (int)L; { const int q = nwg / NXCD, r = nwg % NXCD, xcd = wgid % NXCD, off = wgid / NXCD; wgid = (xcd < r ? xcd * (q + 1) : r * (q + 1) + (xcd - r) * q) + off; }
        const int nig = WGM * nN, gid = wgid / nig, fm = gid * WGM, gsz = (nM - fm) < WGM ? (nM - fm) : WGM;
        u.pm = fm + ((wgid % nig) % gsz); u.pn = (wgid % nig) / gsz; return true;
    }
};

template <class Epi, bool ALIGN_EPI, bool SP2>
__device__ __forceinline__ void gemm_phase(PG8_LAS unsigned char* lds, const Gemm g, const Sched& S, const Epi& E) {
    const int tid = threadIdx.x, wid = __builtin_amdgcn_readfirstlane(tid >> 6), lane = tid & 63, wr = wid >> 2, wc = wid & 3, fr = lane & 15, fq = lane >> 4;
    const int K = g.K, nt = K / BK;
    unsigned voffA[2], voffB[2];
#pragma unroll
    for (int i = 0; i < 2; ++i) { int R, C; stage_rc(tid * 16 + i * 8192, R, C); const int Rb = Epi::PERM ? ((R & ~31) + perm32(R & 31)) : R;
        voffA[i] = (unsigned)(R * K + C) * 2u; voffB[i] = (unsigned)(Rb * K + C) * 2u; }
    const size_t kstep = (size_t)(BK * 2);
    const size_t hstep = (size_t)HALF * K * 2;
    const size_t tstep = 2 * hstep;
    const unsigned ldsw = (unsigned)wid * 1024u;
    const int aoff = lds_byte(wr * 64 + fr, fq * 8), boff = lds_byte(wc * 32 + fr, fq * 8);
#define PG8_SA(b, h) (((b) * 2 + (h)) * HTB)
#define PG8_SB(b, h) ((4 + (b) * 2 + (h)) * HTB)
#define PG8_STAGE(bufoff, gbase, voff) do { _Pragma("unroll") for (int _i = 0; _i < 2; ++_i) \
        __builtin_amdgcn_global_load_lds((const unsigned*)((const char*)(gbase) + (voff)[_i]), (PG8_LAS unsigned*)(lds + (bufoff) + ldsw + _i * 8192), 16, 0, 0); } while (0)
#define PG8_LDA(dst, b, h) do { _Pragma("unroll") for (int m = 0; m < 4; ++m) _Pragma("unroll") for (int k = 0; k < 2; ++k) dst[m][k] = *(const PG8_LAS bf16x8*)(lds + PG8_SA(b, h) + aoff + m * 2048 + k * 1024); } while (0)
#define PG8_LDB(dst, b, h) do { _Pragma("unroll") for (int n = 0; n < 2; ++n) _Pragma("unroll") for (int k = 0; k < 2; ++k) dst[n][k] = *(const PG8_LAS bf16x8*)(lds + PG8_SB(b, h) + boff + n * 2048 + k * 1024); } while (0)
#define PG8_MMA(ai, bj, At, Bt) do { __builtin_amdgcn_s_setprio(1); _Pragma("unroll") for (int m = 0; m < 4; ++m) _Pragma("unroll") for (int n = 0; n < 2; ++n) _Pragma("unroll") for (int k = 0; k < 2; ++k) \
        acc[ai][bj][m][n] = __builtin_amdgcn_mfma_f32_16x16x32_bf16(Bt[n][k], At[m][k], acc[ai][bj][m][n], 0, 0, 0); __builtin_amdgcn_s_setprio(0); } while (0)
#define PG8_WAIT_V(n) asm volatile("s_waitcnt vmcnt(" #n ")" ::: "memory")
#define PG8_WAIT_L(n) asm volatile("s_waitcnt lgkmcnt(" #n ")" ::: "memory")
#define PG8_BAR __builtin_amdgcn_s_barrier()
#define PG8_SCHED __builtin_amdgcn_sched_barrier(0)
    Unit cur, nxt; int ui = 0;
    if (!S.next(0, cur)) return;
    f32x4 acc[2][2][4][2];
#pragma unroll
    for (int a = 0; a < 2; ++a)
#pragma unroll
        for (int b = 0; b < 2; ++b)
#pragma unroll
            for (int m = 0; m < 4; ++m)
#pragma unroll
                for (int n = 0; n < 2; ++n) acc[a][b][m][n] = (f32x4){0.f, 0.f, 0.f, 0.f};
    bf16x8 At[4][2], B0[2][2], B1[2][2];
    const char* cA = E.swap(cur) ? (const char*)g.Bt + (size_t)cur.pn * tstep : (const char*)g.A + (size_t)cur.pm * tstep;
    const char* cB = E.swap(cur) ? (const char*)g.A + (size_t)cur.pm * tstep : (const char*)g.Bt + (size_t)cur.pn * tstep;
    if constexpr (SP2) {
        PG8_STAGE(PG8_SB(0, 0), cB, voffB); PG8_STAGE(PG8_SB(0, 1), cB + hstep, voffB); PG8_STAGE(PG8_SA(0, 0), cA, voffA); PG8_STAGE(PG8_SA(0, 1), cA + hstep, voffA);
        if (wr == 1) PG8_BAR;
        PG8_WAIT_V(2); PG8_BAR;
        PG8_STAGE(PG8_SB(1, 0), cB + kstep, voffB); PG8_STAGE(PG8_SA(1, 0), cA + kstep, voffA); PG8_STAGE(PG8_SB(1, 1), cB + hstep + kstep, voffB);
        PG8_WAIT_V(6); PG8_BAR;
    } else {
        PG8_STAGE(PG8_SB(0, 0), cB, voffB); PG8_STAGE(PG8_SA(0, 0), cA, voffA); PG8_STAGE(PG8_SB(0, 1), cB + hstep, voffB); PG8_STAGE(PG8_SA(0, 1), cA + hstep, voffA);
        if (wr == 1) PG8_BAR;
        PG8_WAIT_V(4); PG8_BAR;
        PG8_STAGE(PG8_SB(1, 0), cB + kstep, voffB); PG8_STAGE(PG8_SA(1, 0), cA + kstep, voffA); PG8_STAGE(PG8_SB(1, 1), cB + hstep + kstep, voffB);
        PG8_WAIT_V(6); PG8_BAR;
    }
    for (;;) {
        const bool has_next = S.next(ui + 1, nxt);
        const bool nsw = has_next && E.swap(nxt);
        const char* nA = has_next ? (nsw ? (const char*)g.Bt + (size_t)nxt.pn * tstep : (const char*)g.A + (size_t)nxt.pm * tstep) : cA;
        const char* nB = has_next ? (nsw ? (const char*)g.A + (size_t)nxt.pm * tstep : (const char*)g.Bt + (size_t)nxt.pn * tstep) : cB;
        for (int t = 0; t < nt; t += 2) {
            const bool last = (t == nt - 2);
            const char* a1 = cA + (size_t)(t + 1) * kstep;
            const char* a2 = last ? nA : cA + (size_t)(t + 2) * kstep; const char* b2 = last ? nB : cB + (size_t)(t + 2) * kstep;
            const char* a3 = a2 + kstep; const char* b3 = b2 + kstep;
            if constexpr (SP2) {
            PG8_LDB(B0, 0, 0); PG8_LDB(B1, 0, 1); PG8_SCHED; PG8_LDA(At, 0, 0); PG8_STAGE(PG8_SA(1, 1), a1 + hstep, voffA);
            PG8_WAIT_V(8); PG8_WAIT_L(0); PG8_BAR; PG8_MMA(0, 0, At, B0); PG8_MMA(0, 1, At, B1); PG8_BAR; PG8_SCHED;
            PG8_LDA(At, 0, 1); PG8_STAGE(PG8_SB(0, 0), b2, voffB); PG8_STAGE(PG8_SB(0, 1), b2 + hstep, voffB); PG8_STAGE(PG8_SA(0, 0), a2, voffA);
            PG8_WAIT_V(8); PG8_WAIT_L(0); PG8_BAR; PG8_MMA(1, 0, At, B0); PG8_MMA(1, 1, At, B1); PG8_BAR; PG8_SCHED;
            PG8_LDB(B0, 1, 0); PG8_LDB(B1, 1, 1); PG8_SCHED; PG8_LDA(At, 1, 0); PG8_STAGE(PG8_SA(0, 1), a2 + hstep, voffA);
            PG8_WAIT_V(8); PG8_WAIT_L(0); PG8_BAR; PG8_MMA(0, 0, At, B0); PG8_MMA(0, 1, At, B1); PG8_BAR; PG8_SCHED;
            PG8_LDA(At, 1, 1); PG8_STAGE(PG8_SB(1, 0), b3, voffB); PG8_STAGE(PG8_SB(1, 1), b3 + hstep, voffB); PG8_STAGE(PG8_SA(1, 0), a3, voffA);
            PG8_WAIT_V(8); PG8_WAIT_L(0); PG8_BAR; PG8_MMA(1, 0, At, B0); PG8_MMA(1, 1, At, B1); PG8_BAR; PG8_SCHED;
            } else {
            PG8_LDB(B0, 0, 0); PG8_SCHED; PG8_LDA(At, 0, 0); PG8_STAGE(PG8_SA(1, 1), a1 + hstep, voffA);
            PG8_WAIT_L(8); PG8_BAR; PG8_WAIT_L(0); PG8_MMA(0, 0, At, B0); PG8_BAR; PG8_SCHED;
            PG8_LDB(B1, 0, 1); PG8_STAGE(PG8_SB(0, 0), b2, voffB);
            PG8_BAR; PG8_WAIT_L(0); PG8_MMA(0, 1, At, B1); PG8_BAR;
            PG8_LDA(At, 0, 1); PG8_STAGE(PG8_SA(0, 0), a2, voffA);
            PG8_BAR; PG8_WAIT_L(0); PG8_MMA(1, 0, At, B0); PG8_BAR; PG8_SCHED;
            PG8_STAGE(PG8_SB(0, 1), b2 + hstep, voffB);
            PG8_WAIT_V(6); PG8_BAR; PG8_MMA(1, 1, At, B1); PG8_BAR;
            PG8_LDB(B0, 1, 0); PG8_SCHED; PG8_LDA(At, 1, 0); PG8_STAGE(PG8_SA(0, 1), a2 + hstep, voffA);
            PG8_WAIT_L(8); PG8_BAR; PG8_WAIT_L(0); PG8_MMA(0, 0, At, B0); PG8_BAR; PG8_SCHED;
            PG8_LDB(B1, 1, 1); PG8_STAGE(PG8_SB(1, 0), b3, voffB);
            PG8_BAR; PG8_WAIT_L(0); PG8_MMA(0, 1, At, B1); PG8_BAR;
            PG8_LDA(At, 1, 1); PG8_STAGE(PG8_SA(1, 0), a3, voffA);
            PG8_BAR; PG8_WAIT_L(0); PG8_MMA(1, 0, At, B0); PG8_BAR; PG8_SCHED;
            PG8_STAGE(PG8_SB(1, 1), b3 + hstep, voffB);
            PG8_WAIT_V(6); PG8_BAR; PG8_MMA(1, 1, At, B1); PG8_BAR;
            }
        }
        if constexpr (ALIGN_EPI) { if (wr == 0) PG8_BAR; }
        E(acc, cur, wr, wc, fr, fq);
        if (!has_next) break;
#pragma unroll
        for (int a = 0; a < 2; ++a)
#pragma unroll
            for (int b = 0; b < 2; ++b)
#pragma unroll
                for (int m = 0; m < 4; ++m)
#pragma unroll
                    for (int n = 0; n < 2; ++n) acc[a][b][m][n] = (f32x4){0.f, 0.f, 0.f, 0.f};
        cur = nxt; cA = nA; cB = nB; ++ui;
        if constexpr (ALIGN_EPI) { if (wr == 1) PG8_BAR; }
    }
    PG8_WAIT_V(0);
    if constexpr (!ALIGN_EPI) { if (wr == 0) PG8_BAR; }
    PG8_BAR;
#undef PG8_SA
#undef PG8_SB
#undef PG8_STAGE
#undef PG8_LDA
#undef PG8_LDB
#undef PG8_MMA
#undef PG8_WAIT_V
#undef PG8_WAIT_L
#undef PG8_BAR
#undef PG8_SCHED
}
}

constexpr int D = 1024, NB = 8, LX = 4096, LCX = 256, NIN = 4608, DA = 512, DB = 512, HD = 128;
constexpr int MLAT = NB * LX, MCTX = NB * LCX, MTOK = MLAT + MCTX;
constexpr int PA_LD = 3072;
constexpr int FZ = 8448, FZC = 640;
constexpr float EPS = 1e-6f;
constexpr float HY_MIN_DECAY = -3.0701134573253944f, HY_MAX_DECAY = -15.350567286626972f;
constexpr int NWAVES = 8, NTHR = 512;

constexpr size_t MiB = 1u << 20;
constexpr size_t WS_CTL = 0, CTL_ZERO_BYTES = 1 * MiB;
constexpr size_t WS_MOD = 1 * MiB;
constexpr size_t WS_LBS = WS_MOD + 256 * 1024;
constexpr size_t WS_WIN = 6 * MiB;
constexpr size_t WS_WOUT = 24 * MiB;
constexpr size_t WS_FG = 28 * MiB;
constexpr size_t WS_FGC = 45 * MiB;
constexpr size_t WS_CTX1 = 46 * MiB;
constexpr size_t WS_OC = 2 * MiB;
constexpr size_t WS_XA = 54 * MiB;
constexpr size_t WS_PA = 122 * MiB;
constexpr size_t WS_PB = 326 * MiB;
constexpr size_t WS_OBT = 462 * MiB;
constexpr size_t WS_HK = 326 * MiB;
constexpr size_t WS_SCL = 496 * MiB;
constexpr size_t WS_END = 504 * MiB;
constexpr int CW_NORM = 1024;
constexpr int CW_BAR = 8192;
constexpr int CW_QUEUE = 4096;

constexpr int LDS_BYTES = 156 * 1024;
#define LAS __attribute__((address_space(3)))
#define GAS __attribute__((address_space(1)))
typedef unsigned short bf16;
typedef unsigned v4u __attribute__((ext_vector_type(4)));
typedef unsigned v2u __attribute__((ext_vector_type(2)));
typedef float f32x4 __attribute__((ext_vector_type(4)));

typedef __bf16 bf2_t __attribute__((ext_vector_type(2)));
typedef float f2_t __attribute__((ext_vector_type(2)));
__device__ __forceinline__ unsigned pk2(float lo, float hi) { const f2_t v = {lo, hi}; return __builtin_bit_cast(unsigned, __builtin_convertvector(v, bf2_t)); }
__device__ __forceinline__ unsigned f2bf(float f) { return pk2(f, 0.f) & 0xffffu; }
__device__ __forceinline__ float bf2f(unsigned short h) { return __builtin_bit_cast(float, (unsigned)h << 16); }
__device__ __forceinline__ unsigned f2h(float f) { _Float16 h = (_Float16)f; return (unsigned)__builtin_bit_cast(unsigned short, h); }
__device__ __forceinline__ unsigned pk2h(float lo, float hi) { return f2h(lo) | (f2h(hi) << 16); }
__device__ __forceinline__ float h2f(unsigned short u) { return (float)__builtin_bit_cast(_Float16, u); }
__device__ __forceinline__ float silu_f(float x) { return x * __builtin_amdgcn_rcpf(1.0f + __expf(-x)); }
__device__ __forceinline__ float sigmoid_f(float x) { return __builtin_amdgcn_rcpf(1.0f + __expf(-x)); }
__device__ __forceinline__ float wave_sum(float v) {
#pragma unroll
    for (int o = 1; o < 64; o <<= 1) v += __shfl_xor(v, o);
    return v;
}


#define PSTAMP_(lds_, k_) do { if (threadIdx.x == 0) ((volatile LAS unsigned long long*)((lds_) + LDS_BYTES - 512))[(k_)] = __builtin_amdgcn_s_memrealtime(); } while (0)
#if defined(PROBE_ID) && PROBE_ID >= 216 && PROBE_ID < 220
#define PSTAMP_H(lds_, k_) PSTAMP_(lds_, k_)
#else
#define PSTAMP_H(lds_, k_) do { } while (0)
#endif
#if defined(PROBE_ID) && PROBE_ID >= 226 && PROBE_ID < 230
#define PSTAMP_P(lds_, k_) PSTAMP_(lds_, k_)
#else
#define PSTAMP_P(lds_, k_) do { } while (0)
#endif
#if defined(PROBE_ID) && PROBE_ID >= 220 && PROBE_ID < 226
#define PSTAMP_S(lds_, k_) PSTAMP_(lds_, k_)
#else
#define PSTAMP_S(lds_, k_) do { } while (0)
#endif
typedef GAS unsigned gu32;
#define XB_TMO      128
#define XB_XCNT(j)  (256  + 64 * (j))
#define XB_XSUB(j)  (1280 + 64 * (j))
#define XB_XGEN(j)  (2304 + 64 * (j))
#define XB_TOP      3328
#define XB_TOPGEN   3392
#define XCD_BAR_WORDS 3456
#define XB_SPIN_CAP (1u << 18)
__device__ __forceinline__ unsigned xb_ld(unsigned* p)              { return __hip_atomic_load(p, __ATOMIC_RELAXED, __HIP_MEMORY_SCOPE_AGENT); }
__device__ __forceinline__ unsigned xb_add(unsigned* p, unsigned v) { return __hip_atomic_fetch_add(p, v, __ATOMIC_RELAXED, __HIP_MEMORY_SCOPE_AGENT); }
__device__ __forceinline__ unsigned xb_xcc_id() { return (unsigned)__builtin_amdgcn_s_getreg((3 << 11) | 20) & 0xFu; }
#define XB_SPIN(cond, bar) do { unsigned _sp = 0; while (cond) { __builtin_amdgcn_s_sleep(1); \
    if ((++_sp & 255u) == 0u) { if (xb_ld(&(bar)[XB_TMO])) break; if (_sp > XB_SPIN_CAP) { atomicAdd(&(bar)[XB_TMO], 1u); break; } } } } while (0)
struct XcdBarrier { unsigned* bar; unsigned x; volatile LAS unsigned* st; };
__device__ __forceinline__ XcdBarrier xcd_barrier_post(unsigned* bar, volatile LAS unsigned* st) {
    XcdBarrier b; b.bar = bar; b.x = xb_xcc_id(); b.st = st;
    if (threadIdx.x == 0) (void)xb_add(&bar[XB_XCNT(b.x)], 1u);
    return b;
}
__device__ __forceinline__ void xcd_barrier_complete(unsigned* bar, unsigned x, unsigned& nloc, unsigned& nx) {
    const unsigned G = gridDim.x * gridDim.y * gridDim.z;
    unsigned sum, cnt, mine, sp = 0u;
    for (;;) {
        sum = 0u; cnt = 0u; mine = 0u;
#pragma unroll
        for (unsigned j = 0; j < 16; ++j) { const unsigned c = xb_ld(&bar[XB_XCNT(j)]); sum += c; cnt += (c > 0u) ? 1u : 0u; mine = (j == x) ? c : mine; }
        if (sum == G) break;
        __builtin_amdgcn_s_sleep(1);
        if ((++sp & 255u) == 0u) { if (xb_ld(&bar[XB_TMO])) break; if (sp > XB_SPIN_CAP) { atomicAdd(&bar[XB_TMO], 1u); break; } }
    }
    nloc = mine > 0u ? mine : 1u; nx = cnt > 0u ? cnt : 1u;
}
__device__ __forceinline__ void xcd_barrier(const XcdBarrier& b) {
    asm volatile("s_waitcnt vmcnt(0)" ::: "memory");
    __syncthreads();
    if (threadIdx.x == 0) {
        unsigned* bar = b.bar;
        __builtin_amdgcn_s_waitcnt(0);
        unsigned nloc = b.st[0], nx = b.st[1];
        if (nloc == 0u) { xcd_barrier_complete(bar, b.x, nloc, nx); b.st[0] = nloc; b.st[1] = nx; }
        const unsigned old = xb_add(&bar[XB_XSUB(b.x)], 1u);
        const unsigned gen = old / nloc;
        if (old + 1u == (gen + 1u) * nloc) {
            __builtin_amdgcn_fence(__ATOMIC_RELEASE, "agent");
            asm volatile("s_waitcnt vmcnt(0)" ::: "memory");
            const unsigned og = xb_add(&bar[XB_TOP], 1u);
            const unsigned tg = og / nx;
            if (og + 1u == (tg + 1u) * nx) xb_add(&bar[XB_TOPGEN], 1u);
            else XB_SPIN(xb_ld(&bar[XB_TOPGEN]) == tg, bar);
            __builtin_amdgcn_fence(__ATOMIC_ACQUIRE, "agent");
            xb_add(&bar[XB_XGEN(b.x)], 1u);
            asm volatile("s_waitcnt vmcnt(0)" ::: "memory");
        } else {
            XB_SPIN(xb_ld(&bar[XB_XGEN(b.x)]) == gen, bar);
            __builtin_amdgcn_fence(__ATOMIC_ACQUIRE, "agent");
            asm volatile("s_waitcnt vmcnt(0)" ::: "memory");
        }
    }
    __syncthreads();
}

struct EpiIn {
    static constexpr bool PERM = true;
    bf16* PA; bf16* PB; const float* lb;
    __device__ __forceinline__ bool swap(const pg8::Unit& u) const { return u.pn >= 10; }
    __device__ __forceinline__ void operator()(const f32x4 (&acc)[2][2][4][2], const pg8::Unit& u, int wr, int wc, int fr, int fq) const {
        if (u.pn < 10) {
            const int type = u.pn >> 1;
            const int row0 = u.pm * 256 + wr * 64 + fr, col0 = u.pn * 256 + wc * 32 + 8 * fq;
#pragma unroll
            for (int bj = 0; bj < 2; ++bj) {
                float lbv[8];
#pragma unroll
                for (int e = 0; e < 8; ++e) lbv[e] = (type == 1 || type == 2) ? lb[col0 + bj * 128 + e - 512] : 0.f;
#pragma unroll
                for (int ai = 0; ai < 2; ++ai)
#pragma unroll
                    for (int m = 0; m < 4; ++m) {
                        bf16* rowp = PA + (size_t)(row0 + ai * 128 + m * 16) * PA_LD + col0 + bj * 128;
                        float x[8];
#pragma unroll
                        for (int e = 0; e < 4; ++e) { x[e] = acc[ai][bj][m][0][e]; x[4 + e] = acc[ai][bj][m][1][e]; }
                        v4u w;
                        if (type == 0) {
#pragma unroll
                            for (int e = 0; e < 8; ++e) x[e] = silu_f(x[e]);
                            w.x = pk2(x[0], x[1]); w.y = pk2(x[2], x[3]); w.z = pk2(x[4], x[5]); w.w = pk2(x[6], x[7]);
                        } else if (type == 1 || type == 2) {
#pragma unroll
                            for (int e = 0; e < 8; ++e) x[e] = lbv[e] + (1.0f - lbv[e]) * sigmoid_f(x[e]);
                            w.x = pk2h(x[0], x[1]); w.y = pk2h(x[2], x[3]); w.z = pk2h(x[4], x[5]); w.w = pk2h(x[6], x[7]);
                        } else {
                            w.x = pk2(x[0], x[1]); w.y = pk2(x[2], x[3]); w.z = pk2(x[4], x[5]); w.w = pk2(x[6], x[7]);
                        }
                        *(v4u*)rowp = w;
                        asm volatile("" ::: "memory");
                    }
            }
        } else {
#pragma unroll
            for (int ai = 0; ai < 2; ++ai)
#pragma unroll
                for (int m = 0; m < 4; ++m) {
                    const int cw = u.pn * 256 + ai * 128 + wr * 64 + m * 16 + fr;
                    bf16* colp = PB + (size_t)(cw - 2560) * MTOK + u.pm * 256 + wc * 32 + 8 * fq;
#pragma unroll
                    for (int bj = 0; bj < 2; ++bj) {
                        const f32x4 v0 = acc[ai][bj][m][0], v1 = acc[ai][bj][m][1];
                        v4u w; w.x = pk2(v0[0], v0[1]); w.y = pk2(v0[2], v0[3]); w.z = pk2(v1[0], v1[1]); w.w = pk2(v1[2], v1[3]);
                        *(v4u*)(colp + bj * 128) = w;
                    }
                }
        }
    }
};
struct EpiOut {
    static constexpr bool PERM = false;
    const float* xin_lat; float* out_lat; const float* xin_ctx; float* out_ctx; const float* mod;
    __device__ __forceinline__ bool swap(const pg8::Unit&) const { return false; }
    __device__ __forceinline__ void operator()(const f32x4 (&acc)[2][2][4][2], const pg8::Unit& u, int wr, int wc, int fr, int fq) const {
        const bool isctx = u.pm >= 128;
        const int col0 = u.pn * 256 + wc * 32 + 4 * fq;
#pragma unroll
        for (int ai = 0; ai < 2; ++ai)
#pragma unroll
            for (int m = 0; m < 4; ++m) {
                const int row = u.pm * 256 + ai * 128 + wr * 64 + m * 16 + fr;
                const int rl = isctx ? row - MLAT : row;
                const int mr = isctx ? 8 : (row >> 12);
                const float* xi = (isctx ? xin_ctx : xin_lat) + (size_t)rl * D + col0;
                float* xo = (isctx ? out_ctx : out_lat) + (size_t)rl * D + col0;
                const float* gt = mod + (size_t)mr * 3 * D + 2 * D + col0;
#pragma unroll
                for (int bj = 0; bj < 2; ++bj)
#pragma unroll
                    for (int n = 0; n < 2; ++n) {
                        const int o = bj * 128 + n * 16;
                        const f32x4 xv = *(const f32x4*)(xi + o), gv = *(const f32x4*)(gt + o);
                        *(f32x4*)(xo + o) = xv + gv * acc[ai][bj][m][n];
                    }
            }
    }
};

struct Args {
    const float* in[23]; float* out; unsigned char* ws; int ph_lo, ph_hi;
};

struct Frame {
    LAS unsigned char* lds; int tid, lane, wave, vcu, G;
};

__device__ __forceinline__ void p0_transpose_item(const float* W, int K, int N, bf16* WT, LAS float* scr, int item, int lane) {
    const int nblk = N / 32, kb = item / nblk, nb = item % nblk, k0 = 64 * kb, n0 = 32 * nb;
#pragma unroll 8
    for (int i = 0; i < 32; ++i) { const int kk = 2 * i + (lane >> 5); scr[kk * 33 + (lane & 31)] = W[(size_t)(k0 + kk) * N + n0 + (lane & 31)]; }
    asm volatile("s_waitcnt lgkmcnt(0)" ::: "memory");
    const int c = lane & 7;
#pragma unroll
    for (int j = 0; j < 4; ++j) { const int n = (lane >> 3) + 8 * j; const LAS float* s = scr + (8 * c) * 33 + n;
        v4u o; o.x = pk2(s[0 * 33], s[1 * 33]); o.y = pk2(s[2 * 33], s[3 * 33]); o.z = pk2(s[4 * 33], s[5 * 33]); o.w = pk2(s[6 * 33], s[7 * 33]);
        *(v4u*)(WT + (size_t)(n0 + n) * K + k0 + 8 * c) = o; }
    asm volatile("s_waitcnt lgkmcnt(0)" ::: "memory");
}

__device__ __forceinline__ void filter_task(const Args& a, Frame& F, const int set, const int n0, int& cached_layer) {
    unsigned char* ws = a.ws;
    const int l = set == 1 ? 1 : 0, L = set == 2 ? 256 : 4096;
    LAS float* w1s = (LAS float*)F.lds;
    LAS float* w2s = w1s + 33 * 64;
    LAS float* w3s = w2s + 64 * 64;
    LAS float* bs = w3s + 64 * 64;
    LAS float* zs = bs + 256;
    LAS float* h3s = zs + 8 * 4 * 64;
    LAS unsigned short* tile = (LAS unsigned short*)(h3s + 32 * 64);
    if (cached_layer != l) {
        __syncthreads();
        for (int e = F.tid; e < 33 * 64; e += NTHR) w1s[e] = a.in[13][l * 33 * 64 + e];
        for (int e = F.tid; e < 4096; e += NTHR) { w2s[e] = a.in[16][l * 4096 + e]; w3s[e] = a.in[18][l * 4096 + e]; }
        if (F.tid < 64) { bs[F.tid] = a.in[14][l * 64 + F.tid]; bs[64 + F.tid] = a.in[17][l * 64 + F.tid]; bs[128 + F.tid] = a.in[19][l * 64 + F.tid]; bs[192 + F.tid] = a.in[15][l * 64 + F.tid]; }
        cached_layer = l;
        __syncthreads();
    }
    {
        const int j = F.lane; LAS float* zw = zs + F.wave * 256; const float fr = bs[192 + j];
#pragma unroll
        for (int p = 0; p < 4; ++p) {
            const int n = n0 + 4 * F.wave + p;
            float zv = 0.f;
            if (j == 0) zv = (float)n / (float)(L - 1);
            else if (j < 33) { const int i = (j - 1) & 15; const double f = 1e-4 + (double)i * ((15.0 - 1e-4) / 15.0); double rev = f * (double)n / (double)L; rev -= floor(rev);
                const float ang = (float)(rev * 6.283185307179586476925); zv = (j <= 16) ? __cosf(ang) : -__sinf(ang); }
            zw[p * 64 + j] = zv;
        }
        asm volatile("s_waitcnt lgkmcnt(0)" ::: "memory");
        float s4[4];
#pragma unroll
        for (int p = 0; p < 4; ++p) s4[p] = bs[j];
        for (int e = 0; e < 33; ++e) { const float wv = w1s[e * 64 + j];
#pragma unroll
            for (int p = 0; p < 4; ++p) s4[p] += zw[p * 64 + e] * wv; }
        asm volatile("s_waitcnt lgkmcnt(0)" ::: "memory");
#pragma unroll
        for (int p = 0; p < 4; ++p) zw[p * 64 + j] = __sinf(fr * s4[p]);
        asm volatile("s_waitcnt lgkmcnt(0)" ::: "memory");
#pragma unroll
        for (int p = 0; p < 4; ++p) s4[p] = bs[64 + j];
        for (int e = 0; e < 64; ++e) { const float wv = w2s[e * 64 + j];
#pragma unroll
            for (int p = 0; p < 4; ++p) s4[p] += zw[p * 64 + e] * wv; }
        asm volatile("s_waitcnt lgkmcnt(0)" ::: "memory");
#pragma unroll
        for (int p = 0; p < 4; ++p) zw[p * 64 + j] = __sinf(fr * s4[p]);
        asm volatile("s_waitcnt lgkmcnt(0)" ::: "memory");
#pragma unroll
        for (int p = 0; p < 4; ++p) s4[p] = bs[128 + j];
        for (int e = 0; e < 64; ++e) { const float wv = w3s[e * 64 + j];
#pragma unroll
            for (int p = 0; p < 4; ++p) s4[p] += zw[p * 64 + e] * wv; }
#pragma unroll
        for (int p = 0; p < 4; ++p) h3s[(4 * F.wave + p) * 64 + j] = __sinf(fr * s4[p]);
    }
    __syncthreads();
    {
        typedef short bf16x8_ __attribute__((ext_vector_type(8)));
        LAS unsigned char* hA = (LAS unsigned char*)(tile + 1024 * 34);
        LAS unsigned char* wB = hA + 32 * 144;
        const int l15 = F.lane & 15, q = F.lane >> 4;
        { const int p = F.tid >> 4, k4 = (F.tid & 15) * 4; const f32x4 hv = *(const LAS f32x4*)(h3s + p * 64 + k4);
          v2u hw; hw.x = pk2(hv[0], hv[1]); hw.y = pk2(hv[2], hv[3]); *(LAS v2u*)(hA + p * 144 + 2 * k4) = hw; }
        float* nrm = (float*)(ws + WS_CTL) + CW_NORM;
        const float* w4 = a.in[20] + (size_t)l * 64 * 1024;
        for (int ch = 0; ch < 8; ++ch) {
            __syncthreads();
            { const int n = F.tid & 127, kq = F.tid >> 7;
              float wv[2][8];
#pragma unroll
              for (int g2 = 0; g2 < 2; ++g2)
#pragma unroll
                  for (int e = 0; e < 8; ++e) wv[g2][e] = w4[(size_t)(16 * kq + 8 * g2 + e) * 1024 + 128 * ch + n];
#pragma unroll
              for (int g2 = 0; g2 < 2; ++g2) { v4u o; o.x = pk2(wv[g2][0], wv[g2][1]); o.y = pk2(wv[g2][2], wv[g2][3]); o.z = pk2(wv[g2][4], wv[g2][5]); o.w = pk2(wv[g2][6], wv[g2][7]);
                  *(LAS v4u*)(wB + n * 144 + (16 * kq + 8 * g2) * 2) = o; } }
            __syncthreads();
            {
                const int col = 128 * ch + 16 * F.wave + l15, c = col & 511;
                f32x4 acc[2];
#pragma unroll
                for (int mt = 0; mt < 2; ++mt) { acc[mt] = (f32x4){0.f, 0.f, 0.f, 0.f};
#pragma unroll
                    for (int ks = 0; ks < 2; ++ks)
                        acc[mt] = __builtin_amdgcn_mfma_f32_16x16x32_bf16(*(const LAS bf16x8_*)(hA + (16 * mt + l15) * 144 + (32 * ks + 8 * q) * 2), *(const LAS bf16x8_*)(wB + (16 * F.wave + l15) * 144 + (32 * ks + 8 * q) * 2), acc[mt], 0, 0, 0); }
                const float dl = fabsf(HY_MIN_DECAY + (float)c * ((HY_MAX_DECAY - HY_MIN_DECAY) / 511.0f));
                float ns = 0.f;
#pragma unroll
                for (int mt = 0; mt < 2; ++mt) {
                    float v4[4];
#pragma unroll
                    for (int r = 0; r < 4; ++r) { const int nn = n0 + 16 * mt + 4 * q + r; v4[r] = acc[mt][r] * __expf(-((float)nn / (float)(L - 1)) * dl); if (col < 512 || nn >= 1) ns += fabsf(v4[r]); }
                    *(LAS unsigned*)(tile + col * 34 + 16 * mt + 4 * q) = pk2(v4[0], v4[1]); *(LAS unsigned*)(tile + col * 34 + 16 * mt + 4 * q + 2) = pk2(v4[2], v4[3]);
                }
                ns += __shfl_xor(ns, 16); ns += __shfl_xor(ns, 32);
                if (q == 0) atomicAdd(&nrm[set * 512 + c], ns);
            }
        }
    }
    __syncthreads();
    {
        bf16* dst = set == 2 ? (bf16*)(ws + WS_FGC) : (bf16*)(ws + WS_FG) + (size_t)set * 512 * FZ;
        const int ld = set == 2 ? FZC : FZ;
        for (int e = F.tid; e < 1024 * 32; e += NTHR) {
            const int col = e >> 5, p = e & 31, c = col & 511, n = n0 + p;
            const unsigned short v = tile[col * 34 + p];
            if (col < 512) dst[(size_t)c * ld + (L - n)] = v;
            else if (n >= 1) dst[(size_t)c * ld + (L + n)] = v;
        }
        if (n0 == 0) {
            const int npad = ld - 2 * L;
            for (int e = F.tid; e < 512 * (npad + 1); e += NTHR) { const int c = e / (npad + 1), k = e % (npad + 1); dst[(size_t)c * ld + (k == 0 ? 0 : 2 * L + k - 1)] = 0; }
        }
    }
    __syncthreads();
}

__device__ __forceinline__ void phase_prologue(const Args& a, Frame& F) {
    unsigned char* ws = a.ws;
    if (F.vcu == 0) {
        float* lbs = (float*)(ws + WS_LBS);
        for (int i = F.tid; i < 1024; i += NTHR) {
            const float a0 = a.in[9][i], a1 = a.in[9][1024 + i];
            const float m = fmaxf(a0, a1), e0 = expf(a0 - m), e1 = expf(a1 - m);
            const float p0 = e0 / (e0 + e1), p1 = e1 / (e0 + e1);
            const float c0 = p0, c1 = p0 + p1;
            lbs[i] = c0 - c0; lbs[1024 + i] = c1 - c0;
        }
    }
    int cached_layer = -1;
    constexpr int I_IN = (D / 64) * (NIN / 32), I_OUT = (D / 64) * (D / 32), NTR = 2 * (I_IN + I_OUT) / 8;
    for (int t = F.vcu; t < NTR; t += F.G) {
        LAS float* scr = (LAS float*)(F.lds + 65536 + F.wave * 8704);
        int r = t * 8 + F.wave; const int l = r / (I_IN + I_OUT); r -= l * (I_IN + I_OUT);
        if (r < I_IN) p0_transpose_item(a.in[7] + (size_t)l * D * NIN, D, NIN, (bf16*)(ws + WS_WIN) + (size_t)l * NIN * D, scr, r, F.lane);
        else p0_transpose_item(a.in[8] + (size_t)l * D * D, D, D, (bf16*)(ws + WS_WOUT) + (size_t)l * D * D, scr, r - I_IN, F.lane);
    }
    __syncthreads();
    if (F.vcu >= 136 && F.vcu < 232) {
        const int task = F.vcu - 136;
        LAS float* sv = (LAS float*)(F.lds + 65536);
        LAS float* part = sv + 9 * 1024;
        const int l = task / 48, n0 = (task % 48) * 64;
        for (int e = F.tid; e < 9 * 1024; e += NTHR) { const int r = e >> 10, k = e & 1023; const float cv = r < 8 ? a.in[1][r * D + k] : a.in[3][k]; sv[e] = cv / (1.0f + expf(-cv)); }
        __syncthreads();
        float acc9[9];
#pragma unroll
        for (int r = 0; r < 9; ++r) acc9[r] = 0.f;
        const float* w = a.in[5] + (size_t)l * D * 3 * D + n0 + F.lane;
#pragma unroll 8
        for (int k = F.wave * 128; k < F.wave * 128 + 128; ++k) {
            const float wv = w[(size_t)k * 3 * D];
#pragma unroll
            for (int r = 0; r < 9; ++r) acc9[r] += sv[r * 1024 + k] * wv;
        }
#pragma unroll
        for (int r = 0; r < 9; ++r) part[(F.wave * 9 + r) * 64 + F.lane] = acc9[r];
        __syncthreads();
        for (int e = F.tid; e < 9 * 64; e += NTHR) {
            const int r = e >> 6, c = e & 63; float sum = 0.f;
#pragma unroll
            for (int w8 = 0; w8 < 8; ++w8) sum += part[(w8 * 9 + r) * 64 + c];
            ((float*)(ws + WS_MOD))[((size_t)l * 9 + r) * 3 * D + n0 + c] = sum + a.in[6][l * 3 * D + n0 + c];
        }
        __syncthreads();
    }
    if (F.vcu < 128) filter_task(a, F, 0, 32 * F.vcu, cached_layer);
    else if (F.vcu < 136) filter_task(a, F, 2, 32 * (F.vcu - 128), cached_layer);
}
__device__ __forceinline__ void phase_filters_l1(const Args& a, Frame& F) {
    int cached_layer = -1; const int b = (int)blockIdx.x;
    if (b >= 32 && b < 160) filter_task(a, F, 1, 32 * (b - 32), cached_layer);
}

__device__ __forceinline__ void phase_normrows(const Args& a, Frame& F, int l, const float* xlat, const float* xctx) {
    unsigned char* ws = a.ws;
    const float* nw = a.in[4] + l * D;
    const float* mod = (const float*)(ws + WS_MOD) + (size_t)l * 9 * 3 * D;
    bf16* XA = (bf16*)(ws + WS_XA);
    const int gw = F.vcu * NWAVES + F.wave, NGW = F.G * NWAVES;
    for (int tok = gw; tok < MTOK; tok += NGW) {
        const bool isctx = tok >= MLAT;
        const float* xr = isctx ? xctx + (size_t)(tok - MLAT) * D : xlat + (size_t)tok * D;
        const int mr = isctx ? 8 : (tok >> 12);
        const float* sh = mod + (size_t)mr * 3 * D; const float* sc = sh + D;
        f32x4 v[4]; float s = 0.f;
#pragma unroll
        for (int j = 0; j < 4; ++j) { v[j] = *(const f32x4*)(xr + 256 * j + 4 * F.lane); s += (v[j].x * v[j].x + v[j].y * v[j].y) + (v[j].z * v[j].z + v[j].w * v[j].w); }
        const float rstd = 1.0f / sqrtf(wave_sum(s) * (1.0f / D) + EPS);
#pragma unroll
        for (int j = 0; j < 4; ++j) {
            const int k = 256 * j + 4 * F.lane;
            const f32x4 w4 = *(const f32x4*)(nw + k), s4 = *(const f32x4*)(sc + k), h4 = *(const f32x4*)(sh + k);
            const f32x4 y = v[j] * rstd * w4 * (s4 + 1.0f) + h4;
            v2u o; o.x = pk2(y.x, y.y); o.y = pk2(y.z, y.w);
            *(v2u*)(XA + (size_t)tok * D + k) = o;
        }
    }
}


namespace scan {
typedef short bf16x8 __attribute__((ext_vector_type(8)));
typedef short bf16x4 __attribute__((ext_vector_type(4)));
constexpr int QI_RS = 264, KT_RS = 160, AI_RS = 160;
constexpr int OFF_QI = 0, OFF_KT = 17408, OFF_VT = 37888, OFF_AI = 58368, OFF_SCL = 68608, SET_BYTES = 70144;
constexpr int PRE_SEG = 0, PRE_QI = 8192, PRE_KI = 8192 + 17408;
#define MFMA16(a, b, c) __builtin_amdgcn_mfma_f32_16x16x32_bf16((a), (b), (c), 0, 0, 0)
__device__ __forceinline__ bf16x8 ld_perm(const LAS unsigned char* p) {
    const bf16x4 lo = *(const LAS bf16x4*)p, hi = *(const LAS bf16x4*)(p + 32);
    return __builtin_shufflevector(lo, hi, 0, 1, 2, 3, 4, 5, 6, 7);
}
__device__ __forceinline__ int tok_row(int g, int i, int b, int dir) {
    if (g < 4) { const int t = 64 * g + i; return MLAT + b * LCX + (dir ? (LCX - 1 - t) : t); }
    const int t = 64 * (g - 4) + i; return b * LX + (dir ? (LX - 1 - t) : t);
}
__device__ __forceinline__ int tok_block(int g, int b, int dir) {
    if (g < 4) return (MLAT / 64) + b * 4 + (dir ? 3 - g : g);
    return b * 64 + (dir ? 63 - (g - 4) : (g - 4));
}
struct PreRaw { unsigned rq[2][8], rf[2][8]; };
__device__ __forceinline__ void prepass_load(PreRaw& R, const bf16* PA, const int tb, const int h) {
    const int lane = threadIdx.x & 63, w = __builtin_amdgcn_readfirstlane(threadIdx.x >> 6);
    const int r0 = 64 * tb, colq = h * HD + 2 * lane;
#pragma unroll
    for (int dir = 0; dir < 2; ++dir)
#pragma unroll
        for (int e = 0; e < 8; ++e) {
            const int i = 8 * w + e, row = r0 + (dir ? 63 - i : i);
            const bf16* p = PA + (size_t)row * PA_LD + colq;
            R.rq[dir][e] = *(const unsigned*)p; R.rf[dir][e] = *(const unsigned*)(p + 512 + dir * 512);
        }
}
__device__ __forceinline__ void prepass_task(LAS unsigned char* lds, bf16* PA, float* SCL, bf16* AT, const int tb, const int h, PreRaw& R, const int nxt_tb, const int nxt_h) {
    int tid_ = threadIdx.x; asm volatile("" : "+v"(tid_));
    const int tid = tid_, lane = tid & 63, w = __builtin_amdgcn_readfirstlane(tid >> 6);
    const int r0 = 64 * tb, colq = h * HD + 2 * lane;
    float qa[2][8], qb[2][8], fa[2][8], fb[2][8];
#pragma unroll
    for (int dir = 0; dir < 2; ++dir)
#pragma unroll
        for (int e = 0; e < 8; ++e) {
            const unsigned rq = R.rq[dir][e], rf = R.rf[dir][e];
            qa[dir][e] = bf2f((unsigned short)(rq & 0xffffu)); qb[dir][e] = bf2f((unsigned short)(rq >> 16));
            fa[dir][e] = h2f((unsigned short)(rf & 0xffffu)); fb[dir][e] = h2f((unsigned short)(rf >> 16));
        }
    float pa[2][8], pb[2][8];
#pragma unroll
    for (int dir = 0; dir < 2; ++dir) {
        pa[dir][0] = fa[dir][0]; pb[dir][0] = fb[dir][0];
#pragma unroll
        for (int e = 1; e < 8; ++e) { pa[dir][e] = pa[dir][e - 1] * fa[dir][e]; pb[dir][e] = pb[dir][e - 1] * fb[dir][e]; }
        LAS float* sg = (LAS float*)(lds + PRE_SEG) + dir * 1024 + w * 128 + 2 * lane; sg[0] = pa[dir][7]; sg[1] = pb[dir][7];
    }
    __syncthreads();
#pragma unroll
    for (int dir = 0; dir < 2; ++dir) {
        const LAS float* seg = (const LAS float*)(lds + PRE_SEG) + dir * 1024 + 2 * lane;
        float ma = 1.f, mb = 1.f;
        if (w >= 4) {
#pragma unroll
            for (int s2 = 4; s2 < 7; ++s2) if (s2 < w) { ma *= seg[s2 * 128]; mb *= seg[s2 * 128 + 1]; }
        } else {
#pragma unroll
            for (int s2 = 1; s2 < 4; ++s2) if (s2 > w) { ma *= seg[s2 * 128]; mb *= seg[s2 * 128 + 1]; }
        }
        float xa[8], xb[8];
        if (w >= 4) {
#pragma unroll
            for (int e = 0; e < 8; ++e) { xa[e] = ma * pa[dir][e]; xb[e] = mb * pb[dir][e]; }
        } else {
            float sa = ma, sb = mb;
#pragma unroll
            for (int e = 7; e >= 0; --e) { xa[e] = sa; xb[e] = sb; sa *= fa[dir][e]; sb *= fb[dir][e]; }
        }
        float gma = 1.f, gmb = 1.f, gea = 1.f, geb = 1.f;
#pragma unroll
        for (int s2 = 0; s2 < 4; ++s2) { gma *= seg[s2 * 128]; gmb *= seg[s2 * 128 + 1]; }
#pragma unroll
        for (int s2 = 4; s2 < 8; ++s2) { gea *= seg[s2 * 128]; geb *= seg[s2 * 128 + 1]; }
#pragma unroll
        for (int e = 0; e < 8; ++e) {
            const float ka = 1.0f - fa[dir][e], kb = 1.0f - fb[dir][e];
            const float ra = __builtin_amdgcn_rcpf(fmaxf(xa[e], 1e-30f)), rb = __builtin_amdgcn_rcpf(fmaxf(xb[e], 1e-30f));
            float Qa, Qb, Ka, Kb;
            if (w >= 4) { Qa = qa[dir][e] * xa[e]; Qb = qb[dir][e] * xb[e]; Ka = ka * ra; Kb = kb * rb; }
            else { Qa = qa[dir][e] * ra; Qb = qb[dir][e] * rb; Ka = ka * xa[e]; Kb = kb * xb[e]; }
            const int i = 8 * w + e, row = r0 + (dir ? 63 - i : i);
            bf16* p = PA + (size_t)row * PA_LD + colq;
            const unsigned qw = pk2(Qa, Qb), kw = pk2(Ka, Kb);
            *(unsigned*)(p + (dir ? 2560 : 0)) = pk2(Qa * gma, Qb * gmb);
            *(unsigned*)(p + 512 + dir * 512) = pk2(Ka * gea, Kb * geb);
            *(LAS unsigned*)(lds + PRE_QI + dir * 34816 + i * QI_RS + 4 * lane) = qw;
            *(LAS unsigned*)(lds + PRE_KI + dir * 34816 + i * QI_RS + 4 * lane) = kw;
        }
        if (w == 0) *(f2_t*)(SCL + (size_t)(dir * 544 + tb) * 512 + colq) = (f2_t){gma * gea, gmb * geb};
    }
    __syncthreads();
    if (nxt_tb >= 0) prepass_load(R, PA, nxt_tb, nxt_h);
    {
        const int l15 = lane & 15, q = lane >> 4;
        for (int tt = w; tt < 32; tt += 8) {
            const int dir = tt >> 4, it = (tt & 15) >> 2, jt = tt & 3;
            f32x4 a4 = (f32x4){0.f, 0.f, 0.f, 0.f};
            if (jt <= it) {
#pragma unroll
                for (int ks = 0; ks < 4; ++ks)
                    a4 = MFMA16(ld_perm(lds + PRE_KI + dir * 34816 + (16 * jt + l15) * QI_RS + (32 * ks + 4 * q) * 2), ld_perm(lds + PRE_QI + dir * 34816 + (16 * it + l15) * QI_RS + (32 * ks + 4 * q) * 2), a4);
#pragma unroll
                for (int r = 0; r < 4; ++r) a4[r] = (16 * jt + 4 * q + r <= 16 * it + l15) ? a4[r] : 0.f;
            }
            v2u wv; wv.x = pk2(a4[0], a4[1]); wv.y = pk2(a4[2], a4[3]);
            *(v2u*)(AT + ((size_t)((dir * 544 + tb) * 4 + h)) * 4096 + (16 * it + l15) * 64 + 16 * jt + 4 * q) = wv;
        }
    }
    __syncthreads();
}
__device__ __forceinline__ void scan_unit(LAS unsigned char* lds, bf16* PA, bf16* OC, const float* SCL, const bf16* AT, const int b, const int h, const int dir, const bool ctxunit) {
    int tid_ = threadIdx.x; asm volatile("" : "+v"(tid_));
    const int tid = tid_, lane = tid & 63, w = __builtin_amdgcn_readfirstlane(tid >> 6);
    const int l15 = lane & 15, q = lane >> 4;
    const int nchunk = ctxunit ? 4 : 68;
    if (w >= 4) {
        const int pw = w - 4, ptid = tid - 256, th = lane >> 5, kq = lane & 31, colq = h * HD + 4 * kq;
        v2u qA[8], kA[8], vA[8], qB[8], kB[8], vB[8]; v4u a0A, a1A, a0B, a1B; f32x4 sA = (f32x4){0.f, 0.f, 0.f, 0.f}, sB = sA;
#define SCAN_LOAD(g, Q_, K_, V_, A0_, A1_, S_) do { _Pragma("unroll") for (int e = 0; e < 8; ++e) { const bf16* p_ = PA + (size_t)tok_row((g), 16 * pw + 8 * th + e, b, dir) * PA_LD + colq; \
            Q_[e] = *(const v2u*)(p_ + (dir ? 2560 : 0)); K_[e] = *(const v2u*)(p_ + 512 + dir * 512); V_[e] = *(const v2u*)(p_ + 1536); } \
            const int tb_ = tok_block((g), b, dir); const bf16* at_ = AT + ((size_t)((dir * 544 + tb_) * 4 + h)) * 4096 + ptid * 16; A0_ = *(const v4u*)at_; A1_ = *(const v4u*)(at_ + 8); \
            S_ = *(const f32x4*)(SCL + (size_t)(dir * 544 + tb_) * 512 + h * HD + 4 * (ptid & 31)); } while (0)
#define SCAN_IMG(set_, Q_, K_, V_, A0_, A1_, S_) do { LAS unsigned char* s_ = lds + (set_) * SET_BYTES; \
            _Pragma("unroll") for (int e = 0; e < 8; ++e) *(LAS v2u*)(s_ + OFF_QI + (16 * pw + 8 * th + e) * QI_RS + 8 * kq) = Q_[e]; \
            _Pragma("unroll") for (int d = 0; d < 4; ++d) { v4u t_, u_; \
                _Pragma("unroll") for (int e = 0; e < 4; ++e) { const unsigned ka_ = (d & 2) ? K_[2 * e].y : K_[2 * e].x, kb_ = (d & 2) ? K_[2 * e + 1].y : K_[2 * e + 1].x, va_ = (d & 2) ? V_[2 * e].y : V_[2 * e].x, vb_ = (d & 2) ? V_[2 * e + 1].y : V_[2 * e + 1].x; \
                    t_[e] = (d & 1) ? ((ka_ >> 16) | (kb_ & 0xffff0000u)) : ((ka_ & 0xffffu) | (kb_ << 16)); u_[e] = (d & 1) ? ((va_ >> 16) | (vb_ & 0xffff0000u)) : ((va_ & 0xffffu) | (vb_ << 16)); } \
                *(LAS v4u*)(s_ + OFF_KT + (4 * kq + d) * KT_RS + 16 * ((2 * pw + th) ^ (kq & 7))) = t_; *(LAS v4u*)(s_ + OFF_VT + (4 * kq + d) * KT_RS + 16 * ((2 * pw + th) ^ (kq & 7))) = u_; } \
            *(LAS v4u*)(s_ + OFF_AI + (ptid >> 2) * AI_RS + 32 * (ptid & 3)) = A0_; *(LAS v4u*)(s_ + OFF_AI + (ptid >> 2) * AI_RS + 32 * (ptid & 3) + 16) = A1_; \
            if (ptid < 32) *(LAS f32x4*)(s_ + OFF_SCL + 16 * ptid) = S_; } while (0)
        const int last = nchunk - 1;
        SCAN_LOAD(0, qA, kA, vA, a0A, a1A, sA);
        SCAN_LOAD(1, qB, kB, vB, a0B, a1B, sB);
        SCAN_IMG(0, qA, kA, vA, a0A, a1A, sA);
        SCAN_LOAD(2, qA, kA, vA, a0A, a1A, sA);
        __syncthreads();
        for (int g = 0; g < nchunk; g += 2) {
            SCAN_IMG(1, qB, kB, vB, a0B, a1B, sB);
            { const int gn = g + 3 < last ? g + 3 : last; SCAN_LOAD(gn, qB, kB, vB, a0B, a1B, sB); }
            __syncthreads();
            SCAN_IMG(0, qA, kA, vA, a0A, a1A, sA);
            { const int gn = g + 4 < last ? g + 4 : last; SCAN_LOAD(gn, qA, kA, vA, a0A, a1A, sA); }
            __syncthreads();
        }
#undef SCAN_LOAD
#undef SCAN_IMG
    } else {
        f32x4 S[2][8];
#pragma unroll
        for (int c = 0; c < 2; ++c)
#pragma unroll
            for (int kt = 0; kt < 8; ++kt) S[c][kt] = (f32x4){0.f, 0.f, 0.f, 0.f};
        const int vc0 = 32 * w;
        if (!ctxunit) PSTAMP_S(lds, 20);
        __syncthreads();
        for (int g = 0; g < nchunk; ++g) {
            const bool do_o = ctxunit || g >= 4;
            if (g == 30) PSTAMP_S(lds, 22);
            const LAS unsigned char* cs = lds + (g & 1) * SET_BYTES;
            bf16x8 vt[2][2];
#pragma unroll
            for (int c = 0; c < 2; ++c) { const int r_ = vc0 + 8 * (l15 >> 2) + 4 * c + (l15 & 3), x_ = (r_ >> 2) & 7;
                vt[c][0] = *(const LAS bf16x8*)(cs + OFF_VT + r_ * KT_RS + 16 * (q ^ x_)); vt[c][1] = *(const LAS bf16x8*)(cs + OFF_VT + r_ * KT_RS + 16 * ((4 + q) ^ x_)); }
            if (do_o) {
                f32x4 O[2][4];
#pragma unroll
                for (int c = 0; c < 2; ++c)
#pragma unroll
                    for (int it = 0; it < 4; ++it) O[c][it] = (f32x4){0.f, 0.f, 0.f, 0.f};
#pragma unroll
                for (int ks = 0; ks < 4; ++ks) {
                    bf16x8 sf[2];
#pragma unroll
                    for (int c = 0; c < 2; ++c) { const f32x4 s0 = S[c][2 * ks], s1 = S[c][2 * ks + 1];
                        v4u pk; pk.x = pk2(s0[0], s0[1]); pk.y = pk2(s0[2], s0[3]); pk.z = pk2(s1[0], s1[1]); pk.w = pk2(s1[2], s1[3]); sf[c] = __builtin_bit_cast(bf16x8, pk); }
#pragma unroll
                    for (int it = 0; it < 4; ++it) { const bf16x8 qf = ld_perm(cs + OFF_QI + (16 * it + l15) * QI_RS + (32 * ks + 4 * q) * 2);
                        O[0][it] = MFMA16(sf[0], qf, O[0][it]); O[1][it] = MFMA16(sf[1], qf, O[1][it]); }
                }
#pragma unroll
                for (int it = 0; it < 4; ++it) {
                    const bf16x8 a0 = *(const LAS bf16x8*)(cs + OFF_AI + (16 * it + l15) * AI_RS + 16 * q);
                    O[0][it] = MFMA16(vt[0][0], a0, O[0][it]); O[1][it] = MFMA16(vt[1][0], a0, O[1][it]);
                    if (it >= 2) { const bf16x8 a1 = *(const LAS bf16x8*)(cs + OFF_AI + (16 * it + l15) * AI_RS + 64 + 16 * q);
                        O[0][it] = MFMA16(vt[0][1], a1, O[0][it]); O[1][it] = MFMA16(vt[1][1], a1, O[1][it]); }
                }
#pragma unroll
                for (int it = 0; it < 4; ++it) {
                    const int row = tok_row(g, 16 * it + l15, b, dir);
                    bf16* dst = (g < 4) ? OC + (size_t)dir * MCTX * 512 + (size_t)(row - MLAT) * 512 + h * HD + vc0 + 8 * q
                                        : PA + (size_t)row * PA_LD + 512 + dir * 512 + h * HD + vc0 + 8 * q;
                    v4u wv; wv.x = pk2(O[0][it][0], O[0][it][1]); wv.y = pk2(O[0][it][2], O[0][it][3]); wv.z = pk2(O[1][it][0], O[1][it][1]); wv.w = pk2(O[1][it][2], O[1][it][3]);
                    *(v4u*)dst = wv;
                }
            }
#pragma unroll
            for (int kt = 0; kt < 8; ++kt) {
                const f32x4 ge = *(const LAS f32x4*)(cs + OFF_SCL + (16 * kt + 4 * q) * 4);
                const int xk_ = (4 * kt + (l15 >> 2)) & 7;
                const bf16x8 k0 = *(const LAS bf16x8*)(cs + OFF_KT + (16 * kt + l15) * KT_RS + 16 * (q ^ xk_)), k1 = *(const LAS bf16x8*)(cs + OFF_KT + (16 * kt + l15) * KT_RS + 16 * ((4 + q) ^ xk_));
#pragma unroll
                for (int c = 0; c < 2; ++c) { f32x4 d4 = ge * S[c][kt]; d4 = MFMA16(k0, vt[c][0], d4); S[c][kt] = MFMA16(k1, vt[c][1], d4); }
            }
            if (g == 30) PSTAMP_S(lds, 23);
            __syncthreads();
            if (g == 30) PSTAMP_S(lds, 24);
        }
        if (!ctxunit) PSTAMP_S(lds, 21);
    }
}
}


namespace hy {
typedef short bf16x8 __attribute__((ext_vector_type(8)));
typedef short bf16x4 __attribute__((ext_vector_type(4)));
constexpr int CS = 16416;
constexpr int VPAD = 7;
constexpr int OFF_F = 0, OFF_V = 4 * CS, V_ROWS = (64 + VPAD + 7) * 8, LDS_END = OFF_V + V_ROWS * 128;
static_assert(LDS_END <= LDS_BYTES - 256, "hyena LDS");
struct ConvW { float x0[4], x1[4], v[4]; };
__device__ __forceinline__ ConvW load_convw(const Args& a, int l, int c) {
    const float* cw = a.in[11] + (size_t)l * 3 * 1536; const float* cb = a.in[12] + (size_t)l * 1536; ConvW r;
#pragma unroll
    for (int j = 0; j < 3; ++j) { r.x0[j] = cw[j * 1536 + c]; r.x1[j] = cw[j * 1536 + 512 + c]; r.v[j] = cw[j * 1536 + 1024 + c]; }
    r.x0[3] = cb[c]; r.x1[3] = cb[512 + c]; r.v[3] = cb[1024 + c];
    return r;
}
__device__ __forceinline__ void hyena_channel(LAS unsigned char* lds, const Args& a, const int l, const int c) {
    int tid_ = threadIdx.x; asm volatile("" : "+v"(tid_));
    const int tid = tid_, lane = tid & 63, w = __builtin_amdgcn_readfirstlane(tid >> 6), l15 = lane & 15, q = lane >> 4;
    unsigned char* ws = a.ws;
    const bf16* PB = (const bf16*)(ws + WS_PB);
    const bf16* x0r = PB + (size_t)c * MTOK; const bf16* x1r = PB + (size_t)(512 + c) * MTOK; const bf16* vr = PB + (size_t)(1024 + c) * MTOK; const bf16* gbr = PB + (size_t)(1536 + c) * MTOK;
    const ConvW cw = load_convw(a, l, c);
    PSTAMP_H(lds, 16);
    {
        const bf16* F = (const bf16*)(ws + WS_FG) + ((size_t)l * 512 + c) * FZ;
        for (int ch = tid; ch < 1024; ch += NTHR) {
            const v4u cur = *(const v4u*)(F + 8 * ch); v4u prev = *(const v4u*)(F + (ch > 0 ? 8 * ch - 8 : 0));
            if (ch == 0) prev = (v4u){0u, 0u, 0u, 0u};
            const unsigned W[8] = {prev.x, prev.y, prev.z, prev.w, cur.x, cur.y, cur.z, cur.w};
            v4u c1, c2, c3;
#pragma unroll
            for (int d = 0; d < 4; ++d) { c1[d] = (W[3 + d] >> 16) | (W[4 + d] << 16); c2[d] = W[3 + d]; c3[d] = (W[2 + d] >> 16) | (W[3 + d] << 16); }
            *(LAS v4u*)(lds + OFF_F + 0 * CS + 16 * ch) = cur;
            *(LAS v4u*)(lds + OFF_F + 1 * CS + 16 * ch) = c1;
            *(LAS v4u*)(lds + OFF_F + 2 * CS + 16 * ch) = c2;
            *(LAS v4u*)(lds + OFF_F + 3 * CS + 16 * ch) = c3;
        }
    }
    {
        for (int e = tid; e < VPAD * 8 * 32; e += NTHR) ((LAS unsigned*)(lds + OFF_V))[e] = 0u;
        for (int e = tid; e < 7 * 8 * 32; e += NTHR) ((LAS unsigned*)(lds + OFF_V + (64 + VPAD) * 8 * 128))[e] = 0u;
        for (int bt = 0; bt < 2; ++bt) {
            v4u vw[4], xw[4]; unsigned short hv[4][2], hx[4][2];
#pragma unroll
            for (int j = 0; j < 4; ++j) {
                const int e = tid + NTHR * (4 * bt + j), b = e >> 9, t0 = (e & 511) * 8;
                const size_t base = (size_t)b * LX + t0;
                const size_t bm = t0 > 0 ? base - 1 : base, bp = t0 + 8 < LX ? base + 8 : base;
                vw[j] = *(const v4u*)(vr + base); xw[j] = *(const v4u*)(x1r + base);
                hv[j][0] = vr[bm]; hv[j][1] = vr[bp]; hx[j][0] = x1r[bm]; hx[j][1] = x1r[bp];
            }
#pragma unroll
            for (int j = 0; j < 4; ++j) {
                const int e = tid + NTHR * (4 * bt + j), b = e >> 9, t0 = (e & 511) * 8, ab = t0 >> 6, ch = (t0 & 63) >> 3;
                float vv[10], xx[10];
                vv[0] = t0 > 0 ? bf2f(hv[j][0]) : 0.f; xx[0] = t0 > 0 ? bf2f(hx[j][0]) : 0.f;
                vv[9] = t0 + 8 < LX ? bf2f(hv[j][1]) : 0.f; xx[9] = t0 + 8 < LX ? bf2f(hx[j][1]) : 0.f;
#pragma unroll
                for (int d = 0; d < 4; ++d) { vv[1 + 2 * d] = bf2f((unsigned short)(vw[j][d] & 0xffffu)); vv[2 + 2 * d] = bf2f((unsigned short)(vw[j][d] >> 16));
                                              xx[1 + 2 * d] = bf2f((unsigned short)(xw[j][d] & 0xffffu)); xx[2 + 2 * d] = bf2f((unsigned short)(xw[j][d] >> 16)); }
                float p[8];
#pragma unroll
                for (int d = 0; d < 8; ++d) p[d] = (cw.v[3] + cw.v[0] * vv[d] + cw.v[1] * vv[d + 1] + cw.v[2] * vv[d + 2]) * (cw.x1[3] + cw.x1[0] * xx[d] + cw.x1[1] * xx[d + 1] + cw.x1[2] * xx[d + 2]);
                v4u o; o.x = pk2(p[0], p[1]); o.y = pk2(p[2], p[3]); o.z = pk2(p[4], p[5]); o.w = pk2(p[6], p[7]);
                const int R = (ab + VPAD) * 8 + b;
                *(LAS v4u*)(lds + OFF_V + R * 128 + 16 * (ch ^ ((R >> 1) & 7))) = o;
            }
        }
    }
    __syncthreads();
    PSTAMP_H(lds, 17);
    f32x4 acc[4][4];
#pragma unroll
    for (int mt = 0; mt < 4; ++mt)
#pragma unroll
        for (int nt = 0; nt < 4; ++nt) acc[mt][nt] = (f32x4){0.f, 0.f, 0.f, 0.f};
    {
        const LAS unsigned char* pa = lds + OFF_F + (l15 & 3) * CS + (4096 - 4 * (l15 >> 2) + 8 * q) * 2 - 96;
        const int rowl = (l15 >> 3) * 8 + (l15 & 7);
        const int cq = (q ^ (rowl >> 1)) & 7;
        const LAS unsigned char* vb0 = lds + OFF_V + rowl * 128 + (8 * w + VPAD) * 1024 + 16 * cq;
        const LAS unsigned char* vb1 = lds + OFF_V + rowl * 128 + (8 * w + VPAD) * 1024 + 16 * (cq ^ 4);
#define HY_LDA(An_, m_) do { const LAS unsigned char* p_ = pa - 128 * (m_); _Pragma("unroll") for (int mt = 0; mt < 4; ++mt) { \
            const bf16x4 lo_ = *(const LAS bf16x4*)(p_ + 32 * (3 - mt)), hi_ = *(const LAS bf16x4*)(p_ + 32 * (3 - mt) + 8); An_[mt] = __builtin_shufflevector(lo_, hi_, 0, 1, 2, 3, 4, 5, 6, 7); } } while (0)
#define HY_LDB(B_, m_, PAR_) do { const LAS unsigned char* p0_ = ((PAR_) ? vb1 : vb0) - 1024 * (m_); const LAS unsigned char* p1_ = ((PAR_) ? vb0 : vb1) - 1024 * (m_); \
            _Pragma("unroll") for (int nt = 0; nt < 4; ++nt) { B_[0][nt] = *(const LAS bf16x8*)(p0_ + 2048 * nt); B_[1][nt] = *(const LAS bf16x8*)(p1_ + 2048 * nt); } } while (0)
#define HY_MMA(An_, Ao0_, Ao1_, B_, m_) do { _Pragma("unroll") for (int nt = 0; nt < 4; ++nt) { const int a0_ = 8 * w + 2 * nt - (m_); if (a0_ + 1 >= 0 && a0_ <= 63) { \
            _Pragma("unroll") for (int mt = 0; mt < 4; ++mt) acc[mt][nt] = __builtin_amdgcn_mfma_f32_16x16x32_bf16(An_[mt], B_[0][nt], acc[mt][nt], 0, 0, 0); \
            acc[0][nt] = __builtin_amdgcn_mfma_f32_16x16x32_bf16(Ao0_, B_[1][nt], acc[0][nt], 0, 0, 0); acc[1][nt] = __builtin_amdgcn_mfma_f32_16x16x32_bf16(Ao1_, B_[1][nt], acc[1][nt], 0, 0, 0); \
            acc[2][nt] = __builtin_amdgcn_mfma_f32_16x16x32_bf16(An_[0], B_[1][nt], acc[2][nt], 0, 0, 0); acc[3][nt] = __builtin_amdgcn_mfma_f32_16x16x32_bf16(An_[1], B_[1][nt], acc[3][nt], 0, 0, 0); } } } while (0)
        bf16x8 Aa[4], Ab[4], Ba[2][4], Bb[2][4], o0, o1;
        const int m0 = 8 * w - 63, mlast = 8 * w + 7;
        { bf16x8 t_[4]; HY_LDA(t_, m0 - 1); o0 = t_[2]; o1 = t_[3]; }
        HY_LDA(Aa, m0); HY_LDB(Ba, m0, 0);
        for (int m = m0; m < mlast; m += 2) {
            HY_LDA(Ab, m + 1); HY_LDB(Bb, m + 1, 1);
            HY_MMA(Aa, o0, o1, Ba, m);
            o0 = Aa[2]; o1 = Aa[3];
            HY_LDA(Aa, m + 2); HY_LDB(Ba, m + 2, 0);
            HY_MMA(Ab, o0, o1, Bb, m + 1);
            o0 = Ab[2]; o1 = Ab[3];
        }
        HY_MMA(Aa, o0, o1, Ba, mlast);
#undef HY_LDA
#undef HY_LDB
#undef HY_MMA
    }
    PSTAMP_H(lds, 18);
    __syncthreads();
    {
        constexpr int YRS = 8208;
        const float inn = 1.0f / ((const float*)(ws + WS_CTL))[CW_NORM + l * 512 + c], hb = a.in[21][l * 512 + c];
        const int b = l15 & 7;
#pragma unroll
        for (int nt = 0; nt < 4; ++nt) {
            const int ab = 8 * w + 2 * nt + (l15 >> 3), R = (ab + VPAD) * 8 + b;
#pragma unroll
            for (int mt = 0; mt < 4; ++mt) {
                const int t = 64 * ab + 16 * mt + 4 * q;
                const v2u vw = *(const LAS v2u*)(lds + OFF_V + R * 128 + 16 * ((2 * mt + (q >> 1)) ^ ((R >> 1) & 7)) + 8 * (q & 1));
                const float y0 = acc[mt][nt][0] * inn + bf2f((unsigned short)(vw.x & 0xffffu)) * hb, y1 = acc[mt][nt][1] * inn + bf2f((unsigned short)(vw.x >> 16)) * hb;
                const float y2 = acc[mt][nt][2] * inn + bf2f((unsigned short)(vw.y & 0xffffu)) * hb, y3 = acc[mt][nt][3] * inn + bf2f((unsigned short)(vw.y >> 16)) * hb;
                v2u yw; yw.x = pk2(y0, y1); yw.y = pk2(y2, y3);
                *(LAS v2u*)(lds + OFF_F + b * YRS + 2 * t) = yw;
            }
        }
        __syncthreads();
        bf16* OBT = (bf16*)(ws + WS_OBT) + (size_t)c * MTOK;
        int tid2 = tid; asm volatile("" : "+v"(tid2));
        for (int bt = 0; bt < 4; ++bt) {
            v4u xw[2], gw[2]; unsigned short hx[2][2];
#pragma unroll
            for (int j = 0; j < 2; ++j) {
                const int e = tid2 + NTHR * (2 * bt + j), bb = e >> 9, t0 = (e & 511) * 8;
                const size_t base = (size_t)bb * LX + t0;
                xw[j] = *(const v4u*)(x0r + base); gw[j] = *(const v4u*)(gbr + base);
                hx[j][0] = x0r[t0 > 0 ? base - 1 : base]; hx[j][1] = x0r[t0 + 8 < LX ? base + 8 : base];
            }
#pragma unroll
            for (int j = 0; j < 2; ++j) {
                const int e = tid2 + NTHR * (2 * bt + j), bb = e >> 9, t0 = (e & 511) * 8;
                const size_t base = (size_t)bb * LX + t0;
                const v4u yw = *(const LAS v4u*)(lds + OFF_F + bb * YRS + 2 * t0);
                float xs[10], o[8];
                xs[0] = t0 > 0 ? bf2f(hx[j][0]) : 0.f; xs[9] = t0 + 8 < LX ? bf2f(hx[j][1]) : 0.f;
#pragma unroll
                for (int d = 0; d < 4; ++d) { xs[1 + 2 * d] = bf2f((unsigned short)(xw[j][d] & 0xffffu)); xs[2 + 2 * d] = bf2f((unsigned short)(xw[j][d] >> 16)); }
#pragma unroll
                for (int d = 0; d < 8; ++d) {
                    const float yv = bf2f((unsigned short)((d & 1) ? (yw[d >> 1] >> 16) : (yw[d >> 1] & 0xffffu)));
                    const float gv = bf2f((unsigned short)((d & 1) ? (gw[j][d >> 1] >> 16) : (gw[j][d >> 1] & 0xffffu)));
                    o[d] = yv * (cw.x0[3] + cw.x0[0] * xs[d] + cw.x0[1] * xs[d + 1] + cw.x0[2] * xs[d + 2]) * silu_f(gv);
                }
                v4u ow; ow.x = pk2(o[0], o[1]); ow.y = pk2(o[2], o[3]); ow.z = pk2(o[4], o[5]); ow.w = pk2(o[6], o[7]);
                *(v4u*)(OBT + base) = ow;
            }
        }
    }
    PSTAMP_H(lds, 19);
    __syncthreads();
}
__device__ __forceinline__ void hyena_ctx_channel(LAS unsigned char* lds, const Args& a, const int c) {
    int tid_ = threadIdx.x; asm volatile("" : "+v"(tid_));
    const int tid = tid_;
    unsigned char* ws = a.ws;
    const bf16* PB = (const bf16*)(ws + WS_PB);
    const bf16* x0r = PB + (size_t)c * MTOK + MLAT; const bf16* x1r = PB + (size_t)(512 + c) * MTOK + MLAT; const bf16* vr = PB + (size_t)(1024 + c) * MTOK + MLAT; const bf16* gbr = PB + (size_t)(1536 + c) * MTOK + MLAT;
    const ConvW cw = load_convw(a, 0, c);
    LAS float* vvc = (LAS float*)lds;
    LAS float* Fc = vvc + 2048;
    for (int e = tid; e < 2048; e += NTHR) {
        const int t = e & 255;
        const float vm_ = bf2f(vr[t > 0 ? e - 1 : e]), v0 = bf2f(vr[e]), vp_ = bf2f(vr[t < 255 ? e + 1 : e]);
        const float xm_ = bf2f(x1r[t > 0 ? e - 1 : e]), x0 = bf2f(x1r[e]), xp_ = bf2f(x1r[t < 255 ? e + 1 : e]);
        const float vm = t > 0 ? vm_ : 0.f, vp = t < 255 ? vp_ : 0.f, xm = t > 0 ? xm_ : 0.f, xp = t < 255 ? xp_ : 0.f;
        vvc[e] = (cw.v[3] + cw.v[0] * vm + cw.v[1] * v0 + cw.v[2] * vp) * (cw.x1[3] + cw.x1[0] * xm + cw.x1[1] * x0 + cw.x1[2] * xp);
    }
    if (tid < 520) Fc[tid] = tid < 512 ? bf2f(((const bf16*)(ws + WS_FGC))[(size_t)c * FZC + tid]) : 0.f;
    __syncthreads();
    const float inn = 1.0f / ((const float*)(ws + WS_CTL))[CW_NORM + 2 * 512 + c], hb = a.in[21][c];
    bf16* OBT = (bf16*)(ws + WS_OBT) + (size_t)c * MTOK + MLAT;
    {
        const int b = tid >> 6, t0 = 4 * (tid & 63), e0 = b * 256 + t0;
        float acc4[4] = {0.f, 0.f, 0.f, 0.f};
        const LAS float* fp = Fc + 252 - t0;
        for (int s4 = 0; s4 < 64; ++s4) {
            const f32x4 ga = *(const LAS f32x4*)(fp + 4 * s4), gb = *(const LAS f32x4*)(fp + 4 * s4 + 4), vq = *(const LAS f32x4*)(vvc + b * 256 + 4 * s4);
            const float g[8] = {ga[0], ga[1], ga[2], ga[3], gb[0], gb[1], gb[2], gb[3]};
#pragma unroll
            for (int i = 0; i < 4; ++i)
#pragma unroll
                for (int u = 0; u < 4; ++u) acc4[i] += g[4 - i + u] * vq[u];
        }
        float xs[6], gv[4];
        xs[0] = t0 > 0 ? bf2f(x0r[e0 - 1]) : 0.f;
#pragma unroll
        for (int i = 0; i < 4; ++i) { xs[1 + i] = bf2f(x0r[e0 + i]); gv[i] = bf2f(gbr[e0 + i]); }
        xs[5] = t0 + 4 < 256 ? bf2f(x0r[e0 + 4]) : 0.f;
        float o[4];
#pragma unroll
        for (int i = 0; i < 4; ++i) o[i] = (acc4[i] * inn + vvc[e0 + i] * hb) * (cw.x0[3] + cw.x0[0] * xs[i] + cw.x0[1] * xs[i + 1] + cw.x0[2] * xs[i + 2]) * silu_f(gv[i]);
        v2u ow; ow.x = pk2(o[0], o[1]); ow.y = pk2(o[2], o[3]);
        *(v2u*)(OBT + e0) = ow;
    }
    __syncthreads();
}
}


__device__ __forceinline__ void phase_prepass(const Args& a, Frame& F) {
    scan::PreRaw R;
    if (F.vcu < 544 * 4) scan::prepass_load(R, (const bf16*)(a.ws + WS_PA), F.vcu >> 2, F.vcu & 3);
    for (int t = F.vcu; t < 544 * 4; t += F.G) { const int tn = t + F.G < 544 * 4 ? t + F.G : -4;
        scan::prepass_task(F.lds, (bf16*)(a.ws + WS_PA), (float*)(a.ws + WS_SCL), (bf16*)(a.ws + WS_XA), t >> 2, t & 3, R, tn >> 2, tn & 3); }
}

__device__ __forceinline__ void phase_mix(const Args& a, Frame& F, const int l, const int part = -1) {
    unsigned* qctr = (unsigned*)(a.ws + WS_CTL) + CW_QUEUE + 64 * l + (part == 1 ? 128 : 0);
    volatile LAS int* slot = (volatile LAS int*)(F.lds + LDS_BYTES - 64);
    const int ntasks = l == 0 ? 64 + 512 + 64 + 512 : 64 + 512;
    for (;;) {
        if (F.tid == 0) slot[0] = (int)atomicAdd(qctr, 1u);
        __syncthreads();
        const int t = __builtin_amdgcn_readfirstlane(slot[0]);
        __syncthreads();
        if (t >= ntasks) break;
        if (part == 0 && !(t < 64 || (t >= 576 && t < 640))) continue;
        if (part == 1 && (t < 64 || (t >= 576 && t < 640))) continue;
        if (t < 64) scan::scan_unit(F.lds, (bf16*)(a.ws + WS_PA), (bf16*)(a.ws + WS_OC), (const float*)(a.ws + WS_SCL), (const bf16*)(a.ws + WS_XA), t >> 3, (t >> 1) & 3, t & 1, false);
        else if (t < 576) hy::hyena_channel(F.lds, a, l, t - 64);
        else if (t < 640) { const int u = t - 576; scan::scan_unit(F.lds, (bf16*)(a.ws + WS_PA), (bf16*)(a.ws + WS_OC), (const float*)(a.ws + WS_SCL), (const bf16*)(a.ws + WS_XA), u >> 3, (u >> 1) & 3, u & 1, true); }
        else hy::hyena_ctx_channel(F.lds, a, t - 640);
        __syncthreads();
    }
}

__device__ __forceinline__ void phase_finalize_ox(const Args& a, Frame& F, int l) {
    unsigned char* ws = a.ws;
    const bf16* PA = (const bf16*)(ws + WS_PA);
    const bf16* OC = (const bf16*)(ws + WS_OC);
    bf16* XA = (bf16*)(ws + WS_XA);
    const float* gnw = a.in[10] + l * 512;
    const int gw = F.vcu * NWAVES + F.wave, NGW = F.G * NWAVES;
    const int ntok = (l == 0) ? MTOK : MLAT;
    for (int tok = gw; tok < ntok; tok += NGW) {
        const bool isctx = tok >= MLAT;
        const int c8 = 8 * F.lane;
        const bf16* pf = isctx ? OC + (size_t)(tok - MLAT) * 512 + c8 : PA + (size_t)tok * PA_LD + 512 + c8;
        const bf16* pb = isctx ? OC + (size_t)MCTX * 512 + (size_t)(tok - MLAT) * 512 + c8 : PA + (size_t)tok * PA_LD + 1024 + c8;
        const v4u wf = *(const v4u*)pf, wb = *(const v4u*)pb, wg = *(const v4u*)(PA + (size_t)tok * PA_LD + 2048 + c8);
        float o[8], g[8];
#pragma unroll
        for (int e = 0; e < 4; ++e) {
            o[2 * e] = bf2f((unsigned short)(wf[e] & 0xffff)) + bf2f((unsigned short)(wb[e] & 0xffff));
            o[2 * e + 1] = bf2f((unsigned short)(wf[e] >> 16)) + bf2f((unsigned short)(wb[e] >> 16));
            g[2 * e] = bf2f((unsigned short)(wg[e] & 0xffff)); g[2 * e + 1] = bf2f((unsigned short)(wg[e] >> 16));
        }
        float s = 0.f;
#pragma unroll
        for (int e = 0; e < 8; ++e) s += o[e] * o[e];
        s += __shfl_xor(s, 1); s += __shfl_xor(s, 2); s += __shfl_xor(s, 4); s += __shfl_xor(s, 8);
        const float rstd = 1.0f / sqrtf(s * (1.0f / HD) + EPS);
        float y[8];
#pragma unroll
        for (int e = 0; e < 8; ++e) y[e] = o[e] * rstd * gnw[c8 + e] * silu_f(g[e]);
        v4u w; w.x = pk2(y[0], y[1]); w.y = pk2(y[2], y[3]); w.z = pk2(y[4], y[5]); w.w = pk2(y[6], y[7]);
        *(v4u*)(XA + (size_t)tok * D + c8) = w;
    }
    LAS unsigned short* t = (LAS unsigned short*)(F.lds + F.wave * 16384);
    const int ntt = ntok / 64;
    for (int it = gw; it < 8 * ntt; it += NGW) {
        const int ct = it / ntt, tt = it % ntt, c0 = ct * 64, t0 = tt * 64;
        const bf16* OBT = (const bf16*)(ws + WS_OBT);
#pragma unroll
        for (int i = 0; i < 8; ++i) {
            const int e = F.lane + 64 * i, c = e >> 3, ch = e & 7;
            const v4u w = *(const v4u*)(OBT + (size_t)(c0 + c) * MTOK + t0 + 8 * ch);
#pragma unroll
            for (int q = 0; q < 4; ++q) { t[c * 66 + 8 * ch + 2 * q] = (unsigned short)(w[q] & 0xffff); t[c * 66 + 8 * ch + 2 * q + 1] = (unsigned short)(w[q] >> 16); }
        }
        asm volatile("s_waitcnt lgkmcnt(0)" ::: "memory");
#pragma unroll
        for (int i = 0; i < 8; ++i) {
            const int e = F.lane + 64 * i, tk = e >> 3, cg = e & 7;
            unsigned short h[8];
#pragma unroll
            for (int q = 0; q < 8; ++q) h[q] = t[(8 * cg + q) * 66 + tk];
            v4u w; w.x = h[0] | ((unsigned)h[1] << 16); w.y = h[2] | ((unsigned)h[3] << 16); w.z = h[4] | ((unsigned)h[5] << 16); w.w = h[6] | ((unsigned)h[7] << 16);
            *(v4u*)(XA + (size_t)(t0 + tk) * D + 512 + c0 + 8 * cg) = w;
        }
        asm volatile("s_waitcnt lgkmcnt(0)" ::: "memory");
    }
}

__device__ __forceinline__ void phase_final_norm(const Args& a, Frame& F) {
    const float* w = a.in[22];
    const int gw = F.vcu * NWAVES + F.wave, NGW = F.G * NWAVES;
    for (int tok = gw; tok < MLAT; tok += NGW) {
        float* xr = a.out + (size_t)tok * D;
        f32x4 v[4]; float s = 0.f;
#pragma unroll
        for (int j = 0; j < 4; ++j) { v[j] = *(const f32x4*)(xr + 256 * j + 4 * F.lane); s += (v[j].x * v[j].x + v[j].y * v[j].y) + (v[j].z * v[j].z + v[j].w * v[j].w); }
        const float rstd = 1.0f / sqrtf(wave_sum(s) * (1.0f / D) + EPS);
#pragma unroll
        for (int j = 0; j < 4; ++j) { const f32x4 w4 = *(const f32x4*)(w + 256 * j + 4 * F.lane); *(f32x4*)(xr + 256 * j + 4 * F.lane) = v[j] * rstd * w4; }
    }
}

enum { PH_PRO = 0, PH_NORM0 = 1, PH_IN0 = 2, PH_PRE0 = 3, PH_MIX0 = 4, PH_FIN0 = 5, PH_OUT0 = 6, PH_NORM1 = 7, PH_IN1 = 8, PH_PRE1 = 9, PH_MIX1 = 10, PH_FIN1 = 11, PH_OUT1 = 12, PH_FINAL = 13 };

__device__ __forceinline__ Frame mkframe(unsigned char* lds) {
    Frame F;
    F.lds = (LAS unsigned char*)lds;
    F.tid = threadIdx.x; F.lane = F.tid & 63; F.wave = __builtin_amdgcn_readfirstlane(F.tid >> 6);
    F.G = gridDim.x; { const int bx = blockIdx.x; F.vcu = (F.G % 8 == 0) ? (bx % 8) * (F.G / 8) + bx / 8 : bx; }
    return F;
}
template <int l> __device__ __forceinline__ void run_inproj(const Args& args, unsigned char* lds) {
    unsigned char* ws = args.ws; Frame F = mkframe(lds);
    pg8::Gemm g{(const bf16*)(ws + WS_XA), (const bf16*)(ws + WS_WIN) + (size_t)l * NIN * D, D};
    pg8::Sched S; S.init(128, 18, F.G, (int)blockIdx.x, 8, l == 0 ? 18 : 8);
    EpiIn E{(bf16*)(ws + WS_PA), (bf16*)(ws + WS_PB), (const float*)(ws + WS_LBS) + l * 1024};
    pg8::gemm_phase<EpiIn, true, true>(F.lds, g, S, E);
}
template <int l> __device__ __forceinline__ void run_outproj(const Args& args, unsigned char* lds) {
    unsigned char* ws = args.ws; Frame F = mkframe(lds);
    pg8::Gemm g{(const bf16*)(ws + WS_XA), (const bf16*)(ws + WS_WOUT) + (size_t)l * D * D, D};
    pg8::Sched S; S.init(128, 4, F.G, (int)blockIdx.x, l == 0 ? 8 : 0, 4);
    EpiOut E{l == 0 ? args.in[0] : args.out, args.out, args.in[2], (float*)(ws + WS_CTX1), (const float*)(ws + WS_MOD) + (size_t)l * 9 * 3 * D};
    pg8::gemm_phase<EpiOut, true, true>(F.lds, g, S, E);
}
__global__ void __launch_bounds__(NTHR, 2) mega(Args args) {
    extern __shared__ __attribute__((aligned(16))) unsigned char lds[];
    const int lo = args.ph_lo, hi = args.ph_hi;
#define IN(k) (lo <= (k) && (k) < hi)
    volatile LAS unsigned* bst = (volatile LAS unsigned*)((LAS unsigned char*)lds + LDS_BYTES - 32);
    if (threadIdx.x < 8) ((volatile LAS unsigned*)((LAS unsigned char*)lds + LDS_BYTES - 32))[threadIdx.x] = 0u;
    __syncthreads();
    XcdBarrier bar; bar.bar = (unsigned*)(args.ws + WS_CTL) + CW_BAR; bar.x = 0; bar.st = bst;
    if (hi - lo > 1) bar = xcd_barrier_post((unsigned*)(args.ws + WS_CTL) + CW_BAR, bst);
#ifdef PROBE_ID
    volatile LAS unsigned long long* pts = (volatile LAS unsigned long long*)((LAS unsigned char*)lds + LDS_BYTES - 512);
    if (threadIdx.x == 0) pts[0] = __builtin_amdgcn_s_memrealtime();
#define SEAM(k) do { if (IN((k) + 1)) xcd_barrier(bar); else __syncthreads(); if (threadIdx.x == 0) pts[(k) + 1] = __builtin_amdgcn_s_memrealtime(); } while (0)
#else
#define SEAM(k) do { if (IN((k) + 1)) xcd_barrier(bar); else __syncthreads(); } while (0)
#endif
    if (IN(PH_PRO)) { Frame F = mkframe(lds); phase_prologue(args, F); SEAM(PH_PRO); }
    if (IN(PH_NORM0)) { Frame F = mkframe(lds); phase_normrows(args, F, 0, args.in[0], args.in[2]); SEAM(PH_NORM0); }
    if (IN(PH_IN0)) { run_inproj<0>(args, lds); SEAM(PH_IN0); }
    if (IN(PH_PRE0)) { Frame F = mkframe(lds); phase_prepass(args, F); SEAM(PH_PRE0); }
#ifdef SPLIT_MIX
    if (IN(PH_MIX0)) { Frame F = mkframe(lds); phase_mix(args, F, 0, 0); xcd_barrier(bar); if (threadIdx.x == 0) pts[15] = __builtin_amdgcn_s_memrealtime(); phase_mix(args, F, 0, 1); SEAM(PH_MIX0); }
#else
    if (IN(PH_MIX0)) { Frame F = mkframe(lds); phase_mix(args, F, 0); SEAM(PH_MIX0); }
#endif
    if (IN(PH_FIN0)) { Frame F = mkframe(lds); phase_finalize_ox(args, F, 0); SEAM(PH_FIN0); }
    if (IN(PH_OUT0)) { run_outproj<0>(args, lds); { Frame F = mkframe(lds); phase_filters_l1(args, F); } SEAM(PH_OUT0); }
    if (IN(PH_NORM1)) { Frame F = mkframe(lds); phase_normrows(args, F, 1, args.out, (const float*)(args.ws + WS_CTX1)); SEAM(PH_NORM1); }
    if (IN(PH_IN1)) { run_inproj<1>(args, lds); SEAM(PH_IN1); }
    if (IN(PH_PRE1)) { Frame F = mkframe(lds); phase_prepass(args, F); SEAM(PH_PRE1); }
    if (IN(PH_MIX1)) { Frame F = mkframe(lds); phase_mix(args, F, 1); SEAM(PH_MIX1); }
    if (IN(PH_FIN1)) { Frame F = mkframe(lds); phase_finalize_ox(args, F, 1); SEAM(PH_FIN1); }
    if (IN(PH_OUT1)) { run_outproj<1>(args, lds); SEAM(PH_OUT1); }
    if (IN(PH_FINAL)) { Frame F = mkframe(lds); phase_final_norm(args, F); SEAM(PH_FINAL); }
#ifdef PROBE_ID
    if (blockIdx.x == 0 && threadIdx.x == 0) {
#ifdef SPLIT_MIX
        const unsigned long long dt = (PROBE_ID == 100) ? pts[15] - pts[PH_MIX0] : pts[PH_MIX0 + 1] - pts[15];
#else
        const unsigned long long dt = (PROBE_ID >= 200) ? ((PROBE_ID == 220 || PROBE_ID >= 226) ? 1ull : 16ull) * (pts[PROBE_ID - 200 + 1] - pts[PROBE_ID - 200]) : pts[PROBE_ID + 1] - pts[PROBE_ID];
#endif
        const unsigned long long t0 = __builtin_amdgcn_s_memrealtime();
        unsigned long long wt = 4ull * dt; if (wt > 300000ull) wt = 300000ull;
        while (__builtin_amdgcn_s_memrealtime() - t0 < wt) __builtin_amdgcn_s_sleep(8);
    }
#endif
#undef IN
#undef SEAM
}

extern "C" void kernel_launch(void* const* d_in, const int* in_sizes, int n_in, void* d_out, int out_size, void* d_ws, size_t ws_size, hipStream_t stream) {
    static int grid = 0;
    if (grid == 0) {
        if (n_in != 23 || ws_size < WS_END) { fprintf(stderr, "kernel_launch: unexpected n_in %d / ws_size %zu\n", n_in, ws_size); grid = -1; return; }
        int dev = 0, cus = 0;
        if (hipGetDevice(&dev) != hipSuccess || hipDeviceGetAttribute(&cus, hipDeviceAttributeMultiprocessorCount, dev) != hipSuccess) { grid = -1; return; }
        if (hipFuncSetAttribute((const void*)mega, hipFuncAttributeMaxDynamicSharedMemorySize, LDS_BYTES) != hipSuccess) { fprintf(stderr, "kernel_launch: hipFuncSetAttribute failed\n"); grid = -1; return; }
        grid = cus;
    }
    if (grid < 0) return;
    (void)hipMemsetAsync((char*)d_ws + WS_CTL, 0, CTL_ZERO_BYTES, stream);
    Args a{};
    for (int i = 0; i < 23; ++i) a.in[i] = (const float*)d_in[i];
    a.out = (float*)d_out; a.ws = (unsigned char*)d_ws;
    a.ph_lo = 0; a.ph_hi = PH_FINAL + 1;
    hipLaunchKernelGGL(mega, dim3(grid), dim3(NTHR), LDS_BYTES, stream, a);
}
```

```cpp
#include <hip/hip_runtime.h>
#include <cstdio>
#include <cstdint>
#include <math.h>

namespace pg8 {
#define PG8_LAS __attribute__((address_space(3)))
typedef unsigned short bf16_t;
typedef short bf16x8 __attribute__((ext_vector_type(8)));
typedef float f32x4 __attribute__((ext_vector_type(4)));
typedef unsigned u32x4 __attribute__((ext_vector_type(4)));
typedef unsigned u32x2 __attribute__((ext_vector_type(2)));
constexpr int BM = 256, BK = 64, HALF = 128, HTB = HALF * BK * 2, STAGE_BYTES = 8 * HTB, NXCD = 8, WGM = 8;

__host__ __device__ __forceinline__ int lds_byte(int r, int c) { const int st = (r >> 4) * 2 + (c >> 5), rr = r & 15, cc = c & 31, ob = rr * 64 + cc * 2; return st * 1024 + (ob ^ (((ob >> 9) & 1) << 5)); }
__host__ __device__ __forceinline__ void stage_rc(int b, int& R, int& C) { const int st = b / 1024, sb = b % 1024, swz = sb ^ (((sb >> 9) & 1) << 5); R = (st >> 1) * 16 + swz / 64; C = (st & 1) * 32 + (swz % 64) / 2; }
__host__ __device__ __forceinline__ int perm32(int rho) { const int n = rho >> 4, i = rho & 15; return 8 * (i >> 2) + 4 * n + (i & 3); }

struct Unit { int pm, pn; };
struct Gemm { const bf16_t* A; const bf16_t* Bt; int K; };

struct Sched {
    int nM, nN, nwg, G, c, nctx, nctxN;
    __device__ void init(int nM_, int nN_, int G_, int c_, int nctxM, int nctxN_) { nM = nM_; nN = nN_; nwg = nM * nN; G = G_; c = c_; nctx = nctxM * nctxN_; nctxN = nctxN_ > 0 ? nctxN_ : 1; }
    __device__ bool next(int i, Unit& u) const {
        const long L = (long)i * G + c;
        if (L >= nwg) { const long L2 = L - nwg; if (L2 >= nctx) return false; u.pm = nM + (int)(L2 / nctxN); u.pn = (int)(L2 % nctxN); return true; }
        int wgid = (int)L; { const int q = nwg / NXCD, r = nwg % NXCD, xcd = wgid % NXCD, off = wgid / NXCD; wgid = (xcd < r ? xcd * (q + 1) : r * (q + 1) + (xcd - r) * q) + off; }
        const int nig = WGM * nN, gid = wgid / nig, fm = gid * WGM, gsz = (nM - fm) < WGM ? (nM - fm) : WGM;
        u.pm = fm + ((wgid % nig) % gsz); u.pn = (wgid % nig) / gsz; return true;
    }
};

template <class Epi, bool ALIGN_EPI, bool SP2>
__device__ __forceinline__ void gemm_phase(PG8_LAS unsigned char* lds, const Gemm g, const Sched& S, const Epi& E) {
    const int tid = threadIdx.x, wid = __builtin_amdgcn_readfirstlane(tid >> 6), lane = tid & 63, wr = wid >> 2, wc = wid & 3, fr = lane & 15, fq = lane >> 4;
    const int K = g.K, nt = K / BK;
    unsigned voffA[2], voffB[2];
#pragma unroll
    for (int i = 0; i < 2; ++i) { int R, C; stage_rc(tid * 16 + i * 8192, R, C); const int Rb = Epi::PERM ? ((R & ~31) + perm32(R & 31)) : R;
        voffA[i] = (unsigned)(R * K + C) * 2u; voffB[i] = (unsigned)(Rb * K + C) * 2u; }
    const size_t kstep = (size_t)(BK * 2);
    const size_t hstep = (size_t)HALF * K * 2;
    const size_t tstep = 2 * hstep;
    const unsigned ldsw = (unsigned)wid * 1024u;
    const int aoff = lds_byte(wr * 64 + fr, fq * 8), boff = lds_byte(wc * 32 + fr, fq * 8);
#define PG8_SA(b, h) (((b) * 2 + (h)) * HTB)
#define PG8_SB(b, h) ((4 + (b) * 2 + (h)) * HTB)
#define PG8_STAGE(bufoff, gbase, voff) do { _Pragma("unroll") for (int _i = 0; _i < 2; ++_i) \
        __builtin_amdgcn_global_load_lds((const unsigned*)((const char*)(gbase) + (voff)[_i]), (PG8_LAS unsigned*)(lds + (bufoff) + ldsw + _i * 8192), 16, 0, 0); } while (0)
#define PG8_LDA(dst, b, h) do { _Pragma("unroll") for (int m = 0; m < 4; ++m) _Pragma("unroll") for (int k = 0; k < 2; ++k) dst[m][k] = *(const PG8_LAS bf16x8*)(lds + PG8_SA(b, h) + aoff + m * 2048 + k * 1024); } while (0)
#define PG8_LDB(dst, b, h) do { _Pragma("unroll") for (int n = 0; n < 2; ++n) _Pragma("unroll") for (int k = 0; k < 2; ++k) dst[n][k] = *(const PG8_LAS bf16x8*)(lds + PG8_SB(b, h) + boff + n * 2048 + k * 1024); } while (0)
#define PG8_MMA(ai, bj, At, Bt) do { __builtin_amdgcn_s_setprio(1); _Pragma("unroll") for (int m = 0; m < 4; ++m) _Pragma("unroll") for (int n = 0; n < 2; ++n) _Pragma("unroll") for (int k = 0; k < 2; ++k) \
        acc[ai][bj][m][n] = __builtin_amdgcn_mfma_f32_16x16x32_bf16(Bt[n][k], At[m][k], acc[ai][bj][m][n], 0, 0, 0); __builtin_amdgcn_s_setprio(0); } while (0)
#define PG8_WAIT_V(n) asm volatile("s_waitcnt vmcnt(" #n ")" ::: "memory")
#define PG8_WAIT_L(n) asm volatile("s_waitcnt lgkmcnt(" #n ")" ::: "memory")
#define PG8_BAR __builtin_amdgcn_s_barrier()
#define PG8_SCHED __builtin_amdgcn_sched_barrier(0)
    Unit cur, nxt; int ui = 0;
    if (!S.next(0, cur)) return;
    f32x4 acc[2][2][4][2];
#pragma unroll
    for (int a = 0; a < 2; ++a)
#pragma unroll
        for (int b = 0; b < 2; ++b)
#pragma unroll
            for (int m = 0; m < 4; ++m)
#pragma unroll
                for (int n = 0; n < 2; ++n) acc[a][b][m][n] = (f32x4){0.f, 0.f, 0.f, 0.f};
    bf16x8 At[4][2], B0[2][2], B1[2][2];
    const char* cA = E.swap(cur) ? (const char*)g.Bt + (size_t)cur.pn * tstep : (const char*)g.A + (size_t)cur.pm * tstep;
    const char* cB = E.swap(cur) ? (const char*)g.A + (size_t)cur.pm * tstep : (const char*)g.Bt + (size_t)cur.pn * tstep;
    if constexpr (SP2) {
        PG8_STAGE(PG8_SB(0, 0), cB, voffB); PG8_STAGE(PG8_SB(0, 1), cB + hstep, voffB); PG8_STAGE(PG8_SA(0, 0), cA, voffA); PG8_STAGE(PG8_SA(0, 1), cA + hstep, voffA);
        if (wr == 1) PG8_BAR;
        PG8_WAIT_V(2); PG8_BAR;
        PG8_STAGE(PG8_SB(1, 0), cB + kstep, voffB); PG8_STAGE(PG8_SA(1, 0), cA + kstep, voffA); PG8_STAGE(PG8_SB(1, 1), cB + hstep + kstep, voffB);
        PG8_WAIT_V(6); PG8_BAR;
    } else {
        PG8_STAGE(PG8_SB(0, 0), cB, voffB); PG8_STAGE(PG8_SA(0, 0), cA, voffA); PG8_STAGE(PG8_SB(0, 1), cB + hstep, voffB); PG8_STAGE(PG8_SA(0, 1), cA + hstep, voffA);
        if (wr == 1) PG8_BAR;
        PG8_WAIT_V(4); PG8_BAR;
        PG8_STAGE(PG8_SB(1, 0), cB + kstep, voffB); PG8_STAGE(PG8_SA(1, 0), cA + kstep, voffA); PG8_STAGE(PG8_SB(1, 1), cB + hstep + kstep, voffB);
        PG8_WAIT_V(6); PG8_BAR;
    }
    for (;;) {
        const bool has_next = S.next(ui + 1, nxt);
        const bool nsw = has_next && E.swap(nxt);
        const char* nA = has_next ? (nsw ? (const char*)g.Bt + (size_t)nxt.pn * tstep : (const char*)g.A + (size_t)nxt.pm * tstep) : cA;
        const char* nB = has_next ? (nsw ? (const char*)g.A + (size_t)nxt.pm * tstep : (const char*)g.Bt + (size_t)nxt.pn * tstep) : cB;
        for (int t = 0; t < nt; t += 2) {
            const bool last = (t == nt - 2);
            const char* a1 = cA + (size_t)(t + 1) * kstep;
            const char* a2 = last ? nA : cA + (size_t)(t + 2) * kstep; const char* b2 = last ? nB : cB + (size_t)(t + 2) * kstep;
            const char* a3 = a2 + kstep; const char* b3 = b2 + kstep;
            if constexpr (SP2) {
            PG8_LDB(B0, 0, 0); PG8_LDB(B1, 0, 1); PG8_SCHED; PG8_LDA(At, 0, 0); PG8_STAGE(PG8_SA(1, 1), a1 + hstep, voffA);
            PG8_WAIT_V(8); PG8_WAIT_L(0); PG8_BAR; PG8_MMA(0, 0, At, B0); PG8_MMA(0, 1, At, B1); PG8_BAR; PG8_SCHED;
            PG8_LDA(At, 0, 1); PG8_STAGE(PG8_SB(0, 0), b2, voffB); PG8_STAGE(PG8_SB(0, 1), b2 + hstep, voffB); PG8_STAGE(PG8_SA(0, 0), a2, voffA);
            PG8_WAIT_V(8); PG8_WAIT_L(0); PG8_BAR; PG8_MMA(1, 0, At, B0); PG8_MMA(1, 1, At, B1); PG8_BAR; PG8_SCHED;
            PG8_LDB(B0, 1, 0); PG8_LDB(B1, 1, 1); PG8_SCHED; PG8_LDA(At, 1, 0); PG8_STAGE(PG8_SA(0, 1), a2 + hstep, voffA);
            PG8_WAIT_V(8); PG8_WAIT_L(0); PG8_BAR; PG8_MMA(0, 0, At, B0); PG8_MMA(0, 1, At, B1); PG8_BAR; PG8_SCHED;
            PG8_LDA(At, 1, 1); PG8_STAGE(PG8_SB(1, 0), b3, voffB); PG8_STAGE(PG8_SB(1, 1), b3 + hstep, voffB); PG8_STAGE(PG8_SA(1, 0), a3, voffA);
            PG8_WAIT_V(8); PG8_WAIT_L(0); PG8_BAR; PG8_MMA(1, 0, At, B0); PG8_MMA(1, 1, At, B1); PG8_BAR; PG8_SCHED;
            } else {
            PG8_LDB(B0, 0, 0); PG8_SCHED; PG8_LDA(At, 0, 0); PG8_STAGE(PG8_SA(1, 1), a1 + hstep, voffA);
            PG8_WAIT_L(8); PG8_BAR; PG8_WAIT_L(0); PG8_MMA(0, 0, At, B0); PG8_BAR; PG8_SCHED;
            PG8_LDB(B1, 0, 1); PG8_STAGE(PG8_SB(0, 0), b2, voffB);
            PG8_BAR; PG8_WAIT_L(0); PG8_MMA(0, 1, At, B1); PG8_BAR;
            PG8_LDA(At, 0, 1); PG8_STAGE(PG8_SA(0, 0), a2, voffA);
            PG8_BAR; PG8_WAIT_L(0); PG8_MMA(1, 0, At, B0); PG8_BAR; PG8_SCHED;
            PG8_STAGE(PG8_SB(0, 1), b2 + hstep, voffB);
            PG8_WAIT_V(6); PG8_BAR; PG8_MMA(1, 1, At, B1); PG8_BAR;
            PG8_LDB(B0, 1, 0); PG8_SCHED; PG8_LDA(At, 1, 0); PG8_STAGE(PG8_SA(0, 1), a2 + hstep, voffA);
            PG8_WAIT_L(8); PG8_BAR; PG8_WAIT_L(0); PG8_MMA(0, 0, At, B0); PG8_BAR; PG8_SCHED;
            PG8_LDB(B1, 1, 1); PG8_STAGE(PG8_SB(1, 0), b3, voffB);
            PG8_BAR; PG8_WAIT_L(0); PG8_MMA(0, 1, At, B1); PG8_BAR;
            PG8_LDA(At, 1, 1); PG8_STAGE(PG8_SA(1, 0), a3, voffA);
            PG8_BAR; PG8_WAIT_L(0); PG8_MMA(1, 0, At, B0); PG8_BAR; PG8_SCHED;
            PG8_STAGE(PG8_SB(1, 1), b3 + hstep, voffB);
            PG8_WAIT_V(6); PG8_BAR; PG8_MMA(1, 1, At, B1); PG8_BAR;
            }
        }
        if constexpr (ALIGN_EPI) { if (wr == 0) PG8_BAR; }
        E(acc, cur, wr, wc, fr, fq);
        if (!has_next) break;
#pragma unroll
        for (int a = 0; a < 2; ++a)
#pragma unroll
            for (int b = 0; b < 2; ++b)
#pragma unroll
                for (int m = 0; m < 4; ++m)
#pragma unroll
                    for (int n = 0; n < 2; ++n) acc[a][b][m][n] = (f32x4){0.f, 0.f, 0.f, 0.f};
        cur = nxt; cA = nA; cB = nB; ++ui;
        if constexpr (ALIGN_EPI) { if (wr == 1) PG8_BAR; }
    }
    PG8_WAIT_V(0);
    if constexpr (!ALIGN_EPI) { if (wr == 0) PG8_BAR; }
    PG8_BAR;
#undef PG8_SA
#undef PG8_SB
#undef PG8_STAGE
#undef PG8_LDA
#undef PG8_LDB
#undef PG8_MMA
#undef PG8_WAIT_V
#undef PG8_WAIT_L
#undef PG8_BAR
#undef PG8_SCHED
}
}

constexpr int D = 1024, NB = 8, LX = 4096, LCX = 256, NIN = 4608, DA = 512, DB = 512, HD = 128;
constexpr int MLAT = NB * LX, MCTX = NB * LCX, MTOK = MLAT + MCTX;
constexpr int PA_LD = 3072;
constexpr int FZ = 8448, FZC = 640;
constexpr float EPS = 1e-6f;
constexpr float HY_MIN_DECAY = -3.0701134573253944f, HY_MAX_DECAY = -15.350567286626972f;
constexpr int NWAVES = 8, NTHR = 512;

constexpr size_t MiB = 1u << 20;
constexpr size_t WS_CTL = 0, CTL_ZERO_BYTES = 1 * MiB;
constexpr size_t WS_MOD = 1 * MiB;
constexpr size_t WS_LBS = WS_MOD + 256 * 1024;
constexpr size_t WS_WIN = 6 * MiB;
constexpr size_t WS_WOUT = 24 * MiB;
constexpr size_t WS_FG = 28 * MiB;
constexpr size_t WS_FGC = 45 * MiB;
constexpr size_t WS_CTX1 = 46 * MiB;
constexpr size_t WS_OC = 2 * MiB;
constexpr size_t WS_XA = 54 * MiB;
constexpr size_t WS_PA = 122 * MiB;
constexpr size_t WS_PB = 326 * MiB;
constexpr size_t WS_OBT = 462 * MiB;
constexpr size_t WS_HK = 326 * MiB;
constexpr size_t WS_SCL = 496 * MiB;
constexpr size_t WS_END = 504 * MiB;
constexpr int CW_NORM = 1024;
constexpr int CW_BAR = 8192;
constexpr int CW_QUEUE = 4096;

constexpr int LDS_BYTES = 156 * 1024;
#define LAS __attribute__((address_space(3)))
#define GAS __attribute__((address_space(1)))
typedef unsigned short bf16;
typedef unsigned v4u __attribute__((ext_vector_type(4)));
typedef unsigned v2u __attribute__((ext_vector_type(2)));
typedef float f32x4 __attribute__((ext_vector_type(4)));

typedef __bf16 bf2_t __attribute__((ext_vector_type(2)));
typedef float f2_t __attribute__((ext_vector_type(2)));
__device__ __forceinline__ unsigned pk2(float lo, float hi) { const f2_t v = {lo, hi}; return __builtin_bit_cast(unsigned, __builtin_convertvector(v, bf2_t)); }
__device__ __forceinline__ unsigned f2bf(float f) { return pk2(f, 0.f) & 0xffffu; }
__device__ __forceinline__ float bf2f(unsigned short h) { return __builtin_bit_cast(float, (unsigned)h << 16); }
__device__ __forceinline__ unsigned f2h(float f) { _Float16 h = (_Float16)f; return (unsigned)__builtin_bit_cast(unsigned short, h); }
__device__ __forceinline__ unsigned pk2h(float lo, float hi) { return f2h(lo) | (f2h(hi) << 16); }
__device__ __forceinline__ float h2f(unsigned short u) { return (float)__builtin_bit_cast(_Float16, u); }
__device__ __forceinline__ float silu_f(float x) { return x * __builtin_amdgcn_rcpf(1.0f + __expf(-x)); }
__device__ __forceinline__ float sigmoid_f(float x) { return __builtin_amdgcn_rcpf(1.0f + __expf(-x)); }
__device__ __forceinline__ float wave_sum(float v) {
#pragma unroll
    for (int o = 1; o < 64; o <<= 1) v += __shfl_xor(v, o);
    return v;
}


#define PSTAMP_(lds_, k_) do { if (threadIdx.x == 0) ((volatile LAS unsigned long long*)((lds_) + LDS_BYTES - 512))[(k_)] = __builtin_amdgcn_s_memrealtime(); } while (0)
#if defined(PROBE_ID) && PROBE_ID >= 216 && PROBE_ID < 220
#define PSTAMP_H(lds_, k_) PSTAMP_(lds_, k_)
#else
#define PSTAMP_H(lds_, k_) do { } while (0)
#endif
#if defined(PROBE_ID) && PROBE_ID >= 226 && PROBE_ID < 230
#define PSTAMP_P(lds_, k_) PSTAMP_(lds_, k_)
#else
#define PSTAMP_P(lds_, k_) do { } while (0)
#endif
#if defined(PROBE_ID) && PROBE_ID >= 220 && PROBE_ID < 226
#define PSTAMP_S(lds_, k_) PSTAMP_(lds_, k_)
#else
#define PSTAMP_S(lds_, k_) do { } while (0)
#endif
typedef GAS unsigned gu32;
#define XB_TMO      128
#define XB_XCNT(j)  (256  + 64 * (j))
#define XB_XSUB(j)  (1280 + 64 * (j))
#define XB_XGEN(j)  (2304 + 64 * (j))
#define XB_TOP      3328
#define XB_TOPGEN   3392
#define XCD_BAR_WORDS 3456
#define XB_SPIN_CAP (1u << 18)
__device__ __forceinline__ unsigned xb_ld(unsigned* p)              { return __hip_atomic_load(p, __ATOMIC_RELAXED, __HIP_MEMORY_SCOPE_AGENT); }
__device__ __forceinline__ unsigned xb_add(unsigned* p, unsigned v) { return __hip_atomic_fetch_add(p, v, __ATOMIC_RELAXED, __HIP_MEMORY_SCOPE_AGENT); }
__device__ __forceinline__ unsigned xb_xcc_id() { return (unsigned)__builtin_amdgcn_s_getreg((3 << 11) | 20) & 0xFu; }
#define XB_SPIN(cond, bar) do { unsigned _sp = 0; while (cond) { __builtin_amdgcn_s_sleep(1); \
    if ((++_sp & 255u) == 0u) { if (xb_ld(&(bar)[XB_TMO])) break; if (_sp > XB_SPIN_CAP) { atomicAdd(&(bar)[XB_TMO], 1u); break; } } } } while (0)
struct XcdBarrier { unsigned* bar; unsigned x; volatile LAS unsigned* st; };
__device__ __forceinline__ XcdBarrier xcd_barrier_post(unsigned* bar, volatile LAS unsigned* st) {
    XcdBarrier b; b.bar = bar; b.x = xb_xcc_id(); b.st = st;
    if (threadIdx.x == 0) (void)xb_add(&bar[XB_XCNT(b.x)], 1u);
    return b;
}
__device__ __forceinline__ void xcd_barrier_complete(unsigned* bar, unsigned x, unsigned& nloc, unsigned& nx) {
    const unsigned G = gridDim.x * gridDim.y * gridDim.z;
    unsigned sum, cnt, mine, sp = 0u;
    for (;;) {
        sum = 0u; cnt = 0u; mine = 0u;
#pragma unroll
        for (unsigned j = 0; j < 16; ++j) { const unsigned c = xb_ld(&bar[XB_XCNT(j)]); sum += c; cnt += (c > 0u) ? 1u : 0u; mine = (j == x) ? c : mine; }
        if (sum == G) break;
        __builtin_amdgcn_s_sleep(1);
        if ((++sp & 255u) == 0u) { if (xb_ld(&bar[XB_TMO])) break; if (sp > XB_SPIN_CAP) { atomicAdd(&bar[XB_TMO], 1u); break; } }
    }
    nloc = mine > 0u ? mine : 1u; nx = cnt > 0u ? cnt : 1u;
}
__device__ __forceinline__ void xcd_barrier(const XcdBarrier& b) {
    asm volatile("s_waitcnt vmcnt(0)" ::: "memory");
    __syncthreads();
    if (threadIdx.x == 0) {
        unsigned* bar = b.bar;
        __builtin_amdgcn_s_waitcnt(0);
        unsigned nloc = b.st[0], nx = b.st[1];
        if (nloc == 0u) { xcd_barrier_complete(bar, b.x, nloc, nx); b.st[0] = nloc; b.st[1] = nx; }
        const unsigned old = xb_add(&bar[XB_XSUB(b.x)], 1u);
        const unsigned gen = old / nloc;
        if (old + 1u == (gen + 1u) * nloc) {
            __builtin_amdgcn_fence(__ATOMIC_RELEASE, "agent");
            asm volatile("s_waitcnt vmcnt(0)" ::: "memory");
            const unsigned og = xb_add(&bar[XB_TOP], 1u);
            const unsigned tg = og / nx;
            if (og + 1u == (tg + 1u) * nx) xb_add(&bar[XB_TOPGEN], 1u);
            else XB_SPIN(xb_ld(&bar[XB_TOPGEN]) == tg, bar);
            __builtin_amdgcn_fence(__ATOMIC_ACQUIRE, "agent");
            xb_add(&bar[XB_XGEN(b.x)], 1u);
            asm volatile("s_waitcnt vmcnt(0)" ::: "memory");
        } else {
            XB_SPIN(xb_ld(&bar[XB_XGEN(b.x)]) == gen, bar);
            __builtin_amdgcn_fence(__ATOMIC_ACQUIRE, "agent");
            asm volatile("s_waitcnt vmcnt(0)" ::: "memory");
        }
    }
    __syncthreads();
}

struct EpiIn {
    static constexpr bool PERM = true;
    bf16* PA; bf16* PB; const float* lb;
    __device__ __forceinline__ bool swap(const pg8::Unit& u) const { return u.pn >= 10; }
    __device__ __forceinline__ void operator()(const f32x4 (&acc)[2][2][4][2], const pg8::Unit& u, int wr, int wc, int fr, int fq) const {
        if (u.pn < 10) {
            const int type = u.pn >> 1;
            const int row0 = u.pm * 256 + wr * 64 + fr, col0 = u.pn * 256 + wc * 32 + 8 * fq;
#pragma unroll
            for (int bj = 0; bj < 2; ++bj) {
                float lbv[8];
#pragma unroll
                for (int e = 0; e < 8; ++e) lbv[e] = (type == 1 || type == 2) ? lb[col0 + bj * 128 + e - 512] : 0.f;
#pragma unroll
                for (int ai = 0; ai < 2; ++ai)
#pragma unroll
                    for (int m = 0; m < 4; ++m) {
                        bf16* rowp = PA + (size_t)(row0 + ai * 128 + m * 16) * PA_LD + col0 + bj * 128;
                        float x[8];
#pragma unroll
                        for (int e = 0; e < 4; ++e) { x[e] = acc[ai][bj][m][0][e]; x[4 + e] = acc[ai][bj][m][1][e]; }
                        v4u w;
                        if (type == 0) {
#pragma unroll
                            for (int e = 0; e < 8; ++e) x[e] = silu_f(x[e]);
                            w.x = pk2(x[0], x[1]); w.y = pk2(x[2], x[3]); w.z = pk2(x[4], x[5]); w.w = pk2(x[6], x[7]);
                        } else if (type == 1 || type == 2) {
#pragma unroll
                            for (int e = 0; e < 8; ++e) x[e] = lbv[e] + (1.0f - lbv[e]) * sigmoid_f(x[e]);
                            w.x = pk2h(x[0], x[1]); w.y = pk2h(x[2], x[3]); w.z = pk2h(x[4], x[5]); w.w = pk2h(x[6], x[7]);
                        } else {
                            w.x = pk2(x[0], x[1]); w.y = pk2(x[2], x[3]); w.z = pk2(x[4], x[5]); w.w = pk2(x[6], x[7]);
                        }
                        *(v4u*)rowp = w;
                        asm volatile("" ::: "memory");
                    }
            }
        } else {
#pragma unroll
            for (int ai = 0; ai < 2; ++ai)
#pragma unroll
                for (int m = 0; m < 4; ++m) {
                    const int cw = u.pn * 256 + ai * 128 + wr * 64 + m * 16 + fr;
                    bf16* colp = PB + (size_t)(cw - 2560) * MTOK + u.pm * 256 + wc * 32 + 8 * fq;
#pragma unroll
                    for (int bj = 0; bj < 2; ++bj) {
                        const f32x4 v0 = acc[ai][bj][m][0], v1 = acc[ai][bj][m][1];
                        v4u w; w.x = pk2(v0[0], v0[1]); w.y = pk2(v0[2], v0[3]); w.z = pk2(v1[0], v1[1]); w.w = pk2(v1[2], v1[3]);
                        *(v4u*)(colp + bj * 128) = w;
                    }
                }
        }
    }
};
struct EpiOut {
    static constexpr bool PERM = true;
    bf16* DL; const float* mod;
    __device__ __forceinline__ bool swap(const pg8::Unit&) const { return false; }
    __device__ __forceinline__ void operator()(const f32x4 (&acc)[2][2][4][2], const pg8::Unit& u, int wr, int wc, int fr, int fq) const {
        const int mr = u.pm >= 128 ? 8 : (u.pm >> 4);
        const int col0 = u.pn * 256 + wc * 32 + 8 * fq;
        f32x4 g0[2], g1[2];
#pragma unroll
        for (int bj = 0; bj < 2; ++bj) { const float* gt = mod + (size_t)mr * 3 * D + 2 * D + col0 + bj * 128; g0[bj] = *(const f32x4*)gt; g1[bj] = *(const f32x4*)(gt + 4); }
#pragma unroll
        for (int ai = 0; ai < 2; ++ai)
#pragma unroll
            for (int m = 0; m < 4; ++m) {
                bf16* rowp = DL + (size_t)(u.pm * 256 + ai * 128 + wr * 64 + m * 16 + fr) * D + col0;
#pragma unroll
                for (int bj = 0; bj < 2; ++bj) {
                    const f32x4 v0 = acc[ai][bj][m][0] * g0[bj], v1 = acc[ai][bj][m][1] * g1[bj];
                    v4u w; w.x = pk2(v0[0], v0[1]); w.y = pk2(v0[2], v0[3]); w.z = pk2(v1[0], v1[1]); w.w = pk2(v1[2], v1[3]);
                    *(v4u*)(rowp + bj * 128) = w;
                }
            }
    }
};

struct Args {
    const float* in[23]; float* out; unsigned char* ws; int ph_lo, ph_hi;
};

struct Frame {
    LAS unsigned char* lds; int tid, lane, wave, vcu, G;
};

__device__ __forceinline__ void p0_transpose_item(const float* W, int K, int N, bf16* WT, LAS float* scr, int item, int lane) {
    const int nblk = N / 32, kb = item / nblk, nb = item % nblk, k0 = 64 * kb, n0 = 32 * nb;
#pragma unroll 8
    for (int i = 0; i < 32; ++i) { const int kk = 2 * i + (lane >> 5); scr[kk * 33 + (lane & 31)] = W[(size_t)(k0 + kk) * N + n0 + (lane & 31)]; }
    asm volatile("s_waitcnt lgkmcnt(0)" ::: "memory");
    const int c = lane & 7;
#pragma unroll
    for (int j = 0; j < 4; ++j) { const int n = (lane >> 3) + 8 * j; const LAS float* s = scr + (8 * c) * 33 + n;
        v4u o; o.x = pk2(s[0 * 33], s[1 * 33]); o.y = pk2(s[2 * 33], s[3 * 33]); o.z = pk2(s[4 * 33], s[5 * 33]); o.w = pk2(s[6 * 33], s[7 * 33]);
        *(v4u*)(WT + (size_t)(n0 + n) * K + k0 + 8 * c) = o; }
    asm volatile("s_waitcnt lgkmcnt(0)" ::: "memory");
}

__device__ __forceinline__ void filter_task(const Args& a, Frame& F, const int set, const int n0, int& cached_layer) {
    unsigned char* ws = a.ws;
    const int l = set == 1 ? 1 : 0, L = set == 2 ? 256 : 4096;
    LAS float* w1s = (LAS float*)F.lds;
    LAS float* w2s = w1s + 33 * 64;
    LAS float* w3s = w2s + 64 * 64;
    LAS float* bs = w3s + 64 * 64;
    LAS float* zs = bs + 256;
    LAS float* h3s = zs + 8 * 4 * 64;
    LAS unsigned short* tile = (LAS unsigned short*)(h3s + 32 * 64);
    if (cached_layer != l) {
        __syncthreads();
        for (int e = F.tid; e < 33 * 64; e += NTHR) w1s[e] = a.in[13][l * 33 * 64 + e];
        for (int e = F.tid; e < 4096; e += NTHR) { w2s[e] = a.in[16][l * 4096 + e]; w3s[e] = a.in[18][l * 4096 + e]; }
        if (F.tid < 64) { bs[F.tid] = a.in[14][l * 64 + F.tid]; bs[64 + F.tid] = a.in[17][l * 64 + F.tid]; bs[128 + F.tid] = a.in[19][l * 64 + F.tid]; bs[192 + F.tid] = a.in[15][l * 64 + F.tid]; }
        cached_layer = l;
        __syncthreads();
    }
    {
        const int j = F.lane; LAS float* zw = zs + F.wave * 256; const float fr = bs[192 + j];
#pragma unroll
        for (int p = 0; p < 4; ++p) {
            const int n = n0 + 4 * F.wave + p;
            float zv = 0.f;
            if (j == 0) zv = (float)n / (float)(L - 1);
            else if (j < 33) { const int i = (j - 1) & 15; const double f = 1e-4 + (double)i * ((15.0 - 1e-4) / 15.0); double rev = f * (double)n / (double)L; rev -= floor(rev);
                const float ang = (float)(rev * 6.283185307179586476925); zv = (j <= 16) ? __cosf(ang) : -__sinf(ang); }
            zw[p * 64 + j] = zv;
        }
        asm volatile("s_waitcnt lgkmcnt(0)" ::: "memory");
        float s4[4];
#pragma unroll
        for (int p = 0; p < 4; ++p) s4[p] = bs[j];
        for (int e = 0; e < 33; ++e) { const float wv = w1s[e * 64 + j];
#pragma unroll
            for (int p = 0; p < 4; ++p) s4[p] += zw[p * 64 + e] * wv; }
        asm volatile("s_waitcnt lgkmcnt(0)" ::: "memory");
#pragma unroll
        for (int p = 0; p < 4; ++p) zw[p * 64 + j] = __sinf(fr * s4[p]);
        asm volatile("s_waitcnt lgkmcnt(0)" ::: "memory");
#pragma unroll
        for (int p = 0; p < 4; ++p) s4[p] = bs[64 + j];
        for (int e = 0; e < 64; ++e) { const float wv = w2s[e * 64 + j];
#pragma unroll
            for (int p = 0; p < 4; ++p) s4[p] += zw[p * 64 + e] * wv; }
        asm volatile("s_waitcnt lgkmcnt(0)" ::: "memory");
#pragma unroll
        for (int p = 0; p < 4; ++p) zw[p * 64 + j] = __sinf(fr * s4[p]);
        asm volatile("s_waitcnt lgkmcnt(0)" ::: "memory");
#pragma unroll
        for (int p = 0; p < 4; ++p) s4[p] = bs[128 + j];
        for (int e = 0; e < 64; ++e) { const float wv = w3s[e * 64 + j];
#pragma unroll
            for (int p = 0; p < 4; ++p) s4[p] += zw[p * 64 + e] * wv; }
#pragma unroll
        for (int p = 0; p < 4; ++p) h3s[(4 * F.wave + p) * 64 + j] = __sinf(fr * s4[p]);
    }
    __syncthreads();
    {
        typedef short bf16x8_ __attribute__((ext_vector_type(8)));
        LAS unsigned char* hA = (LAS unsigned char*)(tile + 1024 * 34);
        LAS unsigned char* wB = hA + 32 * 144;
        const int l15 = F.lane & 15, q = F.lane >> 4;
        { const int p = F.tid >> 4, k4 = (F.tid & 15) * 4; const f32x4 hv = *(const LAS f32x4*)(h3s + p * 64 + k4);
          v2u hw; hw.x = pk2(hv[0], hv[1]); hw.y = pk2(hv[2], hv[3]); *(LAS v2u*)(hA + p * 144 + 2 * k4) = hw; }
        float* nrm = (float*)(ws + WS_CTL) + CW_NORM;
        const float* w4 = a.in[20] + (size_t)l * 64 * 1024;
        for (int ch = 0; ch < 8; ++ch) {
            __syncthreads();
            { const int n = F.tid & 127, kq = F.tid >> 7;
              float wv[2][8];
#pragma unroll
              for (int g2 = 0; g2 < 2; ++g2)
#pragma unroll
                  for (int e = 0; e < 8; ++e) wv[g2][e] = w4[(size_t)(16 * kq + 8 * g2 + e) * 1024 + 128 * ch + n];
#pragma unroll
              for (int g2 = 0; g2 < 2; ++g2) { v4u o; o.x = pk2(wv[g2][0], wv[g2][1]); o.y = pk2(wv[g2][2], wv[g2][3]); o.z = pk2(wv[g2][4], wv[g2][5]); o.w = pk2(wv[g2][6], wv[g2][7]);
                  *(LAS v4u*)(wB + n * 144 + (16 * kq + 8 * g2) * 2) = o; } }
            __syncthreads();
            {
                const int col = 128 * ch + 16 * F.wave + l15, c = col & 511;
                f32x4 acc[2];
#pragma unroll
                for (int mt = 0; mt < 2; ++mt) { acc[mt] = (f32x4){0.f, 0.f, 0.f, 0.f};
#pragma unroll
                    for (int ks = 0; ks < 2; ++ks)
                        acc[mt] = __builtin_amdgcn_mfma_f32_16x16x32_bf16(*(const LAS bf16x8_*)(hA + (16 * mt + l15) * 144 + (32 * ks + 8 * q) * 2), *(const LAS bf16x8_*)(wB + (16 * F.wave + l15) * 144 + (32 * ks + 8 * q) * 2), acc[mt], 0, 0, 0); }
                const float dl = fabsf(HY_MIN_DECAY + (float)c * ((HY_MAX_DECAY - HY_MIN_DECAY) / 511.0f));
                float ns = 0.f;
#pragma unroll
                for (int mt = 0; mt < 2; ++mt) {
                    float v4[4];
#pragma unroll
                    for (int r = 0; r < 4; ++r) { const int nn = n0 + 16 * mt + 4 * q + r; v4[r] = acc[mt][r] * __expf(-((float)nn / (float)(L - 1)) * dl); if (col < 512 || nn >= 1) ns += fabsf(v4[r]); }
                    *(LAS unsigned*)(tile + col * 34 + 16 * mt + 4 * q) = pk2(v4[0], v4[1]); *(LAS unsigned*)(tile + col * 34 + 16 * mt + 4 * q + 2) = pk2(v4[2], v4[3]);
                }
                ns += __shfl_xor(ns, 16); ns += __shfl_xor(ns, 32);
                if (q == 0) atomicAdd(&nrm[set * 512 + c], ns);
            }
        }
    }
    __syncthreads();
    {
        bf16* dst = set == 2 ? (bf16*)(ws + WS_FGC) : (bf16*)(ws + WS_FG) + (size_t)set * 512 * FZ;
        const int ld = set == 2 ? FZC : FZ;
        for (int e = F.tid; e < 1024 * 32; e += NTHR) {
            const int col = e >> 5, p = e & 31, c = col & 511, n = n0 + p;
            const unsigned short v = tile[col * 34 + p];
            if (col < 512) dst[(size_t)c * ld + (L - n)] = v;
            else if (n >= 1) dst[(size_t)c * ld + (L + n)] = v;
        }
        if (n0 == 0) {
            const int npad = ld - 2 * L;
            for (int e = F.tid; e < 512 * (npad + 1); e += NTHR) { const int c = e / (npad + 1), k = e % (npad + 1); dst[(size_t)c * ld + (k == 0 ? 0 : 2 * L + k - 1)] = 0; }
        }
    }
    __syncthreads();
}

__device__ __forceinline__ void phase_prologue(const Args& a, Frame& F) {
    unsigned char* ws = a.ws;
    if (F.vcu == 0) {
        float* lbs = (float*)(ws + WS_LBS);
        for (int i = F.tid; i < 1024; i += NTHR) {
            const float a0 = a.in[9][i], a1 = a.in[9][1024 + i];
            const float m = fmaxf(a0, a1), e0 = expf(a0 - m), e1 = expf(a1 - m);
            const float p0 = e0 / (e0 + e1), p1 = e1 / (e0 + e1);
            const float c0 = p0, c1 = p0 + p1;
            lbs[i] = c0 - c0; lbs[1024 + i] = c1 - c0;
        }
    }
    int cached_layer = -1;
    constexpr int I_IN = (D / 64) * (NIN / 32), I_OUT = (D / 64) * (D / 32), NTR = 2 * (I_IN + I_OUT) / 8;
    for (int t = F.vcu; t < NTR; t += F.G) {
        LAS float* scr = (LAS float*)(F.lds + 65536 + F.wave * 8704);
        int r = t * 8 + F.wave; const int l = r / (I_IN + I_OUT); r -= l * (I_IN + I_OUT);
        if (r < I_IN) p0_transpose_item(a.in[7] + (size_t)l * D * NIN, D, NIN, (bf16*)(ws + WS_WIN) + (size_t)l * NIN * D, scr, r, F.lane);
        else p0_transpose_item(a.in[8] + (size_t)l * D * D, D, D, (bf16*)(ws + WS_WOUT) + (size_t)l * D * D, scr, r - I_IN, F.lane);
    }
    __syncthreads();
    if (F.vcu >= 136 && F.vcu < 232) {
        const int task = F.vcu - 136;
        LAS float* sv = (LAS float*)(F.lds + 65536);
        LAS float* part = sv + 9 * 1024;
        const int l = task / 48, n0 = (task % 48) * 64;
        for (int e = F.tid; e < 9 * 1024; e += NTHR) { const int r = e >> 10, k = e & 1023; const float cv = r < 8 ? a.in[1][r * D + k] : a.in[3][k]; sv[e] = cv / (1.0f + expf(-cv)); }
        __syncthreads();
        float acc9[9];
#pragma unroll
        for (int r = 0; r < 9; ++r) acc9[r] = 0.f;
        const float* w = a.in[5] + (size_t)l * D * 3 * D + n0 + F.lane;
#pragma unroll 8
        for (int k = F.wave * 128; k < F.wave * 128 + 128; ++k) {
            const float wv = w[(size_t)k * 3 * D];
#pragma unroll
            for (int r = 0; r < 9; ++r) acc9[r] += sv[r * 1024 + k] * wv;
        }
#pragma unroll
        for (int r = 0; r < 9; ++r) part[(F.wave * 9 + r) * 64 + F.lane] = acc9[r];
        __syncthreads();
        for (int e = F.tid; e < 9 * 64; e += NTHR) {
            const int r = e >> 6, c = e & 63; float sum = 0.f;
#pragma unroll
            for (int w8 = 0; w8 < 8; ++w8) sum += part[(w8 * 9 + r) * 64 + c];
            ((float*)(ws + WS_MOD))[((size_t)l * 9 + r) * 3 * D + n0 + c] = sum + a.in[6][l * 3 * D + n0 + c];
        }
        __syncthreads();
    }
    if (F.vcu < 16) filter_task(a, F, 0, 32 * (112 + F.vcu), cached_layer);
    else if (F.vcu >= 128 && F.vcu < 136) filter_task(a, F, 2, 32 * (F.vcu - 128), cached_layer);
}
__device__ __forceinline__ void phase_filters_l0(const Args& a, Frame& F) {
    int cached_layer = -1; const int b = (int)blockIdx.x;
    if (b >= 144) filter_task(a, F, 0, 32 * (b - 144), cached_layer);
}
__device__ __forceinline__ void phase_filters_l1(const Args& a, Frame& F) {
    int cached_layer = -1; const int b = (int)blockIdx.x;
    if (b >= 32 && b < 160) filter_task(a, F, 1, 32 * (b - 32), cached_layer);
}

__device__ __forceinline__ void phase_normrows(const Args& a, Frame& F, int l, const float* xlat, const float* xctx) {
    unsigned char* ws = a.ws;
    const float* nw = a.in[4] + l * D;
    const float* mod = (const float*)(ws + WS_MOD) + (size_t)l * 9 * 3 * D;
    bf16* XA = (bf16*)(ws + WS_XA);
    const bf16* DL = (const bf16*)(ws + WS_PB);
    const int gw = F.vcu * NWAVES + F.wave, NGW = F.G * NWAVES;
    for (int tok = gw; tok < MTOK; tok += NGW) {
        const bool isctx = tok >= MLAT;
        const float* xr = isctx ? xctx + (size_t)(tok - MLAT) * D : xlat + (size_t)tok * D;
        const int mr = isctx ? 8 : (tok >> 12);
        const float* sh = mod + (size_t)mr * 3 * D; const float* sc = sh + D;
        f32x4 v[4]; float s = 0.f;
#pragma unroll
        for (int j = 0; j < 4; ++j) v[j] = *(const f32x4*)(xr + 256 * j + 4 * F.lane);
        if (l == 1) {
#pragma unroll
            for (int j = 0; j < 4; ++j) { const v2u dw = *(const v2u*)(DL + (size_t)tok * D + 256 * j + 4 * F.lane);
                v[j].x += bf2f((unsigned short)(dw.x & 0xffffu)); v[j].y += bf2f((unsigned short)(dw.x >> 16)); v[j].z += bf2f((unsigned short)(dw.y & 0xffffu)); v[j].w += bf2f((unsigned short)(dw.y >> 16)); }
            if (!isctx) {
#pragma unroll
                for (int j = 0; j < 4; ++j) *(f32x4*)(a.out + (size_t)tok * D + 256 * j + 4 * F.lane) = v[j];
            }
        }
#pragma unroll
        for (int j = 0; j < 4; ++j) s += (v[j].x * v[j].x + v[j].y * v[j].y) + (v[j].z * v[j].z + v[j].w * v[j].w);
        const float rstd = 1.0f / sqrtf(wave_sum(s) * (1.0f / D) + EPS);
#pragma unroll
        for (int j = 0; j < 4; ++j) {
            const int k = 256 * j + 4 * F.lane;
            const f32x4 w4 = *(const f32x4*)(nw + k), s4 = *(const f32x4*)(sc + k), h4 = *(const f32x4*)(sh + k);
            const f32x4 y = v[j] * rstd * w4 * (s4 + 1.0f) + h4;
            v2u o; o.x = pk2(y.x, y.y); o.y = pk2(y.z, y.w);
            *(v2u*)(XA + (size_t)tok * D + k) = o;
        }
    }
}


namespace scan {
typedef short bf16x8 __attribute__((ext_vector_type(8)));
typedef short bf16x4 __attribute__((ext_vector_type(4)));
constexpr int QI_RS = 264, KT_RS = 160, AI_RS = 160;
constexpr int OFF_QI = 0, OFF_KT = 17408, OFF_VT = 37888, OFF_AI = 58368, OFF_SCL = 68608, SET_BYTES = 70144;
constexpr int PRE_SEG = 0, PRE_QI = 8192, PRE_KI = 8192 + 17408;
#define MFMA16(a, b, c) __builtin_amdgcn_mfma_f32_16x16x32_bf16((a), (b), (c), 0, 0, 0)
__device__ __forceinline__ bf16x8 ld_perm(const LAS unsigned char* p) {
    const bf16x4 lo = *(const LAS bf16x4*)p, hi = *(const LAS bf16x4*)(p + 32);
    return __builtin_shufflevector(lo, hi, 0, 1, 2, 3, 4, 5, 6, 7);
}
__device__ __forceinline__ int tok_row(int g, int i, int b, int dir) {
    if (g < 4) { const int t = 64 * g + i; return MLAT + b * LCX + (dir ? (LCX - 1 - t) : t); }
    const int t = 64 * (g - 4) + i; return b * LX + (dir ? (LX - 1 - t) : t);
}
__device__ __forceinline__ int tok_block(int g, int b, int dir) {
    if (g < 4) return (MLAT / 64) + b * 4 + (dir ? 3 - g : g);
    return b * 64 + (dir ? 63 - (g - 4) : (g - 4));
}
struct PreRaw { unsigned rq[2][8], rf[2][8]; };
__device__ __forceinline__ void prepass_load(PreRaw& R, const bf16* PA, const int tb, const int h) {
    const int lane = threadIdx.x & 63, w = __builtin_amdgcn_readfirstlane(threadIdx.x >> 6);
    const int r0 = 64 * tb, colq = h * HD + 2 * lane;
#pragma unroll
    for (int dir = 0; dir < 2; ++dir)
#pragma unroll
        for (int e = 0; e < 8; ++e) {
            const int i = 8 * w + e, row = r0 + (dir ? 63 - i : i);
            const bf16* p = PA + (size_t)row * PA_LD + colq;
            R.rq[dir][e] = *(const unsigned*)p; R.rf[dir][e] = *(const unsigned*)(p + 512 + dir * 512);
        }
}
__device__ __forceinline__ void prepass_task(LAS unsigned char* lds, bf16* PA, float* SCL, bf16* AT, const int tb, const int h, PreRaw& R, const int nxt_tb, const int nxt_h) {
    int tid_ = threadIdx.x; asm volatile("" : "+v"(tid_));
    const int tid = tid_, lane = tid & 63, w = __builtin_amdgcn_readfirstlane(tid >> 6);
    const int r0 = 64 * tb, colq = h * HD + 2 * lane;
    float qa[2][8], qb[2][8], fa[2][8], fb[2][8];
#pragma unroll
    for (int dir = 0; dir < 2; ++dir)
#pragma unroll
        for (int e = 0; e < 8; ++e) {
            const unsigned rq = R.rq[dir][e], rf = R.rf[dir][e];
            qa[dir][e] = bf2f((unsigned short)(rq & 0xffffu)); qb[dir][e] = bf2f((unsigned short)(rq >> 16));
            fa[dir][e] = h2f((unsigned short)(rf & 0xffffu)); fb[dir][e] = h2f((unsigned short)(rf >> 16));
        }
    float pa[2][8], pb[2][8];
#pragma unroll
    for (int dir = 0; dir < 2; ++dir) {
        pa[dir][0] = fa[dir][0]; pb[dir][0] = fb[dir][0];
#pragma unroll
        for (int e = 1; e < 8; ++e) { pa[dir][e] = pa[dir][e - 1] * fa[dir][e]; pb[dir][e] = pb[dir][e - 1] * fb[dir][e]; }
        LAS float* sg = (LAS float*)(lds + PRE_SEG) + dir * 1024 + w * 128 + 2 * lane; sg[0] = pa[dir][7]; sg[1] = pb[dir][7];
    }
    __syncthreads();
#pragma unroll
    for (int dir = 0; dir < 2; ++dir) {
        const LAS float* seg = (const LAS float*)(lds + PRE_SEG) + dir * 1024 + 2 * lane;
        float ma = 1.f, mb = 1.f;
        if (w >= 4) {
#pragma unroll
            for (int s2 = 4; s2 < 7; ++s2) if (s2 < w) { ma *= seg[s2 * 128]; mb *= seg[s2 * 128 + 1]; }
        } else {
#pragma unroll
            for (int s2 = 1; s2 < 4; ++s2) if (s2 > w) { ma *= seg[s2 * 128]; mb *= seg[s2 * 128 + 1]; }
        }
        float xa[8], xb[8];
        if (w >= 4) {
#pragma unroll
            for (int e = 0; e < 8; ++e) { xa[e] = ma * pa[dir][e]; xb[e] = mb * pb[dir][e]; }
        } else {
            float sa = ma, sb = mb;
#pragma unroll
            for (int e = 7; e >= 0; --e) { xa[e] = sa; xb[e] = sb; sa *= fa[dir][e]; sb *= fb[dir][e]; }
        }
        float gma = 1.f, gmb = 1.f, gea = 1.f, geb = 1.f;
#pragma unroll
        for (int s2 = 0; s2 < 4; ++s2) { gma *= seg[s2 * 128]; gmb *= seg[s2 * 128 + 1]; }
#pragma unroll
        for (int s2 = 4; s2 < 8; ++s2) { gea *= seg[s2 * 128]; geb *= seg[s2 * 128 + 1]; }
#pragma unroll
        for (int e = 0; e < 8; ++e) {
            const float ka = 1.0f - fa[dir][e], kb = 1.0f - fb[dir][e];
            const float ra = __builtin_amdgcn_rcpf(fmaxf(xa[e], 1e-30f)), rb = __builtin_amdgcn_rcpf(fmaxf(xb[e], 1e-30f));
            float Qa, Qb, Ka, Kb;
            if (w >= 4) { Qa = qa[dir][e] * xa[e]; Qb = qb[dir][e] * xb[e]; Ka = ka * ra; Kb = kb * rb; }
            else { Qa = qa[dir][e] * ra; Qb = qb[dir][e] * rb; Ka = ka * xa[e]; Kb = kb * xb[e]; }
            const int i = 8 * w + e, row = r0 + (dir ? 63 - i : i);
            bf16* p = PA + (size_t)row * PA_LD + colq;
            const unsigned qw = pk2(Qa, Qb), kw = pk2(Ka, Kb);
            *(unsigned*)(p + (dir ? 2560 : 0)) = pk2(Qa * gma, Qb * gmb);
            *(unsigned*)(p + 512 + dir * 512) = pk2(Ka * gea, Kb * geb);
            *(LAS unsigned*)(lds + PRE_QI + dir * 34816 + i * QI_RS + 4 * lane) = qw;
            *(LAS unsigned*)(lds + PRE_KI + dir * 34816 + i * QI_RS + 4 * lane) = kw;
        }
        if (w == 0) *(f2_t*)(SCL + (size_t)(dir * 544 + tb) * 512 + colq) = (f2_t){gma * gea, gmb * geb};
    }
    __syncthreads();
    if (nxt_tb >= 0) prepass_load(R, PA, nxt_tb, nxt_h);
    {
        const int l15 = lane & 15, q = lane >> 4;
        for (int tt = w; tt < 32; tt += 8) {
            const int dir = tt >> 4, it = (tt & 15) >> 2, jt = tt & 3;
            f32x4 a4 = (f32x4){0.f, 0.f, 0.f, 0.f};
            if (jt <= it) {
#pragma unroll
                for (int ks = 0; ks < 4; ++ks)
                    a4 = MFMA16(ld_perm(lds + PRE_KI + dir * 34816 + (16 * jt + l15) * QI_RS + (32 * ks + 4 * q) * 2), ld_perm(lds + PRE_QI + dir * 34816 + (16 * it + l15) * QI_RS + (32 * ks + 4 * q) * 2), a4);
#pragma unroll
                for (int r = 0; r < 4; ++r) a4[r] = (16 * jt + 4 * q + r <= 16 * it + l15) ? a4[r] : 0.f;
            }
            v2u wv; wv.x = pk2(a4[0], a4[1]); wv.y = pk2(a4[2], a4[3]);
            *(v2u*)(AT + ((size_t)((dir * 544 + tb) * 4 + h)) * 4096 + (16 * it + l15) * 64 + 16 * jt + 4 * q) = wv;
        }
    }
    __syncthreads();
}
__device__ __forceinline__ void scan_unit(LAS unsigned char* lds, bf16* PA, bf16* OC, const float* SCL, const bf16* AT, const int b, const int h, const int dir, const bool ctxunit) {
    int tid_ = threadIdx.x; asm volatile("" : "+v"(tid_));
    const int tid = tid_, lane = tid & 63, w = __builtin_amdgcn_readfirstlane(tid >> 6);
    const int l15 = lane & 15, q = lane >> 4;
    const int nchunk = ctxunit ? 4 : 68;
    if (w >= 4) {
        const int pw = w - 4, ptid = tid - 256, th = lane >> 5, kq = lane & 31, colq = h * HD + 4 * kq;
        v2u qA[8], kA[8], vA[8], qB[8], kB[8], vB[8]; v4u a0A, a1A, a0B, a1B; f32x4 sA = (f32x4){0.f, 0.f, 0.f, 0.f}, sB = sA;
#define SCAN_LOAD(g, Q_, K_, V_, A0_, A1_, S_) do { _Pragma("unroll") for (int e = 0; e < 8; ++e) { const bf16* p_ = PA + (size_t)tok_row((g), 16 * pw + 8 * th + e, b, dir) * PA_LD + colq; \
            Q_[e] = *(const v2u*)(p_ + (dir ? 2560 : 0)); K_[e] = *(const v2u*)(p_ + 512 + dir * 512); V_[e] = *(const v2u*)(p_ + 1536); } \
            const int tb_ = tok_block((g), b, dir); const bf16* at_ = AT + ((size_t)((dir * 544 + tb_) * 4 + h)) * 4096 + ptid * 16; A0_ = *(const v4u*)at_; A1_ = *(const v4u*)(at_ + 8); \
            S_ = *(const f32x4*)(SCL + (size_t)(dir * 544 + tb_) * 512 + h * HD + 4 * (ptid & 31)); } while (0)
#define SCAN_IMG(set_, Q_, K_, V_, A0_, A1_, S_) do { LAS unsigned char* s_ = lds + (set_) * SET_BYTES; \
            _Pragma("unroll") for (int e = 0; e < 8; ++e) *(LAS v2u*)(s_ + OFF_QI + (16 * pw + 8 * th + e) * QI_RS + 8 * kq) = Q_[e]; \
            _Pragma("unroll") for (int d = 0; d < 4; ++d) { v4u t_, u_; \
                _Pragma("unroll") for (int e = 0; e < 4; ++e) { const unsigned ka_ = (d & 2) ? K_[2 * e].y : K_[2 * e].x, kb_ = (d & 2) ? K_[2 * e + 1].y : K_[2 * e + 1].x, va_ = (d & 2) ? V_[2 * e].y : V_[2 * e].x, vb_ = (d & 2) ? V_[2 * e + 1].y : V_[2 * e + 1].x; \
                    t_[e] = (d & 1) ? ((ka_ >> 16) | (kb_ & 0xffff0000u)) : ((ka_ & 0xffffu) | (kb_ << 16)); u_[e] = (d & 1) ? ((va_ >> 16) | (vb_ & 0xffff0000u)) : ((va_ & 0xffffu) | (vb_ << 16)); } \
                *(LAS v4u*)(s_ + OFF_KT + (4 * kq + d) * KT_RS + 16 * ((2 * pw + th) ^ (kq & 7))) = t_; *(LAS v4u*)(s_ + OFF_VT + (4 * kq + d) * KT_RS + 16 * ((2 * pw + th) ^ (kq & 7))) = u_; } \
            *(LAS v4u*)(s_ + OFF_AI + (ptid >> 2) * AI_RS + 32 * (ptid & 3)) = A0_; *(LAS v4u*)(s_ + OFF_AI + (ptid >> 2) * AI_RS + 32 * (ptid & 3) + 16) = A1_; \
            if (ptid < 32) *(LAS f32x4*)(s_ + OFF_SCL + 16 * ptid) = S_; } while (0)
        const int last = nchunk - 1;
        SCAN_LOAD(0, qA, kA, vA, a0A, a1A, sA);
        SCAN_LOAD(1, qB, kB, vB, a0B, a1B, sB);
        SCAN_IMG(0, qA, kA, vA, a0A, a1A, sA);
        SCAN_LOAD(2, qA, kA, vA, a0A, a1A, sA);
        __syncthreads();
        for (int g = 0; g < nchunk; g += 2) {
            SCAN_IMG(1, qB, kB, vB, a0B, a1B, sB);
            { const int gn = g + 3 < last ? g + 3 : last; SCAN_LOAD(gn, qB, kB, vB, a0B, a1B, sB); }
            __syncthreads();
            SCAN_IMG(0, qA, kA, vA, a0A, a1A, sA);
            { const int gn = g + 4 < last ? g + 4 : last; SCAN_LOAD(gn, qA, kA, vA, a0A, a1A, sA); }
            __syncthreads();
        }
#undef SCAN_LOAD
#undef SCAN_IMG
    } else {
        f32x4 S[2][8];
#pragma unroll
        for (int c = 0; c < 2; ++c)
#pragma unroll
            for (int kt = 0; kt < 8; ++kt) S[c][kt] = (f32x4){0.f, 0.f, 0.f, 0.f};
        const int vc0 = 32 * w;
        if (!ctxunit) PSTAMP_S(lds, 20);
        __syncthreads();
        for (int g = 0; g < nchunk; ++g) {
            const bool do_o = ctxunit || g >= 4;
            if (g == 30) PSTAMP_S(lds, 22);
            const LAS unsigned char* cs = lds + (g & 1) * SET_BYTES;
            bf16x8 vt[2][2];
#pragma unroll
            for (int c = 0; c < 2; ++c) { const int r_ = vc0 + 8 * (l15 >> 2) + 4 * c + (l15 & 3), x_ = (r_ >> 2) & 7;
                vt[c][0] = *(const LAS bf16x8*)(cs + OFF_VT + r_ * KT_RS + 16 * (q ^ x_)); vt[c][1] = *(const LAS bf16x8*)(cs + OFF_VT + r_ * KT_RS + 16 * ((4 + q) ^ x_)); }
            if (do_o) {
                f32x4 O[2][4];
#pragma unroll
                for (int c = 0; c < 2; ++c)
#pragma unroll
                    for (int it = 0; it < 4; ++it) O[c][it] = (f32x4){0.f, 0.f, 0.f, 0.f};
#pragma unroll
                for (int ks = 0; ks < 4; ++ks) {
                    bf16x8 sf[2];
#pragma unroll
                    for (int c = 0; c < 2; ++c) { const f32x4 s0 = S[c][2 * ks], s1 = S[c][2 * ks + 1];
                        v4u pk; pk.x = pk2(s0[0], s0[1]); pk.y = pk2(s0[2], s0[3]); pk.z = pk2(s1[0], s1[1]); pk.w = pk2(s1[2], s1[3]); sf[c] = __builtin_bit_cast(bf16x8, pk); }
#pragma unroll
                    for (int it = 0; it < 4; ++it) { const bf16x8 qf = ld_perm(cs + OFF_QI + (16 * it + l15) * QI_RS + (32 * ks + 4 * q) * 2);
                        O[0][it] = MFMA16(sf[0], qf, O[0][it]); O[1][it] = MFMA16(sf[1], qf, O[1][it]); }
                }
#pragma unroll
                for (int it = 0; it < 4; ++it) {
                    const bf16x8 a0 = *(const LAS bf16x8*)(cs + OFF_AI + (16 * it + l15) * AI_RS + 16 * q);
                    O[0][it] = MFMA16(vt[0][0], a0, O[0][it]); O[1][it] = MFMA16(vt[1][0], a0, O[1][it]);
                    if (it >= 2) { const bf16x8 a1 = *(const LAS bf16x8*)(cs + OFF_AI + (16 * it + l15) * AI_RS + 64 + 16 * q);
                        O[0][it] = MFMA16(vt[0][1], a1, O[0][it]); O[1][it] = MFMA16(vt[1][1], a1, O[1][it]); }
                }
#pragma unroll
                for (int it = 0; it < 4; ++it) {
                    const int row = tok_row(g, 16 * it + l15, b, dir);
                    bf16* dst = (g < 4) ? OC + (size_t)dir * MCTX * 512 + (size_t)(row - MLAT) * 512 + h * HD + vc0 + 8 * q
                                        : PA + (size_t)row * PA_LD + 512 + dir * 512 + h * HD + vc0 + 8 * q;
                    v4u wv; wv.x = pk2(O[0][it][0], O[0][it][1]); wv.y = pk2(O[0][it][2], O[0][it][3]); wv.z = pk2(O[1][it][0], O[1][it][1]); wv.w = pk2(O[1][it][2], O[1][it][3]);
                    *(v4u*)dst = wv;
                }
            }
#pragma unroll
            for (int kt = 0; kt < 8; ++kt) {
                const f32x4 ge = *(const LAS f32x4*)(cs + OFF_SCL + (16 * kt + 4 * q) * 4);
                const int xk_ = (4 * kt + (l15 >> 2)) & 7;
                const bf16x8 k0 = *(const LAS bf16x8*)(cs + OFF_KT + (16 * kt + l15) * KT_RS + 16 * (q ^ xk_)), k1 = *(const LAS bf16x8*)(cs + OFF_KT + (16 * kt + l15) * KT_RS + 16 * ((4 + q) ^ xk_));
#pragma unroll
                for (int c = 0; c < 2; ++c) { f32x4 d4 = ge * S[c][kt]; d4 = MFMA16(k0, vt[c][0], d4); S[c][kt] = MFMA16(k1, vt[c][1], d4); }
            }
            if (g == 30) PSTAMP_S(lds, 23);
            __syncthreads();
            if (g == 30) PSTAMP_S(lds, 24);
        }
        if (!ctxunit) PSTAMP_S(lds, 21);
    }
}
}


namespace hy {
typedef short bf16x8 __attribute__((ext_vector_type(8)));
typedef short bf16x4 __attribute__((ext_vector_type(4)));
constexpr int CS = 16416;
constexpr int VPAD = 7;
constexpr int OFF_F = 0, OFF_V = 4 * CS, V_ROWS = (64 + VPAD + 7) * 8, LDS_END = OFF_V + V_ROWS * 128;
static_assert(LDS_END <= LDS_BYTES - 256, "hyena LDS");
struct ConvW { float x0[4], x1[4], v[4]; };
__device__ __forceinline__ ConvW load_convw(const Args& a, int l, int c) {
    const float* cw = a.in[11] + (size_t)l * 3 * 1536; const float* cb = a.in[12] + (size_t)l * 1536; ConvW r;
#pragma unroll
    for (int j = 0; j < 3; ++j) { r.x0[j] = cw[j * 1536 + c]; r.x1[j] = cw[j * 1536 + 512 + c]; r.v[j] = cw[j * 1536 + 1024 + c]; }
    r.x0[3] = cb[c]; r.x1[3] = cb[512 + c]; r.v[3] = cb[1024 + c];
    return r;
}
__device__ __forceinline__ void hyena_channel(LAS unsigned char* lds, const Args& a, const int l, const int c) {
    int tid_ = threadIdx.x; asm volatile("" : "+v"(tid_));
    const int tid = tid_, lane = tid & 63, w = __builtin_amdgcn_readfirstlane(tid >> 6), l15 = lane & 15, q = lane >> 4;
    unsigned char* ws = a.ws;
    const bf16* PB = (const bf16*)(ws + WS_PB);
    const bf16* x0r = PB + (size_t)c * MTOK; const bf16* x1r = PB + (size_t)(512 + c) * MTOK; const bf16* vr = PB + (size_t)(1024 + c) * MTOK; const bf16* gbr = PB + (size_t)(1536 + c) * MTOK;
    const ConvW cw = load_convw(a, l, c);
    PSTAMP_H(lds, 16);
    {
        const bf16* F = (const bf16*)(ws + WS_FG) + ((size_t)l * 512 + c) * FZ;
        for (int ch = tid; ch < 1024; ch += NTHR) {
            const v4u cur = *(const v4u*)(F + 8 * ch); v4u prev = *(const v4u*)(F + (ch > 0 ? 8 * ch - 8 : 0));
            if (ch == 0) prev = (v4u){0u, 0u, 0u, 0u};
            const unsigned W[8] = {prev.x, prev.y, prev.z, prev.w, cur.x, cur.y, cur.z, cur.w};
            v4u c1, c2, c3;
#pragma unroll
            for (int d = 0; d < 4; ++d) { c1[d] = (W[3 + d] >> 16) | (W[4 + d] << 16); c2[d] = W[3 + d]; c3[d] = (W[2 + d] >> 16) | (W[3 + d] << 16); }
            *(LAS v4u*)(lds + OFF_F + 0 * CS + 16 * ch) = cur;
            *(LAS v4u*)(lds + OFF_F + 1 * CS + 16 * ch) = c1;
            *(LAS v4u*)(lds + OFF_F + 2 * CS + 16 * ch) = c2;
            *(LAS v4u*)(lds + OFF_F + 3 * CS + 16 * ch) = c3;
        }
    }
    {
        for (int e = tid; e < VPAD * 8 * 32; e += NTHR) ((LAS unsigned*)(lds + OFF_V))[e] = 0u;
        for (int e = tid; e < 7 * 8 * 32; e += NTHR) ((LAS unsigned*)(lds + OFF_V + (64 + VPAD) * 8 * 128))[e] = 0u;
        for (int bt = 0; bt < 2; ++bt) {
            v4u vw[4], xw[4]; unsigned short hv[4][2], hx[4][2];
#pragma unroll
            for (int j = 0; j < 4; ++j) {
                const int e = tid + NTHR * (4 * bt + j), b = e >> 9, t0 = (e & 511) * 8;
                const size_t base = (size_t)b * LX + t0;
                const size_t bm = t0 > 0 ? base - 1 : base, bp = t0 + 8 < LX ? base + 8 : base;
                vw[j] = *(const v4u*)(vr + base); xw[j] = *(const v4u*)(x1r + base);
                hv[j][0] = vr[bm]; hv[j][1] = vr[bp]; hx[j][0] = x1r[bm]; hx[j][1] = x1r[bp];
            }
#pragma unroll
            for (int j = 0; j < 4; ++j) {
                const int e = tid + NTHR * (4 * bt + j), b = e >> 9, t0 = (e & 511) * 8, ab = t0 >> 6, ch = (t0 & 63) >> 3;
                float vv[10], xx[10];
                vv[0] = t0 > 0 ? bf2f(hv[j][0]) : 0.f; xx[0] = t0 > 0 ? bf2f(hx[j][0]) : 0.f;
                vv[9] = t0 + 8 < LX ? bf2f(hv[j][1]) : 0.f; xx[9] = t0 + 8 < LX ? bf2f(hx[j][1]) : 0.f;
#pragma unroll
                for (int d = 0; d < 4; ++d) { vv[1 + 2 * d] = bf2f((unsigned short)(vw[j][d] & 0xffffu)); vv[2 + 2 * d] = bf2f((unsigned short)(vw[j][d] >> 16));
                                              xx[1 + 2 * d] = bf2f((unsigned short)(xw[j][d] & 0xffffu)); xx[2 + 2 * d] = bf2f((unsigned short)(xw[j][d] >> 16)); }
                float p[8];
#pragma unroll
                for (int d = 0; d < 8; ++d) p[d] = (cw.v[3] + cw.v[0] * vv[d] + cw.v[1] * vv[d + 1] + cw.v[2] * vv[d + 2]) * (cw.x1[3] + cw.x1[0] * xx[d] + cw.x1[1] * xx[d + 1] + cw.x1[2] * xx[d + 2]);
                v4u o; o.x = pk2(p[0], p[1]); o.y = pk2(p[2], p[3]); o.z = pk2(p[4], p[5]); o.w = pk2(p[6], p[7]);
                const int R = (ab + VPAD) * 8 + b;
                *(LAS v4u*)(lds + OFF_V + R * 128 + 16 * (ch ^ ((R >> 1) & 7))) = o;
            }
        }
    }
    __syncthreads();
    PSTAMP_H(lds, 17);
    f32x4 acc[4][4];
#pragma unroll
    for (int mt = 0; mt < 4; ++mt)
#pragma unroll
        for (int nt = 0; nt < 4; ++nt) acc[mt][nt] = (f32x4){0.f, 0.f, 0.f, 0.f};
    {
        const LAS unsigned char* pa = lds + OFF_F + (l15 & 3) * CS + (4096 - 4 * (l15 >> 2) + 8 * q) * 2 - 96;
        const int rowl = (l15 >> 3) * 8 + (l15 & 7);
        const int cq = (q ^ (rowl >> 1)) & 7;
        const LAS unsigned char* vb0 = lds + OFF_V + rowl * 128 + (8 * w + VPAD) * 1024 + 16 * cq;
        const LAS unsigned char* vb1 = lds + OFF_V + rowl * 128 + (8 * w + VPAD) * 1024 + 16 * (cq ^ 4);
#define HY_LDA(An_, m_) do { const LAS unsigned char* p_ = pa - 128 * (m_); _Pragma("unroll") for (int mt = 0; mt < 4; ++mt) { \
            const bf16x4 lo_ = *(const LAS bf16x4*)(p_ + 32 * (3 - mt)), hi_ = *(const LAS bf16x4*)(p_ + 32 * (3 - mt) + 8); An_[mt] = __builtin_shufflevector(lo_, hi_, 0, 1, 2, 3, 4, 5, 6, 7); } } while (0)
#define HY_LDB(B_, m_, PAR_) do { const LAS unsigned char* p0_ = ((PAR_) ? vb1 : vb0) - 1024 * (m_); const LAS unsigned char* p1_ = ((PAR_) ? vb0 : vb1) - 1024 * (m_); \
            _Pragma("unroll") for (int nt = 0; nt < 4; ++nt) { B_[0][nt] = *(const LAS bf16x8*)(p0_ + 2048 * nt); B_[1][nt] = *(const LAS bf16x8*)(p1_ + 2048 * nt); } } while (0)
#define HY_MMA(An_, Ao0_, Ao1_, B_, m_) do { _Pragma("unroll") for (int nt = 0; nt < 4; ++nt) { const int a0_ = 8 * w + 2 * nt - (m_); if (a0_ + 1 >= 0 && a0_ <= 63) { \
            _Pragma("unroll") for (int mt = 0; mt < 4; ++mt) acc[mt][nt] = __builtin_amdgcn_mfma_f32_16x16x32_bf16(An_[mt], B_[0][nt], acc[mt][nt], 0, 0, 0); \
            acc[0][nt] = __builtin_amdgcn_mfma_f32_16x16x32_bf16(Ao0_, B_[1][nt], acc[0][nt], 0, 0, 0); acc[1][nt] = __builtin_amdgcn_mfma_f32_16x16x32_bf16(Ao1_, B_[1][nt], acc[1][nt], 0, 0, 0); \
            acc[2][nt] = __builtin_amdgcn_mfma_f32_16x16x32_bf16(An_[0], B_[1][nt], acc[2][nt], 0, 0, 0); acc[3][nt] = __builtin_amdgcn_mfma_f32_16x16x32_bf16(An_[1], B_[1][nt], acc[3][nt], 0, 0, 0); } } } while (0)
        bf16x8 Aa[4], Ab[4], Ba[2][4], Bb[2][4], o0, o1;
        const int m0 = 8 * w - 63, mlast = 8 * w + 7;
        { bf16x8 t_[4]; HY_LDA(t_, m0 - 1); o0 = t_[2]; o1 = t_[3]; }
        HY_LDA(Aa, m0); HY_LDB(Ba, m0, 0);
        for (int m = m0; m < mlast; m += 2) {
            HY_LDA(Ab, m + 1); HY_LDB(Bb, m + 1, 1);
            HY_MMA(Aa, o0, o1, Ba, m);
            o0 = Aa[2]; o1 = Aa[3];
            HY_LDA(Aa, m + 2); HY_LDB(Ba, m + 2, 0);
            HY_MMA(Ab, o0, o1, Bb, m + 1);
            o0 = Ab[2]; o1 = Ab[3];
        }
        HY_MMA(Aa, o0, o1, Ba, mlast);
#undef HY_LDA
#undef HY_LDB
#undef HY_MMA
    }
    PSTAMP_H(lds, 18);
    __syncthreads();
    {
        constexpr int YRS = 8208;
        const float inn = 1.0f / ((const float*)(ws + WS_CTL))[CW_NORM + l * 512 + c], hb = a.in[21][l * 512 + c];
        const int b = l15 & 7;
#pragma unroll
        for (int nt = 0; nt < 4; ++nt) {
            const int ab = 8 * w + 2 * nt + (l15 >> 3), R = (ab + VPAD) * 8 + b;
#pragma unroll
            for (int mt = 0; mt < 4; ++mt) {
                const int t = 64 * ab + 16 * mt + 4 * q;
                const v2u vw = *(const LAS v2u*)(lds + OFF_V + R * 128 + 16 * ((2 * mt + (q >> 1)) ^ ((R >> 1) & 7)) + 8 * (q & 1));
                const float y0 = acc[mt][nt][0] * inn + bf2f((unsigned short)(vw.x & 0xffffu)) * hb, y1 = acc[mt][nt][1] * inn + bf2f((unsigned short)(vw.x >> 16)) * hb;
                const float y2 = acc[mt][nt][2] * inn + bf2f((unsigned short)(vw.y & 0xffffu)) * hb, y3 = acc[mt][nt][3] * inn + bf2f((unsigned short)(vw.y >> 16)) * hb;
                v2u yw; yw.x = pk2(y0, y1); yw.y = pk2(y2, y3);
                *(LAS v2u*)(lds + OFF_F + b * YRS + 2 * t) = yw;
            }
        }
        __syncthreads();
        bf16* OBT = (bf16*)(ws + WS_OBT) + (size_t)c * MTOK;
        int tid2 = tid; asm volatile("" : "+v"(tid2));
        for (int bt = 0; bt < 4; ++bt) {
            v4u xw[2], gw[2]; unsigned short hx[2][2];
#pragma unroll
            for (int j = 0; j < 2; ++j) {
                const int e = tid2 + NTHR * (2 * bt + j), bb = e >> 9, t0 = (e & 511) * 8;
                const size_t base = (size_t)bb * LX + t0;
                xw[j] = *(const v4u*)(x0r + base); gw[j] = *(const v4u*)(gbr + base);
                hx[j][0] = x0r[t0 > 0 ? base - 1 : base]; hx[j][1] = x0r[t0 + 8 < LX ? base + 8 : base];
            }
#pragma unroll
            for (int j = 0; j < 2; ++j) {
                const int e = tid2 + NTHR * (2 * bt + j), bb = e >> 9, t0 = (e & 511) * 8;
                const size_t base = (size_t)bb * LX + t0;
                const v4u yw = *(const LAS v4u*)(lds + OFF_F + bb * YRS + 2 * t0);
                float xs[10], o[8];
                xs[0] = t0 > 0 ? bf2f(hx[j][0]) : 0.f; xs[9] = t0 + 8 < LX ? bf2f(hx[j][1]) : 0.f;
#pragma unroll
                for (int d = 0; d < 4; ++d) { xs[1 + 2 * d] = bf2f((unsigned short)(xw[j][d] & 0xffffu)); xs[2 + 2 * d] = bf2f((unsigned short)(xw[j][d] >> 16)); }
#pragma unroll
                for (int d = 0; d < 8; ++d) {
                    const float yv = bf2f((unsigned short)((d & 1) ? (yw[d >> 1] >> 16) : (yw[d >> 1] & 0xffffu)));
                    const float gv = bf2f((unsigned short)((d & 1) ? (gw[j][d >> 1] >> 16) : (gw[j][d >> 1] & 0xffffu)));
                    o[d] = yv * (cw.x0[3] + cw.x0[0] * xs[d] + cw.x0[1] * xs[d + 1] + cw.x0[2] * xs[d + 2]) * silu_f(gv);
                }
                v4u ow; ow.x = pk2(o[0], o[1]); ow.y = pk2(o[2], o[3]); ow.z = pk2(o[4], o[5]); ow.w = pk2(o[6], o[7]);
                *(v4u*)(OBT + base) = ow;
            }
        }
    }
    PSTAMP_H(lds, 19);
    __syncthreads();
}
__device__ __forceinline__ void hyena_ctx_channel(LAS unsigned char* lds, const Args& a, const int c) {
    int tid_ = threadIdx.x; asm volatile("" : "+v"(tid_));
    const int tid = tid_;
    unsigned char* ws = a.ws;
    const bf16* PB = (const bf16*)(ws + WS_PB);
    const bf16* x0r = PB + (size_t)c * MTOK + MLAT; const bf16* x1r = PB + (size_t)(512 + c) * MTOK + MLAT; const bf16* vr = PB + (size_t)(1024 + c) * MTOK + MLAT; const bf16* gbr = PB + (size_t)(1536 + c) * MTOK + MLAT;
    const ConvW cw = load_convw(a, 0, c);
    LAS float* vvc = (LAS float*)lds;
    LAS float* Fc = vvc + 2048;
    for (int e = tid; e < 2048; e += NTHR) {
        const int t = e & 255;
        const float vm_ = bf2f(vr[t > 0 ? e - 1 : e]), v0 = bf2f(vr[e]), vp_ = bf2f(vr[t < 255 ? e + 1 : e]);
        const float xm_ = bf2f(x1r[t > 0 ? e - 1 : e]), x0 = bf2f(x1r[e]), xp_ = bf2f(x1r[t < 255 ? e + 1 : e]);
        const float vm = t > 0 ? vm_ : 0.f, vp = t < 255 ? vp_ : 0.f, xm = t > 0 ? xm_ : 0.f, xp = t < 255 ? xp_ : 0.f;
        vvc[e] = (cw.v[3] + cw.v[0] * vm + cw.v[1] * v0 + cw.v[2] * vp) * (cw.x1[3] + cw.x1[0] * xm + cw.x1[1] * x0 + cw.x1[2] * xp);
    }
    if (tid < 520) Fc[tid] = tid < 512 ? bf2f(((const bf16*)(ws + WS_FGC))[(size_t)c * FZC + tid]) : 0.f;
    __syncthreads();
    const float inn = 1.0f / ((const float*)(ws + WS_CTL))[CW_NORM + 2 * 512 + c], hb = a.in[21][c];
    bf16* OBT = (bf16*)(ws + WS_OBT) + (size_t)c * MTOK + MLAT;
    {
        const int b = tid >> 6, t0 = 4 * (tid & 63), e0 = b * 256 + t0;
        float acc4[4] = {0.f, 0.f, 0.f, 0.f};
        const LAS float* fp = Fc + 252 - t0;
        for (int s4 = 0; s4 < 64; ++s4) {
            const f32x4 ga = *(const LAS f32x4*)(fp + 4 * s4), gb = *(const LAS f32x4*)(fp + 4 * s4 + 4), vq = *(const LAS f32x4*)(vvc + b * 256 + 4 * s4);
            const float g[8] = {ga[0], ga[1], ga[2], ga[3], gb[0], gb[1], gb[2], gb[3]};
#pragma unroll
            for (int i = 0; i < 4; ++i)
#pragma unroll
                for (int u = 0; u < 4; ++u) acc4[i] += g[4 - i + u] * vq[u];
        }
        float xs[6], gv[4];
        xs[0] = t0 > 0 ? bf2f(x0r[e0 - 1]) : 0.f;
#pragma unroll
        for (int i = 0; i < 4; ++i) { xs[1 + i] = bf2f(x0r[e0 + i]); gv[i] = bf2f(gbr[e0 + i]); }
        xs[5] = t0 + 4 < 256 ? bf2f(x0r[e0 + 4]) : 0.f;
        float o[4];
#pragma unroll
        for (int i = 0; i < 4; ++i) o[i] = (acc4[i] * inn + vvc[e0 + i] * hb) * (cw.x0[3] + cw.x0[0] * xs[i] + cw.x0[1] * xs[i + 1] + cw.x0[2] * xs[i + 2]) * silu_f(gv[i]);
        v2u ow; ow.x = pk2(o[0], o[1]); ow.y = pk2(o[2], o[3]);
        *(v2u*)(OBT + e0) = ow;
    }
    __syncthreads();
}
}


__device__ __forceinline__ void phase_prepass(const Args& a, Frame& F) {
    scan::PreRaw R;
    if (F.vcu < 544 * 4) scan::prepass_load(R, (const bf16*)(a.ws + WS_PA), F.vcu >> 2, F.vcu & 3);
    for (int t = F.vcu; t < 544 * 4; t += F.G) { const int tn = t + F.G < 544 * 4 ? t + F.G : -4;
        scan::prepass_task(F.lds, (bf16*)(a.ws + WS_PA), (float*)(a.ws + WS_SCL), (bf16*)(a.ws + WS_XA), t >> 2, t & 3, R, tn >> 2, tn & 3); }
}

__device__ __forceinline__ void phase_mix(const Args& a, Frame& F, const int l, const int part = -1) {
    unsigned* qctr = (unsigned*)(a.ws + WS_CTL) + CW_QUEUE + 64 * l + (part == 1 ? 128 : 0);
    volatile LAS int* slot = (volatile LAS int*)(F.lds + LDS_BYTES - 64);
    const int ntasks = l == 0 ? 64 + 512 + 64 + 512 : 64 + 512;
    for (;;) {
        if (F.tid == 0) slot[0] = (int)atomicAdd(qctr, 1u);
        __syncthreads();
        const int t = __builtin_amdgcn_readfirstlane(slot[0]);
        __syncthreads();
        if (t >= ntasks) break;
        if (part == 0 && !(t < 64 || (t >= 576 && t < 640))) continue;
        if (part == 1 && (t < 64 || (t >= 576 && t < 640))) continue;
        if (t < 64) scan::scan_unit(F.lds, (bf16*)(a.ws + WS_PA), (bf16*)(a.ws + WS_OC), (const float*)(a.ws + WS_SCL), (const bf16*)(a.ws + WS_XA), t >> 3, (t >> 1) & 3, t & 1, false);
        else if (t < 576) hy::hyena_channel(F.lds, a, l, t - 64);
        else if (t < 640) { const int u = t - 576; scan::scan_unit(F.lds, (bf16*)(a.ws + WS_PA), (bf16*)(a.ws + WS_OC), (const float*)(a.ws + WS_SCL), (const bf16*)(a.ws + WS_XA), u >> 3, (u >> 1) & 3, u & 1, true); }
        else hy::hyena_ctx_channel(F.lds, a, t - 640);
        __syncthreads();
    }
}

__device__ __forceinline__ void phase_finalize_ox(const Args& a, Frame& F, int l) {
    unsigned char* ws = a.ws;
    const bf16* PA = (const bf16*)(ws + WS_PA);
    const bf16* OC = (const bf16*)(ws + WS_OC);
    bf16* XA = (bf16*)(ws + WS_XA);
    const float* gnw = a.in[10] + l * 512;
    const int gw = F.vcu * NWAVES + F.wave, NGW = F.G * NWAVES;
    const int ntok = (l == 0) ? MTOK : MLAT;
    for (int tok = gw; tok < ntok; tok += NGW) {
        const bool isctx = tok >= MLAT;
        const int c8 = 8 * F.lane;
        const bf16* pf = isctx ? OC + (size_t)(tok - MLAT) * 512 + c8 : PA + (size_t)tok * PA_LD + 512 + c8;
        const bf16* pb = isctx ? OC + (size_t)MCTX * 512 + (size_t)(tok - MLAT) * 512 + c8 : PA + (size_t)tok * PA_LD + 1024 + c8;
        const v4u wf = *(const v4u*)pf, wb = *(const v4u*)pb, wg = *(const v4u*)(PA + (size_t)tok * PA_LD + 2048 + c8);
        float o[8], g[8];
#pragma unroll
        for (int e = 0; e < 4; ++e) {
            o[2 * e] = bf2f((unsigned short)(wf[e] & 0xffff)) + bf2f((unsigned short)(wb[e] & 0xffff));
            o[2 * e + 1] = bf2f((unsigned short)(wf[e] >> 16)) + bf2f((unsigned short)(wb[e] >> 16));
            g[2 * e] = bf2f((unsigned short)(wg[e] & 0xffff)); g[2 * e + 1] = bf2f((unsigned short)(wg[e] >> 16));
        }
        float s = 0.f;
#pragma unroll
        for (int e = 0; e < 8; ++e) s += o[e] * o[e];
        s += __shfl_xor(s, 1); s += __shfl_xor(s, 2); s += __shfl_xor(s, 4); s += __shfl_xor(s, 8);
        const float rstd = 1.0f / sqrtf(s * (1.0f / HD) + EPS);
        float y[8];
#pragma unroll
        for (int e = 0; e < 8; ++e) y[e] = o[e] * rstd * gnw[c8 + e] * silu_f(g[e]);
        v4u w; w.x = pk2(y[0], y[1]); w.y = pk2(y[2], y[3]); w.z = pk2(y[4], y[5]); w.w = pk2(y[6], y[7]);
        *(v4u*)(XA + (size_t)tok * D + c8) = w;
    }
    LAS unsigned short* t = (LAS unsigned short*)(F.lds + F.wave * 16384);
    const int ntt = ntok / 64;
    for (int it = gw; it < 8 * ntt; it += NGW) {
        const int ct = it / ntt, tt = it % ntt, c0 = ct * 64, t0 = tt * 64;
        const bf16* OBT = (const bf16*)(ws + WS_OBT);
#pragma unroll
        for (int i = 0; i < 8; ++i) {
            const int e = F.lane + 64 * i, c = e >> 3, ch = e & 7;
            const v4u w = *(const v4u*)(OBT + (size_t)(c0 + c) * MTOK + t0 + 8 * ch);
#pragma unroll
            for (int q = 0; q < 4; ++q) { t[c * 66 + 8 * ch + 2 * q] = (unsigned short)(w[q] & 0xffff); t[c * 66 + 8 * ch + 2 * q + 1] = (unsigned short)(w[q] >> 16); }
        }
        asm volatile("s_waitcnt lgkmcnt(0)" ::: "memory");
#pragma unroll
        for (int i = 0; i < 8; ++i) {
            const int e = F.lane + 64 * i, tk = e >> 3, cg = e & 7;
            unsigned short h[8];
#pragma unroll
            for (int q = 0; q < 8; ++q) h[q] = t[(8 * cg + q) * 66 + tk];
            v4u w; w.x = h[0] | ((unsigned)h[1] << 16); w.y = h[2] | ((unsigned)h[3] << 16); w.z = h[4] | ((unsigned)h[5] << 16); w.w = h[6] | ((unsigned)h[7] << 16);
            *(v4u*)(XA + (size_t)(t0 + tk) * D + 512 + c0 + 8 * cg) = w;
        }
        asm volatile("s_waitcnt lgkmcnt(0)" ::: "memory");
    }
}

__device__ __forceinline__ void phase_final_norm(const Args& a, Frame& F) {
    const float* w = a.in[22];
    const bf16* DL = (const bf16*)(a.ws + WS_PB);
    const int gw = F.vcu * NWAVES + F.wave, NGW = F.G * NWAVES;
    for (int tok = gw; tok < MLAT; tok += NGW) {
        float* xr = a.out + (size_t)tok * D;
        f32x4 v[4]; float s = 0.f;
#pragma unroll
        for (int j = 0; j < 4; ++j) { v[j] = *(const f32x4*)(xr + 256 * j + 4 * F.lane); const v2u dw = *(const v2u*)(DL + (size_t)tok * D + 256 * j + 4 * F.lane);
            v[j].x += bf2f((unsigned short)(dw.x & 0xffffu)); v[j].y += bf2f((unsigned short)(dw.x >> 16)); v[j].z += bf2f((unsigned short)(dw.y & 0xffffu)); v[j].w += bf2f((unsigned short)(dw.y >> 16));
            s += (v[j].x * v[j].x + v[j].y * v[j].y) + (v[j].z * v[j].z + v[j].w * v[j].w); }
        const float rstd = 1.0f / sqrtf(wave_sum(s) * (1.0f / D) + EPS);
#pragma unroll
        for (int j = 0; j < 4; ++j) { const f32x4 w4 = *(const f32x4*)(w + 256 * j + 4 * F.lane); *(f32x4*)(xr + 256 * j + 4 * F.lane) = v[j] * rstd * w4; }
    }
}

enum { PH_PRO = 0, PH_NORM0 = 1, PH_IN0 = 2, PH_PRE0 = 3, PH_MIX0 = 4, PH_FIN0 = 5, PH_OUT0 = 6, PH_NORM1 = 7, PH_IN1 = 8, PH_PRE1 = 9, PH_MIX1 = 10, PH_FIN1 = 11, PH_OUT1 = 12, PH_FINAL = 13 };

__device__ __forceinline__ Frame mkframe(unsigned char* lds) {
    Frame F;
    F.lds = (LAS unsigned char*)lds;
    F.tid = threadIdx.x; F.lane = F.tid & 63; F.wave = __builtin_amdgcn_readfirstlane(F.tid >> 6);
    F.G = gridDim.x; { const int bx = blockIdx.x; F.vcu = (F.G % 8 == 0) ? (bx % 8) * (F.G / 8) + bx / 8 : bx; }
    return F;
}
template <int l> __device__ __forceinline__ void run_inproj(const Args& args, unsigned char* lds) {
    unsigned char* ws = args.ws; Frame F = mkframe(lds);
    pg8::Gemm g{(const bf16*)(ws + WS_XA), (const bf16*)(ws + WS_WIN) + (size_t)l * NIN * D, D};
    pg8::Sched S; S.init(128, 18, F.G, (int)blockIdx.x, 8, l == 0 ? 18 : 8);
    EpiIn E{(bf16*)(ws + WS_PA), (bf16*)(ws + WS_PB), (const float*)(ws + WS_LBS) + l * 1024};
    pg8::gemm_phase<EpiIn, true, true>(F.lds, g, S, E);
}
template <int l> __device__ __forceinline__ void run_outproj(const Args& args, unsigned char* lds) {
    unsigned char* ws = args.ws; Frame F = mkframe(lds);
    pg8::Gemm g{(const bf16*)(ws + WS_XA), (const bf16*)(ws + WS_WOUT) + (size_t)l * D * D, D};
    pg8::Sched S; S.init(128, 4, F.G, (int)blockIdx.x, l == 0 ? 8 : 0, 4);
    EpiOut E{(bf16*)(ws + WS_PB), (const float*)(ws + WS_MOD) + (size_t)l * 9 * 3 * D};
    pg8::gemm_phase<EpiOut, true, true>(F.lds, g, S, E);
}
__global__ void __launch_bounds__(NTHR, 2) mega(Args args) {
    extern __shared__ __attribute__((aligned(16))) unsigned char lds[];
    const int lo = args.ph_lo, hi = args.ph_hi;
#define IN(k) (lo <= (k) && (k) < hi)
    volatile LAS unsigned* bst = (volatile LAS unsigned*)((LAS unsigned char*)lds + LDS_BYTES - 32);
    if (threadIdx.x < 8) ((volatile LAS unsigned*)((LAS unsigned char*)lds + LDS_BYTES - 32))[threadIdx.x] = 0u;
    __syncthreads();
    XcdBarrier bar; bar.bar = (unsigned*)(args.ws + WS_CTL) + CW_BAR; bar.x = 0; bar.st = bst;
    if (hi - lo > 1) bar = xcd_barrier_post((unsigned*)(args.ws + WS_CTL) + CW_BAR, bst);
#ifdef PROBE_ID
    volatile LAS unsigned long long* pts = (volatile LAS unsigned long long*)((LAS unsigned char*)lds + LDS_BYTES - 512);
    if (threadIdx.x == 0) pts[0] = __builtin_amdgcn_s_memrealtime();
#define SEAM(k) do { if (IN((k) + 1)) xcd_barrier(bar); else __syncthreads(); if (threadIdx.x == 0) pts[(k) + 1] = __builtin_amdgcn_s_memrealtime(); } while (0)
#else
#define SEAM(k) do { if (IN((k) + 1)) xcd_barrier(bar); else __syncthreads(); } while (0)
#endif
    if (IN(PH_PRO)) { Frame F = mkframe(lds); phase_prologue(args, F); SEAM(PH_PRO); }
    if (IN(PH_NORM0)) { Frame F = mkframe(lds); phase_normrows(args, F, 0, args.in[0], args.in[2]); SEAM(PH_NORM0); }
    if (IN(PH_IN0)) { run_inproj<0>(args, lds); { Frame F = mkframe(lds); phase_filters_l0(args, F); } SEAM(PH_IN0); }
    if (IN(PH_PRE0)) { Frame F = mkframe(lds); phase_prepass(args, F); SEAM(PH_PRE0); }
#ifdef SPLIT_MIX
    if (IN(PH_MIX0)) { Frame F = mkframe(lds); phase_mix(args, F, 0, 0); xcd_barrier(bar); if (threadIdx.x == 0) pts[15] = __builtin_amdgcn_s_memrealtime(); phase_mix(args, F, 0, 1); SEAM(PH_MIX0); }
#else
    if (IN(PH_MIX0)) { Frame F = mkframe(lds); phase_mix(args, F, 0); SEAM(PH_MIX0); }
#endif
    if (IN(PH_FIN0)) { Frame F = mkframe(lds); phase_finalize_ox(args, F, 0); SEAM(PH_FIN0); }
    if (IN(PH_OUT0)) { run_outproj<0>(args, lds); { Frame F = mkframe(lds); phase_filters_l1(args, F); } SEAM(PH_OUT0); }
    if (IN(PH_NORM1)) { Frame F = mkframe(lds); phase_normrows(args, F, 1, args.in[0], args.in[2]); SEAM(PH_NORM1); }
    if (IN(PH_IN1)) { run_inproj<1>(args, lds); SEAM(PH_IN1); }
    if (IN(PH_PRE1)) { Frame F = mkframe(lds); phase_prepass(args, F); SEAM(PH_PRE1); }
    if (IN(PH_MIX1)) { Frame F = mkframe(lds); phase_mix(args, F, 1); SEAM(PH_MIX1); }
    if (IN(PH_FIN1)) { Frame F = mkframe(lds); phase_finalize_ox(args, F, 1); SEAM(PH_FIN1); }
    if (IN(PH_OUT1)) { run_outproj<1>(args, lds); SEAM(PH_OUT1); }
    if (IN(PH_FINAL)) { Frame F = mkframe(lds); phase_final_norm(args, F); SEAM(PH_FINAL); }
#ifdef PROBE_ID
    if (blockIdx.x == 0 && threadIdx.x == 0) {
#ifdef SPLIT_MIX
        const unsigned long long dt = (PROBE_ID == 100) ? pts[15] - pts[PH_MIX0] : pts[PH_MIX0 + 1] - pts[15];
#else
        const unsigned long long dt = (PROBE_ID >= 200) ? ((PROBE_ID == 220 || PROBE_ID >= 226) ? 1ull : 16ull) * (pts[PROBE_ID - 200 + 1] - pts[PROBE_ID - 200]) : pts[PROBE_ID + 1] - pts[PROBE_ID];
#endif
        const unsigned long long t0 = __builtin_amdgcn_s_memrealtime();
        unsigned long long wt = 4ull * dt; if (wt > 300000ull) wt = 300000ull;
        while (__builtin_amdgcn_s_memrealtime() - t0 < wt) __builtin_amdgcn_s_sleep(8);
    }
#endif
#undef IN
#undef SEAM
}

extern "C" void kernel_launch(void* const* d_in, const int* in_sizes, int n_in, void* d_out, int out_size, void* d_ws, size_t ws_size, hipStream_t stream) {
    static int grid = 0;
    if (grid == 0) {
        if (n_in != 23 || ws_size < WS_END) { fprintf(stderr, "kernel_launch: unexpected n_in %d / ws_size %zu\n", n_in, ws_size); grid = -1; return; }
        int dev = 0, cus = 0;
        if (hipGetDevice(&dev) != hipSuccess || hipDeviceGetAttribute(&cus, hipDeviceAttributeMultiprocessorCount, dev) != hipSuccess) { grid = -1; return; }
        if (hipFuncSetAttribute((const void*)mega, hipFuncAttributeMaxDynamicSharedMemorySize, LDS_BYTES) != hipSuccess) { fprintf(stderr, "kernel_launch: hipFuncSetAttribute failed\n"); grid = -1; return; }
        grid = cus;
    }
    if (grid < 0) return;
    (void)hipMemsetAsync((char*)d_ws + WS_CTL, 0, CTL_ZERO_BYTES, stream);
    Args a{};
    for (int i = 0; i < 23; ++i) a.in[i] = (const float*)d_in[i];
    a.out = (float*)d_out; a.ws = (unsigned char*)d_ws;
    a.ph_lo = 0; a.ph_hi = PH_FINAL + 1;
    hipLaunchKernelGGL(mega, dim3(grid), dim3(NTHR), LDS_BYTES, stream, a);
}
```

```cpp
#include <hip/hip_runtime.h>
#include <cstdio>
#include <cstdint>
#include <math.h>

namespace pg8 {
#define PG8_LAS __attribute__((address_space(3)))
typedef unsigned short bf16_t;
typedef short bf16x8 __attribute__((ext_vector_type(8)));
typedef float f32x4 __attribute__((ext_vector_type(4)));
typedef unsigned u32x4 __attribute__((ext_vector_type(4)));
typedef unsigned u32x2 __attribute__((ext_vector_type(2)));
constexpr int BM = 256, BK = 64, HALF = 128, HTB = HALF * BK * 2, STAGE_BYTES = 8 * HTB, NXCD = 8, WGM = 8;

__host__ __device__ __forceinline__ int lds_byte(int r, int c) { const int st = (r >> 4) * 2 + (c >> 5), rr = r & 15, cc = c & 31, ob = rr * 64 + cc * 2; return st * 1024 + (ob ^ (((ob >> 9) & 1) << 5)); }
__host__ __device__ __forceinline__ void stage_rc(int b, int& R, int& C) { const int st = b / 1024, sb = b % 1024, swz = sb ^ (((sb >> 9) & 1) << 5); R = (st >> 1) * 16 + swz / 64; C = (st & 1) * 32 + (swz % 64) / 2; }
__host__ __device__ __forceinline__ int perm32(int rho) { const int n = rho >> 4, i = rho & 15; return 8 * (i >> 2) + 4 * n + (i & 3); }

struct Unit { int pm, pn; };
struct Gemm { const bf16_t* A; const bf16_t* Bt; int K; };

struct Sched {
    int nM, nN, nwg, G, c, nctx, nctxN;
    __device__ void init(int nM_, int nN_, int G_, int c_, int nctxM, int nctxN_) { nM = nM_; nN = nN_; nwg = nM * nN; G = G_; c = c_; nctx = nctxM * nctxN_; nctxN = nctxN_ > 0 ? nctxN_ : 1; }
    __device__ bool next(int i, Unit& u) const {
        const long L = (long)i * G + c;
        if (L >= nwg) { const long L2 = L - nwg; if (L2 >= nctx) return false; u.pm = nM + (int)(L2 / nctxN); u.pn = (int)(L2 % nctxN); return true; }
        int wgid = (int)L; { const int q = nwg / NXCD, r = nwg % NXCD, xcd = wgid % NXCD, off = wgid / NXCD; wgid = (xcd < r ? xcd * (q + 1) : r * (q + 1) + (xcd - r) * q) + off; }
        const int nig = WGM * nN, gid = wgid / nig, fm = gid * WGM, gsz = (nM - fm) < WGM ? (nM - fm) : WGM;
        u.pm = fm + ((wgid % nig) % gsz); u.pn = (wgid % nig) / gsz; return true;
    }
};

template <class Epi, bool ALIGN_EPI, bool SP2>
__device__ __forceinline__ void gemm_phase(PG8_LAS unsigned char* lds, const Gemm g, const Sched& S, const Epi& E) {
    const int tid = threadIdx.x, wid = __builtin_amdgcn_readfirstlane(tid >> 6), lane = tid & 63, wr = wid >> 2, wc = wid & 3, fr = lane & 15, fq = lane >> 4;
    const int K = g.K, nt = K / BK;
    unsigned voffA[2], voffB[2];
#pragma unroll
    for (int i = 0; i < 2; ++i) { int R, C; stage_rc(tid * 16 + i * 8192, R, C); const int Rb = Epi::PERM ? ((R & ~31) + perm32(R & 31)) : R;
        voffA[i] = (unsigned)(R * K + C) * 2u; voffB[i] = (unsigned)(Rb * K + C) * 2u; }
    const size_t kstep = (size_t)(BK * 2);
    const size_t hstep = (size_t)HALF * K * 2;
    const size_t tstep = 2 * hstep;
    const unsigned ldsw = (unsigned)wid * 1024u;
    const int aoff = lds_byte(wr * 64 + fr, fq * 8), boff = lds_byte(wc * 32 + fr, fq * 8);
#define PG8_SA(b, h) (((b) * 2 + (h)) * HTB)
#define PG8_SB(b, h) ((4 + (b) * 2 + (h)) * HTB)
#define PG8_STAGE(bufoff, gbase, voff) do { _Pragma("unroll") for (int _i = 0; _i < 2; ++_i) \
        __builtin_amdgcn_global_load_lds((const unsigned*)((const char*)(gbase) + (voff)[_i]), (PG8_LAS unsigned*)(lds + (bufoff) + ldsw + _i * 8192), 16, 0, 0); } while (0)
#define PG8_LDA(dst, b, h) do { _Pragma("unroll") for (int m = 0; m < 4; ++m) _Pragma("unroll") for (int k = 0; k < 2; ++k) dst[m][k] = *(const PG8_LAS bf16x8*)(lds + PG8_SA(b, h) + aoff + m * 2048 + k * 1024); } while (0)
#define PG8_LDB(dst, b, h) do { _Pragma("unroll") for (int n = 0; n < 2; ++n) _Pragma("unroll") for (int k = 0; k < 2; ++k) dst[n][k] = *(const PG8_LAS bf16x8*)(lds + PG8_SB(b, h) + boff + n * 2048 + k * 1024); } while (0)
#define PG8_MMA(ai, bj, At, Bt) do { __builtin_amdgcn_s_setprio(1); _Pragma("unroll") for (int m = 0; m < 4; ++m) _Pragma("unroll") for (int n = 0; n < 2; ++n) _Pragma("unroll") for (int k = 0; k < 2; ++k) \
        acc[ai][bj][m][n] = __builtin_amdgcn_mfma_f32_16x16x32_bf16(Bt[n][k], At[m][k], acc[ai][bj][m][n], 0, 0, 0); __builtin_amdgcn_s_setprio(0); } while (0)
#define PG8_WAIT_V(n) asm volatile("s_waitcnt vmcnt(" #n ")" ::: "memory")
#define PG8_WAIT_L(n) asm volatile("s_waitcnt lgkmcnt(" #n ")" ::: "memory")
#define PG8_BAR __builtin_amdgcn_s_barrier()
#define PG8_SCHED __builtin_amdgcn_sched_barrier(0)
    Unit cur, nxt; int ui = 0;
    if (!S.next(0, cur)) return;
    f32x4 acc[2][2][4][2];
#pragma unroll
    for (int a = 0; a < 2; ++a)
#pragma unroll
        for (int b = 0; b < 2; ++b)
#pragma unroll
            for (int m = 0; m < 4; ++m)
#pragma unroll
                for (int n = 0; n < 2; ++n) acc[a][b][m][n] = (f32x4){0.f, 0.f, 0.f, 0.f};
    bf16x8 At[4][2], B0[2][2], B1[2][2];
    const char* cA = E.swap(cur) ? (const char*)g.Bt + (size_t)cur.pn * tstep : (const char*)g.A + (size_t)cur.pm * tstep;
    const char* cB = E.swap(cur) ? (const char*)g.A + (size_t)cur.pm * tstep : (const char*)g.Bt + (size_t)cur.pn * tstep;
    if constexpr (SP2) {
        PG8_STAGE(PG8_SB(0, 0), cB, voffB); PG8_STAGE(PG8_SB(0, 1), cB + hstep, voffB); PG8_STAGE(PG8_SA(0, 0), cA, voffA); PG8_STAGE(PG8_SA(0, 1), cA + hstep, voffA);
        if (wr == 1) PG8_BAR;
        PG8_WAIT_V(2); PG8_BAR;
        PG8_STAGE(PG8_SB(1, 0), cB + kstep, voffB); PG8_STAGE(PG8_SA(1, 0), cA + kstep, voffA); PG8_STAGE(PG8_SB(1, 1), cB + hstep + kstep, voffB);
        PG8_WAIT_V(6); PG8_BAR;
    } else {
        PG8_STAGE(PG8_SB(0, 0), cB, voffB); PG8_STAGE(PG8_SA(0, 0), cA, voffA); PG8_STAGE(PG8_SB(0, 1), cB + hstep, voffB); PG8_STAGE(PG8_SA(0, 1), cA + hstep, voffA);
        if (wr == 1) PG8_BAR;
        PG8_WAIT_V(4); PG8_BAR;
        PG8_STAGE(PG8_SB(1, 0), cB + kstep, voffB); PG8_STAGE(PG8_SA(1, 0), cA + kstep, voffA); PG8_STAGE(PG8_SB(1, 1), cB + hstep + kstep, voffB);
        PG8_WAIT_V(6); PG8_BAR;
    }
    for (;;) {
        const bool has_next = S.next(ui + 1, nxt);
        const bool nsw = has_next && E.swap(nxt);
        const char* nA = has_next ? (nsw ? (const char*)g.Bt + (size_t)nxt.pn * tstep : (const char*)g.A + (size_t)nxt.pm * tstep) : cA;
        const char* nB = has_next ? (nsw ? (const char*)g.A + (size_t)nxt.pm * tstep : (const char*)g.Bt + (size_t)nxt.pn * tstep) : cB;
        for (int t = 0; t < nt; t += 2) {
            const bool last = (t == nt - 2);
            const char* a1 = cA + (size_t)(t + 1) * kstep;
            const char* a2 = last ? nA : cA + (size_t)(t + 2) * kstep; const char* b2 = last ? nB : cB + (size_t)(t + 2) * kstep;
            const char* a3 = a2 + kstep; const char* b3 = b2 + kstep;
            if constexpr (SP2) {
            PG8_LDB(B0, 0, 0); PG8_LDB(B1, 0, 1); PG8_SCHED; PG8_LDA(At, 0, 0); PG8_STAGE(PG8_SA(1, 1), a1 + hstep, voffA);
            PG8_WAIT_V(8); PG8_WAIT_L(0); PG8_BAR; PG8_MMA(0, 0, At, B0); PG8_MMA(0, 1, At, B1); PG8_BAR; PG8_SCHED;
            PG8_LDA(At, 0, 1); PG8_STAGE(PG8_SB(0, 0), b2, voffB); PG8_STAGE(PG8_SB(0, 1), b2 + hstep, voffB); PG8_STAGE(PG8_SA(0, 0), a2, voffA);
            PG8_WAIT_V(8); PG8_WAIT_L(0); PG8_BAR; PG8_MMA(1, 0, At, B0); PG8_MMA(1, 1, At, B1); PG8_BAR; PG8_SCHED;
            PG8_LDB(B0, 1, 0); PG8_LDB(B1, 1, 1); PG8_SCHED; PG8_LDA(At, 1, 0); PG8_STAGE(PG8_SA(0, 1), a2 + hstep, voffA);
            PG8_WAIT_V(8); PG8_WAIT_L(0); PG8_BAR; PG8_MMA(0, 0, At, B0); PG8_MMA(0, 1, At, B1); PG8_BAR; PG8_SCHED;
            PG8_LDA(At, 1, 1); PG8_STAGE(PG8_SB(1, 0), b3, voffB); PG8_STAGE(PG8_SB(1, 1), b3 + hstep, voffB); PG8_STAGE(PG8_SA(1, 0), a3, voffA);
            PG8_WAIT_V(8); PG8_WAIT_L(0); PG8_BAR; PG8_MMA(1, 0, At, B0); PG8_MMA(1, 1, At, B1); PG8_BAR; PG8_SCHED;
            } else {
            PG8_LDB(B0, 0, 0); PG8_SCHED; PG8_LDA(At, 0, 0); PG8_STAGE(PG8_SA(1, 1), a1 + hstep, voffA);
            PG8_WAIT_L(8); PG8_BAR; PG8_WAIT_L(0); PG8_MMA(0, 0, At, B0); PG8_BAR; PG8_SCHED;
            PG8_LDB(B1, 0, 1); PG8_STAGE(PG8_SB(0, 0), b2, voffB);
            PG8_BAR; PG8_WAIT_L(0); PG8_MMA(0, 1, At, B1); PG8_BAR;
            PG8_LDA(At, 0, 1); PG8_STAGE(PG8_SA(0, 0), a2, voffA);
            PG8_BAR; PG8_WAIT_L(0); PG8_MMA(1, 0, At, B0); PG8_BAR; PG8_SCHED;
            PG8_STAGE(PG8_SB(0, 1), b2 + hstep, voffB);
            PG8_WAIT_V(6); PG8_BAR; PG8_MMA(1, 1, At, B1); PG8_BAR;
            PG8_LDB(B0, 1, 0); PG8_SCHED; PG8_LDA(At, 1, 0); PG8_STAGE(PG8_SA(0, 1), a2 + hstep, voffA);
            PG8_WAIT_L(8); PG8_BAR; PG8_WAIT_L(0); PG8_MMA(0, 0, At, B0); PG8_BAR; PG8_SCHED;
            PG8_LDB(B1, 1, 1); PG8_STAGE(PG8_SB(1, 0), b3, voffB);
            PG8_BAR; PG8_WAIT_L(0); PG8_MMA(0, 1, At, B1); PG8_BAR;
            PG8_LDA(At, 1, 1); PG8_STAGE(PG8_SA(1, 0), a3, voffA);
            PG8_BAR; PG8_WAIT_L(0); PG8_MMA(1, 0, At, B0); PG8_BAR; PG8_SCHED;
            PG8_STAGE(PG8_SB(1, 1), b3 + hstep, voffB);
            PG8_WAIT_V(6); PG8_BAR; PG8_MMA(1, 1, At, B1); PG8_BAR;
            }
        }
        if constexpr (ALIGN_EPI) { if (wr == 0) PG8_BAR; }
        E(acc, cur, wr, wc, fr, fq);
        if (!has_next) break;
#pragma unroll
        for (int a = 0; a < 2; ++a)
#pragma unroll
            for (int b = 0; b < 2; ++b)
#pragma unroll
                for (int m = 0; m < 4; ++m)
#pragma unroll
                    for (int n = 0; n < 2; ++n) acc[a][b][m][n] = (f32x4){0.f, 0.f, 0.f, 0.f};
        cur = nxt; cA = nA; cB = nB; ++ui;
        if constexpr (ALIGN_EPI) { if (wr == 1) PG8_BAR; }
    }
    PG8_WAIT_V(0);
    if constexpr (!ALIGN_EPI) { if (wr == 0) PG8_BAR; }
    PG8_BAR;
#undef PG8_SA
#undef PG8_SB
#undef PG8_STAGE
#undef PG8_LDA
#undef PG8_LDB
#undef PG8_MMA
#undef PG8_WAIT_V
#undef PG8_WAIT_L
#undef PG8_BAR
#undef PG8_SCHED
}
}

constexpr int D = 1024, NB = 8, LX = 4096, LCX = 256, NIN = 4608, DA = 512, DB = 512, HD = 128;
constexpr int MLAT = NB * LX, MCTX = NB * LCX, MTOK = MLAT + MCTX;
constexpr int PA_LD = 3072;
constexpr int FZ = 8448, FZC = 640;
constexpr float EPS = 1e-6f;
constexpr float HY_MIN_DECAY = -3.0701134573253944f, HY_MAX_DECAY = -15.350567286626972f;
constexpr int NWAVES = 8, NTHR = 512;

constexpr size_t MiB = 1u << 20;
constexpr size_t WS_CTL = 0, CTL_ZERO_BYTES = 1 * MiB;
constexpr size_t WS_MOD = 1 * MiB;
constexpr size_t WS_LBS = WS_MOD + 256 * 1024;
constexpr size_t WS_WIN = 6 * MiB;
constexpr size_t WS_WOUT = 24 * MiB;
constexpr size_t WS_FG = 28 * MiB;
constexpr size_t WS_FGC = 45 * MiB;
constexpr size_t WS_CTX1 = 46 * MiB;
constexpr size_t WS_OC = 2 * MiB;
constexpr size_t WS_XA = 54 * MiB;
constexpr size_t WS_PA = 122 * MiB;
constexpr size_t WS_PB = 326 * MiB;
constexpr size_t WS_OBT = 462 * MiB;
constexpr size_t WS_HK = 326 * MiB;
constexpr size_t WS_SCL = 496 * MiB;
constexpr size_t WS_END = 504 * MiB;
constexpr int CW_NORM = 1024;
constexpr int CW_BAR = 8192;
constexpr int CW_QUEUE = 4096;

constexpr int LDS_BYTES = 156 * 1024;
#define LAS __attribute__((address_space(3)))
#define GAS __attribute__((address_space(1)))
typedef unsigned short bf16;
typedef unsigned v4u __attribute__((ext_vector_type(4)));
typedef unsigned v2u __attribute__((ext_vector_type(2)));
typedef float f32x4 __attribute__((ext_vector_type(4)));

typedef __bf16 bf2_t __attribute__((ext_vector_type(2)));
typedef float f2_t __attribute__((ext_vector_type(2)));
__device__ __forceinline__ unsigned pk2(float lo, float hi) { const f2_t v = {lo, hi}; return __builtin_bit_cast(unsigned, __builtin_convertvector(v, bf2_t)); }
__device__ __forceinline__ unsigned f2bf(float f) { return pk2(f, 0.f) & 0xffffu; }
__device__ __forceinline__ float bf2f(unsigned short h) { return __builtin_bit_cast(float, (unsigned)h << 16); }
__device__ __forceinline__ unsigned f2h(float f) { _Float16 h = (_Float16)f; return (unsigned)__builtin_bit_cast(unsigned short, h); }
__device__ __forceinline__ unsigned pk2h(float lo, float hi) { return f2h(lo) | (f2h(hi) << 16); }
__device__ __forceinline__ float h2f(unsigned short u) { return (float)__builtin_bit_cast(_Float16, u); }
__device__ __forceinline__ float silu_f(float x) { return x * __builtin_amdgcn_rcpf(1.0f + __expf(-x)); }
__device__ __forceinline__ float sigmoid_f(float x) { return __builtin_amdgcn_rcpf(1.0f + __expf(-x)); }
__device__ __forceinline__ float wave_sum(float v) {
#pragma unroll
    for (int o = 1; o < 64; o <<= 1) v += __shfl_xor(v, o);
    return v;
}


#define PSTAMP_(lds_, k_) do { if (threadIdx.x == 0) ((volatile LAS unsigned long long*)((lds_) + LDS_BYTES - 512))[(k_)] = __builtin_amdgcn_s_memrealtime(); } while (0)
#if defined(PROBE_ID) && PROBE_ID >= 216 && PROBE_ID < 220
#define PSTAMP_H(lds_, k_) PSTAMP_(lds_, k_)
#else
#define PSTAMP_H(lds_, k_) do { } while (0)
#endif
#if defined(PROBE_ID) && PROBE_ID >= 226 && PROBE_ID < 230
#define PSTAMP_P(lds_, k_) PSTAMP_(lds_, k_)
#else
#define PSTAMP_P(lds_, k_) do { } while (0)
#endif
#if defined(PROBE_ID) && PROBE_ID >= 220 && PROBE_ID < 226
#define PSTAMP_S(lds_, k_) PSTAMP_(lds_, k_)
#else
#define PSTAMP_S(lds_, k_) do { } while (0)
#endif
typedef GAS unsigned gu32;
#define XB_TMO      128
#define XB_XCNT(j)  (256  + 64 * (j))
#define XB_XSUB(j)  (1280 + 64 * (j))
#define XB_XGEN(j)  (2304 + 64 * (j))
#define XB_TOP      3328
#define XB_TOPGEN   3392
#define XCD_BAR_WORDS 3456
#define XB_SPIN_CAP (1u << 18)
__device__ __forceinline__ unsigned xb_ld(unsigned* p)              { return __hip_atomic_load(p, __ATOMIC_RELAXED, __HIP_MEMORY_SCOPE_AGENT); }
__device__ __forceinline__ unsigned xb_add(unsigned* p, unsigned v) { return __hip_atomic_fetch_add(p, v, __ATOMIC_RELAXED, __HIP_MEMORY_SCOPE_AGENT); }
__device__ __forceinline__ unsigned xb_xcc_id() { return (unsigned)__builtin_amdgcn_s_getreg((3 << 11) | 20) & 0xFu; }
#define XB_SPIN(cond, bar) do { unsigned _sp = 0; while (cond) { __builtin_amdgcn_s_sleep(1); \
    if ((++_sp & 255u) == 0u) { if (xb_ld(&(bar)[XB_TMO])) break; if (_sp > XB_SPIN_CAP) { atomicAdd(&(bar)[XB_TMO], 1u); break; } } } } while (0)
struct XcdBarrier { unsigned* bar; unsigned x; volatile LAS unsigned* st; };
__device__ __forceinline__ XcdBarrier xcd_barrier_post(unsigned* bar, volatile LAS unsigned* st) {
    XcdBarrier b; b.bar = bar; b.x = xb_xcc_id(); b.st = st;
    if (threadIdx.x == 0) (void)xb_add(&bar[XB_XCNT(b.x)], 1u);
    return b;
}
__device__ __forceinline__ void xcd_barrier_complete(unsigned* bar, unsigned x, unsigned& nloc, unsigned& nx) {
    const unsigned G = gridDim.x * gridDim.y * gridDim.z;
    unsigned sum, cnt, mine, sp = 0u;
    for (;;) {
        sum = 0u; cnt = 0u; mine = 0u;
#pragma unroll
        for (unsigned j = 0; j < 16; ++j) { const unsigned c = xb_ld(&bar[XB_XCNT(j)]); sum += c; cnt += (c > 0u) ? 1u : 0u; mine = (j == x) ? c : mine; }
        if (sum == G) break;
        __builtin_amdgcn_s_sleep(1);
        if ((++sp & 255u) == 0u) { if (xb_ld(&bar[XB_TMO])) break; if (sp > XB_SPIN_CAP) { atomicAdd(&bar[XB_TMO], 1u); break; } }
    }
    nloc = mine > 0u ? mine : 1u; nx = cnt > 0u ? cnt : 1u;
}
__device__ __forceinline__ void xcd_barrier(const XcdBarrier& b) {
    asm volatile("s_waitcnt vmcnt(0)" ::: "memory");
    __syncthreads();
    if (threadIdx.x == 0) {
        unsigned* bar = b.bar;
        __builtin_amdgcn_s_waitcnt(0);
        unsigned nloc = b.st[0], nx = b.st[1];
        if (nloc == 0u) { xcd_barrier_complete(bar, b.x, nloc, nx); b.st[0] = nloc; b.st[1] = nx; }
        const unsigned old = xb_add(&bar[XB_XSUB(b.x)], 1u);
        const unsigned gen = old / nloc;
        if (old + 1u == (gen + 1u) * nloc) {
            __builtin_amdgcn_fence(__ATOMIC_RELEASE, "agent");
            asm volatile("s_waitcnt vmcnt(0)" ::: "memory");
            const unsigned og = xb_add(&bar[XB_TOP], 1u);
            const unsigned tg = og / nx;
            if (og + 1u == (tg + 1u) * nx) xb_add(&bar[XB_TOPGEN], 1u);
            else XB_SPIN(xb_ld(&bar[XB_TOPGEN]) == tg, bar);
            __builtin_amdgcn_fence(__ATOMIC_ACQUIRE, "agent");
            xb_add(&bar[XB_XGEN(b.x)], 1u);
            asm volatile("s_waitcnt vmcnt(0)" ::: "memory");
        } else {
            XB_SPIN(xb_ld(&bar[XB_XGEN(b.x)]) == gen, bar);
            __builtin_amdgcn_fence(__ATOMIC_ACQUIRE, "agent");
            asm volatile("s_waitcnt vmcnt(0)" ::: "memory");
        }
    }
    __syncthreads();
}

struct EpiIn {
    static constexpr bool PERM = true;
    bf16* PA; bf16* PB; const float* lb;
    __device__ __forceinline__ bool swap(const pg8::Unit& u) const { return u.pn >= 10; }
    __device__ __forceinline__ void operator()(const f32x4 (&acc)[2][2][4][2], const pg8::Unit& u, int wr, int wc, int fr, int fq) const {
        if (u.pn < 10) {
            const int type = u.pn >> 1;
            const int row0 = u.pm * 256 + wr * 64 + fr, col0 = u.pn * 256 + wc * 32 + 8 * fq;
#pragma unroll
            for (int bj = 0; bj < 2; ++bj) {
                float lbv[8];
#pragma unroll
                for (int e = 0; e < 8; ++e) lbv[e] = (type == 1 || type == 2) ? lb[col0 + bj * 128 + e - 512] : 0.f;
#pragma unroll
                for (int ai = 0; ai < 2; ++ai)
#pragma unroll
                    for (int m = 0; m < 4; ++m) {
                        bf16* rowp = PA + (size_t)(row0 + ai * 128 + m * 16) * PA_LD + col0 + bj * 128;
                        float x[8];
#pragma unroll
                        for (int e = 0; e < 4; ++e) { x[e] = acc[ai][bj][m][0][e]; x[4 + e] = acc[ai][bj][m][1][e]; }
                        v4u w;
                        if (type == 0) {
#pragma unroll
                            for (int e = 0; e < 8; ++e) x[e] = silu_f(x[e]);
                            w.x = pk2(x[0], x[1]); w.y = pk2(x[2], x[3]); w.z = pk2(x[4], x[5]); w.w = pk2(x[6], x[7]);
                        } else if (type == 1 || type == 2) {
#pragma unroll
                            for (int e = 0; e < 8; ++e) x[e] = lbv[e] + (1.0f - lbv[e]) * sigmoid_f(x[e]);
                            w.x = pk2h(x[0], x[1]); w.y = pk2h(x[2], x[3]); w.z = pk2h(x[4], x[5]); w.w = pk2h(x[6], x[7]);
                        } else {
                            w.x = pk2(x[0], x[1]); w.y = pk2(x[2], x[3]); w.z = pk2(x[4], x[5]); w.w = pk2(x[6], x[7]);
                        }
                        *(v4u*)rowp = w;
                        asm volatile("" ::: "memory");
                    }
            }
        } else {
#pragma unroll
            for (int ai = 0; ai < 2; ++ai)
#pragma unroll
                for (int m = 0; m < 4; ++m) {
                    const int cw = u.pn * 256 + ai * 128 + wr * 64 + m * 16 + fr;
                    bf16* colp = PB + (size_t)(cw - 2560) * MTOK + u.pm * 256 + wc * 32 + 8 * fq;
#pragma unroll
                    for (int bj = 0; bj < 2; ++bj) {
                        const f32x4 v0 = acc[ai][bj][m][0], v1 = acc[ai][bj][m][1];
                        v4u w; w.x = pk2(v0[0], v0[1]); w.y = pk2(v0[2], v0[3]); w.z = pk2(v1[0], v1[1]); w.w = pk2(v1[2], v1[3]);
                        *(v4u*)(colp + bj * 128) = w;
                    }
                }
        }
    }
};
struct EpiOut {
    static constexpr bool PERM = true;
    bf16* DL; const float* mod;
    __device__ __forceinline__ bool swap(const pg8::Unit&) const { return false; }
    __device__ __forceinline__ void operator()(const f32x4 (&acc)[2][2][4][2], const pg8::Unit& u, int wr, int wc, int fr, int fq) const {
        const int mr = u.pm >= 128 ? 8 : (u.pm >> 4);
        const int col0 = u.pn * 256 + wc * 32 + 8 * fq;
        f32x4 g0[2], g1[2];
#pragma unroll
        for (int bj = 0; bj < 2; ++bj) { const float* gt = mod + (size_t)mr * 3 * D + 2 * D + col0 + bj * 128; g0[bj] = *(const f32x4*)gt; g1[bj] = *(const f32x4*)(gt + 4); }
#pragma unroll
        for (int ai = 0; ai < 2; ++ai)
#pragma unroll
            for (int m = 0; m < 4; ++m) {
                bf16* rowp = DL + (size_t)(u.pm * 256 + ai * 128 + wr * 64 + m * 16 + fr) * D + col0;
#pragma unroll
                for (int bj = 0; bj < 2; ++bj) {
                    const f32x4 v0 = acc[ai][bj][m][0] * g0[bj], v1 = acc[ai][bj][m][1] * g1[bj];
                    v4u w; w.x = pk2(v0[0], v0[1]); w.y = pk2(v0[2], v0[3]); w.z = pk2(v1[0], v1[1]); w.w = pk2(v1[2], v1[3]);
                    *(v4u*)(rowp + bj * 128) = w;
                }
            }
    }
};

struct Args {
    const float* in[23]; float* out; unsigned char* ws; int ph_lo, ph_hi;
};

struct Frame {
    LAS unsigned char* lds; int tid, lane, wave, vcu, G;
};

__device__ __forceinline__ void p0_transpose_item(const float* W, int K, int N, bf16* WT, LAS float* scr, int item, int lane) {
    const int nblk = N / 32, kb = item / nblk, nb = item % nblk, k0 = 64 * kb, n0 = 32 * nb;
    f32x4 v[8];
#pragma unroll
    for (int i = 0; i < 8; ++i) v[i] = *(const f32x4*)(W + (size_t)(k0 + 8 * i + (lane >> 3)) * N + n0 + 4 * (lane & 7));
#pragma unroll
    for (int i = 0; i < 8; ++i) { LAS float* d = scr + (8 * i + (lane >> 3)) * 33 + 4 * (lane & 7); d[0] = v[i][0]; d[1] = v[i][1]; d[2] = v[i][2]; d[3] = v[i][3]; }
    asm volatile("s_waitcnt lgkmcnt(0)" ::: "memory");
    const int c = lane & 7;
#pragma unroll
    for (int j = 0; j < 4; ++j) { const int n = (lane >> 3) + 8 * j; const LAS float* s = scr + (8 * c) * 33 + n;
        v4u o; o.x = pk2(s[0 * 33], s[1 * 33]); o.y = pk2(s[2 * 33], s[3 * 33]); o.z = pk2(s[4 * 33], s[5 * 33]); o.w = pk2(s[6 * 33], s[7 * 33]);
        *(v4u*)(WT + (size_t)(n0 + n) * K + k0 + 8 * c) = o; }
    asm volatile("s_waitcnt lgkmcnt(0)" ::: "memory");
}

__device__ __forceinline__ void filter_task(const Args& a, Frame& F, const int set, const int n0, int& cached_layer) {
    unsigned char* ws = a.ws;
    const int l = set == 1 ? 1 : 0, L = set == 2 ? 256 : 4096;
    LAS float* w1s = (LAS float*)F.lds;
    LAS float* w2s = w1s + 33 * 64;
    LAS float* w3s = w2s + 64 * 64;
    LAS float* bs = w3s + 64 * 64;
    LAS float* zs = bs + 256;
    LAS float* h3s = zs + 8 * 4 * 64;
    LAS unsigned short* tile = (LAS unsigned short*)(h3s + 32 * 64);
    if (cached_layer != l) {
        __syncthreads();
        for (int e = F.tid; e < 33 * 64; e += NTHR) w1s[e] = a.in[13][l * 33 * 64 + e];
        for (int e = F.tid; e < 4096; e += NTHR) { w2s[e] = a.in[16][l * 4096 + e]; w3s[e] = a.in[18][l * 4096 + e]; }
        if (F.tid < 64) { bs[F.tid] = a.in[14][l * 64 + F.tid]; bs[64 + F.tid] = a.in[17][l * 64 + F.tid]; bs[128 + F.tid] = a.in[19][l * 64 + F.tid]; bs[192 + F.tid] = a.in[15][l * 64 + F.tid]; }
        cached_layer = l;
        __syncthreads();
    }
    {
        const int j = F.lane; LAS float* zw = zs + F.wave * 256; const float fr = bs[192 + j];
#pragma unroll
        for (int p = 0; p < 4; ++p) {
            const int n = n0 + 4 * F.wave + p;
            float zv = 0.f;
            if (j == 0) zv = (float)n / (float)(L - 1);
            else if (j < 33) { const int i = (j - 1) & 15; const double f = 1e-4 + (double)i * ((15.0 - 1e-4) / 15.0); double rev = f * (double)n / (double)L; rev -= floor(rev);
                const float ang = (float)(rev * 6.283185307179586476925); zv = (j <= 16) ? __cosf(ang) : -__sinf(ang); }
            zw[p * 64 + j] = zv;
        }
        asm volatile("s_waitcnt lgkmcnt(0)" ::: "memory");
        float s4[4];
#pragma unroll
        for (int p = 0; p < 4; ++p) s4[p] = bs[j];
        for (int e = 0; e < 33; ++e) { const float wv = w1s[e * 64 + j];
#pragma unroll
            for (int p = 0; p < 4; ++p) s4[p] += zw[p * 64 + e] * wv; }
        asm volatile("s_waitcnt lgkmcnt(0)" ::: "memory");
#pragma unroll
        for (int p = 0; p < 4; ++p) zw[p * 64 + j] = __sinf(fr * s4[p]);
        asm volatile("s_waitcnt lgkmcnt(0)" ::: "memory");
#pragma unroll
        for (int p = 0; p < 4; ++p) s4[p] = bs[64 + j];
        for (int e = 0; e < 64; ++e) { const float wv = w2s[e * 64 + j];
#pragma unroll
            for (int p = 0; p < 4; ++p) s4[p] += zw[p * 64 + e] * wv; }
        asm volatile("s_waitcnt lgkmcnt(0)" ::: "memory");
#pragma unroll
        for (int p = 0; p < 4; ++p) zw[p * 64 + j] = __sinf(fr * s4[p]);
        asm volatile("s_waitcnt lgkmcnt(0)" ::: "memory");
#pragma unroll
        for (int p = 0; p < 4; ++p) s4[p] = bs[128 + j];
        for (int e = 0; e < 64; ++e) { const float wv = w3s[e * 64 + j];
#pragma unroll
            for (int p = 0; p < 4; ++p) s4[p] += zw[p * 64 + e] * wv; }
#pragma unroll
        for (int p = 0; p < 4; ++p) h3s[(4 * F.wave + p) * 64 + j] = __sinf(fr * s4[p]);
    }
    __syncthreads();
    {
        typedef short bf16x8_ __attribute__((ext_vector_type(8)));
        LAS unsigned char* hA = (LAS unsigned char*)(tile + 1024 * 34);
        LAS unsigned char* wB = hA + 32 * 144;
        const int l15 = F.lane & 15, q = F.lane >> 4;
        { const int p = F.tid >> 4, k4 = (F.tid & 15) * 4; const f32x4 hv = *(const LAS f32x4*)(h3s + p * 64 + k4);
          v2u hw; hw.x = pk2(hv[0], hv[1]); hw.y = pk2(hv[2], hv[3]); *(LAS v2u*)(hA + p * 144 + 2 * k4) = hw; }
        float* nrm = (float*)(ws + WS_CTL) + CW_NORM;
        const float* w4 = a.in[20] + (size_t)l * 64 * 1024;
        for (int ch = 0; ch < 8; ++ch) {
            __syncthreads();
            { const int n = F.tid & 127, kq = F.tid >> 7;
              float wv[2][8];
#pragma unroll
              for (int g2 = 0; g2 < 2; ++g2)
#pragma unroll
                  for (int e = 0; e < 8; ++e) wv[g2][e] = w4[(size_t)(16 * kq + 8 * g2 + e) * 1024 + 128 * ch + n];
#pragma unroll
              for (int g2 = 0; g2 < 2; ++g2) { v4u o; o.x = pk2(wv[g2][0], wv[g2][1]); o.y = pk2(wv[g2][2], wv[g2][3]); o.z = pk2(wv[g2][4], wv[g2][5]); o.w = pk2(wv[g2][6], wv[g2][7]);
                  *(LAS v4u*)(wB + n * 144 + (16 * kq + 8 * g2) * 2) = o; } }
            __syncthreads();
            {
                const int col = 128 * ch + 16 * F.wave + l15, c = col & 511;
                f32x4 acc[2];
#pragma unroll
                for (int mt = 0; mt < 2; ++mt) { acc[mt] = (f32x4){0.f, 0.f, 0.f, 0.f};
#pragma unroll
                    for (int ks = 0; ks < 2; ++ks)
                        acc[mt] = __builtin_amdgcn_mfma_f32_16x16x32_bf16(*(const LAS bf16x8_*)(hA + (16 * mt + l15) * 144 + (32 * ks + 8 * q) * 2), *(const LAS bf16x8_*)(wB + (16 * F.wave + l15) * 144 + (32 * ks + 8 * q) * 2), acc[mt], 0, 0, 0); }
                const float dl = fabsf(HY_MIN_DECAY + (float)c * ((HY_MAX_DECAY - HY_MIN_DECAY) / 511.0f));
                float ns = 0.f;
#pragma unroll
                for (int mt = 0; mt < 2; ++mt) {
                    float v4[4];
#pragma unroll
                    for (int r = 0; r < 4; ++r) { const int nn = n0 + 16 * mt + 4 * q + r; v4[r] = acc[mt][r] * __expf(-((float)nn / (float)(L - 1)) * dl); if (col < 512 || nn >= 1) ns += fabsf(v4[r]); }
                    *(LAS unsigned*)(tile + col * 34 + 16 * mt + 4 * q) = pk2(v4[0], v4[1]); *(LAS unsigned*)(tile + col * 34 + 16 * mt + 4 * q + 2) = pk2(v4[2], v4[3]);
                }
                ns += __shfl_xor(ns, 16); ns += __shfl_xor(ns, 32);
                if (q == 0) atomicAdd(&nrm[set * 512 + c], ns);
            }
        }
    }
    __syncthreads();
    {
        bf16* dst = set == 2 ? (bf16*)(ws + WS_FGC) : (bf16*)(ws + WS_FG) + (size_t)set * 512 * FZ;
        const int ld = set == 2 ? FZC : FZ;
        for (int e = F.tid; e < 1024 * 32; e += NTHR) {
            const int col = e >> 5, p = e & 31, c = col & 511, n = n0 + p;
            const unsigned short v = tile[col * 34 + p];
            if (col < 512) dst[(size_t)c * ld + (L - n)] = v;
            else if (n >= 1) dst[(size_t)c * ld + (L + n)] = v;
        }
        if (n0 == 0) {
            const int npad = ld - 2 * L;
            for (int e = F.tid; e < 512 * (npad + 1); e += NTHR) { const int c = e / (npad + 1), k = e % (npad + 1); dst[(size_t)c * ld + (k == 0 ? 0 : 2 * L + k - 1)] = 0; }
        }
    }
    __syncthreads();
}

__device__ __forceinline__ void phase_prologue(const Args& a, Frame& F) {
    unsigned char* ws = a.ws;
    if (F.vcu == 0) {
        float* lbs = (float*)(ws + WS_LBS);
        for (int i = F.tid; i < 1024; i += NTHR) {
            const float a0 = a.in[9][i], a1 = a.in[9][1024 + i];
            const float m = fmaxf(a0, a1), e0 = expf(a0 - m), e1 = expf(a1 - m);
            const float p0 = e0 / (e0 + e1), p1 = e1 / (e0 + e1);
            const float c0 = p0, c1 = p0 + p1;
            lbs[i] = c0 - c0; lbs[1024 + i] = c1 - c0;
        }
    }
    int cached_layer = -1;
    constexpr int I_IN = (D / 64) * (NIN / 32), I_OUT = (D / 64) * (D / 32), NTR = 2 * (I_IN + I_OUT) / 8;
    for (int t = F.vcu; t < NTR; t += F.G) {
        LAS float* scr = (LAS float*)(F.lds + 65536 + F.wave * 8704);
        int r = t * 8 + F.wave; const int l = r / (I_IN + I_OUT); r -= l * (I_IN + I_OUT);
        if (r < I_IN) p0_transpose_item(a.in[7] + (size_t)l * D * NIN, D, NIN, (bf16*)(ws + WS_WIN) + (size_t)l * NIN * D, scr, r, F.lane);
        else p0_transpose_item(a.in[8] + (size_t)l * D * D, D, D, (bf16*)(ws + WS_WOUT) + (size_t)l * D * D, scr, r - I_IN, F.lane);
    }
    __syncthreads();
    if (F.vcu >= 136 && F.vcu < 232) {
        const int task = F.vcu - 136;
        LAS float* sv = (LAS float*)(F.lds + 65536);
        LAS float* part = sv + 9 * 1024;
        const int l = task / 48, n0 = (task % 48) * 64;
        for (int e = F.tid; e < 9 * 1024; e += NTHR) { const int r = e >> 10, k = e & 1023; const float cv = r < 8 ? a.in[1][r * D + k] : a.in[3][k]; sv[e] = cv / (1.0f + expf(-cv)); }
        __syncthreads();
        float acc9[9];
#pragma unroll
        for (int r = 0; r < 9; ++r) acc9[r] = 0.f;
        const float* w = a.in[5] + (size_t)l * D * 3 * D + n0 + F.lane;
#pragma unroll 8
        for (int k = F.wave * 128; k < F.wave * 128 + 128; ++k) {
            const float wv = w[(size_t)k * 3 * D];
#pragma unroll
            for (int r = 0; r < 9; ++r) acc9[r] += sv[r * 1024 + k] * wv;
        }
#pragma unroll
        for (int r = 0; r < 9; ++r) part[(F.wave * 9 + r) * 64 + F.lane] = acc9[r];
        __syncthreads();
        for (int e = F.tid; e < 9 * 64; e += NTHR) {
            const int r = e >> 6, c = e & 63; float sum = 0.f;
#pragma unroll
            for (int w8 = 0; w8 < 8; ++w8) sum += part[(w8 * 9 + r) * 64 + c];
            ((float*)(ws + WS_MOD))[((size_t)l * 9 + r) * 3 * D + n0 + c] = sum + a.in[6][l * 3 * D + n0 + c];
        }
        __syncthreads();
    }
    if (F.vcu < 16) filter_task(a, F, 0, 32 * (112 + F.vcu), cached_layer);
    else if (F.vcu >= 128 && F.vcu < 136) filter_task(a, F, 2, 32 * (F.vcu - 128), cached_layer);
}
__device__ __forceinline__ void phase_filters_l0(const Args& a, Frame& F) {
    int cached_layer = -1; const int b = (int)blockIdx.x;
    if (b >= 144) filter_task(a, F, 0, 32 * (b - 144), cached_layer);
}
__device__ __forceinline__ void phase_filters_l1(const Args& a, Frame& F) {
    int cached_layer = -1; const int b = (int)blockIdx.x;
    if (b >= 32 && b < 160) filter_task(a, F, 1, 32 * (b - 32), cached_layer);
}

__device__ __forceinline__ void phase_normrows(const Args& a, Frame& F, int l, const float* xlat, const float* xctx) {
    unsigned char* ws = a.ws;
    const float* nw = a.in[4] + l * D;
    const float* mod = (const float*)(ws + WS_MOD) + (size_t)l * 9 * 3 * D;
    bf16* XA = (bf16*)(ws + WS_XA);
    const bf16* DL = (const bf16*)(ws + WS_PB);
    const int gw = F.vcu * NWAVES + F.wave, NGW = F.G * NWAVES;
    for (int tok = gw; tok < MTOK; tok += NGW) {
        const bool isctx = tok >= MLAT;
        const float* xr = isctx ? xctx + (size_t)(tok - MLAT) * D : xlat + (size_t)tok * D;
        const int mr = isctx ? 8 : (tok >> 12);
        const float* sh = mod + (size_t)mr * 3 * D; const float* sc = sh + D;
        f32x4 v[4]; float s = 0.f;
#pragma unroll
        for (int j = 0; j < 4; ++j) v[j] = *(const f32x4*)(xr + 256 * j + 4 * F.lane);
        if (l == 1) {
#pragma unroll
            for (int j = 0; j < 4; ++j) { const v2u dw = *(const v2u*)(DL + (size_t)tok * D + 256 * j + 4 * F.lane);
                v[j].x += bf2f((unsigned short)(dw.x & 0xffffu)); v[j].y += bf2f((unsigned short)(dw.x >> 16)); v[j].z += bf2f((unsigned short)(dw.y & 0xffffu)); v[j].w += bf2f((unsigned short)(dw.y >> 16)); }
            if (!isctx) {
#pragma unroll
                for (int j = 0; j < 4; ++j) *(f32x4*)(a.out + (size_t)tok * D + 256 * j + 4 * F.lane) = v[j];
            }
        }
#pragma unroll
        for (int j = 0; j < 4; ++j) s += (v[j].x * v[j].x + v[j].y * v[j].y) + (v[j].z * v[j].z + v[j].w * v[j].w);
        const float rstd = 1.0f / sqrtf(wave_sum(s) * (1.0f / D) + EPS);
#pragma unroll
        for (int j = 0; j < 4; ++j) {
            const int k = 256 * j + 4 * F.lane;
            const f32x4 w4 = *(const f32x4*)(nw + k), s4 = *(const f32x4*)(sc + k), h4 = *(const f32x4*)(sh + k);
            const f32x4 y = v[j] * rstd * w4 * (s4 + 1.0f) + h4;
            v2u o; o.x = pk2(y.x, y.y); o.y = pk2(y.z, y.w);
            *(v2u*)(XA + (size_t)tok * D + k) = o;
        }
    }
}


namespace scan {
typedef short bf16x8 __attribute__((ext_vector_type(8)));
typedef short bf16x4 __attribute__((ext_vector_type(4)));
constexpr int QI_RS = 264, KT_RS = 160;
constexpr int OFF_QI = 0, OFF_KI = 16896, OFF_KT = 33792, OFF_VT = 54272, OFF_SCL = 74752, SET_BYTES = 76288;
constexpr int OFF_SEG = 2 * SET_BYTES;
static_assert(OFF_SEG + 4096 <= LDS_BYTES - 512, "scan LDS");
#define MFMA16(a, b, c) __builtin_amdgcn_mfma_f32_16x16x32_bf16((a), (b), (c), 0, 0, 0)
__device__ __forceinline__ bf16x8 ld_perm(const LAS unsigned char* p) {
    const bf16x4 lo = *(const LAS bf16x4*)p, hi = *(const LAS bf16x4*)(p + 32);
    return __builtin_shufflevector(lo, hi, 0, 1, 2, 3, 4, 5, 6, 7);
}
__device__ __forceinline__ int tok_row(int g, int i, int b, int dir) {
    if (g < 4) { const int t = 64 * g + i; return MLAT + b * LCX + (dir ? (LCX - 1 - t) : t); }
    const int t = 64 * (g - 4) + i; return b * LX + (dir ? (LX - 1 - t) : t);
}
__device__ __forceinline__ void scan_unit(LAS unsigned char* lds, bf16* PA, bf16* OC, const int b, const int h, const int dir, const bool ctxunit) {
    int tid_ = threadIdx.x; asm volatile("" : "+v"(tid_));
    const int tid = tid_, lane = tid & 63, w = __builtin_amdgcn_readfirstlane(tid >> 6);
    const int l15 = lane & 15, q = lane >> 4;
    const int nchunk = ctxunit ? 4 : 68;
    if (w >= 4) {
        const int pw = w - 4, tg = lane >> 3, cq = lane & 7, ch0 = 32 * pw + 4 * cq;
        const bool hi = tg >= 4;
        LAS float* seg = (LAS float*)(lds + OFF_SEG + pw * 1024);
        v2u qA[8], fA[8], vA[8], qB[8], fB[8], vB[8];
#define SCAN_LOAD(g, Q_, F_, V_) do { _Pragma("unroll") for (int e = 0; e < 8; ++e) { const bf16* p_ = PA + (size_t)tok_row((g), 8 * tg + e, b, dir) * PA_LD + h * HD + ch0; \
            Q_[e] = *(const v2u*)p_; F_[e] = *(const v2u*)(p_ + 512 + dir * 512); V_[e] = *(const v2u*)(p_ + 1536); } } while (0)
#define SCAN_IMG(set_, Q_, F_, V_) do { LAS unsigned char* s_ = lds + (set_) * SET_BYTES; \
            f32x4 pr_ = (f32x4){1.f, 1.f, 1.f, 1.f}; \
            _Pragma("unroll") for (int e = 0; e < 8; ++e) { pr_[0] *= h2f((unsigned short)(F_[e].x & 0xffffu)); pr_[1] *= h2f((unsigned short)(F_[e].x >> 16)); pr_[2] *= h2f((unsigned short)(F_[e].y & 0xffffu)); pr_[3] *= h2f((unsigned short)(F_[e].y >> 16)); } \
            *(LAS f32x4*)(seg + tg * 32 + 4 * cq) = pr_; \
            asm volatile("s_waitcnt lgkmcnt(0)" ::: "memory"); \
            f32x4 T_[8]; _Pragma("unroll") for (int t2 = 0; t2 < 8; ++t2) T_[t2] = *(const LAS f32x4*)(seg + t2 * 32 + 4 * cq); \
            asm volatile("s_waitcnt lgkmcnt(0)" ::: "memory"); \
            const f32x4 gm_ = (T_[0] * T_[1]) * (T_[2] * T_[3]), gem_ = (T_[4] * T_[5]) * (T_[6] * T_[7]); \
            f32x4 mul_ = (f32x4){1.f, 1.f, 1.f, 1.f}; \
            _Pragma("unroll") for (int t2 = 1; t2 < 4; ++t2) if (!hi && t2 > tg) mul_ *= T_[t2]; \
            _Pragma("unroll") for (int t2 = 4; t2 < 7; ++t2) if (hi && t2 < tg) mul_ *= T_[t2]; \
            v2u qm_[8], km_[8]; \
            _Pragma("unroll") for (int d = 0; d < 4; ++d) { float f_[8], x_[8]; \
                _Pragma("unroll") for (int e = 0; e < 8; ++e) { const unsigned fw_ = (d & 2) ? F_[e].y : F_[e].x; f_[e] = h2f((unsigned short)((d & 1) ? (fw_ >> 16) : (fw_ & 0xffffu))); } \
                { float pp_ = mul_[d], ss_ = mul_[d]; float pf_[8], sf_[8]; \
                  _Pragma("unroll") for (int e = 0; e < 8; ++e) { pp_ *= f_[e]; pf_[e] = pp_; } \
                  _Pragma("unroll") for (int e = 7; e >= 0; --e) { sf_[e] = ss_; ss_ *= f_[e]; } \
                  _Pragma("unroll") for (int e = 0; e < 8; ++e) x_[e] = fmaxf(hi ? pf_[e] : sf_[e], 1e-30f); } \
                unsigned ke_[8]; \
                _Pragma("unroll") for (int e = 0; e < 8; ++e) { const unsigned qw_ = (d & 2) ? Q_[e].y : Q_[e].x; const float qv_ = bf2f((unsigned short)((d & 1) ? (qw_ >> 16) : (qw_ & 0xffffu))); \
                    const float kk_ = 1.0f - f_[e], r_ = __builtin_amdgcn_rcpf(x_[e]); \
                    const float Qm_ = hi ? qv_ * x_[e] : qv_ * r_, Km_ = hi ? kk_ * r_ : kk_ * x_[e]; \
                    const unsigned qb_ = f2bf(Qm_), kb_ = f2bf(Km_); ke_[e] = f2bf(Km_ * gem_[d]); \
                    if (d == 0) { qm_[e].x = qb_; km_[e].x = kb_; } else if (d == 1) { qm_[e].x |= qb_ << 16; km_[e].x |= kb_ << 16; } else if (d == 2) { qm_[e].y = qb_; km_[e].y = kb_; } else { qm_[e].y |= qb_ << 16; km_[e].y |= kb_ << 16; } } \
                v4u t_, u_; \
                _Pragma("unroll") for (int e = 0; e < 4; ++e) { t_[e] = ke_[2 * e] | (ke_[2 * e + 1] << 16); \
                    const unsigned va_ = (d & 2) ? V_[2 * e].y : V_[2 * e].x, vb_ = (d & 2) ? V_[2 * e + 1].y : V_[2 * e + 1].x; \
                    u_[e] = (d & 1) ? ((va_ >> 16) | (vb_ & 0xffff0000u)) : ((va_ & 0xffffu) | (vb_ << 16)); } \
                *(LAS v4u*)(s_ + OFF_KT + (ch0 + d) * KT_RS + 16 * (tg ^ cq)) = t_; *(LAS v4u*)(s_ + OFF_VT + (ch0 + d) * KT_RS + 16 * (tg ^ cq)) = u_; } \
            _Pragma("unroll") for (int e = 0; e < 8; ++e) { *(LAS v2u*)(s_ + OFF_QI + (8 * tg + e) * QI_RS + 2 * ch0) = qm_[e]; *(LAS v2u*)(s_ + OFF_KI + (8 * tg + e) * QI_RS + 2 * ch0) = km_[e]; } \
            if (tg == 0) { *(LAS f32x4*)(s_ + OFF_SCL + 4 * ch0) = gm_; *(LAS f32x4*)(s_ + OFF_SCL + 512 + 4 * ch0) = gm_ * gem_; } } while (0)
        const int last = nchunk - 1;
        SCAN_LOAD(0, qA, fA, vA);
        SCAN_LOAD(1, qB, fB, vB);
        SCAN_IMG(0, qA, fA, vA);
        SCAN_LOAD(2, qA, fA, vA);
        __syncthreads();
        for (int g = 0; g < nchunk; g += 2) {
            SCAN_IMG(1, qB, fB, vB);
            { const int gn = g + 3 < last ? g + 3 : last; SCAN_LOAD(gn, qB, fB, vB); }
            __syncthreads();
            SCAN_IMG(0, qA, fA, vA);
            { const int gn = g + 4 < last ? g + 4 : last; SCAN_LOAD(gn, qA, fA, vA); }
            __syncthreads();
        }
#undef SCAN_LOAD
#undef SCAN_IMG
    } else {
        f32x4 S[2][8];
#pragma unroll
        for (int c = 0; c < 2; ++c)
#pragma unroll
            for (int kt = 0; kt < 8; ++kt) S[c][kt] = (f32x4){0.f, 0.f, 0.f, 0.f};
        const int vc0 = 32 * w;
        if (!ctxunit) PSTAMP_S(lds, 20);
        __syncthreads();
        for (int g = 0; g < nchunk; ++g) {
            const bool do_o = ctxunit || g >= 4;
            const LAS unsigned char* cs = lds + (g & 1) * SET_BYTES;
            bf16x8 vt[2][2];
#pragma unroll
            for (int c = 0; c < 2; ++c) { const int r_ = vc0 + 8 * (l15 >> 2) + 4 * c + (l15 & 3), x_ = (r_ >> 2) & 7;
                vt[c][0] = *(const LAS bf16x8*)(cs + OFF_VT + r_ * KT_RS + 16 * (q ^ x_)); vt[c][1] = *(const LAS bf16x8*)(cs + OFF_VT + r_ * KT_RS + 16 * ((4 + q) ^ x_)); }
            if (do_o) {
                bf16x8 vp[2][2];
#pragma unroll
                for (int c = 0; c < 2; ++c) { const int r_ = vc0 + 8 * (l15 >> 2) + 4 * c + (l15 & 3), x_ = (r_ >> 2) & 7;
#pragma unroll
                    for (int js = 0; js < 2; ++js) { const int c1 = 4 * js + (q >> 1);
                        const bf16x4 lo = *(const LAS bf16x4*)(cs + OFF_VT + r_ * KT_RS + 16 * (c1 ^ x_) + 8 * (q & 1)), hi4 = *(const LAS bf16x4*)(cs + OFF_VT + r_ * KT_RS + 16 * ((c1 + 2) ^ x_) + 8 * (q & 1));
                        vp[c][js] = __builtin_shufflevector(lo, hi4, 0, 1, 2, 3, 4, 5, 6, 7); } }
                bf16x8 sf[2][4];
#pragma unroll
                for (int ks = 0; ks < 4; ++ks) {
                    const f32x4 m0 = *(const LAS f32x4*)(cs + OFF_SCL + (32 * ks + 4 * q) * 4), m1 = *(const LAS f32x4*)(cs + OFF_SCL + (32 * ks + 16 + 4 * q) * 4);
#pragma unroll
                    for (int c = 0; c < 2; ++c) { const f32x4 s0 = S[c][2 * ks] * m0, s1 = S[c][2 * ks + 1] * m1;
                        v4u pk; pk.x = pk2(s0[0], s0[1]); pk.y = pk2(s0[2], s0[3]); pk.z = pk2(s1[0], s1[1]); pk.w = pk2(s1[2], s1[3]); sf[c][ks] = __builtin_bit_cast(bf16x8, pk); }
                }
#pragma unroll
                for (int it = 0; it < 4; ++it) {
                    bf16x8 qf[4];
#pragma unroll
                    for (int ks = 0; ks < 4; ++ks) qf[ks] = ld_perm(cs + OFF_QI + (16 * it + l15) * QI_RS + (32 * ks + 4 * q) * 2);
                    f32x4 O0 = (f32x4){0.f, 0.f, 0.f, 0.f}, O1 = O0;
#pragma unroll
                    for (int ks = 0; ks < 4; ++ks) { O0 = MFMA16(sf[0][ks], qf[ks], O0); O1 = MFMA16(sf[1][ks], qf[ks], O1); }
                    unsigned pt[4][2];
#pragma unroll
                    for (int jt = 0; jt < 4; ++jt) {
                        if (jt <= it) {
                            f32x4 a4 = (f32x4){0.f, 0.f, 0.f, 0.f};
#pragma unroll
                            for (int ks = 0; ks < 4; ++ks) a4 = MFMA16(ld_perm(cs + OFF_KI + (16 * jt + l15) * QI_RS + (32 * ks + 4 * q) * 2), qf[ks], a4);
                            if (jt == it) {
#pragma unroll
                                for (int r = 0; r < 4; ++r) a4[r] = (4 * q + r <= l15) ? a4[r] : 0.f;
                            }
                            pt[jt][0] = pk2(a4[0], a4[1]); pt[jt][1] = pk2(a4[2], a4[3]);
                        } else { pt[jt][0] = 0u; pt[jt][1] = 0u; }
                    }
                    { v4u bw; bw.x = pt[0][0]; bw.y = pt[0][1]; bw.z = pt[1][0]; bw.w = pt[1][1]; const bf16x8 bb = __builtin_bit_cast(bf16x8, bw);
                      O0 = MFMA16(vp[0][0], bb, O0); O1 = MFMA16(vp[1][0], bb, O1); }
                    if (it >= 2) { v4u bw; bw.x = pt[2][0]; bw.y = pt[2][1]; bw.z = pt[3][0]; bw.w = pt[3][1]; const bf16x8 bb = __builtin_bit_cast(bf16x8, bw);
                      O0 = MFMA16(vp[0][1], bb, O0); O1 = MFMA16(vp[1][1], bb, O1); }
                    const int row = tok_row(g, 16 * it + l15, b, dir);
                    bf16* dst = (g < 4) ? OC + (size_t)dir * MCTX * 512 + (size_t)(row - MLAT) * 512 + h * HD + vc0 + 8 * q
                                        : PA + (size_t)row * PA_LD + 512 + dir * 512 + h * HD + vc0 + 8 * q;
                    v4u wv; wv.x = pk2(O0[0], O0[1]); wv.y = pk2(O0[2], O0[3]); wv.z = pk2(O1[0], O1[1]); wv.w = pk2(O1[2], O1[3]);
                    *(v4u*)dst = wv;
                }
            }
#pragma unroll
            for (int kt = 0; kt < 8; ++kt) {
                const f32x4 ge = *(const LAS f32x4*)(cs + OFF_SCL + 512 + (16 * kt + 4 * q) * 4);
                const int xk_ = (4 * kt + (l15 >> 2)) & 7;
                const bf16x8 k0 = *(const LAS bf16x8*)(cs + OFF_KT + (16 * kt + l15) * KT_RS + 16 * (q ^ xk_)), k1 = *(const LAS bf16x8*)(cs + OFF_KT + (16 * kt + l15) * KT_RS + 16 * ((4 + q) ^ xk_));
#pragma unroll
                for (int c = 0; c < 2; ++c) { f32x4 d4 = ge * S[c][kt]; d4 = MFMA16(k0, vt[c][0], d4); S[c][kt] = MFMA16(k1, vt[c][1], d4); }
            }
            __syncthreads();
        }
        if (!ctxunit) PSTAMP_S(lds, 21);
    }
}
}


namespace hy {
typedef short bf16x8 __attribute__((ext_vector_type(8)));
typedef short bf16x4 __attribute__((ext_vector_type(4)));
constexpr int CS = 16416;
constexpr int VPAD = 7;
constexpr int OFF_F = 0, OFF_V = 4 * CS, V_ROWS = (64 + VPAD + 7) * 8, LDS_END = OFF_V + V_ROWS * 128;
static_assert(LDS_END <= LDS_BYTES - 256, "hyena LDS");
struct ConvW { float x0[4], x1[4], v[4]; };
__device__ __forceinline__ ConvW load_convw(const Args& a, int l, int c) {
    const float* cw = a.in[11] + (size_t)l * 3 * 1536; const float* cb = a.in[12] + (size_t)l * 1536; ConvW r;
#pragma unroll
    for (int j = 0; j < 3; ++j) { r.x0[j] = cw[j * 1536 + c]; r.x1[j] = cw[j * 1536 + 512 + c]; r.v[j] = cw[j * 1536 + 1024 + c]; }
    r.x0[3] = cb[c]; r.x1[3] = cb[512 + c]; r.v[3] = cb[1024 + c];
    return r;
}
__device__ __forceinline__ void hyena_channel(LAS unsigned char* lds, const Args& a, const int l, const int c) {
    int tid_ = threadIdx.x; asm volatile("" : "+v"(tid_));
    const int tid = tid_, lane = tid & 63, w = __builtin_amdgcn_readfirstlane(tid >> 6), l15 = lane & 15, q = lane >> 4;
    unsigned char* ws = a.ws;
    const bf16* PB = (const bf16*)(ws + WS_PB);
    const bf16* x0r = PB + (size_t)c * MTOK; const bf16* x1r = PB + (size_t)(512 + c) * MTOK; const bf16* vr = PB + (size_t)(1024 + c) * MTOK; const bf16* gbr = PB + (size_t)(1536 + c) * MTOK;
    const ConvW cw = load_convw(a, l, c);
    PSTAMP_H(lds, 16);
    {
        const bf16* F = (const bf16*)(ws + WS_FG) + ((size_t)l * 512 + c) * FZ;
        for (int ch = tid; ch < 1024; ch += NTHR) {
            const v4u cur = *(const v4u*)(F + 8 * ch); v4u prev = *(const v4u*)(F + (ch > 0 ? 8 * ch - 8 : 0));
            if (ch == 0) prev = (v4u){0u, 0u, 0u, 0u};
            const unsigned W[8] = {prev.x, prev.y, prev.z, prev.w, cur.x, cur.y, cur.z, cur.w};
            v4u c1, c2, c3;
#pragma unroll
            for (int d = 0; d < 4; ++d) { c1[d] = (W[3 + d] >> 16) | (W[4 + d] << 16); c2[d] = W[3 + d]; c3[d] = (W[2 + d] >> 16) | (W[3 + d] << 16); }
            *(LAS v4u*)(lds + OFF_F + 0 * CS + 16 * ch) = cur;
            *(LAS v4u*)(lds + OFF_F + 1 * CS + 16 * ch) = c1;
            *(LAS v4u*)(lds + OFF_F + 2 * CS + 16 * ch) = c2;
            *(LAS v4u*)(lds + OFF_F + 3 * CS + 16 * ch) = c3;
        }
    }
    {
        for (int e = tid; e < VPAD * 8 * 32; e += NTHR) ((LAS unsigned*)(lds + OFF_V))[e] = 0u;
        for (int e = tid; e < 7 * 8 * 32; e += NTHR) ((LAS unsigned*)(lds + OFF_V + (64 + VPAD) * 8 * 128))[e] = 0u;
        for (int bt = 0; bt < 2; ++bt) {
            v4u vw[4], xw[4]; unsigned short hv[4][2], hx[4][2];
#pragma unroll
            for (int j = 0; j < 4; ++j) {
                const int e = tid + NTHR * (4 * bt + j), b = e >> 9, t0 = (e & 511) * 8;
                const size_t base = (size_t)b * LX + t0;
                const size_t bm = t0 > 0 ? base - 1 : base, bp = t0 + 8 < LX ? base + 8 : base;
                vw[j] = *(const v4u*)(vr + base); xw[j] = *(const v4u*)(x1r + base);
                hv[j][0] = vr[bm]; hv[j][1] = vr[bp]; hx[j][0] = x1r[bm]; hx[j][1] = x1r[bp];
            }
#pragma unroll
            for (int j = 0; j < 4; ++j) {
                const int e = tid + NTHR * (4 * bt + j), b = e >> 9, t0 = (e & 511) * 8, ab = t0 >> 6, ch = (t0 & 63) >> 3;
                float vv[10], xx[10];
                vv[0] = t0 > 0 ? bf2f(hv[j][0]) : 0.f; xx[0] = t0 > 0 ? bf2f(hx[j][0]) : 0.f;
                vv[9] = t0 + 8 < LX ? bf2f(hv[j][1]) : 0.f; xx[9] = t0 + 8 < LX ? bf2f(hx[j][1]) : 0.f;
#pragma unroll
                for (int d = 0; d < 4; ++d) { vv[1 + 2 * d] = bf2f((unsigned short)(vw[j][d] & 0xffffu)); vv[2 + 2 * d] = bf2f((unsigned short)(vw[j][d] >> 16));
                                              xx[1 + 2 * d] = bf2f((unsigned short)(xw[j][d] & 0xffffu)); xx[2 + 2 * d] = bf2f((unsigned short)(xw[j][d] >> 16)); }
                float p[8];
#pragma unroll
                for (int d = 0; d < 8; ++d) p[d] = (cw.v[3] + cw.v[0] * vv[d] + cw.v[1] * vv[d + 1] + cw.v[2] * vv[d + 2]) * (cw.x1[3] + cw.x1[0] * xx[d] + cw.x1[1] * xx[d + 1] + cw.x1[2] * xx[d + 2]);
                v4u o; o.x = pk2(p[0], p[1]); o.y = pk2(p[2], p[3]); o.z = pk2(p[4], p[5]); o.w = pk2(p[6], p[7]);
                const int R = (ab + VPAD) * 8 + b;
                *(LAS v4u*)(lds + OFF_V + R * 128 + 16 * (ch ^ ((R >> 1) & 7))) = o;
            }
        }
    }
    __syncthreads();
    PSTAMP_H(lds, 17);
    f32x4 acc[4][4];
#pragma unroll
    for (int mt = 0; mt < 4; ++mt)
#pragma unroll
        for (int nt = 0; nt < 4; ++nt) acc[mt][nt] = (f32x4){0.f, 0.f, 0.f, 0.f};
    {
        const LAS unsigned char* pa = lds + OFF_F + (l15 & 3) * CS + (4096 - 4 * (l15 >> 2) + 8 * q) * 2 - 96;
        const int rowl = (l15 >> 3) * 8 + (l15 & 7);
        const int cq = (q ^ (rowl >> 1)) & 7;
        const LAS unsigned char* vb0 = lds + OFF_V + rowl * 128 + (8 * w + VPAD) * 1024 + 16 * cq;
        const LAS unsigned char* vb1 = lds + OFF_V + rowl * 128 + (8 * w + VPAD) * 1024 + 16 * (cq ^ 4);
#define HY_LDA(An_, m_) do { const LAS unsigned char* p_ = pa - 128 * (m_); _Pragma("unroll") for (int mt = 0; mt < 4; ++mt) { \
            const bf16x4 lo_ = *(const LAS bf16x4*)(p_ + 32 * (3 - mt)), hi_ = *(const LAS bf16x4*)(p_ + 32 * (3 - mt) + 8); An_[mt] = __builtin_shufflevector(lo_, hi_, 0, 1, 2, 3, 4, 5, 6, 7); } } while (0)
#define HY_LDB(B_, m_, PAR_) do { const LAS unsigned char* p0_ = ((PAR_) ? vb1 : vb0) - 1024 * (m_); const LAS unsigned char* p1_ = ((PAR_) ? vb0 : vb1) - 1024 * (m_); \
            _Pragma("unroll") for (int nt = 0; nt < 4; ++nt) { B_[0][nt] = *(const LAS bf16x8*)(p0_ + 2048 * nt); B_[1][nt] = *(const LAS bf16x8*)(p1_ + 2048 * nt); } } while (0)
#define HY_MMA(An_, Ao0_, Ao1_, B_, m_) do { _Pragma("unroll") for (int nt = 0; nt < 4; ++nt) { const int a0_ = 8 * w + 2 * nt - (m_); if (a0_ + 1 >= 0 && a0_ <= 63) { \
            _Pragma("unroll") for (int mt = 0; mt < 4; ++mt) acc[mt][nt] = __builtin_amdgcn_mfma_f32_16x16x32_bf16(An_[mt], B_[0][nt], acc[mt][nt], 0, 0, 0); \
            acc[0][nt] = __builtin_amdgcn_mfma_f32_16x16x32_bf16(Ao0_, B_[1][nt], acc[0][nt], 0, 0, 0); acc[1][nt] = __builtin_amdgcn_mfma_f32_16x16x32_bf16(Ao1_, B_[1][nt], acc[1][nt], 0, 0, 0); \
            acc[2][nt] = __builtin_amdgcn_mfma_f32_16x16x32_bf16(An_[0], B_[1][nt], acc[2][nt], 0, 0, 0); acc[3][nt] = __builtin_amdgcn_mfma_f32_16x16x32_bf16(An_[1], B_[1][nt], acc[3][nt], 0, 0, 0); } } } while (0)
        bf16x8 Aa[4], Ab[4], Ba[2][4], Bb[2][4], o0, o1;
        const int m0 = 8 * w - 63, mlast = 8 * w + 7;
        { bf16x8 t_[4]; HY_LDA(t_, m0 - 1); o0 = t_[2]; o1 = t_[3]; }
        HY_LDA(Aa, m0); HY_LDB(Ba, m0, 0);
        for (int m = m0; m < mlast; m += 2) {
            HY_LDA(Ab, m + 1); HY_LDB(Bb, m + 1, 1);
            HY_MMA(Aa, o0, o1, Ba, m);
            o0 = Aa[2]; o1 = Aa[3];
            HY_LDA(Aa, m + 2); HY_LDB(Ba, m + 2, 0);
            HY_MMA(Ab, o0, o1, Bb, m + 1);
            o0 = Ab[2]; o1 = Ab[3];
        }
        HY_MMA(Aa, o0, o1, Ba, mlast);
#undef HY_LDA
#undef HY_LDB
#undef HY_MMA
    }
    PSTAMP_H(lds, 18);
    __syncthreads();
    {
        constexpr int YRS = 8208;
        const float inn = 1.0f / ((const float*)(ws + WS_CTL))[CW_NORM + l * 512 + c], hb = a.in[21][l * 512 + c];
        const int b = l15 & 7;
#pragma unroll
        for (int nt = 0; nt < 4; ++nt) {
            const int ab = 8 * w + 2 * nt + (l15 >> 3), R = (ab + VPAD) * 8 + b;
#pragma unroll
            for (int mt = 0; mt < 4; ++mt) {
                const int t = 64 * ab + 16 * mt + 4 * q;
                const v2u vw = *(const LAS v2u*)(lds + OFF_V + R * 128 + 16 * ((2 * mt + (q >> 1)) ^ ((R >> 1) & 7)) + 8 * (q & 1));
                const float y0 = acc[mt][nt][0] * inn + bf2f((unsigned short)(vw.x & 0xffffu)) * hb, y1 = acc[mt][nt][1] * inn + bf2f((unsigned short)(vw.x >> 16)) * hb;
                const float y2 = acc[mt][nt][2] * inn + bf2f((unsigned short)(vw.y & 0xffffu)) * hb, y3 = acc[mt][nt][3] * inn + bf2f((unsigned short)(vw.y >> 16)) * hb;
                v2u yw; yw.x = pk2(y0, y1); yw.y = pk2(y2, y3);
                *(LAS v2u*)(lds + OFF_F + b * YRS + 2 * t) = yw;
            }
        }
        __syncthreads();
        bf16* OBT = (bf16*)(ws + WS_OBT) + (size_t)c * MTOK;
        int tid2 = tid; asm volatile("" : "+v"(tid2));
        for (int bt = 0; bt < 4; ++bt) {
            v4u xw[2], gw[2]; unsigned short hx[2][2];
#pragma unroll
            for (int j = 0; j < 2; ++j) {
                const int e = tid2 + NTHR * (2 * bt + j), bb = e >> 9, t0 = (e & 511) * 8;
                const size_t base = (size_t)bb * LX + t0;
                xw[j] = *(const v4u*)(x0r + base); gw[j] = *(const v4u*)(gbr + base);
                hx[j][0] = x0r[t0 > 0 ? base - 1 : base]; hx[j][1] = x0r[t0 + 8 < LX ? base + 8 : base];
            }
#pragma unroll
            for (int j = 0; j < 2; ++j) {
                const int e = tid2 + NTHR * (2 * bt + j), bb = e >> 9, t0 = (e & 511) * 8;
                const size_t base = (size_t)bb * LX + t0;
                const v4u yw = *(const LAS v4u*)(lds + OFF_F + bb * YRS + 2 * t0);
                float xs[10], o[8];
                xs[0] = t0 > 0 ? bf2f(hx[j][0]) : 0.f; xs[9] = t0 + 8 < LX ? bf2f(hx[j][1]) : 0.f;
#pragma unroll
                for (int d = 0; d < 4; ++d) { xs[1 + 2 * d] = bf2f((unsigned short)(xw[j][d] & 0xffffu)); xs[2 + 2 * d] = bf2f((unsigned short)(xw[j][d] >> 16)); }
#pragma unroll
                for (int d = 0; d < 8; ++d) {
                    const float yv = bf2f((unsigned short)((d & 1) ? (yw[d >> 1] >> 16) : (yw[d >> 1] & 0xffffu)));
                    const float gv = bf2f((unsigned short)((d & 1) ? (gw[j][d >> 1] >> 16) : (gw[j][d >> 1] & 0xffffu)));
                    o[d] = yv * (cw.x0[3] + cw.x0[0] * xs[d] + cw.x0[1] * xs[d + 1] + cw.x0[2] * xs[d + 2]) * silu_f(gv);
                }
                v4u ow; ow.x = pk2(o[0], o[1]); ow.y = pk2(o[2], o[3]); ow.z = pk2(o[4], o[5]); ow.w = pk2(o[6], o[7]);
                *(v4u*)(OBT + base) = ow;
            }
        }
    }
    PSTAMP_H(lds, 19);
    __syncthreads();
}
__device__ __forceinline__ void hyena_ctx_channel(LAS unsigned char* lds, const Args& a, const int c) {
    int tid_ = threadIdx.x; asm volatile("" : "+v"(tid_));
    const int tid = tid_;
    unsigned char* ws = a.ws;
    const bf16* PB = (const bf16*)(ws + WS_PB);
    const bf16* x0r = PB + (size_t)c * MTOK + MLAT; const bf16* x1r = PB + (size_t)(512 + c) * MTOK + MLAT; const bf16* vr = PB + (size_t)(1024 + c) * MTOK + MLAT; const bf16* gbr = PB + (size_t)(1536 + c) * MTOK + MLAT;
    const ConvW cw = load_convw(a, 0, c);
    LAS float* vvc = (LAS float*)lds;
    LAS float* Fc = vvc + 2048;
    for (int e = tid; e < 2048; e += NTHR) {
        const int t = e & 255;
        const float vm_ = bf2f(vr[t > 0 ? e - 1 : e]), v0 = bf2f(vr[e]), vp_ = bf2f(vr[t < 255 ? e + 1 : e]);
        const float xm_ = bf2f(x1r[t > 0 ? e - 1 : e]), x0 = bf2f(x1r[e]), xp_ = bf2f(x1r[t < 255 ? e + 1 : e]);
        const float vm = t > 0 ? vm_ : 0.f, vp = t < 255 ? vp_ : 0.f, xm = t > 0 ? xm_ : 0.f, xp = t < 255 ? xp_ : 0.f;
        vvc[e] = (cw.v[3] + cw.v[0] * vm + cw.v[1] * v0 + cw.v[2] * vp) * (cw.x1[3] + cw.x1[0] * xm + cw.x1[1] * x0 + cw.x1[2] * xp);
    }
    if (tid < 520) Fc[tid] = tid < 512 ? bf2f(((const bf16*)(ws + WS_FGC))[(size_t)c * FZC + tid]) : 0.f;
    __syncthreads();
    const float inn = 1.0f / ((const float*)(ws + WS_CTL))[CW_NORM + 2 * 512 + c], hb = a.in[21][c];
    bf16* OBT = (bf16*)(ws + WS_OBT) + (size_t)c * MTOK + MLAT;
    {
        const int b = tid >> 6, t0 = 4 * (tid & 63), e0 = b * 256 + t0;
        float acc4[4] = {0.f, 0.f, 0.f, 0.f};
        const LAS float* fp = Fc + 252 - t0;
        for (int s4 = 0; s4 < 64; ++s4) {
            const f32x4 ga = *(const LAS f32x4*)(fp + 4 * s4), gb = *(const LAS f32x4*)(fp + 4 * s4 + 4), vq = *(const LAS f32x4*)(vvc + b * 256 + 4 * s4);
            const float g[8] = {ga[0], ga[1], ga[2], ga[3], gb[0], gb[1], gb[2], gb[3]};
#pragma unroll
            for (int i = 0; i < 4; ++i)
#pragma unroll
                for (int u = 0; u < 4; ++u) acc4[i] += g[4 - i + u] * vq[u];
        }
        float xs[6], gv[4];
        xs[0] = t0 > 0 ? bf2f(x0r[e0 - 1]) : 0.f;
#pragma unroll
        for (int i = 0; i < 4; ++i) { xs[1 + i] = bf2f(x0r[e0 + i]); gv[i] = bf2f(gbr[e0 + i]); }
        xs[5] = t0 + 4 < 256 ? bf2f(x0r[e0 + 4]) : 0.f;
        float o[4];
#pragma unroll
        for (int i = 0; i < 4; ++i) o[i] = (acc4[i] * inn + vvc[e0 + i] * hb) * (cw.x0[3] + cw.x0[0] * xs[i] + cw.x0[1] * xs[i + 1] + cw.x0[2] * xs[i + 2]) * silu_f(gv[i]);
        v2u ow; ow.x = pk2(o[0], o[1]); ow.y = pk2(o[2], o[3]);
        *(v2u*)(OBT + e0) = ow;
    }
    __syncthreads();
}
}


__device__ __forceinline__ void phase_mix(const Args& a, Frame& F, const int l, const int part = -1) {
    unsigned* qctr = (unsigned*)(a.ws + WS_CTL) + CW_QUEUE + 64 * l + (part == 1 ? 128 : 0);
    volatile LAS int* slot = (volatile LAS int*)(F.lds + LDS_BYTES - 64);
    const int ntasks = l == 0 ? 64 + 512 + 64 + 512 : 64 + 512;
    for (;;) {
        if (F.tid == 0) slot[0] = (int)atomicAdd(qctr, 1u);
        __syncthreads();
        const int t = __builtin_amdgcn_readfirstlane(slot[0]);
        __syncthreads();
        if (t >= ntasks) break;
        if (part == 0 && !(t < 64 || (t >= 576 && t < 640))) continue;
        if (part == 1 && (t < 64 || (t >= 576 && t < 640))) continue;
        if (t < 64) scan::scan_unit(F.lds, (bf16*)(a.ws + WS_PA), (bf16*)(a.ws + WS_OC), t >> 3, (t >> 1) & 3, t & 1, false);
        else if (t < 576) hy::hyena_channel(F.lds, a, l, t - 64);
        else if (t < 640) { const int u = t - 576; scan::scan_unit(F.lds, (bf16*)(a.ws + WS_PA), (bf16*)(a.ws + WS_OC), u >> 3, (u >> 1) & 3, u & 1, true); }
        else hy::hyena_ctx_channel(F.lds, a, t - 640);
        __syncthreads();
    }
}

__device__ __forceinline__ void phase_finalize_ox(const Args& a, Frame& F, int l) {
    unsigned char* ws = a.ws;
    const bf16* PA = (const bf16*)(ws + WS_PA);
    const bf16* OC = (const bf16*)(ws + WS_OC);
    bf16* XA = (bf16*)(ws + WS_XA);
    const float* gnw = a.in[10] + l * 512;
    const int gw = F.vcu * NWAVES + F.wave, NGW = F.G * NWAVES;
    const int ntok = (l == 0) ? MTOK : MLAT;
    for (int tok = gw; tok < ntok; tok += NGW) {
        const bool isctx = tok >= MLAT;
        const int c8 = 8 * F.lane;
        const bf16* pf = isctx ? OC + (size_t)(tok - MLAT) * 512 + c8 : PA + (size_t)tok * PA_LD + 512 + c8;
        const bf16* pb = isctx ? OC + (size_t)MCTX * 512 + (size_t)(tok - MLAT) * 512 + c8 : PA + (size_t)tok * PA_LD + 1024 + c8;
        const v4u wf = *(const v4u*)pf, wb = *(const v4u*)pb, wg = *(const v4u*)(PA + (size_t)tok * PA_LD + 2048 + c8);
        float o[8], g[8];
#pragma unroll
        for (int e = 0; e < 4; ++e) {
            o[2 * e] = bf2f((unsigned short)(wf[e] & 0xffff)) + bf2f((unsigned short)(wb[e] & 0xffff));
            o[2 * e + 1] = bf2f((unsigned short)(wf[e] >> 16)) + bf2f((unsigned short)(wb[e] >> 16));
            g[2 * e] = bf2f((unsigned short)(wg[e] & 0xffff)); g[2 * e + 1] = bf2f((unsigned short)(wg[e] >> 16));
        }
        float s = 0.f;
#pragma unroll
        for (int e = 0; e < 8; ++e) s += o[e] * o[e];
        s += __shfl_xor(s, 1); s += __shfl_xor(s, 2); s += __shfl_xor(s, 4); s += __shfl_xor(s, 8);
        const float rstd = 1.0f / sqrtf(s * (1.0f / HD) + EPS);
        float y[8];
#pragma unroll
        for (int e = 0; e < 8; ++e) y[e] = o[e] * rstd * gnw[c8 + e] * silu_f(g[e]);
        v4u w; w.x = pk2(y[0], y[1]); w.y = pk2(y[2], y[3]); w.z = pk2(y[4], y[5]); w.w = pk2(y[6], y[7]);
        *(v4u*)(XA + (size_t)tok * D + c8) = w;
    }
    LAS unsigned short* t = (LAS unsigned short*)(F.lds + F.wave * 16384);
    const int ntt = ntok / 64;
    for (int it = gw; it < 8 * ntt; it += NGW) {
        const int ct = it / ntt, tt = it % ntt, c0 = ct * 64, t0 = tt * 64;
        const bf16* OBT = (const bf16*)(ws + WS_OBT);
#pragma unroll
        for (int i = 0; i < 8; ++i) {
            const int e = F.lane + 64 * i, c = e >> 3, ch = e & 7;
            const v4u w = *(const v4u*)(OBT + (size_t)(c0 + c) * MTOK + t0 + 8 * ch);
#pragma unroll
            for (int q = 0; q < 4; ++q) { t[c * 66 + 8 * ch + 2 * q] = (unsigned short)(w[q] & 0xffff); t[c * 66 + 8 * ch + 2 * q + 1] = (unsigned short)(w[q] >> 16); }
        }
        asm volatile("s_waitcnt lgkmcnt(0)" ::: "memory");
#pragma unroll
        for (int i = 0; i < 8; ++i) {
            const int e = F.lane + 64 * i, tk = e >> 3, cg = e & 7;
            unsigned short h[8];
#pragma unroll
            for (int q = 0; q < 8; ++q) h[q] = t[(8 * cg + q) * 66 + tk];
            v4u w; w.x = h[0] | ((unsigned)h[1] << 16); w.y = h[2] | ((unsigned)h[3] << 16); w.z = h[4] | ((unsigned)h[5] << 16); w.w = h[6] | ((unsigned)h[7] << 16);
            *(v4u*)(XA + (size_t)(t0 + tk) * D + 512 + c0 + 8 * cg) = w;
        }
        asm volatile("s_waitcnt lgkmcnt(0)" ::: "memory");
    }
}

__device__ __forceinline__ void phase_final_norm(const Args& a, Frame& F) {
    const float* w = a.in[22];
    const bf16* DL = (const bf16*)(a.ws + WS_PB);
    const int gw = F.vcu * NWAVES + F.wave, NGW = F.G * NWAVES;
    for (int tok = gw; tok < MLAT; tok += NGW) {
        float* xr = a.out + (size_t)tok * D;
        f32x4 v[4]; float s = 0.f;
#pragma unroll
        for (int j = 0; j < 4; ++j) { v[j] = *(const f32x4*)(xr + 256 * j + 4 * F.lane); const v2u dw = *(const v2u*)(DL + (size_t)tok * D + 256 * j + 4 * F.lane);
            v[j].x += bf2f((unsigned short)(dw.x & 0xffffu)); v[j].y += bf2f((unsigned short)(dw.x >> 16)); v[j].z += bf2f((unsigned short)(dw.y & 0xffffu)); v[j].w += bf2f((unsigned short)(dw.y >> 16));
            s += (v[j].x * v[j].x + v[j].y * v[j].y) + (v[j].z * v[j].z + v[j].w * v[j].w); }
        const float rstd = 1.0f / sqrtf(wave_sum(s) * (1.0f / D) + EPS);
#pragma unroll
        for (int j = 0; j < 4; ++j) { const f32x4 w4 = *(const f32x4*)(w + 256 * j + 4 * F.lane); *(f32x4*)(xr + 256 * j + 4 * F.lane) = v[j] * rstd * w4; }
    }
}

enum { PH_PRO = 0, PH_NORM0 = 1, PH_IN0 = 2, PH_MIX0 = 3, PH_FIN0 = 4, PH_OUT0 = 5, PH_NORM1 = 6, PH_IN1 = 7, PH_MIX1 = 8, PH_FIN1 = 9, PH_OUT1 = 10, PH_FINAL = 11 };

__device__ __forceinline__ Frame mkframe(unsigned char* lds) {
    Frame F;
    F.lds = (LAS unsigned char*)lds;
    F.tid = threadIdx.x; F.lane = F.tid & 63; F.wave = __builtin_amdgcn_readfirstlane(F.tid >> 6);
    F.G = gridDim.x; { const int bx = blockIdx.x; F.vcu = (F.G % 8 == 0) ? (bx % 8) * (F.G / 8) + bx / 8 : bx; }
    return F;
}
template <int l> __device__ __forceinline__ void run_inproj(const Args& args, unsigned char* lds) {
    unsigned char* ws = args.ws; Frame F = mkframe(lds);
    pg8::Gemm g{(const bf16*)(ws + WS_XA), (const bf16*)(ws + WS_WIN) + (size_t)l * NIN * D, D};
    pg8::Sched S; S.init(128, 18, F.G, (int)blockIdx.x, 8, l == 0 ? 18 : 8);
    EpiIn E{(bf16*)(ws + WS_PA), (bf16*)(ws + WS_PB), (const float*)(ws + WS_LBS) + l * 1024};
    pg8::gemm_phase<EpiIn, true, true>(F.lds, g, S, E);
}
template <int l> __device__ __forceinline__ void run_outproj(const Args& args, unsigned char* lds) {
    unsigned char* ws = args.ws; Frame F = mkframe(lds);
    pg8::Gemm g{(const bf16*)(ws + WS_XA), (const bf16*)(ws + WS_WOUT) + (size_t)l * D * D, D};
    pg8::Sched S; S.init(128, 4, F.G, (int)blockIdx.x, l == 0 ? 8 : 0, 4);
    EpiOut E{(bf16*)(ws + WS_PB), (const float*)(ws + WS_MOD) + (size_t)l * 9 * 3 * D};
    pg8::gemm_phase<EpiOut, true, true>(F.lds, g, S, E);
}
__global__ void __launch_bounds__(NTHR, 2) mega(Args args) {
    extern __shared__ __attribute__((aligned(16))) unsigned char lds[];
    const int lo = args.ph_lo, hi = args.ph_hi;
#define IN(k) (lo <= (k) && (k) < hi)
    volatile LAS unsigned* bst = (volatile LAS unsigned*)((LAS unsigned char*)lds + LDS_BYTES - 32);
    if (threadIdx.x < 8) ((volatile LAS unsigned*)((LAS unsigned char*)lds + LDS_BYTES - 32))[threadIdx.x] = 0u;
    __syncthreads();
    XcdBarrier bar; bar.bar = (unsigned*)(args.ws + WS_CTL) + CW_BAR; bar.x = 0; bar.st = bst;
    if (hi - lo > 1) bar = xcd_barrier_post((unsigned*)(args.ws + WS_CTL) + CW_BAR, bst);
#ifdef PROBE_ID
    volatile LAS unsigned long long* pts = (volatile LAS unsigned long long*)((LAS unsigned char*)lds + LDS_BYTES - 512);
    if (threadIdx.x == 0) pts[0] = __builtin_amdgcn_s_memrealtime();
#define SEAM(k) do { if (IN((k) + 1)) xcd_barrier(bar); else __syncthreads(); if (threadIdx.x == 0) pts[(k) + 1] = __builtin_amdgcn_s_memrealtime(); } while (0)
#else
#define SEAM(k) do { if (IN((k) + 1)) xcd_barrier(bar); else __syncthreads(); } while (0)
#endif
    if (IN(PH_PRO)) { Frame F = mkframe(lds); phase_prologue(args, F); SEAM(PH_PRO); }
    if (IN(PH_NORM0)) { Frame F = mkframe(lds); phase_normrows(args, F, 0, args.in[0], args.in[2]); SEAM(PH_NORM0); }
    if (IN(PH_IN0)) { run_inproj<0>(args, lds); { Frame F = mkframe(lds); phase_filters_l0(args, F); } SEAM(PH_IN0); }
#ifdef SPLIT_MIX
    if (IN(PH_MIX0)) { Frame F = mkframe(lds); phase_mix(args, F, 0, 0); xcd_barrier(bar); if (threadIdx.x == 0) pts[15] = __builtin_amdgcn_s_memrealtime(); phase_mix(args, F, 0, 1); SEAM(PH_MIX0); }
#else
    if (IN(PH_MIX0)) { Frame F = mkframe(lds); phase_mix(args, F, 0); SEAM(PH_MIX0); }
#endif
    if (IN(PH_FIN0)) { Frame F = mkframe(lds); phase_finalize_ox(args, F, 0); SEAM(PH_FIN0); }
    if (IN(PH_OUT0)) { run_outproj<0>(args, lds); { Frame F = mkframe(lds); phase_filters_l1(args, F); } SEAM(PH_OUT0); }
    if (IN(PH_NORM1)) { Frame F = mkframe(lds); phase_normrows(args, F, 1, args.in[0], args.in[2]); SEAM(PH_NORM1); }
    if (IN(PH_IN1)) { run_inproj<1>(args, lds); SEAM(PH_IN1); }
    if (IN(PH_MIX1)) { Frame F = mkframe(lds); phase_mix(args, F, 1); SEAM(PH_MIX1); }
    if (IN(PH_FIN1)) { Frame F = mkframe(lds); phase_finalize_ox(args, F, 1); SEAM(PH_FIN1); }
    if (IN(PH_OUT1)) { run_outproj<1>(args, lds); SEAM(PH_OUT1); }
    if (IN(PH_FINAL)) { Frame F = mkframe(lds); phase_final_norm(args, F); SEAM(PH_FINAL); }
#ifdef PROBE_ID
    if (blockIdx.x == 0 && threadIdx.x == 0) {
#ifdef SPLIT_MIX
        const unsigned long long dt = (PROBE_ID == 100) ? pts[15] - pts[PH_MIX0] : pts[PH_MIX0 + 1] - pts[15];
#else
        const unsigned long long dt = (PROBE_ID >= 200) ? ((PROBE_ID == 220 || PROBE_ID >= 226) ? 1ull : 16ull) * (pts[PROBE_ID - 200 + 1] - pts[PROBE_ID - 200]) : pts[PROBE_ID + 1] - pts[PROBE_ID];
#endif
        const unsigned long long t0 = __builtin_amdgcn_s_memrealtime();
        unsigned long long wt = 4ull * dt; if (wt > 300000ull) wt = 300000ull;
        while (__builtin_amdgcn_s_memrealtime() - t0 < wt) __builtin_amdgcn_s_sleep(8);
    }
#endif
#undef IN
#undef SEAM
}

extern "C" void kernel_launch(void* const* d_in, const int* in_sizes, int n_in, void* d_out, int out_size, void* d_ws, size_t ws_size, hipStream_t stream) {
    static int grid = 0;
    if (grid == 0) {
        if (n_in != 23 || ws_size < WS_END) { fprintf(stderr, "kernel_launch: unexpected n_in %d / ws_size %zu\n", n_in, ws_size); grid = -1; return; }
        int dev = 0, cus = 0;
        if (hipGetDevice(&dev) != hipSuccess || hipDeviceGetAttribute(&cus, hipDeviceAttributeMultiprocessorCount, dev) != hipSuccess) { grid = -1; return; }
        if (hipFuncSetAttribute((const void*)mega, hipFuncAttributeMaxDynamicSharedMemorySize, LDS_BYTES) != hipSuccess) { fprintf(stderr, "kernel_launch: hipFuncSetAttribute failed\n"); grid = -1; return; }
        grid = cus;
    }
    if (grid < 0) return;
    (void)hipMemsetAsync((char*)d_ws + WS_CTL, 0, CTL_ZERO_BYTES, stream);
    Args a{};
    for (int i = 0; i < 23; ++i) a.in[i] = (const float*)d_in[i];
    a.out = (float*)d_out; a.ws = (unsigned char*)d_ws;
    a.ph_lo = 0; a.ph_hi = PH_FINAL + 1;
    hipLaunchKernelGGL(mega, dim3(grid), dim3(NTHR), LDS_BYTES, stream, a);
}
```

```cpp
#include <hip/hip_runtime.h>
#include <cstdio>
#include <cstdint>
#include <math.h>

namespace pg8 {
#define PG8_LAS __attribute__((address_space(3)))
typedef unsigned short bf16_t;
typedef short bf16x8 __attribute__((ext_vector_type(8)));
typedef float f32x4 __attribute__((ext_vector_type(4)));
typedef unsigned u32x4 __attribute__((ext_vector_type(4)));
typedef unsigned u32x2 __attribute__((ext_vector_type(2)));
constexpr int BM = 256, BK = 64, HALF = 128, HTB = HALF * BK * 2, STAGE_BYTES = 8 * HTB, NXCD = 8, WGM = 8;

__host__ __device__ __forceinline__ int lds_byte(int r, int c) { const int st = (r >> 4) * 2 + (c >> 5), rr = r & 15, cc = c & 31, ob = rr * 64 + cc * 2; return st * 1024 + (ob ^ (((ob >> 9) & 1) << 5)); }
__host__ __device__ __forceinline__ void stage_rc(int b, int& R, int& C) { const int st = b / 1024, sb = b % 1024, swz = sb ^ (((sb >> 9) & 1) << 5); R = (st >> 1) * 16 + swz / 64; C = (st & 1) * 32 + (swz % 64) / 2; }
__host__ __device__ __forceinline__ int perm32(int rho) { const int n = rho >> 4, i = rho & 15; return 8 * (i >> 2) + 4 * n + (i & 3); }

struct Unit { int pm, pn; };
struct Gemm { const bf16_t* A; const bf16_t* Bt; int K; };

struct Sched {
    int nM, nN, nwg, G, c, nctx, nctxN;
    __device__ void init(int nM_, int nN_, int G_, int c_, int nctxM, int nctxN_) { nM = nM_; nN = nN_; nwg = nM * nN; G = G_; c = c_; nctx = nctxM * nctxN_; nctxN = nctxN_ > 0 ? nctxN_ : 1; }
    __device__ bool next(int i, Unit& u) const {
        const long L = (long)i * G + c;
        if (L >= nwg) { const long L2 = L - nwg; if (L2 >= nctx) return false; u.pm = nM + (int)(L2 / nctxN); u.pn = (int)(L2 % nctxN); return true; }
        int wgid = (int)L; { const int q = nwg / NXCD, r = nwg % NXCD, xcd = wgid % NXCD, off = wgid / NXCD; wgid = (xcd < r ? xcd * (q + 1) : r * (q + 1) + (xcd - r) * q) + off; }
        const int nig = WGM * nN, gid = wgid / nig, fm = gid * WGM, gsz = (nM - fm) < WGM ? (nM - fm) : WGM;
        u.pm = fm + ((wgid % nig) % gsz); u.pn = (wgid % nig) / gsz; return true;
    }
};

template <class Epi, bool ALIGN_EPI, bool SP2>
__device__ __forceinline__ void gemm_phase(PG8_LAS unsigned char* lds, const Gemm g, const Sched& S, const Epi& E) {
    const int tid = threadIdx.x, wid = __builtin_amdgcn_readfirstlane(tid >> 6), lane = tid & 63, wr = wid >> 2, wc = wid & 3, fr = lane & 15, fq = lane >> 4;
    const int K = g.K, nt = K / BK;
    unsigned voffA[2], voffB[2];
#pragma unroll
    for (int i = 0; i < 2; ++i) { int R, C; stage_rc(tid * 16 + i * 8192, R, C); const int Rb = Epi::PERM ? ((R & ~31) + perm32(R & 31)) : R;
        voffA[i] = (unsigned)(R * K + C) * 2u; voffB[i] = (unsigned)(Rb * K + C) * 2u; }
    const size_t kstep = (size_t)(BK * 2);
    const size_t hstep = (size_t)HALF * K * 2;
    const size_t tstep = 2 * hstep;
    const unsigned ldsw = (unsigned)wid * 1024u;
    const int aoff = lds_byte(wr * 64 + fr, fq * 8), boff = lds_byte(wc * 32 + fr, fq * 8);
#define PG8_SA(b, h) (((b) * 2 + (h)) * HTB)
#define PG8_SB(b, h) ((4 + (b) * 2 + (h)) * HTB)
#define PG8_STAGE(bufoff, gbase, voff) do { _Pragma("unroll") for (int _i = 0; _i < 2; ++_i) \
        __builtin_amdgcn_global_load_lds((const unsigned*)((const char*)(gbase) + (voff)[_i]), (PG8_LAS unsigned*)(lds + (bufoff) + ldsw + _i * 8192), 16, 0, 0); } while (0)
#define PG8_LDA(dst, b, h) do { _Pragma("unroll") for (int m = 0; m < 4; ++m) _Pragma("unroll") for (int k = 0; k < 2; ++k) dst[m][k] = *(const PG8_LAS bf16x8*)(lds + PG8_SA(b, h) + aoff + m * 2048 + k * 1024); } while (0)
#define PG8_LDB(dst, b, h) do { _Pragma("unroll") for (int n = 0; n < 2; ++n) _Pragma("unroll") for (int k = 0; k < 2; ++k) dst[n][k] = *(const PG8_LAS bf16x8*)(lds + PG8_SB(b, h) + boff + n * 2048 + k * 1024); } while (0)
#define PG8_MMA(ai, bj, At, Bt) do { __builtin_amdgcn_s_setprio(1); _Pragma("unroll") for (int m = 0; m < 4; ++m) _Pragma("unroll") for (int n = 0; n < 2; ++n) _Pragma("unroll") for (int k = 0; k < 2; ++k) \
        acc[ai][bj][m][n] = __builtin_amdgcn_mfma_f32_16x16x32_bf16(Bt[n][k], At[m][k], acc[ai][bj][m][n], 0, 0, 0); __builtin_amdgcn_s_setprio(0); } while (0)
#define PG8_WAIT_V(n) asm volatile("s_waitcnt vmcnt(" #n ")" ::: "memory")
#define PG8_WAIT_L(n) asm volatile("s_waitcnt lgkmcnt(" #n ")" ::: "memory")
#define PG8_BAR __builtin_amdgcn_s_barrier()
#define PG8_SCHED __builtin_amdgcn_sched_barrier(0)
    Unit cur, nxt; int ui = 0;
    if (!S.next(0, cur)) return;
    f32x4 acc[2][2][4][2];
#pragma unroll
    for (int a = 0; a < 2; ++a)
#pragma unroll
        for (int b = 0; b < 2; ++b)
#pragma unroll
            for (int m = 0; m < 4; ++m)
#pragma unroll
                for (int n = 0; n < 2; ++n) acc[a][b][m][n] = (f32x4){0.f, 0.f, 0.f, 0.f};
    bf16x8 At[4][2], B0[2][2], B1[2][2];
    const char* cA = E.swap(cur) ? (const char*)g.Bt + (size_t)cur.pn * tstep : (const char*)g.A + (size_t)cur.pm * tstep;
    const char* cB = E.swap(cur) ? (const char*)g.A + (size_t)cur.pm * tstep : (const char*)g.Bt + (size_t)cur.pn * tstep;
    if constexpr (SP2) {
        PG8_STAGE(PG8_SB(0, 0), cB, voffB); PG8_STAGE(PG8_SB(0, 1), cB + hstep, voffB); PG8_STAGE(PG8_SA(0, 0), cA, voffA); PG8_STAGE(PG8_SA(0, 1), cA + hstep, voffA);
        if (wr == 1) PG8_BAR;
        PG8_WAIT_V(2); PG8_BAR;
        PG8_STAGE(PG8_SB(1, 0), cB + kstep, voffB); PG8_STAGE(PG8_SA(1, 0), cA + kstep, voffA); PG8_STAGE(PG8_SB(1, 1), cB + hstep + kstep, voffB);
        PG8_WAIT_V(6); PG8_BAR;
    } else {
        PG8_STAGE(PG8_SB(0, 0), cB, voffB); PG8_STAGE(PG8_SA(0, 0), cA, voffA); PG8_STAGE(PG8_SB(0, 1), cB + hstep, voffB); PG8_STAGE(PG8_SA(0, 1), cA + hstep, voffA);
        if (wr == 1) PG8_BAR;
        PG8_WAIT_V(4); PG8_BAR;
        PG8_STAGE(PG8_SB(1, 0), cB + kstep, voffB); PG8_STAGE(PG8_SA(1, 0), cA + kstep, voffA); PG8_STAGE(PG8_SB(1, 1), cB + hstep + kstep, voffB);
        PG8_WAIT_V(6); PG8_BAR;
    }
    for (;;) {
        const bool has_next = S.next(ui + 1, nxt);
        const bool nsw = has_next && E.swap(nxt);
        const char* nA = has_next ? (nsw ? (const char*)g.Bt + (size_t)nxt.pn * tstep : (const char*)g.A + (size_t)nxt.pm * tstep) : cA;
        const char* nB = has_next ? (nsw ? (const char*)g.A + (size_t)nxt.pm * tstep : (const char*)g.Bt + (size_t)nxt.pn * tstep) : cB;
        for (int t = 0; t < nt; t += 2) {
            const bool last = (t == nt - 2);
            const char* a1 = cA + (size_t)(t + 1) * kstep;
            const char* a2 = last ? nA : cA + (size_t)(t + 2) * kstep; const char* b2 = last ? nB : cB + (size_t)(t + 2) * kstep;
            const char* a3 = a2 + kstep; const char* b3 = b2 + kstep;
            if constexpr (SP2) {
            PG8_LDB(B0, 0, 0); PG8_LDB(B1, 0, 1); PG8_SCHED; PG8_LDA(At, 0, 0); PG8_STAGE(PG8_SA(1, 1), a1 + hstep, voffA);
            PG8_WAIT_V(8); PG8_WAIT_L(0); PG8_BAR; PG8_MMA(0, 0, At, B0); PG8_MMA(0, 1, At, B1); PG8_BAR; PG8_SCHED;
            PG8_LDA(At, 0, 1); PG8_STAGE(PG8_SB(0, 0), b2, voffB); PG8_STAGE(PG8_SB(0, 1), b2 + hstep, voffB); PG8_STAGE(PG8_SA(0, 0), a2, voffA);
            PG8_WAIT_V(8); PG8_WAIT_L(0); PG8_BAR; PG8_MMA(1, 0, At, B0); PG8_MMA(1, 1, At, B1); PG8_BAR; PG8_SCHED;
            PG8_LDB(B0, 1, 0); PG8_LDB(B1, 1, 1); PG8_SCHED; PG8_LDA(At, 1, 0); PG8_STAGE(PG8_SA(0, 1), a2 + hstep, voffA);
            PG8_WAIT_V(8); PG8_WAIT_L(0); PG8_BAR; PG8_MMA(0, 0, At, B0); PG8_MMA(0, 1, At, B1); PG8_BAR; PG8_SCHED;
            PG8_LDA(At, 1, 1); PG8_STAGE(PG8_SB(1, 0), b3, voffB); PG8_STAGE(PG8_SB(1, 1), b3 + hstep, voffB); PG8_STAGE(PG8_SA(1, 0), a3, voffA);
            PG8_WAIT_V(8); PG8_WAIT_L(0); PG8_BAR; PG8_MMA(1, 0, At, B0); PG8_MMA(1, 1, At, B1); PG8_BAR; PG8_SCHED;
            } else {
            PG8_LDB(B0, 0, 0); PG8_SCHED; PG8_LDA(At, 0, 0); PG8_STAGE(PG8_SA(1, 1), a1 + hstep, voffA);
            PG8_WAIT_L(8); PG8_BAR; PG8_WAIT_L(0); PG8_MMA(0, 0, At, B0); PG8_BAR; PG8_SCHED;
            PG8_LDB(B1, 0, 1); PG8_STAGE(PG8_SB(0, 0), b2, voffB);
            PG8_BAR; PG8_WAIT_L(0); PG8_MMA(0, 1, At, B1); PG8_BAR;
            PG8_LDA(At, 0, 1); PG8_STAGE(PG8_SA(0, 0), a2, voffA);
            PG8_BAR; PG8_WAIT_L(0); PG8_MMA(1, 0, At, B0); PG8_BAR; PG8_SCHED;
            PG8_STAGE(PG8_SB(0, 1), b2 + hstep, voffB);
            PG8_WAIT_V(6); PG8_BAR; PG8_MMA(1, 1, At, B1); PG8_BAR;
            PG8_LDB(B0, 1, 0); PG8_SCHED; PG8_LDA(At, 1, 0); PG8_STAGE(PG8_SA(0, 1), a2 + hstep, voffA);
            PG8_WAIT_L(8); PG8_BAR; PG8_WAIT_L(0); PG8_MMA(0, 0, At, B0); PG8_BAR; PG8_SCHED;
            PG8_LDB(B1, 1, 1); PG8_STAGE(PG8_SB(1, 0), b3, voffB);
            PG8_BAR; PG8_WAIT_L(0); PG8_MMA(0, 1, At, B1); PG8_BAR;
            PG8_LDA(At, 1, 1); PG8_STAGE(PG8_SA(1, 0), a3, voffA);
            PG8_BAR; PG8_WAIT_L(0); PG8_MMA(1, 0, At, B0); PG8_BAR; PG8_SCHED;
            PG8_STAGE(PG8_SB(1, 1), b3 + hstep, voffB);
            PG8_WAIT_V(6); PG8_BAR; PG8_MMA(1, 1, At, B1); PG8_BAR;
            }
        }
        if constexpr (ALIGN_EPI) { if (wr == 0) PG8_BAR; }
        E(acc, cur, wr, wc, fr, fq);
        if (!has_next) break;
#pragma unroll
        for (int a = 0; a < 2; ++a)
#pragma unroll
            for (int b = 0; b < 2; ++b)
#pragma unroll
                for (int m = 0; m < 4; ++m)
#pragma unroll
                    for (int n = 0; n < 2; ++n) acc[a][b][m][n] = (f32x4){0.f, 0.f, 0.f, 0.f};
        cur = nxt; cA = nA; cB = nB; ++ui;
        if constexpr (ALIGN_EPI) { if (wr == 1) PG8_BAR; }
    }
    PG8_WAIT_V(0);
    if constexpr (!ALIGN_EPI) { if (wr == 0) PG8_BAR; }
    PG8_BAR;
#undef PG8_SA
#undef PG8_SB
#undef PG8_STAGE
#undef PG8_LDA
#undef PG8_LDB
#undef PG8_MMA
#undef PG8_WAIT_V
#undef PG8_WAIT_L
#undef PG8_BAR
#undef PG8_SCHED
}
}

constexpr int D = 1024, NB = 8, LX = 4096, LCX = 256, NIN = 4608, DA = 512, DB = 512, HD = 128;
constexpr int MLAT = NB * LX, MCTX = NB * LCX, MTOK = MLAT + MCTX;
constexpr int PA_LD = 3072;
constexpr int FZ = 8448, FZC = 640;
constexpr float EPS = 1e-6f;
constexpr float HY_MIN_DECAY = -3.0701134573253944f, HY_MAX_DECAY = -15.350567286626972f;
constexpr int NWAVES = 8, NTHR = 512;

constexpr size_t MiB = 1u << 20;
constexpr size_t WS_CTL = 0, CTL_ZERO_BYTES = 1 * MiB;
constexpr size_t WS_MOD = 1 * MiB;
constexpr size_t WS_LBS = WS_MOD + 256 * 1024;
constexpr size_t WS_WIN = 6 * MiB;
constexpr size_t WS_WOUT = 24 * MiB;
constexpr size_t WS_FG = 28 * MiB;
constexpr size_t WS_FGC = 45 * MiB;
constexpr size_t WS_CTX1 = 46 * MiB;
constexpr size_t WS_OC = 2 * MiB;
constexpr size_t WS_XA = 54 * MiB;
constexpr size_t WS_PA = 122 * MiB;
constexpr size_t WS_PB = 326 * MiB;
constexpr size_t WS_OBT = 462 * MiB;
constexpr size_t WS_HK = 326 * MiB;
constexpr size_t WS_SCL = 496 * MiB;
constexpr size_t WS_END = 504 * MiB;
constexpr int CW_NORM = 1024;
constexpr int CW_BAR = 8192;
constexpr int CW_QUEUE = 4096;

constexpr int LDS_BYTES = 156 * 1024;
#define LAS __attribute__((address_space(3)))
#define GAS __attribute__((address_space(1)))
typedef unsigned short bf16;
typedef unsigned v4u __attribute__((ext_vector_type(4)));
typedef unsigned v2u __attribute__((ext_vector_type(2)));
typedef float f32x4 __attribute__((ext_vector_type(4)));

typedef __bf16 bf2_t __attribute__((ext_vector_type(2)));
typedef float f2_t __attribute__((ext_vector_type(2)));
__device__ __forceinline__ unsigned pk2(float lo, float hi) { const f2_t v = {lo, hi}; return __builtin_bit_cast(unsigned, __builtin_convertvector(v, bf2_t)); }
__device__ __forceinline__ unsigned f2bf(float f) { return pk2(f, 0.f) & 0xffffu; }
__device__ __forceinline__ float bf2f(unsigned short h) { return __builtin_bit_cast(float, (unsigned)h << 16); }
__device__ __forceinline__ unsigned f2h(float f) { _Float16 h = (_Float16)f; return (unsigned)__builtin_bit_cast(unsigned short, h); }
__device__ __forceinline__ unsigned pk2h(float lo, float hi) { return f2h(lo) | (f2h(hi) << 16); }
__device__ __forceinline__ float h2f(unsigned short u) { return (float)__builtin_bit_cast(_Float16, u); }
__device__ __forceinline__ float silu_f(float x) { return x * __builtin_amdgcn_rcpf(1.0f + __expf(-x)); }
__device__ __forceinline__ float sigmoid_f(float x) { return __builtin_amdgcn_rcpf(1.0f + __expf(-x)); }
__device__ __forceinline__ float wave_sum(float v) {
#pragma unroll
    for (int o = 1; o < 64; o <<= 1) v += __shfl_xor(v, o);
    return v;
}


#define PSTAMP_(lds_, k_) do { if (threadIdx.x == 0) ((volatile LAS unsigned long long*)((lds_) + LDS_BYTES - 512))[(k_)] = __builtin_amdgcn_s_memrealtime(); } while (0)
#if defined(PROBE_ID) && PROBE_ID >= 216 && PROBE_ID < 220
#define PSTAMP_H(lds_, k_) PSTAMP_(lds_, k_)
#else
#define PSTAMP_H(lds_, k_) do { } while (0)
#endif
#if defined(PROBE_ID) && PROBE_ID >= 226 && PROBE_ID < 230
#define PSTAMP_P(lds_, k_) PSTAMP_(lds_, k_)
#else
#define PSTAMP_P(lds_, k_) do { } while (0)
#endif
#if defined(PROBE_ID) && PROBE_ID >= 220 && PROBE_ID < 226
#define PSTAMP_S(lds_, k_) PSTAMP_(lds_, k_)
#else
#define PSTAMP_S(lds_, k_) do { } while (0)
#endif
typedef GAS unsigned gu32;
#define XB_TMO      128
#define XB_XCNT(j)  (256  + 64 * (j))
#define XB_XSUB(j)  (1280 + 64 * (j))
#define XB_XGEN(j)  (2304 + 64 * (j))
#define XB_TOP      3328
#define XB_TOPGEN   3392
#define XCD_BAR_WORDS 3456
#define XB_SPIN_CAP (1u << 18)
__device__ __forceinline__ unsigned xb_ld(unsigned* p)              { return __hip_atomic_load(p, __ATOMIC_RELAXED, __HIP_MEMORY_SCOPE_AGENT); }
__device__ __forceinline__ unsigned xb_add(unsigned* p, unsigned v) { return __hip_atomic_fetch_add(p, v, __ATOMIC_RELAXED, __HIP_MEMORY_SCOPE_AGENT); }
__device__ __forceinline__ unsigned xb_xcc_id() { return (unsigned)__builtin_amdgcn_s_getreg((3 << 11) | 20) & 0xFu; }
#define XB_SPIN(cond, bar) do { unsigned _sp = 0; while (cond) { __builtin_amdgcn_s_sleep(1); \
    if ((++_sp & 255u) == 0u) { if (xb_ld(&(bar)[XB_TMO])) break; if (_sp > XB_SPIN_CAP) { atomicAdd(&(bar)[XB_TMO], 1u); break; } } } } while (0)
struct XcdBarrier { unsigned* bar; unsigned x; volatile LAS unsigned* st; };
__device__ __forceinline__ XcdBarrier xcd_barrier_post(unsigned* bar, volatile LAS unsigned* st) {
    XcdBarrier b; b.bar = bar; b.x = xb_xcc_id(); b.st = st;
    if (threadIdx.x == 0) (void)xb_add(&bar[XB_XCNT(b.x)], 1u);
    return b;
}
__device__ __forceinline__ void xcd_barrier_complete(unsigned* bar, unsigned x, unsigned& nloc, unsigned& nx) {
    const unsigned G = gridDim.x * gridDim.y * gridDim.z;
    unsigned sum, cnt, mine, sp = 0u;
    for (;;) {
        sum = 0u; cnt = 0u; mine = 0u;
#pragma unroll
        for (unsigned j = 0; j < 16; ++j) { const unsigned c = xb_ld(&bar[XB_XCNT(j)]); sum += c; cnt += (c > 0u) ? 1u : 0u; mine = (j == x) ? c : mine; }
        if (sum == G) break;
        __builtin_amdgcn_s_sleep(1);
        if ((++sp & 255u) == 0u) { if (xb_ld(&bar[XB_TMO])) break; if (sp > XB_SPIN_CAP) { atomicAdd(&bar[XB_TMO], 1u); break; } }
    }
    nloc = mine > 0u ? mine : 1u; nx = cnt > 0u ? cnt : 1u;
}
__device__ __forceinline__ void xcd_barrier(const XcdBarrier& b) {
    asm volatile("s_waitcnt vmcnt(0)" ::: "memory");
    __syncthreads();
    if (threadIdx.x == 0) {
        unsigned* bar = b.bar;
        __builtin_amdgcn_s_waitcnt(0);
        unsigned nloc = b.st[0], nx = b.st[1];
        if (nloc == 0u) { xcd_barrier_complete(bar, b.x, nloc, nx); b.st[0] = nloc; b.st[1] = nx; }
        const unsigned old = xb_add(&bar[XB_XSUB(b.x)], 1u);
        const unsigned gen = old / nloc;
        if (old + 1u == (gen + 1u) * nloc) {
            __builtin_amdgcn_fence(__ATOMIC_RELEASE, "agent");
            asm volatile("s_waitcnt vmcnt(0)" ::: "memory");
            const unsigned og = xb_add(&bar[XB_TOP], 1u);
            const unsigned tg = og / nx;
            if (og + 1u == (tg + 1u) * nx) xb_add(&bar[XB_TOPGEN], 1u);
            else XB_SPIN(xb_ld(&bar[XB_TOPGEN]) == tg, bar);
            __builtin_amdgcn_fence(__ATOMIC_ACQUIRE, "agent");
            xb_add(&bar[XB_XGEN(b.x)], 1u);
            asm volatile("s_waitcnt vmcnt(0)" ::: "memory");
        } else {
            XB_SPIN(xb_ld(&bar[XB_XGEN(b.x)]) == gen, bar);
            __builtin_amdgcn_fence(__ATOMIC_ACQUIRE, "agent");
            asm volatile("s_waitcnt vmcnt(0)" ::: "memory");
        }
    }
    __syncthreads();
}

struct EpiIn {
    static constexpr bool PERM = true;
    bf16* PA; bf16* PB; const float* lb;
    __device__ __forceinline__ bool swap(const pg8::Unit& u) const { return u.pn >= 10; }
    __device__ __forceinline__ void operator()(const f32x4 (&acc)[2][2][4][2], const pg8::Unit& u, int wr, int wc, int fr, int fq) const {
        if (u.pn < 10) {
            const int type = u.pn >> 1;
            const int row0 = u.pm * 256 + wr * 64 + fr, col0 = u.pn * 256 + wc * 32 + 8 * fq;
#pragma unroll
            for (int bj = 0; bj < 2; ++bj) {
                float lbv[8];
#pragma unroll
                for (int e = 0; e < 8; ++e) lbv[e] = (type == 1 || type == 2) ? lb[col0 + bj * 128 + e - 512] : 0.f;
#pragma unroll
                for (int ai = 0; ai < 2; ++ai)
#pragma unroll
                    for (int m = 0; m < 4; ++m) {
                        bf16* rowp = PA + (size_t)(row0 + ai * 128 + m * 16) * PA_LD + col0 + bj * 128;
                        float x[8];
#pragma unroll
                        for (int e = 0; e < 4; ++e) { x[e] = acc[ai][bj][m][0][e]; x[4 + e] = acc[ai][bj][m][1][e]; }
                        v4u w;
                        if (type == 0) {
#pragma unroll
                            for (int e = 0; e < 8; ++e) x[e] = silu_f(x[e]);
                            w.x = pk2(x[0], x[1]); w.y = pk2(x[2], x[3]); w.z = pk2(x[4], x[5]); w.w = pk2(x[6], x[7]);
                        } else if (type == 1 || type == 2) {
#pragma unroll
                            for (int e = 0; e < 8; ++e) x[e] = lbv[e] + (1.0f - lbv[e]) * sigmoid_f(x[e]);
                            w.x = pk2h(x[0], x[1]); w.y = pk2h(x[2], x[3]); w.z = pk2h(x[4], x[5]); w.w = pk2h(x[6], x[7]);
                        } else {
                            w.x = pk2(x[0], x[1]); w.y = pk2(x[2], x[3]); w.z = pk2(x[4], x[5]); w.w = pk2(x[6], x[7]);
                        }
                        *(v4u*)rowp = w;
                        asm volatile("" ::: "memory");
                    }
            }
        } else {
#pragma unroll
            for (int ai = 0; ai < 2; ++ai)
#pragma unroll
                for (int m = 0; m < 4; ++m) {
                    const int cw = u.pn * 256 + ai * 128 + wr * 64 + m * 16 + fr;
                    bf16* colp = PB + (size_t)(cw - 2560) * MTOK + u.pm * 256 + wc * 32 + 8 * fq;
#pragma unroll
                    for (int bj = 0; bj < 2; ++bj) {
                        const f32x4 v0 = acc[ai][bj][m][0], v1 = acc[ai][bj][m][1];
                        v4u w; w.x = pk2(v0[0], v0[1]); w.y = pk2(v0[2], v0[3]); w.z = pk2(v1[0], v1[1]); w.w = pk2(v1[2], v1[3]);
                        *(v4u*)(colp + bj * 128) = w;
                    }
                }
        }
    }
};
struct EpiOut {
    static constexpr bool PERM = true;
    bf16* DL; const float* mod;
    __device__ __forceinline__ bool swap(const pg8::Unit&) const { return false; }
    __device__ __forceinline__ void operator()(const f32x4 (&acc)[2][2][4][2], const pg8::Unit& u, int wr, int wc, int fr, int fq) const {
        const int mr = u.pm >= 128 ? 8 : (u.pm >> 4);
        const int col0 = u.pn * 256 + wc * 32 + 8 * fq;
        f32x4 g0[2], g1[2];
#pragma unroll
        for (int bj = 0; bj < 2; ++bj) { const float* gt = mod + (size_t)mr * 3 * D + 2 * D + col0 + bj * 128; g0[bj] = *(const f32x4*)gt; g1[bj] = *(const f32x4*)(gt + 4); }
#pragma unroll
        for (int ai = 0; ai < 2; ++ai)
#pragma unroll
            for (int m = 0; m < 4; ++m) {
                bf16* rowp = DL + (size_t)(u.pm * 256 + ai * 128 + wr * 64 + m * 16 + fr) * D + col0;
#pragma unroll
                for (int bj = 0; bj < 2; ++bj) {
                    const f32x4 v0 = acc[ai][bj][m][0] * g0[bj], v1 = acc[ai][bj][m][1] * g1[bj];
                    v4u w; w.x = pk2(v0[0], v0[1]); w.y = pk2(v0[2], v0[3]); w.z = pk2(v1[0], v1[1]); w.w = pk2(v1[2], v1[3]);
                    *(v4u*)(rowp + bj * 128) = w;
                }
            }
    }
};

struct Args {
    const float* in[23]; float* out; unsigned char* ws; int ph_lo, ph_hi;
};

struct Frame {
    LAS unsigned char* lds; int tid, lane, wave, vcu, G;
};

__device__ __forceinline__ void p0_transpose_item(const float* W, int K, int N, bf16* WT, LAS float* scr, int item, int lane) {
    const int nblk = N / 32, kb = item / nblk, nb = item % nblk, k0 = 64 * kb, n0 = 32 * nb;
    f32x4 v[8];
#pragma unroll
    for (int i = 0; i < 8; ++i) v[i] = *(const f32x4*)(W + (size_t)(k0 + 8 * i + (lane >> 3)) * N + n0 + 4 * (lane & 7));
#pragma unroll
    for (int i = 0; i < 8; ++i) { LAS float* d = scr + (8 * i + (lane >> 3)) * 33 + 4 * (lane & 7); d[0] = v[i][0]; d[1] = v[i][1]; d[2] = v[i][2]; d[3] = v[i][3]; }
    asm volatile("s_waitcnt lgkmcnt(0)" ::: "memory");
    const int c = lane & 7;
#pragma unroll
    for (int j = 0; j < 4; ++j) { const int n = (lane >> 3) + 8 * j; const LAS float* s = scr + (8 * c) * 33 + n;
        v4u o; o.x = pk2(s[0 * 33], s[1 * 33]); o.y = pk2(s[2 * 33], s[3 * 33]); o.z = pk2(s[4 * 33], s[5 * 33]); o.w = pk2(s[6 * 33], s[7 * 33]);
        *(v4u*)(WT + (size_t)(n0 + n) * K + k0 + 8 * c) = o; }
    asm volatile("s_waitcnt lgkmcnt(0)" ::: "memory");
}

__device__ __forceinline__ void filter_task(const Args& a, Frame& F, const int set, const int n0, int& cached_layer) {
    unsigned char* ws = a.ws;
    const int l = set == 1 ? 1 : 0, L = set == 2 ? 256 : 4096;
    LAS float* w1s = (LAS float*)F.lds;
    LAS float* w2s = w1s + 33 * 64;
    LAS float* w3s = w2s + 64 * 64;
    LAS float* bs = w3s + 64 * 64;
    LAS float* zs = bs + 256;
    LAS float* h3s = zs + 8 * 4 * 64;
    LAS unsigned short* tile = (LAS unsigned short*)(h3s + 32 * 64);
    if (cached_layer != l) {
        __syncthreads();
        for (int e = F.tid; e < 33 * 64; e += NTHR) w1s[e] = a.in[13][l * 33 * 64 + e];
        for (int e = F.tid; e < 4096; e += NTHR) { w2s[e] = a.in[16][l * 4096 + e]; w3s[e] = a.in[18][l * 4096 + e]; }
        if (F.tid < 64) { bs[F.tid] = a.in[14][l * 64 + F.tid]; bs[64 + F.tid] = a.in[17][l * 64 + F.tid]; bs[128 + F.tid] = a.in[19][l * 64 + F.tid]; bs[192 + F.tid] = a.in[15][l * 64 + F.tid]; }
        cached_layer = l;
        __syncthreads();
    }
    {
        const int j = F.lane; LAS float* zw = zs + F.wave * 256; const float fr = bs[192 + j];
#pragma unroll
        for (int p = 0; p < 4; ++p) {
            const int n = n0 + 4 * F.wave + p;
            float zv = 0.f;
            if (j == 0) zv = (float)n / (float)(L - 1);
            else if (j < 33) { const int i = (j - 1) & 15; const double f = 1e-4 + (double)i * ((15.0 - 1e-4) / 15.0); double rev = f * (double)n / (double)L; rev -= floor(rev);
                const float ang = (float)(rev * 6.283185307179586476925); zv = (j <= 16) ? __cosf(ang) : -__sinf(ang); }
            zw[p * 64 + j] = zv;
        }
        asm volatile("s_waitcnt lgkmcnt(0)" ::: "memory");
        float s4[4];
#pragma unroll
        for (int p = 0; p < 4; ++p) s4[p] = bs[j];
        for (int e = 0; e < 33; ++e) { const float wv = w1s[e * 64 + j];
#pragma unroll
            for (int p = 0; p < 4; ++p) s4[p] += zw[p * 64 + e] * wv; }
        asm volatile("s_waitcnt lgkmcnt(0)" ::: "memory");
#pragma unroll
        for (int p = 0; p < 4; ++p) zw[p * 64 + j] = __sinf(fr * s4[p]);
        asm volatile("s_waitcnt lgkmcnt(0)" ::: "memory");
#pragma unroll
        for (int p = 0; p < 4; ++p) s4[p] = bs[64 + j];
        for (int e = 0; e < 64; ++e) { const float wv = w2s[e * 64 + j];
#pragma unroll
            for (int p = 0; p < 4; ++p) s4[p] += zw[p * 64 + e] * wv; }
        asm volatile("s_waitcnt lgkmcnt(0)" ::: "memory");
#pragma unroll
        for (int p = 0; p < 4; ++p) zw[p * 64 + j] = __sinf(fr * s4[p]);
        asm volatile("s_waitcnt lgkmcnt(0)" ::: "memory");
#pragma unroll
        for (int p = 0; p < 4; ++p) s4[p] = bs[128 + j];
        for (int e = 0; e < 64; ++e) { const float wv = w3s[e * 64 + j];
#pragma unroll
            for (int p = 0; p < 4; ++p) s4[p] += zw[p * 64 + e] * wv; }
#pragma unroll
        for (int p = 0; p < 4; ++p) h3s[(4 * F.wave + p) * 64 + j] = __sinf(fr * s4[p]);
    }
    __syncthreads();
    {
        typedef short bf16x8_ __attribute__((ext_vector_type(8)));
        LAS unsigned char* hA = (LAS unsigned char*)(tile + 1024 * 34);
        LAS unsigned char* wB = hA + 32 * 144;
        const int l15 = F.lane & 15, q = F.lane >> 4;
        { const int p = F.tid >> 4, k4 = (F.tid & 15) * 4; const f32x4 hv = *(const LAS f32x4*)(h3s + p * 64 + k4);
          v2u hw; hw.x = pk2(hv[0], hv[1]); hw.y = pk2(hv[2], hv[3]); *(LAS v2u*)(hA + p * 144 + 2 * k4) = hw; }
        float* nrm = (float*)(ws + WS_CTL) + CW_NORM;
        const float* w4 = a.in[20] + (size_t)l * 64 * 1024;
        for (int ch = 0; ch < 8; ++ch) {
            __syncthreads();
            { const int n = F.tid & 127, kq = F.tid >> 7;
              float wv[2][8];
#pragma unroll
              for (int g2 = 0; g2 < 2; ++g2)
#pragma unroll
                  for (int e = 0; e < 8; ++e) wv[g2][e] = w4[(size_t)(16 * kq + 8 * g2 + e) * 1024 + 128 * ch + n];
#pragma unroll
              for (int g2 = 0; g2 < 2; ++g2) { v4u o; o.x = pk2(wv[g2][0], wv[g2][1]); o.y = pk2(wv[g2][2], wv[g2][3]); o.z = pk2(wv[g2][4], wv[g2][5]); o.w = pk2(wv[g2][6], wv[g2][7]);
                  *(LAS v4u*)(wB + n * 144 + (16 * kq + 8 * g2) * 2) = o; } }
            __syncthreads();
            {
                const int col = 128 * ch + 16 * F.wave + l15, c = col & 511;
                f32x4 acc[2];
#pragma unroll
                for (int mt = 0; mt < 2; ++mt) { acc[mt] = (f32x4){0.f, 0.f, 0.f, 0.f};
#pragma unroll
                    for (int ks = 0; ks < 2; ++ks)
                        acc[mt] = __builtin_amdgcn_mfma_f32_16x16x32_bf16(*(const LAS bf16x8_*)(hA + (16 * mt + l15) * 144 + (32 * ks + 8 * q) * 2), *(const LAS bf16x8_*)(wB + (16 * F.wave + l15) * 144 + (32 * ks + 8 * q) * 2), acc[mt], 0, 0, 0); }
                const float dl = fabsf(HY_MIN_DECAY + (float)c * ((HY_MAX_DECAY - HY_MIN_DECAY) / 511.0f));
                float ns = 0.f;
#pragma unroll
                for (int mt = 0; mt < 2; ++mt) {
                    float v4[4];
#pragma unroll
                    for (int r = 0; r < 4; ++r) { const int nn = n0 + 16 * mt + 4 * q + r; v4[r] = acc[mt][r] * __expf(-((float)nn / (float)(L - 1)) * dl); if (col < 512 || nn >= 1) ns += fabsf(v4[r]); }
                    *(LAS unsigned*)(tile + col * 34 + 16 * mt + 4 * q) = pk2(v4[0], v4[1]); *(LAS unsigned*)(tile + col * 34 + 16 * mt + 4 * q + 2) = pk2(v4[2], v4[3]);
                }
                ns += __shfl_xor(ns, 16); ns += __shfl_xor(ns, 32);
                if (q == 0) atomicAdd(&nrm[set * 512 + c], ns);
            }
        }
    }
    __syncthreads();
    {
        bf16* dst = set == 2 ? (bf16*)(ws + WS_FGC) : (bf16*)(ws + WS_FG) + (size_t)set * 512 * FZ;
        const int ld = set == 2 ? FZC : FZ;
        for (int e = F.tid; e < 1024 * 32; e += NTHR) {
            const int col = e >> 5, p = e & 31, c = col & 511, n = n0 + p;
            const unsigned short v = tile[col * 34 + p];
            if (col < 512) dst[(size_t)c * ld + (L - n)] = v;
            else if (n >= 1) dst[(size_t)c * ld + (L + n)] = v;
        }
        if (n0 == 0) {
            const int npad = ld - 2 * L;
            for (int e = F.tid; e < 512 * (npad + 1); e += NTHR) { const int c = e / (npad + 1), k = e % (npad + 1); dst[(size_t)c * ld + (k == 0 ? 0 : 2 * L + k - 1)] = 0; }
        }
    }
    __syncthreads();
}

__device__ __forceinline__ void phase_prologue(const Args& a, Frame& F) {
    unsigned char* ws = a.ws;
    if (F.vcu == 0) {
        float* lbs = (float*)(ws + WS_LBS);
        for (int i = F.tid; i < 1024; i += NTHR) {
            const float a0 = a.in[9][i], a1 = a.in[9][1024 + i];
            const float m = fmaxf(a0, a1), e0 = expf(a0 - m), e1 = expf(a1 - m);
            const float p0 = e0 / (e0 + e1), p1 = e1 / (e0 + e1);
            const float c0 = p0, c1 = p0 + p1;
            lbs[i] = c0 - c0; lbs[1024 + i] = c1 - c0;
        }
    }
    int cached_layer = -1;
    constexpr int I_IN = (D / 64) * (NIN / 32), I_OUT = (D / 64) * (D / 32), NTR = 2 * (I_IN + I_OUT) / 8;
    for (int t = F.vcu; t < NTR; t += F.G) {
        LAS float* scr = (LAS float*)(F.lds + 65536 + F.wave * 8704);
        int r = t * 8 + F.wave; const int l = r / (I_IN + I_OUT); r -= l * (I_IN + I_OUT);
        if (r < I_IN) p0_transpose_item(a.in[7] + (size_t)l * D * NIN, D, NIN, (bf16*)(ws + WS_WIN) + (size_t)l * NIN * D, scr, r, F.lane);
        else p0_transpose_item(a.in[8] + (size_t)l * D * D, D, D, (bf16*)(ws + WS_WOUT) + (size_t)l * D * D, scr, r - I_IN, F.lane);
    }
    __syncthreads();
    if (F.vcu >= 136 && F.vcu < 232) {
        const int task = F.vcu - 136;
        LAS float* sv = (LAS float*)(F.lds + 65536);
        LAS float* part = sv + 9 * 1024;
        const int l = task / 48, n0 = (task % 48) * 64;
        for (int e = F.tid; e < 9 * 1024; e += NTHR) { const int r = e >> 10, k = e & 1023; const float cv = r < 8 ? a.in[1][r * D + k] : a.in[3][k]; sv[e] = cv / (1.0f + expf(-cv)); }
        __syncthreads();
        float acc9[9];
#pragma unroll
        for (int r = 0; r < 9; ++r) acc9[r] = 0.f;
        const float* w = a.in[5] + (size_t)l * D * 3 * D + n0 + F.lane;
#pragma unroll 8
        for (int k = F.wave * 128; k < F.wave * 128 + 128; ++k) {
            const float wv = w[(size_t)k * 3 * D];
#pragma unroll
            for (int r = 0; r < 9; ++r) acc9[r] += sv[r * 1024 + k] * wv;
        }
#pragma unroll
        for (int r = 0; r < 9; ++r) part[(F.wave * 9 + r) * 64 + F.lane] = acc9[r];
        __syncthreads();
        for (int e = F.tid; e < 9 * 64; e += NTHR) {
            const int r = e >> 6, c = e & 63; float sum = 0.f;
#pragma unroll
            for (int w8 = 0; w8 < 8; ++w8) sum += part[(w8 * 9 + r) * 64 + c];
            ((float*)(ws + WS_MOD))[((size_t)l * 9 + r) * 3 * D + n0 + c] = sum + a.in[6][l * 3 * D + n0 + c];
        }
        __syncthreads();
    }
    if (F.vcu < 16) filter_task(a, F, 0, 32 * (112 + F.vcu), cached_layer);
    else if (F.vcu >= 128 && F.vcu < 136) filter_task(a, F, 2, 32 * (F.vcu - 128), cached_layer);
}
__device__ __forceinline__ void phase_filters_l0(const Args& a, Frame& F) {
    int cached_layer = -1; const int b = (int)blockIdx.x;
    if (b >= 144) filter_task(a, F, 0, 32 * (b - 144), cached_layer);
}
__device__ __forceinline__ void phase_filters_l1(const Args& a, Frame& F) {
    int cached_layer = -1; const int b = (int)blockIdx.x;
    if (b >= 32 && b < 160) filter_task(a, F, 1, 32 * (b - 32), cached_layer);
}

__device__ __forceinline__ void phase_normrows(const Args& a, Frame& F, int l, const float* xlat, const float* xctx) {
    unsigned char* ws = a.ws;
    const float* nw = a.in[4] + l * D;
    const float* mod = (const float*)(ws + WS_MOD) + (size_t)l * 9 * 3 * D;
    bf16* XA = (bf16*)(ws + WS_XA);
    const bf16* DL = (const bf16*)(ws + WS_PB);
    const int gw = F.vcu * NWAVES + F.wave, NGW = F.G * NWAVES;
    for (int tok = gw; tok < MTOK; tok += NGW) {
        const bool isctx = tok >= MLAT;
        const float* xr = isctx ? xctx + (size_t)(tok - MLAT) * D : xlat + (size_t)tok * D;
        const int mr = isctx ? 8 : (tok >> 12);
        const float* sh = mod + (size_t)mr * 3 * D; const float* sc = sh + D;
        f32x4 v[4]; float s = 0.f;
#pragma unroll
        for (int j = 0; j < 4; ++j) v[j] = *(const f32x4*)(xr + 256 * j + 4 * F.lane);
        if (l == 1) {
#pragma unroll
            for (int j = 0; j < 4; ++j) { const v2u dw = *(const v2u*)(DL + (size_t)tok * D + 256 * j + 4 * F.lane);
                v[j].x += bf2f((unsigned short)(dw.x & 0xffffu)); v[j].y += bf2f((unsigned short)(dw.x >> 16)); v[j].z += bf2f((unsigned short)(dw.y & 0xffffu)); v[j].w += bf2f((unsigned short)(dw.y >> 16)); }
            if (!isctx) {
#pragma unroll
                for (int j = 0; j < 4; ++j) *(f32x4*)(a.out + (size_t)tok * D + 256 * j + 4 * F.lane) = v[j];
            }
        }
#pragma unroll
        for (int j = 0; j < 4; ++j) s += (v[j].x * v[j].x + v[j].y * v[j].y) + (v[j].z * v[j].z + v[j].w * v[j].w);
        const float rstd = 1.0f / sqrtf(wave_sum(s) * (1.0f / D) + EPS);
#pragma unroll
        for (int j = 0; j < 4; ++j) {
            const int k = 256 * j + 4 * F.lane;
            const f32x4 w4 = *(const f32x4*)(nw + k), s4 = *(const f32x4*)(sc + k), h4 = *(const f32x4*)(sh + k);
            const f32x4 y = v[j] * rstd * w4 * (s4 + 1.0f) + h4;
            v2u o; o.x = pk2(y.x, y.y); o.y = pk2(y.z, y.w);
            *(v2u*)(XA + (size_t)tok * D + k) = o;
        }
    }
}


namespace scan {
typedef short bf16x8 __attribute__((ext_vector_type(8)));
typedef short bf16x4 __attribute__((ext_vector_type(4)));
constexpr int QI_RS = 264, KT_RS = 160;
constexpr int OFF_QI = 0, OFF_KI = 16896, OFF_KT = 33792, OFF_VT = 54272, OFF_SCL = 74752, SET_BYTES = 76288;
constexpr int OFF_SEG = 2 * SET_BYTES;
static_assert(OFF_SEG + 4096 <= LDS_BYTES - 512, "scan LDS");
#define MFMA16(a, b, c) __builtin_amdgcn_mfma_f32_16x16x32_bf16((a), (b), (c), 0, 0, 0)
__device__ __forceinline__ bf16x8 ld_perm(const LAS unsigned char* p) {
    const bf16x4 lo = *(const LAS bf16x4*)p, hi = *(const LAS bf16x4*)(p + 32);
    return __builtin_shufflevector(lo, hi, 0, 1, 2, 3, 4, 5, 6, 7);
}
__device__ __forceinline__ int tok_row(int g, int i, int b, int dir) {
    if (g < 4) { const int t = 64 * g + i; return MLAT + b * LCX + (dir ? (LCX - 1 - t) : t); }
    const int t = 64 * (g - 4) + i; return b * LX + (dir ? (LX - 1 - t) : t);
}
template <int HALF>
__device__ __forceinline__ void scan_producer(LAS unsigned char* lds, const bf16* PA, const int b, const int h, const int dir, const int nchunk, const int pw, const int lane) {
    const int tg = lane >> 4, cq = lane & 15, ch0 = 64 * (pw >> 1) + 4 * cq;
    LAS float* seg = (LAS float*)(lds + OFF_SEG + pw * 1024);
    v2u qA[8], fA[8], vA[8], qB[8], fB[8], vB[8];
#define SCAN_LOAD(g, Q_, F_, V_) do { _Pragma("unroll") for (int e = 0; e < 8; ++e) { const bf16* p_ = PA + (size_t)tok_row((g), 32 * HALF + 8 * tg + e, b, dir) * PA_LD + h * HD + ch0; \
        Q_[e] = *(const v2u*)p_; F_[e] = *(const v2u*)(p_ + 512 + dir * 512); V_[e] = *(const v2u*)(p_ + 1536); } } while (0)
#define SCAN_IMG(set_, Q_, F_, V_) do { LAS unsigned char* s_ = lds + (set_) * SET_BYTES; \
        _Pragma("unroll") for (int e = 0; e < 8; ++e) asm volatile("" : "+v"(F_[e].x), "+v"(F_[e].y)); \
        float f_[4][8]; \
        _Pragma("unroll") for (int e = 0; e < 8; ++e) { f_[0][e] = h2f((unsigned short)(F_[e].x & 0xffffu)); f_[1][e] = h2f((unsigned short)(F_[e].x >> 16)); f_[2][e] = h2f((unsigned short)(F_[e].y & 0xffffu)); f_[3][e] = h2f((unsigned short)(F_[e].y >> 16)); } \
        f32x4 pr_; \
        _Pragma("unroll") for (int d = 0; d < 4; ++d) pr_[d] = ((f_[d][0] * f_[d][1]) * (f_[d][2] * f_[d][3])) * ((f_[d][4] * f_[d][5]) * (f_[d][6] * f_[d][7])); \
        *(LAS f32x4*)(seg + tg * 64 + 4 * cq) = pr_; \
        f32x4 T_[4]; _Pragma("unroll") for (int t2 = 0; t2 < 4; ++t2) T_[t2] = *(const LAS f32x4*)(seg + t2 * 64 + 4 * cq); \
        const f32x4 tot_ = (T_[0] * T_[1]) * (T_[2] * T_[3]); \
        f32x4 mul_ = (f32x4){1.f, 1.f, 1.f, 1.f}; \
        if (HALF) { _Pragma("unroll") for (int t2 = 0; t2 < 3; ++t2) if (t2 < tg) mul_ *= T_[t2]; } \
        else      { _Pragma("unroll") for (int t2 = 1; t2 < 4; ++t2) if (t2 > tg) mul_ *= T_[t2]; } \
        float Qp_[4][8], Kp_[4][8]; \
        _Pragma("unroll") for (int d = 0; d < 4; ++d) { float x_[8]; float run_ = mul_[d]; \
            if (HALF) { _Pragma("unroll") for (int e = 0; e < 8; ++e) { run_ *= f_[d][e]; x_[e] = run_; } } \
            else      { _Pragma("unroll") for (int e = 7; e >= 0; --e) { x_[e] = run_; run_ *= f_[d][e]; } } \
            _Pragma("unroll") for (int e = 0; e < 8; ++e) { const unsigned qw_ = (d & 2) ? Q_[e].y : Q_[e].x; const float qv_ = bf2f((unsigned short)((d & 1) ? (qw_ >> 16) : (qw_ & 0xffffu))); \
                const float xx_ = fmaxf(x_[e], 1e-30f), r_ = __builtin_amdgcn_rcpf(xx_), kk_ = 1.0f - f_[d][e]; \
                Qp_[d][e] = HALF ? qv_ * xx_ : qv_ * r_; Kp_[d][e] = HALF ? kk_ * r_ : kk_ * xx_; } \
            v4u t_, u_; \
            _Pragma("unroll") for (int e = 0; e < 4; ++e) { t_[e] = pk2(Kp_[d][2 * e], Kp_[d][2 * e + 1]); \
                const unsigned va_ = (d & 2) ? V_[2 * e].y : V_[2 * e].x, vb_ = (d & 2) ? V_[2 * e + 1].y : V_[2 * e + 1].x; \
                u_[e] = (d & 1) ? ((va_ >> 16) | (vb_ & 0xffff0000u)) : ((va_ & 0xffffu) | (vb_ << 16)); } \
            *(LAS v4u*)(s_ + OFF_KT + (ch0 + d) * KT_RS + 16 * ((4 * HALF + tg) ^ (cq & 7))) = t_; *(LAS v4u*)(s_ + OFF_VT + (ch0 + d) * KT_RS + 16 * ((4 * HALF + tg) ^ (cq & 7))) = u_; } \
        _Pragma("unroll") for (int e = 0; e < 8; ++e) { v2u qq_, kq_; qq_.x = pk2(Qp_[0][e], Qp_[1][e]); qq_.y = pk2(Qp_[2][e], Qp_[3][e]); kq_.x = pk2(Kp_[0][e], Kp_[1][e]); kq_.y = pk2(Kp_[2][e], Kp_[3][e]); \
            *(LAS v2u*)(s_ + OFF_QI + (32 * HALF + 8 * tg + e) * QI_RS + 2 * ch0) = qq_; *(LAS v2u*)(s_ + OFF_KI + (32 * HALF + 8 * tg + e) * QI_RS + 2 * ch0) = kq_; } \
        if (tg == 0) *(LAS f32x4*)(s_ + OFF_SCL + 512 * HALF + 4 * ch0) = tot_; } while (0)
    const int last = nchunk - 1;
    SCAN_LOAD(0, qA, fA, vA);
    SCAN_LOAD(1, qB, fB, vB);
    SCAN_IMG(0, qA, fA, vA);
    SCAN_LOAD(2, qA, fA, vA);
    __syncthreads();
    for (int g = 0; g < nchunk; g += 2) {
        SCAN_IMG(1, qB, fB, vB);
        { const int gn = g + 3 < last ? g + 3 : last; SCAN_LOAD(gn, qB, fB, vB); }
        __syncthreads();
        SCAN_IMG(0, qA, fA, vA);
        { const int gn = g + 4 < last ? g + 4 : last; SCAN_LOAD(gn, qA, fA, vA); }
        __syncthreads();
    }
#undef SCAN_LOAD
#undef SCAN_IMG
}
__device__ __forceinline__ void scan_unit(LAS unsigned char* lds, bf16* PA, bf16* OC, const int b, const int h, const int dir, const bool ctxunit) {
    int tid_ = threadIdx.x; asm volatile("" : "+v"(tid_));
    const int tid = tid_, lane = tid & 63, w = __builtin_amdgcn_readfirstlane(tid >> 6);
    const int l15 = lane & 15, q = lane >> 4;
    const int nchunk = ctxunit ? 4 : 68;
    if (w >= 4) {
        if (w & 1) scan_producer<1>(lds, PA, b, h, dir, nchunk, w - 4, lane); else scan_producer<0>(lds, PA, b, h, dir, nchunk, w - 4, lane);
    } else {
        f32x4 S[2][8];
#pragma unroll
        for (int c = 0; c < 2; ++c)
#pragma unroll
            for (int kt = 0; kt < 8; ++kt) S[c][kt] = (f32x4){0.f, 0.f, 0.f, 0.f};
        const int vc0 = 32 * w;
        if (!ctxunit) PSTAMP_S(lds, 20);
        __syncthreads();
        for (int g = 0; g < nchunk; ++g) {
            const bool do_o = ctxunit || g >= 4;
            const LAS unsigned char* cs = lds + (g & 1) * SET_BYTES;
            if (g == 30) PSTAMP_S(lds, 22);
            bf16x8 vt[2][2];
#pragma unroll
            for (int c = 0; c < 2; ++c) { const int r_ = vc0 + 8 * (l15 >> 2) + 4 * c + (l15 & 3), x_ = (r_ >> 2) & 7;
                vt[c][0] = *(const LAS bf16x8*)(cs + OFF_VT + r_ * KT_RS + 16 * (q ^ x_)); vt[c][1] = *(const LAS bf16x8*)(cs + OFF_VT + r_ * KT_RS + 16 * ((4 + q) ^ x_)); }
            if (do_o) {
                bf16x8 vp[2][2];
#pragma unroll
                for (int c = 0; c < 2; ++c) { const int r_ = vc0 + 8 * (l15 >> 2) + 4 * c + (l15 & 3), x_ = (r_ >> 2) & 7;
#pragma unroll
                    for (int js = 0; js < 2; ++js) { const int c1 = 4 * js + (q >> 1);
                        const bf16x4 lo = *(const LAS bf16x4*)(cs + OFF_VT + r_ * KT_RS + 16 * (c1 ^ x_) + 8 * (q & 1)), hi4 = *(const LAS bf16x4*)(cs + OFF_VT + r_ * KT_RS + 16 * ((c1 + 2) ^ x_) + 8 * (q & 1));
                        vp[c][js] = __builtin_shufflevector(lo, hi4, 0, 1, 2, 3, 4, 5, 6, 7); } }
                bf16x8 sf[2][4];
#pragma unroll
                for (int ks = 0; ks < 4; ++ks) {
                    const f32x4 m0 = *(const LAS f32x4*)(cs + OFF_SCL + (32 * ks + 4 * q) * 4), m1 = *(const LAS f32x4*)(cs + OFF_SCL + (32 * ks + 16 + 4 * q) * 4);
#pragma unroll
                    for (int c = 0; c < 2; ++c) { const f32x4 s0 = S[c][2 * ks] * m0, s1 = S[c][2 * ks + 1] * m1;
                        v4u pk; pk.x = pk2(s0[0], s0[1]); pk.y = pk2(s0[2], s0[3]); pk.z = pk2(s1[0], s1[1]); pk.w = pk2(s1[2], s1[3]); sf[c][ks] = __builtin_bit_cast(bf16x8, pk); }
                }
#pragma unroll
                for (int it = 0; it < 4; ++it) {
                    bf16x8 qf[4];
#pragma unroll
                    for (int ks = 0; ks < 4; ++ks) qf[ks] = ld_perm(cs + OFF_QI + (16 * it + l15) * QI_RS + (32 * ks + 4 * q) * 2);
                    f32x4 O0 = (f32x4){0.f, 0.f, 0.f, 0.f}, O1 = O0;
#pragma unroll
                    for (int ks = 0; ks < 4; ++ks) { O0 = MFMA16(sf[0][ks], qf[ks], O0); O1 = MFMA16(sf[1][ks], qf[ks], O1); }
                    unsigned pt[4][2];
#pragma unroll
                    for (int jt = 0; jt < 4; ++jt) {
                        if (jt <= it) {
                            f32x4 a4 = (f32x4){0.f, 0.f, 0.f, 0.f};
#pragma unroll
                            for (int ks = 0; ks < 4; ++ks) a4 = MFMA16(ld_perm(cs + OFF_KI + (16 * jt + l15) * QI_RS + (32 * ks + 4 * q) * 2), qf[ks], a4);
                            if (jt == it) {
#pragma unroll
                                for (int r = 0; r < 4; ++r) a4[r] = (4 * q + r <= l15) ? a4[r] : 0.f;
                            }
                            pt[jt][0] = pk2(a4[0], a4[1]); pt[jt][1] = pk2(a4[2], a4[3]);
                        } else { pt[jt][0] = 0u; pt[jt][1] = 0u; }
                    }
                    { v4u bw; bw.x = pt[0][0]; bw.y = pt[0][1]; bw.z = pt[1][0]; bw.w = pt[1][1]; const bf16x8 bb = __builtin_bit_cast(bf16x8, bw);
                      O0 = MFMA16(vp[0][0], bb, O0); O1 = MFMA16(vp[1][0], bb, O1); }
                    if (it >= 2) { v4u bw; bw.x = pt[2][0]; bw.y = pt[2][1]; bw.z = pt[3][0]; bw.w = pt[3][1]; const bf16x8 bb = __builtin_bit_cast(bf16x8, bw);
                      O0 = MFMA16(vp[0][1], bb, O0); O1 = MFMA16(vp[1][1], bb, O1); }
                    const int row = tok_row(g, 16 * it + l15, b, dir);
                    bf16* dst = (g < 4) ? OC + (size_t)dir * MCTX * 512 + (size_t)(row - MLAT) * 512 + h * HD + vc0 + 8 * q
                                        : PA + (size_t)row * PA_LD + 512 + dir * 512 + h * HD + vc0 + 8 * q;
                    v4u wv; wv.x = pk2(O0[0], O0[1]); wv.y = pk2(O0[2], O0[3]); wv.z = pk2(O1[0], O1[1]); wv.w = pk2(O1[2], O1[3]);
                    *(v4u*)dst = wv;
                }
            }
#pragma unroll
            for (int kt = 0; kt < 8; ++kt) {
                const f32x4 gmk = *(const LAS f32x4*)(cs + OFF_SCL + (16 * kt + 4 * q) * 4), gem = *(const LAS f32x4*)(cs + OFF_SCL + 512 + (16 * kt + 4 * q) * 4), ge = gmk * gem;
                const int xk_ = (4 * kt + (l15 >> 2)) & 7;
                const bf16x8 k0 = *(const LAS bf16x8*)(cs + OFF_KT + (16 * kt + l15) * KT_RS + 16 * (q ^ xk_)), k1 = *(const LAS bf16x8*)(cs + OFF_KT + (16 * kt + l15) * KT_RS + 16 * ((4 + q) ^ xk_));
#pragma unroll
                for (int c = 0; c < 2; ++c) { f32x4 d4 = MFMA16(k0, vt[c][0], ((f32x4){0.f, 0.f, 0.f, 0.f})); d4 = MFMA16(k1, vt[c][1], d4); S[c][kt] = ge * S[c][kt] + gem * d4; }
            }
            if (g == 30) PSTAMP_S(lds, 23);
            __syncthreads();
            if (g == 30) PSTAMP_S(lds, 24);
        }
        if (!ctxunit) PSTAMP_S(lds, 21);
    }
}
}


namespace hy {
typedef short bf16x8 __attribute__((ext_vector_type(8)));
typedef short bf16x4 __attribute__((ext_vector_type(4)));
constexpr int CS = 16416;
constexpr int VPAD = 7;
constexpr int OFF_F = 0, OFF_V = 4 * CS, V_ROWS = (64 + VPAD + 7) * 8, LDS_END = OFF_V + V_ROWS * 128;
static_assert(LDS_END <= LDS_BYTES - 256, "hyena LDS");
struct ConvW { float x0[4], x1[4], v[4]; };
__device__ __forceinline__ ConvW load_convw(const Args& a, int l, int c) {
    const float* cw = a.in[11] + (size_t)l * 3 * 1536; const float* cb = a.in[12] + (size_t)l * 1536; ConvW r;
#pragma unroll
    for (int j = 0; j < 3; ++j) { r.x0[j] = cw[j * 1536 + c]; r.x1[j] = cw[j * 1536 + 512 + c]; r.v[j] = cw[j * 1536 + 1024 + c]; }
    r.x0[3] = cb[c]; r.x1[3] = cb[512 + c]; r.v[3] = cb[1024 + c];
    return r;
}
__device__ __forceinline__ void hyena_channel(LAS unsigned char* lds, const Args& a, const int l, const int c) {
    int tid_ = threadIdx.x; asm volatile("" : "+v"(tid_));
    const int tid = tid_, lane = tid & 63, w = __builtin_amdgcn_readfirstlane(tid >> 6), l15 = lane & 15, q = lane >> 4;
    unsigned char* ws = a.ws;
    const bf16* PB = (const bf16*)(ws + WS_PB);
    const bf16* x0r = PB + (size_t)c * MTOK; const bf16* x1r = PB + (size_t)(512 + c) * MTOK; const bf16* vr = PB + (size_t)(1024 + c) * MTOK; const bf16* gbr = PB + (size_t)(1536 + c) * MTOK;
    const ConvW cw = load_convw(a, l, c);
    PSTAMP_H(lds, 16);
    {
        const bf16* F = (const bf16*)(ws + WS_FG) + ((size_t)l * 512 + c) * FZ;
        for (int ch = tid; ch < 1024; ch += NTHR) {
            const v4u cur = *(const v4u*)(F + 8 * ch); v4u prev = *(const v4u*)(F + (ch > 0 ? 8 * ch - 8 : 0));
            if (ch == 0) prev = (v4u){0u, 0u, 0u, 0u};
            const unsigned W[8] = {prev.x, prev.y, prev.z, prev.w, cur.x, cur.y, cur.z, cur.w};
            v4u c1, c2, c3;
#pragma unroll
            for (int d = 0; d < 4; ++d) { c1[d] = (W[3 + d] >> 16) | (W[4 + d] << 16); c2[d] = W[3 + d]; c3[d] = (W[2 + d] >> 16) | (W[3 + d] << 16); }
            *(LAS v4u*)(lds + OFF_F + 0 * CS + 16 * ch) = cur;
            *(LAS v4u*)(lds + OFF_F + 1 * CS + 16 * ch) = c1;
            *(LAS v4u*)(lds + OFF_F + 2 * CS + 16 * ch) = c2;
            *(LAS v4u*)(lds + OFF_F + 3 * CS + 16 * ch) = c3;
        }
    }
    {
        for (int e = tid; e < VPAD * 8 * 32; e += NTHR) ((LAS unsigned*)(lds + OFF_V))[e] = 0u;
        for (int e = tid; e < 7 * 8 * 32; e += NTHR) ((LAS unsigned*)(lds + OFF_V + (64 + VPAD) * 8 * 128))[e] = 0u;
        for (int bt = 0; bt < 2; ++bt) {
            v4u vw[4], xw[4]; unsigned short hv[4][2], hx[4][2];
#pragma unroll
            for (int j = 0; j < 4; ++j) {
                const int e = tid + NTHR * (4 * bt + j), b = e >> 9, t0 = (e & 511) * 8;
                const size_t base = (size_t)b * LX + t0;
                const size_t bm = t0 > 0 ? base - 1 : base, bp = t0 + 8 < LX ? base + 8 : base;
                vw[j] = *(const v4u*)(vr + base); xw[j] = *(const v4u*)(x1r + base);
                hv[j][0] = vr[bm]; hv[j][1] = vr[bp]; hx[j][0] = x1r[bm]; hx[j][1] = x1r[bp];
            }
#pragma unroll
            for (int j = 0; j < 4; ++j) {
                const int e = tid + NTHR * (4 * bt + j), b = e >> 9, t0 = (e & 511) * 8, ab = t0 >> 6, ch = (t0 & 63) >> 3;
                float vv[10], xx[10];
                vv[0] = t0 > 0 ? bf2f(hv[j][0]) : 0.f; xx[0] = t0 > 0 ? bf2f(hx[j][0]) : 0.f;
                vv[9] = t0 + 8 < LX ? bf2f(hv[j][1]) : 0.f; xx[9] = t0 + 8 < LX ? bf2f(hx[j][1]) : 0.f;
#pragma unroll
                for (int d = 0; d < 4; ++d) { vv[1 + 2 * d] = bf2f((unsigned short)(vw[j][d] & 0xffffu)); vv[2 + 2 * d] = bf2f((unsigned short)(vw[j][d] >> 16));
                                              xx[1 + 2 * d] = bf2f((unsigned short)(xw[j][d] & 0xffffu)); xx[2 + 2 * d] = bf2f((unsigned short)(xw[j][d] >> 16)); }
                float p[8];
#pragma unroll
                for (int d = 0; d < 8; ++d) p[d] = (cw.v[3] + cw.v[0] * vv[d] + cw.v[1] * vv[d + 1] + cw.v[2] * vv[d + 2]) * (cw.x1[3] + cw.x1[0] * xx[d] + cw.x1[1] * xx[d + 1] + cw.x1[2] * xx[d + 2]);
                v4u o; o.x = pk2(p[0], p[1]); o.y = pk2(p[2], p[3]); o.z = pk2(p[4], p[5]); o.w = pk2(p[6], p[7]);
                const int R = (ab + VPAD) * 8 + b;
                *(LAS v4u*)(lds + OFF_V + R * 128 + 16 * (ch ^ ((R >> 1) & 7))) = o;
            }
        }
    }
    __syncthreads();
    PSTAMP_H(lds, 17);
    f32x4 acc[4][4];
#pragma unroll
    for (int mt = 0; mt < 4; ++mt)
#pragma unroll
        for (int nt = 0; nt < 4; ++nt) acc[mt][nt] = (f32x4){0.f, 0.f, 0.f, 0.f};
    {
        const LAS unsigned char* pa = lds + OFF_F + (l15 & 3) * CS + (4096 - 4 * (l15 >> 2) + 8 * q) * 2 - 96;
        const int rowl = (l15 >> 3) * 8 + (l15 & 7);
        const int cq = (q ^ (rowl >> 1)) & 7;
        const LAS unsigned char* vb0 = lds + OFF_V + rowl * 128 + (8 * w + VPAD) * 1024 + 16 * cq;
        const LAS unsigned char* vb1 = lds + OFF_V + rowl * 128 + (8 * w + VPAD) * 1024 + 16 * (cq ^ 4);
#define HY_LDA(An_, m_) do { const LAS unsigned char* p_ = pa - 128 * (m_); _Pragma("unroll") for (int mt = 0; mt < 4; ++mt) { \
            const bf16x4 lo_ = *(const LAS bf16x4*)(p_ + 32 * (3 - mt)), hi_ = *(const LAS bf16x4*)(p_ + 32 * (3 - mt) + 8); An_[mt] = __builtin_shufflevector(lo_, hi_, 0, 1, 2, 3, 4, 5, 6, 7); } } while (0)
#define HY_LDB(B_, m_, PAR_) do { const LAS unsigned char* p0_ = ((PAR_) ? vb1 : vb0) - 1024 * (m_); const LAS unsigned char* p1_ = ((PAR_) ? vb0 : vb1) - 1024 * (m_); \
            _Pragma("unroll") for (int nt = 0; nt < 4; ++nt) { B_[0][nt] = *(const LAS bf16x8*)(p0_ + 2048 * nt); B_[1][nt] = *(const LAS bf16x8*)(p1_ + 2048 * nt); } } while (0)
#define HY_MMA(An_, Ao0_, Ao1_, B_, m_) do { _Pragma("unroll") for (int nt = 0; nt < 4; ++nt) { const int a0_ = 8 * w + 2 * nt - (m_); if (a0_ + 1 >= 0 && a0_ <= 63) { \
            _Pragma("unroll") for (int mt = 0; mt < 4; ++mt) acc[mt][nt] = __builtin_amdgcn_mfma_f32_16x16x32_bf16(An_[mt], B_[0][nt], acc[mt][nt], 0, 0, 0); \
            acc[0][nt] = __builtin_amdgcn_mfma_f32_16x16x32_bf16(Ao0_, B_[1][nt], acc[0][nt], 0, 0, 0); acc[1][nt] = __builtin_amdgcn_mfma_f32_16x16x32_bf16(Ao1_, B_[1][nt], acc[1][nt], 0, 0, 0); \
            acc[2][nt] = __builtin_amdgcn_mfma_f32_16x16x32_bf16(An_[0], B_[1][nt], acc[2][nt], 0, 0, 0); acc[3][nt] = __builtin_amdgcn_mfma_f32_16x16x32_bf16(An_[1], B_[1][nt], acc[3][nt], 0, 0, 0); } } } while (0)
        bf16x8 Aa[4], Ab[4], Ba[2][4], Bb[2][4], o0, o1;
        const int m0 = 8 * w - 63, mlast = 8 * w + 7;
        { bf16x8 t_[4]; HY_LDA(t_, m0 - 1); o0 = t_[2]; o1 = t_[3]; }
        HY_LDA(Aa, m0); HY_LDB(Ba, m0, 0);
        for (int m = m0; m < mlast; m += 2) {
            HY_LDA(Ab, m + 1); HY_LDB(Bb, m + 1, 1);
            HY_MMA(Aa, o0, o1, Ba, m);
            o0 = Aa[2]; o1 = Aa[3];
            HY_LDA(Aa, m + 2); HY_LDB(Ba, m + 2, 0);
            HY_MMA(Ab, o0, o1, Bb, m + 1);
            o0 = Ab[2]; o1 = Ab[3];
        }
        HY_MMA(Aa, o0, o1, Ba, mlast);
#undef HY_LDA
#undef HY_LDB
#undef HY_MMA
    }
    PSTAMP_H(lds, 18);
    __syncthreads();
    {
        constexpr int YRS = 8208;
        const float inn = 1.0f / ((const float*)(ws + WS_CTL))[CW_NORM + l * 512 + c], hb = a.in[21][l * 512 + c];
        const int b = l15 & 7;
#pragma unroll
        for (int nt = 0; nt < 4; ++nt) {
            const int ab = 8 * w + 2 * nt + (l15 >> 3), R = (ab + VPAD) * 8 + b;
#pragma unroll
            for (int mt = 0; mt < 4; ++mt) {
                const int t = 64 * ab + 16 * mt + 4 * q;
                const v2u vw = *(const LAS v2u*)(lds + OFF_V + R * 128 + 16 * ((2 * mt + (q >> 1)) ^ ((R >> 1) & 7)) + 8 * (q & 1));
                const float y0 = acc[mt][nt][0] * inn + bf2f((unsigned short)(vw.x & 0xffffu)) * hb, y1 = acc[mt][nt][1] * inn + bf2f((unsigned short)(vw.x >> 16)) * hb;
                const float y2 = acc[mt][nt][2] * inn + bf2f((unsigned short)(vw.y & 0xffffu)) * hb, y3 = acc[mt][nt][3] * inn + bf2f((unsigned short)(vw.y >> 16)) * hb;
                v2u yw; yw.x = pk2(y0, y1); yw.y = pk2(y2, y3);
                *(LAS v2u*)(lds + OFF_F + b * YRS + 2 * t) = yw;
            }
        }
        __syncthreads();
        bf16* OBT = (bf16*)(ws + WS_OBT) + (size_t)c * MTOK;
        int tid2 = tid; asm volatile("" : "+v"(tid2));
        for (int bt = 0; bt < 4; ++bt) {
            v4u xw[2], gw[2]; unsigned short hx[2][2];
#pragma unroll
            for (int j = 0; j < 2; ++j) {
                const int e = tid2 + NTHR * (2 * bt + j), bb = e >> 9, t0 = (e & 511) * 8;
                const size_t base = (size_t)bb * LX + t0;
                xw[j] = *(const v4u*)(x0r + base); gw[j] = *(const v4u*)(gbr + base);
                hx[j][0] = x0r[t0 > 0 ? base - 1 : base]; hx[j][1] = x0r[t0 + 8 < LX ? base + 8 : base];
            }
#pragma unroll
            for (int j = 0; j < 2; ++j) {
                const int e = tid2 + NTHR * (2 * bt + j), bb = e >> 9, t0 = (e & 511) * 8;
                const size_t base = (size_t)bb * LX + t0;
                const v4u yw = *(const LAS v4u*)(lds + OFF_F + bb * YRS + 2 * t0);
                float xs[10], o[8];
                xs[0] = t0 > 0 ? bf2f(hx[j][0]) : 0.f; xs[9] = t0 + 8 < LX ? bf2f(hx[j][1]) : 0.f;
#pragma unroll
                for (int d = 0; d < 4; ++d) { xs[1 + 2 * d] = bf2f((unsigned short)(xw[j][d] & 0xffffu)); xs[2 + 2 * d] = bf2f((unsigned short)(xw[j][d] >> 16)); }
#pragma unroll
                for (int d = 0; d < 8; ++d) {
                    const float yv = bf2f((unsigned short)((d & 1) ? (yw[d >> 1] >> 16) : (yw[d >> 1] & 0xffffu)));
                    const float gv = bf2f((unsigned short)((d & 1) ? (gw[j][d >> 1] >> 16) : (gw[j][d >> 1] & 0xffffu)));
                    o[d] = yv * (cw.x0[3] + cw.x0[0] * xs[d] + cw.x0[1] * xs[d + 1] + cw.x0[2] * xs[d + 2]) * silu_f(gv);
                }
                v4u ow; ow.x = pk2(o[0], o[1]); ow.y = pk2(o[2], o[3]); ow.z = pk2(o[4], o[5]); ow.w = pk2(o[6], o[7]);
                *(v4u*)(OBT + base) = ow;
            }
        }
    }
    PSTAMP_H(lds, 19);
    __syncthreads();
}
__device__ __forceinline__ void hyena_ctx_channel(LAS unsigned char* lds, const Args& a, const int c) {
    int tid_ = threadIdx.x; asm volatile("" : "+v"(tid_));
    const int tid = tid_;
    unsigned char* ws = a.ws;
    const bf16* PB = (const bf16*)(ws + WS_PB);
    const bf16* x0r = PB + (size_t)c * MTOK + MLAT; const bf16* x1r = PB + (size_t)(512 + c) * MTOK + MLAT; const bf16* vr = PB + (size_t)(1024 + c) * MTOK + MLAT; const bf16* gbr = PB + (size_t)(1536 + c) * MTOK + MLAT;
    const ConvW cw = load_convw(a, 0, c);
    LAS float* vvc = (LAS float*)lds;
    LAS float* Fc = vvc + 2048;
    for (int e = tid; e < 2048; e += NTHR) {
        const int t = e & 255;
        const float vm_ = bf2f(vr[t > 0 ? e - 1 : e]), v0 = bf2f(vr[e]), vp_ = bf2f(vr[t < 255 ? e + 1 : e]);
        const float xm_ = bf2f(x1r[t > 0 ? e - 1 : e]), x0 = bf2f(x1r[e]), xp_ = bf2f(x1r[t < 255 ? e + 1 : e]);
        const float vm = t > 0 ? vm_ : 0.f, vp = t < 255 ? vp_ : 0.f, xm = t > 0 ? xm_ : 0.f, xp = t < 255 ? xp_ : 0.f;
        vvc[e] = (cw.v[3] + cw.v[0] * vm + cw.v[1] * v0 + cw.v[2] * vp) * (cw.x1[3] + cw.x1[0] * xm + cw.x1[1] * x0 + cw.x1[2] * xp);
    }
    if (tid < 520) Fc[tid] = tid < 512 ? bf2f(((const bf16*)(ws + WS_FGC))[(size_t)c * FZC + tid]) : 0.f;
    __syncthreads();
    const float inn = 1.0f / ((const float*)(ws + WS_CTL))[CW_NORM + 2 * 512 + c], hb = a.in[21][c];
    bf16* OBT = (bf16*)(ws + WS_OBT) + (size_t)c * MTOK + MLAT;
    {
        const int b = tid >> 6, t0 = 4 * (tid & 63), e0 = b * 256 + t0;
        float acc4[4] = {0.f, 0.f, 0.f, 0.f};
        const LAS float* fp = Fc + 252 - t0;
        for (int s4 = 0; s4 < 64; ++s4) {
            const f32x4 ga = *(const LAS f32x4*)(fp + 4 * s4), gb = *(const LAS f32x4*)(fp + 4 * s4 + 4), vq = *(const LAS f32x4*)(vvc + b * 256 + 4 * s4);
            const float g[8] = {ga[0], ga[1], ga[2], ga[3], gb[0], gb[1], gb[2], gb[3]};
#pragma unroll
            for (int i = 0; i < 4; ++i)
#pragma unroll
                for (int u = 0; u < 4; ++u) acc4[i] += g[4 - i + u] * vq[u];
        }
        float xs[6], gv[4];
        xs[0] = t0 > 0 ? bf2f(x0r[e0 - 1]) : 0.f;
#pragma unroll
        for (int i = 0; i < 4; ++i) { xs[1 + i] = bf2f(x0r[e0 + i]); gv[i] = bf2f(gbr[e0 + i]); }
        xs[5] = t0 + 4 < 256 ? bf2f(x0r[e0 + 4]) : 0.f;
        float o[4];
#pragma unroll
        for (int i = 0; i < 4; ++i) o[i] = (acc4[i] * inn + vvc[e0 + i] * hb) * (cw.x0[3] + cw.x0[0] * xs[i] + cw.x0[1] * xs[i + 1] + cw.x0[2] * xs[i + 2]) * silu_f(gv[i]);
        v2u ow; ow.x = pk2(o[0], o[1]); ow.y = pk2(o[2], o[3]);
        *(v2u*)(OBT + e0) = ow;
    }
    __syncthreads();
}
}


__device__ __forceinline__ void phase_mix(const Args& a, Frame& F, const int l, const int part = -1) {
    unsigned* qctr = (unsigned*)(a.ws + WS_CTL) + CW_QUEUE + 64 * l + (part == 1 ? 128 : 0);
    volatile LAS int* slot = (volatile LAS int*)(F.lds + LDS_BYTES - 64);
    const int ntasks = l == 0 ? 64 + 512 + 64 + 512 : 64 + 512;
    for (;;) {
        if (F.tid == 0) slot[0] = (int)atomicAdd(qctr, 1u);
        __syncthreads();
        const int t = __builtin_amdgcn_readfirstlane(slot[0]);
        __syncthreads();
        if (t >= ntasks) break;
        if (part == 0 && !(t < 64 || (t >= 576 && t < 640))) continue;
        if (part == 1 && (t < 64 || (t >= 576 && t < 640))) continue;
        if (t < 64) scan::scan_unit(F.lds, (bf16*)(a.ws + WS_PA), (bf16*)(a.ws + WS_OC), t >> 3, (t >> 1) & 3, t & 1, false);
        else if (t < 576) hy::hyena_channel(F.lds, a, l, t - 64);
        else if (t < 640) { const int u = t - 576; scan::scan_unit(F.lds, (bf16*)(a.ws + WS_PA), (bf16*)(a.ws + WS_OC), u >> 3, (u >> 1) & 3, u & 1, true); }
        else hy::hyena_ctx_channel(F.lds, a, t - 640);
        __syncthreads();
    }
}

__device__ __forceinline__ void phase_finalize_ox(const Args& a, Frame& F, int l) {
    unsigned char* ws = a.ws;
    const bf16* PA = (const bf16*)(ws + WS_PA);
    const bf16* OC = (const bf16*)(ws + WS_OC);
    bf16* XA = (bf16*)(ws + WS_XA);
    const float* gnw = a.in[10] + l * 512;
    const int gw = F.vcu * NWAVES + F.wave, NGW = F.G * NWAVES;
    const int ntok = (l == 0) ? MTOK : MLAT;
    for (int tok = gw; tok < ntok; tok += NGW) {
        const bool isctx = tok >= MLAT;
        const int c8 = 8 * F.lane;
        const bf16* pf = isctx ? OC + (size_t)(tok - MLAT) * 512 + c8 : PA + (size_t)tok * PA_LD + 512 + c8;
        const bf16* pb = isctx ? OC + (size_t)MCTX * 512 + (size_t)(tok - MLAT) * 512 + c8 : PA + (size_t)tok * PA_LD + 1024 + c8;
        const v4u wf = *(const v4u*)pf, wb = *(const v4u*)pb, wg = *(const v4u*)(PA + (size_t)tok * PA_LD + 2048 + c8);
        float o[8], g[8];
#pragma unroll
        for (int e = 0; e < 4; ++e) {
            o[2 * e] = bf2f((unsigned short)(wf[e] & 0xffff)) + bf2f((unsigned short)(wb[e] & 0xffff));
            o[2 * e + 1] = bf2f((unsigned short)(wf[e] >> 16)) + bf2f((unsigned short)(wb[e] >> 16));
            g[2 * e] = bf2f((unsigned short)(wg[e] & 0xffff)); g[2 * e + 1] = bf2f((unsigned short)(wg[e] >> 16));
        }
        float s = 0.f;
#pragma unroll
        for (int e = 0; e < 8; ++e) s += o[e] * o[e];
        s += __shfl_xor(s, 1); s += __shfl_xor(s, 2); s += __shfl_xor(s, 4); s += __shfl_xor(s, 8);
        const float rstd = 1.0f / sqrtf(s * (1.0f / HD) + EPS);
        float y[8];
#pragma unroll
        for (int e = 0; e < 8; ++e) y[e] = o[e] * rstd * gnw[c8 + e] * silu_f(g[e]);
        v4u w; w.x = pk2(y[0], y[1]); w.y = pk2(y[2], y[3]); w.z = pk2(y[4], y[5]); w.w = pk2(y[6], y[7]);
        *(v4u*)(XA + (size_t)tok * D + c8) = w;
    }
    LAS unsigned short* t = (LAS unsigned short*)(F.lds + F.wave * 16384);
    const int ntt = ntok / 64;
    for (int it = gw; it < 8 * ntt; it += NGW) {
        const int ct = it / ntt, tt = it % ntt, c0 = ct * 64, t0 = tt * 64;
        const bf16* OBT = (const bf16*)(ws + WS_OBT);
#pragma unroll
        for (int i = 0; i < 8; ++i) {
            const int e = F.lane + 64 * i, c = e >> 3, ch = e & 7;
            const v4u w = *(const v4u*)(OBT + (size_t)(c0 + c) * MTOK + t0 + 8 * ch);
#pragma unroll
            for (int q = 0; q < 4; ++q) { t[c * 66 + 8 * ch + 2 * q] = (unsigned short)(w[q] & 0xffff); t[c * 66 + 8 * ch + 2 * q + 1] = (unsigned short)(w[q] >> 16); }
        }
        asm volatile("s_waitcnt lgkmcnt(0)" ::: "memory");
#pragma unroll
        for (int i = 0; i < 8; ++i) {
            const int e = F.lane + 64 * i, tk = e >> 3, cg = e & 7;
            unsigned short h[8];
#pragma unroll
            for (int q = 0; q < 8; ++q) h[q] = t[(8 * cg + q) * 66 + tk];
            v4u w; w.x = h[0] | ((unsigned)h[1] << 16); w.y = h[2] | ((unsigned)h[3] << 16); w.z = h[4] | ((unsigned)h[5] << 16); w.w = h[6] | ((unsigned)h[7] << 16);
            *(v4u*)(XA + (size_t)(t0 + tk) * D + 512 + c0 + 8 * cg) = w;
        }
        asm volatile("s_waitcnt lgkmcnt(0)" ::: "memory");
    }
}

__device__ __forceinline__ void phase_final_norm(const Args& a, Frame& F) {
    const float* w = a.in[22];
    const bf16* DL = (const bf16*)(a.ws + WS_PB);
    const int gw = F.vcu * NWAVES + F.wave, NGW = F.G * NWAVES;
    for (int tok = gw; tok < MLAT; tok += NGW) {
        float* xr = a.out + (size_t)tok * D;
        f32x4 v[4]; float s = 0.f;
#pragma unroll
        for (int j = 0; j < 4; ++j) { v[j] = *(const f32x4*)(xr + 256 * j + 4 * F.lane); const v2u dw = *(const v2u*)(DL + (size_t)tok * D + 256 * j + 4 * F.lane);
            v[j].x += bf2f((unsigned short)(dw.x & 0xffffu)); v[j].y += bf2f((unsigned short)(dw.x >> 16)); v[j].z += bf2f((unsigned short)(dw.y & 0xffffu)); v[j].w += bf2f((unsigned short)(dw.y >> 16));
            s += (v[j].x * v[j].x + v[j].y * v[j].y) + (v[j].z * v[j].z + v[j].w * v[j].w); }
        const float rstd = 1.0f / sqrtf(wave_sum(s) * (1.0f / D) + EPS);
#pragma unroll
        for (int j = 0; j < 4; ++j) { const f32x4 w4 = *(const f32x4*)(w + 256 * j + 4 * F.lane); *(f32x4*)(xr + 256 * j + 4 * F.lane) = v[j] * rstd * w4; }
    }
}

enum { PH_PRO = 0, PH_NORM0 = 1, PH_IN0 = 2, PH_MIX0 = 3, PH_FIN0 = 4, PH_OUT0 = 5, PH_NORM1 = 6, PH_IN1 = 7, PH_MIX1 = 8, PH_FIN1 = 9, PH_OUT1 = 10, PH_FINAL = 11 };

__device__ __forceinline__ Frame mkframe(unsigned char* lds) {
    Frame F;
    F.lds = (LAS unsigned char*)lds;
    F.tid = threadIdx.x; F.lane = F.tid & 63; F.wave = __builtin_amdgcn_readfirstlane(F.tid >> 6);
    F.G = gridDim.x; { const int bx = blockIdx.x; F.vcu = (F.G % 8 == 0) ? (bx % 8) * (F.G / 8) + bx / 8 : bx; }
    return F;
}
template <int l> __device__ __forceinline__ void run_inproj(const Args& args, unsigned char* lds) {
    unsigned char* ws = args.ws; Frame F = mkframe(lds);
    pg8::Gemm g{(const bf16*)(ws + WS_XA), (const bf16*)(ws + WS_WIN) + (size_t)l * NIN * D, D};
    pg8::Sched S; S.init(128, 18, F.G, (int)blockIdx.x, 8, l == 0 ? 18 : 8);
    EpiIn E{(bf16*)(ws + WS_PA), (bf16*)(ws + WS_PB), (const float*)(ws + WS_LBS) + l * 1024};
    pg8::gemm_phase<EpiIn, true, true>(F.lds, g, S, E);
}
template <int l> __device__ __forceinline__ void run_outproj(const Args& args, unsigned char* lds) {
    unsigned char* ws = args.ws; Frame F = mkframe(lds);
    pg8::Gemm g{(const bf16*)(ws + WS_XA), (const bf16*)(ws + WS_WOUT) + (size_t)l * D * D, D};
    pg8::Sched S; S.init(128, 4, F.G, (int)blockIdx.x, l == 0 ? 8 : 0, 4);
    EpiOut E{(bf16*)(ws + WS_PB), (const float*)(ws + WS_MOD) + (size_t)l * 9 * 3 * D};
    pg8::gemm_phase<EpiOut, true, true>(F.lds, g, S, E);
}
__global__ void __launch_bounds__(NTHR, 2) mega(Args args) {
    extern __shared__ __attribute__((aligned(16))) unsigned char lds[];
    const int lo = args.ph_lo, hi = args.ph_hi;
#define IN(k) (lo <= (k) && (k) < hi)
    volatile LAS unsigned* bst = (volatile LAS unsigned*)((LAS unsigned char*)lds + LDS_BYTES - 32);
    if (threadIdx.x < 8) ((volatile LAS unsigned*)((LAS unsigned char*)lds + LDS_BYTES - 32))[threadIdx.x] = 0u;
    __syncthreads();
    XcdBarrier bar; bar.bar = (unsigned*)(args.ws + WS_CTL) + CW_BAR; bar.x = 0; bar.st = bst;
    if (hi - lo > 1) bar = xcd_barrier_post((unsigned*)(args.ws + WS_CTL) + CW_BAR, bst);
#ifdef PROBE_ID
    volatile LAS unsigned long long* pts = (volatile LAS unsigned long long*)((LAS unsigned char*)lds + LDS_BYTES - 512);
    if (threadIdx.x == 0) pts[0] = __builtin_amdgcn_s_memrealtime();
#define SEAM(k) do { if (IN((k) + 1)) xcd_barrier(bar); else __syncthreads(); if (threadIdx.x == 0) pts[(k) + 1] = __builtin_amdgcn_s_memrealtime(); } while (0)
#else
#define SEAM(k) do { if (IN((k) + 1)) xcd_barrier(bar); else __syncthreads(); } while (0)
#endif
    if (IN(PH_PRO)) { Frame F = mkframe(lds); phase_prologue(args, F); SEAM(PH_PRO); }
    if (IN(PH_NORM0)) { Frame F = mkframe(lds); phase_normrows(args, F, 0, args.in[0], args.in[2]); SEAM(PH_NORM0); }
    if (IN(PH_IN0)) { run_inproj<0>(args, lds); { Frame F = mkframe(lds); phase_filters_l0(args, F); } SEAM(PH_IN0); }
#ifdef SPLIT_MIX
    if (IN(PH_MIX0)) { Frame F = mkframe(lds); phase_mix(args, F, 0, 0); xcd_barrier(bar); if (threadIdx.x == 0) pts[15] = __builtin_amdgcn_s_memrealtime(); phase_mix(args, F, 0, 1); SEAM(PH_MIX0); }
#else
    if (IN(PH_MIX0)) { Frame F = mkframe(lds); phase_mix(args, F, 0); SEAM(PH_MIX0); }
#endif
    if (IN(PH_FIN0)) { Frame F = mkframe(lds); phase_finalize_ox(args, F, 0); SEAM(PH_FIN0); }
    if (IN(PH_OUT0)) { run_outproj<0>(args, lds); { Frame F = mkframe(lds); phase_filters_l1(args, F); } SEAM(PH_OUT0); }
    if (IN(PH_NORM1)) { Frame F = mkframe(lds); phase_normrows(args, F, 1, args.in[0], args.in[2]); SEAM(PH_NORM1); }
    if (IN(PH_IN1)) { run_inproj<1>(args, lds); SEAM(PH_IN1); }
    if (IN(PH_MIX1)) { Frame F = mkframe(lds); phase_mix(args, F, 1); SEAM(PH_MIX1); }
    if (IN(PH_FIN1)) { Frame F = mkframe(lds); phase_finalize_ox(args, F, 1); SEAM(PH_FIN1); }
    if (IN(PH_OUT1)) { run_outproj<1>(args, lds); SEAM(PH_OUT1); }
    if (IN(PH_FINAL)) { Frame F = mkframe(lds); phase_final_norm(args, F); SEAM(PH_FINAL); }
#ifdef PROBE_ID
    if (blockIdx.x == 0 && threadIdx.x == 0) {
#ifdef SPLIT_MIX
        const unsigned long long dt = (PROBE_ID == 100) ? pts[15] - pts[PH_MIX0] : pts[PH_MIX0 + 1] - pts[15];
#else
        const unsigned long long dt = (PROBE_ID >= 200) ? ((PROBE_ID == 220 || PROBE_ID >= 226) ? 1ull : 16ull) * (pts[PROBE_ID - 200 + 1] - pts[PROBE_ID - 200]) : pts[PROBE_ID + 1] - pts[PROBE_ID];
#endif
        const unsigned long long t0 = __builtin_amdgcn_s_memrealtime();
        unsigned long long wt = 4ull * dt; if (wt > 300000ull) wt = 300000ull;
        while (__builtin_amdgcn_s_memrealtime() - t0 < wt) __builtin_amdgcn_s_sleep(8);
    }
#endif
#undef IN
#undef SEAM
}

extern "C" void kernel_launch(void* const* d_in, const int* in_sizes, int n_in, void* d_out, int out_size, void* d_ws, size_t ws_size, hipStream_t stream) {
    static int grid = 0;
    if (grid == 0) {
        if (n_in != 23 || ws_size < WS_END) { fprintf(stderr, "kernel_launch: unexpected n_in %d / ws_size %zu\n", n_in, ws_size); grid = -1; return; }
        int dev = 0, cus = 0;
        if (hipGetDevice(&dev) != hipSuccess || hipDeviceGetAttribute(&cus, hipDeviceAttributeMultiprocessorCount, dev) != hipSuccess) { grid = -1; return; }
        if (hipFuncSetAttribute((const void*)mega, hipFuncAttributeMaxDynamicSharedMemorySize, LDS_BYTES) != hipSuccess) { fprintf(stderr, "kernel_launch: hipFuncSetAttribute failed\n"); grid = -1; return; }
        grid = cus;
    }
    if (grid < 0) return;
    (void)hipMemsetAsync((char*)d_ws + WS_CTL, 0, CTL_ZERO_BYTES, stream);
    Args a{};
    for (int i = 0; i < 23; ++i) a.in[i] = (const float*)d_in[i];
    a.out = (float*)d_out; a.ws = (unsigned char*)d_ws;
    a.ph_lo = 0; a.ph_hi = PH_FINAL + 1;
    hipLaunchKernelGGL(mega, dim3(grid), dim3(NTHR), LDS_BYTES, stream, a);
}
```

```cpp
#include <hip/hip_runtime.h>
#include <cstdio>
#include <cstdint>
#include <math.h>

namespace pg8 {
#define PG8_LAS __attribute__((address_space(3)))
typedef unsigned short bf16_t;
typedef short bf16x8 __attribute__((ext_vector_type(8)));
typedef float f32x4 __attribute__((ext_vector_type(4)));
typedef unsigned u32x4 __attribute__((ext_vector_type(4)));
typedef unsigned u32x2 __attribute__((ext_vector_type(2)));
constexpr int BM = 256, BK = 64, HALF = 128, HTB = HALF * BK * 2, STAGE_BYTES = 8 * HTB, NXCD = 8, WGM = 8;

__host__ __device__ __forceinline__ int lds_byte(int r, int c) { const int st = (r >> 4) * 2 + (c >> 5), rr = r & 15, cc = c & 31, ob = rr * 64 + cc * 2; return st * 1024 + (ob ^ (((ob >> 9) & 1) << 5)); }
__host__ __device__ __forceinline__ void stage_rc(int b, int& R, int& C) { const int st = b / 1024, sb = b % 1024, swz = sb ^ (((sb >> 9) & 1) << 5); R = (st >> 1) * 16 + swz / 64; C = (st & 1) * 32 + (swz % 64) / 2; }
__host__ __device__ __forceinline__ int perm32(int rho) { const int n = rho >> 4, i = rho & 15; return 8 * (i >> 2) + 4 * n + (i & 3); }

struct Unit { int pm, pn; };
struct Gemm { const bf16_t* A; const bf16_t* Bt; int K; };

struct Sched {
    int nM, nN, nwg, G, c, nctx, nctxN;
    __device__ void init(int nM_, int nN_, int G_, int c_, int nctxM, int nctxN_) { nM = nM_; nN = nN_; nwg = nM * nN; G = G_; c = c_; nctx = nctxM * nctxN_; nctxN = nctxN_ > 0 ? nctxN_ : 1; }
    __device__ bool next(int i, Unit& u) const {
        const long L = (long)i * G + c;
        if (L >= nwg) { const long L2 = L - nwg; if (L2 >= nctx) return false; u.pm = nM + (int)(L2 / nctxN); u.pn = (int)(L2 % nctxN); return true; }
        int wgid = (int)L; { const int q = nwg / NXCD, r = nwg % NXCD, xcd = wgid % NXCD, off = wgid / NXCD; wgid = (xcd < r ? xcd * (q + 1) : r * (q + 1) + (xcd - r) * q) + off; }
        const int nig = WGM * nN, gid = wgid / nig, fm = gid * WGM, gsz = (nM - fm) < WGM ? (nM - fm) : WGM;
        u.pm = fm + ((wgid % nig) % gsz); u.pn = (wgid % nig) / gsz; return true;
    }
};

template <class Epi, bool ALIGN_EPI, bool SP2>
__device__ __forceinline__ void gemm_phase(PG8_LAS unsigned char* lds, const Gemm g, const Sched& S, const Epi& E) {
    const int tid = threadIdx.x, wid = __builtin_amdgcn_readfirstlane(tid >> 6), lane = tid & 63, wr = wid >> 2, wc = wid & 3, fr = lane & 15, fq = lane >> 4;
    const int K = g.K, nt = K / BK;
    unsigned voffA[2], voffB[2];
#pragma unroll
    for (int i = 0; i < 2; ++i) { int R, C; stage_rc(tid * 16 + i * 8192, R, C); const int Rb = Epi::PERM ? ((R & ~31) + perm32(R & 31)) : R;
        voffA[i] = (unsigned)(R * K + C) * 2u; voffB[i] = (unsigned)(Rb * K + C) * 2u; }
    const size_t kstep = (size_t)(BK * 2);
    const size_t hstep = (size_t)HALF * K * 2;
    const size_t tstep = 2 * hstep;
    const unsigned ldsw = (unsigned)wid * 1024u;
    const int aoff = lds_byte(wr * 64 + fr, fq * 8), boff = lds_byte(wc * 32 + fr, fq * 8);
#define PG8_SA(b, h) (((b) * 2 + (h)) * HTB)
#define PG8_SB(b, h) ((4 + (b) * 2 + (h)) * HTB)
#define PG8_STAGE(bufoff, gbase, voff) do { _Pragma("unroll") for (int _i = 0; _i < 2; ++_i) \
        __builtin_amdgcn_global_load_lds((const unsigned*)((const char*)(gbase) + (voff)[_i]), (PG8_LAS unsigned*)(lds + (bufoff) + ldsw + _i * 8192), 16, 0, 0); } while (0)
#define PG8_LDA(dst, b, h) do { _Pragma("unroll") for (int m = 0; m < 4; ++m) _Pragma("unroll") for (int k = 0; k < 2; ++k) dst[m][k] = *(const PG8_LAS bf16x8*)(lds + PG8_SA(b, h) + aoff + m * 2048 + k * 1024); } while (0)
#define PG8_LDB(dst, b, h) do { _Pragma("unroll") for (int n = 0; n < 2; ++n) _Pragma("unroll") for (int k = 0; k < 2; ++k) dst[n][k] = *(const PG8_LAS bf16x8*)(lds + PG8_SB(b, h) + boff + n * 2048 + k * 1024); } while (0)
#define PG8_MMA(ai, bj, At, Bt) do { __builtin_amdgcn_s_setprio(1); _Pragma("unroll") for (int m = 0; m < 4; ++m) _Pragma("unroll") for (int n = 0; n < 2; ++n) _Pragma("unroll") for (int k = 0; k < 2; ++k) \
        acc[ai][bj][m][n] = __builtin_amdgcn_mfma_f32_16x16x32_bf16(Bt[n][k], At[m][k], acc[ai][bj][m][n], 0, 0, 0); __builtin_amdgcn_s_setprio(0); } while (0)
#define PG8_WAIT_V(n) asm volatile("s_waitcnt vmcnt(" #n ")" ::: "memory")
#define PG8_WAIT_L(n) asm volatile("s_waitcnt lgkmcnt(" #n ")" ::: "memory")
#define PG8_BAR __builtin_amdgcn_s_barrier()
#define PG8_SCHED __builtin_amdgcn_sched_barrier(0)
    Unit cur, nxt; int ui = 0;
    if (!S.next(0, cur)) return;
    f32x4 acc[2][2][4][2];
#pragma unroll
    for (int a = 0; a < 2; ++a)
#pragma unroll
        for (int b = 0; b < 2; ++b)
#pragma unroll
            for (int m = 0; m < 4; ++m)
#pragma unroll
                for (int n = 0; n < 2; ++n) acc[a][b][m][n] = (f32x4){0.f, 0.f, 0.f, 0.f};
    bf16x8 At[4][2], B0[2][2], B1[2][2];
    const char* cA = E.swap(cur) ? (const char*)g.Bt + (size_t)cur.pn * tstep : (const char*)g.A + (size_t)cur.pm * tstep;
    const char* cB = E.swap(cur) ? (const char*)g.A + (size_t)cur.pm * tstep : (const char*)g.Bt + (size_t)cur.pn * tstep;
    if constexpr (SP2) {
        PG8_STAGE(PG8_SB(0, 0), cB, voffB); PG8_STAGE(PG8_SB(0, 1), cB + hstep, voffB); PG8_STAGE(PG8_SA(0, 0), cA, voffA); PG8_STAGE(PG8_SA(0, 1), cA + hstep, voffA);
        if (wr == 1) PG8_BAR;
        PG8_WAIT_V(2); PG8_BAR;
        PG8_STAGE(PG8_SB(1, 0), cB + kstep, voffB); PG8_STAGE(PG8_SA(1, 0), cA + kstep, voffA); PG8_STAGE(PG8_SB(1, 1), cB + hstep + kstep, voffB);
        PG8_WAIT_V(6); PG8_BAR;
    } else {
        PG8_STAGE(PG8_SB(0, 0), cB, voffB); PG8_STAGE(PG8_SA(0, 0), cA, voffA); PG8_STAGE(PG8_SB(0, 1), cB + hstep, voffB); PG8_STAGE(PG8_SA(0, 1), cA + hstep, voffA);
        if (wr == 1) PG8_BAR;
        PG8_WAIT_V(4); PG8_BAR;
        PG8_STAGE(PG8_SB(1, 0), cB + kstep, voffB); PG8_STAGE(PG8_SA(1, 0), cA + kstep, voffA); PG8_STAGE(PG8_SB(1, 1), cB + hstep + kstep, voffB);
        PG8_WAIT_V(6); PG8_BAR;
    }
    for (;;) {
        const bool has_next = S.next(ui + 1, nxt);
        const bool nsw = has_next && E.swap(nxt);
        const char* nA = has_next ? (nsw ? (const char*)g.Bt + (size_t)nxt.pn * tstep : (const char*)g.A + (size_t)nxt.pm * tstep) : cA;
        const char* nB = has_next ? (nsw ? (const char*)g.A + (size_t)nxt.pm * tstep : (const char*)g.Bt + (size_t)nxt.pn * tstep) : cB;
        for (int t = 0; t < nt; t += 2) {
            const bool last = (t == nt - 2);
            const char* a1 = cA + (size_t)(t + 1) * kstep;
            const char* a2 = last ? nA : cA + (size_t)(t + 2) * kstep; const char* b2 = last ? nB : cB + (size_t)(t + 2) * kstep;
            const char* a3 = a2 + kstep; const char* b3 = b2 + kstep;
            if constexpr (SP2) {
            PG8_LDB(B0, 0, 0); PG8_LDB(B1, 0, 1); PG8_SCHED; PG8_LDA(At, 0, 0); PG8_STAGE(PG8_SA(1, 1), a1 + hstep, voffA);
            PG8_WAIT_V(8); PG8_WAIT_L(0); PG8_BAR; PG8_MMA(0, 0, At, B0); PG8_MMA(0, 1, At, B1); PG8_BAR; PG8_SCHED;
            PG8_LDA(At, 0, 1); PG8_STAGE(PG8_SB(0, 0), b2, voffB); PG8_STAGE(PG8_SB(0, 1), b2 + hstep, voffB); PG8_STAGE(PG8_SA(0, 0), a2, voffA);
            PG8_WAIT_V(8); PG8_WAIT_L(0); PG8_BAR; PG8_MMA(1, 0, At, B0); PG8_MMA(1, 1, At, B1); PG8_BAR; PG8_SCHED;
            PG8_LDB(B0, 1, 0); PG8_LDB(B1, 1, 1); PG8_SCHED; PG8_LDA(At, 1, 0); PG8_STAGE(PG8_SA(0, 1), a2 + hstep, voffA);
            PG8_WAIT_V(8); PG8_WAIT_L(0); PG8_BAR; PG8_MMA(0, 0, At, B0); PG8_MMA(0, 1, At, B1); PG8_BAR; PG8_SCHED;
            PG8_LDA(At, 1, 1); PG8_STAGE(PG8_SB(1, 0), b3, voffB); PG8_STAGE(PG8_SB(1, 1), b3 + hstep, voffB); PG8_STAGE(PG8_SA(1, 0), a3, voffA);
            PG8_WAIT_V(8); PG8_WAIT_L(0); PG8_BAR; PG8_MMA(1, 0, At, B0); PG8_MMA(1, 1, At, B1); PG8_BAR; PG8_SCHED;
            } else {
            PG8_LDB(B0, 0, 0); PG8_SCHED; PG8_LDA(At, 0, 0); PG8_STAGE(PG8_SA(1, 1), a1 + hstep, voffA);
            PG8_WAIT_L(8); PG8_BAR; PG8_WAIT_L(0); PG8_MMA(0, 0, At, B0); PG8_BAR; PG8_SCHED;
            PG8_LDB(B1, 0, 1); PG8_STAGE(PG8_SB(0, 0), b2, voffB);
            PG8_BAR; PG8_WAIT_L(0); PG8_MMA(0, 1, At, B1); PG8_BAR;
            PG8_LDA(At, 0, 1); PG8_STAGE(PG8_SA(0, 0), a2, voffA);
            PG8_BAR; PG8_WAIT_L(0); PG8_MMA(1, 0, At, B0); PG8_BAR; PG8_SCHED;
            PG8_STAGE(PG8_SB(0, 1), b2 + hstep, voffB);
            PG8_WAIT_V(6); PG8_BAR; PG8_MMA(1, 1, At, B1); PG8_BAR;
            PG8_LDB(B0, 1, 0); PG8_SCHED; PG8_LDA(At, 1, 0); PG8_STAGE(PG8_SA(0, 1), a2 + hstep, voffA);
            PG8_WAIT_L(8); PG8_BAR; PG8_WAIT_L(0); PG8_MMA(0, 0, At, B0); PG8_BAR; PG8_SCHED;
            PG8_LDB(B1, 1, 1); PG8_STAGE(PG8_SB(1, 0), b3, voffB);
            PG8_BAR; PG8_WAIT_L(0); PG8_MMA(0, 1, At, B1); PG8_BAR;
            PG8_LDA(At, 1, 1); PG8_STAGE(PG8_SA(1, 0), a3, voffA);
            PG8_BAR; PG8_WAIT_L(0); PG8_MMA(1, 0, At, B0); PG8_BAR; PG8_SCHED;
            PG8_STAGE(PG8_SB(1, 1), b3 + hstep, voffB);
            PG8_WAIT_V(6); PG8_BAR; PG8_MMA(1, 1, At, B1); PG8_BAR;
            }
        }
        if constexpr (ALIGN_EPI) { if (wr == 0) PG8_BAR; }
        E(acc, cur, wr, wc, fr, fq);
        if (!has_next) break;
#pragma unroll
        for (int a = 0; a < 2; ++a)
#pragma unroll
            for (int b = 0; b < 2; ++b)
#pragma unroll
                for (int m = 0; m < 4; ++m)
#pragma unroll
                    for (int n = 0; n < 2; ++n) acc[a][b][m][n] = (f32x4){0.f, 0.f, 0.f, 0.f};
        cur = nxt; cA = nA; cB = nB; ++ui;
        if constexpr (ALIGN_EPI) { if (wr == 1) PG8_BAR; }
    }
    PG8_WAIT_V(0);
    if constexpr (!ALIGN_EPI) { if (wr == 0) PG8_BAR; }
    PG8_BAR;
#undef PG8_SA
#undef PG8_SB
#undef PG8_STAGE
#undef PG8_LDA
#undef PG8_LDB
#undef PG8_MMA
#undef PG8_WAIT_V
#undef PG8_WAIT_L
#undef PG8_BAR
#undef PG8_SCHED
}
}

constexpr int D = 1024, NB = 8, LX = 4096, LCX = 256, NIN = 4608, DA = 512, DB = 512, HD = 128;
constexpr int MLAT = NB * LX, MCTX = NB * LCX, MTOK = MLAT + MCTX;
constexpr int PA_LD = 3072;
constexpr int FZ = 8448, FZC = 640;
constexpr float EPS = 1e-6f;
constexpr float HY_MIN_DECAY = -3.0701134573253944f, HY_MAX_DECAY = -15.350567286626972f;
constexpr int NWAVES = 8, NTHR = 512;

constexpr size_t MiB = 1u << 20;
constexpr size_t WS_CTL = 0, CTL_ZERO_BYTES = 1 * MiB;
constexpr size_t WS_MOD = 1 * MiB;
constexpr size_t WS_LBS = WS_MOD + 256 * 1024;
constexpr size_t WS_WIN = 6 * MiB;
constexpr size_t WS_WOUT = 24 * MiB;
constexpr size_t WS_FG = 28 * MiB;
constexpr size_t WS_FGC = 45 * MiB;
constexpr size_t WS_CTX1 = 46 * MiB;
constexpr size_t WS_OC = 2 * MiB;
constexpr size_t WS_XA = 54 * MiB;
constexpr size_t WS_PA = 122 * MiB;
constexpr size_t WS_PB = 326 * MiB;
constexpr size_t WS_OBT = 462 * MiB;
constexpr size_t WS_HK = 326 * MiB;
constexpr size_t WS_SCL = 496 * MiB;
constexpr size_t WS_END = 504 * MiB;
constexpr int CW_NORM = 1024;
constexpr int CW_BAR = 8192;
constexpr int CW_QUEUE = 4096;

constexpr int LDS_BYTES = 156 * 1024;
#define LAS __attribute__((address_space(3)))
#define GAS __attribute__((address_space(1)))
typedef unsigned short bf16;
typedef unsigned v4u __attribute__((ext_vector_type(4)));
typedef unsigned v2u __attribute__((ext_vector_type(2)));
typedef float f32x4 __attribute__((ext_vector_type(4)));

typedef __bf16 bf2_t __attribute__((ext_vector_type(2)));
typedef float f2_t __attribute__((ext_vector_type(2)));
__device__ __forceinline__ unsigned pk2(float lo, float hi) { const f2_t v = {lo, hi}; return __builtin_bit_cast(unsigned, __builtin_convertvector(v, bf2_t)); }
__device__ __forceinline__ unsigned f2bf(float f) { return pk2(f, 0.f) & 0xffffu; }
__device__ __forceinline__ float bf2f(unsigned short h) { return __builtin_bit_cast(float, (unsigned)h << 16); }
__device__ __forceinline__ unsigned f2h(float f) { _Float16 h = (_Float16)f; return (unsigned)__builtin_bit_cast(unsigned short, h); }
__device__ __forceinline__ unsigned pk2h(float lo, float hi) { return f2h(lo) | (f2h(hi) << 16); }
__device__ __forceinline__ float h2f(unsigned short u) { return (float)__builtin_bit_cast(_Float16, u); }
__device__ __forceinline__ float silu_f(float x) { return x * __builtin_amdgcn_rcpf(1.0f + __expf(-x)); }
__device__ __forceinline__ float sigmoid_f(float x) { return __builtin_amdgcn_rcpf(1.0f + __expf(-x)); }
__device__ __forceinline__ float wave_sum(float v) {
#pragma unroll
    for (int o = 1; o < 64; o <<= 1) v += __shfl_xor(v, o);
    return v;
}


#define PSTAMP_(lds_, k_) do { if (threadIdx.x == 0) ((volatile LAS unsigned long long*)((lds_) + LDS_BYTES - 512))[(k_)] = __builtin_amdgcn_s_memrealtime(); } while (0)
#if defined(PROBE_ID) && PROBE_ID >= 216 && PROBE_ID < 220
#define PSTAMP_H(lds_, k_) PSTAMP_(lds_, k_)
#else
#define PSTAMP_H(lds_, k_) do { } while (0)
#endif
#if defined(PROBE_ID) && PROBE_ID >= 226 && PROBE_ID < 230
#define PSTAMP_P(lds_, k_) PSTAMP_(lds_, k_)
#else
#define PSTAMP_P(lds_, k_) do { } while (0)
#endif
#if defined(PROBE_ID) && PROBE_ID >= 220 && PROBE_ID < 226
#define PSTAMP_S(lds_, k_) PSTAMP_(lds_, k_)
#else
#define PSTAMP_S(lds_, k_) do { } while (0)
#endif
typedef GAS unsigned gu32;
#define XB_TMO      128
#define XB_XCNT(j)  (256  + 64 * (j))
#define XB_XSUB(j)  (1280 + 64 * (j))
#define XB_XGEN(j)  (2304 + 64 * (j))
#define XB_TOP      3328
#define XB_TOPGEN   3392
#define XCD_BAR_WORDS 3456
#define XB_SPIN_CAP (1u << 18)
__device__ __forceinline__ unsigned xb_ld(unsigned* p)              { return __hip_atomic_load(p, __ATOMIC_RELAXED, __HIP_MEMORY_SCOPE_AGENT); }
__device__ __forceinline__ unsigned xb_add(unsigned* p, unsigned v) { return __hip_atomic_fetch_add(p, v, __ATOMIC_RELAXED, __HIP_MEMORY_SCOPE_AGENT); }
__device__ __forceinline__ unsigned xb_xcc_id() { return (unsigned)__builtin_amdgcn_s_getreg((3 << 11) | 20) & 0xFu; }
#define XB_SPIN(cond, bar) do { unsigned _sp = 0; while (cond) { __builtin_amdgcn_s_sleep(1); \
    if ((++_sp & 255u) == 0u) { if (xb_ld(&(bar)[XB_TMO])) break; if (_sp > XB_SPIN_CAP) { atomicAdd(&(bar)[XB_TMO], 1u); break; } } } } while (0)
struct XcdBarrier { unsigned* bar; unsigned x; volatile LAS unsigned* st; };
__device__ __forceinline__ XcdBarrier xcd_barrier_post(unsigned* bar, volatile LAS unsigned* st) {
    XcdBarrier b; b.bar = bar; b.x = xb_xcc_id(); b.st = st;
    if (threadIdx.x == 0) (void)xb_add(&bar[XB_XCNT(b.x)], 1u);
    return b;
}
__device__ __forceinline__ void xcd_barrier_complete(unsigned* bar, unsigned x, unsigned& nloc, unsigned& nx) {
    const unsigned G = gridDim.x * gridDim.y * gridDim.z;
    unsigned sum, cnt, mine, sp = 0u;
    for (;;) {
        sum = 0u; cnt = 0u; mine = 0u;
#pragma unroll
        for (unsigned j = 0; j < 16; ++j) { const unsigned c = xb_ld(&bar[XB_XCNT(j)]); sum += c; cnt += (c > 0u) ? 1u : 0u; mine = (j == x) ? c : mine; }
        if (sum == G) break;
        __builtin_amdgcn_s_sleep(1);
        if ((++sp & 255u) == 0u) { if (xb_ld(&bar[XB_TMO])) break; if (sp > XB_SPIN_CAP) { atomicAdd(&bar[XB_TMO], 1u); break; } }
    }
    nloc = mine > 0u ? mine : 1u; nx = cnt > 0u ? cnt : 1u;
}
__device__ __forceinline__ void xcd_barrier(const XcdBarrier& b) {
    asm volatile("s_waitcnt vmcnt(0)" ::: "memory");
    __syncthreads();
    if (threadIdx.x == 0) {
        unsigned* bar = b.bar;
        __builtin_amdgcn_s_waitcnt(0);
        unsigned nloc = b.st[0], nx = b.st[1];
        if (nloc == 0u) { xcd_barrier_complete(bar, b.x, nloc, nx); b.st[0] = nloc; b.st[1] = nx; }
        const unsigned old = xb_add(&bar[XB_XSUB(b.x)], 1u);
        const unsigned gen = old / nloc;
        if (old + 1u == (gen + 1u) * nloc) {
            __builtin_amdgcn_fence(__ATOMIC_RELEASE, "agent");
            asm volatile("s_waitcnt vmcnt(0)" ::: "memory");
            const unsigned og = xb_add(&bar[XB_TOP], 1u);
            const unsigned tg = og / nx;
            if (og + 1u == (tg + 1u) * nx) xb_add(&bar[XB_TOPGEN], 1u);
            else XB_SPIN(xb_ld(&bar[XB_TOPGEN]) == tg, bar);
            __builtin_amdgcn_fence(__ATOMIC_ACQUIRE, "agent");
            xb_add(&bar[XB_XGEN(b.x)], 1u);
            asm volatile("s_waitcnt vmcnt(0)" ::: "memory");
        } else {
            XB_SPIN(xb_ld(&bar[XB_XGEN(b.x)]) == gen, bar);
            __builtin_amdgcn_fence(__ATOMIC_ACQUIRE, "agent");
            asm volatile("s_waitcnt vmcnt(0)" ::: "memory");
        }
    }
    __syncthreads();
}

struct EpiIn {
    static constexpr bool PERM = true;
    bf16* PA; bf16* PB; const float* lb;
    __device__ __forceinline__ bool swap(const pg8::Unit& u) const { return u.pn >= 10; }
    __device__ __forceinline__ void operator()(const f32x4 (&acc)[2][2][4][2], const pg8::Unit& u, int wr, int wc, int fr, int fq) const {
        if (u.pn < 10) {
            const int type = u.pn >> 1;
            const int row0 = u.pm * 256 + wr * 64 + fr, col0 = u.pn * 256 + wc * 32 + 8 * fq;
#pragma unroll
            for (int bj = 0; bj < 2; ++bj) {
                float lbv[8];
#pragma unroll
                for (int e = 0; e < 8; ++e) lbv[e] = (type == 1 || type == 2) ? lb[col0 + bj * 128 + e - 512] : 0.f;
#pragma unroll
                for (int ai = 0; ai < 2; ++ai)
#pragma unroll
                    for (int m = 0; m < 4; ++m) {
                        bf16* rowp = PA + (size_t)(row0 + ai * 128 + m * 16) * PA_LD + col0 + bj * 128;
                        float x[8];
#pragma unroll
                        for (int e = 0; e < 4; ++e) { x[e] = acc[ai][bj][m][0][e]; x[4 + e] = acc[ai][bj][m][1][e]; }
                        v4u w;
                        if (type == 0) {
#pragma unroll
                            for (int e = 0; e < 8; ++e) x[e] = silu_f(x[e]);
                            w.x = pk2(x[0], x[1]); w.y = pk2(x[2], x[3]); w.z = pk2(x[4], x[5]); w.w = pk2(x[6], x[7]);
                        } else if (type == 1 || type == 2) {
#pragma unroll
                            for (int e = 0; e < 8; ++e) x[e] = lbv[e] + (1.0f - lbv[e]) * sigmoid_f(x[e]);
                            w.x = pk2h(x[0], x[1]); w.y = pk2h(x[2], x[3]); w.z = pk2h(x[4], x[5]); w.w = pk2h(x[6], x[7]);
                        } else {
                            w.x = pk2(x[0], x[1]); w.y = pk2(x[2], x[3]); w.z = pk2(x[4], x[5]); w.w = pk2(x[6], x[7]);
                        }
                        *(v4u*)rowp = w;
                        asm volatile("" ::: "memory");
                    }
            }
        } else {
#pragma unroll
            for (int ai = 0; ai < 2; ++ai)
#pragma unroll
                for (int m = 0; m < 4; ++m) {
                    const int cw = u.pn * 256 + ai * 128 + wr * 64 + m * 16 + fr;
                    bf16* colp = PB + (size_t)(cw - 2560) * MTOK + u.pm * 256 + wc * 32 + 8 * fq;
#pragma unroll
                    for (int bj = 0; bj < 2; ++bj) {
                        const f32x4 v0 = acc[ai][bj][m][0], v1 = acc[ai][bj][m][1];
                        v4u w; w.x = pk2(v0[0], v0[1]); w.y = pk2(v0[2], v0[3]); w.z = pk2(v1[0], v1[1]); w.w = pk2(v1[2], v1[3]);
                        *(v4u*)(colp + bj * 128) = w;
                    }
                }
        }
    }
};
struct EpiOut {
    static constexpr bool PERM = true;
    bf16* DL; const float* mod;
    __device__ __forceinline__ bool swap(const pg8::Unit&) const { return false; }
    __device__ __forceinline__ void operator()(const f32x4 (&acc)[2][2][4][2], const pg8::Unit& u, int wr, int wc, int fr, int fq) const {
        const int mr = u.pm >= 128 ? 8 : (u.pm >> 4);
        const int col0 = u.pn * 256 + wc * 32 + 8 * fq;
        f32x4 g0[2], g1[2];
#pragma unroll
        for (int bj = 0; bj < 2; ++bj) { const float* gt = mod + (size_t)mr * 3 * D + 2 * D + col0 + bj * 128; g0[bj] = *(const f32x4*)gt; g1[bj] = *(const f32x4*)(gt + 4); }
#pragma unroll
        for (int ai = 0; ai < 2; ++ai)
#pragma unroll
            for (int m = 0; m < 4; ++m) {
                bf16* rowp = DL + (size_t)(u.pm * 256 + ai * 128 + wr * 64 + m * 16 + fr) * D + col0;
#pragma unroll
                for (int bj = 0; bj < 2; ++bj) {
                    const f32x4 v0 = acc[ai][bj][m][0] * g0[bj], v1 = acc[ai][bj][m][1] * g1[bj];
                    v4u w; w.x = pk2(v0[0], v0[1]); w.y = pk2(v0[2], v0[3]); w.z = pk2(v1[0], v1[1]); w.w = pk2(v1[2], v1[3]);
                    *(v4u*)(rowp + bj * 128) = w;
                }
            }
    }
};

struct Args {
    const float* in[23]; float* out; unsigned char* ws; int ph_lo, ph_hi;
};

struct Frame {
    LAS unsigned char* lds; int tid, lane, wave, vcu, G;
};

__device__ __forceinline__ void p0_transpose_item(const float* W, int K, int N, bf16* WT, LAS float* scr, int item, int lane) {
    const int nblk = N / 32, kb = item / nblk, nb = item % nblk, k0 = 64 * kb, n0 = 32 * nb;
    f32x4 v[8];
#pragma unroll
    for (int i = 0; i < 8; ++i) v[i] = *(const f32x4*)(W + (size_t)(k0 + 8 * i + (lane >> 3)) * N + n0 + 4 * (lane & 7));
#pragma unroll
    for (int i = 0; i < 8; ++i) { LAS float* d = scr + (8 * i + (lane >> 3)) * 33 + 4 * (lane & 7); d[0] = v[i][0]; d[1] = v[i][1]; d[2] = v[i][2]; d[3] = v[i][3]; }
    asm volatile("s_waitcnt lgkmcnt(0)" ::: "memory");
    const int c = lane & 7;
#pragma unroll
    for (int j = 0; j < 4; ++j) { const int n = (lane >> 3) + 8 * j; const LAS float* s = scr + (8 * c) * 33 + n;
        v4u o; o.x = pk2(s[0 * 33], s[1 * 33]); o.y = pk2(s[2 * 33], s[3 * 33]); o.z = pk2(s[4 * 33], s[5 * 33]); o.w = pk2(s[6 * 33], s[7 * 33]);
        *(v4u*)(WT + (size_t)(n0 + n) * K + k0 + 8 * c) = o; }
    asm volatile("s_waitcnt lgkmcnt(0)" ::: "memory");
}

__device__ __forceinline__ void filter_task(const Args& a, Frame& F, const int set, const int n0, int& cached_layer) {
    unsigned char* ws = a.ws;
    const int l = set == 1 ? 1 : 0, L = set == 2 ? 256 : 4096;
    LAS float* w1s = (LAS float*)F.lds;
    LAS float* w2s = w1s + 33 * 64;
    LAS float* w3s = w2s + 64 * 64;
    LAS float* bs = w3s + 64 * 64;
    LAS float* zs = bs + 256;
    LAS float* h3s = zs + 8 * 4 * 64;
    LAS unsigned short* tile = (LAS unsigned short*)(h3s + 32 * 64);
    if (cached_layer != l) {
        __syncthreads();
        for (int e = F.tid; e < 33 * 64; e += NTHR) w1s[e] = a.in[13][l * 33 * 64 + e];
        for (int e = F.tid; e < 4096; e += NTHR) { w2s[e] = a.in[16][l * 4096 + e]; w3s[e] = a.in[18][l * 4096 + e]; }
        if (F.tid < 64) { bs[F.tid] = a.in[14][l * 64 + F.tid]; bs[64 + F.tid] = a.in[17][l * 64 + F.tid]; bs[128 + F.tid] = a.in[19][l * 64 + F.tid]; bs[192 + F.tid] = a.in[15][l * 64 + F.tid]; }
        cached_layer = l;
        __syncthreads();
    }
    {
        const int j = F.lane; LAS float* zw = zs + F.wave * 256; const float fr = bs[192 + j];
#pragma unroll
        for (int p = 0; p < 4; ++p) {
            const int n = n0 + 4 * F.wave + p;
            float zv = 0.f;
            if (j == 0) zv = (float)n / (float)(L - 1);
            else if (j < 33) { const int i = (j - 1) & 15; const double f = 1e-4 + (double)i * ((15.0 - 1e-4) / 15.0); double rev = f * (double)n / (double)L; rev -= floor(rev);
                const float ang = (float)(rev * 6.283185307179586476925); zv = (j <= 16) ? __cosf(ang) : -__sinf(ang); }
            zw[p * 64 + j] = zv;
        }
        asm volatile("s_waitcnt lgkmcnt(0)" ::: "memory");
        float s4[4];
#pragma unroll
        for (int p = 0; p < 4; ++p) s4[p] = bs[j];
        for (int e = 0; e < 33; ++e) { const float wv = w1s[e * 64 + j];
#pragma unroll
            for (int p = 0; p < 4; ++p) s4[p] += zw[p * 64 + e] * wv; }
        asm volatile("s_waitcnt lgkmcnt(0)" ::: "memory");
#pragma unroll
        for (int p = 0; p < 4; ++p) zw[p * 64 + j] = __sinf(fr * s4[p]);
        asm volatile("s_waitcnt lgkmcnt(0)" ::: "memory");
#pragma unroll
        for (int p = 0; p < 4; ++p) s4[p] = bs[64 + j];
        for (int e = 0; e < 64; ++e) { const float wv = w2s[e * 64 + j];
#pragma unroll
            for (int p = 0; p < 4; ++p) s4[p] += zw[p * 64 + e] * wv; }
        asm volatile("s_waitcnt lgkmcnt(0)" ::: "memory");
#pragma unroll
        for (int p = 0; p < 4; ++p) zw[p * 64 + j] = __sinf(fr * s4[p]);
        asm volatile("s_waitcnt lgkmcnt(0)" ::: "memory");
#pragma unroll
        for (int p = 0; p < 4; ++p) s4[p] = bs[128 + j];
        for (int e = 0; e < 64; ++e) { const float wv = w3s[e * 64 + j];
#pragma unroll
            for (int p = 0; p < 4; ++p) s4[p] += zw[p * 64 + e] * wv; }
#pragma unroll
        for (int p = 0; p < 4; ++p) h3s[(4 * F.wave + p) * 64 + j] = __sinf(fr * s4[p]);
    }
    __syncthreads();
    {
        typedef short bf16x8_ __attribute__((ext_vector_type(8)));
        LAS unsigned char* hA = (LAS unsigned char*)(tile + 1024 * 34);
        LAS unsigned char* wB = hA + 32 * 144;
        const int l15 = F.lane & 15, q = F.lane >> 4;
        { const int p = F.tid >> 4, k4 = (F.tid & 15) * 4; const f32x4 hv = *(const LAS f32x4*)(h3s + p * 64 + k4);
          v2u hw; hw.x = pk2(hv[0], hv[1]); hw.y = pk2(hv[2], hv[3]); *(LAS v2u*)(hA + p * 144 + 2 * k4) = hw; }
        float* nrm = (float*)(ws + WS_CTL) + CW_NORM;
        const float* w4 = a.in[20] + (size_t)l * 64 * 1024;
        for (int ch = 0; ch < 8; ++ch) {
            __syncthreads();
            { const int n = F.tid & 127, kq = F.tid >> 7;
              float wv[2][8];
#pragma unroll
              for (int g2 = 0; g2 < 2; ++g2)
#pragma unroll
                  for (int e = 0; e < 8; ++e) wv[g2][e] = w4[(size_t)(16 * kq + 8 * g2 + e) * 1024 + 128 * ch + n];
#pragma unroll
              for (int g2 = 0; g2 < 2; ++g2) { v4u o; o.x = pk2(wv[g2][0], wv[g2][1]); o.y = pk2(wv[g2][2], wv[g2][3]); o.z = pk2(wv[g2][4], wv[g2][5]); o.w = pk2(wv[g2][6], wv[g2][7]);
                  *(LAS v4u*)(wB + n * 144 + (16 * kq + 8 * g2) * 2) = o; } }
            __syncthreads();
            {
                const int col = 128 * ch + 16 * F.wave + l15, c = col & 511;
                f32x4 acc[2];
#pragma unroll
                for (int mt = 0; mt < 2; ++mt) { acc[mt] = (f32x4){0.f, 0.f, 0.f, 0.f};
#pragma unroll
                    for (int ks = 0; ks < 2; ++ks)
                        acc[mt] = __builtin_amdgcn_mfma_f32_16x16x32_bf16(*(const LAS bf16x8_*)(hA + (16 * mt + l15) * 144 + (32 * ks + 8 * q) * 2), *(const LAS bf16x8_*)(wB + (16 * F.wave + l15) * 144 + (32 * ks + 8 * q) * 2), acc[mt], 0, 0, 0); }
                const float dl = fabsf(HY_MIN_DECAY + (float)c * ((HY_MAX_DECAY - HY_MIN_DECAY) / 511.0f));
                float ns = 0.f;
#pragma unroll
                for (int mt = 0; mt < 2; ++mt) {
                    float v4[4];
#pragma unroll
                    for (int r = 0; r < 4; ++r) { const int nn = n0 + 16 * mt + 4 * q + r; v4[r] = acc[mt][r] * __expf(-((float)nn / (float)(L - 1)) * dl); if (col < 512 || nn >= 1) ns += fabsf(v4[r]); }
                    *(LAS unsigned*)(tile + col * 34 + 16 * mt + 4 * q) = pk2(v4[0], v4[1]); *(LAS unsigned*)(tile + col * 34 + 16 * mt + 4 * q + 2) = pk2(v4[2], v4[3]);
                }
                ns += __shfl_xor(ns, 16); ns += __shfl_xor(ns, 32);
                if (q == 0) atomicAdd(&nrm[set * 512 + c], ns);
            }
        }
    }
    __syncthreads();
    {
        bf16* dst = set == 2 ? (bf16*)(ws + WS_FGC) : (bf16*)(ws + WS_FG) + (size_t)set * 512 * FZ;
        const int ld = set == 2 ? FZC : FZ;
        for (int e = F.tid; e < 1024 * 32; e += NTHR) {
            const int col = e >> 5, p = e & 31, c = col & 511, n = n0 + p;
            const unsigned short v = tile[col * 34 + p];
            if (col < 512) dst[(size_t)c * ld + (L - n)] = v;
            else if (n >= 1) dst[(size_t)c * ld + (L + n)] = v;
        }
        if (n0 == 0) {
            const int npad = ld - 2 * L;
            for (int e = F.tid; e < 512 * (npad + 1); e += NTHR) { const int c = e / (npad + 1), k = e % (npad + 1); dst[(size_t)c * ld + (k == 0 ? 0 : 2 * L + k - 1)] = 0; }
        }
    }
    __syncthreads();
}

__device__ __forceinline__ void phase_prologue(const Args& a, Frame& F) {
    unsigned char* ws = a.ws;
    if (F.vcu == 0) {
        float* lbs = (float*)(ws + WS_LBS);
        for (int i = F.tid; i < 1024; i += NTHR) {
            const float a0 = a.in[9][i], a1 = a.in[9][1024 + i];
            const float m = fmaxf(a0, a1), e0 = expf(a0 - m), e1 = expf(a1 - m);
            const float p0 = e0 / (e0 + e1), p1 = e1 / (e0 + e1);
            const float c0 = p0, c1 = p0 + p1;
            lbs[i] = c0 - c0; lbs[1024 + i] = c1 - c0;
        }
    }
    int cached_layer = -1;
    constexpr int I_IN = (D / 64) * (NIN / 32), I_OUT = (D / 64) * (D / 32), NTR = 2 * (I_IN + I_OUT) / 8;
    for (int t = F.vcu; t < NTR; t += F.G) {
        LAS float* scr = (LAS float*)(F.lds + 65536 + F.wave * 8704);
        int r = t * 8 + F.wave; const int l = r / (I_IN + I_OUT); r -= l * (I_IN + I_OUT);
        if (r < I_IN) p0_transpose_item(a.in[7] + (size_t)l * D * NIN, D, NIN, (bf16*)(ws + WS_WIN) + (size_t)l * NIN * D, scr, r, F.lane);
        else p0_transpose_item(a.in[8] + (size_t)l * D * D, D, D, (bf16*)(ws + WS_WOUT) + (size_t)l * D * D, scr, r - I_IN, F.lane);
    }
    __syncthreads();
    if (F.vcu >= 136 && F.vcu < 232) {
        const int task = F.vcu - 136;
        LAS float* sv = (LAS float*)(F.lds + 65536);
        LAS float* part = sv + 9 * 1024;
        const int l = task / 48, n0 = (task % 48) * 64;
        for (int e = F.tid; e < 9 * 1024; e += NTHR) { const int r = e >> 10, k = e & 1023; const float cv = r < 8 ? a.in[1][r * D + k] : a.in[3][k]; sv[e] = cv / (1.0f + expf(-cv)); }
        __syncthreads();
        float acc9[9];
#pragma unroll
        for (int r = 0; r < 9; ++r) acc9[r] = 0.f;
        const float* w = a.in[5] + (size_t)l * D * 3 * D + n0 + F.lane;
#pragma unroll 8
        for (int k = F.wave * 128; k < F.wave * 128 + 128; ++k) {
            const float wv = w[(size_t)k * 3 * D];
#pragma unroll
            for (int r = 0; r < 9; ++r) acc9[r] += sv[r * 1024 + k] * wv;
        }
#pragma unroll
        for (int r = 0; r < 9; ++r) part[(F.wave * 9 + r) * 64 + F.lane] = acc9[r];
        __syncthreads();
        for (int e = F.tid; e < 9 * 64; e += NTHR) {
            const int r = e >> 6, c = e & 63; float sum = 0.f;
#pragma unroll
            for (int w8 = 0; w8 < 8; ++w8) sum += part[(w8 * 9 + r) * 64 + c];
            ((float*)(ws + WS_MOD))[((size_t)l * 9 + r) * 3 * D + n0 + c] = sum + a.in[6][l * 3 * D + n0 + c];
        }
        __syncthreads();
    }
    if (F.vcu < 16) filter_task(a, F, 0, 32 * (112 + F.vcu), cached_layer);
    else if (F.vcu >= 128 && F.vcu < 136) filter_task(a, F, 2, 32 * (F.vcu - 128), cached_layer);
}
__device__ __forceinline__ void phase_filters_l0(const Args& a, Frame& F) {
    int cached_layer = -1; const int b = (int)blockIdx.x;
    if (b >= 144) filter_task(a, F, 0, 32 * (b - 144), cached_layer);
}
__device__ __forceinline__ void phase_filters_l1(const Args& a, Frame& F) {
    int cached_layer = -1; const int b = (int)blockIdx.x;
    if (b >= 32 && b < 160) filter_task(a, F, 1, 32 * (b - 32), cached_layer);
}

__device__ __forceinline__ void phase_normrows(const Args& a, Frame& F, int l, const float* xlat, const float* xctx) {
    unsigned char* ws = a.ws;
    const float* nw = a.in[4] + l * D;
    const float* mod = (const float*)(ws + WS_MOD) + (size_t)l * 9 * 3 * D;
    bf16* XA = (bf16*)(ws + WS_XA);
    const bf16* DL = (const bf16*)(ws + WS_PB);
    const int gw = F.vcu * NWAVES + F.wave, NGW = F.G * NWAVES;
    for (int tok = gw; tok < MTOK; tok += NGW) {
        const bool isctx = tok >= MLAT;
        const float* xr = isctx ? xctx + (size_t)(tok - MLAT) * D : xlat + (size_t)tok * D;
        const int mr = isctx ? 8 : (tok >> 12);
        const float* sh = mod + (size_t)mr * 3 * D; const float* sc = sh + D;
        f32x4 v[4]; float s = 0.f;
#pragma unroll
        for (int j = 0; j < 4; ++j) v[j] = *(const f32x4*)(xr + 256 * j + 4 * F.lane);
        if (l == 1) {
#pragma unroll
            for (int j = 0; j < 4; ++j) { const v2u dw = *(const v2u*)(DL + (size_t)tok * D + 256 * j + 4 * F.lane);
                v[j].x += bf2f((unsigned short)(dw.x & 0xffffu)); v[j].y += bf2f((unsigned short)(dw.x >> 16)); v[j].z += bf2f((unsigned short)(dw.y & 0xffffu)); v[j].w += bf2f((unsigned short)(dw.y >> 16)); }
            if (!isctx) {
#pragma unroll
                for (int j = 0; j < 4; ++j) *(f32x4*)(a.out + (size_t)tok * D + 256 * j + 4 * F.lane) = v[j];
            }
        }
#pragma unroll
        for (int j = 0; j < 4; ++j) s += (v[j].x * v[j].x + v[j].y * v[j].y) + (v[j].z * v[j].z + v[j].w * v[j].w);
        const float rstd = 1.0f / sqrtf(wave_sum(s) * (1.0f / D) + EPS);
#pragma unroll
        for (int j = 0; j < 4; ++j) {
            const int k = 256 * j + 4 * F.lane;
            const f32x4 w4 = *(const f32x4*)(nw + k), s4 = *(const f32x4*)(sc + k), h4 = *(const f32x4*)(sh + k);
            const f32x4 y = v[j] * rstd * w4 * (s4 + 1.0f) + h4;
            v2u o; o.x = pk2(y.x, y.y); o.y = pk2(y.z, y.w);
            *(v2u*)(XA + (size_t)tok * D + k) = o;
        }
    }
}


namespace scan {
typedef short bf16x8 __attribute__((ext_vector_type(8)));
typedef short bf16x4 __attribute__((ext_vector_type(4)));
constexpr int QI_RS = 256, KT_RS = 160;
constexpr int OFF_QI = 0, OFF_KI = 16384, OFF_KT = 32768, OFF_VT = 53248, OFF_SCL = 73728, SET_BYTES = 74752;
constexpr int OFF_SEG = 2 * SET_BYTES;
static_assert(OFF_SEG + 4096 <= LDS_BYTES - 512, "scan LDS");
#define MFMA16(a, b, c) __builtin_amdgcn_mfma_f32_16x16x32_bf16((a), (b), (c), 0, 0, 0)
__device__ __forceinline__ bf16x8 ld_qk(const LAS unsigned char* img, int row, int ks, int xq) {
    return *(const LAS bf16x8*)(img + row * QI_RS + ((16 * xq) ^ (64 * ks)));
}
__device__ __forceinline__ int tok_row(int g, int i, int b, int dir) {
    if (g < 4) { const int t = 64 * g + i; return MLAT + b * LCX + (dir ? (LCX - 1 - t) : t); }
    const int t = 64 * (g - 4) + i; return b * LX + (dir ? (LX - 1 - t) : t);
}
template <int HALF>
__device__ __forceinline__ void scan_producer(LAS unsigned char* lds, const bf16* PA, const int b, const int h, const int dir, const int nchunk, const int pw, const int lane) {
    const int tg = lane >> 4, cq = lane & 15, ch0 = 64 * (pw >> 1) + 4 * cq;
    LAS float* seg = (LAS float*)(lds + OFF_SEG + pw * 1024);
    const int qc_ = 8 * (pw >> 1) + 4 * (cq >> 3) + (cq & 3);
    v2u qA[8], fA[8], vA[8], qB[8], fB[8], vB[8];
#define SCAN_LOAD(g, Q_, F_, V_) do { _Pragma("unroll") for (int e = 0; e < 8; ++e) { const bf16* p_ = PA + (size_t)tok_row((g), 32 * HALF + 8 * tg + e, b, dir) * PA_LD + h * HD + ch0; \
        Q_[e] = *(const v2u*)p_; F_[e] = *(const v2u*)(p_ + 512 + dir * 512); V_[e] = *(const v2u*)(p_ + 1536); } } while (0)
#define SCAN_IMG(set_, Q_, F_, V_) do { LAS unsigned char* s_ = lds + (set_) * SET_BYTES; \
        _Pragma("unroll") for (int e = 0; e < 8; ++e) asm volatile("" : "+v"(F_[e].x), "+v"(F_[e].y)); \
        float f_[4][8]; \
        _Pragma("unroll") for (int e = 0; e < 8; ++e) { f_[0][e] = h2f((unsigned short)(F_[e].x & 0xffffu)); f_[1][e] = h2f((unsigned short)(F_[e].x >> 16)); f_[2][e] = h2f((unsigned short)(F_[e].y & 0xffffu)); f_[3][e] = h2f((unsigned short)(F_[e].y >> 16)); } \
        f32x4 pr_; \
        _Pragma("unroll") for (int d = 0; d < 4; ++d) pr_[d] = ((f_[d][0] * f_[d][1]) * (f_[d][2] * f_[d][3])) * ((f_[d][4] * f_[d][5]) * (f_[d][6] * f_[d][7])); \
        *(LAS f32x4*)(seg + tg * 64 + 4 * cq) = pr_; \
        f32x4 T_[4]; _Pragma("unroll") for (int t2 = 0; t2 < 4; ++t2) T_[t2] = *(const LAS f32x4*)(seg + t2 * 64 + 4 * cq); \
        const f32x4 tot_ = (T_[0] * T_[1]) * (T_[2] * T_[3]); \
        f32x4 mul_ = (f32x4){1.f, 1.f, 1.f, 1.f}; \
        if (HALF) { _Pragma("unroll") for (int t2 = 0; t2 < 3; ++t2) if (t2 < tg) mul_ *= T_[t2]; } \
        else      { _Pragma("unroll") for (int t2 = 1; t2 < 4; ++t2) if (t2 > tg) mul_ *= T_[t2]; } \
        float Qp_[4][8], Kp_[4][8]; \
        _Pragma("unroll") for (int d = 0; d < 4; ++d) { float x_[8]; float run_ = mul_[d]; \
            if (HALF) { _Pragma("unroll") for (int e = 0; e < 8; ++e) { run_ *= f_[d][e]; x_[e] = run_; } } \
            else      { _Pragma("unroll") for (int e = 7; e >= 0; --e) { x_[e] = run_; run_ *= f_[d][e]; } } \
            _Pragma("unroll") for (int e = 0; e < 8; ++e) { const unsigned qw_ = (d & 2) ? Q_[e].y : Q_[e].x; const float qv_ = bf2f((unsigned short)((d & 1) ? (qw_ >> 16) : (qw_ & 0xffffu))); \
                const float xx_ = fmaxf(x_[e], 1e-30f), r_ = __builtin_amdgcn_rcpf(xx_), kk_ = 1.0f - f_[d][e]; \
                Qp_[d][e] = HALF ? qv_ * xx_ : qv_ * r_; Kp_[d][e] = HALF ? kk_ * r_ : kk_ * xx_; } \
            v4u t_, u_; \
            _Pragma("unroll") for (int e = 0; e < 4; ++e) { t_[e] = pk2(Kp_[d][2 * e], Kp_[d][2 * e + 1]); \
                const unsigned va_ = (d & 2) ? V_[2 * e].y : V_[2 * e].x, vb_ = (d & 2) ? V_[2 * e + 1].y : V_[2 * e + 1].x; \
                u_[e] = (d & 1) ? ((va_ >> 16) | (vb_ & 0xffff0000u)) : ((va_ & 0xffffu) | (vb_ << 16)); } \
            *(LAS v4u*)(s_ + OFF_KT + (ch0 + d) * KT_RS + 16 * ((4 * HALF + tg) ^ (cq & 7))) = t_; *(LAS v4u*)(s_ + OFF_VT + (ch0 + d) * KT_RS + 16 * ((4 * HALF + tg) ^ (cq & 7))) = u_; } \
        int qx_ = qc_ ^ (8 * (tg & 1)); asm volatile("" : "+v"(qx_)); const int rb_ = (32 * HALF + 8 * tg) * QI_RS + 8 * ((cq >> 2) & 1); \
        _Pragma("unroll") for (int e = 0; e < 8; ++e) { v2u qq_, kq_; qq_.x = pk2(Qp_[0][e], Qp_[1][e]); qq_.y = pk2(Qp_[2][e], Qp_[3][e]); kq_.x = pk2(Kp_[0][e], Kp_[1][e]); kq_.y = pk2(Kp_[2][e], Kp_[3][e]); \
            const int ro_ = rb_ + e * QI_RS + 16 * (qx_ ^ e); \
            *(LAS v2u*)(s_ + OFF_QI + ro_) = qq_; *(LAS v2u*)(s_ + OFF_KI + ro_) = kq_; } \
        if (tg == 0) *(LAS f32x4*)(s_ + OFF_SCL + 512 * HALF + 4 * ch0) = tot_; } while (0)
    const int last = nchunk - 1;
    SCAN_LOAD(0, qA, fA, vA);
    SCAN_LOAD(1, qB, fB, vB);
    SCAN_IMG(0, qA, fA, vA);
    SCAN_LOAD(2, qA, fA, vA);
    __syncthreads();
    for (int g = 0; g < nchunk; g += 2) {
        SCAN_IMG(1, qB, fB, vB);
        { const int gn = g + 3 < last ? g + 3 : last; SCAN_LOAD(gn, qB, fB, vB); }
        __syncthreads();
        SCAN_IMG(0, qA, fA, vA);
        { const int gn = g + 4 < last ? g + 4 : last; SCAN_LOAD(gn, qA, fA, vA); }
        __syncthreads();
    }
#undef SCAN_LOAD
#undef SCAN_IMG
}
__device__ __forceinline__ void scan_unit(LAS unsigned char* lds, bf16* PA, bf16* OC, const int b, const int h, const int dir, const bool ctxunit) {
    int tid_ = threadIdx.x; asm volatile("" : "+v"(tid_));
    const int tid = tid_, lane = tid & 63, w = __builtin_amdgcn_readfirstlane(tid >> 6);
    const int l15 = lane & 15, q = lane >> 4;
    const int nchunk = ctxunit ? 4 : 68;
    if (w >= 4) {
        if (w & 1) scan_producer<1>(lds, PA, b, h, dir, nchunk, w - 4, lane); else scan_producer<0>(lds, PA, b, h, dir, nchunk, w - 4, lane);
    } else {
        f32x4 S[2][8];
#pragma unroll
        for (int c = 0; c < 2; ++c)
#pragma unroll
            for (int kt = 0; kt < 8; ++kt) S[c][kt] = (f32x4){0.f, 0.f, 0.f, 0.f};
        const int vc0 = 32 * w, xq = q ^ l15;
        if (!ctxunit) PSTAMP_S(lds, 20);
        __syncthreads();
        for (int g = 0; g < nchunk; ++g) {
            const bool do_o = ctxunit || g >= 4;
            const LAS unsigned char* cs = lds + (g & 1) * SET_BYTES;
            if (g == 30) PSTAMP_S(lds, 22);
            if (do_o) {
                bf16x8 vp[2][2];
#pragma unroll
                for (int c = 0; c < 2; ++c) { const int r_ = vc0 + 8 * (l15 >> 2) + 4 * c + (l15 & 3), x_ = (r_ >> 2) & 7;
#pragma unroll
                    for (int js = 0; js < 2; ++js) { const int c1 = 4 * js + (q >> 1);
                        const bf16x4 lo = *(const LAS bf16x4*)(cs + OFF_VT + r_ * KT_RS + 16 * (c1 ^ x_) + 8 * (q & 1)), hi4 = *(const LAS bf16x4*)(cs + OFF_VT + r_ * KT_RS + 16 * ((c1 + 2) ^ x_) + 8 * (q & 1));
                        vp[c][js] = __builtin_shufflevector(lo, hi4, 0, 1, 2, 3, 4, 5, 6, 7); } }
                bf16x8 sf[2][4];
#pragma unroll
                for (int ks = 0; ks < 4; ++ks) {
                    const f32x4 m0 = *(const LAS f32x4*)(cs + OFF_SCL + (32 * ks + 4 * q) * 4), m1 = *(const LAS f32x4*)(cs + OFF_SCL + (32 * ks + 16 + 4 * q) * 4);
#pragma unroll
                    for (int c = 0; c < 2; ++c) { const f32x4 s0 = S[c][2 * ks] * m0, s1 = S[c][2 * ks + 1] * m1;
                        v4u pk; pk.x = pk2(s0[0], s0[1]); pk.y = pk2(s0[2], s0[3]); pk.z = pk2(s1[0], s1[1]); pk.w = pk2(s1[2], s1[3]); sf[c][ks] = __builtin_bit_cast(bf16x8, pk); }
                }
#pragma unroll
                for (int it = 0; it < 4; ++it) {
                    bf16x8 qf[4];
#pragma unroll
                    for (int ks = 0; ks < 4; ++ks) qf[ks] = ld_qk(cs + OFF_QI, 16 * it + l15, ks, xq);
                    f32x4 O0 = (f32x4){0.f, 0.f, 0.f, 0.f}, O1 = O0;
#pragma unroll
                    for (int ks = 0; ks < 4; ++ks) { O0 = MFMA16(sf[0][ks], qf[ks], O0); O1 = MFMA16(sf[1][ks], qf[ks], O1); }
                    unsigned pt[4][2];
#pragma unroll
                    for (int jt = 0; jt < 4; ++jt) {
                        if (jt <= it) {
                            f32x4 a4 = (f32x4){0.f, 0.f, 0.f, 0.f};
#pragma unroll
                            for (int ks = 0; ks < 4; ++ks) a4 = MFMA16(ld_qk(cs + OFF_KI, 16 * jt + l15, ks, xq), qf[ks], a4);
                            if (jt == it) {
#pragma unroll
                                for (int r = 0; r < 4; ++r) a4[r] = (4 * q + r <= l15) ? a4[r] : 0.f;
                            }
                            pt[jt][0] = pk2(a4[0], a4[1]); pt[jt][1] = pk2(a4[2], a4[3]);
                        } else { pt[jt][0] = 0u; pt[jt][1] = 0u; }
                    }
                    { v4u bw; bw.x = pt[0][0]; bw.y = pt[0][1]; bw.z = pt[1][0]; bw.w = pt[1][1]; const bf16x8 bb = __builtin_bit_cast(bf16x8, bw);
                      O0 = MFMA16(vp[0][0], bb, O0); O1 = MFMA16(vp[1][0], bb, O1); }
                    if (it >= 2) { v4u bw; bw.x = pt[2][0]; bw.y = pt[2][1]; bw.z = pt[3][0]; bw.w = pt[3][1]; const bf16x8 bb = __builtin_bit_cast(bf16x8, bw);
                      O0 = MFMA16(vp[0][1], bb, O0); O1 = MFMA16(vp[1][1], bb, O1); }
                    const int row = tok_row(g, 16 * it + l15, b, dir);
                    bf16* dst = (g < 4) ? OC + (size_t)dir * MCTX * 512 + (size_t)(row - MLAT) * 512 + h * HD + vc0 + 8 * q
                                        : PA + (size_t)row * PA_LD + 512 + dir * 512 + h * HD + vc0 + 8 * q;
                    v4u wv; wv.x = pk2(O0[0], O0[1]); wv.y = pk2(O0[2], O0[3]); wv.z = pk2(O1[0], O1[1]); wv.w = pk2(O1[2], O1[3]);
                    *(v4u*)dst = wv;
                }
            }
            bf16x8 vt[2][2];
#pragma unroll
            for (int c = 0; c < 2; ++c) { const int r_ = vc0 + 8 * (l15 >> 2) + 4 * c + (l15 & 3), x_ = (r_ >> 2) & 7;
                vt[c][0] = *(const LAS bf16x8*)(cs + OFF_VT + r_ * KT_RS + 16 * (q ^ x_)); vt[c][1] = *(const LAS bf16x8*)(cs + OFF_VT + r_ * KT_RS + 16 * ((4 + q) ^ x_)); }
#pragma unroll
            for (int kt = 0; kt < 8; ++kt) {
                const f32x4 gmk = *(const LAS f32x4*)(cs + OFF_SCL + (16 * kt + 4 * q) * 4), gem = *(const LAS f32x4*)(cs + OFF_SCL + 512 + (16 * kt + 4 * q) * 4), ge = gmk * gem;
                const int xk_ = (4 * kt + (l15 >> 2)) & 7;
                const bf16x8 k0 = *(const LAS bf16x8*)(cs + OFF_KT + (16 * kt + l15) * KT_RS + 16 * (q ^ xk_)), k1 = *(const LAS bf16x8*)(cs + OFF_KT + (16 * kt + l15) * KT_RS + 16 * ((4 + q) ^ xk_));
#pragma unroll
                for (int c = 0; c < 2; ++c) { f32x4 d4 = MFMA16(k0, vt[c][0], ((f32x4){0.f, 0.f, 0.f, 0.f})); d4 = MFMA16(k1, vt[c][1], d4); S[c][kt] = ge * S[c][kt] + gem * d4; }
            }
            if (g == 30) PSTAMP_S(lds, 23);
            __syncthreads();
            if (g == 30) PSTAMP_S(lds, 24);
        }
        if (!ctxunit) PSTAMP_S(lds, 21);
    }
}
}


namespace hy {
typedef short bf16x8 __attribute__((ext_vector_type(8)));
typedef short bf16x4 __attribute__((ext_vector_type(4)));
constexpr int CS = 16416;
constexpr int VPAD = 7;
constexpr int OFF_F = 0, OFF_V = 4 * CS, V_ROWS = (64 + VPAD + 7) * 8, LDS_END = OFF_V + V_ROWS * 128;
static_assert(LDS_END <= LDS_BYTES - 256, "hyena LDS");
struct ConvW { float x0[4], x1[4], v[4]; };
__device__ __forceinline__ ConvW load_convw(const Args& a, int l, int c) {
    const float* cw = a.in[11] + (size_t)l * 3 * 1536; const float* cb = a.in[12] + (size_t)l * 1536; ConvW r;
#pragma unroll
    for (int j = 0; j < 3; ++j) { r.x0[j] = cw[j * 1536 + c]; r.x1[j] = cw[j * 1536 + 512 + c]; r.v[j] = cw[j * 1536 + 1024 + c]; }
    r.x0[3] = cb[c]; r.x1[3] = cb[512 + c]; r.v[3] = cb[1024 + c];
    return r;
}
__device__ __forceinline__ void hyena_channel(LAS unsigned char* lds, const Args& a, const int l, const int c) {
    int tid_ = threadIdx.x; asm volatile("" : "+v"(tid_));
    const int tid = tid_, lane = tid & 63, w = __builtin_amdgcn_readfirstlane(tid >> 6), l15 = lane & 15, q = lane >> 4;
    unsigned char* ws = a.ws;
    const bf16* PB = (const bf16*)(ws + WS_PB);
    const bf16* x0r = PB + (size_t)c * MTOK; const bf16* x1r = PB + (size_t)(512 + c) * MTOK; const bf16* vr = PB + (size_t)(1024 + c) * MTOK; const bf16* gbr = PB + (size_t)(1536 + c) * MTOK;
    const ConvW cw = load_convw(a, l, c);
    PSTAMP_H(lds, 16);
    {
        const bf16* F = (const bf16*)(ws + WS_FG) + ((size_t)l * 512 + c) * FZ;
        for (int ch = tid; ch < 1024; ch += NTHR) {
            const v4u cur = *(const v4u*)(F + 8 * ch); v4u prev = *(const v4u*)(F + (ch > 0 ? 8 * ch - 8 : 0));
            if (ch == 0) prev = (v4u){0u, 0u, 0u, 0u};
            const unsigned W[8] = {prev.x, prev.y, prev.z, prev.w, cur.x, cur.y, cur.z, cur.w};
            v4u c1, c2, c3;
#pragma unroll
            for (int d = 0; d < 4; ++d) { c1[d] = (W[3 + d] >> 16) | (W[4 + d] << 16); c2[d] = W[3 + d]; c3[d] = (W[2 + d] >> 16) | (W[3 + d] << 16); }
            *(LAS v4u*)(lds + OFF_F + 0 * CS + 16 * ch) = cur;
            *(LAS v4u*)(lds + OFF_F + 1 * CS + 16 * ch) = c1;
            *(LAS v4u*)(lds + OFF_F + 2 * CS + 16 * ch) = c2;
            *(LAS v4u*)(lds + OFF_F + 3 * CS + 16 * ch) = c3;
        }
    }
    {
        for (int e = tid; e < VPAD * 8 * 32; e += NTHR) ((LAS unsigned*)(lds + OFF_V))[e] = 0u;
        for (int e = tid; e < 7 * 8 * 32; e += NTHR) ((LAS unsigned*)(lds + OFF_V + (64 + VPAD) * 8 * 128))[e] = 0u;
        for (int bt = 0; bt < 2; ++bt) {
            v4u vw[4], xw[4]; unsigned short hv[4][2], hx[4][2];
#pragma unroll
            for (int j = 0; j < 4; ++j) {
                const int e = tid + NTHR * (4 * bt + j), b = e >> 9, t0 = (e & 511) * 8;
                const size_t base = (size_t)b * LX + t0;
                const size_t bm = t0 > 0 ? base - 1 : base, bp = t0 + 8 < LX ? base + 8 : base;
                vw[j] = *(const v4u*)(vr + base); xw[j] = *(const v4u*)(x1r + base);
                hv[j][0] = vr[bm]; hv[j][1] = vr[bp]; hx[j][0] = x1r[bm]; hx[j][1] = x1r[bp];
            }
#pragma unroll
            for (int j = 0; j < 4; ++j) {
                const int e = tid + NTHR * (4 * bt + j), b = e >> 9, t0 = (e & 511) * 8, ab = t0 >> 6, ch = (t0 & 63) >> 3;
                float vv[10], xx[10];
                vv[0] = t0 > 0 ? bf2f(hv[j][0]) : 0.f; xx[0] = t0 > 0 ? bf2f(hx[j][0]) : 0.f;
                vv[9] = t0 + 8 < LX ? bf2f(hv[j][1]) : 0.f; xx[9] = t0 + 8 < LX ? bf2f(hx[j][1]) : 0.f;
#pragma unroll
                for (int d = 0; d < 4; ++d) { vv[1 + 2 * d] = bf2f((unsigned short)(vw[j][d] & 0xffffu)); vv[2 + 2 * d] = bf2f((unsigned short)(vw[j][d] >> 16));
                                              xx[1 + 2 * d] = bf2f((unsigned short)(xw[j][d] & 0xffffu)); xx[2 + 2 * d] = bf2f((unsigned short)(xw[j][d] >> 16)); }
                float p[8];
#pragma unroll
                for (int d = 0; d < 8; ++d) p[d] = (cw.v[3] + cw.v[0] * vv[d] + cw.v[1] * vv[d + 1] + cw.v[2] * vv[d + 2]) * (cw.x1[3] + cw.x1[0] * xx[d] + cw.x1[1] * xx[d + 1] + cw.x1[2] * xx[d + 2]);
                v4u o; o.x = pk2(p[0], p[1]); o.y = pk2(p[2], p[3]); o.z = pk2(p[4], p[5]); o.w = pk2(p[6], p[7]);
                const int R = (ab + VPAD) * 8 + b;
                *(LAS v4u*)(lds + OFF_V + R * 128 + 16 * (ch ^ ((R >> 1) & 7))) = o;
            }
        }
    }
    __syncthreads();
    PSTAMP_H(lds, 17);
    f32x4 acc[4][4];
#pragma unroll
    for (int mt = 0; mt < 4; ++mt)
#pragma unroll
        for (int nt = 0; nt < 4; ++nt) acc[mt][nt] = (f32x4){0.f, 0.f, 0.f, 0.f};
    {
        const LAS unsigned char* pa = lds + OFF_F + (l15 & 3) * CS + (4096 - 4 * (l15 >> 2) + 8 * q) * 2 - 96;
        const int rowl = (l15 >> 3) * 8 + (l15 & 7);
        const int cq = (q ^ (rowl >> 1)) & 7;
        const LAS unsigned char* vb0 = lds + OFF_V + rowl * 128 + (8 * w + VPAD) * 1024 + 16 * cq;
        const LAS unsigned char* vb1 = lds + OFF_V + rowl * 128 + (8 * w + VPAD) * 1024 + 16 * (cq ^ 4);
#define HY_LDA(An_, m_) do { const LAS unsigned char* p_ = pa - 128 * (m_); _Pragma("unroll") for (int mt = 0; mt < 4; ++mt) { \
            const bf16x4 lo_ = *(const LAS bf16x4*)(p_ + 32 * (3 - mt)), hi_ = *(const LAS bf16x4*)(p_ + 32 * (3 - mt) + 8); An_[mt] = __builtin_shufflevector(lo_, hi_, 0, 1, 2, 3, 4, 5, 6, 7); } } while (0)
#define HY_LDB(B_, m_, PAR_) do { const LAS unsigned char* p0_ = ((PAR_) ? vb1 : vb0) - 1024 * (m_); const LAS unsigned char* p1_ = ((PAR_) ? vb0 : vb1) - 1024 * (m_); \
            _Pragma("unroll") for (int nt = 0; nt < 4; ++nt) { B_[0][nt] = *(const LAS bf16x8*)(p0_ + 2048 * nt); B_[1][nt] = *(const LAS bf16x8*)(p1_ + 2048 * nt); } } while (0)
#define HY_MMA(An_, Ao0_, Ao1_, B_, m_) do { _Pragma("unroll") for (int nt = 0; nt < 4; ++nt) { const int a0_ = 8 * w + 2 * nt - (m_); if (a0_ + 1 >= 0 && a0_ <= 63) { \
            _Pragma("unroll") for (int mt = 0; mt < 4; ++mt) acc[mt][nt] = __builtin_amdgcn_mfma_f32_16x16x32_bf16(An_[mt], B_[0][nt], acc[mt][nt], 0, 0, 0); \
            acc[0][nt] = __builtin_amdgcn_mfma_f32_16x16x32_bf16(Ao0_, B_[1][nt], acc[0][nt], 0, 0, 0); acc[1][nt] = __builtin_amdgcn_mfma_f32_16x16x32_bf16(Ao1_, B_[1][nt], acc[1][nt], 0, 0, 0); \
            acc[2][nt] = __builtin_amdgcn_mfma_f32_16x16x32_bf16(An_[0], B_[1][nt], acc[2][nt], 0, 0, 0); acc[3][nt] = __builtin_amdgcn_mfma_f32_16x16x32_bf16(An_[1], B_[1][nt], acc[3][nt], 0, 0, 0); } } } while (0)
        bf16x8 Aa[4], Ab[4], Ba[2][4], Bb[2][4], o0, o1;
        const int m0 = 8 * w - 63, mlast = 8 * w + 7;
        { bf16x8 t_[4]; HY_LDA(t_, m0 - 1); o0 = t_[2]; o1 = t_[3]; }
        HY_LDA(Aa, m0); HY_LDB(Ba, m0, 0);
        for (int m = m0; m < mlast; m += 2) {
            HY_LDA(Ab, m + 1); HY_LDB(Bb, m + 1, 1);
            HY_MMA(Aa, o0, o1, Ba, m);
            o0 = Aa[2]; o1 = Aa[3];
            HY_LDA(Aa, m + 2); HY_LDB(Ba, m + 2, 0);
            HY_MMA(Ab, o0, o1, Bb, m + 1);
            o0 = Ab[2]; o1 = Ab[3];
        }
        HY_MMA(Aa, o0, o1, Ba, mlast);
#undef HY_LDA
#undef HY_LDB
#undef HY_MMA
    }
    PSTAMP_H(lds, 18);
    __syncthreads();
    {
        constexpr int YRS = 8208;
        const float inn = 1.0f / ((const float*)(ws + WS_CTL))[CW_NORM + l * 512 + c], hb = a.in[21][l * 512 + c];
        const int b = l15 & 7;
#pragma unroll
        for (int nt = 0; nt < 4; ++nt) {
            const int ab = 8 * w + 2 * nt + (l15 >> 3), R = (ab + VPAD) * 8 + b;
#pragma unroll
            for (int mt = 0; mt < 4; ++mt) {
                const int t = 64 * ab + 16 * mt + 4 * q;
                const v2u vw = *(const LAS v2u*)(lds + OFF_V + R * 128 + 16 * ((2 * mt + (q >> 1)) ^ ((R >> 1) & 7)) + 8 * (q & 1));
                const float y0 = acc[mt][nt][0] * inn + bf2f((unsigned short)(vw.x & 0xffffu)) * hb, y1 = acc[mt][nt][1] * inn + bf2f((unsigned short)(vw.x >> 16)) * hb;
                const float y2 = acc[mt][nt][2] * inn + bf2f((unsigned short)(vw.y & 0xffffu)) * hb, y3 = acc[mt][nt][3] * inn + bf2f((unsigned short)(vw.y >> 16)) * hb;
                v2u yw; yw.x = pk2(y0, y1); yw.y = pk2(y2, y3);
                *(LAS v2u*)(lds + OFF_F + b * YRS + 2 * t) = yw;
            }
        }
        __syncthreads();
        bf16* OBT = (bf16*)(ws + WS_OBT) + (size_t)c * MTOK;
        int tid2 = tid; asm volatile("" : "+v"(tid2));
        for (int bt = 0; bt < 4; ++bt) {
            v4u xw[2], gw[2]; unsigned short hx[2][2];
#pragma unroll
            for (int j = 0; j < 2; ++j) {
                const int e = tid2 + NTHR * (2 * bt + j), bb = e >> 9, t0 = (e & 511) * 8;
                const size_t base = (size_t)bb * LX + t0;
                xw[j] = *(const v4u*)(x0r + base); gw[j] = *(const v4u*)(gbr + base);
                hx[j][0] = x0r[t0 > 0 ? base - 1 : base]; hx[j][1] = x0r[t0 + 8 < LX ? base + 8 : base];
            }
#pragma unroll
            for (int j = 0; j < 2; ++j) {
                const int e = tid2 + NTHR * (2 * bt + j), bb = e >> 9, t0 = (e & 511) * 8;
                const size_t base = (size_t)bb * LX + t0;
                const v4u yw = *(const LAS v4u*)(lds + OFF_F + bb * YRS + 2 * t0);
                float xs[10], o[8];
                xs[0] = t0 > 0 ? bf2f(hx[j][0]) : 0.f; xs[9] = t0 + 8 < LX ? bf2f(hx[j][1]) : 0.f;
#pragma unroll
                for (int d = 0; d < 4; ++d) { xs[1 + 2 * d] = bf2f((unsigned short)(xw[j][d] & 0xffffu)); xs[2 + 2 * d] = bf2f((unsigned short)(xw[j][d] >> 16)); }
#pragma unroll
                for (int d = 0; d < 8; ++d) {
                    const float yv = bf2f((unsigned short)((d & 1) ? (yw[d >> 1] >> 16) : (yw[d >> 1] & 0xffffu)));
                    const float gv = bf2f((unsigned short)((d & 1) ? (gw[j][d >> 1] >> 16) : (gw[j][d >> 1] & 0xffffu)));
                    o[d] = yv * (cw.x0[3] + cw.x0[0] * xs[d] + cw.x0[1] * xs[d + 1] + cw.x0[2] * xs[d + 2]) * silu_f(gv);
                }
                v4u ow; ow.x = pk2(o[0], o[1]); ow.y = pk2(o[2], o[3]); ow.z = pk2(o[4], o[5]); ow.w = pk2(o[6], o[7]);
                *(v4u*)(OBT + base) = ow;
            }
        }
    }
    PSTAMP_H(lds, 19);
    __syncthreads();
}
__device__ __forceinline__ void hyena_ctx_channel(LAS unsigned char* lds, const Args& a, const int c) {
    int tid_ = threadIdx.x; asm volatile("" : "+v"(tid_));
    const int tid = tid_;
    unsigned char* ws = a.ws;
    const bf16* PB = (const bf16*)(ws + WS_PB);
    const bf16* x0r = PB + (size_t)c * MTOK + MLAT; const bf16* x1r = PB + (size_t)(512 + c) * MTOK + MLAT; const bf16* vr = PB + (size_t)(1024 + c) * MTOK + MLAT; const bf16* gbr = PB + (size_t)(1536 + c) * MTOK + MLAT;
    const ConvW cw = load_convw(a, 0, c);
    LAS float* vvc = (LAS float*)lds;
    LAS float* Fc = vvc + 2048;
    for (int e = tid; e < 2048; e += NTHR) {
        const int t = e & 255;
        const float vm_ = bf2f(vr[t > 0 ? e - 1 : e]), v0 = bf2f(vr[e]), vp_ = bf2f(vr[t < 255 ? e + 1 : e]);
        const float xm_ = bf2f(x1r[t > 0 ? e - 1 : e]), x0 = bf2f(x1r[e]), xp_ = bf2f(x1r[t < 255 ? e + 1 : e]);
        const float vm = t > 0 ? vm_ : 0.f, vp = t < 255 ? vp_ : 0.f, xm = t > 0 ? xm_ : 0.f, xp = t < 255 ? xp_ : 0.f;
        vvc[e] = (cw.v[3] + cw.v[0] * vm + cw.v[1] * v0 + cw.v[2] * vp) * (cw.x1[3] + cw.x1[0] * xm + cw.x1[1] * x0 + cw.x1[2] * xp);
    }
    if (tid < 520) Fc[tid] = tid < 512 ? bf2f(((const bf16*)(ws + WS_FGC))[(size_t)c * FZC + tid]) : 0.f;
    __syncthreads();
    const float inn = 1.0f / ((const float*)(ws + WS_CTL))[CW_NORM + 2 * 512 + c], hb = a.in[21][c];
    bf16* OBT = (bf16*)(ws + WS_OBT) + (size_t)c * MTOK + MLAT;
    {
        const int b = tid >> 6, t0 = 4 * (tid & 63), e0 = b * 256 + t0;
        float acc4[4] = {0.f, 0.f, 0.f, 0.f};
        const LAS float* fp = Fc + 252 - t0;
        for (int s4 = 0; s4 < 64; ++s4) {
            const f32x4 ga = *(const LAS f32x4*)(fp + 4 * s4), gb = *(const LAS f32x4*)(fp + 4 * s4 + 4), vq = *(const LAS f32x4*)(vvc + b * 256 + 4 * s4);
            const float g[8] = {ga[0], ga[1], ga[2], ga[3], gb[0], gb[1], gb[2], gb[3]};
#pragma unroll
            for (int i = 0; i < 4; ++i)
#pragma unroll
                for (int u = 0; u < 4; ++u) acc4[i] += g[4 - i + u] * vq[u];
        }
        float xs[6], gv[4];
        xs[0] = t0 > 0 ? bf2f(x0r[e0 - 1]) : 0.f;
#pragma unroll
        for (int i = 0; i < 4; ++i) { xs[1 + i] = bf2f(x0r[e0 + i]); gv[i] = bf2f(gbr[e0 + i]); }
        xs[5] = t0 + 4 < 256 ? bf2f(x0r[e0 + 4]) : 0.f;
        float o[4];
#pragma unroll
        for (int i = 0; i < 4; ++i) o[i] = (acc4[i] * inn + vvc[e0 + i] * hb) * (cw.x0[3] + cw.x0[0] * xs[i] + cw.x0[1] * xs[i + 1] + cw.x0[2] * xs[i + 2]) * silu_f(gv[i]);
        v2u ow; ow.x = pk2(o[0], o[1]); ow.y = pk2(o[2], o[3]);
        *(v2u*)(OBT + e0) = ow;
    }
    __syncthreads();
}
}


__device__ __forceinline__ void phase_mix(const Args& a, Frame& F, const int l, const int part = -1) {
    unsigned* qctr = (unsigned*)(a.ws + WS_CTL) + CW_QUEUE + 64 * l + (part == 1 ? 128 : 0);
    volatile LAS int* slot = (volatile LAS int*)(F.lds + LDS_BYTES - 64);
    const int ntasks = l == 0 ? 64 + 512 + 64 + 512 : 64 + 512;
    for (;;) {
        if (F.tid == 0) slot[0] = (int)atomicAdd(qctr, 1u);
        __syncthreads();
        const int t = __builtin_amdgcn_readfirstlane(slot[0]);
        __syncthreads();
        if (t >= ntasks) break;
        if (part == 0 && !(t < 64 || (t >= 576 && t < 640))) continue;
        if (part == 1 && (t < 64 || (t >= 576 && t < 640))) continue;
        if (t < 64) scan::scan_unit(F.lds, (bf16*)(a.ws + WS_PA), (bf16*)(a.ws + WS_OC), t >> 3, (t >> 1) & 3, t & 1, false);
        else if (t < 576) hy::hyena_channel(F.lds, a, l, t - 64);
        else if (t < 640) { const int u = t - 576; scan::scan_unit(F.lds, (bf16*)(a.ws + WS_PA), (bf16*)(a.ws + WS_OC), u >> 3, (u >> 1) & 3, u & 1, true); }
        else hy::hyena_ctx_channel(F.lds, a, t - 640);
        __syncthreads();
    }
}

__device__ __forceinline__ void phase_finalize_ox(const Args& a, Frame& F, int l) {
    unsigned char* ws = a.ws;
    const bf16* PA = (const bf16*)(ws + WS_PA);
    const bf16* OC = (const bf16*)(ws + WS_OC);
    bf16* XA = (bf16*)(ws + WS_XA);
    const float* gnw = a.in[10] + l * 512;
    const int gw = F.vcu * NWAVES + F.wave, NGW = F.G * NWAVES;
    const int ntok = (l == 0) ? MTOK : MLAT;
    for (int tok = gw; tok < ntok; tok += NGW) {
        const bool isctx = tok >= MLAT;
        const int c8 = 8 * F.lane;
        const bf16* pf = isctx ? OC + (size_t)(tok - MLAT) * 512 + c8 : PA + (size_t)tok * PA_LD + 512 + c8;
        const bf16* pb = isctx ? OC + (size_t)MCTX * 512 + (size_t)(tok - MLAT) * 512 + c8 : PA + (size_t)tok * PA_LD + 1024 + c8;
        const v4u wf = *(const v4u*)pf, wb = *(const v4u*)pb, wg = *(const v4u*)(PA + (size_t)tok * PA_LD + 2048 + c8);
        float o[8], g[8];
#pragma unroll
        for (int e = 0; e < 4; ++e) {
            o[2 * e] = bf2f((unsigned short)(wf[e] & 0xffff)) + bf2f((unsigned short)(wb[e] & 0xffff));
            o[2 * e + 1] = bf2f((unsigned short)(wf[e] >> 16)) + bf2f((unsigned short)(wb[e] >> 16));
            g[2 * e] = bf2f((unsigned short)(wg[e] & 0xffff)); g[2 * e + 1] = bf2f((unsigned short)(wg[e] >> 16));
        }
        float s = 0.f;
#pragma unroll
        for (int e = 0; e < 8; ++e) s += o[e] * o[e];
        s += __shfl_xor(s, 1); s += __shfl_xor(s, 2); s += __shfl_xor(s, 4); s += __shfl_xor(s, 8);
        const float rstd = 1.0f / sqrtf(s * (1.0f / HD) + EPS);
        float y[8];
#pragma unroll
        for (int e = 0; e < 8; ++e) y[e] = o[e] * rstd * gnw[c8 + e] * silu_f(g[e]);
        v4u w; w.x = pk2(y[0], y[1]); w.y = pk2(y[2], y[3]); w.z = pk2(y[4], y[5]); w.w = pk2(y[6], y[7]);
        *(v4u*)(XA + (size_t)tok * D + c8) = w;
    }
    LAS unsigned short* t = (LAS unsigned short*)(F.lds + F.wave * 16384);
    const int ntt = ntok / 64;
    for (int it = gw; it < 8 * ntt; it += NGW) {
        const int ct = it / ntt, tt = it % ntt, c0 = ct * 64, t0 = tt * 64;
        const bf16* OBT = (const bf16*)(ws + WS_OBT);
#pragma unroll
        for (int i = 0; i < 8; ++i) {
            const int e = F.lane + 64 * i, c = e >> 3, ch = e & 7;
            const v4u w = *(const v4u*)(OBT + (size_t)(c0 + c) * MTOK + t0 + 8 * ch);
#pragma unroll
            for (int q = 0; q < 4; ++q) { t[c * 66 + 8 * ch + 2 * q] = (unsigned short)(w[q] & 0xffff); t[c * 66 + 8 * ch + 2 * q + 1] = (unsigned short)(w[q] >> 16); }
        }
        asm volatile("s_waitcnt lgkmcnt(0)" ::: "memory");
#pragma unroll
        for (int i = 0; i < 8; ++i) {
            const int e = F.lane + 64 * i, tk = e >> 3, cg = e & 7;
            unsigned short h[8];
#pragma unroll
            for (int q = 0; q < 8; ++q) h[q] = t[(8 * cg + q) * 66 + tk];
            v4u w; w.x = h[0] | ((unsigned)h[1] << 16); w.y = h[2] | ((unsigned)h[3] << 16); w.z = h[4] | ((unsigned)h[5] << 16); w.w = h[6] | ((unsigned)h[7] << 16);
            *(v4u*)(XA + (size_t)(t0 + tk) * D + 512 + c0 + 8 * cg) = w;
        }
        asm volatile("s_waitcnt lgkmcnt(0)" ::: "memory");
    }
}

__device__ __forceinline__ void phase_final_norm(const Args& a, Frame& F) {
    const float* w = a.in[22];
    const bf16* DL = (const bf16*)(a.ws + WS_PB);
    const int gw = F.vcu * NWAVES + F.wave, NGW = F.G * NWAVES;
    for (int tok = gw; tok < MLAT; tok += NGW) {
        float* xr = a.out + (size_t)tok * D;
        f32x4 v[4]; float s = 0.f;
#pragma unroll
        for (int j = 0; j < 4; ++j) { v[j] = *(const f32x4*)(xr + 256 * j + 4 * F.lane); const v2u dw = *(const v2u*)(DL + (size_t)tok * D + 256 * j + 4 * F.lane);
            v[j].x += bf2f((unsigned short)(dw.x & 0xffffu)); v[j].y += bf2f((unsigned short)(dw.x >> 16)); v[j].z += bf2f((unsigned short)(dw.y & 0xffffu)); v[j].w += bf2f((unsigned short)(dw.y >> 16));
            s += (v[j].x * v[j].x + v[j].y * v[j].y) + (v[j].z * v[j].z + v[j].w * v[j].w); }
        const float rstd = 1.0f / sqrtf(wave_sum(s) * (1.0f / D) + EPS);
#pragma unroll
        for (int j = 0; j < 4; ++j) { const f32x4 w4 = *(const f32x4*)(w + 256 * j + 4 * F.lane); *(f32x4*)(xr + 256 * j + 4 * F.lane) = v[j] * rstd * w4; }
    }
}

enum { PH_PRO = 0, PH_NORM0 = 1, PH_IN0 = 2, PH_MIX0 = 3, PH_FIN0 = 4, PH_OUT0 = 5, PH_NORM1 = 6, PH_IN1 = 7, PH_MIX1 = 8, PH_FIN1 = 9, PH_OUT1 = 10, PH_FINAL = 11 };

__device__ __forceinline__ Frame mkframe(unsigned char* lds) {
    Frame F;
    F.lds = (LAS unsigned char*)lds;
    F.tid = threadIdx.x; F.lane = F.tid & 63; F.wave = __builtin_amdgcn_readfirstlane(F.tid >> 6);
    F.G = gridDim.x; { const int bx = blockIdx.x; F.vcu = (F.G % 8 == 0) ? (bx % 8) * (F.G / 8) + bx / 8 : bx; }
    return F;
}
template <int l> __device__ __forceinline__ void run_inproj(const Args& args, unsigned char* lds) {
    unsigned char* ws = args.ws; Frame F = mkframe(lds);
    pg8::Gemm g{(const bf16*)(ws + WS_XA), (const bf16*)(ws + WS_WIN) + (size_t)l * NIN * D, D};
    pg8::Sched S; S.init(128, 18, F.G, (int)blockIdx.x, 8, l == 0 ? 18 : 8);
    EpiIn E{(bf16*)(ws + WS_PA), (bf16*)(ws + WS_PB), (const float*)(ws + WS_LBS) + l * 1024};
    pg8::gemm_phase<EpiIn, true, true>(F.lds, g, S, E);
}
template <int l> __device__ __forceinline__ void run_outproj(const Args& args, unsigned char* lds) {
    unsigned char* ws = args.ws; Frame F = mkframe(lds);
    pg8::Gemm g{(const bf16*)(ws + WS_XA), (const bf16*)(ws + WS_WOUT) + (size_t)l * D * D, D};
    pg8::Sched S; S.init(128, 4, F.G, (int)blockIdx.x, l == 0 ? 8 : 0, 4);
    EpiOut E{(bf16*)(ws + WS_PB), (const float*)(ws + WS_MOD) + (size_t)l * 9 * 3 * D};
    pg8::gemm_phase<EpiOut, true, true>(F.lds, g, S, E);
}
__global__ void __launch_bounds__(NTHR, 2) mega(Args args) {
    extern __shared__ __attribute__((aligned(16))) unsigned char lds[];
    const int lo = args.ph_lo, hi = args.ph_hi;
#define IN(k) (lo <= (k) && (k) < hi)
    volatile LAS unsigned* bst = (volatile LAS unsigned*)((LAS unsigned char*)lds + LDS_BYTES - 32);
    if (threadIdx.x < 8) ((volatile LAS unsigned*)((LAS unsigned char*)lds + LDS_BYTES - 32))[threadIdx.x] = 0u;
    __syncthreads();
    XcdBarrier bar; bar.bar = (unsigned*)(args.ws + WS_CTL) + CW_BAR; bar.x = 0; bar.st = bst;
    if (hi - lo > 1) bar = xcd_barrier_post((unsigned*)(args.ws + WS_CTL) + CW_BAR, bst);
#ifdef PROBE_ID
    volatile LAS unsigned long long* pts = (volatile LAS unsigned long long*)((LAS unsigned char*)lds + LDS_BYTES - 512);
    if (threadIdx.x == 0) pts[0] = __builtin_amdgcn_s_memrealtime();
#define SEAM(k) do { if (IN((k) + 1)) xcd_barrier(bar); else __syncthreads(); if (threadIdx.x == 0) pts[(k) + 1] = __builtin_amdgcn_s_memrealtime(); } while (0)
#else
#define SEAM(k) do { if (IN((k) + 1)) xcd_barrier(bar); else __syncthreads(); } while (0)
#endif
    if (IN(PH_PRO)) { Frame F = mkframe(lds); phase_prologue(args, F); SEAM(PH_PRO); }
    if (IN(PH_NORM0)) { Frame F = mkframe(lds); phase_normrows(args, F, 0, args.in[0], args.in[2]); SEAM(PH_NORM0); }
    if (IN(PH_IN0)) { run_inproj<0>(args, lds); { Frame F = mkframe(lds); phase_filters_l0(args, F); } SEAM(PH_IN0); }
#ifdef SPLIT_MIX
    if (IN(PH_MIX0)) { Frame F = mkframe(lds); phase_mix(args, F, 0, 0); xcd_barrier(bar); if (threadIdx.x == 0) pts[15] = __builtin_amdgcn_s_memrealtime(); phase_mix(args, F, 0, 1); SEAM(PH_MIX0); }
#else
    if (IN(PH_MIX0)) { Frame F = mkframe(lds); phase_mix(args, F, 0); SEAM(PH_MIX0); }
#endif
    if (IN(PH_FIN0)) { Frame F = mkframe(lds); phase_finalize_ox(args, F, 0); SEAM(PH_FIN0); }
    if (IN(PH_OUT0)) { run_outproj<0>(args, lds); { Frame F = mkframe(lds); phase_filters_l1(args, F); } SEAM(PH_OUT0); }
    if (IN(PH_NORM1)) { Frame F = mkframe(lds); phase_normrows(args, F, 1, args.in[0], args.in[2]); SEAM(PH_NORM1); }
    if (IN(PH_IN1)) { run_inproj<1>(args, lds); SEAM(PH_IN1); }
    if (IN(PH_MIX1)) { Frame F = mkframe(lds); phase_mix(args, F, 1); SEAM(PH_MIX1); }
    if (IN(PH_FIN1)) { Frame F = mkframe(lds); phase_finalize_ox(args, F, 1); SEAM(PH_FIN1); }
    if (IN(PH_OUT1)) { run_outproj<1>(args, lds); SEAM(PH_OUT1); }
    if (IN(PH_FINAL)) { Frame F = mkframe(lds); phase_final_norm(args, F); SEAM(PH_FINAL); }
#ifdef PROBE_ID
    if (blockIdx.x == 0 && threadIdx.x == 0) {
#ifdef SPLIT_MIX
        const unsigned long long dt = (PROBE_ID == 100) ? pts[15] - pts[PH_MIX0] : pts[PH_MIX0 + 1] - pts[15];
#else
        const unsigned long long dt = (PROBE_ID >= 200) ? ((PROBE_ID == 220 || PROBE_ID >= 226) ? 1ull : 16ull) * (pts[PROBE_ID - 200 + 1] - pts[PROBE_ID - 200]) : pts[PROBE_ID + 1] - pts[PROBE_ID];
#endif
        const unsigned long long t0 = __builtin_amdgcn_s_memrealtime();
        unsigned long long wt = 4ull * dt; if (wt > 300000ull) wt = 300000ull;
        while (__builtin_amdgcn_s_memrealtime() - t0 < wt) __builtin_amdgcn_s_sleep(8);
    }
#endif
#undef IN
#undef SEAM
}

extern "C" void kernel_launch(void* const* d_in, const int* in_sizes, int n_in, void* d_out, int out_size, void* d_ws, size_t ws_size, hipStream_t stream) {
    static int grid = 0;
    if (grid == 0) {
        if (n_in != 23 || ws_size < WS_END) { fprintf(stderr, "kernel_launch: unexpected n_in %d / ws_size %zu\n", n_in, ws_size); grid = -1; return; }
        int dev = 0, cus = 0;
        if (hipGetDevice(&dev) != hipSuccess || hipDeviceGetAttribute(&cus, hipDeviceAttributeMultiprocessorCount, dev) != hipSuccess) { grid = -1; return; }
        if (hipFuncSetAttribute((const void*)mega, hipFuncAttributeMaxDynamicSharedMemorySize, LDS_BYTES) != hipSuccess) { fprintf(stderr, "kernel_launch: hipFuncSetAttribute failed\n"); grid = -1; return; }
        grid = cus;
    }
    if (grid < 0) return;
    (void)hipMemsetAsync((char*)d_ws + WS_CTL, 0, CTL_ZERO_BYTES, stream);
    Args a{};
    for (int i = 0; i < 23; ++i) a.in[i] = (const float*)d_in[i];
    a.out = (float*)d_out; a.ws = (unsigned char*)d_ws;
    a.ph_lo = 0; a.ph_hi = PH_FINAL + 1;
    hipLaunchKernelGGL(mega, dim3(grid), dim3(NTHR), LDS_BYTES, stream, a);
}
```

```cpp
#include <hip/hip_runtime.h>
#include <cstdio>
#include <cstdint>
#include <math.h>

namespace pg8 {
#define PG8_LAS __attribute__((address_space(3)))
typedef unsigned short bf16_t;
typedef short bf16x8 __attribute__((ext_vector_type(8)));
typedef float f32x4 __attribute__((ext_vector_type(4)));
typedef unsigned u32x4 __attribute__((ext_vector_type(4)));
typedef unsigned u32x2 __attribute__((ext_vector_type(2)));
constexpr int BM = 256, BK = 64, HALF = 128, HTB = HALF * BK * 2, STAGE_BYTES = 8 * HTB, NXCD = 8, WGM = 8;

__host__ __device__ __forceinline__ int lds_byte(int r, int c) { const int st = (r >> 4) * 2 + (c >> 5), rr = r & 15, cc = c & 31, ob = rr * 64 + cc * 2; return st * 1024 + (ob ^ (((ob >> 9) & 1) << 5)); }
__host__ __device__ __forceinline__ void stage_rc(int b, int& R, int& C) { const int st = b / 1024, sb = b % 1024, swz = sb ^ (((sb >> 9) & 1) << 5); R = (st >> 1) * 16 + swz / 64; C = (st & 1) * 32 + (swz % 64) / 2; }
__host__ __device__ __forceinline__ int perm32(int rho) { const int n = rho >> 4, i = rho & 15; return 8 * (i >> 2) + 4 * n + (i & 3); }

struct Unit { int pm, pn; };
struct Gemm { const bf16_t* A; const bf16_t* Bt; int K; };

struct Sched {
    int nM, nN, nwg, G, c, nctx, nctxN;
    __device__ void init(int nM_, int nN_, int G_, int c_, int nctxM, int nctxN_) { nM = nM_; nN = nN_; nwg = nM * nN; G = G_; c = c_; nctx = nctxM * nctxN_; nctxN = nctxN_ > 0 ? nctxN_ : 1; }
    __device__ bool next(int i, Unit& u) const {
        const long L = (long)i * G + c;
        if (L >= nwg) { const long L2 = L - nwg; if (L2 >= nctx) return false; u.pm = nM + (int)(L2 / nctxN); u.pn = (int)(L2 % nctxN); return true; }
        int wgid = (int)L; { const int q = nwg / NXCD, r = nwg % NXCD, xcd = wgid % NXCD, off = wgid / NXCD; wgid = (xcd < r ? xcd * (q + 1) : r * (q + 1) + (xcd - r) * q) + off; }
        const int nig = WGM * nN, gid = wgid / nig, fm = gid * WGM, gsz = (nM - fm) < WGM ? (nM - fm) : WGM;
        u.pm = fm + ((wgid % nig) % gsz); u.pn = (wgid % nig) / gsz; return true;
    }
};

template <class Epi, bool ALIGN_EPI, bool SP2>
__device__ __forceinline__ void gemm_phase(PG8_LAS unsigned char* lds, const Gemm g, const Sched& S, const Epi& E) {
    const int tid = threadIdx.x, wid = __builtin_amdgcn_readfirstlane(tid >> 6), lane = tid & 63, wr = wid >> 2, wc = wid & 3, fr = lane & 15, fq = lane >> 4;
    const int K = g.K, nt = K / BK;
    unsigned voffA[2], voffB[2];
#pragma unroll
    for (int i = 0; i < 2; ++i) { int R, C; stage_rc(tid * 16 + i * 8192, R, C); const int Rb = Epi::PERM ? ((R & ~31) + perm32(R & 31)) : R;
        voffA[i] = (unsigned)(R * K + C) * 2u; voffB[i] = (unsigned)(Rb * K + C) * 2u; }
    const size_t kstep = (size_t)(BK * 2);
    const size_t hstep = (size_t)HALF * K * 2;
    const size_t tstep = 2 * hstep;
    const unsigned ldsw = (unsigned)wid * 1024u;
    const int aoff = lds_byte(wr * 64 + fr, fq * 8), boff = lds_byte(wc * 32 + fr, fq * 8);
#define PG8_SA(b, h) (((b) * 2 + (h)) * HTB)
#define PG8_SB(b, h) ((4 + (b) * 2 + (h)) * HTB)
#define PG8_STAGE(bufoff, gbase, voff) do { _Pragma("unroll") for (int _i = 0; _i < 2; ++_i) \
        __builtin_amdgcn_global_load_lds((const unsigned*)((const char*)(gbase) + (voff)[_i]), (PG8_LAS unsigned*)(lds + (bufoff) + ldsw + _i * 8192), 16, 0, 0); } while (0)
#define PG8_LDA(dst, b, h) do { _Pragma("unroll") for (int m = 0; m < 4; ++m) _Pragma("unroll") for (int k = 0; k < 2; ++k) dst[m][k] = *(const PG8_LAS bf16x8*)(lds + PG8_SA(b, h) + aoff + m * 2048 + k * 1024); } while (0)
#define PG8_LDB(dst, b, h) do { _Pragma("unroll") for (int n = 0; n < 2; ++n) _Pragma("unroll") for (int k = 0; k < 2; ++k) dst[n][k] = *(const PG8_LAS bf16x8*)(lds + PG8_SB(b, h) + boff + n * 2048 + k * 1024); } while (0)
#define PG8_MMA(ai, bj, At, Bt) do { __builtin_amdgcn_s_setprio(1); _Pragma("unroll") for (int m = 0; m < 4; ++m) _Pragma("unroll") for (int n = 0; n < 2; ++n) _Pragma("unroll") for (int k = 0; k < 2; ++k) \
        acc[ai][bj][m][n] = __builtin_amdgcn_mfma_f32_16x16x32_bf16(Bt[n][k], At[m][k], acc[ai][bj][m][n], 0, 0, 0); __builtin_amdgcn_s_setprio(0); } while (0)
#define PG8_WAIT_V(n) asm volatile("s_waitcnt vmcnt(" #n ")" ::: "memory")
#define PG8_WAIT_L(n) asm volatile("s_waitcnt lgkmcnt(" #n ")" ::: "memory")
#define PG8_BAR __builtin_amdgcn_s_barrier()
#define PG8_SCHED __builtin_amdgcn_sched_barrier(0)
    Unit cur, nxt; int ui = 0;
    if (!S.next(0, cur)) return;
    f32x4 acc[2][2][4][2];
#pragma unroll
    for (int a = 0; a < 2; ++a)
#pragma unroll
        for (int b = 0; b < 2; ++b)
#pragma unroll
            for (int m = 0; m < 4; ++m)
#pragma unroll
                for (int n = 0; n < 2; ++n) acc[a][b][m][n] = (f32x4){0.f, 0.f, 0.f, 0.f};
    bf16x8 At[4][2], B0[2][2], B1[2][2];
    const char* cA = E.swap(cur) ? (const char*)g.Bt + (size_t)cur.pn * tstep : (const char*)g.A + (size_t)cur.pm * tstep;
    const char* cB = E.swap(cur) ? (const char*)g.A + (size_t)cur.pm * tstep : (const char*)g.Bt + (size_t)cur.pn * tstep;
    if constexpr (SP2) {
        PG8_STAGE(PG8_SB(0, 0), cB, voffB); PG8_STAGE(PG8_SB(0, 1), cB + hstep, voffB); PG8_STAGE(PG8_SA(0, 0), cA, voffA); PG8_STAGE(PG8_SA(0, 1), cA + hstep, voffA);
        if (wr == 1) PG8_BAR;
        PG8_WAIT_V(2); PG8_BAR;
        PG8_STAGE(PG8_SB(1, 0), cB + kstep, voffB); PG8_STAGE(PG8_SA(1, 0), cA + kstep, voffA); PG8_STAGE(PG8_SB(1, 1), cB + hstep + kstep, voffB);
        PG8_WAIT_V(6); PG8_BAR;
    } else {
        PG8_STAGE(PG8_SB(0, 0), cB, voffB); PG8_STAGE(PG8_SA(0, 0), cA, voffA); PG8_STAGE(PG8_SB(0, 1), cB + hstep, voffB); PG8_STAGE(PG8_SA(0, 1), cA + hstep, voffA);
        if (wr == 1) PG8_BAR;
        PG8_WAIT_V(4); PG8_BAR;
        PG8_STAGE(PG8_SB(1, 0), cB + kstep, voffB); PG8_STAGE(PG8_SA(1, 0), cA + kstep, voffA); PG8_STAGE(PG8_SB(1, 1), cB + hstep + kstep, voffB);
        PG8_WAIT_V(6); PG8_BAR;
    }
    for (;;) {
        const bool has_next = S.next(ui + 1, nxt);
        const bool nsw = has_next && E.swap(nxt);
        const char* nA = has_next ? (nsw ? (const char*)g.Bt + (size_t)nxt.pn * tstep : (const char*)g.A + (size_t)nxt.pm * tstep) : cA;
        const char* nB = has_next ? (nsw ? (const char*)g.A + (size_t)nxt.pm * tstep : (const char*)g.Bt + (size_t)nxt.pn * tstep) : cB;
        for (int t = 0; t < nt; t += 2) {
            const bool last = (t == nt - 2);
            const char* a1 = cA + (size_t)(t + 1) * kstep;
            const char* a2 = last ? nA : cA + (size_t)(t + 2) * kstep; const char* b2 = last ? nB : cB + (size_t)(t + 2) * kstep;
            const char* a3 = a2 + kstep; const char* b3 = b2 + kstep;
            if constexpr (SP2) {
            PG8_LDB(B0, 0, 0); PG8_LDB(B1, 0, 1); PG8_SCHED; PG8_LDA(At, 0, 0); PG8_STAGE(PG8_SA(1, 1), a1 + hstep, voffA);
            PG8_WAIT_V(8); PG8_WAIT_L(0); PG8_BAR; PG8_MMA(0, 0, At, B0); PG8_MMA(0, 1, At, B1); PG8_BAR; PG8_SCHED;
            PG8_LDA(At, 0, 1); PG8_STAGE(PG8_SB(0, 0), b2, voffB); PG8_STAGE(PG8_SB(0, 1), b2 + hstep, voffB); PG8_STAGE(PG8_SA(0, 0), a2, voffA);
            PG8_WAIT_V(8); PG8_WAIT_L(0); PG8_BAR; PG8_MMA(1, 0, At, B0); PG8_MMA(1, 1, At, B1); PG8_BAR; PG8_SCHED;
            PG8_LDB(B0, 1, 0); PG8_LDB(B1, 1, 1); PG8_SCHED; PG8_LDA(At, 1, 0); PG8_STAGE(PG8_SA(0, 1), a2 + hstep, voffA);
            PG8_WAIT_V(8); PG8_WAIT_L(0); PG8_BAR; PG8_MMA(0, 0, At, B0); PG8_MMA(0, 1, At, B1); PG8_BAR; PG8_SCHED;
            PG8_LDA(At, 1, 1); PG8_STAGE(PG8_SB(1, 0), b3, voffB); PG8_STAGE(PG8_SB(1, 1), b3 + hstep, voffB); PG8_STAGE(PG8_SA(1, 0), a3, voffA);
            PG8_WAIT_V(8); PG8_WAIT_L(0); PG8_BAR; PG8_MMA(1, 0, At, B0); PG8_MMA(1, 1, At, B1); PG8_BAR; PG8_SCHED;
            } else {
            PG8_LDB(B0, 0, 0); PG8_SCHED; PG8_LDA(At, 0, 0); PG8_STAGE(PG8_SA(1, 1), a1 + hstep, voffA);
            PG8_WAIT_L(8); PG8_BAR; PG8_WAIT_L(0); PG8_MMA(0, 0, At, B0); PG8_BAR; PG8_SCHED;
            PG8_LDB(B1, 0, 1); PG8_STAGE(PG8_SB(0, 0), b2, voffB);
            PG8_BAR; PG8_WAIT_L(0); PG8_MMA(0, 1, At, B1); PG8_BAR;
            PG8_LDA(At, 0, 1); PG8_STAGE(PG8_SA(0, 0), a2, voffA);
            PG8_BAR; PG8_WAIT_L(0); PG8_MMA(1, 0, At, B0); PG8_BAR; PG8_SCHED;
            PG8_STAGE(PG8_SB(0, 1), b2 + hstep, voffB);
            PG8_WAIT_V(6); PG8_BAR; PG8_MMA(1, 1, At, B1); PG8_BAR;
            PG8_LDB(B0, 1, 0); PG8_SCHED; PG8_LDA(At, 1, 0); PG8_STAGE(PG8_SA(0, 1), a2 + hstep, voffA);
            PG8_WAIT_L(8); PG8_BAR; PG8_WAIT_L(0); PG8_MMA(0, 0, At, B0); PG8_BAR; PG8_SCHED;
            PG8_LDB(B1, 1, 1); PG8_STAGE(PG8_SB(1, 0), b3, voffB);
            PG8_BAR; PG8_WAIT_L(0); PG8_MMA(0, 1, At, B1); PG8_BAR;
            PG8_LDA(At, 1, 1); PG8_STAGE(PG8_SA(1, 0), a3, voffA);
            PG8_BAR; PG8_WAIT_L(0); PG8_MMA(1, 0, At, B0); PG8_BAR; PG8_SCHED;
            PG8_STAGE(PG8_SB(1, 1), b3 + hstep, voffB);
            PG8_WAIT_V(6); PG8_BAR; PG8_MMA(1, 1, At, B1); PG8_BAR;
            }
        }
        if constexpr (ALIGN_EPI) { if (wr == 0) PG8_BAR; }
        E(acc, cur, wr, wc, fr, fq);
        if (!has_next) break;
#pragma unroll
        for (int a = 0; a < 2; ++a)
#pragma unroll
            for (int b = 0; b < 2; ++b)
#pragma unroll
                for (int m = 0; m < 4; ++m)
#pragma unroll
                    for (int n = 0; n < 2; ++n) acc[a][b][m][n] = (f32x4){0.f, 0.f, 0.f, 0.f};
        cur = nxt; cA = nA; cB = nB; ++ui;
        if constexpr (ALIGN_EPI) { if (wr == 1) PG8_BAR; }
    }
    PG8_WAIT_V(0);
    if constexpr (!ALIGN_EPI) { if (wr == 0) PG8_BAR; }
    PG8_BAR;
#undef PG8_SA
#undef PG8_SB
#undef PG8_STAGE
#undef PG8_LDA
#undef PG8_LDB
#undef PG8_MMA
#undef PG8_WAIT_V
#undef PG8_WAIT_L
#undef PG8_BAR
#undef PG8_SCHED
}
}

constexpr int D = 1024, NB = 8, LX = 4096, LCX = 256, NIN = 4608, DA = 512, DB = 512, HD = 128;
constexpr int MLAT = NB * LX, MCTX = NB * LCX, MTOK = MLAT + MCTX;
constexpr int PA_LD = 3072;
constexpr int FZ = 8448, FZC = 640;
constexpr float EPS = 1e-6f;
constexpr float HY_MIN_DECAY = -3.0701134573253944f, HY_MAX_DECAY = -15.350567286626972f;
constexpr int NWAVES = 8, NTHR = 512;

constexpr size_t MiB = 1u << 20;
constexpr size_t WS_CTL = 0, CTL_ZERO_BYTES = 1 * MiB;
constexpr size_t WS_MOD = 1 * MiB;
constexpr size_t WS_LBS = WS_MOD + 256 * 1024;
constexpr size_t WS_WIN = 6 * MiB;
constexpr size_t WS_WOUT = 24 * MiB;
constexpr size_t WS_FG = 28 * MiB;
constexpr size_t WS_FGC = 45 * MiB;
constexpr size_t WS_CTX1 = 46 * MiB;
constexpr size_t WS_OC = 2 * MiB;
constexpr size_t WS_XA = 54 * MiB;
constexpr size_t WS_PA = 122 * MiB;
constexpr size_t WS_PB = 326 * MiB;
constexpr size_t WS_OBT = 462 * MiB;
constexpr size_t WS_HK = 326 * MiB;
constexpr size_t WS_SCL = 496 * MiB;
constexpr size_t WS_END = 504 * MiB;
constexpr int CW_NORM = 1024;
constexpr int CW_BAR = 8192;
constexpr int CW_QUEUE = 4096;

constexpr int LDS_BYTES = 156 * 1024;
#define LAS __attribute__((address_space(3)))
#define GAS __attribute__((address_space(1)))
typedef unsigned short bf16;
typedef unsigned v4u __attribute__((ext_vector_type(4)));
typedef unsigned v2u __attribute__((ext_vector_type(2)));
typedef float f32x4 __attribute__((ext_vector_type(4)));

typedef __bf16 bf2_t __attribute__((ext_vector_type(2)));
typedef float f2_t __attribute__((ext_vector_type(2)));
__device__ __forceinline__ unsigned pk2(float lo, float hi) { const f2_t v = {lo, hi}; return __builtin_bit_cast(unsigned, __builtin_convertvector(v, bf2_t)); }
__device__ __forceinline__ unsigned f2bf(float f) { return pk2(f, 0.f) & 0xffffu; }
__device__ __forceinline__ float bf2f(unsigned short h) { return __builtin_bit_cast(float, (unsigned)h << 16); }
__device__ __forceinline__ unsigned f2h(float f) { _Float16 h = (_Float16)f; return (unsigned)__builtin_bit_cast(unsigned short, h); }
__device__ __forceinline__ unsigned pk2h(float lo, float hi) { return f2h(lo) | (f2h(hi) << 16); }
__device__ __forceinline__ float h2f(unsigned short u) { return (float)__builtin_bit_cast(_Float16, u); }
__device__ __forceinline__ float silu_f(float x) { return x * __builtin_amdgcn_rcpf(1.0f + __expf(-x)); }
__device__ __forceinline__ float sigmoid_f(float x) { return __builtin_amdgcn_rcpf(1.0f + __expf(-x)); }
__device__ __forceinline__ float wave_sum(float v) {
#pragma unroll
    for (int o = 1; o < 64; o <<= 1) v += __shfl_xor(v, o);
    return v;
}


#define PSTAMP_(lds_, k_) do { if (threadIdx.x == 0) ((volatile LAS unsigned long long*)((lds_) + LDS_BYTES - 512))[(k_)] = __builtin_amdgcn_s_memrealtime(); } while (0)
#if defined(PROBE_ID) && PROBE_ID >= 216 && PROBE_ID < 220
#define PSTAMP_H(lds_, k_) PSTAMP_(lds_, k_)
#else
#define PSTAMP_H(lds_, k_) do { } while (0)
#endif
#if defined(PROBE_ID) && PROBE_ID >= 226 && PROBE_ID < 230
#define PSTAMP_P(lds_, k_) PSTAMP_(lds_, k_)
#else
#define PSTAMP_P(lds_, k_) do { } while (0)
#endif
#if defined(PROBE_ID) && PROBE_ID >= 220 && PROBE_ID < 226
#define PSTAMP_S(lds_, k_) PSTAMP_(lds_, k_)
#else
#define PSTAMP_S(lds_, k_) do { } while (0)
#endif
typedef GAS unsigned gu32;
#define XB_TMO      128
#define XB_XCNT(j)  (256  + 64 * (j))
#define XB_XSUB(j)  (1280 + 64 * (j))
#define XB_XGEN(j)  (2304 + 64 * (j))
#define XB_TOP      3328
#define XB_TOPGEN   3392
#define XCD_BAR_WORDS 3456
#define XB_SPIN_CAP (1u << 18)
__device__ __forceinline__ unsigned xb_ld(unsigned* p)              { return __hip_atomic_load(p, __ATOMIC_RELAXED, __HIP_MEMORY_SCOPE_AGENT); }
__device__ __forceinline__ unsigned xb_add(unsigned* p, unsigned v) { return __hip_atomic_fetch_add(p, v, __ATOMIC_RELAXED, __HIP_MEMORY_SCOPE_AGENT); }
__device__ __forceinline__ unsigned xb_xcc_id() { return (unsigned)__builtin_amdgcn_s_getreg((3 << 11) | 20) & 0xFu; }
#define XB_SPIN(cond, bar) do { unsigned _sp = 0; while (cond) { __builtin_amdgcn_s_sleep(1); \
    if ((++_sp & 255u) == 0u) { if (xb_ld(&(bar)[XB_TMO])) break; if (_sp > XB_SPIN_CAP) { atomicAdd(&(bar)[XB_TMO], 1u); break; } } } } while (0)
struct XcdBarrier { unsigned* bar; unsigned x; volatile LAS unsigned* st; };
__device__ __forceinline__ XcdBarrier xcd_barrier_post(unsigned* bar, volatile LAS unsigned* st) {
    XcdBarrier b; b.bar = bar; b.x = xb_xcc_id(); b.st = st;
    if (threadIdx.x == 0) (void)xb_add(&bar[XB_XCNT(b.x)], 1u);
    return b;
}
__device__ __forceinline__ void xcd_barrier_complete(unsigned* bar, unsigned x, unsigned& nloc, unsigned& nx) {
    const unsigned G = gridDim.x * gridDim.y * gridDim.z;
    unsigned sum, cnt, mine, sp = 0u;
    for (;;) {
        sum = 0u; cnt = 0u; mine = 0u;
#pragma unroll
        for (unsigned j = 0; j < 16; ++j) { const unsigned c = xb_ld(&bar[XB_XCNT(j)]); sum += c; cnt += (c > 0u) ? 1u : 0u; mine = (j == x) ? c : mine; }
        if (sum == G) break;
        __builtin_amdgcn_s_sleep(1);
        if ((++sp & 255u) == 0u) { if (xb_ld(&bar[XB_TMO])) break; if (sp > XB_SPIN_CAP) { atomicAdd(&bar[XB_TMO], 1u); break; } }
    }
    nloc = mine > 0u ? mine : 1u; nx = cnt > 0u ? cnt : 1u;
}
__device__ __forceinline__ void xcd_barrier(const XcdBarrier& b) {
    asm volatile("s_waitcnt vmcnt(0)" ::: "memory");
    __syncthreads();
    if (threadIdx.x == 0) {
        unsigned* bar = b.bar;
        __builtin_amdgcn_s_waitcnt(0);
        unsigned nloc = b.st[0], nx = b.st[1];
        if (nloc == 0u) { xcd_barrier_complete(bar, b.x, nloc, nx); b.st[0] = nloc; b.st[1] = nx; }
        const unsigned old = xb_add(&bar[XB_XSUB(b.x)], 1u);
        const unsigned gen = old / nloc;
        if (old + 1u == (gen + 1u) * nloc) {
            __builtin_amdgcn_fence(__ATOMIC_RELEASE, "agent");
            asm volatile("s_waitcnt vmcnt(0)" ::: "memory");
            const unsigned og = xb_add(&bar[XB_TOP], 1u);
            const unsigned tg = og / nx;
            if (og + 1u == (tg + 1u) * nx) xb_add(&bar[XB_TOPGEN], 1u);
            else XB_SPIN(xb_ld(&bar[XB_TOPGEN]) == tg, bar);
            __builtin_amdgcn_fence(__ATOMIC_ACQUIRE, "agent");
            xb_add(&bar[XB_XGEN(b.x)], 1u);
            asm volatile("s_waitcnt vmcnt(0)" ::: "memory");
        } else {
            XB_SPIN(xb_ld(&bar[XB_XGEN(b.x)]) == gen, bar);
            __builtin_amdgcn_fence(__ATOMIC_ACQUIRE, "agent");
            asm volatile("s_waitcnt vmcnt(0)" ::: "memory");
        }
    }
    __syncthreads();
}

struct EpiIn {
    static constexpr bool PERM = true;
    bf16* PA; bf16* PB; const float* lb;
    __device__ __forceinline__ bool swap(const pg8::Unit& u) const { return u.pn >= 10; }
    __device__ __forceinline__ void operator()(const f32x4 (&acc)[2][2][4][2], const pg8::Unit& u, int wr, int wc, int fr, int fq) const {
        if (u.pn < 10) {
            const int type = u.pn >> 1;
            const int row0 = u.pm * 256 + wr * 64 + fr, col0 = u.pn * 256 + wc * 32 + 8 * fq;
#pragma unroll
            for (int bj = 0; bj < 2; ++bj) {
                float lbv[8];
#pragma unroll
                for (int e = 0; e < 8; ++e) lbv[e] = (type == 1 || type == 2) ? lb[col0 + bj * 128 + e - 512] : 0.f;
#pragma unroll
                for (int ai = 0; ai < 2; ++ai)
#pragma unroll
                    for (int m = 0; m < 4; ++m) {
                        bf16* rowp = PA + (size_t)(row0 + ai * 128 + m * 16) * PA_LD + col0 + bj * 128;
                        float x[8];
#pragma unroll
                        for (int e = 0; e < 4; ++e) { x[e] = acc[ai][bj][m][0][e]; x[4 + e] = acc[ai][bj][m][1][e]; }
                        v4u w;
                        if (type == 0) {
#pragma unroll
                            for (int e = 0; e < 8; ++e) x[e] = silu_f(x[e]);
                            w.x = pk2(x[0], x[1]); w.y = pk2(x[2], x[3]); w.z = pk2(x[4], x[5]); w.w = pk2(x[6], x[7]);
                        } else if (type == 1 || type == 2) {
#pragma unroll
                            for (int e = 0; e < 8; ++e) x[e] = lbv[e] + (1.0f - lbv[e]) * sigmoid_f(x[e]);
                            w.x = pk2h(x[0], x[1]); w.y = pk2h(x[2], x[3]); w.z = pk2h(x[4], x[5]); w.w = pk2h(x[6], x[7]);
                        } else {
                            w.x = pk2(x[0], x[1]); w.y = pk2(x[2], x[3]); w.z = pk2(x[4], x[5]); w.w = pk2(x[6], x[7]);
                        }
                        *(v4u*)rowp = w;
                        asm volatile("" ::: "memory");
                    }
            }
        } else {
#pragma unroll
            for (int ai = 0; ai < 2; ++ai)
#pragma unroll
                for (int m = 0; m < 4; ++m) {
                    const int cw = u.pn * 256 + ai * 128 + wr * 64 + m * 16 + fr;
                    bf16* colp = PB + (size_t)(cw - 2560) * MTOK + u.pm * 256 + wc * 32 + 8 * fq;
#pragma unroll
                    for (int bj = 0; bj < 2; ++bj) {
                        const f32x4 v0 = acc[ai][bj][m][0], v1 = acc[ai][bj][m][1];
                        v4u w; w.x = pk2(v0[0], v0[1]); w.y = pk2(v0[2], v0[3]); w.z = pk2(v1[0], v1[1]); w.w = pk2(v1[2], v1[3]);
                        *(v4u*)(colp + bj * 128) = w;
                    }
                }
        }
    }
};
struct EpiOut {
    static constexpr bool PERM = true;
    bf16* DL; const float* mod;
    __device__ __forceinline__ bool swap(const pg8::Unit&) const { return false; }
    __device__ __forceinline__ void operator()(const f32x4 (&acc)[2][2][4][2], const pg8::Unit& u, int wr, int wc, int fr, int fq) const {
        const int mr = u.pm >= 128 ? 8 : (u.pm >> 4);
        const int col0 = u.pn * 256 + wc * 32 + 8 * fq;
        f32x4 g0[2], g1[2];
#pragma unroll
        for (int bj = 0; bj < 2; ++bj) { const float* gt = mod + (size_t)mr * 3 * D + 2 * D + col0 + bj * 128; g0[bj] = *(const f32x4*)gt; g1[bj] = *(const f32x4*)(gt + 4); }
#pragma unroll
        for (int ai = 0; ai < 2; ++ai)
#pragma unroll
            for (int m = 0; m < 4; ++m) {
                bf16* rowp = DL + (size_t)(u.pm * 256 + ai * 128 + wr * 64 + m * 16 + fr) * D + col0;
#pragma unroll
                for (int bj = 0; bj < 2; ++bj) {
                    const f32x4 v0 = acc[ai][bj][m][0] * g0[bj], v1 = acc[ai][bj][m][1] * g1[bj];
                    v4u w; w.x = pk2(v0[0], v0[1]); w.y = pk2(v0[2], v0[3]); w.z = pk2(v1[0], v1[1]); w.w = pk2(v1[2], v1[3]);
                    *(v4u*)(rowp + bj * 128) = w;
                }
            }
    }
};

struct Args {
    const float* in[23]; float* out; unsigned char* ws; int ph_lo, ph_hi;
};

struct Frame {
    LAS unsigned char* lds; int tid, lane, wave, vcu, G;
};

__device__ __forceinline__ void p0_transpose_item(const float* W, int K, int N, bf16* WT, LAS float* scr, int item, int lane) {
    const int nblk = N / 32, kb = item / nblk, nb = item % nblk, k0 = 64 * kb, n0 = 32 * nb;
    f32x4 v[8];
#pragma unroll
    for (int i = 0; i < 8; ++i) v[i] = *(const f32x4*)(W + (size_t)(k0 + 8 * i + (lane >> 3)) * N + n0 + 4 * (lane & 7));
#pragma unroll
    for (int i = 0; i < 8; ++i) { LAS float* d = scr + (8 * i + (lane >> 3)) * 33 + 4 * (lane & 7); d[0] = v[i][0]; d[1] = v[i][1]; d[2] = v[i][2]; d[3] = v[i][3]; }
    asm volatile("s_waitcnt lgkmcnt(0)" ::: "memory");
    const int c = lane & 7;
#pragma unroll
    for (int j = 0; j < 4; ++j) { const int n = (lane >> 3) + 8 * j; const LAS float* s = scr + (8 * c) * 33 + n;
        v4u o; o.x = pk2(s[0 * 33], s[1 * 33]); o.y = pk2(s[2 * 33], s[3 * 33]); o.z = pk2(s[4 * 33], s[5 * 33]); o.w = pk2(s[6 * 33], s[7 * 33]);
        *(v4u*)(WT + (size_t)(n0 + n) * K + k0 + 8 * c) = o; }
    asm volatile("s_waitcnt lgkmcnt(0)" ::: "memory");
}

__device__ __forceinline__ void filter_task(const Args& a, Frame& F, const int set, const int n0, int& cached_layer) {
    unsigned char* ws = a.ws;
    const int l = set == 1 ? 1 : 0, L = set == 2 ? 256 : 4096;
    LAS float* w1s = (LAS float*)F.lds;
    LAS float* w2s = w1s + 33 * 64;
    LAS float* w3s = w2s + 64 * 64;
    LAS float* bs = w3s + 64 * 64;
    LAS float* zs = bs + 256;
    LAS float* h3s = zs + 8 * 4 * 64;
    LAS unsigned short* tile = (LAS unsigned short*)(h3s + 32 * 64);
    if (cached_layer != l) {
        __syncthreads();
        for (int e = F.tid; e < 33 * 64; e += NTHR) w1s[e] = a.in[13][l * 33 * 64 + e];
        for (int e = F.tid; e < 4096; e += NTHR) { w2s[e] = a.in[16][l * 4096 + e]; w3s[e] = a.in[18][l * 4096 + e]; }
        if (F.tid < 64) { bs[F.tid] = a.in[14][l * 64 + F.tid]; bs[64 + F.tid] = a.in[17][l * 64 + F.tid]; bs[128 + F.tid] = a.in[19][l * 64 + F.tid]; bs[192 + F.tid] = a.in[15][l * 64 + F.tid]; }
        cached_layer = l;
        __syncthreads();
    }
    {
        const int j = F.lane; LAS float* zw = zs + F.wave * 256; const float fr = bs[192 + j];
#pragma unroll
        for (int p = 0; p < 4; ++p) {
            const int n = n0 + 4 * F.wave + p;
            float zv = 0.f;
            if (j == 0) zv = (float)n / (float)(L - 1);
            else if (j < 33) { const int i = (j - 1) & 15; const double f = 1e-4 + (double)i * ((15.0 - 1e-4) / 15.0); double rev = f * (double)n / (double)L; rev -= floor(rev);
                const float ang = (float)(rev * 6.283185307179586476925); zv = (j <= 16) ? __cosf(ang) : -__sinf(ang); }
            zw[p * 64 + j] = zv;
        }
        asm volatile("s_waitcnt lgkmcnt(0)" ::: "memory");
        float s4[4];
#pragma unroll
        for (int p = 0; p < 4; ++p) s4[p] = bs[j];
        for (int e = 0; e < 33; ++e) { const float wv = w1s[e * 64 + j];
#pragma unroll
            for (int p = 0; p < 4; ++p) s4[p] += zw[p * 64 + e] * wv; }
        asm volatile("s_waitcnt lgkmcnt(0)" ::: "memory");
#pragma unroll
        for (int p = 0; p < 4; ++p) zw[p * 64 + j] = __sinf(fr * s4[p]);
        asm volatile("s_waitcnt lgkmcnt(0)" ::: "memory");
#pragma unroll
        for (int p = 0; p < 4; ++p) s4[p] = bs[64 + j];
        for (int e = 0; e < 64; ++e) { const float wv = w2s[e * 64 + j];
#pragma unroll
            for (int p = 0; p < 4; ++p) s4[p] += zw[p * 64 + e] * wv; }
        asm volatile("s_waitcnt lgkmcnt(0)" ::: "memory");
#pragma unroll
        for (int p = 0; p < 4; ++p) zw[p * 64 + j] = __sinf(fr * s4[p]);
        asm volatile("s_waitcnt lgkmcnt(0)" ::: "memory");
#pragma unroll
        for (int p = 0; p < 4; ++p) s4[p] = bs[128 + j];
        for (int e = 0; e < 64; ++e) { const float wv = w3s[e * 64 + j];
#pragma unroll
            for (int p = 0; p < 4; ++p) s4[p] += zw[p * 64 + e] * wv; }
#pragma unroll
        for (int p = 0; p < 4; ++p) h3s[(4 * F.wave + p) * 64 + j] = __sinf(fr * s4[p]);
    }
    __syncthreads();
    {
        typedef short bf16x8_ __attribute__((ext_vector_type(8)));
        LAS unsigned char* hA = (LAS unsigned char*)(tile + 1024 * 34);
        LAS unsigned char* wB = hA + 32 * 144;
        const int l15 = F.lane & 15, q = F.lane >> 4;
        { const int p = F.tid >> 4, k4 = (F.tid & 15) * 4; const f32x4 hv = *(const LAS f32x4*)(h3s + p * 64 + k4);
          v2u hw; hw.x = pk2(hv[0], hv[1]); hw.y = pk2(hv[2], hv[3]); *(LAS v2u*)(hA + p * 144 + 2 * k4) = hw; }
        float* nrm = (float*)(ws + WS_CTL) + CW_NORM;
        const float* w4 = a.in[20] + (size_t)l * 64 * 1024;
        for (int ch = 0; ch < 8; ++ch) {
            __syncthreads();
            { const int n = F.tid & 127, kq = F.tid >> 7;
              float wv[2][8];
#pragma unroll
              for (int g2 = 0; g2 < 2; ++g2)
#pragma unroll
                  for (int e = 0; e < 8; ++e) wv[g2][e] = w4[(size_t)(16 * kq + 8 * g2 + e) * 1024 + 128 * ch + n];
#pragma unroll
              for (int g2 = 0; g2 < 2; ++g2) { v4u o; o.x = pk2(wv[g2][0], wv[g2][1]); o.y = pk2(wv[g2][2], wv[g2][3]); o.z = pk2(wv[g2][4], wv[g2][5]); o.w = pk2(wv[g2][6], wv[g2][7]);
                  *(LAS v4u*)(wB + n * 144 + (16 * kq + 8 * g2) * 2) = o; } }
            __syncthreads();
            {
                const int col = 128 * ch + 16 * F.wave + l15, c = col & 511;
                f32x4 acc[2];
#pragma unroll
                for (int mt = 0; mt < 2; ++mt) { acc[mt] = (f32x4){0.f, 0.f, 0.f, 0.f};
#pragma unroll
                    for (int ks = 0; ks < 2; ++ks)
                        acc[mt] = __builtin_amdgcn_mfma_f32_16x16x32_bf16(*(const LAS bf16x8_*)(hA + (16 * mt + l15) * 144 + (32 * ks + 8 * q) * 2), *(const LAS bf16x8_*)(wB + (16 * F.wave + l15) * 144 + (32 * ks + 8 * q) * 2), acc[mt], 0, 0, 0); }
                const float dl = fabsf(HY_MIN_DECAY + (float)c * ((HY_MAX_DECAY - HY_MIN_DECAY) / 511.0f));
                float ns = 0.f;
#pragma unroll
                for (int mt = 0; mt < 2; ++mt) {
                    float v4[4];
#pragma unroll
                    for (int r = 0; r < 4; ++r) { const int nn = n0 + 16 * mt + 4 * q + r; v4[r] = acc[mt][r] * __expf(-((float)nn / (float)(L - 1)) * dl); if (col < 512 || nn >= 1) ns += fabsf(v4[r]); }
                    *(LAS unsigned*)(tile + col * 34 + 16 * mt + 4 * q) = pk2(v4[0], v4[1]); *(LAS unsigned*)(tile + col * 34 + 16 * mt + 4 * q + 2) = pk2(v4[2], v4[3]);
                }
                ns += __shfl_xor(ns, 16); ns += __shfl_xor(ns, 32);
                if (q == 0) atomicAdd(&nrm[set * 512 + c], ns);
            }
        }
    }
    __syncthreads();
    {
        bf16* dst = set == 2 ? (bf16*)(ws + WS_FGC) : (bf16*)(ws + WS_FG) + (size_t)set * 512 * FZ;
        const int ld = set == 2 ? FZC : FZ;
        for (int e = F.tid; e < 1024 * 32; e += NTHR) {
            const int col = e >> 5, p = e & 31, c = col & 511, n = n0 + p;
            const unsigned short v = tile[col * 34 + p];
            if (col < 512) dst[(size_t)c * ld + (L - n)] = v;
            else if (n >= 1) dst[(size_t)c * ld + (L + n)] = v;
        }
        if (n0 == 0) {
            const int npad = ld - 2 * L;
            for (int e = F.tid; e < 512 * (npad + 1); e += NTHR) { const int c = e / (npad + 1), k = e % (npad + 1); dst[(size_t)c * ld + (k == 0 ? 0 : 2 * L + k - 1)] = 0; }
        }
    }
    __syncthreads();
}

__device__ __forceinline__ void phase_prologue(const Args& a, Frame& F) {
    unsigned char* ws = a.ws;
    if (F.vcu == 0) {
        float* lbs = (float*)(ws + WS_LBS);
        for (int i = F.tid; i < 1024; i += NTHR) {
            const float a0 = a.in[9][i], a1 = a.in[9][1024 + i];
            const float m = fmaxf(a0, a1), e0 = expf(a0 - m), e1 = expf(a1 - m);
            const float p0 = e0 / (e0 + e1), p1 = e1 / (e0 + e1);
            const float c0 = p0, c1 = p0 + p1;
            lbs[i] = c0 - c0; lbs[1024 + i] = c1 - c0;
        }
    }
    int cached_layer = -1;
    constexpr int I_IN = (D / 64) * (NIN / 32), I_OUT = (D / 64) * (D / 32), NTR = 2 * (I_IN + I_OUT) / 8;
    for (int t = F.vcu; t < NTR; t += F.G) {
        LAS float* scr = (LAS float*)(F.lds + 65536 + F.wave * 8704);
        int r = t * 8 + F.wave; const int l = r / (I_IN + I_OUT); r -= l * (I_IN + I_OUT);
        if (r < I_IN) p0_transpose_item(a.in[7] + (size_t)l * D * NIN, D, NIN, (bf16*)(ws + WS_WIN) + (size_t)l * NIN * D, scr, r, F.lane);
        else p0_transpose_item(a.in[8] + (size_t)l * D * D, D, D, (bf16*)(ws + WS_WOUT) + (size_t)l * D * D, scr, r - I_IN, F.lane);
    }
    __syncthreads();
    if (F.vcu >= 136 && F.vcu < 232) {
        const int task = F.vcu - 136;
        LAS float* sv = (LAS float*)(F.lds + 65536);
        LAS float* part = sv + 9 * 1024;
        const int l = task / 48, n0 = (task % 48) * 64;
        for (int e = F.tid; e < 9 * 1024; e += NTHR) { const int r = e >> 10, k = e & 1023; const float cv = r < 8 ? a.in[1][r * D + k] : a.in[3][k]; sv[e] = cv / (1.0f + expf(-cv)); }
        __syncthreads();
        float acc9[9];
#pragma unroll
        for (int r = 0; r < 9; ++r) acc9[r] = 0.f;
        const float* w = a.in[5] + (size_t)l * D * 3 * D + n0 + F.lane;
#pragma unroll 8
        for (int k = F.wave * 128; k < F.wave * 128 + 128; ++k) {
            const float wv = w[(size_t)k * 3 * D];
#pragma unroll
            for (int r = 0; r < 9; ++r) acc9[r] += sv[r * 1024 + k] * wv;
        }
#pragma unroll
        for (int r = 0; r < 9; ++r) part[(F.wave * 9 + r) * 64 + F.lane] = acc9[r];
        __syncthreads();
        for (int e = F.tid; e < 9 * 64; e += NTHR) {
            const int r = e >> 6, c = e & 63; float sum = 0.f;
#pragma unroll
            for (int w8 = 0; w8 < 8; ++w8) sum += part[(w8 * 9 + r) * 64 + c];
            ((float*)(ws + WS_MOD))[((size_t)l * 9 + r) * 3 * D + n0 + c] = sum + a.in[6][l * 3 * D + n0 + c];
        }
        __syncthreads();
    }
    if (F.vcu < 16) filter_task(a, F, 0, 32 * (112 + F.vcu), cached_layer);
    else if (F.vcu >= 128 && F.vcu < 136) filter_task(a, F, 2, 32 * (F.vcu - 128), cached_layer);
}
__device__ __forceinline__ void phase_filters_l0(const Args& a, Frame& F) {
    int cached_layer = -1; const int b = (int)blockIdx.x;
    if (b >= 144) filter_task(a, F, 0, 32 * (b - 144), cached_layer);
}
__device__ __forceinline__ void phase_filters_l1(const Args& a, Frame& F) {
    int cached_layer = -1; const int b = (int)blockIdx.x;
    if (b >= 32 && b < 160) filter_task(a, F, 1, 32 * (b - 32), cached_layer);
}

__device__ __forceinline__ void phase_normrows(const Args& a, Frame& F, int l, const float* xlat, const float* xctx) {
    unsigned char* ws = a.ws;
    const float* nw = a.in[4] + l * D;
    const float* mod = (const float*)(ws + WS_MOD) + (size_t)l * 9 * 3 * D;
    bf16* XA = (bf16*)(ws + WS_XA);
    const bf16* DL = (const bf16*)(ws + WS_PB);
    const int gw = F.vcu * NWAVES + F.wave, NGW = F.G * NWAVES;
    for (int tok = gw; tok < MTOK; tok += NGW) {
        const bool isctx = tok >= MLAT;
        const float* xr = isctx ? xctx + (size_t)(tok - MLAT) * D : xlat + (size_t)tok * D;
        const int mr = isctx ? 8 : (tok >> 12);
        const float* sh = mod + (size_t)mr * 3 * D; const float* sc = sh + D;
        f32x4 v[4]; float s = 0.f;
#pragma unroll
        for (int j = 0; j < 4; ++j) v[j] = *(const f32x4*)(xr + 256 * j + 4 * F.lane);
        if (l == 1) {
#pragma unroll
            for (int j = 0; j < 4; ++j) { const v2u dw = *(const v2u*)(DL + (size_t)tok * D + 256 * j + 4 * F.lane);
                v[j].x += bf2f((unsigned short)(dw.x & 0xffffu)); v[j].y += bf2f((unsigned short)(dw.x >> 16)); v[j].z += bf2f((unsigned short)(dw.y & 0xffffu)); v[j].w += bf2f((unsigned short)(dw.y >> 16)); }
            if (!isctx) {
#pragma unroll
                for (int j = 0; j < 4; ++j) { v2u o; o.x = pk2(v[j].x, v[j].y); o.y = pk2(v[j].z, v[j].w); *(v2u*)((unsigned short*)(a.out + (size_t)tok * D) + 1024 + 256 * j + 4 * F.lane) = o; }
            }
        }
#pragma unroll
        for (int j = 0; j < 4; ++j) s += (v[j].x * v[j].x + v[j].y * v[j].y) + (v[j].z * v[j].z + v[j].w * v[j].w);
        const float rstd = 1.0f / sqrtf(wave_sum(s) * (1.0f / D) + EPS);
#pragma unroll
        for (int j = 0; j < 4; ++j) {
            const int k = 256 * j + 4 * F.lane;
            const f32x4 w4 = *(const f32x4*)(nw + k), s4 = *(const f32x4*)(sc + k), h4 = *(const f32x4*)(sh + k);
            const f32x4 y = v[j] * rstd * w4 * (s4 + 1.0f) + h4;
            v2u o; o.x = pk2(y.x, y.y); o.y = pk2(y.z, y.w);
            *(v2u*)(XA + (size_t)tok * D + k) = o;
        }
    }
}


namespace scan {
typedef short bf16x8 __attribute__((ext_vector_type(8)));
typedef short bf16x4 __attribute__((ext_vector_type(4)));
constexpr int QI_RS = 256, KT_RS = 160;
constexpr int OFF_QI = 0, OFF_KI = 16384, OFF_KT = 32768, OFF_VT = 53248, OFF_SCL = 73728, SET_BYTES = 74752;
constexpr int OFF_SEG = 2 * SET_BYTES;
static_assert(OFF_SEG + 4096 <= LDS_BYTES - 512, "scan LDS");
#define MFMA16(a, b, c) __builtin_amdgcn_mfma_f32_16x16x32_bf16((a), (b), (c), 0, 0, 0)
__device__ __forceinline__ bf16x8 ld_qk(const LAS unsigned char* img, int row, int ks, int xq) {
    return *(const LAS bf16x8*)(img + row * QI_RS + ((16 * xq) ^ (64 * ks)));
}
__device__ __forceinline__ int tok_row(int g, int i, int b, int dir) {
    if (g < 4) { const int t = 64 * g + i; return MLAT + b * LCX + (dir ? (LCX - 1 - t) : t); }
    const int t = 64 * (g - 4) + i; return b * LX + (dir ? (LX - 1 - t) : t);
}
template <int HALF>
__device__ __forceinline__ void scan_producer(LAS unsigned char* lds, const bf16* PA, const int b, const int h, const int dir, const int nchunk, const int pw, const int lane) {
    const int tg = lane >> 4, cq = lane & 15, ch0 = 64 * (pw >> 1) + 4 * cq;
    LAS float* seg = (LAS float*)(lds + OFF_SEG + pw * 1024);
    const int qc_ = 8 * (pw >> 1) + 4 * (cq >> 3) + (cq & 3);
    v2u qA[8], fA[8], vA[8], qB[8], fB[8], vB[8];
#define SCAN_LOAD(g, Q_, F_, V_) do { _Pragma("unroll") for (int e = 0; e < 8; ++e) { const bf16* p_ = PA + (size_t)tok_row((g), 32 * HALF + 8 * tg + e, b, dir) * PA_LD + h * HD + ch0; \
        Q_[e] = *(const v2u*)p_; F_[e] = *(const v2u*)(p_ + 512 + dir * 512); V_[e] = *(const v2u*)(p_ + 1536); } } while (0)
#define SCAN_IMG(set_, Q_, F_, V_) do { LAS unsigned char* s_ = lds + (set_) * SET_BYTES; \
        _Pragma("unroll") for (int e = 0; e < 8; ++e) asm volatile("" : "+v"(F_[e].x), "+v"(F_[e].y)); \
        float f_[4][8]; \
        _Pragma("unroll") for (int e = 0; e < 8; ++e) { f_[0][e] = h2f((unsigned short)(F_[e].x & 0xffffu)); f_[1][e] = h2f((unsigned short)(F_[e].x >> 16)); f_[2][e] = h2f((unsigned short)(F_[e].y & 0xffffu)); f_[3][e] = h2f((unsigned short)(F_[e].y >> 16)); } \
        f32x4 pr_; \
        _Pragma("unroll") for (int d = 0; d < 4; ++d) pr_[d] = ((f_[d][0] * f_[d][1]) * (f_[d][2] * f_[d][3])) * ((f_[d][4] * f_[d][5]) * (f_[d][6] * f_[d][7])); \
        *(LAS f32x4*)(seg + tg * 64 + 4 * cq) = pr_; \
        f32x4 T_[4]; _Pragma("unroll") for (int t2 = 0; t2 < 4; ++t2) T_[t2] = *(const LAS f32x4*)(seg + t2 * 64 + 4 * cq); \
        const f32x4 tot_ = (T_[0] * T_[1]) * (T_[2] * T_[3]); \
        f32x4 mul_ = (f32x4){1.f, 1.f, 1.f, 1.f}; \
        if (HALF) { _Pragma("unroll") for (int t2 = 0; t2 < 3; ++t2) if (t2 < tg) mul_ *= T_[t2]; } \
        else      { _Pragma("unroll") for (int t2 = 1; t2 < 4; ++t2) if (t2 > tg) mul_ *= T_[t2]; } \
        float Qp_[4][8], Kp_[4][8]; \
        _Pragma("unroll") for (int d = 0; d < 4; ++d) { float x_[8]; float run_ = mul_[d]; \
            if (HALF) { _Pragma("unroll") for (int e = 0; e < 8; ++e) { run_ *= f_[d][e]; x_[e] = run_; } } \
            else      { _Pragma("unroll") for (int e = 7; e >= 0; --e) { x_[e] = run_; run_ *= f_[d][e]; } } \
            _Pragma("unroll") for (int e = 0; e < 8; ++e) { const unsigned qw_ = (d & 2) ? Q_[e].y : Q_[e].x; const float qv_ = bf2f((unsigned short)((d & 1) ? (qw_ >> 16) : (qw_ & 0xffffu))); \
                const float xx_ = fmaxf(x_[e], 1e-30f), r_ = __builtin_amdgcn_rcpf(xx_), kk_ = 1.0f - f_[d][e]; \
                Qp_[d][e] = HALF ? qv_ * xx_ : qv_ * r_; Kp_[d][e] = HALF ? kk_ * r_ : kk_ * xx_; } \
            v4u t_, u_; \
            _Pragma("unroll") for (int e = 0; e < 4; ++e) { t_[e] = pk2(Kp_[d][2 * e], Kp_[d][2 * e + 1]); \
                const unsigned va_ = (d & 2) ? V_[2 * e].y : V_[2 * e].x, vb_ = (d & 2) ? V_[2 * e + 1].y : V_[2 * e + 1].x; \
                u_[e] = (d & 1) ? ((va_ >> 16) | (vb_ & 0xffff0000u)) : ((va_ & 0xffffu) | (vb_ << 16)); } \
            *(LAS v4u*)(s_ + OFF_KT + (ch0 + d) * KT_RS + 16 * ((4 * HALF + tg) ^ (cq & 7))) = t_; *(LAS v4u*)(s_ + OFF_VT + (ch0 + d) * KT_RS + 16 * ((4 * HALF + tg) ^ (cq & 7))) = u_; } \
        int qx_ = qc_ ^ (8 * (tg & 1)); asm volatile("" : "+v"(qx_)); const int rb_ = (32 * HALF + 8 * tg) * QI_RS + 8 * ((cq >> 2) & 1); \
        _Pragma("unroll") for (int e = 0; e < 8; ++e) { v2u qq_, kq_; qq_.x = pk2(Qp_[0][e], Qp_[1][e]); qq_.y = pk2(Qp_[2][e], Qp_[3][e]); kq_.x = pk2(Kp_[0][e], Kp_[1][e]); kq_.y = pk2(Kp_[2][e], Kp_[3][e]); \
            const int ro_ = rb_ + e * QI_RS + 16 * (qx_ ^ e); \
            *(LAS v2u*)(s_ + OFF_QI + ro_) = qq_; *(LAS v2u*)(s_ + OFF_KI + ro_) = kq_; } \
        if (tg == 0) *(LAS f32x4*)(s_ + OFF_SCL + 512 * HALF + 4 * ch0) = tot_; } while (0)
    const int last = nchunk - 1;
    SCAN_LOAD(0, qA, fA, vA);
    SCAN_LOAD(1, qB, fB, vB);
    SCAN_IMG(0, qA, fA, vA);
    SCAN_LOAD(2, qA, fA, vA);
    __syncthreads();
    for (int g = 0; g < nchunk; g += 2) {
        SCAN_IMG(1, qB, fB, vB);
        { const int gn = g + 3 < last ? g + 3 : last; SCAN_LOAD(gn, qB, fB, vB); }
        __syncthreads();
        SCAN_IMG(0, qA, fA, vA);
        { const int gn = g + 4 < last ? g + 4 : last; SCAN_LOAD(gn, qA, fA, vA); }
        __syncthreads();
    }
#undef SCAN_LOAD
#undef SCAN_IMG
}
__device__ __forceinline__ void scan_unit(LAS unsigned char* lds, bf16* PA, bf16* OC, const int b, const int h, const int dir, const bool ctxunit) {
    int tid_ = threadIdx.x; asm volatile("" : "+v"(tid_));
    const int tid = tid_, lane = tid & 63, w = __builtin_amdgcn_readfirstlane(tid >> 6);
    const int l15 = lane & 15, q = lane >> 4;
    const int nchunk = ctxunit ? 4 : 68;
    if (w >= 4) {
        if (w & 1) scan_producer<1>(lds, PA, b, h, dir, nchunk, w - 4, lane); else scan_producer<0>(lds, PA, b, h, dir, nchunk, w - 4, lane);
    } else {
        f32x4 S[2][8];
#pragma unroll
        for (int c = 0; c < 2; ++c)
#pragma unroll
            for (int kt = 0; kt < 8; ++kt) S[c][kt] = (f32x4){0.f, 0.f, 0.f, 0.f};
        const int vc0 = 32 * w, xq = q ^ l15;
        if (!ctxunit) PSTAMP_S(lds, 20);
        __syncthreads();
        for (int g = 0; g < nchunk; ++g) {
            const bool do_o = ctxunit || g >= 4;
            const LAS unsigned char* cs = lds + (g & 1) * SET_BYTES;
            if (g == 30) PSTAMP_S(lds, 22);
            if (do_o) {
                bf16x8 vp[2][2];
#pragma unroll
                for (int c = 0; c < 2; ++c) { const int r_ = vc0 + 8 * (l15 >> 2) + 4 * c + (l15 & 3), x_ = (r_ >> 2) & 7;
#pragma unroll
                    for (int js = 0; js < 2; ++js) { const int c1 = 4 * js + (q >> 1);
                        const bf16x4 lo = *(const LAS bf16x4*)(cs + OFF_VT + r_ * KT_RS + 16 * (c1 ^ x_) + 8 * (q & 1)), hi4 = *(const LAS bf16x4*)(cs + OFF_VT + r_ * KT_RS + 16 * ((c1 + 2) ^ x_) + 8 * (q & 1));
                        vp[c][js] = __builtin_shufflevector(lo, hi4, 0, 1, 2, 3, 4, 5, 6, 7); } }
                bf16x8 sf[2][4];
#pragma unroll
                for (int ks = 0; ks < 4; ++ks) {
                    const f32x4 m0 = *(const LAS f32x4*)(cs + OFF_SCL + (32 * ks + 4 * q) * 4), m1 = *(const LAS f32x4*)(cs + OFF_SCL + (32 * ks + 16 + 4 * q) * 4);
#pragma unroll
                    for (int c = 0; c < 2; ++c) { const f32x4 s0 = S[c][2 * ks] * m0, s1 = S[c][2 * ks + 1] * m1;
                        v4u pk; pk.x = pk2(s0[0], s0[1]); pk.y = pk2(s0[2], s0[3]); pk.z = pk2(s1[0], s1[1]); pk.w = pk2(s1[2], s1[3]); sf[c][ks] = __builtin_bit_cast(bf16x8, pk); }
                }
#pragma unroll
                for (int it = 0; it < 4; ++it) {
                    bf16x8 qf[4];
#pragma unroll
                    for (int ks = 0; ks < 4; ++ks) qf[ks] = ld_qk(cs + OFF_QI, 16 * it + l15, ks, xq);
                    f32x4 O0 = (f32x4){0.f, 0.f, 0.f, 0.f}, O1 = O0;
#pragma unroll
                    for (int ks = 0; ks < 4; ++ks) { O0 = MFMA16(sf[0][ks], qf[ks], O0); O1 = MFMA16(sf[1][ks], qf[ks], O1); }
                    unsigned pt[4][2];
#pragma unroll
                    for (int jt = 0; jt < 4; ++jt) {
                        if (jt <= it) {
                            f32x4 a4 = (f32x4){0.f, 0.f, 0.f, 0.f};
#pragma unroll
                            for (int ks = 0; ks < 4; ++ks) a4 = MFMA16(ld_qk(cs + OFF_KI, 16 * jt + l15, ks, xq), qf[ks], a4);
                            if (jt == it) {
#pragma unroll
                                for (int r = 0; r < 4; ++r) a4[r] = (4 * q + r <= l15) ? a4[r] : 0.f;
                            }
                            pt[jt][0] = pk2(a4[0], a4[1]); pt[jt][1] = pk2(a4[2], a4[3]);
                        } else { pt[jt][0] = 0u; pt[jt][1] = 0u; }
                    }
                    { v4u bw; bw.x = pt[0][0]; bw.y = pt[0][1]; bw.z = pt[1][0]; bw.w = pt[1][1]; const bf16x8 bb = __builtin_bit_cast(bf16x8, bw);
                      O0 = MFMA16(vp[0][0], bb, O0); O1 = MFMA16(vp[1][0], bb, O1); }
                    if (it >= 2) { v4u bw; bw.x = pt[2][0]; bw.y = pt[2][1]; bw.z = pt[3][0]; bw.w = pt[3][1]; const bf16x8 bb = __builtin_bit_cast(bf16x8, bw);
                      O0 = MFMA16(vp[0][1], bb, O0); O1 = MFMA16(vp[1][1], bb, O1); }
                    const int row = tok_row(g, 16 * it + l15, b, dir);
                    bf16* dst = (g < 4) ? OC + (size_t)dir * MCTX * 512 + (size_t)(row - MLAT) * 512 + h * HD + vc0 + 8 * q
                                        : PA + (size_t)row * PA_LD + 512 + dir * 512 + h * HD + vc0 + 8 * q;
                    v4u wv; wv.x = pk2(O0[0], O0[1]); wv.y = pk2(O0[2], O0[3]); wv.z = pk2(O1[0], O1[1]); wv.w = pk2(O1[2], O1[3]);
                    *(v4u*)dst = wv;
                }
            }
            bf16x8 vt[2][2];
#pragma unroll
            for (int c = 0; c < 2; ++c) { const int r_ = vc0 + 8 * (l15 >> 2) + 4 * c + (l15 & 3), x_ = (r_ >> 2) & 7;
                vt[c][0] = *(const LAS bf16x8*)(cs + OFF_VT + r_ * KT_RS + 16 * (q ^ x_)); vt[c][1] = *(const LAS bf16x8*)(cs + OFF_VT + r_ * KT_RS + 16 * ((4 + q) ^ x_)); }
#pragma unroll
            for (int kt = 0; kt < 8; ++kt) {
                const f32x4 gmk = *(const LAS f32x4*)(cs + OFF_SCL + (16 * kt + 4 * q) * 4), gem = *(const LAS f32x4*)(cs + OFF_SCL + 512 + (16 * kt + 4 * q) * 4), ge = gmk * gem;
                const int xk_ = (4 * kt + (l15 >> 2)) & 7;
                const bf16x8 k0 = *(const LAS bf16x8*)(cs + OFF_KT + (16 * kt + l15) * KT_RS + 16 * (q ^ xk_)), k1 = *(const LAS bf16x8*)(cs + OFF_KT + (16 * kt + l15) * KT_RS + 16 * ((4 + q) ^ xk_));
#pragma unroll
                for (int c = 0; c < 2; ++c) { f32x4 d4 = MFMA16(k0, vt[c][0], ((f32x4){0.f, 0.f, 0.f, 0.f})); d4 = MFMA16(k1, vt[c][1], d4); S[c][kt] = ge * S[c][kt] + gem * d4; }
            }
            if (g == 30) PSTAMP_S(lds, 23);
            __syncthreads();
            if (g == 30) PSTAMP_S(lds, 24);
        }
        if (!ctxunit) PSTAMP_S(lds, 21);
    }
}
}


namespace hy {
typedef short bf16x8 __attribute__((ext_vector_type(8)));
typedef short bf16x4 __attribute__((ext_vector_type(4)));
constexpr int CS = 16416;
constexpr int VPAD = 7;
constexpr int OFF_F = 0, OFF_V = 4 * CS, V_ROWS = (64 + VPAD + 7) * 8, LDS_END = OFF_V + V_ROWS * 128;
static_assert(LDS_END <= LDS_BYTES - 256, "hyena LDS");
struct ConvW { float x0[4], x1[4], v[4]; };
__device__ __forceinline__ ConvW load_convw(const Args& a, int l, int c) {
    const float* cw = a.in[11] + (size_t)l * 3 * 1536; const float* cb = a.in[12] + (size_t)l * 1536; ConvW r;
#pragma unroll
    for (int j = 0; j < 3; ++j) { r.x0[j] = cw[j * 1536 + c]; r.x1[j] = cw[j * 1536 + 512 + c]; r.v[j] = cw[j * 1536 + 1024 + c]; }
    r.x0[3] = cb[c]; r.x1[3] = cb[512 + c]; r.v[3] = cb[1024 + c];
    return r;
}
__device__ __forceinline__ void hyena_channel(LAS unsigned char* lds, const Args& a, const int l, const int c) {
    int tid_ = threadIdx.x; asm volatile("" : "+v"(tid_));
    const int tid = tid_, lane = tid & 63, w = __builtin_amdgcn_readfirstlane(tid >> 6), l15 = lane & 15, q = lane >> 4;
    unsigned char* ws = a.ws;
    const bf16* PB = (const bf16*)(ws + WS_PB);
    const bf16* x0r = PB + (size_t)c * MTOK; const bf16* x1r = PB + (size_t)(512 + c) * MTOK; const bf16* vr = PB + (size_t)(1024 + c) * MTOK; const bf16* gbr = PB + (size_t)(1536 + c) * MTOK;
    const ConvW cw = load_convw(a, l, c);
    PSTAMP_H(lds, 16);
    {
        const bf16* F = (const bf16*)(ws + WS_FG) + ((size_t)l * 512 + c) * FZ;
        for (int ch = tid; ch < 1024; ch += NTHR) {
            const v4u cur = *(const v4u*)(F + 8 * ch); v4u prev = *(const v4u*)(F + (ch > 0 ? 8 * ch - 8 : 0));
            if (ch == 0) prev = (v4u){0u, 0u, 0u, 0u};
            const unsigned W[8] = {prev.x, prev.y, prev.z, prev.w, cur.x, cur.y, cur.z, cur.w};
            v4u c1, c2, c3;
#pragma unroll
            for (int d = 0; d < 4; ++d) { c1[d] = (W[3 + d] >> 16) | (W[4 + d] << 16); c2[d] = W[3 + d]; c3[d] = (W[2 + d] >> 16) | (W[3 + d] << 16); }
            *(LAS v4u*)(lds + OFF_F + 0 * CS + 16 * ch) = cur;
            *(LAS v4u*)(lds + OFF_F + 1 * CS + 16 * ch) = c1;
            *(LAS v4u*)(lds + OFF_F + 2 * CS + 16 * ch) = c2;
            *(LAS v4u*)(lds + OFF_F + 3 * CS + 16 * ch) = c3;
        }
    }
    {
        for (int e = tid; e < VPAD * 8 * 32; e += NTHR) ((LAS unsigned*)(lds + OFF_V))[e] = 0u;
        for (int e = tid; e < 7 * 8 * 32; e += NTHR) ((LAS unsigned*)(lds + OFF_V + (64 + VPAD) * 8 * 128))[e] = 0u;
        for (int bt = 0; bt < 2; ++bt) {
            v4u vw[4], xw[4]; unsigned short hv[4][2], hx[4][2];
#pragma unroll
            for (int j = 0; j < 4; ++j) {
                const int e = tid + NTHR * (4 * bt + j), b = e >> 9, t0 = (e & 511) * 8;
                const size_t base = (size_t)b * LX + t0;
                const size_t bm = t0 > 0 ? base - 1 : base, bp = t0 + 8 < LX ? base + 8 : base;
                vw[j] = *(const v4u*)(vr + base); xw[j] = *(const v4u*)(x1r + base);
                hv[j][0] = vr[bm]; hv[j][1] = vr[bp]; hx[j][0] = x1r[bm]; hx[j][1] = x1r[bp];
            }
#pragma unroll
            for (int j = 0; j < 4; ++j) {
                const int e = tid + NTHR * (4 * bt + j), b = e >> 9, t0 = (e & 511) * 8, ab = t0 >> 6, ch = (t0 & 63) >> 3;
                float vv[10], xx[10];
                vv[0] = t0 > 0 ? bf2f(hv[j][0]) : 0.f; xx[0] = t0 > 0 ? bf2f(hx[j][0]) : 0.f;
                vv[9] = t0 + 8 < LX ? bf2f(hv[j][1]) : 0.f; xx[9] = t0 + 8 < LX ? bf2f(hx[j][1]) : 0.f;
#pragma unroll
                for (int d = 0; d < 4; ++d) { vv[1 + 2 * d] = bf2f((unsigned short)(vw[j][d] & 0xffffu)); vv[2 + 2 * d] = bf2f((unsigned short)(vw[j][d] >> 16));
                                              xx[1 + 2 * d] = bf2f((unsigned short)(xw[j][d] & 0xffffu)); xx[2 + 2 * d] = bf2f((unsigned short)(xw[j][d] >> 16)); }
                float p[8];
#pragma unroll
                for (int d = 0; d < 8; ++d) p[d] = (cw.v[3] + cw.v[0] * vv[d] + cw.v[1] * vv[d + 1] + cw.v[2] * vv[d + 2]) * (cw.x1[3] + cw.x1[0] * xx[d] + cw.x1[1] * xx[d + 1] + cw.x1[2] * xx[d + 2]);
                v4u o; o.x = pk2(p[0], p[1]); o.y = pk2(p[2], p[3]); o.z = pk2(p[4], p[5]); o.w = pk2(p[6], p[7]);
                const int R = (ab + VPAD) * 8 + b;
                *(LAS v4u*)(lds + OFF_V + R * 128 + 16 * (ch ^ ((R >> 1) & 7))) = o;
            }
        }
    }
    __syncthreads();
    PSTAMP_H(lds, 17);
    f32x4 acc[4][4];
#pragma unroll
    for (int mt = 0; mt < 4; ++mt)
#pragma unroll
        for (int nt = 0; nt < 4; ++nt) acc[mt][nt] = (f32x4){0.f, 0.f, 0.f, 0.f};
    {
        const LAS unsigned char* pa = lds + OFF_F + (l15 & 3) * CS + (4096 - 4 * (l15 >> 2) + 8 * q) * 2 - 96;
        const int rowl = (l15 >> 3) * 8 + (l15 & 7);
        const int cq = (q ^ (rowl >> 1)) & 7;
        const LAS unsigned char* vb0 = lds + OFF_V + rowl * 128 + (8 * w + VPAD) * 1024 + 16 * cq;
        const LAS unsigned char* vb1 = lds + OFF_V + rowl * 128 + (8 * w + VPAD) * 1024 + 16 * (cq ^ 4);
#define HY_LDA(An_, m_) do { const LAS unsigned char* p_ = pa - 128 * (m_); _Pragma("unroll") for (int mt = 0; mt < 4; ++mt) { \
            const bf16x4 lo_ = *(const LAS bf16x4*)(p_ + 32 * (3 - mt)), hi_ = *(const LAS bf16x4*)(p_ + 32 * (3 - mt) + 8); An_[mt] = __builtin_shufflevector(lo_, hi_, 0, 1, 2, 3, 4, 5, 6, 7); } } while (0)
#define HY_LDB(B_, m_, PAR_) do { const LAS unsigned char* p0_ = ((PAR_) ? vb1 : vb0) - 1024 * (m_); const LAS unsigned char* p1_ = ((PAR_) ? vb0 : vb1) - 1024 * (m_); \
            _Pragma("unroll") for (int nt = 0; nt < 4; ++nt) { B_[0][nt] = *(const LAS bf16x8*)(p0_ + 2048 * nt); B_[1][nt] = *(const LAS bf16x8*)(p1_ + 2048 * nt); } } while (0)
#define HY_MMA(An_, Ao0_, Ao1_, B_, m_) do { _Pragma("unroll") for (int nt = 0; nt < 4; ++nt) { const int a0_ = 8 * w + 2 * nt - (m_); if (a0_ + 1 >= 0 && a0_ <= 63) { \
            _Pragma("unroll") for (int mt = 0; mt < 4; ++mt) acc[mt][nt] = __builtin_amdgcn_mfma_f32_16x16x32_bf16(An_[mt], B_[0][nt], acc[mt][nt], 0, 0, 0); \
            acc[0][nt] = __builtin_amdgcn_mfma_f32_16x16x32_bf16(Ao0_, B_[1][nt], acc[0][nt], 0, 0, 0); acc[1][nt] = __builtin_amdgcn_mfma_f32_16x16x32_bf16(Ao1_, B_[1][nt], acc[1][nt], 0, 0, 0); \
            acc[2][nt] = __builtin_amdgcn_mfma_f32_16x16x32_bf16(An_[0], B_[1][nt], acc[2][nt], 0, 0, 0); acc[3][nt] = __builtin_amdgcn_mfma_f32_16x16x32_bf16(An_[1], B_[1][nt], acc[3][nt], 0, 0, 0); } } } while (0)
        bf16x8 Aa[4], Ab[4], Ba[2][4], Bb[2][4], o0, o1;
        const int m0 = 8 * w - 63, mlast = 8 * w + 7;
        { bf16x8 t_[4]; HY_LDA(t_, m0 - 1); o0 = t_[2]; o1 = t_[3]; }
        HY_LDA(Aa, m0); HY_LDB(Ba, m0, 0);
        for (int m = m0; m < mlast; m += 2) {
            HY_LDA(Ab, m + 1); HY_LDB(Bb, m + 1, 1);
            HY_MMA(Aa, o0, o1, Ba, m);
            o0 = Aa[2]; o1 = Aa[3];
            HY_LDA(Aa, m + 2); HY_LDB(Ba, m + 2, 0);
            HY_MMA(Ab, o0, o1, Bb, m + 1);
            o0 = Ab[2]; o1 = Ab[3];
        }
        HY_MMA(Aa, o0, o1, Ba, mlast);
#undef HY_LDA
#undef HY_LDB
#undef HY_MMA
    }
    PSTAMP_H(lds, 18);
    __syncthreads();
    {
        constexpr int YRS = 8208;
        const float inn = 1.0f / ((const float*)(ws + WS_CTL))[CW_NORM + l * 512 + c], hb = a.in[21][l * 512 + c];
        const int b = l15 & 7;
#pragma unroll
        for (int nt = 0; nt < 4; ++nt) {
            const int ab = 8 * w + 2 * nt + (l15 >> 3), R = (ab + VPAD) * 8 + b;
#pragma unroll
            for (int mt = 0; mt < 4; ++mt) {
                const int t = 64 * ab + 16 * mt + 4 * q;
                const v2u vw = *(const LAS v2u*)(lds + OFF_V + R * 128 + 16 * ((2 * mt + (q >> 1)) ^ ((R >> 1) & 7)) + 8 * (q & 1));
                const float y0 = acc[mt][nt][0] * inn + bf2f((unsigned short)(vw.x & 0xffffu)) * hb, y1 = acc[mt][nt][1] * inn + bf2f((unsigned short)(vw.x >> 16)) * hb;
                const float y2 = acc[mt][nt][2] * inn + bf2f((unsigned short)(vw.y & 0xffffu)) * hb, y3 = acc[mt][nt][3] * inn + bf2f((unsigned short)(vw.y >> 16)) * hb;
                v2u yw; yw.x = pk2(y0, y1); yw.y = pk2(y2, y3);
                *(LAS v2u*)(lds + OFF_F + b * YRS + 2 * t) = yw;
            }
        }
        __syncthreads();
        bf16* OBT = (bf16*)(ws + WS_OBT) + (size_t)c * MTOK;
        int tid2 = tid; asm volatile("" : "+v"(tid2));
        for (int bt = 0; bt < 4; ++bt) {
            v4u xw[2], gw[2]; unsigned short hx[2][2];
#pragma unroll
            for (int j = 0; j < 2; ++j) {
                const int e = tid2 + NTHR * (2 * bt + j), bb = e >> 9, t0 = (e & 511) * 8;
                const size_t base = (size_t)bb * LX + t0;
                xw[j] = *(const v4u*)(x0r + base); gw[j] = *(const v4u*)(gbr + base);
                hx[j][0] = x0r[t0 > 0 ? base - 1 : base]; hx[j][1] = x0r[t0 + 8 < LX ? base + 8 : base];
            }
#pragma unroll
            for (int j = 0; j < 2; ++j) {
                const int e = tid2 + NTHR * (2 * bt + j), bb = e >> 9, t0 = (e & 511) * 8;
                const size_t base = (size_t)bb * LX + t0;
                const v4u yw = *(const LAS v4u*)(lds + OFF_F + bb * YRS + 2 * t0);
                float xs[10], o[8];
                xs[0] = t0 > 0 ? bf2f(hx[j][0]) : 0.f; xs[9] = t0 + 8 < LX ? bf2f(hx[j][1]) : 0.f;
#pragma unroll
                for (int d = 0; d < 4; ++d) { xs[1 + 2 * d] = bf2f((unsigned short)(xw[j][d] & 0xffffu)); xs[2 + 2 * d] = bf2f((unsigned short)(xw[j][d] >> 16)); }
#pragma unroll
                for (int d = 0; d < 8; ++d) {
                    const float yv = bf2f((unsigned short)((d & 1) ? (yw[d >> 1] >> 16) : (yw[d >> 1] & 0xffffu)));
                    const float gv = bf2f((unsigned short)((d & 1) ? (gw[j][d >> 1] >> 16) : (gw[j][d >> 1] & 0xffffu)));
                    o[d] = yv * (cw.x0[3] + cw.x0[0] * xs[d] + cw.x0[1] * xs[d + 1] + cw.x0[2] * xs[d + 2]) * silu_f(gv);
                }
                v4u ow; ow.x = pk2(o[0], o[1]); ow.y = pk2(o[2], o[3]); ow.z = pk2(o[4], o[5]); ow.w = pk2(o[6], o[7]);
                *(v4u*)(OBT + base) = ow;
            }
        }
    }
    PSTAMP_H(lds, 19);
    __syncthreads();
}
__device__ __forceinline__ void hyena_ctx_channel(LAS unsigned char* lds, const Args& a, const int c) {
    int tid_ = threadIdx.x; asm volatile("" : "+v"(tid_));
    const int tid = tid_;
    unsigned char* ws = a.ws;
    const bf16* PB = (const bf16*)(ws + WS_PB);
    const bf16* x0r = PB + (size_t)c * MTOK + MLAT; const bf16* x1r = PB + (size_t)(512 + c) * MTOK + MLAT; const bf16* vr = PB + (size_t)(1024 + c) * MTOK + MLAT; const bf16* gbr = PB + (size_t)(1536 + c) * MTOK + MLAT;
    const ConvW cw = load_convw(a, 0, c);
    LAS float* vvc = (LAS float*)lds;
    LAS float* Fc = vvc + 2048;
    for (int e = tid; e < 2048; e += NTHR) {
        const int t = e & 255;
        const float vm_ = bf2f(vr[t > 0 ? e - 1 : e]), v0 = bf2f(vr[e]), vp_ = bf2f(vr[t < 255 ? e + 1 : e]);
        const float xm_ = bf2f(x1r[t > 0 ? e - 1 : e]), x0 = bf2f(x1r[e]), xp_ = bf2f(x1r[t < 255 ? e + 1 : e]);
        const float vm = t > 0 ? vm_ : 0.f, vp = t < 255 ? vp_ : 0.f, xm = t > 0 ? xm_ : 0.f, xp = t < 255 ? xp_ : 0.f;
        vvc[e] = (cw.v[3] + cw.v[0] * vm + cw.v[1] * v0 + cw.v[2] * vp) * (cw.x1[3] + cw.x1[0] * xm + cw.x1[1] * x0 + cw.x1[2] * xp);
    }
    if (tid < 520) Fc[tid] = tid < 512 ? bf2f(((const bf16*)(ws + WS_FGC))[(size_t)c * FZC + tid]) : 0.f;
    __syncthreads();
    const float inn = 1.0f / ((const float*)(ws + WS_CTL))[CW_NORM + 2 * 512 + c], hb = a.in[21][c];
    bf16* OBT = (bf16*)(ws + WS_OBT) + (size_t)c * MTOK + MLAT;
    {
        const int b = tid >> 6, t0 = 4 * (tid & 63), e0 = b * 256 + t0;
        float acc4[4] = {0.f, 0.f, 0.f, 0.f};
        const LAS float* fp = Fc + 252 - t0;
        for (int s4 = 0; s4 < 64; ++s4) {
            const f32x4 ga = *(const LAS f32x4*)(fp + 4 * s4), gb = *(const LAS f32x4*)(fp + 4 * s4 + 4), vq = *(const LAS f32x4*)(vvc + b * 256 + 4 * s4);
            const float g[8] = {ga[0], ga[1], ga[2], ga[3], gb[0], gb[1], gb[2], gb[3]};
#pragma unroll
            for (int i = 0; i < 4; ++i)
#pragma unroll
                for (int u = 0; u < 4; ++u) acc4[i] += g[4 - i + u] * vq[u];
        }
        float xs[6], gv[4];
        xs[0] = t0 > 0 ? bf2f(x0r[e0 - 1]) : 0.f;
#pragma unroll
        for (int i = 0; i < 4; ++i) { xs[1 + i] = bf2f(x0r[e0 + i]); gv[i] = bf2f(gbr[e0 + i]); }
        xs[5] = t0 + 4 < 256 ? bf2f(x0r[e0 + 4]) : 0.f;
        float o[4];
#pragma unroll
        for (int i = 0; i < 4; ++i) o[i] = (acc4[i] * inn + vvc[e0 + i] * hb) * (cw.x0[3] + cw.x0[0] * xs[i] + cw.x0[1] * xs[i + 1] + cw.x0[2] * xs[i + 2]) * silu_f(gv[i]);
        v2u ow; ow.x = pk2(o[0], o[1]); ow.y = pk2(o[2], o[3]);
        *(v2u*)(OBT + e0) = ow;
    }
    __syncthreads();
}
}


__device__ __forceinline__ void phase_mix(const Args& a, Frame& F, const int l, const int part = -1) {
    unsigned* qctr = (unsigned*)(a.ws + WS_CTL) + CW_QUEUE + 64 * l + (part == 1 ? 128 : 0);
    volatile LAS int* slot = (volatile LAS int*)(F.lds + LDS_BYTES - 64);
    const int ntasks = l == 0 ? 64 + 512 + 64 + 512 : 64 + 512;
    for (;;) {
        if (F.tid == 0) slot[0] = (int)atomicAdd(qctr, 1u);
        __syncthreads();
        const int t = __builtin_amdgcn_readfirstlane(slot[0]);
        __syncthreads();
        if (t >= ntasks) break;
        if (part == 0 && !(t < 64 || (t >= 576 && t < 640))) continue;
        if (part == 1 && (t < 64 || (t >= 576 && t < 640))) continue;
        if (t < 64) scan::scan_unit(F.lds, (bf16*)(a.ws + WS_PA), (bf16*)(a.ws + WS_OC), t >> 3, (t >> 1) & 3, t & 1, false);
        else if (t < 576) hy::hyena_channel(F.lds, a, l, t - 64);
        else if (t < 640) { const int u = t - 576; scan::scan_unit(F.lds, (bf16*)(a.ws + WS_PA), (bf16*)(a.ws + WS_OC), u >> 3, (u >> 1) & 3, u & 1, true); }
        else hy::hyena_ctx_channel(F.lds, a, t - 640);
        __syncthreads();
    }
}

__device__ __forceinline__ void phase_finalize_ox(const Args& a, Frame& F, int l) {
    unsigned char* ws = a.ws;
    const bf16* PA = (const bf16*)(ws + WS_PA);
    const bf16* OC = (const bf16*)(ws + WS_OC);
    bf16* XA = (bf16*)(ws + WS_XA);
    const float* gnw = a.in[10] + l * 512;
    const int gw = F.vcu * NWAVES + F.wave, NGW = F.G * NWAVES;
    const int ntok = (l == 0) ? MTOK : MLAT;
    for (int tok = gw; tok < ntok; tok += NGW) {
        const bool isctx = tok >= MLAT;
        const int c8 = 8 * F.lane;
        const bf16* pf = isctx ? OC + (size_t)(tok - MLAT) * 512 + c8 : PA + (size_t)tok * PA_LD + 512 + c8;
        const bf16* pb = isctx ? OC + (size_t)MCTX * 512 + (size_t)(tok - MLAT) * 512 + c8 : PA + (size_t)tok * PA_LD + 1024 + c8;
        const v4u wf = *(const v4u*)pf, wb = *(const v4u*)pb, wg = *(const v4u*)(PA + (size_t)tok * PA_LD + 2048 + c8);
        float o[8], g[8];
#pragma unroll
        for (int e = 0; e < 4; ++e) {
            o[2 * e] = bf2f((unsigned short)(wf[e] & 0xffff)) + bf2f((unsigned short)(wb[e] & 0xffff));
            o[2 * e + 1] = bf2f((unsigned short)(wf[e] >> 16)) + bf2f((unsigned short)(wb[e] >> 16));
            g[2 * e] = bf2f((unsigned short)(wg[e] & 0xffff)); g[2 * e + 1] = bf2f((unsigned short)(wg[e] >> 16));
        }
        float s = 0.f;
#pragma unroll
        for (int e = 0; e < 8; ++e) s += o[e] * o[e];
        s += __shfl_xor(s, 1); s += __shfl_xor(s, 2); s += __shfl_xor(s, 4); s += __shfl_xor(s, 8);
        const float rstd = 1.0f / sqrtf(s * (1.0f / HD) + EPS);
        float y[8];
#pragma unroll
        for (int e = 0; e < 8; ++e) y[e] = o[e] * rstd * gnw[c8 + e] * silu_f(g[e]);
        v4u w; w.x = pk2(y[0], y[1]); w.y = pk2(y[2], y[3]); w.z = pk2(y[4], y[5]); w.w = pk2(y[6], y[7]);
        *(v4u*)(XA + (size_t)tok * D + c8) = w;
    }
    LAS unsigned short* t = (LAS unsigned short*)(F.lds + F.wave * 16384);
    const int ntt = ntok / 64;
    for (int it = gw; it < 8 * ntt; it += NGW) {
        const int ct = it / ntt, tt = it % ntt, c0 = ct * 64, t0 = tt * 64;
        const bf16* OBT = (const bf16*)(ws + WS_OBT);
#pragma unroll
        for (int i = 0; i < 8; ++i) {
            const int e = F.lane + 64 * i, c = e >> 3, ch = e & 7;
            const v4u w = *(const v4u*)(OBT + (size_t)(c0 + c) * MTOK + t0 + 8 * ch);
#pragma unroll
            for (int q = 0; q < 4; ++q) { t[c * 66 + 8 * ch + 2 * q] = (unsigned short)(w[q] & 0xffff); t[c * 66 + 8 * ch + 2 * q + 1] = (unsigned short)(w[q] >> 16); }
        }
        asm volatile("s_waitcnt lgkmcnt(0)" ::: "memory");
#pragma unroll
        for (int i = 0; i < 8; ++i) {
            const int e = F.lane + 64 * i, tk = e >> 3, cg = e & 7;
            unsigned short h[8];
#pragma unroll
            for (int q = 0; q < 8; ++q) h[q] = t[(8 * cg + q) * 66 + tk];
            v4u w; w.x = h[0] | ((unsigned)h[1] << 16); w.y = h[2] | ((unsigned)h[3] << 16); w.z = h[4] | ((unsigned)h[5] << 16); w.w = h[6] | ((unsigned)h[7] << 16);
            *(v4u*)(XA + (size_t)(t0 + tk) * D + 512 + c0 + 8 * cg) = w;
        }
        asm volatile("s_waitcnt lgkmcnt(0)" ::: "memory");
    }
}

__device__ __forceinline__ void phase_final_norm(const Args& a, Frame& F) {
    const float* w = a.in[22];
    const bf16* DL = (const bf16*)(a.ws + WS_PB);
    const int gw = F.vcu * NWAVES + F.wave, NGW = F.G * NWAVES;
    for (int tok = gw; tok < MLAT; tok += NGW) {
        float* xr = a.out + (size_t)tok * D;
        f32x4 v[4]; float s = 0.f;
#pragma unroll
        for (int j = 0; j < 4; ++j) { const v2u xw = *(const v2u*)((const unsigned short*)xr + 1024 + 256 * j + 4 * F.lane); const v2u dw = *(const v2u*)(DL + (size_t)tok * D + 256 * j + 4 * F.lane);
            v[j].x = bf2f((unsigned short)(xw.x & 0xffffu)); v[j].y = bf2f((unsigned short)(xw.x >> 16)); v[j].z = bf2f((unsigned short)(xw.y & 0xffffu)); v[j].w = bf2f((unsigned short)(xw.y >> 16));
            v[j].x += bf2f((unsigned short)(dw.x & 0xffffu)); v[j].y += bf2f((unsigned short)(dw.x >> 16)); v[j].z += bf2f((unsigned short)(dw.y & 0xffffu)); v[j].w += bf2f((unsigned short)(dw.y >> 16));
            s += (v[j].x * v[j].x + v[j].y * v[j].y) + (v[j].z * v[j].z + v[j].w * v[j].w); }
        const float rstd = 1.0f / sqrtf(wave_sum(s) * (1.0f / D) + EPS);
#pragma unroll
        for (int j = 0; j < 4; ++j) { const f32x4 w4 = *(const f32x4*)(w + 256 * j + 4 * F.lane); *(f32x4*)(xr + 256 * j + 4 * F.lane) = v[j] * rstd * w4; }
    }
}

enum { PH_PRO = 0, PH_NORM0 = 1, PH_IN0 = 2, PH_MIX0 = 3, PH_FIN0 = 4, PH_OUT0 = 5, PH_NORM1 = 6, PH_IN1 = 7, PH_MIX1 = 8, PH_FIN1 = 9, PH_OUT1 = 10, PH_FINAL = 11 };

__device__ __forceinline__ Frame mkframe(unsigned char* lds) {
    Frame F;
    F.lds = (LAS unsigned char*)lds;
    F.tid = threadIdx.x; F.lane = F.tid & 63; F.wave = __builtin_amdgcn_readfirstlane(F.tid >> 6);
    F.G = gridDim.x; { const int bx = blockIdx.x; F.vcu = (F.G % 8 == 0) ? (bx % 8) * (F.G / 8) + bx / 8 : bx; }
    return F;
}
template <int l> __device__ __forceinline__ void run_inproj(const Args& args, unsigned char* lds) {
    unsigned char* ws = args.ws; Frame F = mkframe(lds);
    pg8::Gemm g{(const bf16*)(ws + WS_XA), (const bf16*)(ws + WS_WIN) + (size_t)l * NIN * D, D};
    pg8::Sched S; S.init(128, 18, F.G, (int)blockIdx.x, 8, l == 0 ? 18 : 8);
    EpiIn E{(bf16*)(ws + WS_PA), (bf16*)(ws + WS_PB), (const float*)(ws + WS_LBS) + l * 1024};
    pg8::gemm_phase<EpiIn, true, true>(F.lds, g, S, E);
}
template <int l> __device__ __forceinline__ void run_outproj(const Args& args, unsigned char* lds) {
    unsigned char* ws = args.ws; Frame F = mkframe(lds);
    pg8::Gemm g{(const bf16*)(ws + WS_XA), (const bf16*)(ws + WS_WOUT) + (size_t)l * D * D, D};
    pg8::Sched S; S.init(128, 4, F.G, (int)blockIdx.x, l == 0 ? 8 : 0, 4);
    EpiOut E{(bf16*)(ws + WS_PB), (const float*)(ws + WS_MOD) + (size_t)l * 9 * 3 * D};
    pg8::gemm_phase<EpiOut, true, true>(F.lds, g, S, E);
}
__global__ void __launch_bounds__(NTHR, 2) mega(Args args) {
    extern __shared__ __attribute__((aligned(16))) unsigned char lds[];
    const int lo = args.ph_lo, hi = args.ph_hi;
#define IN(k) (lo <= (k) && (k) < hi)
    volatile LAS unsigned* bst = (volatile LAS unsigned*)((LAS unsigned char*)lds + LDS_BYTES - 32);
    if (threadIdx.x < 8) ((volatile LAS unsigned*)((LAS unsigned char*)lds + LDS_BYTES - 32))[threadIdx.x] = 0u;
    __syncthreads();
    XcdBarrier bar; bar.bar = (unsigned*)(args.ws + WS_CTL) + CW_BAR; bar.x = 0; bar.st = bst;
    if (hi - lo > 1) bar = xcd_barrier_post((unsigned*)(args.ws + WS_CTL) + CW_BAR, bst);
#ifdef PROBE_ID
    volatile LAS unsigned long long* pts = (volatile LAS unsigned long long*)((LAS unsigned char*)lds + LDS_BYTES - 512);
    if (threadIdx.x == 0) pts[0] = __builtin_amdgcn_s_memrealtime();
#define SEAM(k) do { if (IN((k) + 1)) xcd_barrier(bar); else __syncthreads(); if (threadIdx.x == 0) pts[(k) + 1] = __builtin_amdgcn_s_memrealtime(); } while (0)
#else
#define SEAM(k) do { if (IN((k) + 1)) xcd_barrier(bar); else __syncthreads(); } while (0)
#endif
    if (IN(PH_PRO)) { Frame F = mkframe(lds); phase_prologue(args, F); SEAM(PH_PRO); }
    if (IN(PH_NORM0)) { Frame F = mkframe(lds); phase_normrows(args, F, 0, args.in[0], args.in[2]); SEAM(PH_NORM0); }
    if (IN(PH_IN0)) { run_inproj<0>(args, lds); { Frame F = mkframe(lds); phase_filters_l0(args, F); } SEAM(PH_IN0); }
#ifdef SPLIT_MIX
    if (IN(PH_MIX0)) { Frame F = mkframe(lds); phase_mix(args, F, 0, 0); xcd_barrier(bar); if (threadIdx.x == 0) pts[15] = __builtin_amdgcn_s_memrealtime(); phase_mix(args, F, 0, 1); SEAM(PH_MIX0); }
#else
    if (IN(PH_MIX0)) { Frame F = mkframe(lds); phase_mix(args, F, 0); SEAM(PH_MIX0); }
#endif
    if (IN(PH_FIN0)) { Frame F = mkframe(lds); phase_finalize_ox(args, F, 0); SEAM(PH_FIN0); }
    if (IN(PH_OUT0)) { run_outproj<0>(args, lds); { Frame F = mkframe(lds); phase_filters_l1(args, F); } SEAM(PH_OUT0); }
    if (IN(PH_NORM1)) { Frame F = mkframe(lds); phase_normrows(args, F, 1, args.in[0], args.in[2]); SEAM(PH_NORM1); }
    if (IN(PH_IN1)) { run_inproj<1>(args, lds); SEAM(PH_IN1); }
    if (IN(PH_MIX1)) { Frame F = mkframe(lds); phase_mix(args, F, 1); SEAM(PH_MIX1); }
    if (IN(PH_FIN1)) { Frame F = mkframe(lds); phase_finalize_ox(args, F, 1); SEAM(PH_FIN1); }
    if (IN(PH_OUT1)) { run_outproj<1>(args, lds); SEAM(PH_OUT1); }
    if (IN(PH_FINAL)) { Frame F = mkframe(lds); phase_final_norm(args, F); SEAM(PH_FINAL); }
#ifdef PROBE_ID
    if (blockIdx.x == 0 && threadIdx.x == 0) {
#ifdef SPLIT_MIX
        const unsigned long long dt = (PROBE_ID == 100) ? pts[15] - pts[PH_MIX0] : pts[PH_MIX0 + 1] - pts[15];
#else
        const unsigned long long dt = (PROBE_ID >= 200) ? ((PROBE_ID == 220 || PROBE_ID >= 226) ? 1ull : 16ull) * (pts[PROBE_ID - 200 + 1] - pts[PROBE_ID - 200]) : pts[PROBE_ID + 1] - pts[PROBE_ID];
#endif
        const unsigned long long t0 = __builtin_amdgcn_s_memrealtime();
        unsigned long long wt = 4ull * dt; if (wt > 300000ull) wt = 300000ull;
        while (__builtin_amdgcn_s_memrealtime() - t0 < wt) __builtin_amdgcn_s_sleep(8);
    }
#endif
#undef IN
#undef SEAM
}

extern "C" void kernel_launch(void* const* d_in, const int* in_sizes, int n_in, void* d_out, int out_size, void* d_ws, size_t ws_size, hipStream_t stream) {
    static int grid = 0;
    if (grid == 0) {
        if (n_in != 23 || ws_size < WS_END) { fprintf(stderr, "kernel_launch: unexpected n_in %d / ws_size %zu\n", n_in, ws_size); grid = -1; return; }
        int dev = 0, cus = 0;
        if (hipGetDevice(&dev) != hipSuccess || hipDeviceGetAttribute(&cus, hipDeviceAttributeMultiprocessorCount, dev) != hipSuccess) { grid = -1; return; }
        if (hipFuncSetAttribute((const void*)mega, hipFuncAttributeMaxDynamicSharedMemorySize, LDS_BYTES) != hipSuccess) { fprintf(stderr, "kernel_launch: hipFuncSetAttribute failed\n"); grid = -1; return; }
        grid = cus;
    }
    if (grid < 0) return;
    (void)hipMemsetAsync((char*)d_ws + WS_CTL, 0, CTL_ZERO_BYTES, stream);
    Args a{};
    for (int i = 0; i < 23; ++i) a.in[i] = (const float*)d_in[i];
    a.out = (float*)d_out; a.ws = (unsigned char*)d_ws;
    a.ph_lo = 0; a.ph_hi = PH_FINAL + 1;
    hipLaunchKernelGGL(mega, dim3(grid), dim3(NTHR), LDS_BYTES, stream, a);
}
```

```cpp
#include <hip/hip_runtime.h>
#include <cstdio>
#include <cstdint>
#include <math.h>

namespace pg8 {
#define PG8_LAS __attribute__((address_space(3)))
typedef unsigned short bf16_t;
typedef short bf16x8 __attribute__((ext_vector_type(8)));
typedef float f32x4 __attribute__((ext_vector_type(4)));
typedef unsigned u32x4 __attribute__((ext_vector_type(4)));
typedef unsigned u32x2 __attribute__((ext_vector_type(2)));
constexpr int BM = 256, BK = 64, HALF = 128, HTB = HALF * BK * 2, STAGE_BYTES = 8 * HTB, NXCD = 8, WGM = 8;

__host__ __device__ __forceinline__ int lds_byte(int r, int c) { const int st = (r >> 4) * 2 + (c >> 5), rr = r & 15, cc = c & 31, ob = rr * 64 + cc * 2; return st * 1024 + (ob ^ (((ob >> 9) & 1) << 5)); }
__host__ __device__ __forceinline__ void stage_rc(int b, int& R, int& C) { const int st = b / 1024, sb = b % 1024, swz = sb ^ (((sb >> 9) & 1) << 5); R = (st >> 1) * 16 + swz / 64; C = (st & 1) * 32 + (swz % 64) / 2; }
__host__ __device__ __forceinline__ int perm32(int rho) { const int n = rho >> 4, i = rho & 15; return 8 * (i >> 2) + 4 * n + (i & 3); }

struct Unit { int pm, pn; };
struct Gemm { const bf16_t* A; const bf16_t* Bt; int K; };

struct Sched {
    int nM, nN, nwg, G, c, nctx, nctxN;
    __device__ void init(int nM_, int nN_, int G_, int c_, int nctxM, int nctxN_) { nM = nM_; nN = nN_; nwg = nM * nN; G = G_; c = c_; nctx = nctxM * nctxN_; nctxN = nctxN_ > 0 ? nctxN_ : 1; }
    __device__ bool next(int i, Unit& u) const {
        const long L = (long)i * G + c;
        if (L >= nwg) { const long L2 = L - nwg; if (L2 >= nctx) return false; u.pm = nM + (int)(L2 / nctxN); u.pn = (int)(L2 % nctxN); return true; }
        int wgid = (int)L; { const int q = nwg / NXCD, r = nwg % NXCD, xcd = wgid % NXCD, off = wgid / NXCD; wgid = (xcd < r ? xcd * (q + 1) : r * (q + 1) + (xcd - r) * q) + off; }
        const int nig = WGM * nN, gid = wgid / nig, fm = gid * WGM, gsz = (nM - fm) < WGM ? (nM - fm) : WGM;
        u.pm = fm + ((wgid % nig) % gsz); u.pn = (wgid % nig) / gsz; return true;
    }
};

template <class Epi, bool ALIGN_EPI, bool SP2>
__device__ __forceinline__ void gemm_phase(PG8_LAS unsigned char* lds, const Gemm g, const Sched& S, const Epi& E) {
    const int tid = threadIdx.x, wid = __builtin_amdgcn_readfirstlane(tid >> 6), lane = tid & 63, wr = wid >> 2, wc = wid & 3, fr = lane & 15, fq = lane >> 4;
    const int K = g.K, nt = K / BK;
    unsigned voffA[2], voffB[2];
#pragma unroll
    for (int i = 0; i < 2; ++i) { int R, C; stage_rc(tid * 16 + i * 8192, R, C); const int Rb = Epi::PERM ? ((R & ~31) + perm32(R & 31)) : R;
        voffA[i] = (unsigned)(R * K + C) * 2u; voffB[i] = (unsigned)(Rb * K + C) * 2u; }
    const size_t kstep = (size_t)(BK * 2);
    const size_t hstep = (size_t)HALF * K * 2;
    const size_t tstep = 2 * hstep;
    const unsigned ldsw = (unsigned)wid * 1024u;
    const int aoff = lds_byte(wr * 64 + fr, fq * 8), boff = lds_byte(wc * 32 + fr, fq * 8);
#define PG8_SA(b, h) (((b) * 2 + (h)) * HTB)
#define PG8_SB(b, h) ((4 + (b) * 2 + (h)) * HTB)
#define PG8_STAGE(bufoff, gbase, voff) do { _Pragma("unroll") for (int _i = 0; _i < 2; ++_i) \
        __builtin_amdgcn_global_load_lds((const unsigned*)((const char*)(gbase) + (voff)[_i]), (PG8_LAS unsigned*)(lds + (bufoff) + ldsw + _i * 8192), 16, 0, 0); } while (0)
#define PG8_LDA(dst, b, h) do { _Pragma("unroll") for (int m = 0; m < 4; ++m) _Pragma("unroll") for (int k = 0; k < 2; ++k) dst[m][k] = *(const PG8_LAS bf16x8*)(lds + PG8_SA(b, h) + aoff + m * 2048 + k * 1024); } while (0)
#define PG8_LDB(dst, b, h) do { _Pragma("unroll") for (int n = 0; n < 2; ++n) _Pragma("unroll") for (int k = 0; k < 2; ++k) dst[n][k] = *(const PG8_LAS bf16x8*)(lds + PG8_SB(b, h) + boff + n * 2048 + k * 1024); } while (0)
#define PG8_MMA(ai, bj, At, Bt) do { __builtin_amdgcn_s_setprio(1); _Pragma("unroll") for (int m = 0; m < 4; ++m) _Pragma("unroll") for (int n = 0; n < 2; ++n) _Pragma("unroll") for (int k = 0; k < 2; ++k) \
        acc[ai][bj][m][n] = __builtin_amdgcn_mfma_f32_16x16x32_bf16(Bt[n][k], At[m][k], acc[ai][bj][m][n], 0, 0, 0); __builtin_amdgcn_s_setprio(0); } while (0)
#define PG8_WAIT_V(n) asm volatile("s_waitcnt vmcnt(" #n ")" ::: "memory")
#define PG8_WAIT_L(n) asm volatile("s_waitcnt lgkmcnt(" #n ")" ::: "memory")
#define PG8_BAR __builtin_amdgcn_s_barrier()
#define PG8_SCHED __builtin_amdgcn_sched_barrier(0)
    Unit cur, nxt; int ui = 0;
    if (!S.next(0, cur)) return;
    f32x4 acc[2][2][4][2];
#pragma unroll
    for (int a = 0; a < 2; ++a)
#pragma unroll
        for (int b = 0; b < 2; ++b)
#pragma unroll
            for (int m = 0; m < 4; ++m)
#pragma unroll
                for (int n = 0; n < 2; ++n) acc[a][b][m][n] = (f32x4){0.f, 0.f, 0.f, 0.f};
    bf16x8 At[4][2], B0[2][2], B1[2][2];
    const char* cA = E.swap(cur) ? (const char*)g.Bt + (size_t)cur.pn * tstep : (const char*)g.A + (size_t)cur.pm * tstep;
    const char* cB = E.swap(cur) ? (const char*)g.A + (size_t)cur.pm * tstep : (const char*)g.Bt + (size_t)cur.pn * tstep;
    if constexpr (SP2) {
        PG8_STAGE(PG8_SB(0, 0), cB, voffB); PG8_STAGE(PG8_SB(0, 1), cB + hstep, voffB); PG8_STAGE(PG8_SA(0, 0), cA, voffA); PG8_STAGE(PG8_SA(0, 1), cA + hstep, voffA);
        if (wr == 1) PG8_BAR;
        PG8_WAIT_V(2); PG8_BAR;
        PG8_STAGE(PG8_SB(1, 0), cB + kstep, voffB); PG8_STAGE(PG8_SA(1, 0), cA + kstep, voffA); PG8_STAGE(PG8_SB(1, 1), cB + hstep + kstep, voffB);
        PG8_WAIT_V(6); PG8_BAR;
    } else {
        PG8_STAGE(PG8_SB(0, 0), cB, voffB); PG8_STAGE(PG8_SA(0, 0), cA, voffA); PG8_STAGE(PG8_SB(0, 1), cB + hstep, voffB); PG8_STAGE(PG8_SA(0, 1), cA + hstep, voffA);
        if (wr == 1) PG8_BAR;
        PG8_WAIT_V(4); PG8_BAR;
        PG8_STAGE(PG8_SB(1, 0), cB + kstep, voffB); PG8_STAGE(PG8_SA(1, 0), cA + kstep, voffA); PG8_STAGE(PG8_SB(1, 1), cB + hstep + kstep, voffB);
        PG8_WAIT_V(6); PG8_BAR;
    }
    for (;;) {
        const bool has_next = S.next(ui + 1, nxt);
        const bool nsw = has_next && E.swap(nxt);
        const char* nA = has_next ? (nsw ? (const char*)g.Bt + (size_t)nxt.pn * tstep : (const char*)g.A + (size_t)nxt.pm * tstep) : cA;
        const char* nB = has_next ? (nsw ? (const char*)g.A + (size_t)nxt.pm * tstep : (const char*)g.Bt + (size_t)nxt.pn * tstep) : cB;
        for (int t = 0; t < nt; t += 2) {
            const bool last = (t == nt - 2);
            const char* a1 = cA + (size_t)(t + 1) * kstep;
            const char* a2 = last ? nA : cA + (size_t)(t + 2) * kstep; const char* b2 = last ? nB : cB + (size_t)(t + 2) * kstep;
            const char* a3 = a2 + kstep; const char* b3 = b2 + kstep;
            if constexpr (SP2) {
            PG8_LDB(B0, 0, 0); PG8_LDB(B1, 0, 1); PG8_SCHED; PG8_LDA(At, 0, 0); PG8_STAGE(PG8_SA(1, 1), a1 + hstep, voffA);
            PG8_WAIT_V(8); PG8_WAIT_L(0); PG8_BAR; PG8_MMA(0, 0, At, B0); PG8_MMA(0, 1, At, B1); PG8_BAR; PG8_SCHED;
            PG8_LDA(At, 0, 1); PG8_STAGE(PG8_SB(0, 0), b2, voffB); PG8_STAGE(PG8_SB(0, 1), b2 + hstep, voffB); PG8_STAGE(PG8_SA(0, 0), a2, voffA);
            PG8_WAIT_V(8); PG8_WAIT_L(0); PG8_BAR; PG8_MMA(1, 0, At, B0); PG8_MMA(1, 1, At, B1); PG8_BAR; PG8_SCHED;
            PG8_LDB(B0, 1, 0); PG8_LDB(B1, 1, 1); PG8_SCHED; PG8_LDA(At, 1, 0); PG8_STAGE(PG8_SA(0, 1), a2 + hstep, voffA);
            PG8_WAIT_V(8); PG8_WAIT_L(0); PG8_BAR; PG8_MMA(0, 0, At, B0); PG8_MMA(0, 1, At, B1); PG8_BAR; PG8_SCHED;
            PG8_LDA(At, 1, 1); PG8_STAGE(PG8_SB(1, 0), b3, voffB); PG8_STAGE(PG8_SB(1, 1), b3 + hstep, voffB); PG8_STAGE(PG8_SA(1, 0), a3, voffA);
            PG8_WAIT_V(8); PG8_WAIT_L(0); PG8_BAR; PG8_MMA(1, 0, At, B0); PG8_MMA(1, 1, At, B1); PG8_BAR; PG8_SCHED;
            } else {
            PG8_LDB(B0, 0, 0); PG8_SCHED; PG8_LDA(At, 0, 0); PG8_STAGE(PG8_SA(1, 1), a1 + hstep, voffA);
            PG8_WAIT_L(8); PG8_BAR; PG8_WAIT_L(0); PG8_MMA(0, 0, At, B0); PG8_BAR; PG8_SCHED;
            PG8_LDB(B1, 0, 1); PG8_STAGE(PG8_SB(0, 0), b2, voffB);
            PG8_BAR; PG8_WAIT_L(0); PG8_MMA(0, 1, At, B1); PG8_BAR;
            PG8_LDA(At, 0, 1); PG8_STAGE(PG8_SA(0, 0), a2, voffA);
            PG8_BAR; PG8_WAIT_L(0); PG8_MMA(1, 0, At, B0); PG8_BAR; PG8_SCHED;
            PG8_STAGE(PG8_SB(0, 1), b2 + hstep, voffB);
            PG8_WAIT_V(6); PG8_BAR; PG8_MMA(1, 1, At, B1); PG8_BAR;
            PG8_LDB(B0, 1, 0); PG8_SCHED; PG8_LDA(At, 1, 0); PG8_STAGE(PG8_SA(0, 1), a2 + hstep, voffA);
            PG8_WAIT_L(8); PG8_BAR; PG8_WAIT_L(0); PG8_MMA(0, 0, At, B0); PG8_BAR; PG8_SCHED;
            PG8_LDB(B1, 1, 1); PG8_STAGE(PG8_SB(1, 0), b3, voffB);
            PG8_BAR; PG8_WAIT_L(0); PG8_MMA(0, 1, At, B1); PG8_BAR;
            PG8_LDA(At, 1, 1); PG8_STAGE(PG8_SA(1, 0), a3, voffA);
            PG8_BAR; PG8_WAIT_L(0); PG8_MMA(1, 0, At, B0); PG8_BAR; PG8_SCHED;
            PG8_STAGE(PG8_SB(1, 1), b3 + hstep, voffB);
            PG8_WAIT_V(6); PG8_BAR; PG8_MMA(1, 1, At, B1); PG8_BAR;
            }
        }
        if constexpr (ALIGN_EPI) { if (wr == 0) PG8_BAR; }
        E(acc, cur, wr, wc, fr, fq);
        if (!has_next) break;
#pragma unroll
        for (int a = 0; a < 2; ++a)
#pragma unroll
            for (int b = 0; b < 2; ++b)
#pragma unroll
                for (int m = 0; m < 4; ++m)
#pragma unroll
                    for (int n = 0; n < 2; ++n) acc[a][b][m][n] = (f32x4){0.f, 0.f, 0.f, 0.f};
        cur = nxt; cA = nA; cB = nB; ++ui;
        if constexpr (ALIGN_EPI) { if (wr == 1) PG8_BAR; }
    }
    PG8_WAIT_V(0);
    if constexpr (!ALIGN_EPI) { if (wr == 0) PG8_BAR; }
    PG8_BAR;
#undef PG8_SA
#undef PG8_SB
#undef PG8_STAGE
#undef PG8_LDA
#undef PG8_LDB
#undef PG8_MMA
#undef PG8_WAIT_V
#undef PG8_WAIT_L
#undef PG8_BAR
#undef PG8_SCHED
}
}

constexpr int D = 1024, NB = 8, LX = 4096, LCX = 256, NIN = 4608, DA = 512, DB = 512, HD = 128;
constexpr int MLAT = NB * LX, MCTX = NB * LCX, MTOK = MLAT + MCTX;
constexpr int PA_LD = 3072;
constexpr int FZ = 8448, FZC = 640;
constexpr float EPS = 1e-6f;
constexpr float HY_MIN_DECAY = -3.0701134573253944f, HY_MAX_DECAY = -15.350567286626972f;
constexpr int NWAVES = 8, NTHR = 512;

constexpr size_t MiB = 1u << 20;
constexpr size_t WS_CTL = 0, CTL_ZERO_BYTES = 1 * MiB;
constexpr size_t WS_MOD = 1 * MiB;
constexpr size_t WS_LBS = WS_MOD + 256 * 1024;
constexpr size_t WS_WIN = 6 * MiB;
constexpr size_t WS_WOUT = 24 * MiB;
constexpr size_t WS_FG = 28 * MiB;
constexpr size_t WS_FGC = 45 * MiB;
constexpr size_t WS_CTX1 = 46 * MiB;
constexpr size_t WS_OC = 2 * MiB;
constexpr size_t WS_XA = 54 * MiB;
constexpr size_t WS_PA = 122 * MiB;
constexpr size_t WS_PB = 326 * MiB;
constexpr size_t WS_OBT = 462 * MiB;
constexpr size_t WS_HK = 326 * MiB;
constexpr size_t WS_SCL = 496 * MiB;
constexpr size_t WS_END = 504 * MiB;
constexpr int CW_NORM = 1024;
constexpr int CW_BAR = 8192;
constexpr int CW_QUEUE = 4096;

constexpr int LDS_BYTES = 156 * 1024;
#define LAS __attribute__((address_space(3)))
#define GAS __attribute__((address_space(1)))
typedef unsigned short bf16;
typedef unsigned v4u __attribute__((ext_vector_type(4)));
typedef unsigned v2u __attribute__((ext_vector_type(2)));
typedef float f32x4 __attribute__((ext_vector_type(4)));

typedef __bf16 bf2_t __attribute__((ext_vector_type(2)));
typedef float f2_t __attribute__((ext_vector_type(2)));
__device__ __forceinline__ unsigned pk2(float lo, float hi) { const f2_t v = {lo, hi}; return __builtin_bit_cast(unsigned, __builtin_convertvector(v, bf2_t)); }
__device__ __forceinline__ unsigned f2bf(float f) { return pk2(f, 0.f) & 0xffffu; }
__device__ __forceinline__ float bf2f(unsigned short h) { return __builtin_bit_cast(float, (unsigned)h << 16); }
__device__ __forceinline__ unsigned f2h(float f) { _Float16 h = (_Float16)f; return (unsigned)__builtin_bit_cast(unsigned short, h); }
__device__ __forceinline__ unsigned pk2h(float lo, float hi) { return f2h(lo) | (f2h(hi) << 16); }
__device__ __forceinline__ float h2f(unsigned short u) { return (float)__builtin_bit_cast(_Float16, u); }
__device__ __forceinline__ float silu_f(float x) { return x * __builtin_amdgcn_rcpf(1.0f + __expf(-x)); }
__device__ __forceinline__ float sigmoid_f(float x) { return __builtin_amdgcn_rcpf(1.0f + __expf(-x)); }
__device__ __forceinline__ float wave_sum(float v) {
#pragma unroll
    for (int o = 1; o < 64; o <<= 1) v += __shfl_xor(v, o);
    return v;
}


#define PSTAMP_(lds_, k_) do { if (threadIdx.x == 0) ((volatile LAS unsigned long long*)((lds_) + LDS_BYTES - 512))[(k_)] = __builtin_amdgcn_s_memrealtime(); } while (0)
#if defined(PROBE_ID) && PROBE_ID >= 216 && PROBE_ID < 220
#define PSTAMP_H(lds_, k_) PSTAMP_(lds_, k_)
#else
#define PSTAMP_H(lds_, k_) do { } while (0)
#endif
#if defined(PROBE_ID) && PROBE_ID >= 226 && PROBE_ID < 230
#define PSTAMP_P(lds_, k_) PSTAMP_(lds_, k_)
#else
#define PSTAMP_P(lds_, k_) do { } while (0)
#endif
#if defined(PROBE_ID) && PROBE_ID >= 220 && PROBE_ID < 226
#define PSTAMP_S(lds_, k_) PSTAMP_(lds_, k_)
#else
#define PSTAMP_S(lds_, k_) do { } while (0)
#endif
typedef GAS unsigned gu32;
#define XB_TMO      128
#define XB_XCNT(j)  (256  + 64 * (j))
#define XB_XSUB(j)  (1280 + 64 * (j))
#define XB_XGEN(j)  (2304 + 64 * (j))
#define XB_TOP      3328
#define XB_TOPGEN   3392
#define XCD_BAR_WORDS 3456
#define XB_SPIN_CAP (1u << 18)
__device__ __forceinline__ unsigned xb_ld(unsigned* p)              { return __hip_atomic_load(p, __ATOMIC_RELAXED, __HIP_MEMORY_SCOPE_AGENT); }
__device__ __forceinline__ unsigned xb_add(unsigned* p, unsigned v) { return __hip_atomic_fetch_add(p, v, __ATOMIC_RELAXED, __HIP_MEMORY_SCOPE_AGENT); }
__device__ __forceinline__ unsigned xb_xcc_id() { return (unsigned)__builtin_amdgcn_s_getreg((3 << 11) | 20) & 0xFu; }
#define XB_SPIN(cond, bar) do { unsigned _sp = 0; while (cond) { __builtin_amdgcn_s_sleep(1); \
    if ((++_sp & 255u) == 0u) { if (xb_ld(&(bar)[XB_TMO])) break; if (_sp > XB_SPIN_CAP) { atomicAdd(&(bar)[XB_TMO], 1u); break; } } } } while (0)
struct XcdBarrier { unsigned* bar; unsigned x; volatile LAS unsigned* st; };
__device__ __forceinline__ XcdBarrier xcd_barrier_post(unsigned* bar, volatile LAS unsigned* st) {
    XcdBarrier b; b.bar = bar; b.x = xb_xcc_id(); b.st = st;
    if (threadIdx.x == 0) (void)xb_add(&bar[XB_XCNT(b.x)], 1u);
    return b;
}
__device__ __forceinline__ void xcd_barrier_complete(unsigned* bar, unsigned x, unsigned& nloc, unsigned& nx) {
    const unsigned G = gridDim.x * gridDim.y * gridDim.z;
    unsigned sum, cnt, mine, sp = 0u;
    for (;;) {
        sum = 0u; cnt = 0u; mine = 0u;
#pragma unroll
        for (unsigned j = 0; j < 16; ++j) { const unsigned c = xb_ld(&bar[XB_XCNT(j)]); sum += c; cnt += (c > 0u) ? 1u : 0u; mine = (j == x) ? c : mine; }
        if (sum == G) break;
        __builtin_amdgcn_s_sleep(1);
        if ((++sp & 255u) == 0u) { if (xb_ld(&bar[XB_TMO])) break; if (sp > XB_SPIN_CAP) { atomicAdd(&bar[XB_TMO], 1u); break; } }
    }
    nloc = mine > 0u ? mine : 1u; nx = cnt > 0u ? cnt : 1u;
}
__device__ __forceinline__ void xcd_barrier(const XcdBarrier& b) {
    asm volatile("s_waitcnt vmcnt(0)" ::: "memory");
    __syncthreads();
    if (threadIdx.x == 0) {
        unsigned* bar = b.bar;
        __builtin_amdgcn_s_waitcnt(0);
        unsigned nloc = b.st[0], nx = b.st[1];
        if (nloc == 0u) { xcd_barrier_complete(bar, b.x, nloc, nx); b.st[0] = nloc; b.st[1] = nx; }
        const unsigned old = xb_add(&bar[XB_XSUB(b.x)], 1u);
        const unsigned gen = old / nloc;
        if (old + 1u == (gen + 1u) * nloc) {
            __builtin_amdgcn_fence(__ATOMIC_RELEASE, "agent");
            asm volatile("s_waitcnt vmcnt(0)" ::: "memory");
            const unsigned og = xb_add(&bar[XB_TOP], 1u);
            const unsigned tg = og / nx;
            if (og + 1u == (tg + 1u) * nx) xb_add(&bar[XB_TOPGEN], 1u);
            else XB_SPIN(xb_ld(&bar[XB_TOPGEN]) == tg, bar);
            __builtin_amdgcn_fence(__ATOMIC_ACQUIRE, "agent");
            xb_add(&bar[XB_XGEN(b.x)], 1u);
            asm volatile("s_waitcnt vmcnt(0)" ::: "memory");
        } else {
            XB_SPIN(xb_ld(&bar[XB_XGEN(b.x)]) == gen, bar);
            __builtin_amdgcn_fence(__ATOMIC_ACQUIRE, "agent");
            asm volatile("s_waitcnt vmcnt(0)" ::: "memory");
        }
    }
    __syncthreads();
}

struct EpiIn {
    static constexpr bool PERM = true;
    bf16* PA; bf16* PB; const float* lb;
    __device__ __forceinline__ bool swap(const pg8::Unit& u) const { return u.pn >= 10; }
    __device__ __forceinline__ void operator()(const f32x4 (&acc)[2][2][4][2], const pg8::Unit& u, int wr, int wc, int fr, int fq) const {
        if (u.pn < 10) {
            const int type = u.pn >> 1;
            const int row0 = u.pm * 256 + wr * 64 + fr, col0 = u.pn * 256 + wc * 32 + 8 * fq;
#pragma unroll
            for (int bj = 0; bj < 2; ++bj) {
                float lbv[8];
#pragma unroll
                for (int e = 0; e < 8; ++e) lbv[e] = (type == 1 || type == 2) ? lb[col0 + bj * 128 + e - 512] : 0.f;
#pragma unroll
                for (int ai = 0; ai < 2; ++ai)
#pragma unroll
                    for (int m = 0; m < 4; ++m) {
                        bf16* rowp = PA + (size_t)(row0 + ai * 128 + m * 16) * PA_LD + col0 + bj * 128;
                        float x[8];
#pragma unroll
                        for (int e = 0; e < 4; ++e) { x[e] = acc[ai][bj][m][0][e]; x[4 + e] = acc[ai][bj][m][1][e]; }
                        v4u w;
                        if (type == 0) {
#pragma unroll
                            for (int e = 0; e < 8; ++e) x[e] = silu_f(x[e]);
                            w.x = pk2(x[0], x[1]); w.y = pk2(x[2], x[3]); w.z = pk2(x[4], x[5]); w.w = pk2(x[6], x[7]);
                        } else if (type == 1 || type == 2) {
#pragma unroll
                            for (int e = 0; e < 8; ++e) x[e] = lbv[e] + (1.0f - lbv[e]) * sigmoid_f(x[e]);
                            w.x = pk2h(x[0], x[1]); w.y = pk2h(x[2], x[3]); w.z = pk2h(x[4], x[5]); w.w = pk2h(x[6], x[7]);
                        } else {
                            w.x = pk2(x[0], x[1]); w.y = pk2(x[2], x[3]); w.z = pk2(x[4], x[5]); w.w = pk2(x[6], x[7]);
                        }
                        *(v4u*)rowp = w;
                        asm volatile("" ::: "memory");
                    }
            }
        } else {
#pragma unroll
            for (int ai = 0; ai < 2; ++ai)
#pragma unroll
                for (int m = 0; m < 4; ++m) {
                    const int cw = u.pn * 256 + ai * 128 + wr * 64 + m * 16 + fr;
                    bf16* colp = PB + (size_t)(cw - 2560) * MTOK + u.pm * 256 + wc * 32 + 8 * fq;
#pragma unroll
                    for (int bj = 0; bj < 2; ++bj) {
                        const f32x4 v0 = acc[ai][bj][m][0], v1 = acc[ai][bj][m][1];
                        v4u w; w.x = pk2(v0[0], v0[1]); w.y = pk2(v0[2], v0[3]); w.z = pk2(v1[0], v1[1]); w.w = pk2(v1[2], v1[3]);
                        *(v4u*)(colp + bj * 128) = w;
                    }
                }
        }
    }
};
struct EpiOut {
    static constexpr bool PERM = true;
    bf16* DL; const float* mod;
    __device__ __forceinline__ bool swap(const pg8::Unit&) const { return false; }
    __device__ __forceinline__ void operator()(const f32x4 (&acc)[2][2][4][2], const pg8::Unit& u, int wr, int wc, int fr, int fq) const {
        const int mr = u.pm >= 128 ? 8 : (u.pm >> 4);
        const int col0 = u.pn * 256 + wc * 32 + 8 * fq;
        f32x4 g0[2], g1[2];
#pragma unroll
        for (int bj = 0; bj < 2; ++bj) { const float* gt = mod + (size_t)mr * 3 * D + 2 * D + col0 + bj * 128; g0[bj] = *(const f32x4*)gt; g1[bj] = *(const f32x4*)(gt + 4); }
#pragma unroll
        for (int ai = 0; ai < 2; ++ai)
#pragma unroll
            for (int m = 0; m < 4; ++m) {
                bf16* rowp = DL + (size_t)(u.pm * 256 + ai * 128 + wr * 64 + m * 16 + fr) * D + col0;
#pragma unroll
                for (int bj = 0; bj < 2; ++bj) {
                    const f32x4 v0 = acc[ai][bj][m][0] * g0[bj], v1 = acc[ai][bj][m][1] * g1[bj];
                    v4u w; w.x = pk2(v0[0], v0[1]); w.y = pk2(v0[2], v0[3]); w.z = pk2(v1[0], v1[1]); w.w = pk2(v1[2], v1[3]);
                    *(v4u*)(rowp + bj * 128) = w;
                }
            }
    }
};

struct Args {
    const float* in[23]; float* out; unsigned char* ws; int ph_lo, ph_hi;
};

struct Frame {
    LAS unsigned char* lds; int tid, lane, wave, vcu, G;
};

__device__ __forceinline__ void p0_transpose_item(const float* W, int K, int N, bf16* WT, LAS float* scr, int item, int lane) {
    const int nblk = N / 32, kb = item / nblk, nb = item % nblk, k0 = 64 * kb, n0 = 32 * nb;
    f32x4 v[8];
#pragma unroll
    for (int i = 0; i < 8; ++i) v[i] = *(const f32x4*)(W + (size_t)(k0 + 8 * i + (lane >> 3)) * N + n0 + 4 * (lane & 7));
#pragma unroll
    for (int i = 0; i < 8; ++i) { LAS float* d = scr + (8 * i + (lane >> 3)) * 33 + 4 * (lane & 7); d[0] = v[i][0]; d[1] = v[i][1]; d[2] = v[i][2]; d[3] = v[i][3]; }
    asm volatile("s_waitcnt lgkmcnt(0)" ::: "memory");
    const int c = lane & 7;
#pragma unroll
    for (int j = 0; j < 4; ++j) { const int n = (lane >> 3) + 8 * j; const LAS float* s = scr + (8 * c) * 33 + n;
        v4u o; o.x = pk2(s[0 * 33], s[1 * 33]); o.y = pk2(s[2 * 33], s[3 * 33]); o.z = pk2(s[4 * 33], s[5 * 33]); o.w = pk2(s[6 * 33], s[7 * 33]);
        *(v4u*)(WT + (size_t)(n0 + n) * K + k0 + 8 * c) = o; }
    asm volatile("s_waitcnt lgkmcnt(0)" ::: "memory");
}

__device__ __forceinline__ void filter_task(const Args& a, Frame& F, const int set, const int n0, int& cached_layer) {
    unsigned char* ws = a.ws;
    const int l = set == 1 ? 1 : 0, L = set == 2 ? 256 : 4096;
    LAS float* w1s = (LAS float*)F.lds;
    LAS float* w2s = w1s + 33 * 64;
    LAS float* w3s = w2s + 64 * 64;
    LAS float* bs = w3s + 64 * 64;
    LAS float* zs = bs + 256;
    LAS float* h3s = zs + 8 * 4 * 64;
    LAS unsigned short* tile = (LAS unsigned short*)(h3s + 32 * 64);
    if (cached_layer != l) {
        __syncthreads();
        for (int e = F.tid; e < 33 * 64; e += NTHR) w1s[e] = a.in[13][l * 33 * 64 + e];
        for (int e = F.tid; e < 4096; e += NTHR) { w2s[e] = a.in[16][l * 4096 + e]; w3s[e] = a.in[18][l * 4096 + e]; }
        if (F.tid < 64) { bs[F.tid] = a.in[14][l * 64 + F.tid]; bs[64 + F.tid] = a.in[17][l * 64 + F.tid]; bs[128 + F.tid] = a.in[19][l * 64 + F.tid]; bs[192 + F.tid] = a.in[15][l * 64 + F.tid]; }
        cached_layer = l;
        __syncthreads();
    }
    {
        const int j = F.lane; LAS float* zw = zs + F.wave * 256; const float fr = bs[192 + j];
#pragma unroll
        for (int p = 0; p < 4; ++p) {
            const int n = n0 + 4 * F.wave + p;
            float zv = 0.f;
            if (j == 0) zv = (float)n / (float)(L - 1);
            else if (j < 33) { const int i = (j - 1) & 15; const double f = 1e-4 + (double)i * ((15.0 - 1e-4) / 15.0); double rev = f * (double)n / (double)L; rev -= floor(rev);
                const float ang = (float)(rev * 6.283185307179586476925); zv = (j <= 16) ? __cosf(ang) : -__sinf(ang); }
            zw[p * 64 + j] = zv;
        }
        asm volatile("s_waitcnt lgkmcnt(0)" ::: "memory");
        float s4[4];
#pragma unroll
        for (int p = 0; p < 4; ++p) s4[p] = bs[j];
        for (int e = 0; e < 33; ++e) { const float wv = w1s[e * 64 + j];
#pragma unroll
            for (int p = 0; p < 4; ++p) s4[p] += zw[p * 64 + e] * wv; }
        asm volatile("s_waitcnt lgkmcnt(0)" ::: "memory");
#pragma unroll
        for (int p = 0; p < 4; ++p) zw[p * 64 + j] = __sinf(fr * s4[p]);
        asm volatile("s_waitcnt lgkmcnt(0)" ::: "memory");
#pragma unroll
        for (int p = 0; p < 4; ++p) s4[p] = bs[64 + j];
        for (int e = 0; e < 64; ++e) { const float wv = w2s[e * 64 + j];
#pragma unroll
            for (int p = 0; p < 4; ++p) s4[p] += zw[p * 64 + e] * wv; }
        asm volatile("s_waitcnt lgkmcnt(0)" ::: "memory");
#pragma unroll
        for (int p = 0; p < 4; ++p) zw[p * 64 + j] = __sinf(fr * s4[p]);
        asm volatile("s_waitcnt lgkmcnt(0)" ::: "memory");
#pragma unroll
        for (int p = 0; p < 4; ++p) s4[p] = bs[128 + j];
        for (int e = 0; e < 64; ++e) { const float wv = w3s[e * 64 + j];
#pragma unroll
            for (int p = 0; p < 4; ++p) s4[p] += zw[p * 64 + e] * wv; }
#pragma unroll
        for (int p = 0; p < 4; ++p) h3s[(4 * F.wave + p) * 64 + j] = __sinf(fr * s4[p]);
    }
    __syncthreads();
    {
        typedef short bf16x8_ __attribute__((ext_vector_type(8)));
        LAS unsigned char* hA = (LAS unsigned char*)(tile + 1024 * 34);
        LAS unsigned char* wB = hA + 32 * 144;
        const int l15 = F.lane & 15, q = F.lane >> 4;
        { const int p = F.tid >> 4, k4 = (F.tid & 15) * 4; const f32x4 hv = *(const LAS f32x4*)(h3s + p * 64 + k4);
          v2u hw; hw.x = pk2(hv[0], hv[1]); hw.y = pk2(hv[2], hv[3]); *(LAS v2u*)(hA + p * 144 + 2 * k4) = hw; }
        float* nrm = (float*)(ws + WS_CTL) + CW_NORM;
        const float* w4 = a.in[20] + (size_t)l * 64 * 1024;
        for (int ch = 0; ch < 8; ++ch) {
            __syncthreads();
            { const int n = F.tid & 127, kq = F.tid >> 7;
              float wv[2][8];
#pragma unroll
              for (int g2 = 0; g2 < 2; ++g2)
#pragma unroll
                  for (int e = 0; e < 8; ++e) wv[g2][e] = w4[(size_t)(16 * kq + 8 * g2 + e) * 1024 + 128 * ch + n];
#pragma unroll
              for (int g2 = 0; g2 < 2; ++g2) { v4u o; o.x = pk2(wv[g2][0], wv[g2][1]); o.y = pk2(wv[g2][2], wv[g2][3]); o.z = pk2(wv[g2][4], wv[g2][5]); o.w = pk2(wv[g2][6], wv[g2][7]);
                  *(LAS v4u*)(wB + n * 144 + (16 * kq + 8 * g2) * 2) = o; } }
            __syncthreads();
            {
                const int col = 128 * ch + 16 * F.wave + l15, c = col & 511;
                f32x4 acc[2];
#pragma unroll
                for (int mt = 0; mt < 2; ++mt) { acc[mt] = (f32x4){0.f, 0.f, 0.f, 0.f};
#pragma unroll
                    for (int ks = 0; ks < 2; ++ks)
                        acc[mt] = __builtin_amdgcn_mfma_f32_16x16x32_bf16(*(const LAS bf16x8_*)(hA + (16 * mt + l15) * 144 + (32 * ks + 8 * q) * 2), *(const LAS bf16x8_*)(wB + (16 * F.wave + l15) * 144 + (32 * ks + 8 * q) * 2), acc[mt], 0, 0, 0); }
                const float dl = fabsf(HY_MIN_DECAY + (float)c * ((HY_MAX_DECAY - HY_MIN_DECAY) / 511.0f));
                float ns = 0.f;
#pragma unroll
                for (int mt = 0; mt < 2; ++mt) {
                    float v4[4];
#pragma unroll
                    for (int r = 0; r < 4; ++r) { const int nn = n0 + 16 * mt + 4 * q + r; v4[r] = acc[mt][r] * __expf(-((float)nn / (float)(L - 1)) * dl); if (col < 512 || nn >= 1) ns += fabsf(v4[r]); }
                    *(LAS unsigned*)(tile + col * 34 + 16 * mt + 4 * q) = pk2(v4[0], v4[1]); *(LAS unsigned*)(tile + col * 34 + 16 * mt + 4 * q + 2) = pk2(v4[2], v4[3]);
                }
                ns += __shfl_xor(ns, 16); ns += __shfl_xor(ns, 32);
                if (q == 0) atomicAdd(&nrm[set * 512 + c], ns);
            }
        }
    }
    __syncthreads();
    {
        bf16* dst = set == 2 ? (bf16*)(ws + WS_FGC) : (bf16*)(ws + WS_FG) + (size_t)set * 512 * FZ;
        const int ld = set == 2 ? FZC : FZ;
        for (int e = F.tid; e < 1024 * 32; e += NTHR) {
            const int col = e >> 5, p = e & 31, c = col & 511, n = n0 + p;
            const unsigned short v = tile[col * 34 + p];
            if (col < 512) dst[(size_t)c * ld + (L - n)] = v;
            else if (n >= 1) dst[(size_t)c * ld + (L + n)] = v;
        }
        if (n0 == 0) {
            const int npad = ld - 2 * L;
            for (int e = F.tid; e < 512 * (npad + 1); e += NTHR) { const int c = e / (npad + 1), k = e % (npad + 1); dst[(size_t)c * ld + (k == 0 ? 0 : 2 * L + k - 1)] = 0; }
        }
    }
    __syncthreads();
}

__device__ __forceinline__ void phase_prologue(const Args& a, Frame& F) {
    unsigned char* ws = a.ws;
    if (F.vcu == 0) {
        float* lbs = (float*)(ws + WS_LBS);
        for (int i = F.tid; i < 1024; i += NTHR) {
            const float a0 = a.in[9][i], a1 = a.in[9][1024 + i];
            const float m = fmaxf(a0, a1), e0 = expf(a0 - m), e1 = expf(a1 - m);
            const float p0 = e0 / (e0 + e1), p1 = e1 / (e0 + e1);
            const float c0 = p0, c1 = p0 + p1;
            lbs[i] = c0 - c0; lbs[1024 + i] = c1 - c0;
        }
    }
    int cached_layer = -1;
    constexpr int I_IN = (D / 64) * (NIN / 32), I_OUT = (D / 64) * (D / 32), NTR = 2 * (I_IN + I_OUT) / 8;
    for (int t = F.vcu; t < NTR; t += F.G) {
        LAS float* scr = (LAS float*)(F.lds + 65536 + F.wave * 8704);
        int r = t * 8 + F.wave; const int l = r / (I_IN + I_OUT); r -= l * (I_IN + I_OUT);
        if (r < I_IN) p0_transpose_item(a.in[7] + (size_t)l * D * NIN, D, NIN, (bf16*)(ws + WS_WIN) + (size_t)l * NIN * D, scr, r, F.lane);
        else p0_transpose_item(a.in[8] + (size_t)l * D * D, D, D, (bf16*)(ws + WS_WOUT) + (size_t)l * D * D, scr, r - I_IN, F.lane);
    }
    __syncthreads();
    if (F.vcu >= 136 && F.vcu < 232) {
        const int task = F.vcu - 136;
        LAS float* sv = (LAS float*)(F.lds + 65536);
        LAS float* part = sv + 9 * 1024;
        const int l = task / 48, n0 = (task % 48) * 64;
        for (int e = F.tid; e < 9 * 1024; e += NTHR) { const int r = e >> 10, k = e & 1023; const float cv = r < 8 ? a.in[1][r * D + k] : a.in[3][k]; sv[e] = cv / (1.0f + expf(-cv)); }
        __syncthreads();
        float acc9[9];
#pragma unroll
        for (int r = 0; r < 9; ++r) acc9[r] = 0.f;
        const float* w = a.in[5] + (size_t)l * D * 3 * D + n0 + F.lane;
#pragma unroll 8
        for (int k = F.wave * 128; k < F.wave * 128 + 128; ++k) {
            const float wv = w[(size_t)k * 3 * D];
#pragma unroll
            for (int r = 0; r < 9; ++r) acc9[r] += sv[r * 1024 + k] * wv;
        }
#pragma unroll
        for (int r = 0; r < 9; ++r) part[(F.wave * 9 + r) * 64 + F.lane] = acc9[r];
        __syncthreads();
        for (int e = F.tid; e < 9 * 64; e += NTHR) {
            const int r = e >> 6, c = e & 63; float sum = 0.f;
#pragma unroll
            for (int w8 = 0; w8 < 8; ++w8) sum += part[(w8 * 9 + r) * 64 + c];
            ((float*)(ws + WS_MOD))[((size_t)l * 9 + r) * 3 * D + n0 + c] = sum + a.in[6][l * 3 * D + n0 + c];
        }
        __syncthreads();
    }
    if (F.vcu < 16) filter_task(a, F, 0, 32 * (112 + F.vcu), cached_layer);
    else if (F.vcu >= 128 && F.vcu < 136) filter_task(a, F, 2, 32 * (F.vcu - 128), cached_layer);
}
__device__ __forceinline__ void phase_filters_l0(const Args& a, Frame& F) {
    int cached_layer = -1; const int b = (int)blockIdx.x;
    if (b >= 144) filter_task(a, F, 0, 32 * (b - 144), cached_layer);
}
__device__ __forceinline__ void phase_filters_l1(const Args& a, Frame& F) {
    int cached_layer = -1; const int b = (int)blockIdx.x;
    if (b >= 32 && b < 160) filter_task(a, F, 1, 32 * (b - 32), cached_layer);
}

__device__ __forceinline__ void phase_normrows(const Args& a, Frame& F, int l, const float* xlat, const float* xctx) {
    unsigned char* ws = a.ws;
    const float* nw = a.in[4] + l * D;
    const float* mod = (const float*)(ws + WS_MOD) + (size_t)l * 9 * 3 * D;
    bf16* XA = (bf16*)(ws + WS_XA);
    const bf16* DL = (const bf16*)(ws + WS_PB);
    const int gw = F.vcu * NWAVES + F.wave, NGW = F.G * NWAVES;
    for (int tok = gw; tok < MTOK; tok += NGW) {
        const bool isctx = tok >= MLAT;
        const float* xr = isctx ? xctx + (size_t)(tok - MLAT) * D : xlat + (size_t)tok * D;
        const int mr = isctx ? 8 : (tok >> 12);
        const float* sh = mod + (size_t)mr * 3 * D; const float* sc = sh + D;
        f32x4 v[4]; float s = 0.f;
#pragma unroll
        for (int j = 0; j < 4; ++j) v[j] = *(const f32x4*)(xr + 256 * j + 4 * F.lane);
        if (l == 1) {
#pragma unroll
            for (int j = 0; j < 4; ++j) { const v2u dw = *(const v2u*)(DL + (size_t)tok * D + 256 * j + 4 * F.lane);
                v[j].x += bf2f((unsigned short)(dw.x & 0xffffu)); v[j].y += bf2f((unsigned short)(dw.x >> 16)); v[j].z += bf2f((unsigned short)(dw.y & 0xffffu)); v[j].w += bf2f((unsigned short)(dw.y >> 16)); }
            if (!isctx) {
#pragma unroll
                for (int j = 0; j < 4; ++j) *(f32x4*)(a.out + (size_t)tok * D + 256 * j + 4 * F.lane) = v[j];
            }
        }
#pragma unroll
        for (int j = 0; j < 4; ++j) s += (v[j].x * v[j].x + v[j].y * v[j].y) + (v[j].z * v[j].z + v[j].w * v[j].w);
        const float rstd = 1.0f / sqrtf(wave_sum(s) * (1.0f / D) + EPS);
#pragma unroll
        for (int j = 0; j < 4; ++j) {
            const int k = 256 * j + 4 * F.lane;
            const f32x4 w4 = *(const f32x4*)(nw + k), s4 = *(const f32x4*)(sc + k), h4 = *(const f32x4*)(sh + k);
            const f32x4 y = v[j] * rstd * w4 * (s4 + 1.0f) + h4;
            v2u o; o.x = pk2(y.x, y.y); o.y = pk2(y.z, y.w);
            *(v2u*)(XA + (size_t)tok * D + k) = o;
        }
    }
}


namespace scan {
typedef short bf16x8 __attribute__((ext_vector_type(8)));
typedef short bf16x4 __attribute__((ext_vector_type(4)));
constexpr int QI_RS = 256, KT_RS = 160;
constexpr int OFF_QI = 0, OFF_KI = 16384, OFF_KT = 32768, OFF_VT = 53248, OFF_SCL = 73728, SET_BYTES = 74752;
constexpr int OFF_SEG = 2 * SET_BYTES;
static_assert(OFF_SEG + 4096 <= LDS_BYTES - 512, "scan LDS");
#define MFMA16(a, b, c) __builtin_amdgcn_mfma_f32_16x16x32_bf16((a), (b), (c), 0, 0, 0)
__device__ __forceinline__ bf16x8 ld_qk(const LAS unsigned char* img, int row, int ks, int xq) {
    return *(const LAS bf16x8*)(img + row * QI_RS + ((16 * xq) ^ (64 * ks)));
}
__device__ __forceinline__ int tok_row(int g, int i, int b, int dir) {
    if (g < 4) { const int t = 64 * g + i; return MLAT + b * LCX + (dir ? (LCX - 1 - t) : t); }
    const int t = 64 * (g - 4) + i; return b * LX + (dir ? (LX - 1 - t) : t);
}
template <int HALF>
__device__ __forceinline__ void scan_producer(LAS unsigned char* lds, const bf16* PA, const int b, const int h, const int dir, const int nchunk, const int pw, const int lane) {
    const int tg = lane >> 4, cq = lane & 15, ch0 = 64 * (pw >> 1) + 4 * cq;
    LAS float* seg = (LAS float*)(lds + OFF_SEG + pw * 1024);
    const int qc_ = 8 * (pw >> 1) + 4 * (cq >> 3) + (cq & 3);
    v2u qA[8], fA[8], vA[8], qB[8], fB[8], vB[8];
#define SCAN_LOAD(g, Q_, F_, V_) do { _Pragma("unroll") for (int e = 0; e < 8; ++e) { const bf16* p_ = PA + (size_t)tok_row((g), 32 * HALF + 8 * tg + e, b, dir) * PA_LD + h * HD + ch0; \
        Q_[e] = *(const v2u*)p_; F_[e] = *(const v2u*)(p_ + 512 + dir * 512); V_[e] = *(const v2u*)(p_ + 1536); } } while (0)
#define SCAN_IMG(set_, Q_, F_, V_) do { LAS unsigned char* s_ = lds + (set_) * SET_BYTES; \
        _Pragma("unroll") for (int e = 0; e < 8; ++e) asm volatile("" : "+v"(F_[e].x), "+v"(F_[e].y)); \
        float f_[4][8]; \
        _Pragma("unroll") for (int e = 0; e < 8; ++e) { f_[0][e] = h2f((unsigned short)(F_[e].x & 0xffffu)); f_[1][e] = h2f((unsigned short)(F_[e].x >> 16)); f_[2][e] = h2f((unsigned short)(F_[e].y & 0xffffu)); f_[3][e] = h2f((unsigned short)(F_[e].y >> 16)); } \
        f32x4 pr_; \
        _Pragma("unroll") for (int d = 0; d < 4; ++d) pr_[d] = ((f_[d][0] * f_[d][1]) * (f_[d][2] * f_[d][3])) * ((f_[d][4] * f_[d][5]) * (f_[d][6] * f_[d][7])); \
        *(LAS f32x4*)(seg + tg * 64 + 4 * cq) = pr_; \
        f32x4 T_[4]; _Pragma("unroll") for (int t2 = 0; t2 < 4; ++t2) T_[t2] = *(const LAS f32x4*)(seg + t2 * 64 + 4 * cq); \
        const f32x4 tot_ = (T_[0] * T_[1]) * (T_[2] * T_[3]); \
        f32x4 mul_ = (f32x4){1.f, 1.f, 1.f, 1.f}; \
        if (HALF) { _Pragma("unroll") for (int t2 = 0; t2 < 3; ++t2) if (t2 < tg) mul_ *= T_[t2]; } \
        else      { _Pragma("unroll") for (int t2 = 1; t2 < 4; ++t2) if (t2 > tg) mul_ *= T_[t2]; } \
        float Qp_[4][8], Kp_[4][8]; \
        _Pragma("unroll") for (int d = 0; d < 4; ++d) { float x_[8]; float run_ = mul_[d]; \
            if (HALF) { _Pragma("unroll") for (int e = 0; e < 8; ++e) { run_ *= f_[d][e]; x_[e] = run_; } } \
            else      { _Pragma("unroll") for (int e = 7; e >= 0; --e) { x_[e] = run_; run_ *= f_[d][e]; } } \
            _Pragma("unroll") for (int e = 0; e < 8; ++e) { const unsigned qw_ = (d & 2) ? Q_[e].y : Q_[e].x; const float qv_ = bf2f((unsigned short)((d & 1) ? (qw_ >> 16) : (qw_ & 0xffffu))); \
                const float xx_ = fmaxf(x_[e], 1e-30f), r_ = __builtin_amdgcn_rcpf(xx_), kk_ = 1.0f - f_[d][e]; \
                Qp_[d][e] = HALF ? qv_ * xx_ : qv_ * r_; Kp_[d][e] = HALF ? kk_ * r_ : kk_ * xx_; } \
            v4u t_, u_; \
            _Pragma("unroll") for (int e = 0; e < 4; ++e) { t_[e] = pk2(Kp_[d][2 * e], Kp_[d][2 * e + 1]); \
                const unsigned va_ = (d & 2) ? V_[2 * e].y : V_[2 * e].x, vb_ = (d & 2) ? V_[2 * e + 1].y : V_[2 * e + 1].x; \
                u_[e] = (d & 1) ? ((va_ >> 16) | (vb_ & 0xffff0000u)) : ((va_ & 0xffffu) | (vb_ << 16)); } \
            *(LAS v4u*)(s_ + OFF_KT + (ch0 + d) * KT_RS + 16 * ((4 * HALF + tg) ^ (cq & 7))) = t_; *(LAS v4u*)(s_ + OFF_VT + (ch0 + d) * KT_RS + 16 * ((4 * HALF + tg) ^ (cq & 7))) = u_; } \
        int qx_ = qc_ ^ (8 * (tg & 1)); asm volatile("" : "+v"(qx_)); const int rb_ = (32 * HALF + 8 * tg) * QI_RS + 8 * ((cq >> 2) & 1); \
        _Pragma("unroll") for (int e = 0; e < 8; ++e) { v2u qq_, kq_; qq_.x = pk2(Qp_[0][e], Qp_[1][e]); qq_.y = pk2(Qp_[2][e], Qp_[3][e]); kq_.x = pk2(Kp_[0][e], Kp_[1][e]); kq_.y = pk2(Kp_[2][e], Kp_[3][e]); \
            const int ro_ = rb_ + e * QI_RS + 16 * (qx_ ^ e); \
            *(LAS v2u*)(s_ + OFF_QI + ro_) = qq_; *(LAS v2u*)(s_ + OFF_KI + ro_) = kq_; } \
        if (tg == 0) *(LAS f32x4*)(s_ + OFF_SCL + 512 * HALF + 4 * ch0) = tot_; } while (0)
    const int last = nchunk - 1;
    SCAN_LOAD(0, qA, fA, vA);
    SCAN_LOAD(1, qB, fB, vB);
    SCAN_IMG(0, qA, fA, vA);
    SCAN_LOAD(2, qA, fA, vA);
    __syncthreads();
    for (int g = 0; g < nchunk; g += 2) {
        SCAN_IMG(1, qB, fB, vB);
        { const int gn = g + 3 < last ? g + 3 : last; SCAN_LOAD(gn, qB, fB, vB); }
        __syncthreads();
        SCAN_IMG(0, qA, fA, vA);
        { const int gn = g + 4 < last ? g + 4 : last; SCAN_LOAD(gn, qA, fA, vA); }
        __syncthreads();
    }
#undef SCAN_LOAD
#undef SCAN_IMG
}
__device__ __forceinline__ void scan_unit(LAS unsigned char* lds, bf16* PA, bf16* OC, const int b, const int h, const int dir, const bool ctxunit) {
    int tid_ = threadIdx.x; asm volatile("" : "+v"(tid_));
    const int tid = tid_, lane = tid & 63, w = __builtin_amdgcn_readfirstlane(tid >> 6);
    const int l15 = lane & 15, q = lane >> 4;
    const int nchunk = ctxunit ? 4 : 68;
    if (w >= 4) {
        if (w & 1) scan_producer<1>(lds, PA, b, h, dir, nchunk, w - 4, lane); else scan_producer<0>(lds, PA, b, h, dir, nchunk, w - 4, lane);
    } else {
        f32x4 S[2][8];
#pragma unroll
        for (int c = 0; c < 2; ++c)
#pragma unroll
            for (int kt = 0; kt < 8; ++kt) S[c][kt] = (f32x4){0.f, 0.f, 0.f, 0.f};
        const int vc0 = 32 * w, xq = q ^ l15;
        if (!ctxunit) PSTAMP_S(lds, 20);
        __syncthreads();
        for (int g = 0; g < nchunk; ++g) {
            const bool do_o = ctxunit || g >= 4;
            const LAS unsigned char* cs = lds + (g & 1) * SET_BYTES;
            if (g == 30) PSTAMP_S(lds, 22);
#pragma unroll
            for (int kt = 0; kt < 8; ++kt) { const f32x4 gm4 = *(const LAS f32x4*)(cs + OFF_SCL + (16 * kt + 4 * q) * 4); S[0][kt] *= gm4; S[1][kt] *= gm4; }
            if (do_o) {
                bf16x8 vp[2][2];
#pragma unroll
                for (int c = 0; c < 2; ++c) { const int r_ = vc0 + 8 * (l15 >> 2) + 4 * c + (l15 & 3), x_ = (r_ >> 2) & 7;
#pragma unroll
                    for (int js = 0; js < 2; ++js) { const int c1 = 4 * js + (q >> 1);
                        const bf16x4 lo = *(const LAS bf16x4*)(cs + OFF_VT + r_ * KT_RS + 16 * (c1 ^ x_) + 8 * (q & 1)), hi4 = *(const LAS bf16x4*)(cs + OFF_VT + r_ * KT_RS + 16 * ((c1 + 2) ^ x_) + 8 * (q & 1));
                        vp[c][js] = __builtin_shufflevector(lo, hi4, 0, 1, 2, 3, 4, 5, 6, 7); } }
                bf16x8 sf[2][4];
#pragma unroll
                for (int ks = 0; ks < 4; ++ks) {
#pragma unroll
                    for (int c = 0; c < 2; ++c) { const f32x4 s0 = S[c][2 * ks], s1 = S[c][2 * ks + 1];
                        v4u pk; pk.x = pk2(s0[0], s0[1]); pk.y = pk2(s0[2], s0[3]); pk.z = pk2(s1[0], s1[1]); pk.w = pk2(s1[2], s1[3]); sf[c][ks] = __builtin_bit_cast(bf16x8, pk); }
                }
#pragma unroll
                for (int it = 0; it < 4; ++it) {
                    bf16x8 qf[4];
#pragma unroll
                    for (int ks = 0; ks < 4; ++ks) qf[ks] = ld_qk(cs + OFF_QI, 16 * it + l15, ks, xq);
                    f32x4 O0 = (f32x4){0.f, 0.f, 0.f, 0.f}, O1 = O0;
#pragma unroll
                    for (int ks = 0; ks < 4; ++ks) { O0 = MFMA16(sf[0][ks], qf[ks], O0); O1 = MFMA16(sf[1][ks], qf[ks], O1); }
                    unsigned pt[4][2];
#pragma unroll
                    for (int jt = 0; jt < 4; ++jt) {
                        if (jt <= it) {
                            f32x4 a4 = (f32x4){0.f, 0.f, 0.f, 0.f};
#pragma unroll
                            for (int ks = 0; ks < 4; ++ks) a4 = MFMA16(ld_qk(cs + OFF_KI, 16 * jt + l15, ks, xq), qf[ks], a4);
                            if (jt == it) {
#pragma unroll
                                for (int r = 0; r < 4; ++r) a4[r] = (4 * q + r <= l15) ? a4[r] : 0.f;
                            }
                            pt[jt][0] = pk2(a4[0], a4[1]); pt[jt][1] = pk2(a4[2], a4[3]);
                        } else { pt[jt][0] = 0u; pt[jt][1] = 0u; }
                    }
                    { v4u bw; bw.x = pt[0][0]; bw.y = pt[0][1]; bw.z = pt[1][0]; bw.w = pt[1][1]; const bf16x8 bb = __builtin_bit_cast(bf16x8, bw);
                      O0 = MFMA16(vp[0][0], bb, O0); O1 = MFMA16(vp[1][0], bb, O1); }
                    if (it >= 2) { v4u bw; bw.x = pt[2][0]; bw.y = pt[2][1]; bw.z = pt[3][0]; bw.w = pt[3][1]; const bf16x8 bb = __builtin_bit_cast(bf16x8, bw);
                      O0 = MFMA16(vp[0][1], bb, O0); O1 = MFMA16(vp[1][1], bb, O1); }
                    const int row = tok_row(g, 16 * it + l15, b, dir);
                    bf16* dst = (g < 4) ? OC + (size_t)dir * MCTX * 512 + (size_t)(row - MLAT) * 512 + h * HD + vc0 + 8 * q
                                        : PA + (size_t)row * PA_LD + 512 + dir * 512 + h * HD + vc0 + 8 * q;
                    v4u wv; wv.x = pk2(O0[0], O0[1]); wv.y = pk2(O0[2], O0[3]); wv.z = pk2(O1[0], O1[1]); wv.w = pk2(O1[2], O1[3]);
                    *(v4u*)dst = wv;
                }
            }
            bf16x8 vt[2][2];
#pragma unroll
            for (int c = 0; c < 2; ++c) { const int r_ = vc0 + 8 * (l15 >> 2) + 4 * c + (l15 & 3), x_ = (r_ >> 2) & 7;
                vt[c][0] = *(const LAS bf16x8*)(cs + OFF_VT + r_ * KT_RS + 16 * (q ^ x_)); vt[c][1] = *(const LAS bf16x8*)(cs + OFF_VT + r_ * KT_RS + 16 * ((4 + q) ^ x_)); }
#pragma unroll
            for (int kt = 0; kt < 8; ++kt) {
                const f32x4 gem = *(const LAS f32x4*)(cs + OFF_SCL + 512 + (16 * kt + 4 * q) * 4);
                const int xk_ = (4 * kt + (l15 >> 2)) & 7;
                const bf16x8 k0 = *(const LAS bf16x8*)(cs + OFF_KT + (16 * kt + l15) * KT_RS + 16 * (q ^ xk_)), k1 = *(const LAS bf16x8*)(cs + OFF_KT + (16 * kt + l15) * KT_RS + 16 * ((4 + q) ^ xk_));
#pragma unroll
                for (int c = 0; c < 2; ++c) { f32x4 d4 = MFMA16(k0, vt[c][0], S[c][kt]); d4 = MFMA16(k1, vt[c][1], d4); S[c][kt] = gem * d4; }
            }
            if (g == 30) PSTAMP_S(lds, 23);
            __syncthreads();
            if (g == 30) PSTAMP_S(lds, 24);
        }
        if (!ctxunit) PSTAMP_S(lds, 21);
    }
}
}


namespace hy {
typedef short bf16x8 __attribute__((ext_vector_type(8)));
typedef short bf16x4 __attribute__((ext_vector_type(4)));
constexpr int CS = 16416;
constexpr int VPAD = 7;
constexpr int OFF_F = 0, OFF_V = 4 * CS, V_ROWS = (64 + VPAD + 7) * 8, LDS_END = OFF_V + V_ROWS * 128;
static_assert(LDS_END <= LDS_BYTES - 256, "hyena LDS");
struct ConvW { float x0[4], x1[4], v[4]; };
__device__ __forceinline__ ConvW load_convw(const Args& a, int l, int c) {
    const float* cw = a.in[11] + (size_t)l * 3 * 1536; const float* cb = a.in[12] + (size_t)l * 1536; ConvW r;
#pragma unroll
    for (int j = 0; j < 3; ++j) { r.x0[j] = cw[j * 1536 + c]; r.x1[j] = cw[j * 1536 + 512 + c]; r.v[j] = cw[j * 1536 + 1024 + c]; }
    r.x0[3] = cb[c]; r.x1[3] = cb[512 + c]; r.v[3] = cb[1024 + c];
    return r;
}
__device__ __forceinline__ void hyena_channel(LAS unsigned char* lds, const Args& a, const int l, const int c) {
    int tid_ = threadIdx.x; asm volatile("" : "+v"(tid_));
    const int tid = tid_, lane = tid & 63, w = __builtin_amdgcn_readfirstlane(tid >> 6), l15 = lane & 15, q = lane >> 4;
    unsigned char* ws = a.ws;
    const bf16* PB = (const bf16*)(ws + WS_PB);
    const bf16* x0r = PB + (size_t)c * MTOK; const bf16* x1r = PB + (size_t)(512 + c) * MTOK; const bf16* vr = PB + (size_t)(1024 + c) * MTOK; const bf16* gbr = PB + (size_t)(1536 + c) * MTOK;
    const ConvW cw = load_convw(a, l, c);
    PSTAMP_H(lds, 16);
    {
        const bf16* F = (const bf16*)(ws + WS_FG) + ((size_t)l * 512 + c) * FZ;
        for (int ch = tid; ch < 1024; ch += NTHR) {
            const v4u cur = *(const v4u*)(F + 8 * ch); v4u prev = *(const v4u*)(F + (ch > 0 ? 8 * ch - 8 : 0));
            if (ch == 0) prev = (v4u){0u, 0u, 0u, 0u};
            const unsigned W[8] = {prev.x, prev.y, prev.z, prev.w, cur.x, cur.y, cur.z, cur.w};
            v4u c1, c2, c3;
#pragma unroll
            for (int d = 0; d < 4; ++d) { c1[d] = (W[3 + d] >> 16) | (W[4 + d] << 16); c2[d] = W[3 + d]; c3[d] = (W[2 + d] >> 16) | (W[3 + d] << 16); }
            *(LAS v4u*)(lds + OFF_F + 0 * CS + 16 * ch) = cur;
            *(LAS v4u*)(lds + OFF_F + 1 * CS + 16 * ch) = c1;
            *(LAS v4u*)(lds + OFF_F + 2 * CS + 16 * ch) = c2;
            *(LAS v4u*)(lds + OFF_F + 3 * CS + 16 * ch) = c3;
        }
    }
    {
        for (int e = tid; e < VPAD * 8 * 32; e += NTHR) ((LAS unsigned*)(lds + OFF_V))[e] = 0u;
        for (int e = tid; e < 7 * 8 * 32; e += NTHR) ((LAS unsigned*)(lds + OFF_V + (64 + VPAD) * 8 * 128))[e] = 0u;
        for (int bt = 0; bt < 2; ++bt) {
            v4u vw[4], xw[4]; unsigned short hv[4][2], hx[4][2];
#pragma unroll
            for (int j = 0; j < 4; ++j) {
                const int e = tid + NTHR * (4 * bt + j), b = e >> 9, t0 = (e & 511) * 8;
                const size_t base = (size_t)b * LX + t0;
                const size_t bm = t0 > 0 ? base - 1 : base, bp = t0 + 8 < LX ? base + 8 : base;
                vw[j] = *(const v4u*)(vr + base); xw[j] = *(const v4u*)(x1r + base);
                hv[j][0] = vr[bm]; hv[j][1] = vr[bp]; hx[j][0] = x1r[bm]; hx[j][1] = x1r[bp];
            }
#pragma unroll
            for (int j = 0; j < 4; ++j) {
                const int e = tid + NTHR * (4 * bt + j), b = e >> 9, t0 = (e & 511) * 8, ab = t0 >> 6, ch = (t0 & 63) >> 3;
                float vv[10], xx[10];
                vv[0] = t0 > 0 ? bf2f(hv[j][0]) : 0.f; xx[0] = t0 > 0 ? bf2f(hx[j][0]) : 0.f;
                vv[9] = t0 + 8 < LX ? bf2f(hv[j][1]) : 0.f; xx[9] = t0 + 8 < LX ? bf2f(hx[j][1]) : 0.f;
#pragma unroll
                for (int d = 0; d < 4; ++d) { vv[1 + 2 * d] = bf2f((unsigned short)(vw[j][d] & 0xffffu)); vv[2 + 2 * d] = bf2f((unsigned short)(vw[j][d] >> 16));
                                              xx[1 + 2 * d] = bf2f((unsigned short)(xw[j][d] & 0xffffu)); xx[2 + 2 * d] = bf2f((unsigned short)(xw[j][d] >> 16)); }
                float p[8];
#pragma unroll
                for (int d = 0; d < 8; ++d) p[d] = (cw.v[3] + cw.v[0] * vv[d] + cw.v[1] * vv[d + 1] + cw.v[2] * vv[d + 2]) * (cw.x1[3] + cw.x1[0] * xx[d] + cw.x1[1] * xx[d + 1] + cw.x1[2] * xx[d + 2]);
                v4u o; o.x = pk2(p[0], p[1]); o.y = pk2(p[2], p[3]); o.z = pk2(p[4], p[5]); o.w = pk2(p[6], p[7]);
                const int R = (ab + VPAD) * 8 + b;
                *(LAS v4u*)(lds + OFF_V + R * 128 + 16 * (ch ^ ((R >> 1) & 7))) = o;
            }
        }
    }
    __syncthreads();
    PSTAMP_H(lds, 17);
    f32x4 acc[4][4];
#pragma unroll
    for (int mt = 0; mt < 4; ++mt)
#pragma unroll
        for (int nt = 0; nt < 4; ++nt) acc[mt][nt] = (f32x4){0.f, 0.f, 0.f, 0.f};
    {
        const LAS unsigned char* pa = lds + OFF_F + (l15 & 3) * CS + (4096 - 4 * (l15 >> 2) + 8 * q) * 2 - 96;
        const int rowl = (l15 >> 3) * 8 + (l15 & 7);
        const int cq = (q ^ (rowl >> 1)) & 7;
        const LAS unsigned char* vb0 = lds + OFF_V + rowl * 128 + (8 * w + VPAD) * 1024 + 16 * cq;
        const LAS unsigned char* vb1 = lds + OFF_V + rowl * 128 + (8 * w + VPAD) * 1024 + 16 * (cq ^ 4);
#define HY_LDA(An_, m_) do { const LAS unsigned char* p_ = pa - 128 * (m_); _Pragma("unroll") for (int mt = 0; mt < 4; ++mt) { \
            const bf16x4 lo_ = *(const LAS bf16x4*)(p_ + 32 * (3 - mt)), hi_ = *(const LAS bf16x4*)(p_ + 32 * (3 - mt) + 8); An_[mt] = __builtin_shufflevector(lo_, hi_, 0, 1, 2, 3, 4, 5, 6, 7); } } while (0)
#define HY_LDB(B_, m_, PAR_) do { const LAS unsigned char* p0_ = ((PAR_) ? vb1 : vb0) - 1024 * (m_); const LAS unsigned char* p1_ = ((PAR_) ? vb0 : vb1) - 1024 * (m_); \
            _Pragma("unroll") for (int nt = 0; nt < 4; ++nt) { B_[0][nt] = *(const LAS bf16x8*)(p0_ + 2048 * nt); B_[1][nt] = *(const LAS bf16x8*)(p1_ + 2048 * nt); } } while (0)
#define HY_MMA(An_, Ao0_, Ao1_, B_, m_) do { _Pragma("unroll") for (int nt = 0; nt < 4; ++nt) { const int a0_ = 8 * w + 2 * nt - (m_); if (a0_ + 1 >= 0 && a0_ <= 63) { \
            _Pragma("unroll") for (int mt = 0; mt < 4; ++mt) acc[mt][nt] = __builtin_amdgcn_mfma_f32_16x16x32_bf16(An_[mt], B_[0][nt], acc[mt][nt], 0, 0, 0); \
            acc[0][nt] = __builtin_amdgcn_mfma_f32_16x16x32_bf16(Ao0_, B_[1][nt], acc[0][nt], 0, 0, 0); acc[1][nt] = __builtin_amdgcn_mfma_f32_16x16x32_bf16(Ao1_, B_[1][nt], acc[1][nt], 0, 0, 0); \
            acc[2][nt] = __builtin_amdgcn_mfma_f32_16x16x32_bf16(An_[0], B_[1][nt], acc[2][nt], 0, 0, 0); acc[3][nt] = __builtin_amdgcn_mfma_f32_16x16x32_bf16(An_[1], B_[1][nt], acc[3][nt], 0, 0, 0); } } } while (0)
        bf16x8 Aa[4], Ab[4], Ba[2][4], Bb[2][4], o0, o1;
        const int m0 = 8 * w - 63, mlast = 8 * w + 7;
        { bf16x8 t_[4]; HY_LDA(t_, m0 - 1); o0 = t_[2]; o1 = t_[3]; }
        HY_LDA(Aa, m0); HY_LDB(Ba, m0, 0);
        for (int m = m0; m < mlast; m += 2) {
            HY_LDA(Ab, m + 1); HY_LDB(Bb, m + 1, 1);
            HY_MMA(Aa, o0, o1, Ba, m);
            o0 = Aa[2]; o1 = Aa[3];
            HY_LDA(Aa, m + 2); HY_LDB(Ba, m + 2, 0);
            HY_MMA(Ab, o0, o1, Bb, m + 1);
            o0 = Ab[2]; o1 = Ab[3];
        }
        HY_MMA(Aa, o0, o1, Ba, mlast);
#undef HY_LDA
#undef HY_LDB
#undef HY_MMA
    }
    PSTAMP_H(lds, 18);
    __syncthreads();
    {
        constexpr int YRS = 8208;
        const float inn = 1.0f / ((const float*)(ws + WS_CTL))[CW_NORM + l * 512 + c], hb = a.in[21][l * 512 + c];
        const int b = l15 & 7;
#pragma unroll
        for (int nt = 0; nt < 4; ++nt) {
            const int ab = 8 * w + 2 * nt + (l15 >> 3), R = (ab + VPAD) * 8 + b;
#pragma unroll
            for (int mt = 0; mt < 4; ++mt) {
                const int t = 64 * ab + 16 * mt + 4 * q;
                const v2u vw = *(const LAS v2u*)(lds + OFF_V + R * 128 + 16 * ((2 * mt + (q >> 1)) ^ ((R >> 1) & 7)) + 8 * (q & 1));
                const float y0 = acc[mt][nt][0] * inn + bf2f((unsigned short)(vw.x & 0xffffu)) * hb, y1 = acc[mt][nt][1] * inn + bf2f((unsigned short)(vw.x >> 16)) * hb;
                const float y2 = acc[mt][nt][2] * inn + bf2f((unsigned short)(vw.y & 0xffffu)) * hb, y3 = acc[mt][nt][3] * inn + bf2f((unsigned short)(vw.y >> 16)) * hb;
                v2u yw; yw.x = pk2(y0, y1); yw.y = pk2(y2, y3);
                *(LAS v2u*)(lds + OFF_F + b * YRS + 2 * t) = yw;
            }
        }
        __syncthreads();
        bf16* OBT = (bf16*)(ws + WS_OBT) + (size_t)c * MTOK;
        int tid2 = tid; asm volatile("" : "+v"(tid2));
        for (int bt = 0; bt < 4; ++bt) {
            v4u xw[2], gw[2]; unsigned short hx[2][2];
#pragma unroll
            for (int j = 0; j < 2; ++j) {
                const int e = tid2 + NTHR * (2 * bt + j), bb = e >> 9, t0 = (e & 511) * 8;
                const size_t base = (size_t)bb * LX + t0;
                xw[j] = *(const v4u*)(x0r + base); gw[j] = *(const v4u*)(gbr + base);
                hx[j][0] = x0r[t0 > 0 ? base - 1 : base]; hx[j][1] = x0r[t0 + 8 < LX ? base + 8 : base];
            }
#pragma unroll
            for (int j = 0; j < 2; ++j) {
                const int e = tid2 + NTHR * (2 * bt + j), bb = e >> 9, t0 = (e & 511) * 8;
                const size_t base = (size_t)bb * LX + t0;
                const v4u yw = *(const LAS v4u*)(lds + OFF_F + bb * YRS + 2 * t0);
                float xs[10], o[8];
                xs[0] = t0 > 0 ? bf2f(hx[j][0]) : 0.f; xs[9] = t0 + 8 < LX ? bf2f(hx[j][1]) : 0.f;
#pragma unroll
                for (int d = 0; d < 4; ++d) { xs[1 + 2 * d] = bf2f((unsigned short)(xw[j][d] & 0xffffu)); xs[2 + 2 * d] = bf2f((unsigned short)(xw[j][d] >> 16)); }
#pragma unroll
                for (int d = 0; d < 8; ++d) {
                    const float yv = bf2f((unsigned short)((d & 1) ? (yw[d >> 1] >> 16) : (yw[d >> 1] & 0xffffu)));
                    const float gv = bf2f((unsigned short)((d & 1) ? (gw[j][d >> 1] >> 16) : (gw[j][d >> 1] & 0xffffu)));
                    o[d] = yv * (cw.x0[3] + cw.x0[0] * xs[d] + cw.x0[1] * xs[d + 1] + cw.x0[2] * xs[d + 2]) * silu_f(gv);
                }
                v4u ow; ow.x = pk2(o[0], o[1]); ow.y = pk2(o[2], o[3]); ow.z = pk2(o[4], o[5]); ow.w = pk2(o[6], o[7]);
                *(v4u*)(OBT + base) = ow;
            }
        }
    }
    PSTAMP_H(lds, 19);
    __syncthreads();
}
__device__ __forceinline__ void hyena_ctx_channel(LAS unsigned char* lds, const Args& a, const int c) {
    int tid_ = threadIdx.x; asm volatile("" : "+v"(tid_));
    const int tid = tid_;
    unsigned char* ws = a.ws;
    const bf16* PB = (const bf16*)(ws + WS_PB);
    const bf16* x0r = PB + (size_t)c * MTOK + MLAT; const bf16* x1r = PB + (size_t)(512 + c) * MTOK + MLAT; const bf16* vr = PB + (size_t)(1024 + c) * MTOK + MLAT; const bf16* gbr = PB + (size_t)(1536 + c) * MTOK + MLAT;
    const ConvW cw = load_convw(a, 0, c);
    LAS float* vvc = (LAS float*)lds;
    LAS float* Fc = vvc + 2048;
    for (int e = tid; e < 2048; e += NTHR) {
        const int t = e & 255;
        const float vm_ = bf2f(vr[t > 0 ? e - 1 : e]), v0 = bf2f(vr[e]), vp_ = bf2f(vr[t < 255 ? e + 1 : e]);
        const float xm_ = bf2f(x1r[t > 0 ? e - 1 : e]), x0 = bf2f(x1r[e]), xp_ = bf2f(x1r[t < 255 ? e + 1 : e]);
        const float vm = t > 0 ? vm_ : 0.f, vp = t < 255 ? vp_ : 0.f, xm = t > 0 ? xm_ : 0.f, xp = t < 255 ? xp_ : 0.f;
        vvc[e] = (cw.v[3] + cw.v[0] * vm + cw.v[1] * v0 + cw.v[2] * vp) * (cw.x1[3] + cw.x1[0] * xm + cw.x1[1] * x0 + cw.x1[2] * xp);
    }
    if (tid < 520) Fc[tid] = tid < 512 ? bf2f(((const bf16*)(ws + WS_FGC))[(size_t)c * FZC + tid]) : 0.f;
    __syncthreads();
    const float inn = 1.0f / ((const float*)(ws + WS_CTL))[CW_NORM + 2 * 512 + c], hb = a.in[21][c];
    bf16* OBT = (bf16*)(ws + WS_OBT) + (size_t)c * MTOK + MLAT;
    {
        const int b = tid >> 6, t0 = 4 * (tid & 63), e0 = b * 256 + t0;
        float acc4[4] = {0.f, 0.f, 0.f, 0.f};
        const LAS float* fp = Fc + 252 - t0;
        for (int s4 = 0; s4 < 64; ++s4) {
            const f32x4 ga = *(const LAS f32x4*)(fp + 4 * s4), gb = *(const LAS f32x4*)(fp + 4 * s4 + 4), vq = *(const LAS f32x4*)(vvc + b * 256 + 4 * s4);
            const float g[8] = {ga[0], ga[1], ga[2], ga[3], gb[0], gb[1], gb[2], gb[3]};
#pragma unroll
            for (int i = 0; i < 4; ++i)
#pragma unroll
                for (int u = 0; u < 4; ++u) acc4[i] += g[4 - i + u] * vq[u];
        }
        float xs[6], gv[4];
        xs[0] = t0 > 0 ? bf2f(x0r[e0 - 1]) : 0.f;
#pragma unroll
        for (int i = 0; i < 4; ++i) { xs[1 + i] = bf2f(x0r[e0 + i]); gv[i] = bf2f(gbr[e0 + i]); }
        xs[5] = t0 + 4 < 256 ? bf2f(x0r[e0 + 4]) : 0.f;
        float o[4];
#pragma unroll
        for (int i = 0; i < 4; ++i) o[i] = (acc4[i] * inn + vvc[e0 + i] * hb) * (cw.x0[3] + cw.x0[0] * xs[i] + cw.x0[1] * xs[i + 1] + cw.x0[2] * xs[i + 2]) * silu_f(gv[i]);
        v2u ow; ow.x = pk2(o[0], o[1]); ow.y = pk2(o[2], o[3]);
        *(v2u*)(OBT + e0) = ow;
    }
    __syncthreads();
}
}


__device__ __forceinline__ void phase_mix(const Args& a, Frame& F, const int l, const int part = -1) {
    unsigned* qctr = (unsigned*)(a.ws + WS_CTL) + CW_QUEUE + 64 * l + (part == 1 ? 128 : 0);
    volatile LAS int* slot = (volatile LAS int*)(F.lds + LDS_BYTES - 64);
    const int ntasks = l == 0 ? 64 + 512 + 64 + 512 : 64 + 512;
    for (;;) {
        if (F.tid == 0) slot[0] = (int)atomicAdd(qctr, 1u);
        __syncthreads();
        const int t = __builtin_amdgcn_readfirstlane(slot[0]);
        __syncthreads();
        if (t >= ntasks) break;
        if (part == 0 && !(t < 64 || (t >= 576 && t < 640))) continue;
        if (part == 1 && (t < 64 || (t >= 576 && t < 640))) continue;
        if (t < 64) scan::scan_unit(F.lds, (bf16*)(a.ws + WS_PA), (bf16*)(a.ws + WS_OC), t >> 3, (t >> 1) & 3, t & 1, false);
        else if (t < 576) hy::hyena_channel(F.lds, a, l, t - 64);
        else if (t < 640) { const int u = t - 576; scan::scan_unit(F.lds, (bf16*)(a.ws + WS_PA), (bf16*)(a.ws + WS_OC), u >> 3, (u >> 1) & 3, u & 1, true); }
        else hy::hyena_ctx_channel(F.lds, a, t - 640);
        __syncthreads();
    }
}

__device__ __forceinline__ void phase_finalize_ox(const Args& a, Frame& F, int l) {
    unsigned char* ws = a.ws;
    const bf16* PA = (const bf16*)(ws + WS_PA);
    const bf16* OC = (const bf16*)(ws + WS_OC);
    bf16* XA = (bf16*)(ws + WS_XA);
    const float* gnw = a.in[10] + l * 512;
    const int gw = F.vcu * NWAVES + F.wave, NGW = F.G * NWAVES;
    const int ntok = (l == 0) ? MTOK : MLAT;
    for (int tok = gw; tok < ntok; tok += NGW) {
        const bool isctx = tok >= MLAT;
        const int c8 = 8 * F.lane;
        const bf16* pf = isctx ? OC + (size_t)(tok - MLAT) * 512 + c8 : PA + (size_t)tok * PA_LD + 512 + c8;
        const bf16* pb = isctx ? OC + (size_t)MCTX * 512 + (size_t)(tok - MLAT) * 512 + c8 : PA + (size_t)tok * PA_LD + 1024 + c8;
        const v4u wf = *(const v4u*)pf, wb = *(const v4u*)pb, wg = *(const v4u*)(PA + (size_t)tok * PA_LD + 2048 + c8);
        float o[8], g[8];
#pragma unroll
        for (int e = 0; e < 4; ++e) {
            o[2 * e] = bf2f((unsigned short)(wf[e] & 0xffff)) + bf2f((unsigned short)(wb[e] & 0xffff));
            o[2 * e + 1] = bf2f((unsigned short)(wf[e] >> 16)) + bf2f((unsigned short)(wb[e] >> 16));
            g[2 * e] = bf2f((unsigned short)(wg[e] & 0xffff)); g[2 * e + 1] = bf2f((unsigned short)(wg[e] >> 16));
        }
        float s = 0.f;
#pragma unroll
        for (int e = 0; e < 8; ++e) s += o[e] * o[e];
        s += __shfl_xor(s, 1); s += __shfl_xor(s, 2); s += __shfl_xor(s, 4); s += __shfl_xor(s, 8);
        const float rstd = 1.0f / sqrtf(s * (1.0f / HD) + EPS);
        float y[8];
#pragma unroll
        for (int e = 0; e < 8; ++e) y[e] = o[e] * rstd * gnw[c8 + e] * silu_f(g[e]);
        v4u w; w.x = pk2(y[0], y[1]); w.y = pk2(y[2], y[3]); w.z = pk2(y[4], y[5]); w.w = pk2(y[6], y[7]);
        *(v4u*)(XA + (size_t)tok * D + c8) = w;
    }
    LAS unsigned short* t = (LAS unsigned short*)(F.lds + F.wave * 16384);
    const int ntt = ntok / 64;
    for (int it = gw; it < 8 * ntt; it += NGW) {
        const int ct = it / ntt, tt = it % ntt, c0 = ct * 64, t0 = tt * 64;
        const bf16* OBT = (const bf16*)(ws + WS_OBT);
#pragma unroll
        for (int i = 0; i < 8; ++i) {
            const int e = F.lane + 64 * i, c = e >> 3, ch = e & 7;
            const v4u w = *(const v4u*)(OBT + (size_t)(c0 + c) * MTOK + t0 + 8 * ch);
#pragma unroll
            for (int q = 0; q < 4; ++q) { t[c * 66 + 8 * ch + 2 * q] = (unsigned short)(w[q] & 0xffff); t[c * 66 + 8 * ch + 2 * q + 1] = (unsigned short)(w[q] >> 16); }
        }
        asm volatile("s_waitcnt lgkmcnt(0)" ::: "memory");
#pragma unroll
        for (int i = 0; i < 8; ++i) {
            const int e = F.lane + 64 * i, tk = e >> 3, cg = e & 7;
            unsigned short h[8];
#pragma unroll
            for (int q = 0; q < 8; ++q) h[q] = t[(8 * cg + q) * 66 + tk];
            v4u w; w.x = h[0] | ((unsigned)h[1] << 16); w.y = h[2] | ((unsigned)h[3] << 16); w.z = h[4] | ((unsigned)h[5] << 16); w.w = h[6] | ((unsigned)h[7] << 16);
            *(v4u*)(XA + (size_t)(t0 + tk) * D + 512 + c0 + 8 * cg) = w;
        }
        asm volatile("s_waitcnt lgkmcnt(0)" ::: "memory");
    }
}

__device__ __forceinline__ void phase_final_norm(const Args& a, Frame& F) {
    const float* w = a.in[22];
    const bf16* DL = (const bf16*)(a.ws + WS_PB);
    const int gw = F.vcu * NWAVES + F.wave, NGW = F.G * NWAVES;
    for (int tok = gw; tok < MLAT; tok += NGW) {
        float* xr = a.out + (size_t)tok * D;
        f32x4 v[4]; float s = 0.f;
#pragma unroll
        for (int j = 0; j < 4; ++j) { v[j] = *(const f32x4*)(xr + 256 * j + 4 * F.lane); const v2u dw = *(const v2u*)(DL + (size_t)tok * D + 256 * j + 4 * F.lane);
            v[j].x += bf2f((unsigned short)(dw.x & 0xffffu)); v[j].y += bf2f((unsigned short)(dw.x >> 16)); v[j].z += bf2f((unsigned short)(dw.y & 0xffffu)); v[j].w += bf2f((unsigned short)(dw.y >> 16));
            s += (v[j].x * v[j].x + v[j].y * v[j].y) + (v[j].z * v[j].z + v[j].w * v[j].w); }
        const float rstd = 1.0f / sqrtf(wave_sum(s) * (1.0f / D) + EPS);
#pragma unroll
        for (int j = 0; j < 4; ++j) { const f32x4 w4 = *(const f32x4*)(w + 256 * j + 4 * F.lane); *(f32x4*)(xr + 256 * j + 4 * F.lane) = v[j] * rstd * w4; }
    }
}

enum { PH_PRO = 0, PH_NORM0 = 1, PH_IN0 = 2, PH_MIX0 = 3, PH_FIN0 = 4, PH_OUT0 = 5, PH_NORM1 = 6, PH_IN1 = 7, PH_MIX1 = 8, PH_FIN1 = 9, PH_OUT1 = 10, PH_FINAL = 11 };

__device__ __forceinline__ Frame mkframe(unsigned char* lds) {
    Frame F;
    F.lds = (LAS unsigned char*)lds;
    F.tid = threadIdx.x; F.lane = F.tid & 63; F.wave = __builtin_amdgcn_readfirstlane(F.tid >> 6);
    F.G = gridDim.x; { const int bx = blockIdx.x; F.vcu = (F.G % 8 == 0) ? (bx % 8) * (F.G / 8) + bx / 8 : bx; }
    return F;
}
template <int l> __device__ __forceinline__ void run_inproj(const Args& args, unsigned char* lds) {
    unsigned char* ws = args.ws; Frame F = mkframe(lds);
    pg8::Gemm g{(const bf16*)(ws + WS_XA), (const bf16*)(ws + WS_WIN) + (size_t)l * NIN * D, D};
    pg8::Sched S; S.init(128, 18, F.G, (int)blockIdx.x, 8, l == 0 ? 18 : 8);
    EpiIn E{(bf16*)(ws + WS_PA), (bf16*)(ws + WS_PB), (const float*)(ws + WS_LBS) + l * 1024};
    pg8::gemm_phase<EpiIn, true, true>(F.lds, g, S, E);
}
template <int l> __device__ __forceinline__ void run_outproj(const Args& args, unsigned char* lds) {
    unsigned char* ws = args.ws; Frame F = mkframe(lds);
    pg8::Gemm g{(const bf16*)(ws + WS_XA), (const bf16*)(ws + WS_WOUT) + (size_t)l * D * D, D};
    pg8::Sched S; S.init(128, 4, F.G, (int)blockIdx.x, l == 0 ? 8 : 0, 4);
    EpiOut E{(bf16*)(ws + WS_PB), (const float*)(ws + WS_MOD) + (size_t)l * 9 * 3 * D};
    pg8::gemm_phase<EpiOut, true, true>(F.lds, g, S, E);
}
__global__ void __launch_bounds__(NTHR, 2) mega(Args args) {
    extern __shared__ __attribute__((aligned(16))) unsigned char lds[];
    const int lo = args.ph_lo, hi = args.ph_hi;
#define IN(k) (lo <= (k) && (k) < hi)
    volatile LAS unsigned* bst = (volatile LAS unsigned*)((LAS unsigned char*)lds + LDS_BYTES - 32);
    if (threadIdx.x < 8) ((volatile LAS unsigned*)((LAS unsigned char*)lds + LDS_BYTES - 32))[threadIdx.x] = 0u;
    __syncthreads();
    XcdBarrier bar; bar.bar = (unsigned*)(args.ws + WS_CTL) + CW_BAR; bar.x = 0; bar.st = bst;
    if (hi - lo > 1) bar = xcd_barrier_post((unsigned*)(args.ws + WS_CTL) + CW_BAR, bst);
#ifdef PROBE_ID
    volatile LAS unsigned long long* pts = (volatile LAS unsigned long long*)((LAS unsigned char*)lds + LDS_BYTES - 512);
    if (threadIdx.x == 0) pts[0] = __builtin_amdgcn_s_memrealtime();
#define SEAM(k) do { if (IN((k) + 1)) xcd_barrier(bar); else __syncthreads(); if (threadIdx.x == 0) pts[(k) + 1] = __builtin_amdgcn_s_memrealtime(); } while (0)
#else
#define SEAM(k) do { if (IN((k) + 1)) xcd_barrier(bar); else __syncthreads(); } while (0)
#endif
    if (IN(PH_PRO)) { Frame F = mkframe(lds); phase_prologue(args, F); SEAM(PH_PRO); }
    if (IN(PH_NORM0)) { Frame F = mkframe(lds); phase_normrows(args, F, 0, args.in[0], args.in[2]); SEAM(PH_NORM0); }
    if (IN(PH_IN0)) { run_inproj<0>(args, lds); { Frame F = mkframe(lds); phase_filters_l0(args, F); } SEAM(PH_IN0); }
#ifdef SPLIT_MIX
    if (IN(PH_MIX0)) { Frame F = mkframe(lds); phase_mix(args, F, 0, 0); xcd_barrier(bar); if (threadIdx.x == 0) pts[15] = __builtin_amdgcn_s_memrealtime(); phase_mix(args, F, 0, 1); SEAM(PH_MIX0); }
#else
    if (IN(PH_MIX0)) { Frame F = mkframe(lds); phase_mix(args, F, 0); SEAM(PH_MIX0); }
#endif
    if (IN(PH_FIN0)) { Frame F = mkframe(lds); phase_finalize_ox(args, F, 0); SEAM(PH_FIN0); }
    if (IN(PH_OUT0)) { run_outproj<0>(args, lds); { Frame F = mkframe(lds); phase_filters_l1(args, F); } SEAM(PH_OUT0); }
    if (IN(PH_NORM1)) { Frame F = mkframe(lds); phase_normrows(args, F, 1, args.in[0], args.in[2]); SEAM(PH_NORM1); }
    if (IN(PH_IN1)) { run_inproj<1>(args, lds); SEAM(PH_IN1); }
    if (IN(PH_MIX1)) { Frame F = mkframe(lds); phase_mix(args, F, 1); SEAM(PH_MIX1); }
    if (IN(PH_FIN1)) { Frame F = mkframe(lds); phase_finalize_ox(args, F, 1); SEAM(PH_FIN1); }
    if (IN(PH_OUT1)) { run_outproj<1>(args, lds); SEAM(PH_OUT1); }
    if (IN(PH_FINAL)) { Frame F = mkframe(lds); phase_final_norm(args, F); SEAM(PH_FINAL); }
#ifdef PROBE_ID
    if (blockIdx.x == 0 && threadIdx.x == 0) {
#ifdef SPLIT_MIX
        const unsigned long long dt = (PROBE_ID == 100) ? pts[15] - pts[PH_MIX0] : pts[PH_MIX0 + 1] - pts[15];
#else
        const unsigned long long dt = (PROBE_ID >= 200) ? ((PROBE_ID == 220 || PROBE_ID >= 226) ? 1ull : 16ull) * (pts[PROBE_ID - 200 + 1] - pts[PROBE_ID - 200]) : pts[PROBE_ID + 1] - pts[PROBE_ID];
#endif
        const unsigned long long t0 = __builtin_amdgcn_s_memrealtime();
        unsigned long long wt = 4ull * dt; if (wt > 300000ull) wt = 300000ull;
        while (__builtin_amdgcn_s_memrealtime() - t0 < wt) __builtin_amdgcn_s_sleep(8);
    }
#endif
#undef IN
#undef SEAM
}

extern "C" void kernel_launch(void* const* d_in, const int* in_sizes, int n_in, void* d_out, int out_size, void* d_ws, size_t ws_size, hipStream_t stream) {
    static int grid = 0;
    if (grid == 0) {
        if (n_in != 23 || ws_size < WS_END) { fprintf(stderr, "kernel_launch: unexpected n_in %d / ws_size %zu\n", n_in, ws_size); grid = -1; return; }
        int dev = 0, cus = 0;
        if (hipGetDevice(&dev) != hipSuccess || hipDeviceGetAttribute(&cus, hipDeviceAttributeMultiprocessorCount, dev) != hipSuccess) { grid = -1; return; }
        if (hipFuncSetAttribute((const void*)mega, hipFuncAttributeMaxDynamicSharedMemorySize, LDS_BYTES) != hipSuccess) { fprintf(stderr, "kernel_launch: hipFuncSetAttribute failed\n"); grid = -1; return; }
        grid = cus;
    }
    if (grid < 0) return;
    (void)hipMemsetAsync((char*)d_ws + WS_CTL, 0, CTL_ZERO_BYTES, stream);
    Args a{};
    for (int i = 0; i < 23; ++i) a.in[i] = (const float*)d_in[i];
    a.out = (float*)d_out; a.ws = (unsigned char*)d_ws;
    a.ph_lo = 0; a.ph_hi = PH_FINAL + 1;
    hipLaunchKernelGGL(mega, dim3(grid), dim3(NTHR), LDS_BYTES, stream, a);
}
```

```cpp
#include <hip/hip_runtime.h>
#include <cstdio>
#include <cstdint>
#include <math.h>

namespace pg8 {
#define PG8_LAS __attribute__((address_space(3)))
typedef unsigned short bf16_t;
typedef short bf16x8 __attribute__((ext_vector_type(8)));
typedef float f32x4 __attribute__((ext_vector_type(4)));
typedef unsigned u32x4 __attribute__((ext_vector_type(4)));
typedef unsigned u32x2 __attribute__((ext_vector_type(2)));
constexpr int BM = 256, BK = 64, HALF = 128, HTB = HALF * BK * 2, STAGE_BYTES = 8 * HTB, NXCD = 8, WGM = 8;

__host__ __device__ __forceinline__ int lds_byte(int r, int c) { const int st = (r >> 4) * 2 + (c >> 5), rr = r & 15, cc = c & 31, ob = rr * 64 + cc * 2; return st * 1024 + (ob ^ (((ob >> 9) & 1) << 5)); }
__host__ __device__ __forceinline__ void stage_rc(int b, int& R, int& C) { const int st = b / 1024, sb = b % 1024, swz = sb ^ (((sb >> 9) & 1) << 5); R = (st >> 1) * 16 + swz / 64; C = (st & 1) * 32 + (swz % 64) / 2; }
__host__ __device__ __forceinline__ int perm32(int rho) { const int n = rho >> 4, i = rho & 15; return 8 * (i >> 2) + 4 * n + (i & 3); }

struct Unit { int pm, pn; };
struct Gemm { const bf16_t* A; const bf16_t* Bt; int K; };

struct Sched {
    int nM, nN, nwg, G, c, nctx, nctxN;
    __device__ void init(int nM_, int nN_, int G_, int c_, int nctxM, int nctxN_) { nM = nM_; nN = nN_; nwg = nM * nN; G = G_; c = c_; nctx = nctxM * nctxN_; nctxN = nctxN_ > 0 ? nctxN_ : 1; }
    __device__ bool next(int i, Unit& u) const {
        const long L = (long)i * G + c;
        if (L >= nwg) { const long L2 = L - nwg; if (L2 >= nctx) return false; u.pm = nM + (int)(L2 / nctxN); u.pn = (int)(L2 % nctxN); return true; }
        int wgid = (int)L; { const int q = nwg / NXCD, r = nwg % NXCD, xcd = wgid % NXCD, off = wgid / NXCD; wgid = (xcd < r ? xcd * (q + 1) : r * (q + 1) + (xcd - r) * q) + off; }
        const int nig = WGM * nN, gid = wgid / nig, fm = gid * WGM, gsz = (nM - fm) < WGM ? (nM - fm) : WGM;
        u.pm = fm + ((wgid % nig) % gsz); u.pn = (wgid % nig) / gsz; return true;
    }
};

template <class Epi, bool ALIGN_EPI, bool SP2>
__device__ __forceinline__ void gemm_phase(PG8_LAS unsigned char* lds, const Gemm g, const Sched& S, const Epi& E) {
    const int tid = threadIdx.x, wid = __builtin_amdgcn_readfirstlane(tid >> 6), lane = tid & 63, wr = wid >> 2, wc = wid & 3, fr = lane & 15, fq = lane >> 4;
    const int K = g.K, nt = K / BK;
    unsigned voffA[2], voffB[2];
#pragma unroll
    for (int i = 0; i < 2; ++i) { int R, C; stage_rc(tid * 16 + i * 8192, R, C); const int Rb = Epi::PERM ? ((R & ~31) + perm32(R & 31)) : R;
        voffA[i] = (unsigned)(R * K + C) * 2u; voffB[i] = (unsigned)(Rb * K + C) * 2u; }
    const size_t kstep = (size_t)(BK * 2);
    const size_t hstep = (size_t)HALF * K * 2;
    const size_t tstep = 2 * hstep;
    const unsigned ldsw = (unsigned)wid * 1024u;
    const int aoff = lds_byte(wr * 64 + fr, fq * 8), boff = lds_byte(wc * 32 + fr, fq * 8);
#define PG8_SA(b, h) (((b) * 2 + (h)) * HTB)
#define PG8_SB(b, h) ((4 + (b) * 2 + (h)) * HTB)
#define PG8_STAGE(bufoff, gbase, voff) do { _Pragma("unroll") for (int _i = 0; _i < 2; ++_i) \
        __builtin_amdgcn_global_load_lds((const unsigned*)((const char*)(gbase) + (voff)[_i]), (PG8_LAS unsigned*)(lds + (bufoff) + ldsw + _i * 8192), 16, 0, 0); } while (0)
#define PG8_LDA(dst, b, h) do { _Pragma("unroll") for (int m = 0; m < 4; ++m) _Pragma("unroll") for (int k = 0; k < 2; ++k) dst[m][k] = *(const PG8_LAS bf16x8*)(lds + PG8_SA(b, h) + aoff + m * 2048 + k * 1024); } while (0)
#define PG8_LDB(dst, b, h) do { _Pragma("unroll") for (int n = 0; n < 2; ++n) _Pragma("unroll") for (int k = 0; k < 2; ++k) dst[n][k] = *(const PG8_LAS bf16x8*)(lds + PG8_SB(b, h) + boff + n * 2048 + k * 1024); } while (0)
#define PG8_MMA(ai, bj, At, Bt) do { __builtin_amdgcn_s_setprio(1); _Pragma("unroll") for (int m = 0; m < 4; ++m) _Pragma("unroll") for (int n = 0; n < 2; ++n) _Pragma("unroll") for (int k = 0; k < 2; ++k) \
        acc[ai][bj][m][n] = __builtin_amdgcn_mfma_f32_16x16x32_bf16(Bt[n][k], At[m][k], acc[ai][bj][m][n], 0, 0, 0); __builtin_amdgcn_s_setprio(0); } while (0)
#define PG8_WAIT_V(n) asm volatile("s_waitcnt vmcnt(" #n ")" ::: "memory")
#define PG8_WAIT_L(n) asm volatile("s_waitcnt lgkmcnt(" #n ")" ::: "memory")
#define PG8_BAR __builtin_amdgcn_s_barrier()
#define PG8_SCHED __builtin_amdgcn_sched_barrier(0)
    Unit cur, nxt; int ui = 0;
    if (!S.next(0, cur)) return;
    f32x4 acc[2][2][4][2];
#pragma unroll
    for (int a = 0; a < 2; ++a)
#pragma unroll
        for (int b = 0; b < 2; ++b)
#pragma unroll
            for (int m = 0; m < 4; ++m)
#pragma unroll
                for (int n = 0; n < 2; ++n) acc[a][b][m][n] = (f32x4){0.f, 0.f, 0.f, 0.f};
    bf16x8 At[4][2], B0[2][2], B1[2][2];
    const char* cA = E.swap(cur) ? (const char*)g.Bt + (size_t)cur.pn * tstep : (const char*)g.A + (size_t)cur.pm * tstep;
    const char* cB = E.swap(cur) ? (const char*)g.A + (size_t)cur.pm * tstep : (const char*)g.Bt + (size_t)cur.pn * tstep;
    if constexpr (SP2) {
        PG8_STAGE(PG8_SB(0, 0), cB, voffB); PG8_STAGE(PG8_SB(0, 1), cB + hstep, voffB); PG8_STAGE(PG8_SA(0, 0), cA, voffA); PG8_STAGE(PG8_SA(0, 1), cA + hstep, voffA);
        if (wr == 1) PG8_BAR;
        PG8_WAIT_V(2); PG8_BAR;
        PG8_STAGE(PG8_SB(1, 0), cB + kstep, voffB); PG8_STAGE(PG8_SA(1, 0), cA + kstep, voffA); PG8_STAGE(PG8_SB(1, 1), cB + hstep + kstep, voffB);
        PG8_WAIT_V(6); PG8_BAR;
    } else {
        PG8_STAGE(PG8_SB(0, 0), cB, voffB); PG8_STAGE(PG8_SA(0, 0), cA, voffA); PG8_STAGE(PG8_SB(0, 1), cB + hstep, voffB); PG8_STAGE(PG8_SA(0, 1), cA + hstep, voffA);
        if (wr == 1) PG8_BAR;
        PG8_WAIT_V(4); PG8_BAR;
        PG8_STAGE(PG8_SB(1, 0), cB + kstep, voffB); PG8_STAGE(PG8_SA(1, 0), cA + kstep, voffA); PG8_STAGE(PG8_SB(1, 1), cB + hstep + kstep, voffB);
        PG8_WAIT_V(6); PG8_BAR;
    }
    for (;;) {
        const bool has_next = S.next(ui + 1, nxt);
        const bool nsw = has_next && E.swap(nxt);
        const char* nA = has_next ? (nsw ? (const char*)g.Bt + (size_t)nxt.pn * tstep : (const char*)g.A + (size_t)nxt.pm * tstep) : cA;
        const char* nB = has_next ? (nsw ? (const char*)g.A + (size_t)nxt.pm * tstep : (const char*)g.Bt + (size_t)nxt.pn * tstep) : cB;
        for (int t = 0; t < nt; t += 2) {
            const bool last = (t == nt - 2);
            const char* a1 = cA + (size_t)(t + 1) * kstep;
            const char* a2 = last ? nA : cA + (size_t)(t + 2) * kstep; const char* b2 = last ? nB : cB + (size_t)(t + 2) * kstep;
            const char* a3 = a2 + kstep; const char* b3 = b2 + kstep;
            if constexpr (SP2) {
            PG8_LDB(B0, 0, 0); PG8_LDB(B1, 0, 1); PG8_SCHED; PG8_LDA(At, 0, 0); PG8_STAGE(PG8_SA(1, 1), a1 + hstep, voffA);
            PG8_WAIT_V(8); PG8_WAIT_L(0); PG8_BAR; PG8_MMA(0, 0, At, B0); PG8_MMA(0, 1, At, B1); PG8_BAR; PG8_SCHED;
            PG8_LDA(At, 0, 1); PG8_STAGE(PG8_SB(0, 0), b2, voffB); PG8_STAGE(PG8_SB(0, 1), b2 + hstep, voffB); PG8_STAGE(PG8_SA(0, 0), a2, voffA);
            PG8_WAIT_V(8); PG8_WAIT_L(0); PG8_BAR; PG8_MMA(1, 0, At, B0); PG8_MMA(1, 1, At, B1); PG8_BAR; PG8_SCHED;
            PG8_LDB(B0, 1, 0); PG8_LDB(B1, 1, 1); PG8_SCHED; PG8_LDA(At, 1, 0); PG8_STAGE(PG8_SA(0, 1), a2 + hstep, voffA);
            PG8_WAIT_V(8); PG8_WAIT_L(0); PG8_BAR; PG8_MMA(0, 0, At, B0); PG8_MMA(0, 1, At, B1); PG8_BAR; PG8_SCHED;
            PG8_LDA(At, 1, 1); PG8_STAGE(PG8_SB(1, 0), b3, voffB); PG8_STAGE(PG8_SB(1, 1), b3 + hstep, voffB); PG8_STAGE(PG8_SA(1, 0), a3, voffA);
            PG8_WAIT_V(8); PG8_WAIT_L(0); PG8_BAR; PG8_MMA(1, 0, At, B0); PG8_MMA(1, 1, At, B1); PG8_BAR; PG8_SCHED;
            } else {
            PG8_LDB(B0, 0, 0); PG8_SCHED; PG8_LDA(At, 0, 0); PG8_STAGE(PG8_SA(1, 1), a1 + hstep, voffA);
            PG8_WAIT_L(8); PG8_BAR; PG8_WAIT_L(0); PG8_MMA(0, 0, At, B0); PG8_BAR; PG8_SCHED;
            PG8_LDB(B1, 0, 1); PG8_STAGE(PG8_SB(0, 0), b2, voffB);
            PG8_BAR; PG8_WAIT_L(0); PG8_MMA(0, 1, At, B1); PG8_BAR;
            PG8_LDA(At, 0, 1); PG8_STAGE(PG8_SA(0, 0), a2, voffA);
            PG8_BAR; PG8_WAIT_L(0); PG8_MMA(1, 0, At, B0); PG8_BAR; PG8_SCHED;
            PG8_STAGE(PG8_SB(0, 1), b2 + hstep, voffB);
            PG8_WAIT_V(6); PG8_BAR; PG8_MMA(1, 1, At, B1); PG8_BAR;
            PG8_LDB(B0, 1, 0); PG8_SCHED; PG8_LDA(At, 1, 0); PG8_STAGE(PG8_SA(0, 1), a2 + hstep, voffA);
            PG8_WAIT_L(8); PG8_BAR; PG8_WAIT_L(0); PG8_MMA(0, 0, At, B0); PG8_BAR; PG8_SCHED;
            PG8_LDB(B1, 1, 1); PG8_STAGE(PG8_SB(1, 0), b3, voffB);
            PG8_BAR; PG8_WAIT_L(0); PG8_MMA(0, 1, At, B1); PG8_BAR;
            PG8_LDA(At, 1, 1); PG8_STAGE(PG8_SA(1, 0), a3, voffA);
            PG8_BAR; PG8_WAIT_L(0); PG8_MMA(1, 0, At, B0); PG8_BAR; PG8_SCHED;
            PG8_STAGE(PG8_SB(1, 1), b3 + hstep, voffB);
            PG8_WAIT_V(6); PG8_BAR; PG8_MMA(1, 1, At, B1); PG8_BAR;
            }
        }
        if constexpr (ALIGN_EPI) { if (wr == 0) PG8_BAR; }
        E(acc, cur, wr, wc, fr, fq);
        if (!has_next) break;
#pragma unroll
        for (int a = 0; a < 2; ++a)
#pragma unroll
            for (int b = 0; b < 2; ++b)
#pragma unroll
                for (int m = 0; m < 4; ++m)
#pragma unroll
                    for (int n = 0; n < 2; ++n) acc[a][b][m][n] = (f32x4){0.f, 0.f, 0.f, 0.f};
        cur = nxt; cA = nA; cB = nB; ++ui;
        if constexpr (ALIGN_EPI) { if (wr == 1) PG8_BAR; }
    }
    PG8_WAIT_V(0);
    if constexpr (!ALIGN_EPI) { if (wr == 0) PG8_BAR; }
    PG8_BAR;
#undef PG8_SA
#undef PG8_SB
#undef PG8_STAGE
#undef PG8_LDA
#undef PG8_LDB
#undef PG8_MMA
#undef PG8_WAIT_V
#undef PG8_WAIT_L
#undef PG8_BAR
#undef PG8_SCHED
}
}

constexpr int D = 1024, NB = 8, LX = 4096, LCX = 256, NIN = 4608, DA = 512, DB = 512, HD = 128;
constexpr int MLAT = NB * LX, MCTX = NB * LCX, MTOK = MLAT + MCTX;
constexpr int PA_LD = 3072;
constexpr int FZ = 8448, FZC = 640;
constexpr float EPS = 1e-6f;
constexpr float HY_MIN_DECAY = -3.0701134573253944f, HY_MAX_DECAY = -15.350567286626972f;
constexpr int NWAVES = 8, NTHR = 512;

constexpr size_t MiB = 1u << 20;
constexpr size_t WS_CTL = 0, CTL_ZERO_BYTES = 1 * MiB;
constexpr size_t WS_MOD = 1 * MiB;
constexpr size_t WS_LBS = WS_MOD + 256 * 1024;
constexpr size_t WS_WIN = 6 * MiB;
constexpr size_t WS_WOUT = 24 * MiB;
constexpr size_t WS_FG = 28 * MiB;
constexpr size_t WS_FGC = 45 * MiB;
constexpr size_t WS_CTX1 = 46 * MiB;
constexpr size_t WS_OC = 2 * MiB;
constexpr size_t WS_XA = 54 * MiB;
constexpr size_t WS_PA = 122 * MiB;
constexpr size_t WS_PB = 326 * MiB;
constexpr size_t WS_OBT = 462 * MiB;
constexpr size_t WS_HK = 326 * MiB;
constexpr size_t WS_SCL = 496 * MiB;
constexpr size_t WS_END = 504 * MiB;
constexpr int CW_NORM = 1024;
constexpr int CW_BAR = 8192;
constexpr int CW_QUEUE = 4096;

constexpr int LDS_BYTES = 156 * 1024;
#define LAS __attribute__((address_space(3)))
#define GAS __attribute__((address_space(1)))
typedef unsigned short bf16;
typedef unsigned v4u __attribute__((ext_vector_type(4)));
typedef unsigned v2u __attribute__((ext_vector_type(2)));
typedef float f32x4 __attribute__((ext_vector_type(4)));

typedef __bf16 bf2_t __attribute__((ext_vector_type(2)));
typedef float f2_t __attribute__((ext_vector_type(2)));
__device__ __forceinline__ unsigned pk2(float lo, float hi) { const f2_t v = {lo, hi}; return __builtin_bit_cast(unsigned, __builtin_convertvector(v, bf2_t)); }
__device__ __forceinline__ unsigned f2bf(float f) { return pk2(f, 0.f) & 0xffffu; }
__device__ __forceinline__ float bf2f(unsigned short h) { return __builtin_bit_cast(float, (unsigned)h << 16); }
__device__ __forceinline__ unsigned f2h(float f) { _Float16 h = (_Float16)f; return (unsigned)__builtin_bit_cast(unsigned short, h); }
__device__ __forceinline__ unsigned pk2h(float lo, float hi) { return f2h(lo) | (f2h(hi) << 16); }
__device__ __forceinline__ float h2f(unsigned short u) { return (float)__builtin_bit_cast(_Float16, u); }
__device__ __forceinline__ float silu_f(float x) { return x * __builtin_amdgcn_rcpf(1.0f + __expf(-x)); }
__device__ __forceinline__ float sigmoid_f(float x) { return __builtin_amdgcn_rcpf(1.0f + __expf(-x)); }
__device__ __forceinline__ float wave_sum(float v) {
#pragma unroll
    for (int o = 1; o < 64; o <<= 1) v += __shfl_xor(v, o);
    return v;
}


#define PSTAMP_(lds_, k_) do { if (threadIdx.x == 0) ((volatile LAS unsigned long long*)((lds_) + LDS_BYTES - 512))[(k_)] = __builtin_amdgcn_s_memrealtime(); } while (0)
#if defined(PROBE_ID) && PROBE_ID >= 216 && PROBE_ID < 220
#define PSTAMP_H(lds_, k_) PSTAMP_(lds_, k_)
#else
#define PSTAMP_H(lds_, k_) do { } while (0)
#endif
#if defined(PROBE_ID) && PROBE_ID >= 226 && PROBE_ID < 230
#define PSTAMP_P(lds_, k_) PSTAMP_(lds_, k_)
#else
#define PSTAMP_P(lds_, k_) do { } while (0)
#endif
#if defined(PROBE_ID) && PROBE_ID >= 220 && PROBE_ID < 226
#define PSTAMP_S(lds_, k_) PSTAMP_(lds_, k_)
#else
#define PSTAMP_S(lds_, k_) do { } while (0)
#endif
typedef GAS unsigned gu32;
#define XB_TMO      128
#define XB_XCNT(j)  (256  + 64 * (j))
#define XB_XSUB(j)  (1280 + 64 * (j))
#define XB_XGEN(j)  (2304 + 64 * (j))
#define XB_TOP      3328
#define XB_TOPGEN   3392
#define XCD_BAR_WORDS 3456
#define XB_SPIN_CAP (1u << 18)
__device__ __forceinline__ unsigned xb_ld(unsigned* p)              { return __hip_atomic_load(p, __ATOMIC_RELAXED, __HIP_MEMORY_SCOPE_AGENT); }
__device__ __forceinline__ unsigned xb_add(unsigned* p, unsigned v) { return __hip_atomic_fetch_add(p, v, __ATOMIC_RELAXED, __HIP_MEMORY_SCOPE_AGENT); }
__device__ __forceinline__ unsigned xb_xcc_id() { return (unsigned)__builtin_amdgcn_s_getreg((3 << 11) | 20) & 0xFu; }
#define XB_SPIN(cond, bar) do { unsigned _sp = 0; while (cond) { __builtin_amdgcn_s_sleep(1); \
    if ((++_sp & 255u) == 0u) { if (xb_ld(&(bar)[XB_TMO])) break; if (_sp > XB_SPIN_CAP) { atomicAdd(&(bar)[XB_TMO], 1u); break; } } } } while (0)
struct XcdBarrier { unsigned* bar; unsigned x; volatile LAS unsigned* st; };
__device__ __forceinline__ XcdBarrier xcd_barrier_post(unsigned* bar, volatile LAS unsigned* st) {
    XcdBarrier b; b.bar = bar; b.x = xb_xcc_id(); b.st = st;
    if (threadIdx.x == 0) (void)xb_add(&bar[XB_XCNT(b.x)], 1u);
    return b;
}
__device__ __forceinline__ void xcd_barrier_complete(unsigned* bar, unsigned x, unsigned& nloc, unsigned& nx) {
    const unsigned G = gridDim.x * gridDim.y * gridDim.z;
    unsigned sum, cnt, mine, sp = 0u;
    for (;;) {
        sum = 0u; cnt = 0u; mine = 0u;
#pragma unroll
        for (unsigned j = 0; j < 16; ++j) { const unsigned c = xb_ld(&bar[XB_XCNT(j)]); sum += c; cnt += (c > 0u) ? 1u : 0u; mine = (j == x) ? c : mine; }
        if (sum == G) break;
        __builtin_amdgcn_s_sleep(1);
        if ((++sp & 255u) == 0u) { if (xb_ld(&bar[XB_TMO])) break; if (sp > XB_SPIN_CAP) { atomicAdd(&bar[XB_TMO], 1u); break; } }
    }
    nloc = mine > 0u ? mine : 1u; nx = cnt > 0u ? cnt : 1u;
}
__device__ __forceinline__ void xcd_barrier(const XcdBarrier& b) {
    asm volatile("s_waitcnt vmcnt(0)" ::: "memory");
    __syncthreads();
    if (threadIdx.x == 0) {
        unsigned* bar = b.bar;
        __builtin_amdgcn_s_waitcnt(0);
        unsigned nloc = b.st[0], nx = b.st[1];
        if (nloc == 0u) { xcd_barrier_complete(bar, b.x, nloc, nx); b.st[0] = nloc; b.st[1] = nx; }
        const unsigned old = xb_add(&bar[XB_XSUB(b.x)], 1u);
        const unsigned gen = old / nloc;
        if (old + 1u == (gen + 1u) * nloc) {
            __builtin_amdgcn_fence(__ATOMIC_RELEASE, "agent");
            asm volatile("s_waitcnt vmcnt(0)" ::: "memory");
            const unsigned og = xb_add(&bar[XB_TOP], 1u);
            const unsigned tg = og / nx;
            if (og + 1u == (tg + 1u) * nx) xb_add(&bar[XB_TOPGEN], 1u);
            else XB_SPIN(xb_ld(&bar[XB_TOPGEN]) == tg, bar);
            __builtin_amdgcn_fence(__ATOMIC_ACQUIRE, "agent");
            xb_add(&bar[XB_XGEN(b.x)], 1u);
            asm volatile("s_waitcnt vmcnt(0)" ::: "memory");
        } else {
            XB_SPIN(xb_ld(&bar[XB_XGEN(b.x)]) == gen, bar);
            __builtin_amdgcn_fence(__ATOMIC_ACQUIRE, "agent");
            asm volatile("s_waitcnt vmcnt(0)" ::: "memory");
        }
    }
    __syncthreads();
}

struct EpiIn {
    static constexpr bool PERM = true;
    bf16* PA; bf16* PB; const float* lb;
    __device__ __forceinline__ bool swap(const pg8::Unit& u) const { return u.pn >= 10; }
    __device__ __forceinline__ void operator()(const f32x4 (&acc)[2][2][4][2], const pg8::Unit& u, int wr, int wc, int fr, int fq) const {
        if (u.pn < 10) {
            const int type = u.pn >> 1;
            const int row0 = u.pm * 256 + wr * 64 + fr, col0 = u.pn * 256 + wc * 32 + 8 * fq;
#pragma unroll
            for (int bj = 0; bj < 2; ++bj) {
                float lbv[8];
#pragma unroll
                for (int e = 0; e < 8; ++e) lbv[e] = (type == 1 || type == 2) ? lb[col0 + bj * 128 + e - 512] : 0.f;
#pragma unroll
                for (int ai = 0; ai < 2; ++ai)
#pragma unroll
                    for (int m = 0; m < 4; ++m) {
                        bf16* rowp = PA + (size_t)(row0 + ai * 128 + m * 16) * PA_LD + col0 + bj * 128;
                        float x[8];
#pragma unroll
                        for (int e = 0; e < 4; ++e) { x[e] = acc[ai][bj][m][0][e]; x[4 + e] = acc[ai][bj][m][1][e]; }
                        v4u w;
                        if (type == 0) {
#pragma unroll
                            for (int e = 0; e < 8; ++e) x[e] = silu_f(x[e]);
                            w.x = pk2(x[0], x[1]); w.y = pk2(x[2], x[3]); w.z = pk2(x[4], x[5]); w.w = pk2(x[6], x[7]);
                        } else if (type == 1 || type == 2) {
#pragma unroll
                            for (int e = 0; e < 8; ++e) x[e] = lbv[e] + (1.0f - lbv[e]) * sigmoid_f(x[e]);
                            w.x = pk2h(x[0], x[1]); w.y = pk2h(x[2], x[3]); w.z = pk2h(x[4], x[5]); w.w = pk2h(x[6], x[7]);
                        } else {
                            w.x = pk2(x[0], x[1]); w.y = pk2(x[2], x[3]); w.z = pk2(x[4], x[5]); w.w = pk2(x[6], x[7]);
                        }
                        *(v4u*)rowp = w;
                        asm volatile("" ::: "memory");
                    }
            }
        } else {
#pragma unroll
            for (int ai = 0; ai < 2; ++ai)
#pragma unroll
                for (int m = 0; m < 4; ++m) {
                    const int cw = u.pn * 256 + ai * 128 + wr * 64 + m * 16 + fr;
                    bf16* colp = PB + (size_t)(cw - 2560) * MTOK + u.pm * 256 + wc * 32 + 8 * fq;
#pragma unroll
                    for (int bj = 0; bj < 2; ++bj) {
                        const f32x4 v0 = acc[ai][bj][m][0], v1 = acc[ai][bj][m][1];
                        v4u w; w.x = pk2(v0[0], v0[1]); w.y = pk2(v0[2], v0[3]); w.z = pk2(v1[0], v1[1]); w.w = pk2(v1[2], v1[3]);
                        *(v4u*)(colp + bj * 128) = w;
                    }
                }
        }
    }
};
struct EpiOut {
    static constexpr bool PERM = true;
    bf16* DL; const float* mod;
    __device__ __forceinline__ bool swap(const pg8::Unit&) const { return false; }
    __device__ __forceinline__ void operator()(const f32x4 (&acc)[2][2][4][2], const pg8::Unit& u, int wr, int wc, int fr, int fq) const {
        const int mr = u.pm >= 128 ? 8 : (u.pm >> 4);
        const int col0 = u.pn * 256 + wc * 32 + 8 * fq;
        f32x4 g0[2], g1[2];
#pragma unroll
        for (int bj = 0; bj < 2; ++bj) { const float* gt = mod + (size_t)mr * 3 * D + 2 * D + col0 + bj * 128; g0[bj] = *(const f32x4*)gt; g1[bj] = *(const f32x4*)(gt + 4); }
#pragma unroll
        for (int ai = 0; ai < 2; ++ai)
#pragma unroll
            for (int m = 0; m < 4; ++m) {
                bf16* rowp = DL + (size_t)(u.pm * 256 + ai * 128 + wr * 64 + m * 16 + fr) * D + col0;
#pragma unroll
                for (int bj = 0; bj < 2; ++bj) {
                    const f32x4 v0 = acc[ai][bj][m][0] * g0[bj], v1 = acc[ai][bj][m][1] * g1[bj];
                    v4u w; w.x = pk2(v0[0], v0[1]); w.y = pk2(v0[2], v0[3]); w.z = pk2(v1[0], v1[1]); w.w = pk2(v1[2], v1[3]);
                    *(v4u*)(rowp + bj * 128) = w;
                }
            }
    }
};

struct Args {
    const float* in[23]; float* out; unsigned char* ws; int ph_lo, ph_hi;
};

struct Frame {
    LAS unsigned char* lds; int tid, lane, wave, vcu, G;
};

__device__ __forceinline__ void p0_transpose_item(const float* W, int K, int N, bf16* WT, LAS float* scr, int item, int lane) {
    const int nblk = N / 32, kb = item / nblk, nb = item % nblk, k0 = 64 * kb, n0 = 32 * nb;
    f32x4 v[8];
#pragma unroll
    for (int i = 0; i < 8; ++i) v[i] = *(const f32x4*)(W + (size_t)(k0 + 8 * i + (lane >> 3)) * N + n0 + 4 * (lane & 7));
#pragma unroll
    for (int i = 0; i < 8; ++i) { LAS float* d = scr + (8 * i + (lane >> 3)) * 33 + 4 * (lane & 7); d[0] = v[i][0]; d[1] = v[i][1]; d[2] = v[i][2]; d[3] = v[i][3]; }
    asm volatile("s_waitcnt lgkmcnt(0)" ::: "memory");
    const int c = lane & 7;
#pragma unroll
    for (int j = 0; j < 4; ++j) { const int n = (lane >> 3) + 8 * j; const LAS float* s = scr + (8 * c) * 33 + n;
        v4u o; o.x = pk2(s[0 * 33], s[1 * 33]); o.y = pk2(s[2 * 33], s[3 * 33]); o.z = pk2(s[4 * 33], s[5 * 33]); o.w = pk2(s[6 * 33], s[7 * 33]);
        *(v4u*)(WT + (size_t)(n0 + n) * K + k0 + 8 * c) = o; }
    asm volatile("s_waitcnt lgkmcnt(0)" ::: "memory");
}

__device__ __forceinline__ void filter_task(const Args& a, Frame& F, const int set, const int n0, int& cached_layer) {
    unsigned char* ws = a.ws;
    const int l = set == 1 ? 1 : 0, L = set == 2 ? 256 : 4096;
    LAS float* w1s = (LAS float*)F.lds;
    LAS float* w2s = w1s + 33 * 64;
    LAS float* w3s = w2s + 64 * 64;
    LAS float* bs = w3s + 64 * 64;
    LAS float* zs = bs + 256;
    LAS float* h3s = zs + 8 * 4 * 64;
    LAS unsigned short* tile = (LAS unsigned short*)(h3s + 32 * 64);
    if (cached_layer != l) {
        __syncthreads();
        for (int e = F.tid; e < 33 * 64; e += NTHR) w1s[e] = a.in[13][l * 33 * 64 + e];
        for (int e = F.tid; e < 4096; e += NTHR) { w2s[e] = a.in[16][l * 4096 + e]; w3s[e] = a.in[18][l * 4096 + e]; }
        if (F.tid < 64) { bs[F.tid] = a.in[14][l * 64 + F.tid]; bs[64 + F.tid] = a.in[17][l * 64 + F.tid]; bs[128 + F.tid] = a.in[19][l * 64 + F.tid]; bs[192 + F.tid] = a.in[15][l * 64 + F.tid]; }
        cached_layer = l;
        __syncthreads();
    }
    {
        const int j = F.lane; LAS float* zw = zs + F.wave * 256; const float fr = bs[192 + j];
#pragma unroll
        for (int p = 0; p < 4; ++p) {
            const int n = n0 + 4 * F.wave + p;
            float zv = 0.f;
            if (j == 0) zv = (float)n / (float)(L - 1);
            else if (j < 33) { const int i = (j - 1) & 15; const double f = 1e-4 + (double)i * ((15.0 - 1e-4) / 15.0); double rev = f * (double)n / (double)L; rev -= floor(rev);
                const float ang = (float)(rev * 6.283185307179586476925); zv = (j <= 16) ? __cosf(ang) : -__sinf(ang); }
            zw[p * 64 + j] = zv;
        }
        asm volatile("s_waitcnt lgkmcnt(0)" ::: "memory");
        float s4[4];
#pragma unroll
        for (int p = 0; p < 4; ++p) s4[p] = bs[j];
        for (int e = 0; e < 33; ++e) { const float wv = w1s[e * 64 + j];
#pragma unroll
            for (int p = 0; p < 4; ++p) s4[p] += zw[p * 64 + e] * wv; }
        asm volatile("s_waitcnt lgkmcnt(0)" ::: "memory");
#pragma unroll
        for (int p = 0; p < 4; ++p) zw[p * 64 + j] = __sinf(fr * s4[p]);
        asm volatile("s_waitcnt lgkmcnt(0)" ::: "memory");
#pragma unroll
        for (int p = 0; p < 4; ++p) s4[p] = bs[64 + j];
        for (int e = 0; e < 64; ++e) { const float wv = w2s[e * 64 + j];
#pragma unroll
            for (int p = 0; p < 4; ++p) s4[p] += zw[p * 64 + e] * wv; }
        asm volatile("s_waitcnt lgkmcnt(0)" ::: "memory");
#pragma unroll
        for (int p = 0; p < 4; ++p) zw[p * 64 + j] = __sinf(fr * s4[p]);
        asm volatile("s_waitcnt lgkmcnt(0)" ::: "memory");
#pragma unroll
        for (int p = 0; p < 4; ++p) s4[p] = bs[128 + j];
        for (int e = 0; e < 64; ++e) { const float wv = w3s[e * 64 + j];
#pragma unroll
            for (int p = 0; p < 4; ++p) s4[p] += zw[p * 64 + e] * wv; }
#pragma unroll
        for (int p = 0; p < 4; ++p) h3s[(4 * F.wave + p) * 64 + j] = __sinf(fr * s4[p]);
    }
    __syncthreads();
    {
        typedef short bf16x8_ __attribute__((ext_vector_type(8)));
        LAS unsigned char* hA = (LAS unsigned char*)(tile + 1024 * 34);
        LAS unsigned char* wB = hA + 32 * 144;
        const int l15 = F.lane & 15, q = F.lane >> 4;
        { const int p = F.tid >> 4, k4 = (F.tid & 15) * 4; const f32x4 hv = *(const LAS f32x4*)(h3s + p * 64 + k4);
          v2u hw; hw.x = pk2(hv[0], hv[1]); hw.y = pk2(hv[2], hv[3]); *(LAS v2u*)(hA + p * 144 + 2 * k4) = hw; }
        float* nrm = (float*)(ws + WS_CTL) + CW_NORM;
        const float* w4 = a.in[20] + (size_t)l * 64 * 1024;
        for (int ch = 0; ch < 8; ++ch) {
            __syncthreads();
            { const int n = F.tid & 127, kq = F.tid >> 7;
              float wv[2][8];
#pragma unroll
              for (int g2 = 0; g2 < 2; ++g2)
#pragma unroll
                  for (int e = 0; e < 8; ++e) wv[g2][e] = w4[(size_t)(16 * kq + 8 * g2 + e) * 1024 + 128 * ch + n];
#pragma unroll
              for (int g2 = 0; g2 < 2; ++g2) { v4u o; o.x = pk2(wv[g2][0], wv[g2][1]); o.y = pk2(wv[g2][2], wv[g2][3]); o.z = pk2(wv[g2][4], wv[g2][5]); o.w = pk2(wv[g2][6], wv[g2][7]);
                  *(LAS v4u*)(wB + n * 144 + (16 * kq + 8 * g2) * 2) = o; } }
            __syncthreads();
            {
                const int col = 128 * ch + 16 * F.wave + l15, c = col & 511;
                f32x4 acc[2];
#pragma unroll
                for (int mt = 0; mt < 2; ++mt) { acc[mt] = (f32x4){0.f, 0.f, 0.f, 0.f};
#pragma unroll
                    for (int ks = 0; ks < 2; ++ks)
                        acc[mt] = __builtin_amdgcn_mfma_f32_16x16x32_bf16(*(const LAS bf16x8_*)(hA + (16 * mt + l15) * 144 + (32 * ks + 8 * q) * 2), *(const LAS bf16x8_*)(wB + (16 * F.wave + l15) * 144 + (32 * ks + 8 * q) * 2), acc[mt], 0, 0, 0); }
                const float dl = fabsf(HY_MIN_DECAY + (float)c * ((HY_MAX_DECAY - HY_MIN_DECAY) / 511.0f));
                float ns = 0.f;
#pragma unroll
                for (int mt = 0; mt < 2; ++mt) {
                    float v4[4];
#pragma unroll
                    for (int r = 0; r < 4; ++r) { const int nn = n0 + 16 * mt + 4 * q + r; v4[r] = acc[mt][r] * __expf(-((float)nn / (float)(L - 1)) * dl); if (col < 512 || nn >= 1) ns += fabsf(v4[r]); }
                    *(LAS unsigned*)(tile + col * 34 + 16 * mt + 4 * q) = pk2(v4[0], v4[1]); *(LAS unsigned*)(tile + col * 34 + 16 * mt + 4 * q + 2) = pk2(v4[2], v4[3]);
                }
                ns += __shfl_xor(ns, 16); ns += __shfl_xor(ns, 32);
                if (q == 0) atomicAdd(&nrm[set * 512 + c], ns);
            }
        }
    }
    __syncthreads();
    {
        bf16* dst = set == 2 ? (bf16*)(ws + WS_FGC) : (bf16*)(ws + WS_FG) + (size_t)set * 512 * FZ;
        const int ld = set == 2 ? FZC : FZ;
        for (int e = F.tid; e < 1024 * 32; e += NTHR) {
            const int col = e >> 5, p = e & 31, c = col & 511, n = n0 + p;
            const unsigned short v = tile[col * 34 + p];
            if (col < 512) dst[(size_t)c * ld + (L - n)] = v;
            else if (n >= 1) dst[(size_t)c * ld + (L + n)] = v;
        }
        if (n0 == 0) {
            const int npad = ld - 2 * L;
            for (int e = F.tid; e < 512 * (npad + 1); e += NTHR) { const int c = e / (npad + 1), k = e % (npad + 1); dst[(size_t)c * ld + (k == 0 ? 0 : 2 * L + k - 1)] = 0; }
        }
    }
    __syncthreads();
}

__device__ __forceinline__ void phase_prologue(const Args& a, Frame& F) {
    unsigned char* ws = a.ws;
    if (F.vcu == 0) {
        float* lbs = (float*)(ws + WS_LBS);
        for (int i = F.tid; i < 1024; i += NTHR) {
            const float a0 = a.in[9][i], a1 = a.in[9][1024 + i];
            const float m = fmaxf(a0, a1), e0 = expf(a0 - m), e1 = expf(a1 - m);
            const float p0 = e0 / (e0 + e1), p1 = e1 / (e0 + e1);
            const float c0 = p0, c1 = p0 + p1;
            lbs[i] = c0 - c0; lbs[1024 + i] = c1 - c0;
        }
    }
    int cached_layer = -1;
    constexpr int I_IN = (D / 64) * (NIN / 32), I_OUT = (D / 64) * (D / 32), NTR = 2 * (I_IN + I_OUT) / 8;
    for (int t = F.vcu; t < NTR; t += F.G) {
        LAS float* scr = (LAS float*)(F.lds + 65536 + F.wave * 8704);
        int r = t * 8 + F.wave; const int l = r / (I_IN + I_OUT); r -= l * (I_IN + I_OUT);
        if (r < I_IN) p0_transpose_item(a.in[7] + (size_t)l * D * NIN, D, NIN, (bf16*)(ws + WS_WIN) + (size_t)l * NIN * D, scr, r, F.lane);
        else p0_transpose_item(a.in[8] + (size_t)l * D * D, D, D, (bf16*)(ws + WS_WOUT) + (size_t)l * D * D, scr, r - I_IN, F.lane);
    }
    __syncthreads();
    if (F.vcu >= 160) {
        const int task = F.vcu - 160;
        LAS float* sv = (LAS float*)(F.lds + 65536);
        LAS float* part = sv + 9 * 1024;
        const int l = task / 48, n0 = (task % 48) * 64;
        for (int e = F.tid; e < 9 * 1024; e += NTHR) { const int r = e >> 10, k = e & 1023; const float cv = r < 8 ? a.in[1][r * D + k] : a.in[3][k]; sv[e] = cv / (1.0f + expf(-cv)); }
        __syncthreads();
        float acc9[9];
#pragma unroll
        for (int r = 0; r < 9; ++r) acc9[r] = 0.f;
        const float* w = a.in[5] + (size_t)l * D * 3 * D + n0 + F.lane;
#pragma unroll 16
        for (int k = F.wave * 128; k < F.wave * 128 + 128; ++k) {
            const float wv = w[(size_t)k * 3 * D];
#pragma unroll
            for (int r = 0; r < 9; ++r) acc9[r] += sv[r * 1024 + k] * wv;
        }
#pragma unroll
        for (int r = 0; r < 9; ++r) part[(F.wave * 9 + r) * 64 + F.lane] = acc9[r];
        __syncthreads();
        for (int e = F.tid; e < 9 * 64; e += NTHR) {
            const int r = e >> 6, c = e & 63; float sum = 0.f;
#pragma unroll
            for (int w8 = 0; w8 < 8; ++w8) sum += part[(w8 * 9 + r) * 64 + c];
            ((float*)(ws + WS_MOD))[((size_t)l * 9 + r) * 3 * D + n0 + c] = sum + a.in[6][l * 3 * D + n0 + c];
        }
        __syncthreads();
    }
    if (F.vcu < 16) filter_task(a, F, 0, 32 * (112 + F.vcu), cached_layer);
    else if (F.vcu >= 128 && F.vcu < 136) filter_task(a, F, 2, 32 * (F.vcu - 128), cached_layer);
}
__device__ __forceinline__ void phase_filters_l0(const Args& a, Frame& F) {
    int cached_layer = -1; const int b = (int)blockIdx.x;
    if (b >= 144) filter_task(a, F, 0, 32 * (b - 144), cached_layer);
}
__device__ __forceinline__ void phase_filters_l1(const Args& a, Frame& F) {
    int cached_layer = -1; const int b = (int)blockIdx.x;
    if (b >= 32 && b < 160) filter_task(a, F, 1, 32 * (b - 32), cached_layer);
}

__device__ __forceinline__ void phase_normrows(const Args& a, Frame& F, int l, const float* xlat, const float* xctx) {
    unsigned char* ws = a.ws;
    const float* nw = a.in[4] + l * D;
    const float* mod = (const float*)(ws + WS_MOD) + (size_t)l * 9 * 3 * D;
    bf16* XA = (bf16*)(ws + WS_XA);
    const bf16* DL = (const bf16*)(ws + WS_PB);
    const int gw = F.vcu * NWAVES + F.wave, NGW = F.G * NWAVES;
    for (int tok = gw; tok < MTOK; tok += NGW) {
        const bool isctx = tok >= MLAT;
        const float* xr = isctx ? xctx + (size_t)(tok - MLAT) * D : xlat + (size_t)tok * D;
        const int mr = isctx ? 8 : (tok >> 12);
        const float* sh = mod + (size_t)mr * 3 * D; const float* sc = sh + D;
        f32x4 v[4]; float s = 0.f;
#pragma unroll
        for (int j = 0; j < 4; ++j) v[j] = *(const f32x4*)(xr + 256 * j + 4 * F.lane);
        if (l == 1) {
#pragma unroll
            for (int j = 0; j < 4; ++j) { const v2u dw = *(const v2u*)(DL + (size_t)tok * D + 256 * j + 4 * F.lane);
                v[j].x += bf2f((unsigned short)(dw.x & 0xffffu)); v[j].y += bf2f((unsigned short)(dw.x >> 16)); v[j].z += bf2f((unsigned short)(dw.y & 0xffffu)); v[j].w += bf2f((unsigned short)(dw.y >> 16)); }
            if (!isctx) {
#pragma unroll
                for (int j = 0; j < 4; ++j) *(f32x4*)(a.out + (size_t)tok * D + 256 * j + 4 * F.lane) = v[j];
            }
        }
#pragma unroll
        for (int j = 0; j < 4; ++j) s += (v[j].x * v[j].x + v[j].y * v[j].y) + (v[j].z * v[j].z + v[j].w * v[j].w);
        const float rstd = 1.0f / sqrtf(wave_sum(s) * (1.0f / D) + EPS);
#pragma unroll
        for (int j = 0; j < 4; ++j) {
            const int k = 256 * j + 4 * F.lane;
            const f32x4 w4 = *(const f32x4*)(nw + k), s4 = *(const f32x4*)(sc + k), h4 = *(const f32x4*)(sh + k);
            const f32x4 y = v[j] * rstd * w4 * (s4 + 1.0f) + h4;
            v2u o; o.x = pk2(y.x, y.y); o.y = pk2(y.z, y.w);
            *(v2u*)(XA + (size_t)tok * D + k) = o;
        }
    }
}


namespace scan {
typedef short bf16x8 __attribute__((ext_vector_type(8)));
typedef short bf16x4 __attribute__((ext_vector_type(4)));
constexpr int QI_RS = 256, KT_RS = 160;
constexpr int OFF_QI = 0, OFF_KI = 16384, OFF_KT = 32768, OFF_VT = 53248, OFF_SCL = 73728, SET_BYTES = 74752;
constexpr int OFF_SEG = 2 * SET_BYTES;
static_assert(OFF_SEG + 4096 <= LDS_BYTES - 512, "scan LDS");
#define MFMA16(a, b, c) __builtin_amdgcn_mfma_f32_16x16x32_bf16((a), (b), (c), 0, 0, 0)
__device__ __forceinline__ bf16x8 ld_qk(const LAS unsigned char* img, int row, int ks, int xq) {
    return *(const LAS bf16x8*)(img + row * QI_RS + ((16 * xq) ^ (64 * ks)));
}
__device__ __forceinline__ int tok_row(int g, int i, int b, int dir) {
    if (g < 4) { const int t = 64 * g + i; return MLAT + b * LCX + (dir ? (LCX - 1 - t) : t); }
    const int t = 64 * (g - 4) + i; return b * LX + (dir ? (LX - 1 - t) : t);
}
template <int HALF>
__device__ __forceinline__ void scan_producer(LAS unsigned char* lds, const bf16* PA, const int b, const int h, const int dir, const int nchunk, const int pw, const int lane) {
    const int tg = lane >> 4, cq = lane & 15, ch0 = 64 * (pw >> 1) + 4 * cq;
    LAS float* seg = (LAS float*)(lds + OFF_SEG + pw * 1024);
    const int qc_ = 8 * (pw >> 1) + 4 * (cq >> 3) + (cq & 3);
    v2u qA[8], fA[8], vA[8], qB[8], fB[8], vB[8];
#define SCAN_LOAD(g, Q_, F_, V_) do { _Pragma("unroll") for (int e = 0; e < 8; ++e) { const bf16* p_ = PA + (size_t)tok_row((g), 32 * HALF + 8 * tg + e, b, dir) * PA_LD + h * HD + ch0; \
        Q_[e] = *(const v2u*)p_; F_[e] = *(const v2u*)(p_ + 512 + dir * 512); V_[e] = *(const v2u*)(p_ + 1536); } } while (0)
#define SCAN_IMG(set_, Q_, F_, V_) do { LAS unsigned char* s_ = lds + (set_) * SET_BYTES; \
        _Pragma("unroll") for (int e = 0; e < 8; ++e) asm volatile("" : "+v"(F_[e].x), "+v"(F_[e].y)); \
        float f_[4][8]; \
        _Pragma("unroll") for (int e = 0; e < 8; ++e) { f_[0][e] = h2f((unsigned short)(F_[e].x & 0xffffu)); f_[1][e] = h2f((unsigned short)(F_[e].x >> 16)); f_[2][e] = h2f((unsigned short)(F_[e].y & 0xffffu)); f_[3][e] = h2f((unsigned short)(F_[e].y >> 16)); } \
        f32x4 pr_; \
        _Pragma("unroll") for (int d = 0; d < 4; ++d) pr_[d] = ((f_[d][0] * f_[d][1]) * (f_[d][2] * f_[d][3])) * ((f_[d][4] * f_[d][5]) * (f_[d][6] * f_[d][7])); \
        *(LAS f32x4*)(seg + tg * 64 + 4 * cq) = pr_; \
        f32x4 T_[4]; _Pragma("unroll") for (int t2 = 0; t2 < 4; ++t2) T_[t2] = *(const LAS f32x4*)(seg + t2 * 64 + 4 * cq); \
        const f32x4 tot_ = (T_[0] * T_[1]) * (T_[2] * T_[3]); \
        f32x4 mul_ = (f32x4){1.f, 1.f, 1.f, 1.f}; \
        if (HALF) { _Pragma("unroll") for (int t2 = 0; t2 < 3; ++t2) if (t2 < tg) mul_ *= T_[t2]; } \
        else      { _Pragma("unroll") for (int t2 = 1; t2 < 4; ++t2) if (t2 > tg) mul_ *= T_[t2]; } \
        float Qp_[4][8], Kp_[4][8]; \
        _Pragma("unroll") for (int d = 0; d < 4; ++d) { float x_[8]; float run_ = mul_[d]; \
            if (HALF) { _Pragma("unroll") for (int e = 0; e < 8; ++e) { run_ *= f_[d][e]; x_[e] = run_; } } \
            else      { _Pragma("unroll") for (int e = 7; e >= 0; --e) { x_[e] = run_; run_ *= f_[d][e]; } } \
            _Pragma("unroll") for (int e = 0; e < 8; ++e) { const unsigned qw_ = (d & 2) ? Q_[e].y : Q_[e].x; const float qv_ = bf2f((unsigned short)((d & 1) ? (qw_ >> 16) : (qw_ & 0xffffu))); \
                const float xx_ = fmaxf(x_[e], 1e-30f), r_ = __builtin_amdgcn_rcpf(xx_), kk_ = 1.0f - f_[d][e]; \
                Qp_[d][e] = HALF ? qv_ * xx_ : qv_ * r_; Kp_[d][e] = HALF ? kk_ * r_ : kk_ * xx_; } \
            v4u t_, u_; \
            _Pragma("unroll") for (int e = 0; e < 4; ++e) { t_[e] = pk2(Kp_[d][2 * e], Kp_[d][2 * e + 1]); \
                const unsigned va_ = (d & 2) ? V_[2 * e].y : V_[2 * e].x, vb_ = (d & 2) ? V_[2 * e + 1].y : V_[2 * e + 1].x; \
                u_[e] = (d & 1) ? ((va_ >> 16) | (vb_ & 0xffff0000u)) : ((va_ & 0xffffu) | (vb_ << 16)); } \
            *(LAS v4u*)(s_ + OFF_KT + (ch0 + d) * KT_RS + 16 * ((4 * HALF + tg) ^ (cq & 7))) = t_; *(LAS v4u*)(s_ + OFF_VT + (ch0 + d) * KT_RS + 16 * ((4 * HALF + tg) ^ (cq & 7))) = u_; } \
        int qx_ = qc_ ^ (8 * (tg & 1)); asm volatile("" : "+v"(qx_)); const int rb_ = (32 * HALF + 8 * tg) * QI_RS + 8 * ((cq >> 2) & 1); \
        _Pragma("unroll") for (int e = 0; e < 8; ++e) { v2u qq_, kq_; qq_.x = pk2(Qp_[0][e], Qp_[1][e]); qq_.y = pk2(Qp_[2][e], Qp_[3][e]); kq_.x = pk2(Kp_[0][e], Kp_[1][e]); kq_.y = pk2(Kp_[2][e], Kp_[3][e]); \
            const int ro_ = rb_ + e * QI_RS + 16 * (qx_ ^ e); \
            *(LAS v2u*)(s_ + OFF_QI + ro_) = qq_; *(LAS v2u*)(s_ + OFF_KI + ro_) = kq_; } \
        if (tg == 0) *(LAS f32x4*)(s_ + OFF_SCL + 512 * HALF + 4 * ch0) = tot_; } while (0)
    const int last = nchunk - 1;
    SCAN_LOAD(0, qA, fA, vA);
    SCAN_LOAD(1, qB, fB, vB);
    SCAN_IMG(0, qA, fA, vA);
    SCAN_LOAD(2, qA, fA, vA);
    __syncthreads();
    for (int g = 0; g < nchunk; g += 2) {
        SCAN_IMG(1, qB, fB, vB);
        { const int gn = g + 3 < last ? g + 3 : last; SCAN_LOAD(gn, qB, fB, vB); }
        __syncthreads();
        SCAN_IMG(0, qA, fA, vA);
        { const int gn = g + 4 < last ? g + 4 : last; SCAN_LOAD(gn, qA, fA, vA); }
        __syncthreads();
    }
#undef SCAN_LOAD
#undef SCAN_IMG
}
__device__ __forceinline__ void scan_unit(LAS unsigned char* lds, bf16* PA, bf16* OC, const int b, const int h, const int dir, const bool ctxunit) {
    int tid_ = threadIdx.x; asm volatile("" : "+v"(tid_));
    const int tid = tid_, lane = tid & 63, w = __builtin_amdgcn_readfirstlane(tid >> 6);
    const int l15 = lane & 15, q = lane >> 4;
    const int nchunk = ctxunit ? 4 : 68;
    if (w >= 4) {
        if (w & 1) scan_producer<1>(lds, PA, b, h, dir, nchunk, w - 4, lane); else scan_producer<0>(lds, PA, b, h, dir, nchunk, w - 4, lane);
    } else {
        f32x4 S[2][8];
#pragma unroll
        for (int c = 0; c < 2; ++c)
#pragma unroll
            for (int kt = 0; kt < 8; ++kt) S[c][kt] = (f32x4){0.f, 0.f, 0.f, 0.f};
        const int vc0 = 32 * w, xq = q ^ l15;
        if (!ctxunit) PSTAMP_S(lds, 20);
        __syncthreads();
        for (int g = 0; g < nchunk; ++g) {
            const bool do_o = ctxunit || g >= 4;
            const LAS unsigned char* cs = lds + (g & 1) * SET_BYTES;
            if (g == 30) PSTAMP_S(lds, 22);
#pragma unroll
            for (int kt = 0; kt < 8; ++kt) { const f32x4 gm4 = *(const LAS f32x4*)(cs + OFF_SCL + (16 * kt + 4 * q) * 4); S[0][kt] *= gm4; S[1][kt] *= gm4; }
            if (do_o) {
                bf16x8 vp[2][2];
#pragma unroll
                for (int c = 0; c < 2; ++c) { const int r_ = vc0 + 8 * (l15 >> 2) + 4 * c + (l15 & 3), x_ = (r_ >> 2) & 7;
#pragma unroll
                    for (int js = 0; js < 2; ++js) { const int c1 = 4 * js + (q >> 1);
                        const bf16x4 lo = *(const LAS bf16x4*)(cs + OFF_VT + r_ * KT_RS + 16 * (c1 ^ x_) + 8 * (q & 1)), hi4 = *(const LAS bf16x4*)(cs + OFF_VT + r_ * KT_RS + 16 * ((c1 + 2) ^ x_) + 8 * (q & 1));
                        vp[c][js] = __builtin_shufflevector(lo, hi4, 0, 1, 2, 3, 4, 5, 6, 7); } }
                bf16x8 sf[2][4];
#pragma unroll
                for (int ks = 0; ks < 4; ++ks) {
#pragma unroll
                    for (int c = 0; c < 2; ++c) { const f32x4 s0 = S[c][2 * ks], s1 = S[c][2 * ks + 1];
                        v4u pk; pk.x = pk2(s0[0], s0[1]); pk.y = pk2(s0[2], s0[3]); pk.z = pk2(s1[0], s1[1]); pk.w = pk2(s1[2], s1[3]); sf[c][ks] = __builtin_bit_cast(bf16x8, pk); }
                }
#pragma unroll
                for (int it = 0; it < 4; ++it) {
                    bf16x8 qf[4];
#pragma unroll
                    for (int ks = 0; ks < 4; ++ks) qf[ks] = ld_qk(cs + OFF_QI, 16 * it + l15, ks, xq);
                    f32x4 O0 = (f32x4){0.f, 0.f, 0.f, 0.f}, O1 = O0;
#pragma unroll
                    for (int ks = 0; ks < 4; ++ks) { O0 = MFMA16(sf[0][ks], qf[ks], O0); O1 = MFMA16(sf[1][ks], qf[ks], O1); }
                    unsigned pt[4][2];
#pragma unroll
                    for (int jt = 0; jt < 4; ++jt) {
                        if (jt <= it) {
                            f32x4 a4 = (f32x4){0.f, 0.f, 0.f, 0.f};
#pragma unroll
                            for (int ks = 0; ks < 4; ++ks) a4 = MFMA16(ld_qk(cs + OFF_KI, 16 * jt + l15, ks, xq), qf[ks], a4);
                            if (jt == it) {
#pragma unroll
                                for (int r = 0; r < 4; ++r) a4[r] = (4 * q + r <= l15) ? a4[r] : 0.f;
                            }
                            pt[jt][0] = pk2(a4[0], a4[1]); pt[jt][1] = pk2(a4[2], a4[3]);
                        } else { pt[jt][0] = 0u; pt[jt][1] = 0u; }
                    }
                    { v4u bw; bw.x = pt[0][0]; bw.y = pt[0][1]; bw.z = pt[1][0]; bw.w = pt[1][1]; const bf16x8 bb = __builtin_bit_cast(bf16x8, bw);
                      O0 = MFMA16(vp[0][0], bb, O0); O1 = MFMA16(vp[1][0], bb, O1); }
                    if (it >= 2) { v4u bw; bw.x = pt[2][0]; bw.y = pt[2][1]; bw.z = pt[3][0]; bw.w = pt[3][1]; const bf16x8 bb = __builtin_bit_cast(bf16x8, bw);
                      O0 = MFMA16(vp[0][1], bb, O0); O1 = MFMA16(vp[1][1], bb, O1); }
                    const int row = tok_row(g, 16 * it + l15, b, dir);
                    bf16* dst = (g < 4) ? OC + (size_t)dir * MCTX * 512 + (size_t)(row - MLAT) * 512 + h * HD + vc0 + 8 * q
                                        : PA + (size_t)row * PA_LD + 512 + dir * 512 + h * HD + vc0 + 8 * q;
                    v4u wv; wv.x = pk2(O0[0], O0[1]); wv.y = pk2(O0[2], O0[3]); wv.z = pk2(O1[0], O1[1]); wv.w = pk2(O1[2], O1[3]);
                    *(v4u*)dst = wv;
                }
            }
            bf16x8 vt[2][2];
#pragma unroll
            for (int c = 0; c < 2; ++c) { const int r_ = vc0 + 8 * (l15 >> 2) + 4 * c + (l15 & 3), x_ = (r_ >> 2) & 7;
                vt[c][0] = *(const LAS bf16x8*)(cs + OFF_VT + r_ * KT_RS + 16 * (q ^ x_)); vt[c][1] = *(const LAS bf16x8*)(cs + OFF_VT + r_ * KT_RS + 16 * ((4 + q) ^ x_)); }
#pragma unroll
            for (int kt = 0; kt < 8; ++kt) {
                const f32x4 gem = *(const LAS f32x4*)(cs + OFF_SCL + 512 + (16 * kt + 4 * q) * 4);
                const int xk_ = (4 * kt + (l15 >> 2)) & 7;
                const bf16x8 k0 = *(const LAS bf16x8*)(cs + OFF_KT + (16 * kt + l15) * KT_RS + 16 * (q ^ xk_)), k1 = *(const LAS bf16x8*)(cs + OFF_KT + (16 * kt + l15) * KT_RS + 16 * ((4 + q) ^ xk_));
#pragma unroll
                for (int c = 0; c < 2; ++c) { f32x4 d4 = MFMA16(k0, vt[c][0], S[c][kt]); d4 = MFMA16(k1, vt[c][1], d4); S[c][kt] = gem * d4; }
            }
            if (g == 30) PSTAMP_S(lds, 23);
            __syncthreads();
            if (g == 30) PSTAMP_S(lds, 24);
        }
        if (!ctxunit) PSTAMP_S(lds, 21);
    }
}
}


namespace hy {
typedef short bf16x8 __attribute__((ext_vector_type(8)));
typedef short bf16x4 __attribute__((ext_vector_type(4)));
constexpr int CS = 16416;
constexpr int VPAD = 7;
constexpr int OFF_F = 0, OFF_V = 4 * CS, V_ROWS = (64 + VPAD + 7) * 8, LDS_END = OFF_V + V_ROWS * 128;
static_assert(LDS_END <= LDS_BYTES - 256, "hyena LDS");
struct ConvW { float x0[4], x1[4], v[4]; };
__device__ __forceinline__ ConvW load_convw(const Args& a, int l, int c) {
    const float* cw = a.in[11] + (size_t)l * 3 * 1536; const float* cb = a.in[12] + (size_t)l * 1536; ConvW r;
#pragma unroll
    for (int j = 0; j < 3; ++j) { r.x0[j] = cw[j * 1536 + c]; r.x1[j] = cw[j * 1536 + 512 + c]; r.v[j] = cw[j * 1536 + 1024 + c]; }
    r.x0[3] = cb[c]; r.x1[3] = cb[512 + c]; r.v[3] = cb[1024 + c];
    return r;
}
__device__ __forceinline__ void hyena_channel(LAS unsigned char* lds, const Args& a, const int l, const int c) {
    int tid_ = threadIdx.x; asm volatile("" : "+v"(tid_));
    const int tid = tid_, lane = tid & 63, w = __builtin_amdgcn_readfirstlane(tid >> 6), l15 = lane & 15, q = lane >> 4;
    unsigned char* ws = a.ws;
    const bf16* PB = (const bf16*)(ws + WS_PB);
    const bf16* x0r = PB + (size_t)c * MTOK; const bf16* x1r = PB + (size_t)(512 + c) * MTOK; const bf16* vr = PB + (size_t)(1024 + c) * MTOK; const bf16* gbr = PB + (size_t)(1536 + c) * MTOK;
    const ConvW cw = load_convw(a, l, c);
    PSTAMP_H(lds, 16);
    {
        const bf16* F = (const bf16*)(ws + WS_FG) + ((size_t)l * 512 + c) * FZ;
        for (int ch = tid; ch < 1024; ch += NTHR) {
            const v4u cur = *(const v4u*)(F + 8 * ch); v4u prev = *(const v4u*)(F + (ch > 0 ? 8 * ch - 8 : 0));
            if (ch == 0) prev = (v4u){0u, 0u, 0u, 0u};
            const unsigned W[8] = {prev.x, prev.y, prev.z, prev.w, cur.x, cur.y, cur.z, cur.w};
            v4u c1, c2, c3;
#pragma unroll
            for (int d = 0; d < 4; ++d) { c1[d] = (W[3 + d] >> 16) | (W[4 + d] << 16); c2[d] = W[3 + d]; c3[d] = (W[2 + d] >> 16) | (W[3 + d] << 16); }
            *(LAS v4u*)(lds + OFF_F + 0 * CS + 16 * ch) = cur;
            *(LAS v4u*)(lds + OFF_F + 1 * CS + 16 * ch) = c1;
            *(LAS v4u*)(lds + OFF_F + 2 * CS + 16 * ch) = c2;
            *(LAS v4u*)(lds + OFF_F + 3 * CS + 16 * ch) = c3;
        }
    }
    {
        for (int e = tid; e < VPAD * 8 * 32; e += NTHR) ((LAS unsigned*)(lds + OFF_V))[e] = 0u;
        for (int e = tid; e < 7 * 8 * 32; e += NTHR) ((LAS unsigned*)(lds + OFF_V + (64 + VPAD) * 8 * 128))[e] = 0u;
        for (int bt = 0; bt < 2; ++bt) {
            v4u vw[4], xw[4]; unsigned short hv[4][2], hx[4][2];
#pragma unroll
            for (int j = 0; j < 4; ++j) {
                const int e = tid + NTHR * (4 * bt + j), b = e >> 9, t0 = (e & 511) * 8;
                const size_t base = (size_t)b * LX + t0;
                const size_t bm = t0 > 0 ? base - 1 : base, bp = t0 + 8 < LX ? base + 8 : base;
                vw[j] = *(const v4u*)(vr + base); xw[j] = *(const v4u*)(x1r + base);
                hv[j][0] = vr[bm]; hv[j][1] = vr[bp]; hx[j][0] = x1r[bm]; hx[j][1] = x1r[bp];
            }
#pragma unroll
            for (int j = 0; j < 4; ++j) {
                const int e = tid + NTHR * (4 * bt + j), b = e >> 9, t0 = (e & 511) * 8, ab = t0 >> 6, ch = (t0 & 63) >> 3;
                float vv[10], xx[10];
                vv[0] = t0 > 0 ? bf2f(hv[j][0]) : 0.f; xx[0] = t0 > 0 ? bf2f(hx[j][0]) : 0.f;
                vv[9] = t0 + 8 < LX ? bf2f(hv[j][1]) : 0.f; xx[9] = t0 + 8 < LX ? bf2f(hx[j][1]) : 0.f;
#pragma unroll
                for (int d = 0; d < 4; ++d) { vv[1 + 2 * d] = bf2f((unsigned short)(vw[j][d] & 0xffffu)); vv[2 + 2 * d] = bf2f((unsigned short)(vw[j][d] >> 16));
                                              xx[1 + 2 * d] = bf2f((unsigned short)(xw[j][d] & 0xffffu)); xx[2 + 2 * d] = bf2f((unsigned short)(xw[j][d] >> 16)); }
                float p[8];
#pragma unroll
                for (int d = 0; d < 8; ++d) p[d] = (cw.v[3] + cw.v[0] * vv[d] + cw.v[1] * vv[d + 1] + cw.v[2] * vv[d + 2]) * (cw.x1[3] + cw.x1[0] * xx[d] + cw.x1[1] * xx[d + 1] + cw.x1[2] * xx[d + 2]);
                v4u o; o.x = pk2(p[0], p[1]); o.y = pk2(p[2], p[3]); o.z = pk2(p[4], p[5]); o.w = pk2(p[6], p[7]);
                const int R = (ab + VPAD) * 8 + b;
                *(LAS v4u*)(lds + OFF_V + R * 128 + 16 * (ch ^ ((R >> 1) & 7))) = o;
            }
        }
    }
    __syncthreads();
    PSTAMP_H(lds, 17);
    f32x4 acc[4][4];
#pragma unroll
    for (int mt = 0; mt < 4; ++mt)
#pragma unroll
        for (int nt = 0; nt < 4; ++nt) acc[mt][nt] = (f32x4){0.f, 0.f, 0.f, 0.f};
    {
        const LAS unsigned char* pa = lds + OFF_F + (l15 & 3) * CS + (4096 - 4 * (l15 >> 2) + 8 * q) * 2 - 96;
        const int rowl = (l15 >> 3) * 8 + (l15 & 7);
        const int cq = (q ^ (rowl >> 1)) & 7;
        const LAS unsigned char* vb0 = lds + OFF_V + rowl * 128 + (8 * w + VPAD) * 1024 + 16 * cq;
        const LAS unsigned char* vb1 = lds + OFF_V + rowl * 128 + (8 * w + VPAD) * 1024 + 16 * (cq ^ 4);
#define HY_LDA(An_, m_) do { const LAS unsigned char* p_ = pa - 128 * (m_); _Pragma("unroll") for (int mt = 0; mt < 4; ++mt) { \
            const bf16x4 lo_ = *(const LAS bf16x4*)(p_ + 32 * (3 - mt)), hi_ = *(const LAS bf16x4*)(p_ + 32 * (3 - mt) + 8); An_[mt] = __builtin_shufflevector(lo_, hi_, 0, 1, 2, 3, 4, 5, 6, 7); } } while (0)
#define HY_LDB(B_, m_, PAR_) do { const LAS unsigned char* p0_ = ((PAR_) ? vb1 : vb0) - 1024 * (m_); const LAS unsigned char* p1_ = ((PAR_) ? vb0 : vb1) - 1024 * (m_); \
            _Pragma("unroll") for (int nt = 0; nt < 4; ++nt) { B_[0][nt] = *(const LAS bf16x8*)(p0_ + 2048 * nt); B_[1][nt] = *(const LAS bf16x8*)(p1_ + 2048 * nt); } } while (0)
#define HY_MMA(An_, Ao0_, Ao1_, B_, m_) do { _Pragma("unroll") for (int nt = 0; nt < 4; ++nt) { const int a0_ = 8 * w + 2 * nt - (m_); if (a0_ + 1 >= 0 && a0_ <= 63) { \
            _Pragma("unroll") for (int mt = 0; mt < 4; ++mt) acc[mt][nt] = __builtin_amdgcn_mfma_f32_16x16x32_bf16(An_[mt], B_[0][nt], acc[mt][nt], 0, 0, 0); \
            acc[0][nt] = __builtin_amdgcn_mfma_f32_16x16x32_bf16(Ao0_, B_[1][nt], acc[0][nt], 0, 0, 0); acc[1][nt] = __builtin_amdgcn_mfma_f32_16x16x32_bf16(Ao1_, B_[1][nt], acc[1][nt], 0, 0, 0); \
            acc[2][nt] = __builtin_amdgcn_mfma_f32_16x16x32_bf16(An_[0], B_[1][nt], acc[2][nt], 0, 0, 0); acc[3][nt] = __builtin_amdgcn_mfma_f32_16x16x32_bf16(An_[1], B_[1][nt], acc[3][nt], 0, 0, 0); } } } while (0)
        bf16x8 Aa[4], Ab[4], Ba[2][4], Bb[2][4], o0, o1;
        const int m0 = 8 * w - 63, mlast = 8 * w + 7;
        { bf16x8 t_[4]; HY_LDA(t_, m0 - 1); o0 = t_[2]; o1 = t_[3]; }
        HY_LDA(Aa, m0); HY_LDB(Ba, m0, 0);
        for (int m = m0; m < mlast; m += 2) {
            HY_LDA(Ab, m + 1); HY_LDB(Bb, m + 1, 1);
            HY_MMA(Aa, o0, o1, Ba, m);
            o0 = Aa[2]; o1 = Aa[3];
            HY_LDA(Aa, m + 2); HY_LDB(Ba, m + 2, 0);
            HY_MMA(Ab, o0, o1, Bb, m + 1);
            o0 = Ab[2]; o1 = Ab[3];
        }
        HY_MMA(Aa, o0, o1, Ba, mlast);
#undef HY_LDA
#undef HY_LDB
#undef HY_MMA
    }
    PSTAMP_H(lds, 18);
    __syncthreads();
    {
        constexpr int YRS = 8208;
        const float inn = 1.0f / ((const float*)(ws + WS_CTL))[CW_NORM + l * 512 + c], hb = a.in[21][l * 512 + c];
        const int b = l15 & 7;
#pragma unroll
        for (int nt = 0; nt < 4; ++nt) {
            const int ab = 8 * w + 2 * nt + (l15 >> 3), R = (ab + VPAD) * 8 + b;
#pragma unroll
            for (int mt = 0; mt < 4; ++mt) {
                const int t = 64 * ab + 16 * mt + 4 * q;
                const v2u vw = *(const LAS v2u*)(lds + OFF_V + R * 128 + 16 * ((2 * mt + (q >> 1)) ^ ((R >> 1) & 7)) + 8 * (q & 1));
                const float y0 = acc[mt][nt][0] * inn + bf2f((unsigned short)(vw.x & 0xffffu)) * hb, y1 = acc[mt][nt][1] * inn + bf2f((unsigned short)(vw.x >> 16)) * hb;
                const float y2 = acc[mt][nt][2] * inn + bf2f((unsigned short)(vw.y & 0xffffu)) * hb, y3 = acc[mt][nt][3] * inn + bf2f((unsigned short)(vw.y >> 16)) * hb;
                v2u yw; yw.x = pk2(y0, y1); yw.y = pk2(y2, y3);
                *(LAS v2u*)(lds + OFF_F + b * YRS + 2 * t) = yw;
            }
        }
        __syncthreads();
        bf16* OBT = (bf16*)(ws + WS_OBT) + (size_t)c * MTOK;
        int tid2 = tid; asm volatile("" : "+v"(tid2));
        for (int bt = 0; bt < 4; ++bt) {
            v4u xw[2], gw[2]; unsigned short hx[2][2];
#pragma unroll
            for (int j = 0; j < 2; ++j) {
                const int e = tid2 + NTHR * (2 * bt + j), bb = e >> 9, t0 = (e & 511) * 8;
                const size_t base = (size_t)bb * LX + t0;
                xw[j] = *(const v4u*)(x0r + base); gw[j] = *(const v4u*)(gbr + base);
                hx[j][0] = x0r[t0 > 0 ? base - 1 : base]; hx[j][1] = x0r[t0 + 8 < LX ? base + 8 : base];
            }
#pragma unroll
            for (int j = 0; j < 2; ++j) {
                const int e = tid2 + NTHR * (2 * bt + j), bb = e >> 9, t0 = (e & 511) * 8;
                const size_t base = (size_t)bb * LX + t0;
                const v4u yw = *(const LAS v4u*)(lds + OFF_F + bb * YRS + 2 * t0);
                float xs[10], o[8];
                xs[0] = t0 > 0 ? bf2f(hx[j][0]) : 0.f; xs[9] = t0 + 8 < LX ? bf2f(hx[j][1]) : 0.f;
#pragma unroll
                for (int d = 0; d < 4; ++d) { xs[1 + 2 * d] = bf2f((unsigned short)(xw[j][d] & 0xffffu)); xs[2 + 2 * d] = bf2f((unsigned short)(xw[j][d] >> 16)); }
#pragma unroll
                for (int d = 0; d < 8; ++d) {
                    const float yv = bf2f((unsigned short)((d & 1) ? (yw[d >> 1] >> 16) : (yw[d >> 1] & 0xffffu)));
                    const float gv = bf2f((unsigned short)((d & 1) ? (gw[j][d >> 1] >> 16) : (gw[j][d >> 1] & 0xffffu)));
                    o[d] = yv * (cw.x0[3] + cw.x0[0] * xs[d] + cw.x0[1] * xs[d + 1] + cw.x0[2] * xs[d + 2]) * silu_f(gv);
                }
                v4u ow; ow.x = pk2(o[0], o[1]); ow.y = pk2(o[2], o[3]); ow.z = pk2(o[4], o[5]); ow.w = pk2(o[6], o[7]);
                *(v4u*)(OBT + base) = ow;
            }
        }
    }
    PSTAMP_H(lds, 19);
    __syncthreads();
}
__device__ __forceinline__ void hyena_ctx_channel(LAS unsigned char* lds, const Args& a, const int c) {
    int tid_ = threadIdx.x; asm volatile("" : "+v"(tid_));
    const int tid = tid_;
    unsigned char* ws = a.ws;
    const bf16* PB = (const bf16*)(ws + WS_PB);
    const bf16* x0r = PB + (size_t)c * MTOK + MLAT; const bf16* x1r = PB + (size_t)(512 + c) * MTOK + MLAT; const bf16* vr = PB + (size_t)(1024 + c) * MTOK + MLAT; const bf16* gbr = PB + (size_t)(1536 + c) * MTOK + MLAT;
    const ConvW cw = load_convw(a, 0, c);
    LAS float* vvc = (LAS float*)lds;
    LAS float* Fc = vvc + 2048;
    for (int e = tid; e < 2048; e += NTHR) {
        const int t = e & 255;
        const float vm_ = bf2f(vr[t > 0 ? e - 1 : e]), v0 = bf2f(vr[e]), vp_ = bf2f(vr[t < 255 ? e + 1 : e]);
        const float xm_ = bf2f(x1r[t > 0 ? e - 1 : e]), x0 = bf2f(x1r[e]), xp_ = bf2f(x1r[t < 255 ? e + 1 : e]);
        const float vm = t > 0 ? vm_ : 0.f, vp = t < 255 ? vp_ : 0.f, xm = t > 0 ? xm_ : 0.f, xp = t < 255 ? xp_ : 0.f;
        vvc[e] = (cw.v[3] + cw.v[0] * vm + cw.v[1] * v0 + cw.v[2] * vp) * (cw.x1[3] + cw.x1[0] * xm + cw.x1[1] * x0 + cw.x1[2] * xp);
    }
    if (tid < 520) Fc[tid] = tid < 512 ? bf2f(((const bf16*)(ws + WS_FGC))[(size_t)c * FZC + tid]) : 0.f;
    __syncthreads();
    const float inn = 1.0f / ((const float*)(ws + WS_CTL))[CW_NORM + 2 * 512 + c], hb = a.in[21][c];
    bf16* OBT = (bf16*)(ws + WS_OBT) + (size_t)c * MTOK + MLAT;
    {
        const int b = tid >> 6, t0 = 4 * (tid & 63), e0 = b * 256 + t0;
        float acc4[4] = {0.f, 0.f, 0.f, 0.f};
        const LAS float* fp = Fc + 252 - t0;
        for (int s4 = 0; s4 < 64; ++s4) {
            const f32x4 ga = *(const LAS f32x4*)(fp + 4 * s4), gb = *(const LAS f32x4*)(fp + 4 * s4 + 4), vq = *(const LAS f32x4*)(vvc + b * 256 + 4 * s4);
            const float g[8] = {ga[0], ga[1], ga[2], ga[3], gb[0], gb[1], gb[2], gb[3]};
#pragma unroll
            for (int i = 0; i < 4; ++i)
#pragma unroll
                for (int u = 0; u < 4; ++u) acc4[i] += g[4 - i + u] * vq[u];
        }
        float xs[6], gv[4];
        xs[0] = t0 > 0 ? bf2f(x0r[e0 - 1]) : 0.f;
#pragma unroll
        for (int i = 0; i < 4; ++i) { xs[1 + i] = bf2f(x0r[e0 + i]); gv[i] = bf2f(gbr[e0 + i]); }
        xs[5] = t0 + 4 < 256 ? bf2f(x0r[e0 + 4]) : 0.f;
        float o[4];
#pragma unroll
        for (int i = 0; i < 4; ++i) o[i] = (acc4[i] * inn + vvc[e0 + i] * hb) * (cw.x0[3] + cw.x0[0] * xs[i] + cw.x0[1] * xs[i + 1] + cw.x0[2] * xs[i + 2]) * silu_f(gv[i]);
        v2u ow; ow.x = pk2(o[0], o[1]); ow.y = pk2(o[2], o[3]);
        *(v2u*)(OBT + e0) = ow;
    }
    __syncthreads();
}
}


__device__ __forceinline__ void phase_mix(const Args& a, Frame& F, const int l, const int part = -1) {
    unsigned* qctr = (unsigned*)(a.ws + WS_CTL) + CW_QUEUE + 64 * l + (part == 1 ? 128 : 0);
    volatile LAS int* slot = (volatile LAS int*)(F.lds + LDS_BYTES - 64);
    const int ntasks = l == 0 ? 64 + 512 + 64 + 512 : 64 + 512;
    for (;;) {
        if (F.tid == 0) slot[0] = (int)atomicAdd(qctr, 1u);
        __syncthreads();
        const int t = __builtin_amdgcn_readfirstlane(slot[0]);
        __syncthreads();
        if (t >= ntasks) break;
        if (part == 0 && !(t < 64 || (t >= 576 && t < 640))) continue;
        if (part == 1 && (t < 64 || (t >= 576 && t < 640))) continue;
        if (t < 64) scan::scan_unit(F.lds, (bf16*)(a.ws + WS_PA), (bf16*)(a.ws + WS_OC), t >> 3, (t >> 1) & 3, t & 1, false);
        else if (t < 576) hy::hyena_channel(F.lds, a, l, t - 64);
        else if (t < 640) { const int u = t - 576; scan::scan_unit(F.lds, (bf16*)(a.ws + WS_PA), (bf16*)(a.ws + WS_OC), u >> 3, (u >> 1) & 3, u & 1, true); }
        else hy::hyena_ctx_channel(F.lds, a, t - 640);
        __syncthreads();
    }
}

__device__ __forceinline__ void phase_finalize_ox(const Args& a, Frame& F, int l) {
    unsigned char* ws = a.ws;
    const bf16* PA = (const bf16*)(ws + WS_PA);
    const bf16* OC = (const bf16*)(ws + WS_OC);
    bf16* XA = (bf16*)(ws + WS_XA);
    const float* gnw = a.in[10] + l * 512;
    const int gw = F.vcu * NWAVES + F.wave, NGW = F.G * NWAVES;
    const int ntok = (l == 0) ? MTOK : MLAT;
    for (int tok = gw; tok < ntok; tok += NGW) {
        const bool isctx = tok >= MLAT;
        const int c8 = 8 * F.lane;
        const bf16* pf = isctx ? OC + (size_t)(tok - MLAT) * 512 + c8 : PA + (size_t)tok * PA_LD + 512 + c8;
        const bf16* pb = isctx ? OC + (size_t)MCTX * 512 + (size_t)(tok - MLAT) * 512 + c8 : PA + (size_t)tok * PA_LD + 1024 + c8;
        const v4u wf = *(const v4u*)pf, wb = *(const v4u*)pb, wg = *(const v4u*)(PA + (size_t)tok * PA_LD + 2048 + c8);
        float o[8], g[8];
#pragma unroll
        for (int e = 0; e < 4; ++e) {
            o[2 * e] = bf2f((unsigned short)(wf[e] & 0xffff)) + bf2f((unsigned short)(wb[e] & 0xffff));
            o[2 * e + 1] = bf2f((unsigned short)(wf[e] >> 16)) + bf2f((unsigned short)(wb[e] >> 16));
            g[2 * e] = bf2f((unsigned short)(wg[e] & 0xffff)); g[2 * e + 1] = bf2f((unsigned short)(wg[e] >> 16));
        }
        float s = 0.f;
#pragma unroll
        for (int e = 0; e < 8; ++e) s += o[e] * o[e];
        s += __shfl_xor(s, 1); s += __shfl_xor(s, 2); s += __shfl_xor(s, 4); s += __shfl_xor(s, 8);
        const float rstd = 1.0f / sqrtf(s * (1.0f / HD) + EPS);
        float y[8];
#pragma unroll
        for (int e = 0; e < 8; ++e) y[e] = o[e] * rstd * gnw[c8 + e] * silu_f(g[e]);
        v4u w; w.x = pk2(y[0], y[1]); w.y = pk2(y[2], y[3]); w.z = pk2(y[4], y[5]); w.w = pk2(y[6], y[7]);
        *(v4u*)(XA + (size_t)tok * D + c8) = w;
    }
    LAS unsigned short* t = (LAS unsigned short*)(F.lds + F.wave * 16384);
    const int ntt = ntok / 64;
    for (int it = gw; it < 8 * ntt; it += NGW) {
        const int ct = it / ntt, tt = it % ntt, c0 = ct * 64, t0 = tt * 64;
        const bf16* OBT = (const bf16*)(ws + WS_OBT);
#pragma unroll
        for (int i = 0; i < 8; ++i) {
            const int e = F.lane + 64 * i, c = e >> 3, ch = e & 7;
            const v4u w = *(const v4u*)(OBT + (size_t)(c0 + c) * MTOK + t0 + 8 * ch);
#pragma unroll
            for (int q = 0; q < 4; ++q) { t[c * 66 + 8 * ch + 2 * q] = (unsigned short)(w[q] & 0xffff); t[c * 66 + 8 * ch + 2 * q + 1] = (unsigned short)(w[q] >> 16); }
        }
        asm volatile("s_waitcnt lgkmcnt(0)" ::: "memory");
#pragma unroll
        for (int i = 0; i < 8; ++i) {
            const int e = F.lane + 64 * i, tk = e >> 3, cg = e & 7;
            unsigned short h[8];
#pragma unroll
            for (int q = 0; q < 8; ++q) h[q] = t[(8 * cg + q) * 66 + tk];
            v4u w; w.x = h[0] | ((unsigned)h[1] << 16); w.y = h[2] | ((unsigned)h[3] << 16); w.z = h[4] | ((unsigned)h[5] << 16); w.w = h[6] | ((unsigned)h[7] << 16);
            *(v4u*)(XA + (size_t)(t0 + tk) * D + 512 + c0 + 8 * cg) = w;
        }
        asm volatile("s_waitcnt lgkmcnt(0)" ::: "memory");
    }
}

__device__ __forceinline__ void phase_final_norm(const Args& a, Frame& F) {
    const float* w = a.in[22];
    const bf16* DL = (const bf16*)(a.ws + WS_PB);
    const int gw = F.vcu * NWAVES + F.wave, NGW = F.G * NWAVES;
    for (int tok = gw; tok < MLAT; tok += NGW) {
        float* xr = a.out + (size_t)tok * D;
        f32x4 v[4]; float s = 0.f;
#pragma unroll
        for (int j = 0; j < 4; ++j) { v[j] = *(const f32x4*)(xr + 256 * j + 4 * F.lane); const v2u dw = *(const v2u*)(DL + (size_t)tok * D + 256 * j + 4 * F.lane);
            v[j].x += bf2f((unsigned short)(dw.x & 0xffffu)); v[j].y += bf2f((unsigned short)(dw.x >> 16)); v[j].z += bf2f((unsigned short)(dw.y & 0xffffu)); v[j].w += bf2f((unsigned short)(dw.y >> 16));
            s += (v[j].x * v[j].x + v[j].y * v[j].y) + (v[j].z * v[j].z + v[j].w * v[j].w); }
        const float rstd = 1.0f / sqrtf(wave_sum(s) * (1.0f / D) + EPS);
#pragma unroll
        for (int j = 0; j < 4; ++j) { const f32x4 w4 = *(const f32x4*)(w + 256 * j + 4 * F.lane); *(f32x4*)(xr + 256 * j + 4 * F.lane) = v[j] * rstd * w4; }
    }
}

enum { PH_PRO = 0, PH_NORM0 = 1, PH_IN0 = 2, PH_MIX0 = 3, PH_FIN0 = 4, PH_OUT0 = 5, PH_NORM1 = 6, PH_IN1 = 7, PH_MIX1 = 8, PH_FIN1 = 9, PH_OUT1 = 10, PH_FINAL = 11 };

__device__ __forceinline__ Frame mkframe(unsigned char* lds) {
    Frame F;
    F.lds = (LAS unsigned char*)lds;
    F.tid = threadIdx.x; F.lane = F.tid & 63; F.wave = __builtin_amdgcn_readfirstlane(F.tid >> 6);
    F.G = gridDim.x; { const int bx = blockIdx.x; F.vcu = (F.G % 8 == 0) ? (bx % 8) * (F.G / 8) + bx / 8 : bx; }
    return F;
}
template <int l> __device__ __forceinline__ void run_inproj(const Args& args, unsigned char* lds) {
    unsigned char* ws = args.ws; Frame F = mkframe(lds);
    pg8::Gemm g{(const bf16*)(ws + WS_XA), (const bf16*)(ws + WS_WIN) + (size_t)l * NIN * D, D};
    pg8::Sched S; S.init(128, 18, F.G, (int)blockIdx.x, 8, l == 0 ? 18 : 8);
    EpiIn E{(bf16*)(ws + WS_PA), (bf16*)(ws + WS_PB), (const float*)(ws + WS_LBS) + l * 1024};
    pg8::gemm_phase<EpiIn, true, true>(F.lds, g, S, E);
}
template <int l> __device__ __forceinline__ void run_outproj(const Args& args, unsigned char* lds) {
    unsigned char* ws = args.ws; Frame F = mkframe(lds);
    pg8::Gemm g{(const bf16*)(ws + WS_XA), (const bf16*)(ws + WS_WOUT) + (size_t)l * D * D, D};
    pg8::Sched S; S.init(128, 4, F.G, (int)blockIdx.x, l == 0 ? 8 : 0, 4);
    EpiOut E{(bf16*)(ws + WS_PB), (const float*)(ws + WS_MOD) + (size_t)l * 9 * 3 * D};
    pg8::gemm_phase<EpiOut, true, true>(F.lds, g, S, E);
}
__global__ void __launch_bounds__(NTHR, 2) mega(Args args) {
    extern __shared__ __attribute__((aligned(16))) unsigned char lds[];
    const int lo = args.ph_lo, hi = args.ph_hi;
#define IN(k) (lo <= (k) && (k) < hi)
    volatile LAS unsigned* bst = (volatile LAS unsigned*)((LAS unsigned char*)lds + LDS_BYTES - 32);
    if (threadIdx.x < 8) ((volatile LAS unsigned*)((LAS unsigned char*)lds + LDS_BYTES - 32))[threadIdx.x] = 0u;
    __syncthreads();
    XcdBarrier bar; bar.bar = (unsigned*)(args.ws + WS_CTL) + CW_BAR; bar.x = 0; bar.st = bst;
    if (hi - lo > 1) bar = xcd_barrier_post((unsigned*)(args.ws + WS_CTL) + CW_BAR, bst);
#ifdef PROBE_ID
    volatile LAS unsigned long long* pts = (volatile LAS unsigned long long*)((LAS unsigned char*)lds + LDS_BYTES - 512);
    if (threadIdx.x == 0) pts[0] = __builtin_amdgcn_s_memrealtime();
#define SEAM(k) do { if (IN((k) + 1)) xcd_barrier(bar); else __syncthreads(); if (threadIdx.x == 0) pts[(k) + 1] = __builtin_amdgcn_s_memrealtime(); } while (0)
#else
#define SEAM(k) do { if (IN((k) + 1)) xcd_barrier(bar); else __syncthreads(); } while (0)
#endif
    if (IN(PH_PRO)) { Frame F = mkframe(lds); phase_prologue(args, F); SEAM(PH_PRO); }
    if (IN(PH_NORM0)) { Frame F = mkframe(lds); phase_normrows(args, F, 0, args.in[0], args.in[2]); SEAM(PH_NORM0); }
    if (IN(PH_IN0)) { run_inproj<0>(args, lds); { Frame F = mkframe(lds); phase_filters_l0(args, F); } SEAM(PH_IN0); }
#ifdef SPLIT_MIX
    if (IN(PH_MIX0)) { Frame F = mkframe(lds); phase_mix(args, F, 0, 0); xcd_barrier(bar); if (threadIdx.x == 0) pts[15] = __builtin_amdgcn_s_memrealtime(); phase_mix(args, F, 0, 1); SEAM(PH_MIX0); }
#else
    if (IN(PH_MIX0)) { Frame F = mkframe(lds); phase_mix(args, F, 0); SEAM(PH_MIX0); }
#endif
    if (IN(PH_FIN0)) { Frame F = mkframe(lds); phase_finalize_ox(args, F, 0); SEAM(PH_FIN0); }
    if (IN(PH_OUT0)) { run_outproj<0>(args, lds); { Frame F = mkframe(lds); phase_filters_l1(args, F); } SEAM(PH_OUT0); }
    if (IN(PH_NORM1)) { Frame F = mkframe(lds); phase_normrows(args, F, 1, args.in[0], args.in[2]); SEAM(PH_NORM1); }
    if (IN(PH_IN1)) { run_inproj<1>(args, lds); SEAM(PH_IN1); }
    if (IN(PH_MIX1)) { Frame F = mkframe(lds); phase_mix(args, F, 1); SEAM(PH_MIX1); }
    if (IN(PH_FIN1)) { Frame F = mkframe(lds); phase_finalize_ox(args, F, 1); SEAM(PH_FIN1); }
    if (IN(PH_OUT1)) { run_outproj<1>(args, lds); SEAM(PH_OUT1); }
    if (IN(PH_FINAL)) { Frame F = mkframe(lds); phase_final_norm(args, F); SEAM(PH_FINAL); }
#ifdef PROBE_ID
    if (blockIdx.x == 0 && threadIdx.x == 0) {
#ifdef SPLIT_MIX
        const unsigned long long dt = (PROBE_ID == 100) ? pts[15] - pts[PH_MIX0] : pts[PH_MIX0 + 1] - pts[15];
#else
        const unsigned long long dt = (PROBE_ID >= 200) ? ((PROBE_ID == 220 || PROBE_ID >= 226) ? 1ull : 16ull) * (pts[PROBE_ID - 200 + 1] - pts[PROBE_ID - 200]) : pts[PROBE_ID + 1] - pts[PROBE_ID];
#endif
        const unsigned long long t0 = __builtin_amdgcn_s_memrealtime();
        unsigned long long wt = 4ull * dt; if (wt > 300000ull) wt = 300000ull;
        while (__builtin_amdgcn_s_memrealtime() - t0 < wt) __builtin_amdgcn_s_sleep(8);
    }
#endif
#undef IN
#undef SEAM
}

extern "C" void kernel_launch(void* const* d_in, const int* in_sizes, int n_in, void* d_out, int out_size, void* d_ws, size_t ws_size, hipStream_t stream) {
    static int grid = 0;
    if (grid == 0) {
        if (n_in != 23 || ws_size < WS_END) { fprintf(stderr, "kernel_launch: unexpected n_in %d / ws_size %zu\n", n_in, ws_size); grid = -1; return; }
        int dev = 0, cus = 0;
        if (hipGetDevice(&dev) != hipSuccess || hipDeviceGetAttribute(&cus, hipDeviceAttributeMultiprocessorCount, dev) != hipSuccess) { grid = -1; return; }
        if (hipFuncSetAttribute((const void*)mega, hipFuncAttributeMaxDynamicSharedMemorySize, LDS_BYTES) != hipSuccess) { fprintf(stderr, "kernel_launch: hipFuncSetAttribute failed\n"); grid = -1; return; }
        grid = cus;
    }
    if (grid < 0) return;
    (void)hipMemsetAsync((char*)d_ws + WS_CTL, 0, CTL_ZERO_BYTES, stream);
    Args a{};
    for (int i = 0; i < 23; ++i) a.in[i] = (const float*)d_in[i];
    a.out = (float*)d_out; a.ws = (unsigned char*)d_ws;
    a.ph_lo = 0; a.ph_hi = PH_FINAL + 1;
    hipLaunchKernelGGL(mega, dim3(grid), dim3(NTHR), LDS_BYTES, stream, a);
}
```

```cpp
#include <hip/hip_runtime.h>
#include <cstdio>
#include <cstdint>
#include <math.h>

namespace pg8 {
#define PG8_LAS __attribute__((address_space(3)))
typedef unsigned short bf16_t;
typedef short bf16x8 __attribute__((ext_vector_type(8)));
typedef float f32x4 __attribute__((ext_vector_type(4)));
typedef unsigned u32x4 __attribute__((ext_vector_type(4)));
typedef unsigned u32x2 __attribute__((ext_vector_type(2)));
constexpr int BM = 256, BK = 64, HALF = 128, HTB = HALF * BK * 2, STAGE_BYTES = 8 * HTB, NXCD = 8, WGM = 8;

__host__ __device__ __forceinline__ int lds_byte(int r, int c) { const int st = (r >> 4) * 2 + (c >> 5), rr = r & 15, cc = c & 31, ob = rr * 64 + cc * 2; return st * 1024 + (ob ^ (((ob >> 9) & 1) << 5)); }
__host__ __device__ __forceinline__ void stage_rc(int b, int& R, int& C) { const int st = b / 1024, sb = b % 1024, swz = sb ^ (((sb >> 9) & 1) << 5); R = (st >> 1) * 16 + swz / 64; C = (st & 1) * 32 + (swz % 64) / 2; }
__host__ __device__ __forceinline__ int perm32(int rho) { const int n = rho >> 4, i = rho & 15; return 8 * (i >> 2) + 4 * n + (i & 3); }

struct Unit { int pm, pn; };
struct Gemm { const bf16_t* A; const bf16_t* Bt; int K; };

struct Sched {
    int nM, nN, nwg, G, c, nctx, nctxN;
    __device__ void init(int nM_, int nN_, int G_, int c_, int nctxM, int nctxN_) { nM = nM_; nN = nN_; nwg = nM * nN; G = G_; c = c_; nctx = nctxM * nctxN_; nctxN = nctxN_ > 0 ? nctxN_ : 1; }
    __device__ bool next(int i, Unit& u) const {
        const long L = (long)i * G + c;
        if (L >= nwg) { const long L2 = L - nwg; if (L2 >= nctx) return false; u.pm = nM + (int)(L2 / nctxN); u.pn = (int)(L2 % nctxN); return true; }
        int wgid = (int)L; { const int q = nwg / NXCD, r = nwg % NXCD, xcd = wgid % NXCD, off = wgid / NXCD; wgid = (xcd < r ? xcd * (q + 1) : r * (q + 1) + (xcd - r) * q) + off; }
        const int nig = WGM * nN, gid = wgid / nig, fm = gid * WGM, gsz = (nM - fm) < WGM ? (nM - fm) : WGM;
        u.pm = fm + ((wgid % nig) % gsz); u.pn = (wgid % nig) / gsz; return true;
    }
};

template <class Epi, bool ALIGN_EPI, bool SP2>
__device__ __forceinline__ void gemm_phase(PG8_LAS unsigned char* lds, const Gemm g, const Sched& S, const Epi& E) {
    const int tid = threadIdx.x, wid = __builtin_amdgcn_readfirstlane(tid >> 6), lane = tid & 63, wr = wid >> 2, wc = wid & 3, fr = lane & 15, fq = lane >> 4;
    const int K = g.K, nt = K / BK;
    unsigned voffA[2], voffB[2];
#pragma unroll
    for (int i = 0; i < 2; ++i) { int R, C; stage_rc(tid * 16 + i * 8192, R, C); const int Rb = Epi::PERM ? ((R & ~31) + perm32(R & 31)) : R;
        voffA[i] = (unsigned)(R * K + C) * 2u; voffB[i] = (unsigned)(Rb * K + C) * 2u; }
    const size_t kstep = (size_t)(BK * 2);
    const size_t hstep = (size_t)HALF * K * 2;
    const size_t tstep = 2 * hstep;
    const unsigned ldsw = (unsigned)wid * 1024u;
    const int aoff = lds_byte(wr * 64 + fr, fq * 8), boff = lds_byte(wc * 32 + fr, fq * 8);
#define PG8_SA(b, h) (((b) * 2 + (h)) * HTB)
#define PG8_SB(b, h) ((4 + (b) * 2 + (h)) * HTB)
#define PG8_STAGE(bufoff, gbase, voff) do { _Pragma("unroll") for (int _i = 0; _i < 2; ++_i) \
        __builtin_amdgcn_global_load_lds((const unsigned*)((const char*)(gbase) + (voff)[_i]), (PG8_LAS unsigned*)(lds + (bufoff) + ldsw + _i * 8192), 16, 0, 0); } while (0)
#define PG8_LDA(dst, b, h) do { _Pragma("unroll") for (int m = 0; m < 4; ++m) _Pragma("unroll") for (int k = 0; k < 2; ++k) dst[m][k] = *(const PG8_LAS bf16x8*)(lds + PG8_SA(b, h) + aoff + m * 2048 + k * 1024); } while (0)
#define PG8_LDB(dst, b, h) do { _Pragma("unroll") for (int n = 0; n < 2; ++n) _Pragma("unroll") for (int k = 0; k < 2; ++k) dst[n][k] = *(const PG8_LAS bf16x8*)(lds + PG8_SB(b, h) + boff + n * 2048 + k * 1024); } while (0)
#define PG8_MMA(ai, bj, At, Bt) do { __builtin_amdgcn_s_setprio(1); _Pragma("unroll") for (int m = 0; m < 4; ++m) _Pragma("unroll") for (int n = 0; n < 2; ++n) _Pragma("unroll") for (int k = 0; k < 2; ++k) \
        acc[ai][bj][m][n] = __builtin_amdgcn_mfma_f32_16x16x32_bf16(Bt[n][k], At[m][k], acc[ai][bj][m][n], 0, 0, 0); __builtin_amdgcn_s_setprio(0); } while (0)
#define PG8_WAIT_V(n) asm volatile("s_waitcnt vmcnt(" #n ")" ::: "memory")
#define PG8_WAIT_L(n) asm volatile("s_waitcnt lgkmcnt(" #n ")" ::: "memory")
#define PG8_BAR __builtin_amdgcn_s_barrier()
#define PG8_SCHED __builtin_amdgcn_sched_barrier(0)
    Unit cur, nxt; int ui = 0;
    if (!S.next(0, cur)) return;
    f32x4 acc[2][2][4][2];
#pragma unroll
    for (int a = 0; a < 2; ++a)
#pragma unroll
        for (int b = 0; b < 2; ++b)
#pragma unroll
            for (int m = 0; m < 4; ++m)
#pragma unroll
                for (int n = 0; n < 2; ++n) acc[a][b][m][n] = (f32x4){0.f, 0.f, 0.f, 0.f};
    bf16x8 At[4][2], B0[2][2], B1[2][2];
    const char* cA = E.swap(cur) ? (const char*)g.Bt + (size_t)cur.pn * tstep : (const char*)g.A + (size_t)cur.pm * tstep;
    const char* cB = E.swap(cur) ? (const char*)g.A + (size_t)cur.pm * tstep : (const char*)g.Bt + (size_t)cur.pn * tstep;
    if constexpr (SP2) {
        PG8_STAGE(PG8_SB(0, 0), cB, voffB); PG8_STAGE(PG8_SB(0, 1), cB + hstep, voffB); PG8_STAGE(PG8_SA(0, 0), cA, voffA); PG8_STAGE(PG8_SA(0, 1), cA + hstep, voffA);
        if (wr == 1) PG8_BAR;
        PG8_WAIT_V(2); PG8_BAR;
        PG8_STAGE(PG8_SB(1, 0), cB + kstep, voffB); PG8_STAGE(PG8_SA(1, 0), cA + kstep, voffA); PG8_STAGE(PG8_SB(1, 1), cB + hstep + kstep, voffB);
        PG8_WAIT_V(6); PG8_BAR;
    } else {
        PG8_STAGE(PG8_SB(0, 0), cB, voffB); PG8_STAGE(PG8_SA(0, 0), cA, voffA); PG8_STAGE(PG8_SB(0, 1), cB + hstep, voffB); PG8_STAGE(PG8_SA(0, 1), cA + hstep, voffA);
        if (wr == 1) PG8_BAR;
        PG8_WAIT_V(4); PG8_BAR;
        PG8_STAGE(PG8_SB(1, 0), cB + kstep, voffB); PG8_STAGE(PG8_SA(1, 0), cA + kstep, voffA); PG8_STAGE(PG8_SB(1, 1), cB + hstep + kstep, voffB);
        PG8_WAIT_V(6); PG8_BAR;
    }
    for (;;) {
        const bool has_next = S.next(ui + 1, nxt);
        const bool nsw = has_next && E.swap(nxt);
        const char* nA = has_next ? (nsw ? (const char*)g.Bt + (size_t)nxt.pn * tstep : (const char*)g.A + (size_t)nxt.pm * tstep) : cA;
        const char* nB = has_next ? (nsw ? (const char*)g.A + (size_t)nxt.pm * tstep : (const char*)g.Bt + (size_t)nxt.pn * tstep) : cB;
        for (int t = 0; t < nt; t += 2) {
            const bool last = (t == nt - 2);
            const char* a1 = cA + (size_t)(t + 1) * kstep;
            const char* a2 = last ? nA : cA + (size_t)(t + 2) * kstep; const char* b2 = last ? nB : cB + (size_t)(t + 2) * kstep;
            const char* a3 = a2 + kstep; const char* b3 = b2 + kstep;
            if constexpr (SP2) {
            PG8_LDB(B0, 0, 0); PG8_LDB(B1, 0, 1); PG8_SCHED; PG8_LDA(At, 0, 0); PG8_STAGE(PG8_SA(1, 1), a1 + hstep, voffA);
            PG8_WAIT_V(8); PG8_WAIT_L(0); PG8_BAR; PG8_MMA(0, 0, At, B0); PG8_MMA(0, 1, At, B1); PG8_BAR; PG8_SCHED;
            PG8_LDA(At, 0, 1); PG8_STAGE(PG8_SB(0, 0), b2, voffB); PG8_STAGE(PG8_SB(0, 1), b2 + hstep, voffB); PG8_STAGE(PG8_SA(0, 0), a2, voffA);
            PG8_WAIT_V(8); PG8_WAIT_L(0); PG8_BAR; PG8_MMA(1, 0, At, B0); PG8_MMA(1, 1, At, B1); PG8_BAR; PG8_SCHED;
            PG8_LDB(B0, 1, 0); PG8_LDB(B1, 1, 1); PG8_SCHED; PG8_LDA(At, 1, 0); PG8_STAGE(PG8_SA(0, 1), a2 + hstep, voffA);
            PG8_WAIT_V(8); PG8_WAIT_L(0); PG8_BAR; PG8_MMA(0, 0, At, B0); PG8_MMA(0, 1, At, B1); PG8_BAR; PG8_SCHED;
            PG8_LDA(At, 1, 1); PG8_STAGE(PG8_SB(1, 0), b3, voffB); PG8_STAGE(PG8_SB(1, 1), b3 + hstep, voffB); PG8_STAGE(PG8_SA(1, 0), a3, voffA);
            PG8_WAIT_V(8); PG8_WAIT_L(0); PG8_BAR; PG8_MMA(1, 0, At, B0); PG8_MMA(1, 1, At, B1); PG8_BAR; PG8_SCHED;
            } else {
            PG8_LDB(B0, 0, 0); PG8_SCHED; PG8_LDA(At, 0, 0); PG8_STAGE(PG8_SA(1, 1), a1 + hstep, voffA);
            PG8_WAIT_L(8); PG8_BAR; PG8_WAIT_L(0); PG8_MMA(0, 0, At, B0); PG8_BAR; PG8_SCHED;
            PG8_LDB(B1, 0, 1); PG8_STAGE(PG8_SB(0, 0), b2, voffB);
            PG8_BAR; PG8_WAIT_L(0); PG8_MMA(0, 1, At, B1); PG8_BAR;
            PG8_LDA(At, 0, 1); PG8_STAGE(PG8_SA(0, 0), a2, voffA);
            PG8_BAR; PG8_WAIT_L(0); PG8_MMA(1, 0, At, B0); PG8_BAR; PG8_SCHED;
            PG8_STAGE(PG8_SB(0, 1), b2 + hstep, voffB);
            PG8_WAIT_V(6); PG8_BAR; PG8_MMA(1, 1, At, B1); PG8_BAR;
            PG8_LDB(B0, 1, 0); PG8_SCHED; PG8_LDA(At, 1, 0); PG8_STAGE(PG8_SA(0, 1), a2 + hstep, voffA);
            PG8_WAIT_L(8); PG8_BAR; PG8_WAIT_L(0); PG8_MMA(0, 0, At, B0); PG8_BAR; PG8_SCHED;
            PG8_LDB(B1, 1, 1); PG8_STAGE(PG8_SB(1, 0), b3, voffB);
            PG8_BAR; PG8_WAIT_L(0); PG8_MMA(0, 1, At, B1); PG8_BAR;
            PG8_LDA(At, 1, 1); PG8_STAGE(PG8_SA(1, 0), a3, voffA);
            PG8_BAR; PG8_WAIT_L(0); PG8_MMA(1, 0, At, B0); PG8_BAR; PG8_SCHED;
            PG8_STAGE(PG8_SB(1, 1), b3 + hstep, voffB);
            PG8_WAIT_V(6); PG8_BAR; PG8_MMA(1, 1, At, B1); PG8_BAR;
            }
        }
        if constexpr (ALIGN_EPI) { if (wr == 0) PG8_BAR; }
        E(acc, cur, wr, wc, fr, fq);
        if (!has_next) break;
#pragma unroll
        for (int a = 0; a < 2; ++a)
#pragma unroll
            for (int b = 0; b < 2; ++b)
#pragma unroll
                for (int m = 0; m < 4; ++m)
#pragma unroll
                    for (int n = 0; n < 2; ++n) acc[a][b][m][n] = (f32x4){0.f, 0.f, 0.f, 0.f};
        cur = nxt; cA = nA; cB = nB; ++ui;
        if constexpr (ALIGN_EPI) { if (wr == 1) PG8_BAR; }
    }
    PG8_WAIT_V(0);
    if constexpr (!ALIGN_EPI) { if (wr == 0) PG8_BAR; }
    PG8_BAR;
#undef PG8_SA
#undef PG8_SB
#undef PG8_STAGE
#undef PG8_LDA
#undef PG8_LDB
#undef PG8_MMA
#undef PG8_WAIT_V
#undef PG8_WAIT_L
#undef PG8_BAR
#undef PG8_SCHED
}
}

constexpr int D = 1024, NB = 8, LX = 4096, LCX = 256, NIN = 4608, DA = 512, DB = 512, HD = 128;
constexpr int MLAT = NB * LX, MCTX = NB * LCX, MTOK = MLAT + MCTX;
constexpr int PA_LD = 3072;
constexpr int FZ = 8448, FZC = 640;
constexpr float EPS = 1e-6f;
constexpr float HY_MIN_DECAY = -3.0701134573253944f, HY_MAX_DECAY = -15.350567286626972f;
constexpr int NWAVES = 8, NTHR = 512;

constexpr size_t MiB = 1u << 20;
constexpr size_t WS_CTL = 0, CTL_ZERO_BYTES = 1 * MiB;
constexpr size_t WS_MOD = 1 * MiB;
constexpr size_t WS_LBS = WS_MOD + 256 * 1024;
constexpr size_t WS_WIN = 6 * MiB;
constexpr size_t WS_WOUT = 24 * MiB;
constexpr size_t WS_FG = 28 * MiB;
constexpr size_t WS_FGC = 45 * MiB;
constexpr size_t WS_CTX1 = 46 * MiB;
constexpr size_t WS_OC = 2 * MiB;
constexpr size_t WS_XA = 54 * MiB;
constexpr size_t WS_PA = 122 * MiB;
constexpr size_t WS_PB = 326 * MiB;
constexpr size_t WS_OBT = 462 * MiB;
constexpr size_t WS_HK = 326 * MiB;
constexpr size_t WS_SCL = 496 * MiB;
constexpr size_t WS_END = 504 * MiB;
constexpr int CW_NORM = 1024;
constexpr int CW_BAR = 8192;
constexpr int CW_QUEUE = 4096;

constexpr int LDS_BYTES = 156 * 1024;
#define LAS __attribute__((address_space(3)))
#define GAS __attribute__((address_space(1)))
typedef unsigned short bf16;
typedef unsigned v4u __attribute__((ext_vector_type(4)));
typedef unsigned v2u __attribute__((ext_vector_type(2)));
typedef float f32x4 __attribute__((ext_vector_type(4)));

typedef __bf16 bf2_t __attribute__((ext_vector_type(2)));
typedef float f2_t __attribute__((ext_vector_type(2)));
__device__ __forceinline__ unsigned pk2(float lo, float hi) { const f2_t v = {lo, hi}; return __builtin_bit_cast(unsigned, __builtin_convertvector(v, bf2_t)); }
__device__ __forceinline__ unsigned f2bf(float f) { return pk2(f, 0.f) & 0xffffu; }
__device__ __forceinline__ float bf2f(unsigned short h) { return __builtin_bit_cast(float, (unsigned)h << 16); }
__device__ __forceinline__ unsigned f2h(float f) { _Float16 h = (_Float16)f; return (unsigned)__builtin_bit_cast(unsigned short, h); }
__device__ __forceinline__ unsigned pk2h(float lo, float hi) { return f2h(lo) | (f2h(hi) << 16); }
__device__ __forceinline__ float h2f(unsigned short u) { return (float)__builtin_bit_cast(_Float16, u); }
__device__ __forceinline__ float silu_f(float x) { return x * __builtin_amdgcn_rcpf(1.0f + __expf(-x)); }
__device__ __forceinline__ float sigmoid_f(float x) { return __builtin_amdgcn_rcpf(1.0f + __expf(-x)); }
__device__ __forceinline__ float wave_sum(float v) {
#pragma unroll
    for (int o = 1; o < 64; o <<= 1) v += __shfl_xor(v, o);
    return v;
}


#define PSTAMP_(lds_, k_) do { if (threadIdx.x == 0) ((volatile LAS unsigned long long*)((lds_) + LDS_BYTES - 512))[(k_)] = __builtin_amdgcn_s_memrealtime(); } while (0)
#if defined(PROBE_ID) && PROBE_ID >= 216 && PROBE_ID < 220
#define PSTAMP_H(lds_, k_) PSTAMP_(lds_, k_)
#else
#define PSTAMP_H(lds_, k_) do { } while (0)
#endif
#if defined(PROBE_ID) && PROBE_ID >= 226 && PROBE_ID < 230
#define PSTAMP_P(lds_, k_) PSTAMP_(lds_, k_)
#else
#define PSTAMP_P(lds_, k_) do { } while (0)
#endif
#if defined(PROBE_ID) && PROBE_ID >= 220 && PROBE_ID < 226
#define PSTAMP_S(lds_, k_) PSTAMP_(lds_, k_)
#else
#define PSTAMP_S(lds_, k_) do { } while (0)
#endif
typedef GAS unsigned gu32;
#define XB_TMO      128
#define XB_XCNT(j)  (256  + 64 * (j))
#define XB_XSUB(j)  (1280 + 64 * (j))
#define XB_XGEN(j)  (2304 + 64 * (j))
#define XB_TOP      3328
#define XB_TOPGEN   3392
#define XCD_BAR_WORDS 3456
#define XB_SPIN_CAP (1u << 18)
__device__ __forceinline__ unsigned xb_ld(unsigned* p)              { return __hip_atomic_load(p, __ATOMIC_RELAXED, __HIP_MEMORY_SCOPE_AGENT); }
__device__ __forceinline__ unsigned xb_add(unsigned* p, unsigned v) { return __hip_atomic_fetch_add(p, v, __ATOMIC_RELAXED, __HIP_MEMORY_SCOPE_AGENT); }
__device__ __forceinline__ unsigned xb_xcc_id() { return (unsigned)__builtin_amdgcn_s_getreg((3 << 11) | 20) & 0xFu; }
#define XB_SPIN(cond, bar) do { unsigned _sp = 0; while (cond) { __builtin_amdgcn_s_sleep(1); \
    if ((++_sp & 255u) == 0u) { if (xb_ld(&(bar)[XB_TMO])) break; if (_sp > XB_SPIN_CAP) { atomicAdd(&(bar)[XB_TMO], 1u); break; } } } } while (0)
struct XcdBarrier { unsigned* bar; unsigned x; volatile LAS unsigned* st; };
__device__ __forceinline__ XcdBarrier xcd_barrier_post(unsigned* bar, volatile LAS unsigned* st) {
    XcdBarrier b; b.bar = bar; b.x = xb_xcc_id(); b.st = st;
    if (threadIdx.x == 0) (void)xb_add(&bar[XB_XCNT(b.x)], 1u);
    return b;
}
__device__ __forceinline__ void xcd_barrier_complete(unsigned* bar, unsigned x, unsigned& nloc, unsigned& nx) {
    const unsigned G = gridDim.x * gridDim.y * gridDim.z;
    unsigned sum, cnt, mine, sp = 0u;
    for (;;) {
        sum = 0u; cnt = 0u; mine = 0u;
#pragma unroll
        for (unsigned j = 0; j < 16; ++j) { const unsigned c = xb_ld(&bar[XB_XCNT(j)]); sum += c; cnt += (c > 0u) ? 1u : 0u; mine = (j == x) ? c : mine; }
        if (sum == G) break;
        __builtin_amdgcn_s_sleep(1);
        if ((++sp & 255u) == 0u) { if (xb_ld(&bar[XB_TMO])) break; if (sp > XB_SPIN_CAP) { atomicAdd(&bar[XB_TMO], 1u); break; } }
    }
    nloc = mine > 0u ? mine : 1u; nx = cnt > 0u ? cnt : 1u;
}
__device__ __forceinline__ void xcd_barrier(const XcdBarrier& b) {
    asm volatile("s_waitcnt vmcnt(0)" ::: "memory");
    __syncthreads();
    if (threadIdx.x == 0) {
        unsigned* bar = b.bar;
        __builtin_amdgcn_s_waitcnt(0);
        unsigned nloc = b.st[0], nx = b.st[1];
        if (nloc == 0u) { xcd_barrier_complete(bar, b.x, nloc, nx); b.st[0] = nloc; b.st[1] = nx; }
        const unsigned old = xb_add(&bar[XB_XSUB(b.x)], 1u);
        const unsigned gen = old / nloc;
        if (old + 1u == (gen + 1u) * nloc) {
            __builtin_amdgcn_fence(__ATOMIC_RELEASE, "agent");
            asm volatile("s_waitcnt vmcnt(0)" ::: "memory");
            const unsigned og = xb_add(&bar[XB_TOP], 1u);
            const unsigned tg = og / nx;
            if (og + 1u == (tg + 1u) * nx) xb_add(&bar[XB_TOPGEN], 1u);
            else XB_SPIN(xb_ld(&bar[XB_TOPGEN]) == tg, bar);
            __builtin_amdgcn_fence(__ATOMIC_ACQUIRE, "agent");
            xb_add(&bar[XB_XGEN(b.x)], 1u);
            asm volatile("s_waitcnt vmcnt(0)" ::: "memory");
        } else {
            XB_SPIN(xb_ld(&bar[XB_XGEN(b.x)]) == gen, bar);
            __builtin_amdgcn_fence(__ATOMIC_ACQUIRE, "agent");
            asm volatile("s_waitcnt vmcnt(0)" ::: "memory");
        }
    }
    __syncthreads();
}

struct EpiIn {
    static constexpr bool PERM = true;
    bf16* PA; bf16* PB; const float* lb;
    __device__ __forceinline__ bool swap(const pg8::Unit& u) const { return u.pn >= 10; }
    __device__ __forceinline__ void operator()(const f32x4 (&acc)[2][2][4][2], const pg8::Unit& u, int wr, int wc, int fr, int fq) const {
        if (u.pn < 10) {
            const int type = u.pn >> 1;
            const int row0 = u.pm * 256 + wr * 64 + fr, col0 = u.pn * 256 + wc * 32 + 8 * fq;
#pragma unroll
            for (int bj = 0; bj < 2; ++bj) {
                float lbv[8];
#pragma unroll
                for (int e = 0; e < 8; ++e) lbv[e] = (type == 1 || type == 2) ? lb[col0 + bj * 128 + e - 512] : 0.f;
#pragma unroll
                for (int ai = 0; ai < 2; ++ai)
#pragma unroll
                    for (int m = 0; m < 4; ++m) {
                        bf16* rowp = PA + (size_t)(row0 + ai * 128 + m * 16) * PA_LD + col0 + bj * 128;
                        float x[8];
#pragma unroll
                        for (int e = 0; e < 4; ++e) { x[e] = acc[ai][bj][m][0][e]; x[4 + e] = acc[ai][bj][m][1][e]; }
                        v4u w;
                        if (type == 0) {
#pragma unroll
                            for (int e = 0; e < 8; ++e) x[e] = silu_f(x[e]);
                            w.x = pk2(x[0], x[1]); w.y = pk2(x[2], x[3]); w.z = pk2(x[4], x[5]); w.w = pk2(x[6], x[7]);
                        } else if (type == 1 || type == 2) {
#pragma unroll
                            for (int e = 0; e < 8; ++e) x[e] = lbv[e] + (1.0f - lbv[e]) * sigmoid_f(x[e]);
                            w.x = pk2h(x[0], x[1]); w.y = pk2h(x[2], x[3]); w.z = pk2h(x[4], x[5]); w.w = pk2h(x[6], x[7]);
                        } else {
                            w.x = pk2(x[0], x[1]); w.y = pk2(x[2], x[3]); w.z = pk2(x[4], x[5]); w.w = pk2(x[6], x[7]);
                        }
                        *(v4u*)rowp = w;
                        asm volatile("" ::: "memory");
                    }
            }
        } else {
#pragma unroll
            for (int ai = 0; ai < 2; ++ai)
#pragma unroll
                for (int m = 0; m < 4; ++m) {
                    const int cw = u.pn * 256 + ai * 128 + wr * 64 + m * 16 + fr;
                    bf16* colp = PB + (size_t)(cw - 2560) * MTOK + u.pm * 256 + wc * 32 + 8 * fq;
#pragma unroll
                    for (int bj = 0; bj < 2; ++bj) {
                        const f32x4 v0 = acc[ai][bj][m][0], v1 = acc[ai][bj][m][1];
                        v4u w; w.x = pk2(v0[0], v0[1]); w.y = pk2(v0[2], v0[3]); w.z = pk2(v1[0], v1[1]); w.w = pk2(v1[2], v1[3]);
                        *(v4u*)(colp + bj * 128) = w;
                    }
                }
        }
    }
};
struct EpiOut {
    static constexpr bool PERM = true;
    bf16* DL; const float* mod;
    __device__ __forceinline__ bool swap(const pg8::Unit&) const { return false; }
    __device__ __forceinline__ void operator()(const f32x4 (&acc)[2][2][4][2], const pg8::Unit& u, int wr, int wc, int fr, int fq) const {
        const int mr = u.pm >= 128 ? 8 : (u.pm >> 4);
        const int col0 = u.pn * 256 + wc * 32 + 8 * fq;
        f32x4 g0[2], g1[2];
#pragma unroll
        for (int bj = 0; bj < 2; ++bj) { const float* gt = mod + (size_t)mr * 3 * D + 2 * D + col0 + bj * 128; g0[bj] = *(const f32x4*)gt; g1[bj] = *(const f32x4*)(gt + 4); }
#pragma unroll
        for (int ai = 0; ai < 2; ++ai)
#pragma unroll
            for (int m = 0; m < 4; ++m) {
                bf16* rowp = DL + (size_t)(u.pm * 256 + ai * 128 + wr * 64 + m * 16 + fr) * D + col0;
#pragma unroll
                for (int bj = 0; bj < 2; ++bj) {
                    const f32x4 v0 = acc[ai][bj][m][0] * g0[bj], v1 = acc[ai][bj][m][1] * g1[bj];
                    v4u w; w.x = pk2(v0[0], v0[1]); w.y = pk2(v0[2], v0[3]); w.z = pk2(v1[0], v1[1]); w.w = pk2(v1[2], v1[3]);
                    *(v4u*)(rowp + bj * 128) = w;
                }
            }
    }
};

struct Args {
    const float* in[23]; float* out; unsigned char* ws; int ph_lo, ph_hi;
};

struct Frame {
    LAS unsigned char* lds; int tid, lane, wave, vcu, G;
};

__device__ __forceinline__ void p0_transpose_item(const float* W, int K, int N, bf16* WT, LAS float* scr, int item, int lane) {
    const int nblk = N / 32, kb = item / nblk, nb = item % nblk, k0 = 64 * kb, n0 = 32 * nb;
    f32x4 v[8];
#pragma unroll
    for (int i = 0; i < 8; ++i) v[i] = *(const f32x4*)(W + (size_t)(k0 + 8 * i + (lane >> 3)) * N + n0 + 4 * (lane & 7));
#pragma unroll
    for (int i = 0; i < 8; ++i) { LAS float* d = scr + (8 * i + (lane >> 3)) * 33 + 4 * (lane & 7); d[0] = v[i][0]; d[1] = v[i][1]; d[2] = v[i][2]; d[3] = v[i][3]; }
    asm volatile("s_waitcnt lgkmcnt(0)" ::: "memory");
    const int c = lane & 7;
#pragma unroll
    for (int j = 0; j < 4; ++j) { const int n = (lane >> 3) + 8 * j; const LAS float* s = scr + (8 * c) * 33 + n;
        v4u o; o.x = pk2(s[0 * 33], s[1 * 33]); o.y = pk2(s[2 * 33], s[3 * 33]); o.z = pk2(s[4 * 33], s[5 * 33]); o.w = pk2(s[6 * 33], s[7 * 33]);
        *(v4u*)(WT + (size_t)(n0 + n) * K + k0 + 8 * c) = o; }
    asm volatile("s_waitcnt lgkmcnt(0)" ::: "memory");
}

__device__ __forceinline__ void filter_task(const Args& a, Frame& F, const int set, const int n0, int& cached_layer) {
    unsigned char* ws = a.ws;
    const int l = set == 1 ? 1 : 0, L = set == 2 ? 256 : 4096;
    LAS float* w1s = (LAS float*)F.lds;
    LAS float* w2s = w1s + 33 * 64;
    LAS float* w3s = w2s + 64 * 64;
    LAS float* bs = w3s + 64 * 64;
    LAS float* zs = bs + 256;
    LAS float* h3s = zs + 8 * 4 * 64;
    LAS unsigned short* tile = (LAS unsigned short*)(h3s + 32 * 64);
    if (cached_layer != l) {
        __syncthreads();
        for (int e = F.tid; e < 33 * 64; e += NTHR) w1s[e] = a.in[13][l * 33 * 64 + e];
        for (int e = F.tid; e < 4096; e += NTHR) { w2s[e] = a.in[16][l * 4096 + e]; w3s[e] = a.in[18][l * 4096 + e]; }
        if (F.tid < 64) { bs[F.tid] = a.in[14][l * 64 + F.tid]; bs[64 + F.tid] = a.in[17][l * 64 + F.tid]; bs[128 + F.tid] = a.in[19][l * 64 + F.tid]; bs[192 + F.tid] = a.in[15][l * 64 + F.tid]; }
        cached_layer = l;
        __syncthreads();
    }
    {
        const int j = F.lane; LAS float* zw = zs + F.wave * 256; const float fr = bs[192 + j];
#pragma unroll
        for (int p = 0; p < 4; ++p) {
            const int n = n0 + 4 * F.wave + p;
            float zv = 0.f;
            if (j == 0) zv = (float)n / (float)(L - 1);
            else if (j < 33) { const int i = (j - 1) & 15; const double f = 1e-4 + (double)i * ((15.0 - 1e-4) / 15.0); double rev = f * (double)n / (double)L; rev -= floor(rev);
                const float ang = (float)(rev * 6.283185307179586476925); zv = (j <= 16) ? __cosf(ang) : -__sinf(ang); }
            zw[p * 64 + j] = zv;
        }
        asm volatile("s_waitcnt lgkmcnt(0)" ::: "memory");
        float s4[4];
#pragma unroll
        for (int p = 0; p < 4; ++p) s4[p] = bs[j];
        for (int e = 0; e < 33; ++e) { const float wv = w1s[e * 64 + j];
#pragma unroll
            for (int p = 0; p < 4; ++p) s4[p] += zw[p * 64 + e] * wv; }
        asm volatile("s_waitcnt lgkmcnt(0)" ::: "memory");
#pragma unroll
        for (int p = 0; p < 4; ++p) zw[p * 64 + j] = __sinf(fr * s4[p]);
        asm volatile("s_waitcnt lgkmcnt(0)" ::: "memory");
#pragma unroll
        for (int p = 0; p < 4; ++p) s4[p] = bs[64 + j];
        for (int e = 0; e < 64; ++e) { const float wv = w2s[e * 64 + j];
#pragma unroll
            for (int p = 0; p < 4; ++p) s4[p] += zw[p * 64 + e] * wv; }
        asm volatile("s_waitcnt lgkmcnt(0)" ::: "memory");
#pragma unroll
        for (int p = 0; p < 4; ++p) zw[p * 64 + j] = __sinf(fr * s4[p]);
        asm volatile("s_waitcnt lgkmcnt(0)" ::: "memory");
#pragma unroll
        for (int p = 0; p < 4; ++p) s4[p] = bs[128 + j];
        for (int e = 0; e < 64; ++e) { const float wv = w3s[e * 64 + j];
#pragma unroll
            for (int p = 0; p < 4; ++p) s4[p] += zw[p * 64 + e] * wv; }
#pragma unroll
        for (int p = 0; p < 4; ++p) h3s[(4 * F.wave + p) * 64 + j] = __sinf(fr * s4[p]);
    }
    __syncthreads();
    {
        typedef short bf16x8_ __attribute__((ext_vector_type(8)));
        LAS unsigned char* hA = (LAS unsigned char*)(tile + 1024 * 34);
        LAS unsigned char* wB = hA + 32 * 144;
        const int l15 = F.lane & 15, q = F.lane >> 4;
        { const int p = F.tid >> 4, k4 = (F.tid & 15) * 4; const f32x4 hv = *(const LAS f32x4*)(h3s + p * 64 + k4);
          v2u hw; hw.x = pk2(hv[0], hv[1]); hw.y = pk2(hv[2], hv[3]); *(LAS v2u*)(hA + p * 144 + 2 * k4) = hw; }
        float* nrm = (float*)(ws + WS_CTL) + CW_NORM;
        const float* w4 = a.in[20] + (size_t)l * 64 * 1024;
        for (int ch = 0; ch < 8; ++ch) {
            __syncthreads();
            { const int n = F.tid & 127, kq = F.tid >> 7;
              float wv[2][8];
#pragma unroll
              for (int g2 = 0; g2 < 2; ++g2)
#pragma unroll
                  for (int e = 0; e < 8; ++e) wv[g2][e] = w4[(size_t)(16 * kq + 8 * g2 + e) * 1024 + 128 * ch + n];
#pragma unroll
              for (int g2 = 0; g2 < 2; ++g2) { v4u o; o.x = pk2(wv[g2][0], wv[g2][1]); o.y = pk2(wv[g2][2], wv[g2][3]); o.z = pk2(wv[g2][4], wv[g2][5]); o.w = pk2(wv[g2][6], wv[g2][7]);
                  *(LAS v4u*)(wB + n * 144 + (16 * kq + 8 * g2) * 2) = o; } }
            __syncthreads();
            {
                const int col = 128 * ch + 16 * F.wave + l15, c = col & 511;
                f32x4 acc[2];
#pragma unroll
                for (int mt = 0; mt < 2; ++mt) { acc[mt] = (f32x4){0.f, 0.f, 0.f, 0.f};
#pragma unroll
                    for (int ks = 0; ks < 2; ++ks)
                        acc[mt] = __builtin_amdgcn_mfma_f32_16x16x32_bf16(*(const LAS bf16x8_*)(hA + (16 * mt + l15) * 144 + (32 * ks + 8 * q) * 2), *(const LAS bf16x8_*)(wB + (16 * F.wave + l15) * 144 + (32 * ks + 8 * q) * 2), acc[mt], 0, 0, 0); }
                const float dl = fabsf(HY_MIN_DECAY + (float)c * ((HY_MAX_DECAY - HY_MIN_DECAY) / 511.0f));
                float ns = 0.f;
#pragma unroll
                for (int mt = 0; mt < 2; ++mt) {
                    float v4[4];
#pragma unroll
                    for (int r = 0; r < 4; ++r) { const int nn = n0 + 16 * mt + 4 * q + r; v4[r] = acc[mt][r] * __expf(-((float)nn / (float)(L - 1)) * dl); if (col < 512 || nn >= 1) ns += fabsf(v4[r]); }
                    *(LAS unsigned*)(tile + col * 34 + 16 * mt + 4 * q) = pk2(v4[0], v4[1]); *(LAS unsigned*)(tile + col * 34 + 16 * mt + 4 * q + 2) = pk2(v4[2], v4[3]);
                }
                ns += __shfl_xor(ns, 16); ns += __shfl_xor(ns, 32);
                if (q == 0) atomicAdd(&nrm[set * 512 + c], ns);
            }
        }
    }
    __syncthreads();
    {
        bf16* dst = set == 2 ? (bf16*)(ws + WS_FGC) : (bf16*)(ws + WS_FG) + (size_t)set * 512 * FZ;
        const int ld = set == 2 ? FZC : FZ;
        for (int e = F.tid; e < 1024 * 32; e += NTHR) {
            const int col = e >> 5, p = e & 31, c = col & 511, n = n0 + p;
            const unsigned short v = tile[col * 34 + p];
            if (col < 512) dst[(size_t)c * ld + (L - n)] = v;
            else if (n >= 1) dst[(size_t)c * ld + (L + n)] = v;
        }
        if (n0 == 0) {
            const int npad = ld - 2 * L;
            for (int e = F.tid; e < 512 * (npad + 1); e += NTHR) { const int c = e / (npad + 1), k = e % (npad + 1); dst[(size_t)c * ld + (k == 0 ? 0 : 2 * L + k - 1)] = 0; }
        }
    }
    __syncthreads();
}

__device__ __forceinline__ void phase_prologue(const Args& a, Frame& F) {
    unsigned char* ws = a.ws;
    if (F.vcu == 0) {
        float* lbs = (float*)(ws + WS_LBS);
        for (int i = F.tid; i < 1024; i += NTHR) {
            const float a0 = a.in[9][i], a1 = a.in[9][1024 + i];
            const float m = fmaxf(a0, a1), e0 = expf(a0 - m), e1 = expf(a1 - m);
            const float p0 = e0 / (e0 + e1), p1 = e1 / (e0 + e1);
            const float c0 = p0, c1 = p0 + p1;
            lbs[i] = c0 - c0; lbs[1024 + i] = c1 - c0;
        }
    }
    int cached_layer = -1;
    PSTAMP_P(F.lds, 26);
    constexpr int I_IN = (D / 64) * (NIN / 32), I_OUT = (D / 64) * (D / 32), NTR = 2 * (I_IN + I_OUT) / 8;
    const bool filtcu = F.vcu < 16 || (F.vcu >= 128 && F.vcu < 136), modcu = F.vcu >= 160;
    const int tr0 = modcu ? F.vcu - 160 : filtcu ? NTR : 96 + (F.vcu < 128 ? F.vcu - 16 : F.vcu - 136 + 112), trend = modcu ? 96 : NTR;
    for (int t = tr0; t < trend; t += 136) {
        LAS float* scr = (LAS float*)(F.lds + 65536 + F.wave * 8704);
        int r = t * 8 + F.wave; const int l = r / (I_IN + I_OUT); r -= l * (I_IN + I_OUT);
        if (r < I_IN) p0_transpose_item(a.in[7] + (size_t)l * D * NIN, D, NIN, (bf16*)(ws + WS_WIN) + (size_t)l * NIN * D, scr, r, F.lane);
        else p0_transpose_item(a.in[8] + (size_t)l * D * D, D, D, (bf16*)(ws + WS_WOUT) + (size_t)l * D * D, scr, r - I_IN, F.lane);
    }
    __syncthreads();
    PSTAMP_P(F.lds, 27);
    if (F.vcu >= 160) {
        const int task = F.vcu - 160;
        LAS float* sv = (LAS float*)(F.lds + 65536);
        LAS float* part = sv + 9 * 1024;
        const int l = task / 48, n0 = (task % 48) * 64;
        for (int e = F.tid; e < 9 * 1024; e += NTHR) { const int r = e >> 10, k = e & 1023; const float cv = r < 8 ? a.in[1][r * D + k] : a.in[3][k]; sv[e] = cv / (1.0f + expf(-cv)); }
        __syncthreads();
        float acc9[9];
#pragma unroll
        for (int r = 0; r < 9; ++r) acc9[r] = 0.f;
        const float* w = a.in[5] + (size_t)l * D * 3 * D + n0 + F.lane;
#pragma unroll 16
        for (int k = F.wave * 128; k < F.wave * 128 + 128; ++k) {
            const float wv = w[(size_t)k * 3 * D];
#pragma unroll
            for (int r = 0; r < 9; ++r) acc9[r] += sv[r * 1024 + k] * wv;
        }
#pragma unroll
        for (int r = 0; r < 9; ++r) part[(F.wave * 9 + r) * 64 + F.lane] = acc9[r];
        __syncthreads();
        for (int e = F.tid; e < 9 * 64; e += NTHR) {
            const int r = e >> 6, c = e & 63; float sum = 0.f;
#pragma unroll
            for (int w8 = 0; w8 < 8; ++w8) sum += part[(w8 * 9 + r) * 64 + c];
            ((float*)(ws + WS_MOD))[((size_t)l * 9 + r) * 3 * D + n0 + c] = sum + a.in[6][l * 3 * D + n0 + c];
        }
        __syncthreads();
    }
    PSTAMP_P(F.lds, 28);
    if (F.vcu < 16) filter_task(a, F, 0, 32 * (112 + F.vcu), cached_layer);
    else if (F.vcu >= 128 && F.vcu < 136) filter_task(a, F, 2, 32 * (F.vcu - 128), cached_layer);
    PSTAMP_P(F.lds, 29);
}
__device__ __forceinline__ void phase_filters_l0(const Args& a, Frame& F) {
    int cached_layer = -1; const int b = (int)blockIdx.x;
    if (b >= 144) filter_task(a, F, 0, 32 * (b - 144), cached_layer);
}
__device__ __forceinline__ void phase_filters_l1(const Args& a, Frame& F) {
    int cached_layer = -1; const int b = (int)blockIdx.x;
    if (b >= 32 && b < 160) filter_task(a, F, 1, 32 * (b - 32), cached_layer);
}

__device__ __forceinline__ void phase_normrows(const Args& a, Frame& F, int l, const float* xlat, const float* xctx) {
    unsigned char* ws = a.ws;
    const float* nw = a.in[4] + l * D;
    const float* mod = (const float*)(ws + WS_MOD) + (size_t)l * 9 * 3 * D;
    bf16* XA = (bf16*)(ws + WS_XA);
    const bf16* DL = (const bf16*)(ws + WS_PB);
    const int gw = F.vcu * NWAVES + F.wave, NGW = F.G * NWAVES;
    for (int tok = gw; tok < MTOK; tok += NGW) {
        const bool isctx = tok >= MLAT;
        const float* xr = isctx ? xctx + (size_t)(tok - MLAT) * D : xlat + (size_t)tok * D;
        const int mr = isctx ? 8 : (tok >> 12);
        const float* sh = mod + (size_t)mr * 3 * D; const float* sc = sh + D;
        f32x4 v[4]; float s = 0.f;
#pragma unroll
        for (int j = 0; j < 4; ++j) v[j] = *(const f32x4*)(xr + 256 * j + 4 * F.lane);
        if (l == 1) {
#pragma unroll
            for (int j = 0; j < 4; ++j) { const v2u dw = *(const v2u*)(DL + (size_t)tok * D + 256 * j + 4 * F.lane);
                v[j].x += bf2f((unsigned short)(dw.x & 0xffffu)); v[j].y += bf2f((unsigned short)(dw.x >> 16)); v[j].z += bf2f((unsigned short)(dw.y & 0xffffu)); v[j].w += bf2f((unsigned short)(dw.y >> 16)); }
            if (!isctx) {
#pragma unroll
                for (int j = 0; j < 4; ++j) *(f32x4*)(a.out + (size_t)tok * D + 256 * j + 4 * F.lane) = v[j];
            }
        }
#pragma unroll
        for (int j = 0; j < 4; ++j) s += (v[j].x * v[j].x + v[j].y * v[j].y) + (v[j].z * v[j].z + v[j].w * v[j].w);
        const float rstd = 1.0f / sqrtf(wave_sum(s) * (1.0f / D) + EPS);
#pragma unroll
        for (int j = 0; j < 4; ++j) {
            const int k = 256 * j + 4 * F.lane;
            const f32x4 w4 = *(const f32x4*)(nw + k), s4 = *(const f32x4*)(sc + k), h4 = *(const f32x4*)(sh + k);
            const f32x4 y = v[j] * rstd * w4 * (s4 + 1.0f) + h4;
            v2u o; o.x = pk2(y.x, y.y); o.y = pk2(y.z, y.w);
            *(v2u*)(XA + (size_t)tok * D + k) = o;
        }
    }
}


namespace scan {
typedef short bf16x8 __attribute__((ext_vector_type(8)));
typedef short bf16x4 __attribute__((ext_vector_type(4)));
constexpr int QI_RS = 256, KT_RS = 160;
constexpr int OFF_QI = 0, OFF_KI = 16384, OFF_KT = 32768, OFF_VT = 53248, OFF_SCL = 73728, SET_BYTES = 74752;
constexpr int OFF_SEG = 2 * SET_BYTES;
static_assert(OFF_SEG + 4096 <= LDS_BYTES - 512, "scan LDS");
#define MFMA16(a, b, c) __builtin_amdgcn_mfma_f32_16x16x32_bf16((a), (b), (c), 0, 0, 0)
__device__ __forceinline__ bf16x8 ld_qk(const LAS unsigned char* img, int row, int ks, int xq) {
    return *(const LAS bf16x8*)(img + row * QI_RS + ((16 * xq) ^ (64 * ks)));
}
__device__ __forceinline__ int tok_row(int g, int i, int b, int dir) {
    if (g < 4) { const int t = 64 * g + i; return MLAT + b * LCX + (dir ? (LCX - 1 - t) : t); }
    const int t = 64 * (g - 4) + i; return b * LX + (dir ? (LX - 1 - t) : t);
}
template <int HALF>
__device__ __forceinline__ void scan_producer(LAS unsigned char* lds, const bf16* PA, const int b, const int h, const int dir, const int nchunk, const int pw, const int lane) {
    const int tg = lane >> 4, cq = lane & 15, ch0 = 64 * (pw >> 1) + 4 * cq;
    LAS float* seg = (LAS float*)(lds + OFF_SEG + pw * 1024);
    const int qc_ = 8 * (pw >> 1) + 4 * (cq >> 3) + (cq & 3);
    v2u qA[8], fA[8], vA[8], qB[8], fB[8], vB[8];
#define SCAN_LOAD(g, Q_, F_, V_) do { _Pragma("unroll") for (int e = 0; e < 8; ++e) { const bf16* p_ = PA + (size_t)tok_row((g), 32 * HALF + 8 * tg + e, b, dir) * PA_LD + h * HD + ch0; \
        Q_[e] = *(const v2u*)p_; F_[e] = *(const v2u*)(p_ + 512 + dir * 512); V_[e] = *(const v2u*)(p_ + 1536); } } while (0)
#define SCAN_IMG(set_, Q_, F_, V_) do { LAS unsigned char* s_ = lds + (set_) * SET_BYTES; \
        _Pragma("unroll") for (int e = 0; e < 8; ++e) asm volatile("" : "+v"(F_[e].x), "+v"(F_[e].y)); \
        float f_[4][8]; \
        _Pragma("unroll") for (int e = 0; e < 8; ++e) { f_[0][e] = h2f((unsigned short)(F_[e].x & 0xffffu)); f_[1][e] = h2f((unsigned short)(F_[e].x >> 16)); f_[2][e] = h2f((unsigned short)(F_[e].y & 0xffffu)); f_[3][e] = h2f((unsigned short)(F_[e].y >> 16)); } \
        f32x4 pr_; \
        _Pragma("unroll") for (int d = 0; d < 4; ++d) pr_[d] = ((f_[d][0] * f_[d][1]) * (f_[d][2] * f_[d][3])) * ((f_[d][4] * f_[d][5]) * (f_[d][6] * f_[d][7])); \
        *(LAS f32x4*)(seg + tg * 64 + 4 * cq) = pr_; \
        f32x4 T_[4]; _Pragma("unroll") for (int t2 = 0; t2 < 4; ++t2) T_[t2] = *(const LAS f32x4*)(seg + t2 * 64 + 4 * cq); \
        const f32x4 tot_ = (T_[0] * T_[1]) * (T_[2] * T_[3]); \
        f32x4 mul_ = (f32x4){1.f, 1.f, 1.f, 1.f}; \
        if (HALF) { _Pragma("unroll") for (int t2 = 0; t2 < 3; ++t2) if (t2 < tg) mul_ *= T_[t2]; } \
        else      { _Pragma("unroll") for (int t2 = 1; t2 < 4; ++t2) if (t2 > tg) mul_ *= T_[t2]; } \
        float Qp_[4][8], Kp_[4][8]; \
        _Pragma("unroll") for (int d = 0; d < 4; ++d) { float x_[8]; float run_ = mul_[d]; \
            if (HALF) { _Pragma("unroll") for (int e = 0; e < 8; ++e) { run_ *= f_[d][e]; x_[e] = run_; } } \
            else      { _Pragma("unroll") for (int e = 7; e >= 0; --e) { x_[e] = run_; run_ *= f_[d][e]; } } \
            _Pragma("unroll") for (int e = 0; e < 8; ++e) { const unsigned qw_ = (d & 2) ? Q_[e].y : Q_[e].x; const float qv_ = bf2f((unsigned short)((d & 1) ? (qw_ >> 16) : (qw_ & 0xffffu))); \
                const float xx_ = fmaxf(x_[e], 1e-30f), r_ = __builtin_amdgcn_rcpf(xx_), kk_ = 1.0f - f_[d][e]; \
                Qp_[d][e] = HALF ? qv_ * xx_ : qv_ * r_; Kp_[d][e] = HALF ? kk_ * r_ : kk_ * xx_; } \
            v4u t_, u_; \
            _Pragma("unroll") for (int e = 0; e < 4; ++e) { t_[e] = pk2(Kp_[d][2 * e], Kp_[d][2 * e + 1]); \
                const unsigned va_ = (d & 2) ? V_[2 * e].y : V_[2 * e].x, vb_ = (d & 2) ? V_[2 * e + 1].y : V_[2 * e + 1].x; \
                u_[e] = (d & 1) ? ((va_ >> 16) | (vb_ & 0xffff0000u)) : ((va_ & 0xffffu) | (vb_ << 16)); } \
            *(LAS v4u*)(s_ + OFF_KT + (ch0 + d) * KT_RS + 16 * ((4 * HALF + tg) ^ (cq & 7))) = t_; *(LAS v4u*)(s_ + OFF_VT + (ch0 + d) * KT_RS + 16 * ((4 * HALF + tg) ^ (cq & 7))) = u_; } \
        int qx_ = qc_ ^ (8 * (tg & 1)); asm volatile("" : "+v"(qx_)); const int rb_ = (32 * HALF + 8 * tg) * QI_RS + 8 * ((cq >> 2) & 1); \
        _Pragma("unroll") for (int e = 0; e < 8; ++e) { v2u qq_, kq_; qq_.x = pk2(Qp_[0][e], Qp_[1][e]); qq_.y = pk2(Qp_[2][e], Qp_[3][e]); kq_.x = pk2(Kp_[0][e], Kp_[1][e]); kq_.y = pk2(Kp_[2][e], Kp_[3][e]); \
            const int ro_ = rb_ + e * QI_RS + 16 * (qx_ ^ e); \
            *(LAS v2u*)(s_ + OFF_QI + ro_) = qq_; *(LAS v2u*)(s_ + OFF_KI + ro_) = kq_; } \
        if (tg == 0) *(LAS f32x4*)(s_ + OFF_SCL + 512 * HALF + 4 * ch0) = tot_; } while (0)
    const int last = nchunk - 1;
    SCAN_LOAD(0, qA, fA, vA);
    SCAN_LOAD(1, qB, fB, vB);
    SCAN_IMG(0, qA, fA, vA);
    SCAN_LOAD(2, qA, fA, vA);
    __syncthreads();
    for (int g = 0; g < nchunk; g += 2) {
        SCAN_IMG(1, qB, fB, vB);
        { const int gn = g + 3 < last ? g + 3 : last; SCAN_LOAD(gn, qB, fB, vB); }
        __syncthreads();
        SCAN_IMG(0, qA, fA, vA);
        { const int gn = g + 4 < last ? g + 4 : last; SCAN_LOAD(gn, qA, fA, vA); }
        __syncthreads();
    }
#undef SCAN_LOAD
#undef SCAN_IMG
}
__device__ __forceinline__ void scan_unit(LAS unsigned char* lds, bf16* PA, bf16* OC, const int b, const int h, const int dir, const bool ctxunit) {
    int tid_ = threadIdx.x; asm volatile("" : "+v"(tid_));
    const int tid = tid_, lane = tid & 63, w = __builtin_amdgcn_readfirstlane(tid >> 6);
    const int l15 = lane & 15, q = lane >> 4;
    const int nchunk = ctxunit ? 4 : 68;
    if (w >= 4) {
        if (w & 1) scan_producer<1>(lds, PA, b, h, dir, nchunk, w - 4, lane); else scan_producer<0>(lds, PA, b, h, dir, nchunk, w - 4, lane);
    } else {
        f32x4 S[2][8];
#pragma unroll
        for (int c = 0; c < 2; ++c)
#pragma unroll
            for (int kt = 0; kt < 8; ++kt) S[c][kt] = (f32x4){0.f, 0.f, 0.f, 0.f};
        const int vc0 = 32 * w, xq = q ^ l15;
        if (!ctxunit) PSTAMP_S(lds, 20);
        __syncthreads();
        for (int g = 0; g < nchunk; ++g) {
            const bool do_o = ctxunit || g >= 4;
            const LAS unsigned char* cs = lds + (g & 1) * SET_BYTES;
            if (g == 30) PSTAMP_S(lds, 22);
#pragma unroll
            for (int kt = 0; kt < 8; ++kt) { const f32x4 gm4 = *(const LAS f32x4*)(cs + OFF_SCL + (16 * kt + 4 * q) * 4); S[0][kt] *= gm4; S[1][kt] *= gm4; }
            if (do_o) {
                bf16x8 vp[2][2];
#pragma unroll
                for (int c = 0; c < 2; ++c) { const int r_ = vc0 + 8 * (l15 >> 2) + 4 * c + (l15 & 3), x_ = (r_ >> 2) & 7;
#pragma unroll
                    for (int js = 0; js < 2; ++js) { const int c1 = 4 * js + (q >> 1);
                        const bf16x4 lo = *(const LAS bf16x4*)(cs + OFF_VT + r_ * KT_RS + 16 * (c1 ^ x_) + 8 * (q & 1)), hi4 = *(const LAS bf16x4*)(cs + OFF_VT + r_ * KT_RS + 16 * ((c1 + 2) ^ x_) + 8 * (q & 1));
                        vp[c][js] = __builtin_shufflevector(lo, hi4, 0, 1, 2, 3, 4, 5, 6, 7); } }
                bf16x8 sf[2][4];
#pragma unroll
                for (int ks = 0; ks < 4; ++ks) {
#pragma unroll
                    for (int c = 0; c < 2; ++c) { const f32x4 s0 = S[c][2 * ks], s1 = S[c][2 * ks + 1];
                        v4u pk; pk.x = pk2(s0[0], s0[1]); pk.y = pk2(s0[2], s0[3]); pk.z = pk2(s1[0], s1[1]); pk.w = pk2(s1[2], s1[3]); sf[c][ks] = __builtin_bit_cast(bf16x8, pk); }
                }
#pragma unroll
                for (int it = 0; it < 4; ++it) {
                    bf16x8 qf[4];
#pragma unroll
                    for (int ks = 0; ks < 4; ++ks) qf[ks] = ld_qk(cs + OFF_QI, 16 * it + l15, ks, xq);
                    f32x4 O0 = (f32x4){0.f, 0.f, 0.f, 0.f}, O1 = O0;
#pragma unroll
                    for (int ks = 0; ks < 4; ++ks) { O0 = MFMA16(sf[0][ks], qf[ks], O0); O1 = MFMA16(sf[1][ks], qf[ks], O1); }
                    unsigned pt[4][2];
#pragma unroll
                    for (int jt = 0; jt < 4; ++jt) {
                        if (jt <= it) {
                            f32x4 a4 = (f32x4){0.f, 0.f, 0.f, 0.f};
#pragma unroll
                            for (int ks = 0; ks < 4; ++ks) a4 = MFMA16(ld_qk(cs + OFF_KI, 16 * jt + l15, ks, xq), qf[ks], a4);
                            if (jt == it) {
#pragma unroll
                                for (int r = 0; r < 4; ++r) a4[r] = (4 * q + r <= l15) ? a4[r] : 0.f;
                            }
                            pt[jt][0] = pk2(a4[0], a4[1]); pt[jt][1] = pk2(a4[2], a4[3]);
                        } else { pt[jt][0] = 0u; pt[jt][1] = 0u; }
                    }
                    { v4u bw; bw.x = pt[0][0]; bw.y = pt[0][1]; bw.z = pt[1][0]; bw.w = pt[1][1]; const bf16x8 bb = __builtin_bit_cast(bf16x8, bw);
                      O0 = MFMA16(vp[0][0], bb, O0); O1 = MFMA16(vp[1][0], bb, O1); }
                    if (it >= 2) { v4u bw; bw.x = pt[2][0]; bw.y = pt[2][1]; bw.z = pt[3][0]; bw.w = pt[3][1]; const bf16x8 bb = __builtin_bit_cast(bf16x8, bw);
                      O0 = MFMA16(vp[0][1], bb, O0); O1 = MFMA16(vp[1][1], bb, O1); }
                    const int row = tok_row(g, 16 * it + l15, b, dir);
                    bf16* dst = (g < 4) ? OC + (size_t)dir * MCTX * 512 + (size_t)(row - MLAT) * 512 + h * HD + vc0 + 8 * q
                                        : PA + (size_t)row * PA_LD + 512 + dir * 512 + h * HD + vc0 + 8 * q;
                    v4u wv; wv.x = pk2(O0[0], O0[1]); wv.y = pk2(O0[2], O0[3]); wv.z = pk2(O1[0], O1[1]); wv.w = pk2(O1[2], O1[3]);
                    *(v4u*)dst = wv;
                }
            }
            bf16x8 vt[2][2];
#pragma unroll
            for (int c = 0; c < 2; ++c) { const int r_ = vc0 + 8 * (l15 >> 2) + 4 * c + (l15 & 3), x_ = (r_ >> 2) & 7;
                vt[c][0] = *(const LAS bf16x8*)(cs + OFF_VT + r_ * KT_RS + 16 * (q ^ x_)); vt[c][1] = *(const LAS bf16x8*)(cs + OFF_VT + r_ * KT_RS + 16 * ((4 + q) ^ x_)); }
#pragma unroll
            for (int kt = 0; kt < 8; ++kt) {
                const f32x4 gem = *(const LAS f32x4*)(cs + OFF_SCL + 512 + (16 * kt + 4 * q) * 4);
                const int xk_ = (4 * kt + (l15 >> 2)) & 7;
                const bf16x8 k0 = *(const LAS bf16x8*)(cs + OFF_KT + (16 * kt + l15) * KT_RS + 16 * (q ^ xk_)), k1 = *(const LAS bf16x8*)(cs + OFF_KT + (16 * kt + l15) * KT_RS + 16 * ((4 + q) ^ xk_));
#pragma unroll
                for (int c = 0; c < 2; ++c) { f32x4 d4 = MFMA16(k0, vt[c][0], S[c][kt]); d4 = MFMA16(k1, vt[c][1], d4); S[c][kt] = gem * d4; }
            }
            if (g == 30) PSTAMP_S(lds, 23);
            __syncthreads();
            if (g == 30) PSTAMP_S(lds, 24);
        }
        if (!ctxunit) PSTAMP_S(lds, 21);
    }
}
}


namespace hy {
typedef short bf16x8 __attribute__((ext_vector_type(8)));
typedef short bf16x4 __attribute__((ext_vector_type(4)));
constexpr int CS = 16416;
constexpr int VPAD = 7;
constexpr int OFF_F = 0, OFF_V = 4 * CS, V_ROWS = (64 + VPAD + 7) * 8, LDS_END = OFF_V + V_ROWS * 128;
static_assert(LDS_END <= LDS_BYTES - 256, "hyena LDS");
struct ConvW { float x0[4], x1[4], v[4]; };
__device__ __forceinline__ ConvW load_convw(const Args& a, int l, int c) {
    const float* cw = a.in[11] + (size_t)l * 3 * 1536; const float* cb = a.in[12] + (size_t)l * 1536; ConvW r;
#pragma unroll
    for (int j = 0; j < 3; ++j) { r.x0[j] = cw[j * 1536 + c]; r.x1[j] = cw[j * 1536 + 512 + c]; r.v[j] = cw[j * 1536 + 1024 + c]; }
    r.x0[3] = cb[c]; r.x1[3] = cb[512 + c]; r.v[3] = cb[1024 + c];
    return r;
}
__device__ __forceinline__ void hyena_channel(LAS unsigned char* lds, const Args& a, const int l, const int c) {
    int tid_ = threadIdx.x; asm volatile("" : "+v"(tid_));
    const int tid = tid_, lane = tid & 63, w = __builtin_amdgcn_readfirstlane(tid >> 6), l15 = lane & 15, q = lane >> 4;
    unsigned char* ws = a.ws;
    const bf16* PB = (const bf16*)(ws + WS_PB);
    const bf16* x0r = PB + (size_t)c * MTOK; const bf16* x1r = PB + (size_t)(512 + c) * MTOK; const bf16* vr = PB + (size_t)(1024 + c) * MTOK; const bf16* gbr = PB + (size_t)(1536 + c) * MTOK;
    const ConvW cw = load_convw(a, l, c);
    PSTAMP_H(lds, 16);
    {
        const bf16* F = (const bf16*)(ws + WS_FG) + ((size_t)l * 512 + c) * FZ;
        for (int ch = tid; ch < 1024; ch += NTHR) {
            const v4u cur = *(const v4u*)(F + 8 * ch); v4u prev = *(const v4u*)(F + (ch > 0 ? 8 * ch - 8 : 0));
            if (ch == 0) prev = (v4u){0u, 0u, 0u, 0u};
            const unsigned W[8] = {prev.x, prev.y, prev.z, prev.w, cur.x, cur.y, cur.z, cur.w};
            v4u c1, c2, c3;
#pragma unroll
            for (int d = 0; d < 4; ++d) { c1[d] = (W[3 + d] >> 16) | (W[4 + d] << 16); c2[d] = W[3 + d]; c3[d] = (W[2 + d] >> 16) | (W[3 + d] << 16); }
            *(LAS v4u*)(lds + OFF_F + 0 * CS + 16 * ch) = cur;
            *(LAS v4u*)(lds + OFF_F + 1 * CS + 16 * ch) = c1;
            *(LAS v4u*)(lds + OFF_F + 2 * CS + 16 * ch) = c2;
            *(LAS v4u*)(lds + OFF_F + 3 * CS + 16 * ch) = c3;
        }
    }
    {
        for (int e = tid; e < VPAD * 8 * 32; e += NTHR) ((LAS unsigned*)(lds + OFF_V))[e] = 0u;
        for (int e = tid; e < 7 * 8 * 32; e += NTHR) ((LAS unsigned*)(lds + OFF_V + (64 + VPAD) * 8 * 128))[e] = 0u;
        for (int bt = 0; bt < 2; ++bt) {
            v4u vw[4], xw[4]; unsigned short hv[4][2], hx[4][2];
#pragma unroll
            for (int j = 0; j < 4; ++j) {
                const int e = tid + NTHR * (4 * bt + j), b = e >> 9, t0 = (e & 511) * 8;
                const size_t base = (size_t)b * LX + t0;
                const size_t bm = t0 > 0 ? base - 1 : base, bp = t0 + 8 < LX ? base + 8 : base;
                vw[j] = *(const v4u*)(vr + base); xw[j] = *(const v4u*)(x1r + base);
                hv[j][0] = vr[bm]; hv[j][1] = vr[bp]; hx[j][0] = x1r[bm]; hx[j][1] = x1r[bp];
            }
#pragma unroll
            for (int j = 0; j < 4; ++j) {
                const int e = tid + NTHR * (4 * bt + j), b = e >> 9, t0 = (e & 511) * 8, ab = t0 >> 6, ch = (t0 & 63) >> 3;
                float vv[10], xx[10];
                vv[0] = t0 > 0 ? bf2f(hv[j][0]) : 0.f; xx[0] = t0 > 0 ? bf2f(hx[j][0]) : 0.f;
                vv[9] = t0 + 8 < LX ? bf2f(hv[j][1]) : 0.f; xx[9] = t0 + 8 < LX ? bf2f(hx[j][1]) : 0.f;
#pragma unroll
                for (int d = 0; d < 4; ++d) { vv[1 + 2 * d] = bf2f((unsigned short)(vw[j][d] & 0xffffu)); vv[2 + 2 * d] = bf2f((unsigned short)(vw[j][d] >> 16));
                                              xx[1 + 2 * d] = bf2f((unsigned short)(xw[j][d] & 0xffffu)); xx[2 + 2 * d] = bf2f((unsigned short)(xw[j][d] >> 16)); }
                float p[8];
#pragma unroll
                for (int d = 0; d < 8; ++d) p[d] = (cw.v[3] + cw.v[0] * vv[d] + cw.v[1] * vv[d + 1] + cw.v[2] * vv[d + 2]) * (cw.x1[3] + cw.x1[0] * xx[d] + cw.x1[1] * xx[d + 1] + cw.x1[2] * xx[d + 2]);
                v4u o; o.x = pk2(p[0], p[1]); o.y = pk2(p[2], p[3]); o.z = pk2(p[4], p[5]); o.w = pk2(p[6], p[7]);
                const int R = (ab + VPAD) * 8 + b;
                *(LAS v4u*)(lds + OFF_V + R * 128 + 16 * (ch ^ ((R >> 1) & 7))) = o;
            }
        }
    }
    __syncthreads();
    PSTAMP_H(lds, 17);
    f32x4 acc[4][4];
#pragma unroll
    for (int mt = 0; mt < 4; ++mt)
#pragma unroll
        for (int nt = 0; nt < 4; ++nt) acc[mt][nt] = (f32x4){0.f, 0.f, 0.f, 0.f};
    {
        const LAS unsigned char* pa = lds + OFF_F + (l15 & 3) * CS + (4096 - 4 * (l15 >> 2) + 8 * q) * 2 - 96;
        const int rowl = (l15 >> 3) * 8 + (l15 & 7);
        const int cq = (q ^ (rowl >> 1)) & 7;
        const LAS unsigned char* vb0 = lds + OFF_V + rowl * 128 + (8 * w + VPAD) * 1024 + 16 * cq;
        const LAS unsigned char* vb1 = lds + OFF_V + rowl * 128 + (8 * w + VPAD) * 1024 + 16 * (cq ^ 4);
#define HY_LDA(An_, m_) do { const LAS unsigned char* p_ = pa - 128 * (m_); _Pragma("unroll") for (int mt = 0; mt < 4; ++mt) { \
            const bf16x4 lo_ = *(const LAS bf16x4*)(p_ + 32 * (3 - mt)), hi_ = *(const LAS bf16x4*)(p_ + 32 * (3 - mt) + 8); An_[mt] = __builtin_shufflevector(lo_, hi_, 0, 1, 2, 3, 4, 5, 6, 7); } } while (0)
#define HY_LDB(B_, m_, PAR_) do { const LAS unsigned char* p0_ = ((PAR_) ? vb1 : vb0) - 1024 * (m_); const LAS unsigned char* p1_ = ((PAR_) ? vb0 : vb1) - 1024 * (m_); \
            _Pragma("unroll") for (int nt = 0; nt < 4; ++nt) { B_[0][nt] = *(const LAS bf16x8*)(p0_ + 2048 * nt); B_[1][nt] = *(const LAS bf16x8*)(p1_ + 2048 * nt); } } while (0)
#define HY_MMA(An_, Ao0_, Ao1_, B_, m_) do { _Pragma("unroll") for (int nt = 0; nt < 4; ++nt) { const int a0_ = 8 * w + 2 * nt - (m_); if (a0_ + 1 >= 0 && a0_ <= 63) { \
            _Pragma("unroll") for (int mt = 0; mt < 4; ++mt) acc[mt][nt] = __builtin_amdgcn_mfma_f32_16x16x32_bf16(An_[mt], B_[0][nt], acc[mt][nt], 0, 0, 0); \
            acc[0][nt] = __builtin_amdgcn_mfma_f32_16x16x32_bf16(Ao0_, B_[1][nt], acc[0][nt], 0, 0, 0); acc[1][nt] = __builtin_amdgcn_mfma_f32_16x16x32_bf16(Ao1_, B_[1][nt], acc[1][nt], 0, 0, 0); \
            acc[2][nt] = __builtin_amdgcn_mfma_f32_16x16x32_bf16(An_[0], B_[1][nt], acc[2][nt], 0, 0, 0); acc[3][nt] = __builtin_amdgcn_mfma_f32_16x16x32_bf16(An_[1], B_[1][nt], acc[3][nt], 0, 0, 0); } } } while (0)
        bf16x8 Aa[4], Ab[4], Ba[2][4], Bb[2][4], o0, o1;
        const int m0 = 8 * w - 63, mlast = 8 * w + 7;
        { bf16x8 t_[4]; HY_LDA(t_, m0 - 1); o0 = t_[2]; o1 = t_[3]; }
        HY_LDA(Aa, m0); HY_LDB(Ba, m0, 0);
        for (int m = m0; m < mlast; m += 2) {
            HY_LDA(Ab, m + 1); HY_LDB(Bb, m + 1, 1);
            HY_MMA(Aa, o0, o1, Ba, m);
            o0 = Aa[2]; o1 = Aa[3];
            HY_LDA(Aa, m + 2); HY_LDB(Ba, m + 2, 0);
            HY_MMA(Ab, o0, o1, Bb, m + 1);
            o0 = Ab[2]; o1 = Ab[3];
        }
        HY_MMA(Aa, o0, o1, Ba, mlast);
#undef HY_LDA
#undef HY_LDB
#undef HY_MMA
    }
    PSTAMP_H(lds, 18);
    __syncthreads();
    {
        constexpr int YRS = 8208;
        const float inn = 1.0f / ((const float*)(ws + WS_CTL))[CW_NORM + l * 512 + c], hb = a.in[21][l * 512 + c];
        const int b = l15 & 7;
#pragma unroll
        for (int nt = 0; nt < 4; ++nt) {
            const int ab = 8 * w + 2 * nt + (l15 >> 3), R = (ab + VPAD) * 8 + b;
#pragma unroll
            for (int mt = 0; mt < 4; ++mt) {
                const int t = 64 * ab + 16 * mt + 4 * q;
                const v2u vw = *(const LAS v2u*)(lds + OFF_V + R * 128 + 16 * ((2 * mt + (q >> 1)) ^ ((R >> 1) & 7)) + 8 * (q & 1));
                const float y0 = acc[mt][nt][0] * inn + bf2f((unsigned short)(vw.x & 0xffffu)) * hb, y1 = acc[mt][nt][1] * inn + bf2f((unsigned short)(vw.x >> 16)) * hb;
                const float y2 = acc[mt][nt][2] * inn + bf2f((unsigned short)(vw.y & 0xffffu)) * hb, y3 = acc[mt][nt][3] * inn + bf2f((unsigned short)(vw.y >> 16)) * hb;
                v2u yw; yw.x = pk2(y0, y1); yw.y = pk2(y2, y3);
                *(LAS v2u*)(lds + OFF_F + b * YRS + 2 * t) = yw;
            }
        }
        __syncthreads();
        bf16* OBT = (bf16*)(ws + WS_OBT) + (size_t)c * MTOK;
        int tid2 = tid; asm volatile("" : "+v"(tid2));
        for (int bt = 0; bt < 4; ++bt) {
            v4u xw[2], gw[2]; unsigned short hx[2][2];
#pragma unroll
            for (int j = 0; j < 2; ++j) {
                const int e = tid2 + NTHR * (2 * bt + j), bb = e >> 9, t0 = (e & 511) * 8;
                const size_t base = (size_t)bb * LX + t0;
                xw[j] = *(const v4u*)(x0r + base); gw[j] = *(const v4u*)(gbr + base);
                hx[j][0] = x0r[t0 > 0 ? base - 1 : base]; hx[j][1] = x0r[t0 + 8 < LX ? base + 8 : base];
            }
#pragma unroll
            for (int j = 0; j < 2; ++j) {
                const int e = tid2 + NTHR * (2 * bt + j), bb = e >> 9, t0 = (e & 511) * 8;
                const size_t base = (size_t)bb * LX + t0;
                const v4u yw = *(const LAS v4u*)(lds + OFF_F + bb * YRS + 2 * t0);
                float xs[10], o[8];
                xs[0] = t0 > 0 ? bf2f(hx[j][0]) : 0.f; xs[9] = t0 + 8 < LX ? bf2f(hx[j][1]) : 0.f;
#pragma unroll
                for (int d = 0; d < 4; ++d) { xs[1 + 2 * d] = bf2f((unsigned short)(xw[j][d] & 0xffffu)); xs[2 + 2 * d] = bf2f((unsigned short)(xw[j][d] >> 16)); }
#pragma unroll
                for (int d = 0; d < 8; ++d) {
                    const float yv = bf2f((unsigned short)((d & 1) ? (yw[d >> 1] >> 16) : (yw[d >> 1] & 0xffffu)));
                    const float gv = bf2f((unsigned short)((d & 1) ? (gw[j][d >> 1] >> 16) : (gw[j][d >> 1] & 0xffffu)));
                    o[d] = yv * (cw.x0[3] + cw.x0[0] * xs[d] + cw.x0[1] * xs[d + 1] + cw.x0[2] * xs[d + 2]) * silu_f(gv);
                }
                v4u ow; ow.x = pk2(o[0], o[1]); ow.y = pk2(o[2], o[3]); ow.z = pk2(o[4], o[5]); ow.w = pk2(o[6], o[7]);
                *(v4u*)(OBT + base) = ow;
            }
        }
    }
    PSTAMP_H(lds, 19);
    __syncthreads();
}
__device__ __forceinline__ void hyena_ctx_channel(LAS unsigned char* lds, const Args& a, const int c) {
    int tid_ = threadIdx.x; asm volatile("" : "+v"(tid_));
    const int tid = tid_;
    unsigned char* ws = a.ws;
    const bf16* PB = (const bf16*)(ws + WS_PB);
    const bf16* x0r = PB + (size_t)c * MTOK + MLAT; const bf16* x1r = PB + (size_t)(512 + c) * MTOK + MLAT; const bf16* vr = PB + (size_t)(1024 + c) * MTOK + MLAT; const bf16* gbr = PB + (size_t)(1536 + c) * MTOK + MLAT;
    const ConvW cw = load_convw(a, 0, c);
    LAS float* vvc = (LAS float*)lds;
    LAS float* Fc = vvc + 2048;
    for (int e = tid; e < 2048; e += NTHR) {
        const int t = e & 255;
        const float vm_ = bf2f(vr[t > 0 ? e - 1 : e]), v0 = bf2f(vr[e]), vp_ = bf2f(vr[t < 255 ? e + 1 : e]);
        const float xm_ = bf2f(x1r[t > 0 ? e - 1 : e]), x0 = bf2f(x1r[e]), xp_ = bf2f(x1r[t < 255 ? e + 1 : e]);
        const float vm = t > 0 ? vm_ : 0.f, vp = t < 255 ? vp_ : 0.f, xm = t > 0 ? xm_ : 0.f, xp = t < 255 ? xp_ : 0.f;
        vvc[e] = (cw.v[3] + cw.v[0] * vm + cw.v[1] * v0 + cw.v[2] * vp) * (cw.x1[3] + cw.x1[0] * xm + cw.x1[1] * x0 + cw.x1[2] * xp);
    }
    if (tid < 520) Fc[tid] = tid < 512 ? bf2f(((const bf16*)(ws + WS_FGC))[(size_t)c * FZC + tid]) : 0.f;
    __syncthreads();
    const float inn = 1.0f / ((const float*)(ws + WS_CTL))[CW_NORM + 2 * 512 + c], hb = a.in[21][c];
    bf16* OBT = (bf16*)(ws + WS_OBT) + (size_t)c * MTOK + MLAT;
    {
        const int b = tid >> 6, t0 = 4 * (tid & 63), e0 = b * 256 + t0;
        float acc4[4] = {0.f, 0.f, 0.f, 0.f};
        const LAS float* fp = Fc + 252 - t0;
        for (int s4 = 0; s4 < 64; ++s4) {
            const f32x4 ga = *(const LAS f32x4*)(fp + 4 * s4), gb = *(const LAS f32x4*)(fp + 4 * s4 + 4), vq = *(const LAS f32x4*)(vvc + b * 256 + 4 * s4);
            const float g[8] = {ga[0], ga[1], ga[2], ga[3], gb[0], gb[1], gb[2], gb[3]};
#pragma unroll
            for (int i = 0; i < 4; ++i)
#pragma unroll
                for (int u = 0; u < 4; ++u) acc4[i] += g[4 - i + u] * vq[u];
        }
        float xs[6], gv[4];
        xs[0] = t0 > 0 ? bf2f(x0r[e0 - 1]) : 0.f;
#pragma unroll
        for (int i = 0; i < 4; ++i) { xs[1 + i] = bf2f(x0r[e0 + i]); gv[i] = bf2f(gbr[e0 + i]); }
        xs[5] = t0 + 4 < 256 ? bf2f(x0r[e0 + 4]) : 0.f;
        float o[4];
#pragma unroll
        for (int i = 0; i < 4; ++i) o[i] = (acc4[i] * inn + vvc[e0 + i] * hb) * (cw.x0[3] + cw.x0[0] * xs[i] + cw.x0[1] * xs[i + 1] + cw.x0[2] * xs[i + 2]) * silu_f(gv[i]);
        v2u ow; ow.x = pk2(o[0], o[1]); ow.y = pk2(o[2], o[3]);
        *(v2u*)(OBT + e0) = ow;
    }
    __syncthreads();
}
}


__device__ __forceinline__ void phase_mix(const Args& a, Frame& F, const int l, const int part = -1) {
    unsigned* qctr = (unsigned*)(a.ws + WS_CTL) + CW_QUEUE + 64 * l + (part == 1 ? 128 : 0);
    volatile LAS int* slot = (volatile LAS int*)(F.lds + LDS_BYTES - 64);
    const int ntasks = l == 0 ? 64 + 512 + 64 + 512 : 64 + 512;
    for (;;) {
        if (F.tid == 0) slot[0] = (int)atomicAdd(qctr, 1u);
        __syncthreads();
        const int t = __builtin_amdgcn_readfirstlane(slot[0]);
        __syncthreads();
        if (t >= ntasks) break;
        if (part == 0 && !(t < 64 || (t >= 576 && t < 640))) continue;
        if (part == 1 && (t < 64 || (t >= 576 && t < 640))) continue;
        if (t < 64) scan::scan_unit(F.lds, (bf16*)(a.ws + WS_PA), (bf16*)(a.ws + WS_OC), t >> 3, (t >> 1) & 3, t & 1, false);
        else if (t < 576) hy::hyena_channel(F.lds, a, l, t - 64);
        else if (t < 640) { const int u = t - 576; scan::scan_unit(F.lds, (bf16*)(a.ws + WS_PA), (bf16*)(a.ws + WS_OC), u >> 3, (u >> 1) & 3, u & 1, true); }
        else hy::hyena_ctx_channel(F.lds, a, t - 640);
        __syncthreads();
    }
}

__device__ __forceinline__ void phase_finalize_ox(const Args& a, Frame& F, int l) {
    unsigned char* ws = a.ws;
    const bf16* PA = (const bf16*)(ws + WS_PA);
    const bf16* OC = (const bf16*)(ws + WS_OC);
    bf16* XA = (bf16*)(ws + WS_XA);
    const float* gnw = a.in[10] + l * 512;
    const int gw = F.vcu * NWAVES + F.wave, NGW = F.G * NWAVES;
    const int ntok = (l == 0) ? MTOK : MLAT;
    for (int tok = gw; tok < ntok; tok += NGW) {
        const bool isctx = tok >= MLAT;
        const int c8 = 8 * F.lane;
        const bf16* pf = isctx ? OC + (size_t)(tok - MLAT) * 512 + c8 : PA + (size_t)tok * PA_LD + 512 + c8;
        const bf16* pb = isctx ? OC + (size_t)MCTX * 512 + (size_t)(tok - MLAT) * 512 + c8 : PA + (size_t)tok * PA_LD + 1024 + c8;
        const v4u wf = *(const v4u*)pf, wb = *(const v4u*)pb, wg = *(const v4u*)(PA + (size_t)tok * PA_LD + 2048 + c8);
        float o[8], g[8];
#pragma unroll
        for (int e = 0; e < 4; ++e) {
            o[2 * e] = bf2f((unsigned short)(wf[e] & 0xffff)) + bf2f((unsigned short)(wb[e] & 0xffff));
            o[2 * e + 1] = bf2f((unsigned short)(wf[e] >> 16)) + bf2f((unsigned short)(wb[e] >> 16));
            g[2 * e] = bf2f((unsigned short)(wg[e] & 0xffff)); g[2 * e + 1] = bf2f((unsigned short)(wg[e] >> 16));
        }
        float s = 0.f;
#pragma unroll
        for (int e = 0; e < 8; ++e) s += o[e] * o[e];
        s += __shfl_xor(s, 1); s += __shfl_xor(s, 2); s += __shfl_xor(s, 4); s += __shfl_xor(s, 8);
        const float rstd = 1.0f / sqrtf(s * (1.0f / HD) + EPS);
        float y[8];
#pragma unroll
        for (int e = 0; e < 8; ++e) y[e] = o[e] * rstd * gnw[c8 + e] * silu_f(g[e]);
        v4u w; w.x = pk2(y[0], y[1]); w.y = pk2(y[2], y[3]); w.z = pk2(y[4], y[5]); w.w = pk2(y[6], y[7]);
        *(v4u*)(XA + (size_t)tok * D + c8) = w;
    }
    LAS unsigned short* t = (LAS unsigned short*)(F.lds + F.wave * 16384);
    const int ntt = ntok / 64;
    for (int it = gw; it < 8 * ntt; it += NGW) {
        const int ct = it / ntt, tt = it % ntt, c0 = ct * 64, t0 = tt * 64;
        const bf16* OBT = (const bf16*)(ws + WS_OBT);
#pragma unroll
        for (int i = 0; i < 8; ++i) {
            const int e = F.lane + 64 * i, c = e >> 3, ch = e & 7;
            const v4u w = *(const v4u*)(OBT + (size_t)(c0 + c) * MTOK + t0 + 8 * ch);
#pragma unroll
            for (int q = 0; q < 4; ++q) { t[c * 66 + 8 * ch + 2 * q] = (unsigned short)(w[q] & 0xffff); t[c * 66 + 8 * ch + 2 * q + 1] = (unsigned short)(w[q] >> 16); }
        }
        asm volatile("s_waitcnt lgkmcnt(0)" ::: "memory");
#pragma unroll
        for (int i = 0; i < 8; ++i) {
            const int e = F.lane + 64 * i, tk = e >> 3, cg = e & 7;
            unsigned short h[8];
#pragma unroll
            for (int q = 0; q < 8; ++q) h[q] = t[(8 * cg + q) * 66 + tk];
            v4u w; w.x = h[0] | ((unsigned)h[1] << 16); w.y = h[2] | ((unsigned)h[3] << 16); w.z = h[4] | ((unsigned)h[5] << 16); w.w = h[6] | ((unsigned)h[7] << 16);
            *(v4u*)(XA + (size_t)(t0 + tk) * D + 512 + c0 + 8 * cg) = w;
        }
        asm volatile("s_waitcnt lgkmcnt(0)" ::: "memory");
    }
}

__device__ __forceinline__ void phase_final_norm(const Args& a, Frame& F) {
    const float* w = a.in[22];
    const bf16* DL = (const bf16*)(a.ws + WS_PB);
    const int gw = F.vcu * NWAVES + F.wave, NGW = F.G * NWAVES;
    for (int tok = gw; tok < MLAT; tok += NGW) {
        float* xr = a.out + (size_t)tok * D;
        f32x4 v[4]; float s = 0.f;
#pragma unroll
        for (int j = 0; j < 4; ++j) { v[j] = *(const f32x4*)(xr + 256 * j + 4 * F.lane); const v2u dw = *(const v2u*)(DL + (size_t)tok * D + 256 * j + 4 * F.lane);
            v[j].x += bf2f((unsigned short)(dw.x & 0xffffu)); v[j].y += bf2f((unsigned short)(dw.x >> 16)); v[j].z += bf2f((unsigned short)(dw.y & 0xffffu)); v[j].w += bf2f((unsigned short)(dw.y >> 16));
            s += (v[j].x * v[j].x + v[j].y * v[j].y) + (v[j].z * v[j].z + v[j].w * v[j].w); }
        const float rstd = 1.0f / sqrtf(wave_sum(s) * (1.0f / D) + EPS);
#pragma unroll
        for (int j = 0; j < 4; ++j) { const f32x4 w4 = *(const f32x4*)(w + 256 * j + 4 * F.lane); *(f32x4*)(xr + 256 * j + 4 * F.lane) = v[j] * rstd * w4; }
    }
}

enum { PH_PRO = 0, PH_NORM0 = 1, PH_IN0 = 2, PH_MIX0 = 3, PH_FIN0 = 4, PH_OUT0 = 5, PH_NORM1 = 6, PH_IN1 = 7, PH_MIX1 = 8, PH_FIN1 = 9, PH_OUT1 = 10, PH_FINAL = 11 };

__device__ __forceinline__ Frame mkframe(unsigned char* lds) {
    Frame F;
    F.lds = (LAS unsigned char*)lds;
    F.tid = threadIdx.x; F.lane = F.tid & 63; F.wave = __builtin_amdgcn_readfirstlane(F.tid >> 6);
    F.G = gridDim.x; { const int bx = blockIdx.x; F.vcu = (F.G % 8 == 0) ? (bx % 8) * (F.G / 8) + bx / 8 : bx; }
    return F;
}
template <int l> __device__ __forceinline__ void run_inproj(const Args& args, unsigned char* lds) {
    unsigned char* ws = args.ws; Frame F = mkframe(lds);
    pg8::Gemm g{(const bf16*)(ws + WS_XA), (const bf16*)(ws + WS_WIN) + (size_t)l * NIN * D, D};
    pg8::Sched S; S.init(128, 18, F.G, (int)blockIdx.x, 8, l == 0 ? 18 : 8);
    EpiIn E{(bf16*)(ws + WS_PA), (bf16*)(ws + WS_PB), (const float*)(ws + WS_LBS) + l * 1024};
    pg8::gemm_phase<EpiIn, true, true>(F.lds, g, S, E);
}
template <int l> __device__ __forceinline__ void run_outproj(const Args& args, unsigned char* lds) {
    unsigned char* ws = args.ws; Frame F = mkframe(lds);
    pg8::Gemm g{(const bf16*)(ws + WS_XA), (const bf16*)(ws + WS_WOUT) + (size_t)l * D * D, D};
    pg8::Sched S; S.init(128, 4, F.G, (int)blockIdx.x, l == 0 ? 8 : 0, 4);
    EpiOut E{(bf16*)(ws + WS_PB), (const float*)(ws + WS_MOD) + (size_t)l * 9 * 3 * D};
    pg8::gemm_phase<EpiOut, true, true>(F.lds, g, S, E);
}
__global__ void __launch_bounds__(NTHR, 2) mega(Args args) {
    extern __shared__ __attribute__((aligned(16))) unsigned char lds[];
    const int lo = args.ph_lo, hi = args.ph_hi;
#define IN(k) (lo <= (k) && (k) < hi)
    volatile LAS unsigned* bst = (volatile LAS unsigned*)((LAS unsigned char*)lds + LDS_BYTES - 32);
    if (threadIdx.x < 8) ((volatile LAS unsigned*)((LAS unsigned char*)lds + LDS_BYTES - 32))[threadIdx.x] = 0u;
    __syncthreads();
    XcdBarrier bar; bar.bar = (unsigned*)(args.ws + WS_CTL) + CW_BAR; bar.x = 0; bar.st = bst;
    if (hi - lo > 1) bar = xcd_barrier_post((unsigned*)(args.ws + WS_CTL) + CW_BAR, bst);
#ifdef PROBE_ID
    volatile LAS unsigned long long* pts = (volatile LAS unsigned long long*)((LAS unsigned char*)lds + LDS_BYTES - 512);
    if (threadIdx.x == 0) pts[0] = __builtin_amdgcn_s_memrealtime();
#define SEAM(k) do { if (IN((k) + 1)) xcd_barrier(bar); else __syncthreads(); if (threadIdx.x == 0) pts[(k) + 1] = __builtin_amdgcn_s_memrealtime(); } while (0)
#else
#define SEAM(k) do { if (IN((k) + 1)) xcd_barrier(bar); else __syncthreads(); } while (0)
#endif
    if (IN(PH_PRO)) { Frame F = mkframe(lds); phase_prologue(args, F); SEAM(PH_PRO); }
    if (IN(PH_NORM0)) { Frame F = mkframe(lds); phase_normrows(args, F, 0, args.in[0], args.in[2]); SEAM(PH_NORM0); }
    if (IN(PH_IN0)) { run_inproj<0>(args, lds); { Frame F = mkframe(lds); phase_filters_l0(args, F); } SEAM(PH_IN0); }
#ifdef SPLIT_MIX
    if (IN(PH_MIX0)) { Frame F = mkframe(lds); phase_mix(args, F, 0, 0); xcd_barrier(bar); if (threadIdx.x == 0) pts[15] = __builtin_amdgcn_s_memrealtime(); phase_mix(args, F, 0, 1); SEAM(PH_MIX0); }
#else
    if (IN(PH_MIX0)) { Frame F = mkframe(lds); phase_mix(args, F, 0); SEAM(PH_MIX0); }
#endif
    if (IN(PH_FIN0)) { Frame F = mkframe(lds); phase_finalize_ox(args, F, 0); SEAM(PH_FIN0); }
    if (IN(PH_OUT0)) { run_outproj<0>(args, lds); { Frame F = mkframe(lds); phase_filters_l1(args, F); } SEAM(PH_OUT0); }
    if (IN(PH_NORM1)) { Frame F = mkframe(lds); phase_normrows(args, F, 1, args.in[0], args.in[2]); SEAM(PH_NORM1); }
    if (IN(PH_IN1)) { run_inproj<1>(args, lds); SEAM(PH_IN1); }
    if (IN(PH_MIX1)) { Frame F = mkframe(lds); phase_mix(args, F, 1); SEAM(PH_MIX1); }
    if (IN(PH_FIN1)) { Frame F = mkframe(lds); phase_finalize_ox(args, F, 1); SEAM(PH_FIN1); }
    if (IN(PH_OUT1)) { run_outproj<1>(args, lds); SEAM(PH_OUT1); }
    if (IN(PH_FINAL)) { Frame F = mkframe(lds); phase_final_norm(args, F); SEAM(PH_FINAL); }
#ifdef PROBE_ID
    if (blockIdx.x == 0 && threadIdx.x == 0) {
#ifdef SPLIT_MIX
        const unsigned long long dt = (PROBE_ID == 100) ? pts[15] - pts[PH_MIX0] : pts[PH_MIX0 + 1] - pts[15];
#else
        const unsigned long long dt = (PROBE_ID >= 200) ? ((PROBE_ID == 220 || PROBE_ID >= 226) ? 1ull : 16ull) * (pts[PROBE_ID - 200 + 1] - pts[PROBE_ID - 200]) : pts[PROBE_ID + 1] - pts[PROBE_ID];
#endif
        const unsigned long long t0 = __builtin_amdgcn_s_memrealtime();
        unsigned long long wt = 4ull * dt; if (wt > 300000ull) wt = 300000ull;
        while (__builtin_amdgcn_s_memrealtime() - t0 < wt) __builtin_amdgcn_s_sleep(8);
    }
#endif
#undef IN
#undef SEAM
}

extern "C" void kernel_launch(void* const* d_in, const int* in_sizes, int n_in, void* d_out, int out_size, void* d_ws, size_t ws_size, hipStream_t stream) {
    static int grid = 0;
    if (grid == 0) {
        if (n_in != 23 || ws_size < WS_END) { fprintf(stderr, "kernel_launch: unexpected n_in %d / ws_size %zu\n", n_in, ws_size); grid = -1; return; }
        int dev = 0, cus = 0;
        if (hipGetDevice(&dev) != hipSuccess || hipDeviceGetAttribute(&cus, hipDeviceAttributeMultiprocessorCount, dev) != hipSuccess) { grid = -1; return; }
        if (hipFuncSetAttribute((const void*)mega, hipFuncAttributeMaxDynamicSharedMemorySize, LDS_BYTES) != hipSuccess) { fprintf(stderr, "kernel_launch: hipFuncSetAttribute failed\n"); grid = -1; return; }
        grid = cus;
    }
    if (grid < 0) return;
    (void)hipMemsetAsync((char*)d_ws + WS_CTL, 0, CTL_ZERO_BYTES, stream);
    Args a{};
    for (int i = 0; i < 23; ++i) a.in[i] = (const float*)d_in[i];
    a.out = (float*)d_out; a.ws = (unsigned char*)d_ws;
    a.ph_lo = 0; a.ph_hi = PH_FINAL + 1;
    hipLaunchKernelGGL(mega, dim3(grid), dim3(NTHR), LDS_BYTES, stream, a);
}
```

```cpp
#include <hip/hip_runtime.h>
#include <cstdio>
#include <cstdint>
#include <math.h>

namespace pg8 {
#define PG8_LAS __attribute__((address_space(3)))
typedef unsigned short bf16_t;
typedef short bf16x8 __attribute__((ext_vector_type(8)));
typedef float f32x4 __attribute__((ext_vector_type(4)));
typedef unsigned u32x4 __attribute__((ext_vector_type(4)));
typedef unsigned u32x2 __attribute__((ext_vector_type(2)));
constexpr int BM = 256, BK = 64, HALF = 128, HTB = HALF * BK * 2, STAGE_BYTES = 8 * HTB, NXCD = 8, WGM = 8;

__host__ __device__ __forceinline__ int lds_byte(int r, int c) { const int st = (r >> 4) * 2 + (c >> 5), rr = r & 15, cc = c & 31, ob = rr * 64 + cc * 2; return st * 1024 + (ob ^ (((ob >> 9) & 1) << 5)); }
__host__ __device__ __forceinline__ void stage_rc(int b, int& R, int& C) { const int st = b / 1024, sb = b % 1024, swz = sb ^ (((sb >> 9) & 1) << 5); R = (st >> 1) * 16 + swz / 64; C = (st & 1) * 32 + (swz % 64) / 2; }
__host__ __device__ __forceinline__ int perm32(int rho) { const int n = rho >> 4, i = rho & 15; return 8 * (i >> 2) + 4 * n + (i & 3); }

struct Unit { int pm, pn; };
struct Gemm { const bf16_t* A; const bf16_t* Bt; int K; };

struct Sched {
    int nM, nN, nwg, G, c, nctx, nctxN;
    __device__ void init(int nM_, int nN_, int G_, int c_, int nctxM, int nctxN_) { nM = nM_; nN = nN_; nwg = nM * nN; G = G_; c = c_; nctx = nctxM * nctxN_; nctxN = nctxN_ > 0 ? nctxN_ : 1; }
    __device__ bool next(int i, Unit& u) const {
        const long L = (long)i * G + c;
        if (L >= nwg) { const long L2 = L - nwg; if (L2 >= nctx) return false; u.pm = nM + (int)(L2 / nctxN); u.pn = (int)(L2 % nctxN); return true; }
        int wgid = (int)L; { const int q = nwg / NXCD, r = nwg % NXCD, xcd = wgid % NXCD, off = wgid / NXCD; wgid = (xcd < r ? xcd * (q + 1) : r * (q + 1) + (xcd - r) * q) + off; }
        const int nig = WGM * nN, gid = wgid / nig, fm = gid * WGM, gsz = (nM - fm) < WGM ? (nM - fm) : WGM;
        u.pm = fm + ((wgid % nig) % gsz); u.pn = (wgid % nig) / gsz; return true;
    }
};

template <class Epi, bool ALIGN_EPI, bool SP2>
__device__ __forceinline__ void gemm_phase(PG8_LAS unsigned char* lds, const Gemm g, const Sched& S, const Epi& E) {
    const int tid = threadIdx.x, wid = __builtin_amdgcn_readfirstlane(tid >> 6), lane = tid & 63, wr = wid >> 2, wc = wid & 3, fr = lane & 15, fq = lane >> 4;
    const int K = g.K, nt = K / BK;
    unsigned voffA[2], voffB[2];
#pragma unroll
    for (int i = 0; i < 2; ++i) { int R, C; stage_rc(tid * 16 + i * 8192, R, C); const int Rb = Epi::PERM ? ((R & ~31) + perm32(R & 31)) : R;
        voffA[i] = (unsigned)(R * K + C) * 2u; voffB[i] = (unsigned)(Rb * K + C) * 2u; }
    const size_t kstep = (size_t)(BK * 2);
    const size_t hstep = (size_t)HALF * K * 2;
    const size_t tstep = 2 * hstep;
    const unsigned ldsw = (unsigned)wid * 1024u;
    const int aoff = lds_byte(wr * 64 + fr, fq * 8), boff = lds_byte(wc * 32 + fr, fq * 8);
#define PG8_SA(b, h) (((b) * 2 + (h)) * HTB)
#define PG8_SB(b, h) ((4 + (b) * 2 + (h)) * HTB)
#define PG8_STAGE(bufoff, gbase, voff) do { _Pragma("unroll") for (int _i = 0; _i < 2; ++_i) \
        __builtin_amdgcn_global_load_lds((const unsigned*)((const char*)(gbase) + (voff)[_i]), (PG8_LAS unsigned*)(lds + (bufoff) + ldsw + _i * 8192), 16, 0, 0); } while (0)
#define PG8_LDA(dst, b, h) do { _Pragma("unroll") for (int m = 0; m < 4; ++m) _Pragma("unroll") for (int k = 0; k < 2; ++k) dst[m][k] = *(const PG8_LAS bf16x8*)(lds + PG8_SA(b, h) + aoff + m * 2048 + k * 1024); } while (0)
#define PG8_LDB(dst, b, h) do { _Pragma("unroll") for (int n = 0; n < 2; ++n) _Pragma("unroll") for (int k = 0; k < 2; ++k) dst[n][k] = *(const PG8_LAS bf16x8*)(lds + PG8_SB(b, h) + boff + n * 2048 + k * 1024); } while (0)
#define PG8_MMA(ai, bj, At, Bt) do { __builtin_amdgcn_s_setprio(1); _Pragma("unroll") for (int m = 0; m < 4; ++m) _Pragma("unroll") for (int n = 0; n < 2; ++n) _Pragma("unroll") for (int k = 0; k < 2; ++k) \
        acc[ai][bj][m][n] = __builtin_amdgcn_mfma_f32_16x16x32_bf16(Bt[n][k], At[m][k], acc[ai][bj][m][n], 0, 0, 0); __builtin_amdgcn_s_setprio(0); } while (0)
#define PG8_WAIT_V(n) asm volatile("s_waitcnt vmcnt(" #n ")" ::: "memory")
#define PG8_WAIT_L(n) asm volatile("s_waitcnt lgkmcnt(" #n ")" ::: "memory")
#define PG8_BAR __builtin_amdgcn_s_barrier()
#define PG8_SCHED __builtin_amdgcn_sched_barrier(0)
    Unit cur, nxt; int ui = 0;
    if (!S.next(0, cur)) return;
    f32x4 acc[2][2][4][2];
#pragma unroll
    for (int a = 0; a < 2; ++a)
#pragma unroll
        for (int b = 0; b < 2; ++b)
#pragma unroll
            for (int m = 0; m < 4; ++m)
#pragma unroll
                for (int n = 0; n < 2; ++n) acc[a][b][m][n] = (f32x4){0.f, 0.f, 0.f, 0.f};
    bf16x8 At[4][2], B0[2][2], B1[2][2];
    const char* cA = E.swap(cur) ? (const char*)g.Bt + (size_t)cur.pn * tstep : (const char*)g.A + (size_t)cur.pm * tstep;
    const char* cB = E.swap(cur) ? (const char*)g.A + (size_t)cur.pm * tstep : (const char*)g.Bt + (size_t)cur.pn * tstep;
    if constexpr (SP2) {
        PG8_STAGE(PG8_SB(0, 0), cB, voffB); PG8_STAGE(PG8_SB(0, 1), cB + hstep, voffB); PG8_STAGE(PG8_SA(0, 0), cA, voffA); PG8_STAGE(PG8_SA(0, 1), cA + hstep, voffA);
        if (wr == 1) PG8_BAR;
        PG8_WAIT_V(2); PG8_BAR;
        PG8_STAGE(PG8_SB(1, 0), cB + kstep, voffB); PG8_STAGE(PG8_SA(1, 0), cA + kstep, voffA); PG8_STAGE(PG8_SB(1, 1), cB + hstep + kstep, voffB);
        PG8_WAIT_V(6); PG8_BAR;
    } else {
        PG8_STAGE(PG8_SB(0, 0), cB, voffB); PG8_STAGE(PG8_SA(0, 0), cA, voffA); PG8_STAGE(PG8_SB(0, 1), cB + hstep, voffB); PG8_STAGE(PG8_SA(0, 1), cA + hstep, voffA);
        if (wr == 1) PG8_BAR;
        PG8_WAIT_V(4); PG8_BAR;
        PG8_STAGE(PG8_SB(1, 0), cB + kstep, voffB); PG8_STAGE(PG8_SA(1, 0), cA + kstep, voffA); PG8_STAGE(PG8_SB(1, 1), cB + hstep + kstep, voffB);
        PG8_WAIT_V(6); PG8_BAR;
    }
    for (;;) {
        const bool has_next = S.next(ui + 1, nxt);
        const bool nsw = has_next && E.swap(nxt);
        const char* nA = has_next ? (nsw ? (const char*)g.Bt + (size_t)nxt.pn * tstep : (const char*)g.A + (size_t)nxt.pm * tstep) : cA;
        const char* nB = has_next ? (nsw ? (const char*)g.A + (size_t)nxt.pm * tstep : (const char*)g.Bt + (size_t)nxt.pn * tstep) : cB;
        for (int t = 0; t < nt; t += 2) {
            const bool last = (t == nt - 2);
            const char* a1 = cA + (size_t)(t + 1) * kstep;
            const char* a2 = last ? nA : cA + (size_t)(t + 2) * kstep; const char* b2 = last ? nB : cB + (size_t)(t + 2) * kstep;
            const char* a3 = a2 + kstep; const char* b3 = b2 + kstep;
            if constexpr (SP2) {
            PG8_LDB(B0, 0, 0); PG8_LDB(B1, 0, 1); PG8_SCHED; PG8_LDA(At, 0, 0); PG8_STAGE(PG8_SA(1, 1), a1 + hstep, voffA);
            PG8_WAIT_V(8); PG8_WAIT_L(0); PG8_BAR; PG8_MMA(0, 0, At, B0); PG8_MMA(0, 1, At, B1); PG8_BAR; PG8_SCHED;
            PG8_LDA(At, 0, 1); PG8_STAGE(PG8_SB(0, 0), b2, voffB); PG8_STAGE(PG8_SB(0, 1), b2 + hstep, voffB); PG8_STAGE(PG8_SA(0, 0), a2, voffA);
            PG8_WAIT_V(8); PG8_WAIT_L(0); PG8_BAR; PG8_MMA(1, 0, At, B0); PG8_MMA(1, 1, At, B1); PG8_BAR; PG8_SCHED;
            PG8_LDB(B0, 1, 0); PG8_LDB(B1, 1, 1); PG8_SCHED; PG8_LDA(At, 1, 0); PG8_STAGE(PG8_SA(0, 1), a2 + hstep, voffA);
            PG8_WAIT_V(8); PG8_WAIT_L(0); PG8_BAR; PG8_MMA(0, 0, At, B0); PG8_MMA(0, 1, At, B1); PG8_BAR; PG8_SCHED;
            PG8_LDA(At, 1, 1); PG8_STAGE(PG8_SB(1, 0), b3, voffB); PG8_STAGE(PG8_SB(1, 1), b3 + hstep, voffB); PG8_STAGE(PG8_SA(1, 0), a3, voffA);
            PG8_WAIT_V(8); PG8_WAIT_L(0); PG8_BAR; PG8_MMA(1, 0, At, B0); PG8_MMA(1, 1, At, B1); PG8_BAR; PG8_SCHED;
            } else {
            PG8_LDB(B0, 0, 0); PG8_SCHED; PG8_LDA(At, 0, 0); PG8_STAGE(PG8_SA(1, 1), a1 + hstep, voffA);
            PG8_WAIT_L(8); PG8_BAR; PG8_WAIT_L(0); PG8_MMA(0, 0, At, B0); PG8_BAR; PG8_SCHED;
            PG8_LDB(B1, 0, 1); PG8_STAGE(PG8_SB(0, 0), b2, voffB);
            PG8_BAR; PG8_WAIT_L(0); PG8_MMA(0, 1, At, B1); PG8_BAR;
            PG8_LDA(At, 0, 1); PG8_STAGE(PG8_SA(0, 0), a2, voffA);
            PG8_BAR; PG8_WAIT_L(0); PG8_MMA(1, 0, At, B0); PG8_BAR; PG8_SCHED;
            PG8_STAGE(PG8_SB(0, 1), b2 + hstep, voffB);
            PG8_WAIT_V(6); PG8_BAR; PG8_MMA(1, 1, At, B1); PG8_BAR;
            PG8_LDB(B0, 1, 0); PG8_SCHED; PG8_LDA(At, 1, 0); PG8_STAGE(PG8_SA(0, 1), a2 + hstep, voffA);
            PG8_WAIT_L(8); PG8_BAR; PG8_WAIT_L(0); PG8_MMA(0, 0, At, B0); PG8_BAR; PG8_SCHED;
            PG8_LDB(B1, 1, 1); PG8_STAGE(PG8_SB(1, 0), b3, voffB);
            PG8_BAR; PG8_WAIT_L(0); PG8_MMA(0, 1, At, B1); PG8_BAR;
            PG8_LDA(At, 1, 1); PG8_STAGE(PG8_SA(1, 0), a3, voffA);
            PG8_BAR; PG8_WAIT_L(0); PG8_MMA(1, 0, At, B0); PG8_BAR; PG8_SCHED;
            PG8_STAGE(PG8_SB(1, 1), b3 + hstep, voffB);
            PG8_WAIT_V(6); PG8_BAR; PG8_MMA(1, 1, At, B1); PG8_BAR;
            }
        }
        if constexpr (ALIGN_EPI) { if (wr == 0) PG8_BAR; }
        E(acc, cur, wr, wc, fr, fq);
        if (!has_next) break;
#pragma unroll
        for (int a = 0; a < 2; ++a)
#pragma unroll
            for (int b = 0; b < 2; ++b)
#pragma unroll
                for (int m = 0; m < 4; ++m)
#pragma unroll
                    for (int n = 0; n < 2; ++n) acc[a][b][m][n] = (f32x4){0.f, 0.f, 0.f, 0.f};
        cur = nxt; cA = nA; cB = nB; ++ui;
        if constexpr (ALIGN_EPI) { if (wr == 1) PG8_BAR; }
    }
    PG8_WAIT_V(0);
    if constexpr (!ALIGN_EPI) { if (wr == 0) PG8_BAR; }
    PG8_BAR;
#undef PG8_SA
#undef PG8_SB
#undef PG8_STAGE
#undef PG8_LDA
#undef PG8_LDB
#undef PG8_MMA
#undef PG8_WAIT_V
#undef PG8_WAIT_L
#undef PG8_BAR
#undef PG8_SCHED
}
}

constexpr int D = 1024, NB = 8, LX = 4096, LCX = 256, NIN = 4608, DA = 512, DB = 512, HD = 128;
constexpr int MLAT = NB * LX, MCTX = NB * LCX, MTOK = MLAT + MCTX;
constexpr int PA_LD = 3072;
constexpr int FZ = 8448, FZC = 640;
constexpr float EPS = 1e-6f;
constexpr float HY_MIN_DECAY = -3.0701134573253944f, HY_MAX_DECAY = -15.350567286626972f;
constexpr int NWAVES = 8, NTHR = 512;

constexpr size_t MiB = 1u << 20;
constexpr size_t WS_CTL = 0, CTL_ZERO_BYTES = 1 * MiB;
constexpr size_t WS_MOD = 1 * MiB;
constexpr size_t WS_LBS = WS_MOD + 256 * 1024;
constexpr size_t WS_WIN = 6 * MiB;
constexpr size_t WS_WOUT = 24 * MiB;
constexpr size_t WS_FG = 28 * MiB;
constexpr size_t WS_FGC = 45 * MiB;
constexpr size_t WS_CTX1 = 46 * MiB;
constexpr size_t WS_OC = 2 * MiB;
constexpr size_t WS_XA = 54 * MiB;
constexpr size_t WS_PA = 122 * MiB;
constexpr size_t WS_PB = 326 * MiB;
constexpr size_t WS_OBT = 462 * MiB;
constexpr size_t WS_HK = 326 * MiB;
constexpr size_t WS_SCL = 496 * MiB;
constexpr size_t WS_END = 504 * MiB;
constexpr int CW_NORM = 1024;
constexpr int CW_BAR = 8192;
constexpr int CW_QUEUE = 4096;

constexpr int LDS_BYTES = 156 * 1024;
#define LAS __attribute__((address_space(3)))
#define GAS __attribute__((address_space(1)))
typedef unsigned short bf16;
typedef unsigned v4u __attribute__((ext_vector_type(4)));
typedef unsigned v2u __attribute__((ext_vector_type(2)));
typedef float f32x4 __attribute__((ext_vector_type(4)));

typedef __bf16 bf2_t __attribute__((ext_vector_type(2)));
typedef float f2_t __attribute__((ext_vector_type(2)));
__device__ __forceinline__ unsigned pk2(float lo, float hi) { const f2_t v = {lo, hi}; return __builtin_bit_cast(unsigned, __builtin_convertvector(v, bf2_t)); }
__device__ __forceinline__ unsigned f2bf(float f) { return pk2(f, 0.f) & 0xffffu; }
__device__ __forceinline__ float bf2f(unsigned short h) { return __builtin_bit_cast(float, (unsigned)h << 16); }
__device__ __forceinline__ unsigned f2h(float f) { _Float16 h = (_Float16)f; return (unsigned)__builtin_bit_cast(unsigned short, h); }
__device__ __forceinline__ unsigned pk2h(float lo, float hi) { return f2h(lo) | (f2h(hi) << 16); }
__device__ __forceinline__ float h2f(unsigned short u) { return (float)__builtin_bit_cast(_Float16, u); }
__device__ __forceinline__ float silu_f(float x) { return x * __builtin_amdgcn_rcpf(1.0f + __expf(-x)); }
__device__ __forceinline__ float sigmoid_f(float x) { return __builtin_amdgcn_rcpf(1.0f + __expf(-x)); }
__device__ __forceinline__ float wave_sum(float v) {
#pragma unroll
    for (int o = 1; o < 64; o <<= 1) v += __shfl_xor(v, o);
    return v;
}


#define PSTAMP_(lds_, k_) do { if (threadIdx.x == 0) ((volatile LAS unsigned long long*)((lds_) + LDS_BYTES - 512))[(k_)] = __builtin_amdgcn_s_memrealtime(); } while (0)
#if defined(PROBE_ID) && PROBE_ID >= 216 && PROBE_ID < 220
#define PSTAMP_H(lds_, k_) PSTAMP_(lds_, k_)
#else
#define PSTAMP_H(lds_, k_) do { } while (0)
#endif
#if defined(PROBE_ID) && PROBE_ID >= 226 && PROBE_ID < 230
#define PSTAMP_P(lds_, k_) PSTAMP_(lds_, k_)
#else
#define PSTAMP_P(lds_, k_) do { } while (0)
#endif
#if defined(PROBE_ID) && PROBE_ID >= 220 && PROBE_ID < 226
#define PSTAMP_S(lds_, k_) PSTAMP_(lds_, k_)
#else
#define PSTAMP_S(lds_, k_) do { } while (0)
#endif
typedef GAS unsigned gu32;
#define XB_TMO      128
#define XB_XCNT(j)  (256  + 64 * (j))
#define XB_XSUB(j)  (1280 + 64 * (j))
#define XB_XGEN(j)  (2304 + 64 * (j))
#define XB_TOP      3328
#define XB_TOPGEN   3392
#define XCD_BAR_WORDS 3456
#define XB_SPIN_CAP (1u << 18)
__device__ __forceinline__ unsigned xb_ld(unsigned* p)              { return __hip_atomic_load(p, __ATOMIC_RELAXED, __HIP_MEMORY_SCOPE_AGENT); }
__device__ __forceinline__ unsigned xb_add(unsigned* p, unsigned v) { return __hip_atomic_fetch_add(p, v, __ATOMIC_RELAXED, __HIP_MEMORY_SCOPE_AGENT); }
__device__ __forceinline__ unsigned xb_xcc_id() { return (unsigned)__builtin_amdgcn_s_getreg((3 << 11) | 20) & 0xFu; }
#define XB_SPIN(cond, bar) do { unsigned _sp = 0; while (cond) { __builtin_amdgcn_s_sleep(1); \
    if ((++_sp & 255u) == 0u) { if (xb_ld(&(bar)[XB_TMO])) break; if (_sp > XB_SPIN_CAP) { atomicAdd(&(bar)[XB_TMO], 1u); break; } } } } while (0)
struct XcdBarrier { unsigned* bar; unsigned x; volatile LAS unsigned* st; };
__device__ __forceinline__ XcdBarrier xcd_barrier_post(unsigned* bar, volatile LAS unsigned* st) {
    XcdBarrier b; b.bar = bar; b.x = xb_xcc_id(); b.st = st;
    if (threadIdx.x == 0) (void)xb_add(&bar[XB_XCNT(b.x)], 1u);
    return b;
}
__device__ __forceinline__ void xcd_barrier_complete(unsigned* bar, unsigned x, unsigned& nloc, unsigned& nx) {
    const unsigned G = gridDim.x * gridDim.y * gridDim.z;
    unsigned sum, cnt, mine, sp = 0u;
    for (;;) {
        sum = 0u; cnt = 0u; mine = 0u;
#pragma unroll
        for (unsigned j = 0; j < 16; ++j) { const unsigned c = xb_ld(&bar[XB_XCNT(j)]); sum += c; cnt += (c > 0u) ? 1u : 0u; mine = (j == x) ? c : mine; }
        if (sum == G) break;
        __builtin_amdgcn_s_sleep(1);
        if ((++sp & 255u) == 0u) { if (xb_ld(&bar[XB_TMO])) break; if (sp > XB_SPIN_CAP) { atomicAdd(&bar[XB_TMO], 1u); break; } }
    }
    nloc = mine > 0u ? mine : 1u; nx = cnt > 0u ? cnt : 1u;
}
__device__ __forceinline__ void xcd_barrier(const XcdBarrier& b) {
    asm volatile("s_waitcnt vmcnt(0)" ::: "memory");
    __syncthreads();
    if (threadIdx.x == 0) {
        unsigned* bar = b.bar;
        __builtin_amdgcn_s_waitcnt(0);
        unsigned nloc = b.st[0], nx = b.st[1];
        if (nloc == 0u) { xcd_barrier_complete(bar, b.x, nloc, nx); b.st[0] = nloc; b.st[1] = nx; }
        const unsigned old = xb_add(&bar[XB_XSUB(b.x)], 1u);
        const unsigned gen = old / nloc;
        if (old + 1u == (gen + 1u) * nloc) {
            __builtin_amdgcn_fence(__ATOMIC_RELEASE, "agent");
            asm volatile("s_waitcnt vmcnt(0)" ::: "memory");
            const unsigned og = xb_add(&bar[XB_TOP], 1u);
            const unsigned tg = og / nx;
            if (og + 1u == (tg + 1u) * nx) xb_add(&bar[XB_TOPGEN], 1u);
            else XB_SPIN(xb_ld(&bar[XB_TOPGEN]) == tg, bar);
            __builtin_amdgcn_fence(__ATOMIC_ACQUIRE, "agent");
            xb_add(&bar[XB_XGEN(b.x)], 1u);
            asm volatile("s_waitcnt vmcnt(0)" ::: "memory");
        } else {
            XB_SPIN(xb_ld(&bar[XB_XGEN(b.x)]) == gen, bar);
            __builtin_amdgcn_fence(__ATOMIC_ACQUIRE, "agent");
            asm volatile("s_waitcnt vmcnt(0)" ::: "memory");
        }
    }
    __syncthreads();
}

struct EpiIn {
    static constexpr bool PERM = true;
    bf16* PA; bf16* PB; const float* lb;
    __device__ __forceinline__ bool swap(const pg8::Unit& u) const { return u.pn >= 10; }
    __device__ __forceinline__ void operator()(const f32x4 (&acc)[2][2][4][2], const pg8::Unit& u, int wr, int wc, int fr, int fq) const {
        if (u.pn < 10) {
            const int type = u.pn >> 1;
            const int row0 = u.pm * 256 + wr * 64 + fr, col0 = u.pn * 256 + wc * 32 + 8 * fq;
#pragma unroll
            for (int bj = 0; bj < 2; ++bj) {
                float lbv[8];
#pragma unroll
                for (int e = 0; e < 8; ++e) lbv[e] = (type == 1 || type == 2) ? lb[col0 + bj * 128 + e - 512] : 0.f;
#pragma unroll
                for (int ai = 0; ai < 2; ++ai)
#pragma unroll
                    for (int m = 0; m < 4; ++m) {
                        bf16* rowp = PA + (size_t)(row0 + ai * 128 + m * 16) * PA_LD + col0 + bj * 128;
                        float x[8];
#pragma unroll
                        for (int e = 0; e < 4; ++e) { x[e] = acc[ai][bj][m][0][e]; x[4 + e] = acc[ai][bj][m][1][e]; }
                        v4u w;
                        if (type == 0) {
#pragma unroll
                            for (int e = 0; e < 8; ++e) x[e] = silu_f(x[e]);
                            w.x = pk2(x[0], x[1]); w.y = pk2(x[2], x[3]); w.z = pk2(x[4], x[5]); w.w = pk2(x[6], x[7]);
                        } else if (type == 1 || type == 2) {
#pragma unroll
                            for (int e = 0; e < 8; ++e) x[e] = lbv[e] + (1.0f - lbv[e]) * sigmoid_f(x[e]);
                            w.x = pk2h(x[0], x[1]); w.y = pk2h(x[2], x[3]); w.z = pk2h(x[4], x[5]); w.w = pk2h(x[6], x[7]);
                        } else {
                            w.x = pk2(x[0], x[1]); w.y = pk2(x[2], x[3]); w.z = pk2(x[4], x[5]); w.w = pk2(x[6], x[7]);
                        }
                        *(v4u*)rowp = w;
                        asm volatile("" ::: "memory");
                    }
            }
        } else {
#pragma unroll
            for (int ai = 0; ai < 2; ++ai)
#pragma unroll
                for (int m = 0; m < 4; ++m) {
                    const int cw = u.pn * 256 + ai * 128 + wr * 64 + m * 16 + fr;
                    bf16* colp = PB + (size_t)(cw - 2560) * MTOK + u.pm * 256 + wc * 32 + 8 * fq;
#pragma unroll
                    for (int bj = 0; bj < 2; ++bj) {
                        const f32x4 v0 = acc[ai][bj][m][0], v1 = acc[ai][bj][m][1];
                        v4u w; w.x = pk2(v0[0], v0[1]); w.y = pk2(v0[2], v0[3]); w.z = pk2(v1[0], v1[1]); w.w = pk2(v1[2], v1[3]);
                        *(v4u*)(colp + bj * 128) = w;
                    }
                }
        }
    }
};
struct EpiOut {
    static constexpr bool PERM = true;
    bf16* DL; const float* mod;
    __device__ __forceinline__ bool swap(const pg8::Unit&) const { return false; }
    __device__ __forceinline__ void operator()(const f32x4 (&acc)[2][2][4][2], const pg8::Unit& u, int wr, int wc, int fr, int fq) const {
        const int mr = u.pm >= 128 ? 8 : (u.pm >> 4);
        const int col0 = u.pn * 256 + wc * 32 + 8 * fq;
        f32x4 g0[2], g1[2];
#pragma unroll
        for (int bj = 0; bj < 2; ++bj) { const float* gt = mod + (size_t)mr * 3 * D + 2 * D + col0 + bj * 128; g0[bj] = *(const f32x4*)gt; g1[bj] = *(const f32x4*)(gt + 4); }
#pragma unroll
        for (int ai = 0; ai < 2; ++ai)
#pragma unroll
            for (int m = 0; m < 4; ++m) {
                bf16* rowp = DL + (size_t)(u.pm * 256 + ai * 128 + wr * 64 + m * 16 + fr) * D + col0;
#pragma unroll
                for (int bj = 0; bj < 2; ++bj) {
                    const f32x4 v0 = acc[ai][bj][m][0] * g0[bj], v1 = acc[ai][bj][m][1] * g1[bj];
                    v4u w; w.x = pk2(v0[0], v0[1]); w.y = pk2(v0[2], v0[3]); w.z = pk2(v1[0], v1[1]); w.w = pk2(v1[2], v1[3]);
                    *(v4u*)(rowp + bj * 128) = w;
                }
            }
    }
};

struct Args {
    const float* in[23]; float* out; unsigned char* ws; int ph_lo, ph_hi;
};

struct Frame {
    LAS unsigned char* lds; int tid, lane, wave, vcu, G;
};

__device__ __forceinline__ void p0_transpose_item(const float* W, int K, int N, bf16* WT, LAS float* scr, int item, int lane) {
    const int nblk = N / 32, kb = item / nblk, nb = item % nblk, k0 = 64 * kb, n0 = 32 * nb;
    f32x4 v[8];
#pragma unroll
    for (int i = 0; i < 8; ++i) v[i] = *(const f32x4*)(W + (size_t)(k0 + 8 * i + (lane >> 3)) * N + n0 + 4 * (lane & 7));
#pragma unroll
    for (int i = 0; i < 8; ++i) { LAS float* d = scr + (8 * i + (lane >> 3)) * 33 + 4 * (lane & 7); d[0] = v[i][0]; d[1] = v[i][1]; d[2] = v[i][2]; d[3] = v[i][3]; }
    asm volatile("s_waitcnt lgkmcnt(0)" ::: "memory");
    const int c = lane & 7;
#pragma unroll
    for (int j = 0; j < 4; ++j) { const int n = (lane >> 3) + 8 * j; const LAS float* s = scr + (8 * c) * 33 + n;
        v4u o; o.x = pk2(s[0 * 33], s[1 * 33]); o.y = pk2(s[2 * 33], s[3 * 33]); o.z = pk2(s[4 * 33], s[5 * 33]); o.w = pk2(s[6 * 33], s[7 * 33]);
        *(v4u*)(WT + (size_t)(n0 + n) * K + k0 + 8 * c) = o; }
    asm volatile("s_waitcnt lgkmcnt(0)" ::: "memory");
}

__device__ __forceinline__ void filter_task(const Args& a, Frame& F, const int set, const int n0, int& cached_layer) {
    unsigned char* ws = a.ws;
    const int l = set == 1 ? 1 : 0, L = set == 2 ? 256 : 4096;
    LAS float* w1s = (LAS float*)F.lds;
    LAS float* w2s = w1s + 33 * 64;
    LAS float* w3s = w2s + 64 * 64;
    LAS float* bs = w3s + 64 * 64;
    LAS float* zs = bs + 256;
    LAS float* h3s = zs + 8 * 4 * 64;
    LAS unsigned short* tile = (LAS unsigned short*)(h3s + 32 * 64);
    if (cached_layer != l) {
        __syncthreads();
        for (int e = F.tid; e < 33 * 64; e += NTHR) w1s[e] = a.in[13][l * 33 * 64 + e];
        for (int e = F.tid; e < 4096; e += NTHR) { w2s[e] = a.in[16][l * 4096 + e]; w3s[e] = a.in[18][l * 4096 + e]; }
        if (F.tid < 64) { bs[F.tid] = a.in[14][l * 64 + F.tid]; bs[64 + F.tid] = a.in[17][l * 64 + F.tid]; bs[128 + F.tid] = a.in[19][l * 64 + F.tid]; bs[192 + F.tid] = a.in[15][l * 64 + F.tid]; }
        cached_layer = l;
        __syncthreads();
    }
    {
        const int j = F.lane; LAS float* zw = zs + F.wave * 256; const float fr = bs[192 + j];
#pragma unroll
        for (int p = 0; p < 4; ++p) {
            const int n = n0 + 4 * F.wave + p;
            float zv = 0.f;
            if (j == 0) zv = (float)n / (float)(L - 1);
            else if (j < 33) { const int i = (j - 1) & 15; const double f = 1e-4 + (double)i * ((15.0 - 1e-4) / 15.0); double rev = f * (double)n / (double)L; rev -= floor(rev);
                const float ang = (float)(rev * 6.283185307179586476925); zv = (j <= 16) ? __cosf(ang) : -__sinf(ang); }
            zw[p * 64 + j] = zv;
        }
        asm volatile("s_waitcnt lgkmcnt(0)" ::: "memory");
        float s4[4];
#pragma unroll
        for (int p = 0; p < 4; ++p) s4[p] = bs[j];
        for (int e = 0; e < 33; ++e) { const float wv = w1s[e * 64 + j];
#pragma unroll
            for (int p = 0; p < 4; ++p) s4[p] += zw[p * 64 + e] * wv; }
        asm volatile("s_waitcnt lgkmcnt(0)" ::: "memory");
#pragma unroll
        for (int p = 0; p < 4; ++p) zw[p * 64 + j] = __sinf(fr * s4[p]);
        asm volatile("s_waitcnt lgkmcnt(0)" ::: "memory");
#pragma unroll
        for (int p = 0; p < 4; ++p) s4[p] = bs[64 + j];
        for (int e = 0; e < 64; ++e) { const float wv = w2s[e * 64 + j];
#pragma unroll
            for (int p = 0; p < 4; ++p) s4[p] += zw[p * 64 + e] * wv; }
        asm volatile("s_waitcnt lgkmcnt(0)" ::: "memory");
#pragma unroll
        for (int p = 0; p < 4; ++p) zw[p * 64 + j] = __sinf(fr * s4[p]);
        asm volatile("s_waitcnt lgkmcnt(0)" ::: "memory");
#pragma unroll
        for (int p = 0; p < 4; ++p) s4[p] = bs[128 + j];
        for (int e = 0; e < 64; ++e) { const float wv = w3s[e * 64 + j];
#pragma unroll
            for (int p = 0; p < 4; ++p) s4[p] += zw[p * 64 + e] * wv; }
#pragma unroll
        for (int p = 0; p < 4; ++p) h3s[(4 * F.wave + p) * 64 + j] = __sinf(fr * s4[p]);
    }
    __syncthreads();
    {
        typedef short bf16x8_ __attribute__((ext_vector_type(8)));
        LAS unsigned char* hA = (LAS unsigned char*)(tile + 1024 * 34);
        LAS unsigned char* wB = hA + 32 * 144;
        const int l15 = F.lane & 15, q = F.lane >> 4;
        { const int p = F.tid >> 4, k4 = (F.tid & 15) * 4; const f32x4 hv = *(const LAS f32x4*)(h3s + p * 64 + k4);
          v2u hw; hw.x = pk2(hv[0], hv[1]); hw.y = pk2(hv[2], hv[3]); *(LAS v2u*)(hA + p * 144 + 2 * k4) = hw; }
        float* nrm = (float*)(ws + WS_CTL) + CW_NORM;
        const float* w4 = a.in[20] + (size_t)l * 64 * 1024;
        for (int ch = 0; ch < 8; ++ch) {
            __syncthreads();
            { const int n = F.tid & 127, kq = F.tid >> 7;
              float wv[2][8];
#pragma unroll
              for (int g2 = 0; g2 < 2; ++g2)
#pragma unroll
                  for (int e = 0; e < 8; ++e) wv[g2][e] = w4[(size_t)(16 * kq + 8 * g2 + e) * 1024 + 128 * ch + n];
#pragma unroll
              for (int g2 = 0; g2 < 2; ++g2) { v4u o; o.x = pk2(wv[g2][0], wv[g2][1]); o.y = pk2(wv[g2][2], wv[g2][3]); o.z = pk2(wv[g2][4], wv[g2][5]); o.w = pk2(wv[g2][6], wv[g2][7]);
                  *(LAS v4u*)(wB + n * 144 + (16 * kq + 8 * g2) * 2) = o; } }
            __syncthreads();
            {
                const int col = 128 * ch + 16 * F.wave + l15, c = col & 511;
                f32x4 acc[2];
#pragma unroll
                for (int mt = 0; mt < 2; ++mt) { acc[mt] = (f32x4){0.f, 0.f, 0.f, 0.f};
#pragma unroll
                    for (int ks = 0; ks < 2; ++ks)
                        acc[mt] = __builtin_amdgcn_mfma_f32_16x16x32_bf16(*(const LAS bf16x8_*)(hA + (16 * mt + l15) * 144 + (32 * ks + 8 * q) * 2), *(const LAS bf16x8_*)(wB + (16 * F.wave + l15) * 144 + (32 * ks + 8 * q) * 2), acc[mt], 0, 0, 0); }
                const float dl = fabsf(HY_MIN_DECAY + (float)c * ((HY_MAX_DECAY - HY_MIN_DECAY) / 511.0f));
                float ns = 0.f;
#pragma unroll
                for (int mt = 0; mt < 2; ++mt) {
                    float v4[4];
#pragma unroll
                    for (int r = 0; r < 4; ++r) { const int nn = n0 + 16 * mt + 4 * q + r; v4[r] = acc[mt][r] * __expf(-((float)nn / (float)(L - 1)) * dl); if (col < 512 || nn >= 1) ns += fabsf(v4[r]); }
                    *(LAS unsigned*)(tile + col * 34 + 16 * mt + 4 * q) = pk2(v4[0], v4[1]); *(LAS unsigned*)(tile + col * 34 + 16 * mt + 4 * q + 2) = pk2(v4[2], v4[3]);
                }
                ns += __shfl_xor(ns, 16); ns += __shfl_xor(ns, 32);
                if (q == 0) atomicAdd(&nrm[set * 512 + c], ns);
            }
        }
    }
    __syncthreads();
    {
        bf16* dst = set == 2 ? (bf16*)(ws + WS_FGC) : (bf16*)(ws + WS_FG) + (size_t)set * 512 * FZ;
        const int ld = set == 2 ? FZC : FZ;
        for (int e = F.tid; e < 1024 * 32; e += NTHR) {
            const int col = e >> 5, p = e & 31, c = col & 511, n = n0 + p;
            const unsigned short v = tile[col * 34 + p];
            if (col < 512) dst[(size_t)c * ld + (L - n)] = v;
            else if (n >= 1) dst[(size_t)c * ld + (L + n)] = v;
        }
        if (n0 == 0) {
            const int npad = ld - 2 * L;
            for (int e = F.tid; e < 512 * (npad + 1); e += NTHR) { const int c = e / (npad + 1), k = e % (npad + 1); dst[(size_t)c * ld + (k == 0 ? 0 : 2 * L + k - 1)] = 0; }
        }
    }
    __syncthreads();
}

__device__ __forceinline__ void phase_prologue(const Args& a, Frame& F) {
    unsigned char* ws = a.ws;
    if (F.vcu == 0) {
        float* lbs = (float*)(ws + WS_LBS);
        for (int i = F.tid; i < 1024; i += NTHR) {
            const float a0 = a.in[9][i], a1 = a.in[9][1024 + i];
            const float m = fmaxf(a0, a1), e0 = expf(a0 - m), e1 = expf(a1 - m);
            const float p0 = e0 / (e0 + e1), p1 = e1 / (e0 + e1);
            const float c0 = p0, c1 = p0 + p1;
            lbs[i] = c0 - c0; lbs[1024 + i] = c1 - c0;
        }
    }
    int cached_layer = -1;
    PSTAMP_P(F.lds, 26);
    constexpr int I_IN = (D / 64) * (NIN / 32), I_OUT = (D / 64) * (D / 32), NTR = 2 * (I_IN + I_OUT) / 8;
    const bool filtcu = F.vcu < 16 || (F.vcu >= 128 && F.vcu < 136), modcu = F.vcu >= 160;
    const int tr0 = modcu ? F.vcu - 160 : filtcu ? NTR : 96 + (F.vcu < 128 ? F.vcu - 16 : F.vcu - 136 + 112), trend = modcu ? 96 : NTR;
    for (int t = tr0; t < trend; t += 136) {
        LAS float* scr = (LAS float*)(F.lds + 65536 + F.wave * 8704);
        int r = t * 8 + F.wave; const int l = r / (I_IN + I_OUT); r -= l * (I_IN + I_OUT);
        if (r < I_IN) p0_transpose_item(a.in[7] + (size_t)l * D * NIN, D, NIN, (bf16*)(ws + WS_WIN) + (size_t)l * NIN * D, scr, r, F.lane);
        else p0_transpose_item(a.in[8] + (size_t)l * D * D, D, D, (bf16*)(ws + WS_WOUT) + (size_t)l * D * D, scr, r - I_IN, F.lane);
    }
    __syncthreads();
    PSTAMP_P(F.lds, 27);
    if (F.vcu >= 160) {
        const int task = F.vcu - 160;
        LAS float* sv = (LAS float*)(F.lds + 65536);
        LAS float* part = sv + 9 * 1024;
        const int l = task / 48, n0 = (task % 48) * 64;
        for (int e = F.tid; e < 9 * 1024; e += NTHR) { const int r = e >> 10, k = e & 1023; const float cv = r < 8 ? a.in[1][r * D + k] : a.in[3][k]; sv[e] = cv / (1.0f + expf(-cv)); }
        __syncthreads();
        float acc9[9];
#pragma unroll
        for (int r = 0; r < 9; ++r) acc9[r] = 0.f;
        const float* w = a.in[5] + (size_t)l * D * 3 * D + n0 + F.lane;
#pragma unroll 16
        for (int k = F.wave * 128; k < F.wave * 128 + 128; ++k) {
            const float wv = w[(size_t)k * 3 * D];
#pragma unroll
            for (int r = 0; r < 9; ++r) acc9[r] += sv[r * 1024 + k] * wv;
        }
#pragma unroll
        for (int r = 0; r < 9; ++r) part[(F.wave * 9 + r) * 64 + F.lane] = acc9[r];
        __syncthreads();
        for (int e = F.tid; e < 9 * 64; e += NTHR) {
            const int r = e >> 6, c = e & 63; float sum = 0.f;
#pragma unroll
            for (int w8 = 0; w8 < 8; ++w8) sum += part[(w8 * 9 + r) * 64 + c];
            ((float*)(ws + WS_MOD))[((size_t)l * 9 + r) * 3 * D + n0 + c] = sum + a.in[6][l * 3 * D + n0 + c];
        }
        __syncthreads();
    }
    PSTAMP_P(F.lds, 28);
    if (F.vcu < 16) filter_task(a, F, 0, 32 * (112 + F.vcu), cached_layer);
    else if (F.vcu >= 128 && F.vcu < 136) filter_task(a, F, 2, 32 * (F.vcu - 128), cached_layer);
    PSTAMP_P(F.lds, 29);
}
__device__ __forceinline__ void phase_filters_l0(const Args& a, Frame& F) {
    int cached_layer = -1; const int b = (int)blockIdx.x;
    if (b >= 144) filter_task(a, F, 0, 32 * (b - 144), cached_layer);
}
__device__ __forceinline__ void phase_filters_l1(const Args& a, Frame& F) {
    int cached_layer = -1; const int b = (int)blockIdx.x;
    if (b >= 32 && b < 160) filter_task(a, F, 1, 32 * (b - 32), cached_layer);
}

__device__ __forceinline__ void phase_normrows(const Args& a, Frame& F, int l, const float* xlat, const float* xctx) {
    unsigned char* ws = a.ws;
    const float* nw = a.in[4] + l * D;
    const float* mod = (const float*)(ws + WS_MOD) + (size_t)l * 9 * 3 * D;
    bf16* XA = (bf16*)(ws + WS_XA);
    const bf16* DL = (const bf16*)(ws + WS_PB);
    const int gw = F.vcu * NWAVES + F.wave, NGW = F.G * NWAVES;
    f32x4 v[4]; v2u dw[4];
#define NR_LOAD(tok_, V_, DW_) do { const int t_ = (tok_) < MTOK ? (tok_) : MTOK - 1; const bool c_ = t_ >= MLAT; \
        const float* xr_ = c_ ? xctx + (size_t)(t_ - MLAT) * D : xlat + (size_t)t_ * D; \
        _Pragma("unroll") for (int j = 0; j < 4; ++j) V_[j] = *(const f32x4*)(xr_ + 256 * j + 4 * F.lane); \
        if (l == 1) { _Pragma("unroll") for (int j = 0; j < 4; ++j) DW_[j] = *(const v2u*)(DL + (size_t)t_ * D + 256 * j + 4 * F.lane); } } while (0)
    NR_LOAD(gw, v, dw);
    for (int tok = gw; tok < MTOK; tok += NGW) {
        const bool isctx = tok >= MLAT;
        const int mr = isctx ? 8 : (tok >> 12);
        const float* sh = mod + (size_t)mr * 3 * D; const float* sc = sh + D;
        f32x4 vn[4]; v2u dn[4];
        NR_LOAD(tok + NGW, vn, dn);
        float s = 0.f;
        if (l == 1) {
#pragma unroll
            for (int j = 0; j < 4; ++j) { v[j].x += bf2f((unsigned short)(dw[j].x & 0xffffu)); v[j].y += bf2f((unsigned short)(dw[j].x >> 16)); v[j].z += bf2f((unsigned short)(dw[j].y & 0xffffu)); v[j].w += bf2f((unsigned short)(dw[j].y >> 16)); }
            if (!isctx) {
#pragma unroll
                for (int j = 0; j < 4; ++j) *(f32x4*)(a.out + (size_t)tok * D + 256 * j + 4 * F.lane) = v[j];
            }
        }
#pragma unroll
        for (int j = 0; j < 4; ++j) s += (v[j].x * v[j].x + v[j].y * v[j].y) + (v[j].z * v[j].z + v[j].w * v[j].w);
        const float rstd = 1.0f / sqrtf(wave_sum(s) * (1.0f / D) + EPS);
#pragma unroll
        for (int j = 0; j < 4; ++j) {
            const int k = 256 * j + 4 * F.lane;
            const f32x4 w4 = *(const f32x4*)(nw + k), s4 = *(const f32x4*)(sc + k), h4 = *(const f32x4*)(sh + k);
            const f32x4 y = v[j] * rstd * w4 * (s4 + 1.0f) + h4;
            v2u o; o.x = pk2(y.x, y.y); o.y = pk2(y.z, y.w);
            *(v2u*)(XA + (size_t)tok * D + k) = o;
        }
#pragma unroll
        for (int j = 0; j < 4; ++j) { v[j] = vn[j]; dw[j] = dn[j]; }
    }
#undef NR_LOAD
}


namespace scan {
typedef short bf16x8 __attribute__((ext_vector_type(8)));
typedef short bf16x4 __attribute__((ext_vector_type(4)));
constexpr int QI_RS = 256, KT_RS = 160;
constexpr int OFF_QI = 0, OFF_KI = 16384, OFF_KT = 32768, OFF_VT = 53248, OFF_SCL = 73728, SET_BYTES = 74752;
constexpr int OFF_SEG = 2 * SET_BYTES;
static_assert(OFF_SEG + 4096 <= LDS_BYTES - 512, "scan LDS");
#define MFMA16(a, b, c) __builtin_amdgcn_mfma_f32_16x16x32_bf16((a), (b), (c), 0, 0, 0)
__device__ __forceinline__ bf16x8 ld_qk(const LAS unsigned char* img, int row, int ks, int xq) {
    return *(const LAS bf16x8*)(img + row * QI_RS + ((16 * xq) ^ (64 * ks)));
}
__device__ __forceinline__ int tok_row(int g, int i, int b, int dir) {
    if (g < 4) { const int t = 64 * g + i; return MLAT + b * LCX + (dir ? (LCX - 1 - t) : t); }
    const int t = 64 * (g - 4) + i; return b * LX + (dir ? (LX - 1 - t) : t);
}
template <int HALF>
__device__ __forceinline__ void scan_producer(LAS unsigned char* lds, const bf16* PA, const int b, const int h, const int dir, const int nchunk, const int pw, const int lane) {
    const int tg = lane >> 4, cq = lane & 15, ch0 = 64 * (pw >> 1) + 4 * cq;
    LAS float* seg = (LAS float*)(lds + OFF_SEG + pw * 1024);
    const int qc_ = 8 * (pw >> 1) + 4 * (cq >> 3) + (cq & 3);
    v2u qA[8], fA[8], vA[8], qB[8], fB[8], vB[8];
#define SCAN_LOAD(g, Q_, F_, V_) do { _Pragma("unroll") for (int e = 0; e < 8; ++e) { const bf16* p_ = PA + (size_t)tok_row((g), 32 * HALF + 8 * tg + e, b, dir) * PA_LD + h * HD + ch0; \
        Q_[e] = *(const v2u*)p_; F_[e] = *(const v2u*)(p_ + 512 + dir * 512); V_[e] = *(const v2u*)(p_ + 1536); } } while (0)
#define SCAN_IMG(set_, Q_, F_, V_) do { LAS unsigned char* s_ = lds + (set_) * SET_BYTES; \
        _Pragma("unroll") for (int e = 0; e < 8; ++e) asm volatile("" : "+v"(F_[e].x), "+v"(F_[e].y)); \
        float f_[4][8]; \
        _Pragma("unroll") for (int e = 0; e < 8; ++e) { f_[0][e] = h2f((unsigned short)(F_[e].x & 0xffffu)); f_[1][e] = h2f((unsigned short)(F_[e].x >> 16)); f_[2][e] = h2f((unsigned short)(F_[e].y & 0xffffu)); f_[3][e] = h2f((unsigned short)(F_[e].y >> 16)); } \
        f32x4 pr_; \
        _Pragma("unroll") for (int d = 0; d < 4; ++d) pr_[d] = ((f_[d][0] * f_[d][1]) * (f_[d][2] * f_[d][3])) * ((f_[d][4] * f_[d][5]) * (f_[d][6] * f_[d][7])); \
        *(LAS f32x4*)(seg + tg * 64 + 4 * cq) = pr_; \
        f32x4 T_[4]; _Pragma("unroll") for (int t2 = 0; t2 < 4; ++t2) T_[t2] = *(const LAS f32x4*)(seg + t2 * 64 + 4 * cq); \
        const f32x4 tot_ = (T_[0] * T_[1]) * (T_[2] * T_[3]); \
        f32x4 mul_ = (f32x4){1.f, 1.f, 1.f, 1.f}; \
        if (HALF) { _Pragma("unroll") for (int t2 = 0; t2 < 3; ++t2) if (t2 < tg) mul_ *= T_[t2]; } \
        else      { _Pragma("unroll") for (int t2 = 1; t2 < 4; ++t2) if (t2 > tg) mul_ *= T_[t2]; } \
        float Qp_[4][8], Kp_[4][8]; \
        _Pragma("unroll") for (int d = 0; d < 4; ++d) { float x_[8]; float run_ = mul_[d]; \
            if (HALF) { _Pragma("unroll") for (int e = 0; e < 8; ++e) { run_ *= f_[d][e]; x_[e] = run_; } } \
            else      { _Pragma("unroll") for (int e = 7; e >= 0; --e) { x_[e] = run_; run_ *= f_[d][e]; } } \
            _Pragma("unroll") for (int e = 0; e < 8; ++e) { const unsigned qw_ = (d & 2) ? Q_[e].y : Q_[e].x; const float qv_ = bf2f((unsigned short)((d & 1) ? (qw_ >> 16) : (qw_ & 0xffffu))); \
                const float xx_ = fmaxf(x_[e], 1e-30f), r_ = __builtin_amdgcn_rcpf(xx_), kk_ = 1.0f - f_[d][e]; \
                Qp_[d][e] = HALF ? qv_ * xx_ : qv_ * r_; Kp_[d][e] = HALF ? kk_ * r_ : kk_ * xx_; } \
            v4u t_, u_; \
            _Pragma("unroll") for (int e = 0; e < 4; ++e) { t_[e] = pk2(Kp_[d][2 * e], Kp_[d][2 * e + 1]); \
                const unsigned va_ = (d & 2) ? V_[2 * e].y : V_[2 * e].x, vb_ = (d & 2) ? V_[2 * e + 1].y : V_[2 * e + 1].x; \
                u_[e] = (d & 1) ? ((va_ >> 16) | (vb_ & 0xffff0000u)) : ((va_ & 0xffffu) | (vb_ << 16)); } \
            *(LAS v4u*)(s_ + OFF_KT + (ch0 + d) * KT_RS + 16 * ((4 * HALF + tg) ^ (cq & 7))) = t_; *(LAS v4u*)(s_ + OFF_VT + (ch0 + d) * KT_RS + 16 * ((4 * HALF + tg) ^ (cq & 7))) = u_; } \
        int qx_ = qc_ ^ (8 * (tg & 1)); asm volatile("" : "+v"(qx_)); const int rb_ = (32 * HALF + 8 * tg) * QI_RS + 8 * ((cq >> 2) & 1); \
        _Pragma("unroll") for (int e = 0; e < 8; ++e) { v2u qq_, kq_; qq_.x = pk2(Qp_[0][e], Qp_[1][e]); qq_.y = pk2(Qp_[2][e], Qp_[3][e]); kq_.x = pk2(Kp_[0][e], Kp_[1][e]); kq_.y = pk2(Kp_[2][e], Kp_[3][e]); \
            const int ro_ = rb_ + e * QI_RS + 16 * (qx_ ^ e); \
            *(LAS v2u*)(s_ + OFF_QI + ro_) = qq_; *(LAS v2u*)(s_ + OFF_KI + ro_) = kq_; } \
        if (tg == 0) *(LAS f32x4*)(s_ + OFF_SCL + 512 * HALF + 4 * ch0) = tot_; } while (0)
    const int last = nchunk - 1;
    SCAN_LOAD(0, qA, fA, vA);
    SCAN_LOAD(1, qB, fB, vB);
    SCAN_IMG(0, qA, fA, vA);
    SCAN_LOAD(2, qA, fA, vA);
    __syncthreads();
    for (int g = 0; g < nchunk; g += 2) {
        SCAN_IMG(1, qB, fB, vB);
        { const int gn = g + 3 < last ? g + 3 : last; SCAN_LOAD(gn, qB, fB, vB); }
        __syncthreads();
        SCAN_IMG(0, qA, fA, vA);
        { const int gn = g + 4 < last ? g + 4 : last; SCAN_LOAD(gn, qA, fA, vA); }
        __syncthreads();
    }
#undef SCAN_LOAD
#undef SCAN_IMG
}
__device__ __forceinline__ void scan_unit(LAS unsigned char* lds, bf16* PA, bf16* OC, const int b, const int h, const int dir, const bool ctxunit) {
    int tid_ = threadIdx.x; asm volatile("" : "+v"(tid_));
    const int tid = tid_, lane = tid & 63, w = __builtin_amdgcn_readfirstlane(tid >> 6);
    const int l15 = lane & 15, q = lane >> 4;
    const int nchunk = ctxunit ? 4 : 68;
    if (w >= 4) {
        if (w & 1) scan_producer<1>(lds, PA, b, h, dir, nchunk, w - 4, lane); else scan_producer<0>(lds, PA, b, h, dir, nchunk, w - 4, lane);
    } else {
        f32x4 S[2][8];
#pragma unroll
        for (int c = 0; c < 2; ++c)
#pragma unroll
            for (int kt = 0; kt < 8; ++kt) S[c][kt] = (f32x4){0.f, 0.f, 0.f, 0.f};
        const int vc0 = 32 * w, xq = q ^ l15;
        if (!ctxunit) PSTAMP_S(lds, 20);
        __syncthreads();
        for (int g = 0; g < nchunk; ++g) {
            const bool do_o = ctxunit || g >= 4;
            const LAS unsigned char* cs = lds + (g & 1) * SET_BYTES;
            if (g == 30) PSTAMP_S(lds, 22);
#pragma unroll
            for (int kt = 0; kt < 8; ++kt) { const f32x4 gm4 = *(const LAS f32x4*)(cs + OFF_SCL + (16 * kt + 4 * q) * 4); S[0][kt] *= gm4; S[1][kt] *= gm4; }
            if (do_o) {
                bf16x8 vp[2][2];
#pragma unroll
                for (int c = 0; c < 2; ++c) { const int r_ = vc0 + 8 * (l15 >> 2) + 4 * c + (l15 & 3), x_ = (r_ >> 2) & 7;
#pragma unroll
                    for (int js = 0; js < 2; ++js) { const int c1 = 4 * js + (q >> 1);
                        const bf16x4 lo = *(const LAS bf16x4*)(cs + OFF_VT + r_ * KT_RS + 16 * (c1 ^ x_) + 8 * (q & 1)), hi4 = *(const LAS bf16x4*)(cs + OFF_VT + r_ * KT_RS + 16 * ((c1 + 2) ^ x_) + 8 * (q & 1));
                        vp[c][js] = __builtin_shufflevector(lo, hi4, 0, 1, 2, 3, 4, 5, 6, 7); } }
                bf16x8 sf[2][4];
#pragma unroll
                for (int ks = 0; ks < 4; ++ks) {
#pragma unroll
                    for (int c = 0; c < 2; ++c) { const f32x4 s0 = S[c][2 * ks], s1 = S[c][2 * ks + 1];
                        v4u pk; pk.x = pk2(s0[0], s0[1]); pk.y = pk2(s0[2], s0[3]); pk.z = pk2(s1[0], s1[1]); pk.w = pk2(s1[2], s1[3]); sf[c][ks] = __builtin_bit_cast(bf16x8, pk); }
                }
#pragma unroll
                for (int it = 0; it < 4; ++it) {
                    bf16x8 qf[4];
#pragma unroll
                    for (int ks = 0; ks < 4; ++ks) qf[ks] = ld_qk(cs + OFF_QI, 16 * it + l15, ks, xq);
                    f32x4 O0 = (f32x4){0.f, 0.f, 0.f, 0.f}, O1 = O0;
#pragma unroll
                    for (int ks = 0; ks < 4; ++ks) { O0 = MFMA16(sf[0][ks], qf[ks], O0); O1 = MFMA16(sf[1][ks], qf[ks], O1); }
                    unsigned pt[4][2];
#pragma unroll
                    for (int jt = 0; jt < 4; ++jt) {
                        if (jt <= it) {
                            f32x4 a4 = (f32x4){0.f, 0.f, 0.f, 0.f};
#pragma unroll
                            for (int ks = 0; ks < 4; ++ks) a4 = MFMA16(ld_qk(cs + OFF_KI, 16 * jt + l15, ks, xq), qf[ks], a4);
                            if (jt == it) {
#pragma unroll
                                for (int r = 0; r < 4; ++r) a4[r] = (4 * q + r <= l15) ? a4[r] : 0.f;
                            }
                            pt[jt][0] = pk2(a4[0], a4[1]); pt[jt][1] = pk2(a4[2], a4[3]);
                        } else { pt[jt][0] = 0u; pt[jt][1] = 0u; }
                    }
                    { v4u bw; bw.x = pt[0][0]; bw.y = pt[0][1]; bw.z = pt[1][0]; bw.w = pt[1][1]; const bf16x8 bb = __builtin_bit_cast(bf16x8, bw);
                      O0 = MFMA16(vp[0][0], bb, O0); O1 = MFMA16(vp[1][0], bb, O1); }
                    if (it >= 2) { v4u bw; bw.x = pt[2][0]; bw.y = pt[2][1]; bw.z = pt[3][0]; bw.w = pt[3][1]; const bf16x8 bb = __builtin_bit_cast(bf16x8, bw);
                      O0 = MFMA16(vp[0][1], bb, O0); O1 = MFMA16(vp[1][1], bb, O1); }
                    const int row = tok_row(g, 16 * it + l15, b, dir);
                    bf16* dst = (g < 4) ? OC + (size_t)dir * MCTX * 512 + (size_t)(row - MLAT) * 512 + h * HD + vc0 + 8 * q
                                        : PA + (size_t)row * PA_LD + 512 + dir * 512 + h * HD + vc0 + 8 * q;
                    v4u wv; wv.x = pk2(O0[0], O0[1]); wv.y = pk2(O0[2], O0[3]); wv.z = pk2(O1[0], O1[1]); wv.w = pk2(O1[2], O1[3]);
                    *(v4u*)dst = wv;
                }
            }
            bf16x8 vt[2][2];
#pragma unroll
            for (int c = 0; c < 2; ++c) { const int r_ = vc0 + 8 * (l15 >> 2) + 4 * c + (l15 & 3), x_ = (r_ >> 2) & 7;
                vt[c][0] = *(const LAS bf16x8*)(cs + OFF_VT + r_ * KT_RS + 16 * (q ^ x_)); vt[c][1] = *(const LAS bf16x8*)(cs + OFF_VT + r_ * KT_RS + 16 * ((4 + q) ^ x_)); }
#pragma unroll
            for (int kt = 0; kt < 8; ++kt) {
                const f32x4 gem = *(const LAS f32x4*)(cs + OFF_SCL + 512 + (16 * kt + 4 * q) * 4);
                const int xk_ = (4 * kt + (l15 >> 2)) & 7;
                const bf16x8 k0 = *(const LAS bf16x8*)(cs + OFF_KT + (16 * kt + l15) * KT_RS + 16 * (q ^ xk_)), k1 = *(const LAS bf16x8*)(cs + OFF_KT + (16 * kt + l15) * KT_RS + 16 * ((4 + q) ^ xk_));
#pragma unroll
                for (int c = 0; c < 2; ++c) { f32x4 d4 = MFMA16(k0, vt[c][0], S[c][kt]); d4 = MFMA16(k1, vt[c][1], d4); S[c][kt] = gem * d4; }
            }
            if (g == 30) PSTAMP_S(lds, 23);
            __syncthreads();
            if (g == 30) PSTAMP_S(lds, 24);
        }
        if (!ctxunit) PSTAMP_S(lds, 21);
    }
}
}


namespace hy {
typedef short bf16x8 __attribute__((ext_vector_type(8)));
typedef short bf16x4 __attribute__((ext_vector_type(4)));
constexpr int CS = 16416;
constexpr int VPAD = 7;
constexpr int OFF_F = 0, OFF_V = 4 * CS, V_ROWS = (64 + VPAD + 7) * 8, LDS_END = OFF_V + V_ROWS * 128;
static_assert(LDS_END <= LDS_BYTES - 256, "hyena LDS");
struct ConvW { float x0[4], x1[4], v[4]; };
__device__ __forceinline__ ConvW load_convw(const Args& a, int l, int c) {
    const float* cw = a.in[11] + (size_t)l * 3 * 1536; const float* cb = a.in[12] + (size_t)l * 1536; ConvW r;
#pragma unroll
    for (int j = 0; j < 3; ++j) { r.x0[j] = cw[j * 1536 + c]; r.x1[j] = cw[j * 1536 + 512 + c]; r.v[j] = cw[j * 1536 + 1024 + c]; }
    r.x0[3] = cb[c]; r.x1[3] = cb[512 + c]; r.v[3] = cb[1024 + c];
    return r;
}
__device__ __forceinline__ void hyena_channel(LAS unsigned char* lds, const Args& a, const int l, const int c) {
    int tid_ = threadIdx.x; asm volatile("" : "+v"(tid_));
    const int tid = tid_, lane = tid & 63, w = __builtin_amdgcn_readfirstlane(tid >> 6), l15 = lane & 15, q = lane >> 4;
    unsigned char* ws = a.ws;
    const bf16* PB = (const bf16*)(ws + WS_PB);
    const bf16* x0r = PB + (size_t)c * MTOK; const bf16* x1r = PB + (size_t)(512 + c) * MTOK; const bf16* vr = PB + (size_t)(1024 + c) * MTOK; const bf16* gbr = PB + (size_t)(1536 + c) * MTOK;
    const ConvW cw = load_convw(a, l, c);
    PSTAMP_H(lds, 16);
    {
        const bf16* F = (const bf16*)(ws + WS_FG) + ((size_t)l * 512 + c) * FZ;
        for (int ch = tid; ch < 1024; ch += NTHR) {
            const v4u cur = *(const v4u*)(F + 8 * ch); v4u prev = *(const v4u*)(F + (ch > 0 ? 8 * ch - 8 : 0));
            if (ch == 0) prev = (v4u){0u, 0u, 0u, 0u};
            const unsigned W[8] = {prev.x, prev.y, prev.z, prev.w, cur.x, cur.y, cur.z, cur.w};
            v4u c1, c2, c3;
#pragma unroll
            for (int d = 0; d < 4; ++d) { c1[d] = (W[3 + d] >> 16) | (W[4 + d] << 16); c2[d] = W[3 + d]; c3[d] = (W[2 + d] >> 16) | (W[3 + d] << 16); }
            *(LAS v4u*)(lds + OFF_F + 0 * CS + 16 * ch) = cur;
            *(LAS v4u*)(lds + OFF_F + 1 * CS + 16 * ch) = c1;
            *(LAS v4u*)(lds + OFF_F + 2 * CS + 16 * ch) = c2;
            *(LAS v4u*)(lds + OFF_F + 3 * CS + 16 * ch) = c3;
        }
    }
    {
        for (int e = tid; e < VPAD * 8 * 32; e += NTHR) ((LAS unsigned*)(lds + OFF_V))[e] = 0u;
        for (int e = tid; e < 7 * 8 * 32; e += NTHR) ((LAS unsigned*)(lds + OFF_V + (64 + VPAD) * 8 * 128))[e] = 0u;
        for (int bt = 0; bt < 2; ++bt) {
            v4u vw[4], xw[4]; unsigned short hv[4][2], hx[4][2];
#pragma unroll
            for (int j = 0; j < 4; ++j) {
                const int e = tid + NTHR * (4 * bt + j), b = e >> 9, t0 = (e & 511) * 8;
                const size_t base = (size_t)b * LX + t0;
                const size_t bm = t0 > 0 ? base - 1 : base, bp = t0 + 8 < LX ? base + 8 : base;
                vw[j] = *(const v4u*)(vr + base); xw[j] = *(const v4u*)(x1r + base);
                hv[j][0] = vr[bm]; hv[j][1] = vr[bp]; hx[j][0] = x1r[bm]; hx[j][1] = x1r[bp];
            }
#pragma unroll
            for (int j = 0; j < 4; ++j) {
                const int e = tid + NTHR * (4 * bt + j), b = e >> 9, t0 = (e & 511) * 8, ab = t0 >> 6, ch = (t0 & 63) >> 3;
                float vv[10], xx[10];
                vv[0] = t0 > 0 ? bf2f(hv[j][0]) : 0.f; xx[0] = t0 > 0 ? bf2f(hx[j][0]) : 0.f;
                vv[9] = t0 + 8 < LX ? bf2f(hv[j][1]) : 0.f; xx[9] = t0 + 8 < LX ? bf2f(hx[j][1]) : 0.f;
#pragma unroll
                for (int d = 0; d < 4; ++d) { vv[1 + 2 * d] = bf2f((unsigned short)(vw[j][d] & 0xffffu)); vv[2 + 2 * d] = bf2f((unsigned short)(vw[j][d] >> 16));
                                              xx[1 + 2 * d] = bf2f((unsigned short)(xw[j][d] & 0xffffu)); xx[2 + 2 * d] = bf2f((unsigned short)(xw[j][d] >> 16)); }
                float p[8];
#pragma unroll
                for (int d = 0; d < 8; ++d) p[d] = (cw.v[3] + cw.v[0] * vv[d] + cw.v[1] * vv[d + 1] + cw.v[2] * vv[d + 2]) * (cw.x1[3] + cw.x1[0] * xx[d] + cw.x1[1] * xx[d + 1] + cw.x1[2] * xx[d + 2]);
                v4u o; o.x = pk2(p[0], p[1]); o.y = pk2(p[2], p[3]); o.z = pk2(p[4], p[5]); o.w = pk2(p[6], p[7]);
                const int R = (ab + VPAD) * 8 + b;
                *(LAS v4u*)(lds + OFF_V + R * 128 + 16 * (ch ^ ((R >> 1) & 7))) = o;
            }
        }
    }
    __syncthreads();
    PSTAMP_H(lds, 17);
    f32x4 acc[4][4];
#pragma unroll
    for (int mt = 0; mt < 4; ++mt)
#pragma unroll
        for (int nt = 0; nt < 4; ++nt) acc[mt][nt] = (f32x4){0.f, 0.f, 0.f, 0.f};
    {
        const LAS unsigned char* pa = lds + OFF_F + (l15 & 3) * CS + (4096 - 4 * (l15 >> 2) + 8 * q) * 2 - 96;
        const int rowl = (l15 >> 3) * 8 + (l15 & 7);
        const int cq = (q ^ (rowl >> 1)) & 7;
        const LAS unsigned char* vb0 = lds + OFF_V + rowl * 128 + (8 * w + VPAD) * 1024 + 16 * cq;
        const LAS unsigned char* vb1 = lds + OFF_V + rowl * 128 + (8 * w + VPAD) * 1024 + 16 * (cq ^ 4);
#define HY_LDA(An_, m_) do { const LAS unsigned char* p_ = pa - 128 * (m_); _Pragma("unroll") for (int mt = 0; mt < 4; ++mt) { \
            const bf16x4 lo_ = *(const LAS bf16x4*)(p_ + 32 * (3 - mt)), hi_ = *(const LAS bf16x4*)(p_ + 32 * (3 - mt) + 8); An_[mt] = __builtin_shufflevector(lo_, hi_, 0, 1, 2, 3, 4, 5, 6, 7); } } while (0)
#define HY_LDB(B_, m_, PAR_) do { const LAS unsigned char* p0_ = ((PAR_) ? vb1 : vb0) - 1024 * (m_); const LAS unsigned char* p1_ = ((PAR_) ? vb0 : vb1) - 1024 * (m_); \
            _Pragma("unroll") for (int nt = 0; nt < 4; ++nt) { B_[0][nt] = *(const LAS bf16x8*)(p0_ + 2048 * nt); B_[1][nt] = *(const LAS bf16x8*)(p1_ + 2048 * nt); } } while (0)
#define HY_MMA(An_, Ao0_, Ao1_, B_, m_) do { _Pragma("unroll") for (int nt = 0; nt < 4; ++nt) { const int a0_ = 8 * w + 2 * nt - (m_); if (a0_ + 1 >= 0 && a0_ <= 63) { \
            _Pragma("unroll") for (int mt = 0; mt < 4; ++mt) acc[mt][nt] = __builtin_amdgcn_mfma_f32_16x16x32_bf16(An_[mt], B_[0][nt], acc[mt][nt], 0, 0, 0); \
            acc[0][nt] = __builtin_amdgcn_mfma_f32_16x16x32_bf16(Ao0_, B_[1][nt], acc[0][nt], 0, 0, 0); acc[1][nt] = __builtin_amdgcn_mfma_f32_16x16x32_bf16(Ao1_, B_[1][nt], acc[1][nt], 0, 0, 0); \
            acc[2][nt] = __builtin_amdgcn_mfma_f32_16x16x32_bf16(An_[0], B_[1][nt], acc[2][nt], 0, 0, 0); acc[3][nt] = __builtin_amdgcn_mfma_f32_16x16x32_bf16(An_[1], B_[1][nt], acc[3][nt], 0, 0, 0); } } } while (0)
        bf16x8 Aa[4], Ab[4], Ba[2][4], Bb[2][4], o0, o1;
        const int m0 = 8 * w - 63, mlast = 8 * w + 7;
        { bf16x8 t_[4]; HY_LDA(t_, m0 - 1); o0 = t_[2]; o1 = t_[3]; }
        HY_LDA(Aa, m0); HY_LDB(Ba, m0, 0);
        for (int m = m0; m < mlast; m += 2) {
            HY_LDA(Ab, m + 1); HY_LDB(Bb, m + 1, 1);
            HY_MMA(Aa, o0, o1, Ba, m);
            o0 = Aa[2]; o1 = Aa[3];
            HY_LDA(Aa, m + 2); HY_LDB(Ba, m + 2, 0);
            HY_MMA(Ab, o0, o1, Bb, m + 1);
            o0 = Ab[2]; o1 = Ab[3];
        }
        HY_MMA(Aa, o0, o1, Ba, mlast);
#undef HY_LDA
#undef HY_LDB
#undef HY_MMA
    }
    PSTAMP_H(lds, 18);
    __syncthreads();
    {
        constexpr int YRS = 8208;
        const float inn = 1.0f / ((const float*)(ws + WS_CTL))[CW_NORM + l * 512 + c], hb = a.in[21][l * 512 + c];
        const int b = l15 & 7;
#pragma unroll
        for (int nt = 0; nt < 4; ++nt) {
            const int ab = 8 * w + 2 * nt + (l15 >> 3), R = (ab + VPAD) * 8 + b;
#pragma unroll
            for (int mt = 0; mt < 4; ++mt) {
                const int t = 64 * ab + 16 * mt + 4 * q;
                const v2u vw = *(const LAS v2u*)(lds + OFF_V + R * 128 + 16 * ((2 * mt + (q >> 1)) ^ ((R >> 1) & 7)) + 8 * (q & 1));
                const float y0 = acc[mt][nt][0] * inn + bf2f((unsigned short)(vw.x & 0xffffu)) * hb, y1 = acc[mt][nt][1] * inn + bf2f((unsigned short)(vw.x >> 16)) * hb;
                const float y2 = acc[mt][nt][2] * inn + bf2f((unsigned short)(vw.y & 0xffffu)) * hb, y3 = acc[mt][nt][3] * inn + bf2f((unsigned short)(vw.y >> 16)) * hb;
                v2u yw; yw.x = pk2(y0, y1); yw.y = pk2(y2, y3);
                *(LAS v2u*)(lds + OFF_F + b * YRS + 2 * t) = yw;
            }
        }
        __syncthreads();
        bf16* OBT = (bf16*)(ws + WS_OBT) + (size_t)c * MTOK;
        int tid2 = tid; asm volatile("" : "+v"(tid2));
        for (int bt = 0; bt < 4; ++bt) {
            v4u xw[2], gw[2]; unsigned short hx[2][2];
#pragma unroll
            for (int j = 0; j < 2; ++j) {
                const int e = tid2 + NTHR * (2 * bt + j), bb = e >> 9, t0 = (e & 511) * 8;
                const size_t base = (size_t)bb * LX + t0;
                xw[j] = *(const v4u*)(x0r + base); gw[j] = *(const v4u*)(gbr + base);
                hx[j][0] = x0r[t0 > 0 ? base - 1 : base]; hx[j][1] = x0r[t0 + 8 < LX ? base + 8 : base];
            }
#pragma unroll
            for (int j = 0; j < 2; ++j) {
                const int e = tid2 + NTHR * (2 * bt + j), bb = e >> 9, t0 = (e & 511) * 8;
                const size_t base = (size_t)bb * LX + t0;
                const v4u yw = *(const LAS v4u*)(lds + OFF_F + bb * YRS + 2 * t0);
                float xs[10], o[8];
                xs[0] = t0 > 0 ? bf2f(hx[j][0]) : 0.f; xs[9] = t0 + 8 < LX ? bf2f(hx[j][1]) : 0.f;
#pragma unroll
                for (int d = 0; d < 4; ++d) { xs[1 + 2 * d] = bf2f((unsigned short)(xw[j][d] & 0xffffu)); xs[2 + 2 * d] = bf2f((unsigned short)(xw[j][d] >> 16)); }
#pragma unroll
                for (int d = 0; d < 8; ++d) {
                    const float yv = bf2f((unsigned short)((d & 1) ? (yw[d >> 1] >> 16) : (yw[d >> 1] & 0xffffu)));
                    const float gv = bf2f((unsigned short)((d & 1) ? (gw[j][d >> 1] >> 16) : (gw[j][d >> 1] & 0xffffu)));
                    o[d] = yv * (cw.x0[3] + cw.x0[0] * xs[d] + cw.x0[1] * xs[d + 1] + cw.x0[2] * xs[d + 2]) * silu_f(gv);
                }
                v4u ow; ow.x = pk2(o[0], o[1]); ow.y = pk2(o[2], o[3]); ow.z = pk2(o[4], o[5]); ow.w = pk2(o[6], o[7]);
                *(v4u*)(OBT + base) = ow;
            }
        }
    }
    PSTAMP_H(lds, 19);
    __syncthreads();
}
__device__ __forceinline__ void hyena_ctx_channel(LAS unsigned char* lds, const Args& a, const int c) {
    int tid_ = threadIdx.x; asm volatile("" : "+v"(tid_));
    const int tid = tid_;
    unsigned char* ws = a.ws;
    const bf16* PB = (const bf16*)(ws + WS_PB);
    const bf16* x0r = PB + (size_t)c * MTOK + MLAT; const bf16* x1r = PB + (size_t)(512 + c) * MTOK + MLAT; const bf16* vr = PB + (size_t)(1024 + c) * MTOK + MLAT; const bf16* gbr = PB + (size_t)(1536 + c) * MTOK + MLAT;
    const ConvW cw = load_convw(a, 0, c);
    LAS float* vvc = (LAS float*)lds;
    LAS float* Fc = vvc + 2048;
    for (int e = tid; e < 2048; e += NTHR) {
        const int t = e & 255;
        const float vm_ = bf2f(vr[t > 0 ? e - 1 : e]), v0 = bf2f(vr[e]), vp_ = bf2f(vr[t < 255 ? e + 1 : e]);
        const float xm_ = bf2f(x1r[t > 0 ? e - 1 : e]), x0 = bf2f(x1r[e]), xp_ = bf2f(x1r[t < 255 ? e + 1 : e]);
        const float vm = t > 0 ? vm_ : 0.f, vp = t < 255 ? vp_ : 0.f, xm = t > 0 ? xm_ : 0.f, xp = t < 255 ? xp_ : 0.f;
        vvc[e] = (cw.v[3] + cw.v[0] * vm + cw.v[1] * v0 + cw.v[2] * vp) * (cw.x1[3] + cw.x1[0] * xm + cw.x1[1] * x0 + cw.x1[2] * xp);
    }
    if (tid < 520) Fc[tid] = tid < 512 ? bf2f(((const bf16*)(ws + WS_FGC))[(size_t)c * FZC + tid]) : 0.f;
    __syncthreads();
    const float inn = 1.0f / ((const float*)(ws + WS_CTL))[CW_NORM + 2 * 512 + c], hb = a.in[21][c];
    bf16* OBT = (bf16*)(ws + WS_OBT) + (size_t)c * MTOK + MLAT;
    {
        const int b = tid >> 6, t0 = 4 * (tid & 63), e0 = b * 256 + t0;
        float acc4[4] = {0.f, 0.f, 0.f, 0.f};
        const LAS float* fp = Fc + 252 - t0;
        for (int s4 = 0; s4 < 64; ++s4) {
            const f32x4 ga = *(const LAS f32x4*)(fp + 4 * s4), gb = *(const LAS f32x4*)(fp + 4 * s4 + 4), vq = *(const LAS f32x4*)(vvc + b * 256 + 4 * s4);
            const float g[8] = {ga[0], ga[1], ga[2], ga[3], gb[0], gb[1], gb[2], gb[3]};
#pragma unroll
            for (int i = 0; i < 4; ++i)
#pragma unroll
                for (int u = 0; u < 4; ++u) acc4[i] += g[4 - i + u] * vq[u];
        }
        float xs[6], gv[4];
        xs[0] = t0 > 0 ? bf2f(x0r[e0 - 1]) : 0.f;
#pragma unroll
        for (int i = 0; i < 4; ++i) { xs[1 + i] = bf2f(x0r[e0 + i]); gv[i] = bf2f(gbr[e0 + i]); }
        xs[5] = t0 + 4 < 256 ? bf2f(x0r[e0 + 4]) : 0.f;
        float o[4];
#pragma unroll
        for (int i = 0; i < 4; ++i) o[i] = (acc4[i] * inn + vvc[e0 + i] * hb) * (cw.x0[3] + cw.x0[0] * xs[i] + cw.x0[1] * xs[i + 1] + cw.x0[2] * xs[i + 2]) * silu_f(gv[i]);
        v2u ow; ow.x = pk2(o[0], o[1]); ow.y = pk2(o[2], o[3]);
        *(v2u*)(OBT + e0) = ow;
    }
    __syncthreads();
}
}


__device__ __forceinline__ void phase_mix(const Args& a, Frame& F, const int l, const int part = -1) {
    unsigned* qctr = (unsigned*)(a.ws + WS_CTL) + CW_QUEUE + 64 * l + (part == 1 ? 128 : 0);
    volatile LAS int* slot = (volatile LAS int*)(F.lds + LDS_BYTES - 64);
    const int ntasks = l == 0 ? 64 + 512 + 64 + 512 : 64 + 512;
    for (;;) {
        if (F.tid == 0) slot[0] = (int)atomicAdd(qctr, 1u);
        __syncthreads();
        const int t = __builtin_amdgcn_readfirstlane(slot[0]);
        __syncthreads();
        if (t >= ntasks) break;
        if (part == 0 && !(t < 64 || (t >= 576 && t < 640))) continue;
        if (part == 1 && (t < 64 || (t >= 576 && t < 640))) continue;
        if (t < 64) scan::scan_unit(F.lds, (bf16*)(a.ws + WS_PA), (bf16*)(a.ws + WS_OC), t >> 3, (t >> 1) & 3, t & 1, false);
        else if (t < 576) hy::hyena_channel(F.lds, a, l, t - 64);
        else if (t < 640) { const int u = t - 576; scan::scan_unit(F.lds, (bf16*)(a.ws + WS_PA), (bf16*)(a.ws + WS_OC), u >> 3, (u >> 1) & 3, u & 1, true); }
        else hy::hyena_ctx_channel(F.lds, a, t - 640);
        __syncthreads();
    }
}

__device__ __forceinline__ void phase_finalize_ox(const Args& a, Frame& F, int l) {
    unsigned char* ws = a.ws;
    const bf16* PA = (const bf16*)(ws + WS_PA);
    const bf16* OC = (const bf16*)(ws + WS_OC);
    bf16* XA = (bf16*)(ws + WS_XA);
    const float* gnw = a.in[10] + l * 512;
    const int gw = F.vcu * NWAVES + F.wave, NGW = F.G * NWAVES;
    const int ntok = (l == 0) ? MTOK : MLAT;
    for (int tok = gw; tok < ntok; tok += NGW) {
        const bool isctx = tok >= MLAT;
        const int c8 = 8 * F.lane;
        const bf16* pf = isctx ? OC + (size_t)(tok - MLAT) * 512 + c8 : PA + (size_t)tok * PA_LD + 512 + c8;
        const bf16* pb = isctx ? OC + (size_t)MCTX * 512 + (size_t)(tok - MLAT) * 512 + c8 : PA + (size_t)tok * PA_LD + 1024 + c8;
        const v4u wf = *(const v4u*)pf, wb = *(const v4u*)pb, wg = *(const v4u*)(PA + (size_t)tok * PA_LD + 2048 + c8);
        float o[8], g[8];
#pragma unroll
        for (int e = 0; e < 4; ++e) {
            o[2 * e] = bf2f((unsigned short)(wf[e] & 0xffff)) + bf2f((unsigned short)(wb[e] & 0xffff));
            o[2 * e + 1] = bf2f((unsigned short)(wf[e] >> 16)) + bf2f((unsigned short)(wb[e] >> 16));
            g[2 * e] = bf2f((unsigned short)(wg[e] & 0xffff)); g[2 * e + 1] = bf2f((unsigned short)(wg[e] >> 16));
        }
        float s = 0.f;
#pragma unroll
        for (int e = 0; e < 8; ++e) s += o[e] * o[e];
        s += __shfl_xor(s, 1); s += __shfl_xor(s, 2); s += __shfl_xor(s, 4); s += __shfl_xor(s, 8);
        const float rstd = 1.0f / sqrtf(s * (1.0f / HD) + EPS);
        float y[8];
#pragma unroll
        for (int e = 0; e < 8; ++e) y[e] = o[e] * rstd * gnw[c8 + e] * silu_f(g[e]);
        v4u w; w.x = pk2(y[0], y[1]); w.y = pk2(y[2], y[3]); w.z = pk2(y[4], y[5]); w.w = pk2(y[6], y[7]);
        *(v4u*)(XA + (size_t)tok * D + c8) = w;
    }
    LAS unsigned short* t = (LAS unsigned short*)(F.lds + F.wave * 16384);
    const int ntt = ntok / 64;
    for (int it = gw; it < 8 * ntt; it += NGW) {
        const int ct = it / ntt, tt = it % ntt, c0 = ct * 64, t0 = tt * 64;
        const bf16* OBT = (const bf16*)(ws + WS_OBT);
#pragma unroll
        for (int i = 0; i < 8; ++i) {
            const int e = F.lane + 64 * i, c = e >> 3, ch = e & 7;
            const v4u w = *(const v4u*)(OBT + (size_t)(c0 + c) * MTOK + t0 + 8 * ch);
#pragma unroll
            for (int q = 0; q < 4; ++q) { t[c * 66 + 8 * ch + 2 * q] = (unsigned short)(w[q] & 0xffff); t[c * 66 + 8 * ch + 2 * q + 1] = (unsigned short)(w[q] >> 16); }
        }
        asm volatile("s_waitcnt lgkmcnt(0)" ::: "memory");
#pragma unroll
        for (int i = 0; i < 8; ++i) {
            const int e = F.lane + 64 * i, tk = e >> 3, cg = e & 7;
            unsigned short h[8];
#pragma unroll
            for (int q = 0; q < 8; ++q) h[q] = t[(8 * cg + q) * 66 + tk];
            v4u w; w.x = h[0] | ((unsigned)h[1] << 16); w.y = h[2] | ((unsigned)h[3] << 16); w.z = h[4] | ((unsigned)h[5] << 16); w.w = h[6] | ((unsigned)h[7] << 16);
            *(v4u*)(XA + (size_t)(t0 + tk) * D + 512 + c0 + 8 * cg) = w;
        }
        asm volatile("s_waitcnt lgkmcnt(0)" ::: "memory");
    }
}

__device__ __forceinline__ void phase_final_norm(const Args& a, Frame& F) {
    const float* w = a.in[22];
    const bf16* DL = (const bf16*)(a.ws + WS_PB);
    const int gw = F.vcu * NWAVES + F.wave, NGW = F.G * NWAVES;
    for (int tok = gw; tok < MLAT; tok += NGW) {
        float* xr = a.out + (size_t)tok * D;
        f32x4 v[4]; float s = 0.f;
#pragma unroll
        for (int j = 0; j < 4; ++j) { v[j] = *(const f32x4*)(xr + 256 * j + 4 * F.lane); const v2u dw = *(const v2u*)(DL + (size_t)tok * D + 256 * j + 4 * F.lane);
            v[j].x += bf2f((unsigned short)(dw.x & 0xffffu)); v[j].y += bf2f((unsigned short)(dw.x >> 16)); v[j].z += bf2f((unsigned short)(dw.y & 0xffffu)); v[j].w += bf2f((unsigned short)(dw.y >> 16));
            s += (v[j].x * v[j].x + v[j].y * v[j].y) + (v[j].z * v[j].z + v[j].w * v[j].w); }
        const float rstd = 1.0f / sqrtf(wave_sum(s) * (1.0f / D) + EPS);
#pragma unroll
        for (int j = 0; j < 4; ++j) { const f32x4 w4 = *(const f32x4*)(w + 256 * j + 4 * F.lane); *(f32x4*)(xr + 256 * j + 4 * F.lane) = v[j] * rstd * w4; }
    }
}

enum { PH_PRO = 0, PH_NORM0 = 1, PH_IN0 = 2, PH_MIX0 = 3, PH_FIN0 = 4, PH_OUT0 = 5, PH_NORM1 = 6, PH_IN1 = 7, PH_MIX1 = 8, PH_FIN1 = 9, PH_OUT1 = 10, PH_FINAL = 11 };

__device__ __forceinline__ Frame mkframe(unsigned char* lds) {
    Frame F;
    F.lds = (LAS unsigned char*)lds;
    F.tid = threadIdx.x; F.lane = F.tid & 63; F.wave = __builtin_amdgcn_readfirstlane(F.tid >> 6);
    F.G = gridDim.x; { const int bx = blockIdx.x; F.vcu = (F.G % 8 == 0) ? (bx % 8) * (F.G / 8) + bx / 8 : bx; }
    return F;
}
template <int l> __device__ __forceinline__ void run_inproj(const Args& args, unsigned char* lds) {
    unsigned char* ws = args.ws; Frame F = mkframe(lds);
    pg8::Gemm g{(const bf16*)(ws + WS_XA), (const bf16*)(ws + WS_WIN) + (size_t)l * NIN * D, D};
    pg8::Sched S; S.init(128, 18, F.G, (int)blockIdx.x, 8, l == 0 ? 18 : 8);
    EpiIn E{(bf16*)(ws + WS_PA), (bf16*)(ws + WS_PB), (const float*)(ws + WS_LBS) + l * 1024};
    pg8::gemm_phase<EpiIn, true, true>(F.lds, g, S, E);
}
template <int l> __device__ __forceinline__ void run_outproj(const Args& args, unsigned char* lds) {
    unsigned char* ws = args.ws; Frame F = mkframe(lds);
    pg8::Gemm g{(const bf16*)(ws + WS_XA), (const bf16*)(ws + WS_WOUT) + (size_t)l * D * D, D};
    pg8::Sched S; S.init(128, 4, F.G, (int)blockIdx.x, l == 0 ? 8 : 0, 4);
    EpiOut E{(bf16*)(ws + WS_PB), (const float*)(ws + WS_MOD) + (size_t)l * 9 * 3 * D};
    pg8::gemm_phase<EpiOut, true, true>(F.lds, g, S, E);
}
__global__ void __launch_bounds__(NTHR, 2) mega(Args args) {
    extern __shared__ __attribute__((aligned(16))) unsigned char lds[];
    const int lo = args.ph_lo, hi = args.ph_hi;
#define IN(k) (lo <= (k) && (k) < hi)
    volatile LAS unsigned* bst = (volatile LAS unsigned*)((LAS unsigned char*)lds + LDS_BYTES - 32);
    if (threadIdx.x < 8) ((volatile LAS unsigned*)((LAS unsigned char*)lds + LDS_BYTES - 32))[threadIdx.x] = 0u;
    __syncthreads();
    XcdBarrier bar; bar.bar = (unsigned*)(args.ws + WS_CTL) + CW_BAR; bar.x = 0; bar.st = bst;
    if (hi - lo > 1) bar = xcd_barrier_post((unsigned*)(args.ws + WS_CTL) + CW_BAR, bst);
#ifdef PROBE_ID
    volatile LAS unsigned long long* pts = (volatile LAS unsigned long long*)((LAS unsigned char*)lds + LDS_BYTES - 512);
    if (threadIdx.x == 0) pts[0] = __builtin_amdgcn_s_memrealtime();
#define SEAM(k) do { if (IN((k) + 1)) xcd_barrier(bar); else __syncthreads(); if (threadIdx.x == 0) pts[(k) + 1] = __builtin_amdgcn_s_memrealtime(); } while (0)
#else
#define SEAM(k) do { if (IN((k) + 1)) xcd_barrier(bar); else __syncthreads(); } while (0)
#endif
    if (IN(PH_PRO)) { Frame F = mkframe(lds); phase_prologue(args, F); SEAM(PH_PRO); }
    if (IN(PH_NORM0)) { Frame F = mkframe(lds); phase_normrows(args, F, 0, args.in[0], args.in[2]); SEAM(PH_NORM0); }
    if (IN(PH_IN0)) { run_inproj<0>(args, lds); { Frame F = mkframe(lds); phase_filters_l0(args, F); } SEAM(PH_IN0); }
#ifdef SPLIT_MIX
    if (IN(PH_MIX0)) { Frame F = mkframe(lds); phase_mix(args, F, 0, 0); xcd_barrier(bar); if (threadIdx.x == 0) pts[15] = __builtin_amdgcn_s_memrealtime(); phase_mix(args, F, 0, 1); SEAM(PH_MIX0); }
#else
    if (IN(PH_MIX0)) { Frame F = mkframe(lds); phase_mix(args, F, 0); SEAM(PH_MIX0); }
#endif
    if (IN(PH_FIN0)) { Frame F = mkframe(lds); phase_finalize_ox(args, F, 0); SEAM(PH_FIN0); }
    if (IN(PH_OUT0)) { run_outproj<0>(args, lds); { Frame F = mkframe(lds); phase_filters_l1(args, F); } SEAM(PH_OUT0); }
    if (IN(PH_NORM1)) { Frame F = mkframe(lds); phase_normrows(args, F, 1, args.in[0], args.in[2]); SEAM(PH_NORM1); }
    if (IN(PH_IN1)) { run_inproj<1>(args, lds); SEAM(PH_IN1); }
    if (IN(PH_MIX1)) { Frame F = mkframe(lds); phase_mix(args, F, 1); SEAM(PH_MIX1); }
    if (IN(PH_FIN1)) { Frame F = mkframe(lds); phase_finalize_ox(args, F, 1); SEAM(PH_FIN1); }
    if (IN(PH_OUT1)) { run_outproj<1>(args, lds); SEAM(PH_OUT1); }
    if (IN(PH_FINAL)) { Frame F = mkframe(lds); phase_final_norm(args, F); SEAM(PH_FINAL); }
#ifdef PROBE_ID
    if (blockIdx.x == 0 && threadIdx.x == 0) {
#ifdef SPLIT_MIX
        const unsigned long long dt = (PROBE_ID == 100) ? pts[15] - pts[PH_MIX0] : pts[PH_MIX0 + 1] - pts[15];
#else
        const unsigned long long dt = (PROBE_ID >= 200) ? ((PROBE_ID == 220 || PROBE_ID >= 226) ? 1ull : 16ull) * (pts[PROBE_ID - 200 + 1] - pts[PROBE_ID - 200]) : pts[PROBE_ID + 1] - pts[PROBE_ID];
#endif
        const unsigned long long t0 = __builtin_amdgcn_s_memrealtime();
        unsigned long long wt = 4ull * dt; if (wt > 300000ull) wt = 300000ull;
        while (__builtin_amdgcn_s_memrealtime() - t0 < wt) __builtin_amdgcn_s_sleep(8);
    }
#endif
#undef IN
#undef SEAM
}

extern "C" void kernel_launch(void* const* d_in, const int* in_sizes, int n_in, void* d_out, int out_size, void* d_ws, size_t ws_size, hipStream_t stream) {
    static int grid = 0;
    if (grid == 0) {
        if (n_in != 23 || ws_size < WS_END) { fprintf(stderr, "kernel_launch: unexpected n_in %d / ws_size %zu\n", n_in, ws_size); grid = -1; return; }
        int dev = 0, cus = 0;
        if (hipGetDevice(&dev) != hipSuccess || hipDeviceGetAttribute(&cus, hipDeviceAttributeMultiprocessorCount, dev) != hipSuccess) { grid = -1; return; }
        if (hipFuncSetAttribute((const void*)mega, hipFuncAttributeMaxDynamicSharedMemorySize, LDS_BYTES) != hipSuccess) { fprintf(stderr, "kernel_launch: hipFuncSetAttribute failed\n"); grid = -1; return; }
        grid = cus;
    }
    if (grid < 0) return;
    (void)hipMemsetAsync((char*)d_ws + WS_CTL, 0, CTL_ZERO_BYTES, stream);
    Args a{};
    for (int i = 0; i < 23; ++i) a.in[i] = (const float*)d_in[i];
    a.out = (float*)d_out; a.ws = (unsigned char*)d_ws;
    a.ph_lo = 0; a.ph_hi = PH_FINAL + 1;
    hipLaunchKernelGGL(mega, dim3(grid), dim3(NTHR), LDS_BYTES, stream, a);
}
```
